# Optimizing an MI355X kernel written in HIP

```python
import math
import jax
import jax.numpy as jnp
from jax import lax
import numpy as np

D_MODEL = 1024
BATCH = 16
SEQ = 4096
DEPTH = 2

MEM_LEN = 256
N_EVEN = (DEPTH + 1) // 2
N_ODD = DEPTH // 2
NORM_EPS = 1e-6

RW_HEAD_DIM = 64
RW_DIM = D_MODEL // 2
RW_HEADS = RW_DIM // RW_HEAD_DIM
RW_DECAY_RANK = 64
RW_A_RANK = 64
RW_GATE_RANK = 128
RW_GN_EPS = 64e-5
RW_PROJ = 3 * RW_DIM + RW_DECAY_RANK + RW_A_RANK + RW_GATE_RANK

SSD_HEAD_DIM = 64
SSD_DIM = D_MODEL // 2
SSD_HEADS = SSD_DIM // SSD_HEAD_DIM
SSD_GROUPS = 2
SSD_STATE = 128
SSD_CONV = 3
SSD_CHUNK = 128
SSD_CONV_DIM = SSD_DIM + 2 * SSD_GROUPS * SSD_STATE
SSD_PROJ = SSD_DIM + SSD_CONV_DIM + SSD_HEADS

AB_PROJ = RW_PROJ + SSD_PROJ
AB_OUT = RW_DIM + SSD_DIM

HG_HEADS = 8
HG_KEY_DIM = 128
HG_VAL_DIM = D_MODEL // HG_HEADS
HG_KEY_WIDTH = HG_HEADS * HG_KEY_DIM
HG_VAL_WIDTH = HG_HEADS * HG_VAL_DIM
HG_CHUNK = 64
HG_PROJ = 3 * HG_KEY_WIDTH + 2 * HG_VAL_WIDTH

XA_HEADS = 4
XA_HEAD_DIM = D_MODEL // XA_HEADS
FFN_DIM = ((8 * D_MODEL + 3 * 256 - 1) // (3 * 256)) * 256

kernel_name = "bidir_rwkv7_mamba2_hgrn2_hybrid_block"


def rms_norm(x, gain):
    xf = x.astype(jnp.float32)
    y = xf * lax.rsqrt(jnp.mean(xf * xf, axis=-1, keepdims=True) + NORM_EPS)
    return (y * gain.astype(jnp.float32)).astype(x.dtype)


def flip_time(z):
    return jnp.flip(z, axis=1)


def centred_shift(z):
    prev = jnp.pad(z[:, :-1], ((0, 0), (1, 0), (0, 0)))
    nxt = jnp.pad(z[:, 1:], ((0, 0), (0, 1), (0, 0)))
    return 0.5 * (prev + nxt)


def centred_depthwise_conv(u, w, b):
    out = lax.conv_general_dilated(
        u, w[:, None, :].astype(u.dtype), window_strides=(1,),
        padding=[(SSD_CONV // 2, SSD_CONV // 2)],
        dimension_numbers=('NWC', 'WIO', 'NWC'), feature_group_count=u.shape[-1])
    return out + b.astype(u.dtype)


def rwkv7_scan(r, w, k, v, kk, a):
    nb, _, nh, n = r.shape

    def step(state, inp):
        r_t, w_t, k_t, v_t, kk_t, a_t = inp
        sa = jnp.einsum('bhvk,bhk->bhv', state, -kk_t)
        state = (state * w_t[:, :, None, :]
                 + sa[..., None] * (kk_t * a_t)[:, :, None, :]
                 + v_t[..., None] * k_t[:, :, None, :])
        return state, jnp.einsum('bhvk,bhk->bhv', state, r_t)

    xs = tuple(jnp.moveaxis(z, 1, 0) for z in (r, w, k, v, kk, a))
    _, out = lax.scan(step, jnp.zeros((nb, nh, n, n), jnp.float32), xs)
    return jnp.moveaxis(out, 0, 1)


def rwkv7_branch(p, w0, w2, a0, a2, g2, k_k, k_a, r_k, gn_w, gn_b):
    nb, t, _ = p.shape
    o1, o2, o3 = RW_DIM, 2 * RW_DIM, 3 * RW_DIM
    o4 = o3 + RW_DECAY_RANK
    o5 = o4 + RW_A_RANK
    r, k, v = p[..., :o1], p[..., o1:o2], p[..., o2:o3]
    wd, ad, gd = p[..., o3:o4], p[..., o4:o5], p[..., o5:]

    def heads(z):
        return z.reshape(nb, t, RW_HEADS, RW_HEAD_DIM)

    a = jax.nn.sigmoid(a0 + ad @ a2)
    g = jax.nn.sigmoid(gd) @ g2
    kk = heads(k * k_k)
    kk = kk / jnp.maximum(jnp.linalg.norm(kk, axis=-1, keepdims=True), 1e-12)
    k = k * (1.0 + (a - 1.0) * k_a)
    w_lora = jnp.tanh(wd)

    def decay(d):
        w = -jax.nn.softplus(-(w0[d] + w_lora @ w2[d])) - 0.5
        return heads(jnp.exp(-jnp.exp(w)))

    rh, kh, vh, ah = heads(r), heads(k), heads(v), heads(a)
    o_fwd = rwkv7_scan(rh, decay(0), kh, vh, kk, ah)
    o_bwd = flip_time(rwkv7_scan(flip_time(rh), flip_time(decay(1)), flip_time(kh),
                                 flip_time(vh), flip_time(kk), flip_time(ah)))
    o = o_fwd + o_bwd
    mu = jnp.mean(o, axis=-1, keepdims=True)
    var = jnp.mean(jnp.square(o - mu), axis=-1, keepdims=True)
    o = (o - mu) * lax.rsqrt(var + RW_GN_EPS)
    o = o * gn_w.reshape(RW_HEADS, RW_HEAD_DIM) + gn_b.reshape(RW_HEADS, RW_HEAD_DIM)
    o = o + jnp.sum(rh * kh * r_k, axis=-1, keepdims=True) * vh
    return o.reshape(nb, t, RW_DIM) * g


def ssd_chunked(xs, dt, a, bm, cm):
    nb, t = xs.shape[0], xs.shape[1]
    nc, L = t // SSD_CHUNK, SSD_CHUNK
    J = SSD_HEADS // SSD_GROUPS
    xdt = (xs * dt[..., None]).reshape(nb, nc, L, SSD_GROUPS, J, SSD_HEAD_DIM)
    la = (dt * a).reshape(nb, nc, L, SSD_GROUPS, J).transpose(0, 3, 4, 1, 2)
    bc = bm.reshape(nb, nc, L, SSD_GROUPS, SSD_STATE)
    cc = cm.reshape(nb, nc, L, SSD_GROUPS, SSD_STATE)
    cum = jnp.cumsum(la, axis=-1)
    tri = jnp.tril(jnp.ones((L, L), bool))
    decay = jnp.exp(jnp.where(tri, cum[..., :, None] - cum[..., None, :], -jnp.inf))
    scores = jnp.einsum('bclgn,bcsgn->bgcls', cc, bc)
    y_diag = jnp.einsum('bgjcls,bcsgjp->bclgjp', scores[:, :, None] * decay, xdt)
    states = jnp.einsum('bclgn,bgjcl,bclgjp->bcgjpn', bc, jnp.exp(cum[..., -1:] - cum), xdt)
    tot = jnp.pad(cum[..., -1], ((0, 0), (0, 0), (0, 0), (1, 0)))
    ctot = jnp.cumsum(tot, axis=-1)
    tri_c = jnp.tril(jnp.ones((nc + 1, nc + 1), bool))
    decay_c = jnp.exp(jnp.where(tri_c, ctot[..., :, None] - ctot[..., None, :], -jnp.inf))
    states = jnp.concatenate([jnp.zeros_like(states[:, :1]), states], axis=1)
    carried = jnp.einsum('bgjzc,bcgjpn->bzgjpn', decay_c, states)[:, :-1]
    y_off = jnp.einsum('bclgn,bcgjpn,bgjcl->bclgjp', cc, carried, jnp.exp(cum))
    return (y_diag + y_off).reshape(nb, t, SSD_HEADS, SSD_HEAD_DIM)


def ssd_branch(p, conv_w, conv_b, dt_bias, a_log, d_skip, norm_w):
    nb, t, _ = p.shape
    gn = SSD_GROUPS * SSD_STATE
    z = p[..., :SSD_DIM].astype(jnp.float32)
    xbc = p[..., SSD_DIM:SSD_DIM + SSD_CONV_DIM]
    dt_raw = p[..., SSD_DIM + SSD_CONV_DIM:].astype(jnp.float32)
    xbc = jax.nn.silu(centred_depthwise_conv(xbc, conv_w, conv_b)).astype(jnp.float32)
    xs = xbc[..., :SSD_DIM].reshape(nb, t, SSD_HEADS, SSD_HEAD_DIM)
    bm = xbc[..., SSD_DIM:SSD_DIM + gn].reshape(nb, t, SSD_GROUPS, SSD_STATE)
    cm = xbc[..., SSD_DIM + gn:].reshape(nb, t, SSD_GROUPS, SSD_STATE)
    dt_f = jax.nn.softplus(dt_raw + dt_bias[0])
    dt_b = jax.nn.softplus(dt_raw + dt_bias[1])
    y_f = ssd_chunked(xs, dt_f, -jnp.exp(a_log[0]), bm, cm)
    y_b = flip_time(ssd_chunked(flip_time(xs), flip_time(dt_b), -jnp.exp(a_log[1]),
                                flip_time(bm), flip_time(cm)))
    y = y_f + y_b + d_skip[:, None] * xs
    y = (y.reshape(nb, t, SSD_DIM) * jax.nn.silu(z)).reshape(nb, t, SSD_GROUPS, SSD_DIM // SSD_GROUPS)
    y = y * lax.rsqrt(jnp.mean(y * y, axis=-1, keepdims=True) + NORM_EPS)
    return y.reshape(nb, t, SSD_DIM) * norm_w


def rwkv_ssd_mixer(h, w_in, w_out, rw_mu, rw_w0, rw_w2, rw_a0, rw_a2, rw_g2, rw_k_k, rw_k_a,
                   rw_r_k, rw_gn_w, rw_gn_b, ssd_conv_w, ssd_conv_b, ssd_dt_bias, ssd_a_log,
                   ssd_d, ssd_norm_w):
    p = h @ w_in
    p_rw = p[..., :RW_PROJ].astype(jnp.float32)
    p_rw = p_rw + rw_mu * (centred_shift(p_rw) - p_rw)
    o_rw = rwkv7_branch(p_rw, rw_w0, rw_w2, rw_a0, rw_a2, rw_g2, rw_k_k, rw_k_a, rw_r_k,
                        rw_gn_w, rw_gn_b)
    o_ssd = ssd_branch(p[..., RW_PROJ:], ssd_conv_w, ssd_conv_b, ssd_dt_bias, ssd_a_log,
                       ssd_d, ssd_norm_w)
    o = jnp.concatenate([o_rw, o_ssd], axis=-1).astype(h.dtype)
    return o @ w_out


def gla_chunked(q, k, v, log_f):
    nb, t, nh, dk = q.shape
    dv = v.shape[-1]
    nc, L = t // HG_CHUNK, HG_CHUNK

    def to_chunks(z):
        return z.reshape(nb, nc, L, nh, z.shape[-1]).transpose(1, 0, 3, 2, 4)

    tri = jnp.tril(jnp.ones((L, L), bool))[..., None]

    def step(state, inp):
        qc, kc, vc, gc = inp
        bcum = jnp.cumsum(gc, axis=2)
        decay = jnp.exp(jnp.where(tri, bcum[:, :, :, None, :] - bcum[:, :, None, :, :], -jnp.inf))
        attn = jnp.einsum('bhld,bhlsd,bhsd->bhls', qc, decay, kc)
        out = (jnp.einsum('bhls,bhsv->bhlv', attn, vc)
               + jnp.einsum('bhld,bhdv->bhlv', qc * jnp.exp(bcum), state))
        last = bcum[:, :, -1:, :]
        state = (state * jnp.exp(bcum[:, :, -1, :])[..., None]
                 + jnp.einsum('bhsd,bhsv->bhdv', kc * jnp.exp(last - bcum), vc))
        return state, out

    xs = (to_chunks(q), to_chunks(k), to_chunks(v), to_chunks(log_f))
    _, out = lax.scan(step, jnp.zeros((nb, nh, dk, dv), jnp.float32), xs)
    return out.transpose(1, 0, 3, 2, 4).reshape(nb, t, nh, dv)


def hgrn2_mixer(h, w_in, w_out, norm_w, lb):
    nb, t, _ = h.shape
    kw, vw = HG_KEY_WIDTH, HG_VAL_WIDTH
    p = (h @ w_in).astype(jnp.float32)
    q, f_fwd, f_bwd = p[..., :kw], p[..., kw:2 * kw], p[..., 2 * kw:3 * kw]
    i, g = p[..., 3 * kw:3 * kw + vw], p[..., 3 * kw + vw:]

    def kheads(z):
        return z.reshape(nb, t, HG_HEADS, HG_KEY_DIM)

    def gates(f_raw):
        f = lb + (1.0 - lb) * jax.nn.sigmoid(f_raw)
        return kheads(1.0 - f), kheads(jnp.log(f))

    k_f, lf_f = gates(f_fwd)
    k_b, lf_b = gates(f_bwd)
    qh = kheads(q)
    ih = i.reshape(nb, t, HG_HEADS, HG_VAL_DIM)
    o = (gla_chunked(qh, k_f, ih, lf_f)
         + flip_time(gla_chunked(flip_time(qh), flip_time(k_b), flip_time(ih), flip_time(lf_b))))
    o = o * lax.rsqrt(jnp.mean(o * o, axis=-1, keepdims=True) + NORM_EPS)
    o = o * norm_w.reshape(HG_HEADS, HG_VAL_DIM)
    o = o.reshape(nb, t, vw) * jax.nn.silu(g)
    return o.astype(h.dtype) @ w_out


def memory_cross_attention(h, m, wq, wkv, wo):
    nb, t, _ = h.shape
    nm = m.shape[1]
    q = (h @ wq).reshape(nb, t, XA_HEADS, XA_HEAD_DIM)
    kv = m @ wkv
    k = kv[..., :D_MODEL].reshape(nb, nm, XA_HEADS, XA_HEAD_DIM)
    v = kv[..., D_MODEL:].reshape(nb, nm, XA_HEADS, XA_HEAD_DIM)
    s = jnp.einsum('bthd,bmhd->bhtm', q, k).astype(jnp.float32) * (XA_HEAD_DIM ** -0.5)
    pr = jax.nn.softmax(s, axis=-1).astype(v.dtype)
    o = jnp.einsum('bhtm,bmhd->bthd', pr, v).reshape(nb, t, D_MODEL)
    return o @ wo


def swiglu_ffn(h, w_in, w_out):
    gu = h @ w_in
    return (jax.nn.silu(gu[..., :FFN_DIM]) * gu[..., FFN_DIM:]) @ w_out


def setup_inputs(seed: int = 0) -> dict:
    key = jax.random.key(seed)
    ks = jax.random.split(key, 40)
    f32 = jnp.float32

    def nrm(k, shape, scale):
        return scale * jax.random.normal(k, shape, f32)

    def gain(k, shape):
        return 1.0 + 0.01 * jax.random.normal(k, shape, f32)

    dt0 = jnp.exp(jax.random.uniform(ks[17], (N_EVEN, 2, SSD_HEADS), f32,
                                     minval=math.log(1e-3), maxval=math.log(1e-1)))
    return {
        "x": nrm(ks[0], (BATCH, SEQ, D_MODEL), 1.0),
        "mem": nrm(ks[1], (BATCH, MEM_LEN, D_MODEL), 1.0),
        "mix_norm": gain(ks[2], (DEPTH, D_MODEL)),
        "ab_w_in": nrm(ks[3], (N_EVEN, D_MODEL, AB_PROJ), D_MODEL ** -0.5),
        "ab_w_out": nrm(ks[4], (N_EVEN, AB_OUT, D_MODEL), AB_OUT ** -0.5),
        "rw_mu": jax.random.uniform(ks[5], (N_EVEN, RW_PROJ), f32),
        "rw_w0": jax.random.uniform(ks[6], (N_EVEN, 2, RW_DIM), f32, minval=-6.5, maxval=-1.5),
        "rw_w2": nrm(ks[7], (N_EVEN, 2, RW_DECAY_RANK, RW_DIM), 0.1 * RW_DECAY_RANK ** -0.5),
        "rw_a0": nrm(ks[8], (N_EVEN, RW_DIM), 0.1),
        "rw_a2": nrm(ks[9], (N_EVEN, RW_A_RANK, RW_DIM), RW_A_RANK ** -0.5),
        "rw_g2": nrm(ks[10], (N_EVEN, RW_GATE_RANK, RW_DIM), RW_GATE_RANK ** -0.5),
        "rw_k_k": 0.85 + nrm(ks[11], (N_EVEN, RW_DIM), 0.05),
        "rw_k_a": 1.0 + nrm(ks[12], (N_EVEN, RW_DIM), 0.05),
        "rw_r_k": nrm(ks[13], (N_EVEN, RW_HEADS, RW_HEAD_DIM), 0.1),
        "rw_gn_w": gain(ks[14], (N_EVEN, RW_DIM)),
        "rw_gn_b": nrm(ks[15], (N_EVEN, RW_DIM), 0.01),
        "ssd_conv_w": nrm(ks[16], (N_EVEN, SSD_CONV, SSD_CONV_DIM), SSD_CONV ** -0.5),
        "ssd_conv_b": nrm(ks[18], (N_EVEN, SSD_CONV_DIM), 0.01),
        "ssd_dt_bias": dt0 + jnp.log(-jnp.expm1(-dt0)),
        "ssd_a_log": jnp.log(jax.random.uniform(ks[19], (N_EVEN, 2, SSD_HEADS), f32, minval=1.0, maxval=16.0)),
        "ssd_d": 1.0 + nrm(ks[20], (N_EVEN, SSD_HEADS), 0.1),
        "ssd_norm_w": gain(ks[21], (N_EVEN, SSD_DIM)),
        "hg_w_in": nrm(ks[22], (N_ODD, D_MODEL, HG_PROJ), D_MODEL ** -0.5),
        "hg_w_out": nrm(ks[23], (N_ODD, HG_VAL_WIDTH, D_MODEL), HG_VAL_WIDTH ** -0.5),
        "hg_norm_w": gain(ks[24], (N_ODD, HG_VAL_WIDTH)),
        "hg_lb": nrm(ks[25], (DEPTH, HG_KEY_WIDTH), 0.1),
        "xa_norm": gain(ks[26], (DEPTH, D_MODEL)),
        "mem_norm": gain(ks[27], (DEPTH, D_MODEL)),
        "xa_wq": nrm(ks[28], (DEPTH, D_MODEL, D_MODEL), D_MODEL ** -0.5),
        "xa_wkv": nrm(ks[29], (DEPTH, D_MODEL, 2 * D_MODEL), D_MODEL ** -0.5),
        "xa_wo": nrm(ks[30], (DEPTH, D_MODEL, D_MODEL), D_MODEL ** -0.5),
        "ffn_norm": gain(ks[31], (DEPTH, D_MODEL)),
        "ffn_w_in": nrm(ks[32], (DEPTH, D_MODEL, 2 * FFN_DIM), D_MODEL ** -0.5),
        "ffn_w_out": nrm(ks[33], (DEPTH, FFN_DIM, D_MODEL), FFN_DIM ** -0.5),
        "final_norm": gain(ks[34], (D_MODEL,)),
    }


def reference(x, mem, mix_norm, ab_w_in, ab_w_out, rw_mu, rw_w0, rw_w2, rw_a0, rw_a2, rw_g2,
              rw_k_k, rw_k_a, rw_r_k, rw_gn_w, rw_gn_b, ssd_conv_w, ssd_conv_b, ssd_dt_bias,
              ssd_a_log, ssd_d, ssd_norm_w, hg_w_in, hg_w_out, hg_norm_w, hg_lb, xa_norm,
              mem_norm, xa_wq, xa_wkv, xa_wo, ffn_norm, ffn_w_in, ffn_w_out, final_norm):
    lb_all = jax.nn.softmax(hg_lb.astype(jnp.float32), axis=0)
    lb_all = jnp.cumsum(lb_all, axis=0) - lb_all[0]
    for layer in range(DEPTH):
        h = rms_norm(x, mix_norm[layer])
        if layer % 2 == 0:
            e = layer // 2
            mixed = rwkv_ssd_mixer(h, ab_w_in[e], ab_w_out[e], rw_mu[e], rw_w0[e], rw_w2[e],
                                   rw_a0[e], rw_a2[e], rw_g2[e], rw_k_k[e], rw_k_a[e], rw_r_k[e],
                                   rw_gn_w[e], rw_gn_b[e], ssd_conv_w[e], ssd_conv_b[e],
                                   ssd_dt_bias[e], ssd_a_log[e], ssd_d[e], ssd_norm_w[e])
        else:
            o = layer // 2
            mixed = hgrn2_mixer(h, hg_w_in[o], hg_w_out[o], hg_norm_w[o], lb_all[layer])
        x = x + mixed
        x = x + memory_cross_attention(rms_norm(x, xa_norm[layer]), rms_norm(mem, mem_norm[layer]),
                                       xa_wq[layer], xa_wkv[layer], xa_wo[layer])
        x = x + swiglu_ffn(rms_norm(x, ffn_norm[layer]), ffn_w_in[layer], ffn_w_out[layer])
    return rms_norm(x, final_norm)
```

```cpp
#include <hip/hip_runtime.h>
#include <hip/hip_cooperative_groups.h>
#include <cstdio>
#include <cstdint>
namespace cg = cooperative_groups;

#ifndef MK_COOP
#define MK_COOP 1
#endif

#define LAS __attribute__((address_space(3)))
typedef unsigned short bf16_t;
typedef short bf16x8 __attribute__((ext_vector_type(8)));
typedef float f32x4 __attribute__((ext_vector_type(4)));
typedef float f32x2 __attribute__((ext_vector_type(2)));
typedef unsigned u32x4 __attribute__((ext_vector_type(4)));
typedef unsigned u32x2 __attribute__((ext_vector_type(2)));

constexpr int NB = 16, SEQ = 4096, T = NB * SEQ, D = 1024;
constexpr int ABPAD = 3584, ABP = 3336;
constexpr int HGP = 5120;
constexpr int FFN = 2816;
constexpr int NPHASE = 28;

constexpr size_t MiB = 1u << 20;
constexpr size_t WS_WAB = 1 * MiB, WS_WABO = 8 * MiB, WS_WHG = 10 * MiB, WS_WHGO = 20 * MiB, WS_WQ = 22 * MiB, WS_WKV = 26 * MiB, WS_WO = 34 * MiB,
                 WS_WF1 = 38 * MiB, WS_WF2 = 60 * MiB, WS_G2T = 71 * MiB, WS_MEMN = 72 * MiB, WS_KMEM = 88 * MiB, WS_VT = 104 * MiB,
                 WS_H = 128 * MiB, WS_P = 256 * MiB, WS_PATT = 384 * MiB, WS_OMIX0 = 704 * MiB, WS_END = 832 * MiB;
constexpr size_t DO_STATES = 0, DO_G = 128 * MiB, DO_SG = 192 * MiB, DO_BONUS = 208 * MiB, DO_TOT = 210 * MiB;

constexpr int LDS_BYTES = 151552;
constexpr int XLDS_OFF = 131072;

__device__ __forceinline__ unsigned f2bf(float f) { unsigned u = __builtin_bit_cast(unsigned, f); return (u + 0x7fffu + ((u >> 16) & 1u)) >> 16; }
__device__ __forceinline__ unsigned pk2(float lo, float hi) { return f2bf(lo) | (f2bf(hi) << 16); }
__device__ __forceinline__ float bf2f(unsigned short b) { return __builtin_bit_cast(float, (unsigned)b << 16); }
__device__ __forceinline__ float bflo(unsigned u) { return __builtin_bit_cast(float, u << 16); }
__device__ __forceinline__ float bfhi(unsigned u) { return __builtin_bit_cast(float, u & 0xffff0000u); }
__device__ __forceinline__ float sigmoidf_(float x) { return 1.0f / (1.0f + __expf(-x)); }
__device__ __forceinline__ float wave_sum(float v) {
#pragma unroll
    for (int o = 1; o < 64; o <<= 1) v += __shfl_xor(v, o);
    return v;
}
template <int CTRL> __device__ __forceinline__ float dppf(float x) { return __builtin_bit_cast(float, __builtin_amdgcn_mov_dpp(__builtin_bit_cast(int, x), CTRL, 0xf, 0xf, true)); }
__device__ __forceinline__ float sum8(float v) { v += dppf<0xB1>(v); v += dppf<0x4E>(v); v += dppf<0x141>(v); return v; }
#define LDS_WAIT() asm volatile("s_waitcnt lgkmcnt(0)" ::: "memory")

namespace pg8 {
constexpr int BM = 256, BK = 64, HALF = 128, HTB = HALF * BK * 2, STAGE_BYTES = 8 * HTB, NXCD = 8, WGM = 8;
__host__ __device__ __forceinline__ int lds_byte(int r, int c) { const int st = (r >> 4) * 2 + (c >> 5), rr = r & 15, cc = c & 31, ob = rr * 64 + cc * 2; return st * 1024 + (ob ^ (((ob >> 9) & 1) << 5)); }
__host__ __device__ __forceinline__ void stage_rc(int b, int& R, int& C) { const int st = b / 1024, sb = b % 1024, swz = sb ^ (((sb >> 9) & 1) << 5); R = (st >> 1) * 16 + swz / 64; C = (st & 1) * 32 + (swz % 64) / 2; }
__host__ __device__ __forceinline__ int perm32(int rho) { const int n = rho >> 4, i = rho & 15; return 8 * (i >> 2) + 4 * n + (i & 3); }

struct Unit { int pm, pn, z; };
struct Gemm {
    const bf16_t* A; const bf16_t* Bt; int lda, ldb, K, nM, nN, nZ, zdiv; long sAo, sAi, sBo, sBi, sCo, sCi;
    __device__ __forceinline__ long offA(const Unit& u) const { return (long)(u.z / zdiv) * sAo + (long)(u.z % zdiv) * sAi + (long)u.pm * BM * lda; }
    __device__ __forceinline__ long offB(const Unit& u) const { return (long)(u.z / zdiv) * sBo + (long)(u.z % zdiv) * sBi + (long)u.pn * BM * ldb; }
    __device__ __forceinline__ long offC(const Unit& u) const { return (long)(u.z / zdiv) * sCo + (long)(u.z % zdiv) * sCi; }
};
__device__ __forceinline__ Gemm make_gemm(const bf16_t* A, const bf16_t* Bt, int M, int N, int K, int lda, int ldb) {
    Gemm g; g.A = A; g.Bt = Bt; g.lda = lda; g.ldb = ldb; g.K = K; g.nM = M / BM; g.nN = N / BM; g.nZ = 1; g.zdiv = 1; g.sAo = g.sAi = g.sBo = g.sBi = g.sCo = g.sCi = 0; return g;
}
struct Order {
    int nM, nN, nwg, total, G, c;
    __device__ __forceinline__ void init(const Gemm& g, int G_, int c_) { nM = g.nM; nN = g.nN; nwg = nM * nN; total = nwg * g.nZ; G = G_; c = c_; }
    __device__ __forceinline__ bool next(int i, Unit& u) const {
        const long L = (long)i * G + c; if (L >= total) return false;
        u.z = (int)(L / nwg); int wgid = (int)(L % nwg);
        { const int q = nwg / NXCD, r = nwg % NXCD, xcd = wgid % NXCD, off = wgid / NXCD; wgid = (xcd < r ? xcd * (q + 1) : r * (q + 1) + (xcd - r) * q) + off; }
        const int nig = WGM * nN, gid = wgid / nig, fm = gid * WGM, gsz = (nM - fm) < WGM ? (nM - fm) : WGM;
        u.pm = fm + ((wgid % nig) % gsz); u.pn = (wgid % nig) / gsz; return true;
    }
};

__device__ __forceinline__ unsigned cvt_pk_bf16(float lo, float hi) { unsigned r; asm volatile("v_cvt_pk_bf16_f32 %0, %1, %2" : "=v"(r) : "v"(lo), "v"(hi)); return r; }

struct EpiBf16 {
    static constexpr bool PERM = true;
    bf16_t* O; int ldc; float scale;
    __device__ __forceinline__ void operator()(const f32x4 (&acc)[2][2][4][2], const Unit& u, long coff, int wr, int wc, int fr, int fq, LAS unsigned char* xl) const {
        const int row0 = u.pm * BM + wr * 64 + fr, col0 = u.pn * BM + wc * 32 + 8 * fq; bf16_t* base = O + coff;
#pragma unroll
        for (int ai = 0; ai < 2; ++ai)
#pragma unroll
            for (int m = 0; m < 4; ++m) { bf16_t* rowp = base + (size_t)(row0 + ai * HALF + m * 16) * ldc + col0;
#pragma unroll
                for (int bj = 0; bj < 2; ++bj) { const f32x4 v0 = acc[ai][bj][m][0] * scale, v1 = acc[ai][bj][m][1] * scale;
                    u32x4 w; w.x = cvt_pk_bf16(v0[0], v0[1]); w.y = cvt_pk_bf16(v0[2], v0[3]); w.z = cvt_pk_bf16(v1[0], v1[1]); w.w = cvt_pk_bf16(v1[2], v1[3]);
                    *(u32x4*)(rowp + bj * HALF) = w; } }
    }
};
struct EpiResid {
    static constexpr bool PERM = false;
    const float* base; float* out; int ldc;
    __device__ __forceinline__ void operator()(const f32x4 (&acc)[2][2][4][2], const Unit& u, long coff, int wr, int wc, int fr, int fq, LAS unsigned char* xl) const {
        const int col0 = u.pn * BM + wc * 32 + 4 * fq;
#pragma unroll
        for (int ai = 0; ai < 2; ++ai)
#pragma unroll
            for (int m = 0; m < 4; ++m) { const size_t off = (size_t)(u.pm * BM + ai * HALF + wr * 64 + m * 16 + fr) * ldc + col0;
#pragma unroll
                for (int bj = 0; bj < 2; ++bj)
#pragma unroll
                    for (int n = 0; n < 2; ++n) { const f32x4 bs = *(const f32x4*)(base + off + bj * HALF + n * 16); *(f32x4*)(out + off + bj * HALF + n * 16) = bs + acc[ai][bj][m][n]; } }
    }
};
struct EpiSwiglu {
    static constexpr bool PERM = true;
    bf16_t* O; int ldc;
    __device__ __forceinline__ void operator()(const f32x4 (&acc)[2][2][4][2], const Unit& u, long coff, int wr, int wc, int fr, int fq, LAS unsigned char* xl) const {
        const int row0 = u.pm * BM + wr * 64 + fr, col0 = u.pn * HALF + wc * 32 + 8 * fq;
#pragma unroll
        for (int ai = 0; ai < 2; ++ai)
#pragma unroll
            for (int m = 0; m < 4; ++m) { bf16_t* rowp = O + (size_t)(row0 + ai * HALF + m * 16) * ldc + col0; float r[8];
#pragma unroll
                for (int n = 0; n < 2; ++n)
#pragma unroll
                    for (int i = 0; i < 4; ++i) { const float g = acc[ai][0][m][n][i], uu = acc[ai][1][m][n][i]; r[n * 4 + i] = g / (1.0f + __expf(-g)) * uu; }
                u32x4 w; w.x = cvt_pk_bf16(r[0], r[1]); w.y = cvt_pk_bf16(r[2], r[3]); w.z = cvt_pk_bf16(r[4], r[5]); w.w = cvt_pk_bf16(r[6], r[7]);
                *(u32x4*)rowp = w; }
    }
};
struct EpiSoftmax {
    static constexpr bool PERM = true;
    bf16_t* O; int ldc;
    __device__ __forceinline__ void operator()(f32x4 (&acc)[2][2][4][2], const Unit& u, long coff, int wr, int wc, int fr, int fq, LAS unsigned char* xl) const {
        LAS float* XM = (LAS float*)xl; LAS float* XS = (LAS float*)(xl + 4096);
#pragma unroll
        for (int ai = 0; ai < 2; ++ai)
#pragma unroll
            for (int m = 0; m < 4; ++m) { float mx = -3.0e38f;
#pragma unroll
                for (int bj = 0; bj < 2; ++bj)
#pragma unroll
                    for (int n = 0; n < 2; ++n)
#pragma unroll
                        for (int i = 0; i < 4; ++i) mx = fmaxf(mx, acc[ai][bj][m][n][i]);
                mx = fmaxf(mx, __shfl_xor(mx, 16)); mx = fmaxf(mx, __shfl_xor(mx, 32));
                if (fq == 0) XM[(ai * HALF + wr * 64 + m * 16 + fr) * 4 + wc] = mx; }
        LDS_WAIT(); __builtin_amdgcn_s_barrier(); asm volatile("" ::: "memory");
#pragma unroll
        for (int ai = 0; ai < 2; ++ai)
#pragma unroll
            for (int m = 0; m < 4; ++m) { const f32x4 mm = *(const LAS f32x4*)(XM + (ai * HALF + wr * 64 + m * 16 + fr) * 4);
                const float mx = fmaxf(fmaxf(mm[0], mm[1]), fmaxf(mm[2], mm[3])); float s = 0.f;
#pragma unroll
                for (int bj = 0; bj < 2; ++bj)
#pragma unroll
                    for (int n = 0; n < 2; ++n)
#pragma unroll
                        for (int i = 0; i < 4; ++i) { const float e = __expf(acc[ai][bj][m][n][i] - mx); acc[ai][bj][m][n][i] = e; s += e; }
                s += __shfl_xor(s, 16); s += __shfl_xor(s, 32);
                if (fq == 0) XS[(ai * HALF + wr * 64 + m * 16 + fr) * 4 + wc] = s; }
        LDS_WAIT(); __builtin_amdgcn_s_barrier(); asm volatile("" ::: "memory");
        const int row0 = u.pm * BM + wr * 64 + fr, col0 = wc * 32 + 8 * fq; bf16_t* base = O + coff;
#pragma unroll
        for (int ai = 0; ai < 2; ++ai)
#pragma unroll
            for (int m = 0; m < 4; ++m) { const f32x4 ss = *(const LAS f32x4*)(XS + (ai * HALF + wr * 64 + m * 16 + fr) * 4);
                const float inv = 1.0f / ((ss[0] + ss[1]) + (ss[2] + ss[3])); bf16_t* rowp = base + (size_t)(row0 + ai * HALF + m * 16) * ldc + col0;
#pragma unroll
                for (int bj = 0; bj < 2; ++bj) { const f32x4 v0 = acc[ai][bj][m][0] * inv, v1 = acc[ai][bj][m][1] * inv;
                    u32x4 w; w.x = cvt_pk_bf16(v0[0], v0[1]); w.y = cvt_pk_bf16(v0[2], v0[3]); w.z = cvt_pk_bf16(v1[0], v1[1]); w.w = cvt_pk_bf16(v1[2], v1[3]);
                    *(u32x4*)(rowp + bj * HALF) = w; } }
    }
};

template <class Epi, bool ALIGN_EPI>
__device__ __forceinline__ void gemm_phase(LAS unsigned char* lds, LAS unsigned char* xl, const Gemm g, const Order& S, Epi& E) {
    const int tid = threadIdx.x, wid = __builtin_amdgcn_readfirstlane(tid >> 6), lane = tid & 63, wr = wid >> 2, wc = wid & 3, fr = lane & 15, fq = lane >> 4;
    const int K = g.K, nt = K / BK;
    unsigned voffA[2], voffB[2];
#pragma unroll
    for (int i = 0; i < 2; ++i) { int R, C; stage_rc(tid * 16 + i * 8192, R, C); const int Rb = Epi::PERM ? ((R & ~31) + perm32(R & 31)) : R;
        voffA[i] = (unsigned)(R * g.lda + C) * 2u; voffB[i] = (unsigned)(Rb * g.ldb + C) * 2u; }
    const size_t kstep = (size_t)(BK * 2);
    const size_t hstepA = (size_t)HALF * g.lda * 2, hstepB = (size_t)HALF * g.ldb * 2;
    const unsigned ldsw = (unsigned)wid * 1024u;
    const int aoff = lds_byte(wr * 64 + fr, fq * 8), boff = lds_byte(wc * 32 + fr, fq * 8);
#define PG8_SA(b, h) (((b) * 2 + (h)) * HTB)
#define PG8_SB(b, h) ((4 + (b) * 2 + (h)) * HTB)
#define PG8_STAGE(bufoff, gbase, voff) do { _Pragma("unroll") for (int _i = 0; _i < 2; ++_i) \
        __builtin_amdgcn_global_load_lds((const unsigned*)((const char*)(gbase) + (voff)[_i]), (LAS unsigned*)(lds + (bufoff) + ldsw + _i * 8192), 16, 0, 0); } while (0)
#define PG8_LDA(dst, b, h) do { _Pragma("unroll") for (int m = 0; m < 4; ++m) _Pragma("unroll") for (int k = 0; k < 2; ++k) dst[m][k] = *(const LAS bf16x8*)(lds + PG8_SA(b, h) + aoff + m * 2048 + k * 1024); } while (0)
#define PG8_LDB(dst, b, h) do { _Pragma("unroll") for (int n = 0; n < 2; ++n) _Pragma("unroll") for (int k = 0; k < 2; ++k) dst[n][k] = *(const LAS bf16x8*)(lds + PG8_SB(b, h) + boff + n * 2048 + k * 1024); } while (0)
#define PG8_MMA(ai, bj, At, Bt) do { __builtin_amdgcn_s_setprio(1); _Pragma("unroll") for (int m = 0; m < 4; ++m) _Pragma("unroll") for (int n = 0; n < 2; ++n) _Pragma("unroll") for (int k = 0; k < 2; ++k) \
        acc[ai][bj][m][n] = __builtin_amdgcn_mfma_f32_16x16x32_bf16(Bt[n][k], At[m][k], acc[ai][bj][m][n], 0, 0, 0); __builtin_amdgcn_s_setprio(0); } while (0)
#define PG8_WAIT_V(n) asm volatile("s_waitcnt vmcnt(" #n ")" ::: "memory")
#define PG8_WAIT_L(n) asm volatile("s_waitcnt lgkmcnt(" #n ")" ::: "memory")
#define PG8_BAR __builtin_amdgcn_s_barrier()
#define PG8_SCHED __builtin_amdgcn_sched_barrier(0)
    Unit cur, nxt; int ui = 0;
    if (!S.next(0, cur)) return;
    f32x4 acc[2][2][4][2];
#pragma unroll
    for (int a = 0; a < 2; ++a)
#pragma unroll
        for (int b = 0; b < 2; ++b)
#pragma unroll
            for (int m = 0; m < 4; ++m)
#pragma unroll
                for (int n = 0; n < 2; ++n) acc[a][b][m][n] = (f32x4){0.f, 0.f, 0.f, 0.f};
    bf16x8 At[4][2], B0[2][2], B1[2][2];
    const char* cA = (const char*)g.A + 2 * g.offA(cur); const char* cB = (const char*)g.Bt + 2 * g.offB(cur);
    PG8_STAGE(PG8_SB(0, 0), cB, voffB); PG8_STAGE(PG8_SB(0, 1), cB + hstepB, voffB); PG8_STAGE(PG8_SA(0, 0), cA, voffA); PG8_STAGE(PG8_SA(0, 1), cA + hstepA, voffA);
    if (wr == 1) PG8_BAR;
    PG8_WAIT_V(2); PG8_BAR;
    PG8_STAGE(PG8_SB(1, 0), cB + kstep, voffB); PG8_STAGE(PG8_SA(1, 0), cA + kstep, voffA); PG8_STAGE(PG8_SB(1, 1), cB + hstepB + kstep, voffB);
    PG8_WAIT_V(6); PG8_BAR;
    for (;;) {
        const bool has_next = S.next(ui + 1, nxt);
        const char* nA = has_next ? (const char*)g.A + 2 * g.offA(nxt) : cA; const char* nB = has_next ? (const char*)g.Bt + 2 * g.offB(nxt) : cB;
        for (int t = 0; t < nt; t += 2) {
            const bool last = (t == nt - 2);
            const char* a1 = cA + (size_t)(t + 1) * kstep;
            const char* a2 = last ? nA : cA + (size_t)(t + 2) * kstep; const char* b2 = last ? nB : cB + (size_t)(t + 2) * kstep;
            const char* a3 = a2 + kstep; const char* b3 = b2 + kstep;
            PG8_LDB(B0, 0, 0); PG8_LDB(B1, 0, 1); PG8_SCHED; PG8_LDA(At, 0, 0); PG8_STAGE(PG8_SA(1, 1), a1 + hstepA, voffA);
            PG8_WAIT_V(8); PG8_WAIT_L(0); PG8_BAR; PG8_MMA(0, 0, At, B0); PG8_MMA(0, 1, At, B1); PG8_BAR; PG8_SCHED;
            PG8_LDA(At, 0, 1); PG8_STAGE(PG8_SB(0, 0), b2, voffB); PG8_STAGE(PG8_SB(0, 1), b2 + hstepB, voffB); PG8_STAGE(PG8_SA(0, 0), a2, voffA);
            PG8_WAIT_V(8); PG8_WAIT_L(0); PG8_BAR; PG8_MMA(1, 0, At, B0); PG8_MMA(1, 1, At, B1); PG8_BAR; PG8_SCHED;
            PG8_LDB(B0, 1, 0); PG8_LDB(B1, 1, 1); PG8_SCHED; PG8_LDA(At, 1, 0); PG8_STAGE(PG8_SA(0, 1), a2 + hstepA, voffA);
            PG8_WAIT_V(8); PG8_WAIT_L(0); PG8_BAR; PG8_MMA(0, 0, At, B0); PG8_MMA(0, 1, At, B1); PG8_BAR; PG8_SCHED;
            PG8_LDA(At, 1, 1); PG8_STAGE(PG8_SB(1, 0), b3, voffB); PG8_STAGE(PG8_SB(1, 1), b3 + hstepB, voffB); PG8_STAGE(PG8_SA(1, 0), a3, voffA);
            PG8_WAIT_V(8); PG8_WAIT_L(0); PG8_BAR; PG8_MMA(1, 0, At, B0); PG8_MMA(1, 1, At, B1); PG8_BAR; PG8_SCHED;
        }
        if constexpr (ALIGN_EPI) { if (wr == 0) PG8_BAR; }
        E(acc, cur, g.offC(cur), wr, wc, fr, fq, xl);
        if (!has_next) break;
#pragma unroll
        for (int a = 0; a < 2; ++a)
#pragma unroll
            for (int b = 0; b < 2; ++b)
#pragma unroll
                for (int m = 0; m < 4; ++m)
#pragma unroll
                    for (int n = 0; n < 2; ++n) acc[a][b][m][n] = (f32x4){0.f, 0.f, 0.f, 0.f};
        cur = nxt; cA = nA; cB = nB; ++ui;
        if constexpr (ALIGN_EPI) { if (wr == 1) PG8_BAR; }
    }
    PG8_WAIT_V(0);
    if constexpr (!ALIGN_EPI) { if (wr == 0) PG8_BAR; }
    PG8_BAR;
#undef PG8_SA
#undef PG8_SB
#undef PG8_STAGE
#undef PG8_LDA
#undef PG8_LDB
#undef PG8_MMA
#undef PG8_WAIT_V
#undef PG8_WAIT_L
#undef PG8_BAR
#undef PG8_SCHED
}
}

__device__ __forceinline__ f32x4 mfma16(bf16x8 bfrag, bf16x8 afrag, f32x4 acc) { return __builtin_amdgcn_mfma_f32_16x16x32_bf16(bfrag, afrag, acc, 0, 0, 0); }
__device__ __forceinline__ bf16x8 ldsfrag(const LAS bf16_t* base, int ld, int r0, int k0, int fr, int fq) { return *(const LAS bf16x8*)(base + (r0 + fr) * ld + k0 + fq * 8); }

template <int MODE> __device__ __forceinline__ void transpose_item(const float* W, int K, int N, bf16_t* WT, LAS float* scr, int item, int nblk, int lane) {
    const int kb = item / nblk, nb = item % nblk, k0 = 64 * kb, n0 = 32 * nb; const int nsrc = n0 + (lane & 31);
#pragma unroll 8
    for (int i = 0; i < 32; ++i) { const int kk = 2 * i + (lane >> 5); scr[kk * 33 + (lane & 31)] = (nsrc < N) ? W[(size_t)(k0 + kk) * N + nsrc] : 0.f; }
    LDS_WAIT();
    const int c = lane & 7;
#pragma unroll
    for (int j = 0; j < 4; ++j) { const int n = (lane >> 3) + 8 * j; const LAS float* s = scr + (8 * c) * 33 + n;
        u32x4 o; o.x = pk2(s[0 * 33], s[1 * 33]); o.y = pk2(s[2 * 33], s[3 * 33]); o.z = pk2(s[4 * 33], s[5 * 33]); o.w = pk2(s[6 * 33], s[7 * 33]);
        int drow = n0 + n; if (MODE == 1) { const int jn = drow % FFN, isu = drow / FFN; drow = (jn / 128) * 256 + isu * 128 + (jn % 128); }
        *(u32x4*)(WT + (size_t)drow * K + k0 + 8 * c) = o; }
    LDS_WAIT();
}
__device__ __forceinline__ void rms_row_bf16(const float* xrow, const float* gain, bf16_t* orow, int lane) {
    const f32x4* xr = (const f32x4*)xrow + lane; f32x4 v[4]; float s = 0.f;
#pragma unroll
    for (int j = 0; j < 4; ++j) { v[j] = xr[64 * j]; s += (v[j].x * v[j].x + v[j].y * v[j].y) + (v[j].z * v[j].z + v[j].w * v[j].w); }
    const float rs = rsqrtf(wave_sum(s) * (1.f / D) + 1e-6f);
    const f32x4* gr = (const f32x4*)gain + lane; u32x2* o8 = (u32x2*)orow + lane;
#pragma unroll
    for (int j = 0; j < 4; ++j) { const f32x4 g = gr[64 * j]; u32x2 w; w.x = pk2(v[j].x * rs * g.x, v[j].y * rs * g.y); w.y = pk2(v[j].z * rs * g.z, v[j].w * rs * g.w); o8[64 * j] = w; }
}
__device__ __forceinline__ void rms_rows_phase(const float* X, const float* gain, bf16_t* H, int nrows, int gw, int NGW, int lane) {
    for (int m = gw; m < nrows; m += NGW) rms_row_bf16(X + (size_t)m * D, gain, H + (size_t)m * D, lane);
}

__device__ __forceinline__ void rwkv_chain(LAS unsigned char* lds, int cid, const bf16_t* P0, const float* mu, const float* w0, const float* w2, const float* a0, const float* a2,
                                           const float* k_k, const float* k_a, const float* r_k, bf16_t* ORW, bf16_t* SG, float* BONUS) {
    const int tid = threadIdx.x, lane = tid & 63, wid = tid >> 6, fr = lane & 15, fq = lane >> 4;
    const int b = cid >> 4, h = (cid >> 1) & 7, dir = cid & 1;
    LAS float* rS = (LAS float*)(lds); LAS float* kS = (LAS float*)(lds + 8192); LAS float* vS = (LAS float*)(lds + 16384); LAS float* wS = (LAS float*)(lds + 24576);
    LAS float* nkS = (LAS float*)(lds + 32768); LAS float* bS = (LAS float*)(lds + 40960); LAS float* preA = (LAS float*)(lds + 49152); LAS float* preW = (LAS float*)(lds + 57344);
    LAS float* oS = (LAS float*)(lds + 65536); LAS bf16_t* adB = (LAS bf16_t*)(lds + 73728); LAS bf16_t* wdB = (LAS bf16_t*)(lds + 78336);
    LAS bf16_t* a2B = (LAS bf16_t*)(lds + 82944); LAS bf16_t* w2B = (LAS bf16_t*)(lds + 92160); LAS float* cst = (LAS float*)(lds + 101376);
    __syncthreads();
    for (int e = tid; e < 64 * 64; e += 512) { const int j = e & 63, r = e >> 6;
        a2B[j * 72 + r] = (bf16_t)f2bf(a2[r * 512 + h * 64 + j]); w2B[j * 72 + r] = (bf16_t)f2bf(w2[(dir * 64 + r) * 512 + h * 64 + j]); }
    if (tid < 64) { const int j = tid, c = h * 64 + j;
        cst[0 * 64 + j] = a0[c]; cst[1 * 64 + j] = w0[dir * 512 + c]; cst[2 * 64 + j] = k_k[c]; cst[3 * 64 + j] = k_a[c]; cst[4 * 64 + j] = r_k[c];
        cst[5 * 64 + j] = mu[c]; cst[6 * 64 + j] = mu[512 + c]; cst[7 * 64 + j] = mu[1024 + c]; cst[8 * 64 + j] = mu[1536 + j]; cst[9 * 64 + j] = mu[1600 + j];
        cst[10 * 64 + j] = (j < 16) ? mu[1664 + h * 16 + j] : 0.f; }
    float S[8];
#pragma unroll
    for (int i = 0; i < 8; ++i) S[i] = 0.f;
    const int vrow = tid >> 3, part = tid & 7;
    __syncthreads();
    const bf16_t* Pb = P0 + (size_t)b * SEQ * ABPAD;
    for (int cc = 0; cc < 128; ++cc) {
        const int t0 = dir ? (127 - cc) * 32 : cc * 32;
        for (int e = tid; e < 32 * 160; e += 512) {
            const int tok = e / 160, cp = e % 160, grp = cp >> 5, c2 = (cp & 31) * 2;
            const int gcol = (grp == 0 ? h * 64 : grp == 1 ? 512 + h * 64 : grp == 2 ? 1024 + h * 64 : grp == 3 ? 1536 : 1600) + c2;
            const int t = t0 + tok; const bf16_t* p = Pb + (size_t)t * ABPAD + gcol;
            const unsigned cur = *(const unsigned*)p, prv = (t > 0) ? *(const unsigned*)(p - ABPAD) : 0u, nxt = (t < SEQ - 1) ? *(const unsigned*)(p + ABPAD) : 0u;
            const float m0 = cst[(5 + grp) * 64 + c2], m1 = cst[(5 + grp) * 64 + c2 + 1];
            const float c0 = bflo(cur), c1 = bfhi(cur);
            const float x0 = c0 + m0 * (0.5f * (bflo(prv) + bflo(nxt)) - c0), x1 = c1 + m1 * (0.5f * (bfhi(prv) + bfhi(nxt)) - c1);
            if (grp == 0) { rS[tok * 64 + c2] = x0; rS[tok * 64 + c2 + 1] = x1; }
            else if (grp == 1) { kS[tok * 64 + c2] = x0; kS[tok * 64 + c2 + 1] = x1; }
            else if (grp == 2) { vS[tok * 64 + c2] = x0; vS[tok * 64 + c2 + 1] = x1; }
            else if (grp == 3) { *(LAS unsigned*)(wdB + tok * 72 + c2) = pk2(tanhf(x0), tanhf(x1)); }
            else { *(LAS unsigned*)(adB + tok * 72 + c2) = pk2(x0, x1); }
        }
        if (dir == 0) {
            const int tok = tid >> 4, c = tid & 15, t = t0 + tok; const bf16_t* p = Pb + (size_t)t * ABPAD + 1664 + h * 16 + c;
            const float cur = bf2f(*p), prv = (t > 0) ? bf2f(*(p - ABPAD)) : 0.f, nxt = (t < SEQ - 1) ? bf2f(*(p + ABPAD)) : 0.f;
            const float x = cur + cst[10 * 64 + c] * (0.5f * (prv + nxt) - cur);
            SG[((size_t)b * SEQ + t) * 128 + h * 16 + c] = (bf16_t)f2bf(sigmoidf_(x));
        }
        __syncthreads();
        { const int mat = wid >> 2, ntile = wid & 3; const LAS bf16_t* Aop = mat ? wdB : adB; const LAS bf16_t* Bop = mat ? w2B : a2B; LAS float* pre = mat ? preW : preA;
#pragma unroll
          for (int mt = 0; mt < 2; ++mt) { f32x4 acc = (f32x4){0.f, 0.f, 0.f, 0.f};
#pragma unroll
              for (int ks = 0; ks < 2; ++ks) acc = mfma16(ldsfrag(Bop, 72, ntile * 16, ks * 32, fr, fq), ldsfrag(Aop, 72, mt * 16, ks * 32, fr, fq), acc);
              *(LAS f32x4*)(pre + (mt * 16 + fr) * 64 + ntile * 16 + fq * 4) = acc; } }
        __syncthreads();
        { const int tok = tid >> 4, c0 = (tid & 15) * 4; float kkr[4], av[4], kp[4], wv[4]; float ss = 0.f, bon = 0.f;
#pragma unroll
          for (int i = 0; i < 4; ++i) { const int c = c0 + i, ix = tok * 64 + c;
              const float a = sigmoidf_(cst[c] + preA[ix]); const float sg = sigmoidf_(cst[64 + c] + preW[ix]);
              wv[i] = __expf(-0.60653065971f * sg);
              const float kraw = kS[ix]; kkr[i] = kraw * cst[128 + c]; ss += kkr[i] * kkr[i];
              kp[i] = kraw * (1.0f + (a - 1.0f) * cst[192 + c]); av[i] = a; bon += rS[ix] * kp[i] * cst[256 + c]; }
#pragma unroll
          for (int o = 1; o < 16; o <<= 1) { ss += __shfl_xor(ss, o); bon += __shfl_xor(bon, o); }
          const float inv = 1.0f / fmaxf(sqrtf(ss), 1e-12f);
#pragma unroll
          for (int i = 0; i < 4; ++i) { const int ix = tok * 64 + c0 + i; const float kk = kkr[i] * inv; nkS[ix] = -kk; bS[ix] = kk * av[i]; kS[ix] = kp[i]; wS[ix] = wv[i]; }
          if (dir == 0 && (tid & 15) == 0) BONUS[((size_t)b * SEQ + t0 + tok) * 8 + h] = bon; }
        __syncthreads();
        for (int s = 0; s < 32; ++s) {
            const int tt = dir ? 31 - s : s; const int o8 = tt * 64 + part * 8;
            const f32x4 w0v = *(const LAS f32x4*)(wS + o8), w1v = *(const LAS f32x4*)(wS + o8 + 4);
            const f32x4 n0v = *(const LAS f32x4*)(nkS + o8), n1v = *(const LAS f32x4*)(nkS + o8 + 4);
            const f32x4 b0v = *(const LAS f32x4*)(bS + o8), b1v = *(const LAS f32x4*)(bS + o8 + 4);
            const f32x4 k0v = *(const LAS f32x4*)(kS + o8), k1v = *(const LAS f32x4*)(kS + o8 + 4);
            const f32x4 r0v = *(const LAS f32x4*)(rS + o8), r1v = *(const LAS f32x4*)(rS + o8 + 4);
            const float vv = vS[tt * 64 + vrow];
            float sa = 0.f;
#pragma unroll
            for (int i = 0; i < 4; ++i) { sa += S[i] * n0v[i]; sa += S[4 + i] * n1v[i]; }
            sa = sum8(sa);
            float oo = 0.f;
#pragma unroll
            for (int i = 0; i < 4; ++i) {
                S[i] = S[i] * w0v[i] + sa * b0v[i] + vv * k0v[i]; S[4 + i] = S[4 + i] * w1v[i] + sa * b1v[i] + vv * k1v[i];
                oo += S[i] * r0v[i]; oo += S[4 + i] * r1v[i]; }
            oo = sum8(oo);
            if (part == 0) oS[tt * 64 + vrow] = oo;
        }
        __syncthreads();
        { const int tok = tid >> 4, c0 = (tid & 15) * 4; const f32x4 o = *(const LAS f32x4*)(oS + tok * 64 + c0);
          u32x2 w; w.x = pk2(o[0], o[1]); w.y = pk2(o[2], o[3]);
          *(u32x2*)(ORW + (size_t)dir * T * 512 + ((size_t)b * SEQ + t0 + tok) * 512 + h * 64 + c0) = w; }
    }
    __syncthreads();
}

__device__ __forceinline__ void rwkv_combine(const bf16_t* P0, const bf16_t* ORW, const float* BONUS, const bf16_t* G, const float* mu, const float* gn_w, const float* gn_b, bf16_t* OMIX, int gw, int NGW, int lane) {
    const int c0 = lane * 8, head = lane >> 3;
    float muv[8], gw8[8], gb8[8];
#pragma unroll
    for (int i = 0; i < 8; ++i) { muv[i] = mu[1024 + c0 + i]; gw8[i] = gn_w[c0 + i]; gb8[i] = gn_b[c0 + i]; }
    for (int tk = gw; tk < T; tk += NGW) {
        const int t = tk & (SEQ - 1);
        const u32x4 uf = *(const u32x4*)(ORW + (size_t)tk * 512 + c0), ub = *(const u32x4*)(ORW + (size_t)T * 512 + (size_t)tk * 512 + c0);
        float o[8];
#pragma unroll
        for (int i = 0; i < 4; ++i) { o[2 * i] = bflo(uf[i]) + bflo(ub[i]); o[2 * i + 1] = bfhi(uf[i]) + bfhi(ub[i]); }
        float s = 0.f;
#pragma unroll
        for (int i = 0; i < 8; ++i) s += o[i];
        const float mean = sum8(s) * (1.f / 64.f); float q = 0.f;
#pragma unroll
        for (int i = 0; i < 8; ++i) { o[i] -= mean; q += o[i] * o[i]; }
        const float rstd = rsqrtf(sum8(q) * (1.f / 64.f) + 64e-5f);
        const bf16_t* pv = P0 + (size_t)tk * ABPAD + 1024 + c0;
        const u32x4 vc = *(const u32x4*)pv; u32x4 vp = (u32x4){0u, 0u, 0u, 0u}, vn = (u32x4){0u, 0u, 0u, 0u};
        if (t > 0) vp = *(const u32x4*)(pv - ABPAD);
        if (t < SEQ - 1) vn = *(const u32x4*)(pv + ABPAD);
        const u32x4 gg = *(const u32x4*)(G + (size_t)tk * 512 + c0);
        const float bon = BONUS[(size_t)tk * 8 + head];
        float r[8];
#pragma unroll
        for (int i = 0; i < 4; ++i) {
            const float c_lo = bflo(vc[i]), c_hi = bfhi(vc[i]);
            const float v_lo = c_lo + muv[2 * i] * (0.5f * (bflo(vp[i]) + bflo(vn[i])) - c_lo), v_hi = c_hi + muv[2 * i + 1] * (0.5f * (bfhi(vp[i]) + bfhi(vn[i])) - c_hi);
            r[2 * i] = (o[2 * i] * rstd * gw8[2 * i] + gb8[2 * i] + bon * v_lo) * bflo(gg[i]);
            r[2 * i + 1] = (o[2 * i + 1] * rstd * gw8[2 * i + 1] + gb8[2 * i + 1] + bon * v_hi) * bfhi(gg[i]); }
        u32x4 w; w.x = pk2(r[0], r[1]); w.y = pk2(r[2], r[3]); w.z = pk2(r[4], r[5]); w.w = pk2(r[6], r[7]);
        *(u32x4*)(OMIX + (size_t)tk * D + c0) = w;
    }
}

constexpr int SLD = 136;
__device__ __forceinline__ float softplusf_(float x) { return x > 20.f ? x : log1pf(__expf(x)); }
__device__ __forceinline__ void ssd_dt_cum(LAS float* dtS, LAS float* cumS, LAS float* totS, const bf16_t* Prow0, int g, int w, int lane, const float* dt_bias, const float* a_log) {
    const int j = w >> 1, d = w & 1, head = g * 4 + j;
    const float bias = dt_bias[d * 8 + head], A = -__expf(a_log[d * 8 + head]);
    const float x0 = bf2f(Prow0[(size_t)(2 * lane) * ABPAD + 3328 + head]), x1 = bf2f(Prow0[(size_t)(2 * lane + 1) * ABPAD + 3328 + head]);
    const float dt0 = softplusf_(x0 + bias), dt1 = softplusf_(x1 + bias), la0 = dt0 * A, la1 = dt1 * A;
    const float s = la0 + la1; float inc = s;
#pragma unroll
    for (int off = 1; off < 64; off <<= 1) { const float n = __shfl_up(inc, off); if (lane >= off) inc += n; }
    const float tot = __shfl(inc, 63), exc = inc - s;
    float c0, c1; if (d == 0) { c0 = exc + la0; c1 = inc; } else { c0 = tot - exc; c1 = tot - exc - la0; }
    dtS[w * 128 + 2 * lane] = dt0; dtS[w * 128 + 2 * lane + 1] = dt1; cumS[w * 128 + 2 * lane] = c0; cumS[w * 128 + 2 * lane + 1] = c1;
    if (lane == 0) totS[w] = tot;
}
template <int NR, bool TR> __device__ __forceinline__ void ssd_conv_col(LAS bf16_t* dst, int col, int cx, int l0, const bf16_t* Pb, int t0, const float* cw, const float* cb) {
    const float w0 = cw[cx], w1 = cw[1024 + cx], w2 = cw[2048 + cx], bias = cb[cx];
    const bf16_t* p = Pb + (size_t)(t0 + l0) * ABPAD + 2304 + cx;
    float um = (t0 + l0 > 0) ? bf2f(*(p - ABPAD)) : 0.f, u0 = bf2f(*p);
#pragma unroll 4
    for (int i = 0; i < NR; i += 2) {
        const int t = t0 + l0 + i;
        const float u1 = bf2f(*(p + (size_t)(i + 1) * ABPAD));
        const float u2 = (t + 2 < SEQ) ? bf2f(*(p + (size_t)(i + 2) * ABPAD)) : 0.f;
        float va = w0 * um + w1 * u0 + w2 * u1 + bias, vb = w0 * u0 + w1 * u1 + w2 * u2 + bias;
        va = va / (1.0f + __expf(-va)); vb = vb / (1.0f + __expf(-vb));
        if (TR) *(LAS unsigned*)(dst + col * SLD + l0 + i) = pk2(va, vb);
        else { dst[(l0 + i) * SLD + col] = (bf16_t)f2bf(va); dst[(l0 + i + 1) * SLD + col] = (bf16_t)f2bf(vb); }
        um = u1; u0 = u2;
    }
}
__device__ __forceinline__ void ssd_s1_unit(LAS unsigned char* lds, int unit, const bf16_t* P0, const float* cw, const float* cb, const float* dt_bias, const float* a_log, bf16_t* STATES, float* TOT) {
    const int tid = threadIdx.x, lane = tid & 63, w = tid >> 6, fr = lane & 15, fq = lane >> 4;
    const int g = unit & 1, c = (unit >> 1) & 31, b = unit >> 6, t0 = c * 128;
    LAS bf16_t* BT = (LAS bf16_t*)lds; LAS bf16_t* XT = (LAS bf16_t*)(lds + 34816); LAS float* dtS = (LAS float*)(lds + 104448); LAS float* cumS = (LAS float*)(lds + 108544);
    LAS float* scS = (LAS float*)(lds + 112640); LAS float* totS = (LAS float*)(lds + 116736);
    const bf16_t* Pb = P0 + (size_t)b * SEQ * ABPAD;
    __syncthreads();
    ssd_conv_col<32, true>(BT, tid & 127, 512 + g * 128 + (tid & 127), (tid >> 7) * 32, Pb, t0, cw, cb);
    ssd_conv_col<64, true>(XT, tid & 255, g * 256 + (tid & 255), (tid >> 8) * 64, Pb, t0, cw, cb);
    ssd_dt_cum(dtS, cumS, totS, Pb + (size_t)t0 * ABPAD, g, w, lane, dt_bias, a_log);
    __syncthreads();
    for (int e = tid; e < 1024; e += 512) scS[e] = dtS[e] * __expf(totS[e >> 7] - cumS[e]);
    if (tid < 8) TOT[((size_t)(b * 32 + c) * 2 + (tid & 1)) * 8 + g * 4 + (tid >> 1)] = totS[tid];
    __syncthreads();
    const int j = w >> 1;
#pragma unroll 1
    for (int d = 0; d < 2; ++d) {
        f32x4 acc[2][8];
#pragma unroll
        for (int mt = 0; mt < 2; ++mt)
#pragma unroll
            for (int nt = 0; nt < 8; ++nt) acc[mt][nt] = (f32x4){0.f, 0.f, 0.f, 0.f};
#pragma unroll 1
        for (int ks = 0; ks < 4; ++ks) {
            const int k0 = ks * 32; const LAS float* sp = scS + (j * 2 + d) * 128 + k0 + fq * 8;
            const f32x4 s0 = *(const LAS f32x4*)sp, s1 = *(const LAS f32x4*)(sp + 4);
            bf16x8 afr[2];
#pragma unroll
            for (int mt = 0; mt < 2; ++mt) { const u32x4 raw = *(const LAS u32x4*)(XT + (32 * w + mt * 16 + fr) * SLD + k0 + fq * 8); u32x4 o;
                o.x = pk2(bflo(raw.x) * s0[0], bfhi(raw.x) * s0[1]); o.y = pk2(bflo(raw.y) * s0[2], bfhi(raw.y) * s0[3]);
                o.z = pk2(bflo(raw.z) * s1[0], bfhi(raw.z) * s1[1]); o.w = pk2(bflo(raw.w) * s1[2], bfhi(raw.w) * s1[3]);
                afr[mt] = __builtin_bit_cast(bf16x8, o); }
#pragma unroll
            for (int nt = 0; nt < 8; ++nt) { const bf16x8 bfr = ldsfrag(BT, SLD, nt * 16, k0, fr, fq);
#pragma unroll
                for (int mt = 0; mt < 2; ++mt) acc[mt][nt] = mfma16(bfr, afr[mt], acc[mt][nt]); }
        }
        bf16_t* dst = STATES + (((size_t)(b * 32 + c) * 2 + d) * 8 + g * 4 + j) * 8192;
#pragma unroll
        for (int mt = 0; mt < 2; ++mt) { const int p = (w & 1) * 32 + mt * 16 + fr;
#pragma unroll
            for (int nt = 0; nt < 8; ++nt) { u32x2 o; o.x = pk2(acc[mt][nt][0], acc[mt][nt][1]); o.y = pk2(acc[mt][nt][2], acc[mt][nt][3]);
                *(u32x2*)(dst + p * 128 + nt * 16 + fq * 4) = o; } }
    }
}
__device__ __forceinline__ void ssd_s2(bf16_t* STATES, const float* TOT, int gtid, int NGT) {
    for (int it = gtid; it < 16 * 2 * 8 * 1024; it += NGT) {
        const int e8 = it & 1023, head = (it >> 10) & 7, d = (it >> 13) & 1, b = it >> 14;
        float run[8];
#pragma unroll
        for (int i = 0; i < 8; ++i) run[i] = 0.f;
        for (int cc = 0; cc < 32; ++cc) {
            const int c = d ? 31 - cc : cc; const size_t sidx = ((size_t)(b * 32 + c) * 2 + d) * 8 + head;
            u32x4* p = (u32x4*)(STATES + sidx * 8192 + e8 * 8); const u32x4 loc = *p; const float dec = __expf(TOT[sidx]);
            u32x4 o; o.x = pk2(run[0], run[1]); o.y = pk2(run[2], run[3]); o.z = pk2(run[4], run[5]); o.w = pk2(run[6], run[7]); *p = o;
#pragma unroll
            for (int i = 0; i < 4; ++i) { run[2 * i] = run[2 * i] * dec + bflo(loc[i]); run[2 * i + 1] = run[2 * i + 1] * dec + bfhi(loc[i]); }
        }
    }
}
__device__ __forceinline__ void ssd_s3_unit(LAS unsigned char* lds, int unit, const bf16_t* P0, const float* cw, const float* cb, const float* dt_bias, const float* a_log, const float* dskip, const float* norm_w,
                                            const bf16_t* STATES, bf16_t* OMIX) {
    const int tid = threadIdx.x, lane = tid & 63, w = tid >> 6, fr = lane & 15, fq = lane >> 4;
    const int g = unit & 1, c = (unit >> 1) & 31, b = unit >> 6, t0 = c * 128;
    LAS bf16_t* CS = (LAS bf16_t*)lds; LAS bf16_t* BS = (LAS bf16_t*)(lds + 34816); LAS bf16_t* XT = (LAS bf16_t*)(lds + 69632);
    LAS float* dtS = (LAS float*)(lds + 139264); LAS float* cumS = (LAS float*)(lds + 143360); LAS float* totS = (LAS float*)(lds + 147456);
    const bf16_t* Pb = P0 + (size_t)b * SEQ * ABPAD;
    __syncthreads();
    ssd_conv_col<32, false>(BS, tid & 127, 512 + g * 128 + (tid & 127), (tid >> 7) * 32, Pb, t0, cw, cb);
    ssd_conv_col<32, false>(CS, tid & 127, 768 + g * 128 + (tid & 127), (tid >> 7) * 32, Pb, t0, cw, cb);
    ssd_conv_col<64, true>(XT, tid & 255, g * 256 + (tid & 255), (tid >> 8) * 64, Pb, t0, cw, cb);
    ssd_dt_cum(dtS, cumS, totS, Pb + (size_t)t0 * ABPAD, g, w, lane, dt_bias, a_log);
    __syncthreads();
    const int l = 16 * w + fr;
    f32x4 sc[8];
#pragma unroll
    for (int nt = 0; nt < 8; ++nt) sc[nt] = (f32x4){0.f, 0.f, 0.f, 0.f};
#pragma unroll
    for (int ks = 0; ks < 4; ++ks) { const bf16x8 afr = ldsfrag(CS, SLD, 16 * w, ks * 32, fr, fq);
#pragma unroll
        for (int nt = 0; nt < 8; ++nt) sc[nt] = mfma16(ldsfrag(BS, SLD, nt * 16, ks * 32, fr, fq), afr, sc[nt]); }
    __syncthreads();
    LAS bf16_t* Mw = BS + w * 16 * SLD;
    const size_t row = (size_t)b * SEQ + t0 + l; float ss = 0.f;
#pragma unroll 1
    for (int j = 0; j < 4; ++j) {
        const LAS float* cf = cumS + (j * 2) * 128; const LAS float* cbw = cumS + (j * 2 + 1) * 128; const LAS float* df = dtS + (j * 2) * 128; const LAS float* db = dtS + (j * 2 + 1) * 128;
        const float cfl = cf[l], cbl = cbw[l];
#pragma unroll
        for (int nt = 0; nt < 8; ++nt) { float mv[4];
#pragma unroll
            for (int i = 0; i < 4; ++i) { const int s = nt * 16 + fq * 4 + i;
                const float ff = (s <= l) ? __expf(cfl - cf[s]) * df[s] : 0.f; const float fb = (s >= l) ? __expf(cbl - cbw[s]) * db[s] : 0.f;
                mv[i] = sc[nt][i] * (ff + fb); }
            u32x2 o; o.x = pk2(mv[0], mv[1]); o.y = pk2(mv[2], mv[3]); *(LAS u32x2*)(Mw + fr * SLD + nt * 16 + fq * 4) = o; }
        LDS_WAIT();
        f32x4 yd[4], yf[4], yb[4];
#pragma unroll
        for (int pt = 0; pt < 4; ++pt) { yd[pt] = (f32x4){0.f, 0.f, 0.f, 0.f}; yf[pt] = yd[pt]; yb[pt] = yd[pt]; }
        const size_t sbase = ((size_t)(b * 32 + c) * 2) * 8 + g * 4 + j;
        const bf16_t* carf = STATES + sbase * 8192; const bf16_t* carb = STATES + (sbase + 8) * 8192;
#pragma unroll 1
        for (int ks = 0; ks < 4; ++ks) {
            const bf16x8 am = *(const LAS bf16x8*)(Mw + fr * SLD + ks * 32 + fq * 8); const bf16x8 ac = ldsfrag(CS, SLD, 16 * w, ks * 32, fr, fq);
#pragma unroll
            for (int pt = 0; pt < 4; ++pt) {
                yd[pt] = mfma16(ldsfrag(XT, SLD, j * 64 + pt * 16, ks * 32, fr, fq), am, yd[pt]);
                const bf16x8 bfv = *(const bf16x8*)(carf + (pt * 16 + fr) * 128 + ks * 32 + fq * 8), bbv = *(const bf16x8*)(carb + (pt * 16 + fr) * 128 + ks * 32 + fq * 8);
                yf[pt] = mfma16(bfv, ac, yf[pt]); yb[pt] = mfma16(bbv, ac, yb[pt]); }
        }
        const float ef = __expf(cfl), eb = __expf(cbl), dsk = dskip[g * 4 + j];
#pragma unroll
        for (int pt = 0; pt < 4; ++pt) { const f32x4 yv = yd[pt] + yf[pt] * ef + yb[pt] * eb;
            const int col = j * 64 + pt * 16 + fq * 4; const u32x2 zz = *(const u32x2*)(P0 + row * ABPAD + 1792 + g * 256 + col);
            const float z4[4] = {bflo(zz.x), bfhi(zz.x), bflo(zz.y), bfhi(zz.y)}; float v4[4];
#pragma unroll
            for (int i = 0; i < 4; ++i) { const float xs = bf2f(XT[(col + i) * SLD + l]); float v = yv[i] + dsk * xs; const float z = z4[i]; v = v * (z / (1.0f + __expf(-z)));
                v4[i] = v; ss += v * v; }
            u32x2 o; o.x = pk2(v4[0], v4[1]); o.y = pk2(v4[2], v4[3]); *(u32x2*)(OMIX + row * D + 512 + g * 256 + col) = o; }
        asm volatile("" ::: "memory");
    }
    ss += __shfl_xor(ss, 16); ss += __shfl_xor(ss, 32);
    const float rs = rsqrtf(ss * (1.f / 256.f) + 1e-6f);
    asm volatile("s_waitcnt vmcnt(0)" ::: "memory");
#pragma unroll 4
    for (int q = 0; q < 16; ++q) { const int col = g * 256 + q * 16 + fq * 4; const f32x4 nw = *(const f32x4*)(norm_w + col);
        u32x2* p = (u32x2*)(OMIX + row * D + 512 + col); const u32x2 v = *p;
        u32x2 o; o.x = pk2(bflo(v.x) * rs * nw[0], bfhi(v.x) * rs * nw[1]); o.y = pk2(bflo(v.y) * rs * nw[2], bfhi(v.y) * rs * nw[3]); *p = o; }
}

constexpr int HLD = 136, HLS = 72;
__device__ __forceinline__ void hgrn_chain(LAS unsigned char* lds, int cid, bf16_t* P1, const float* hg_lb) {
    const int tid = threadIdx.x, lane = tid & 63, w = tid >> 6, fr = lane & 15, fq = lane >> 4;
    const int b = cid >> 4, h = (cid >> 1) & 7, dir = cid & 1;
    LAS bf16_t* QE = (LAS bf16_t*)lds;
    LAS bf16_t* KE = (LAS bf16_t*)(lds + 17408);
    LAS bf16_t* KLT = (LAS bf16_t*)(lds + 34816);
    LAS bf16_t* VT = (LAS bf16_t*)(lds + 53248);
    LAS bf16_t* AT = (LAS bf16_t*)(lds + 71680);
    LAS bf16_t* ST = (LAS bf16_t*)(lds + 80896);
    LAS float* totS = (LAS float*)(lds + 115712);
    LAS float* lastS = (LAS float*)(lds + 117760);
    __syncthreads();
    for (int e = tid; e < 128 * HLD / 2; e += 512) ((LAS unsigned*)ST)[e] = 0u;
    const int dcol = tid & 127, qtr = tid >> 7, i0 = qtr * 16;
    const float lbv = 1.0f / (1.0f + __expf(hg_lb[h * 128 + dcol] - hg_lb[1024 + h * 128 + dcol]));
    f32x4 st[8];
#pragma unroll
    for (int i = 0; i < 8; ++i) st[i] = (f32x4){0.f, 0.f, 0.f, 0.f};
    bf16_t* Pb = P1 + (size_t)b * SEQ * HGP;
    __syncthreads();
    for (int cc = 0; cc < 64; ++cc) {
        const int t0 = (dir ? 63 - cc : cc) * 64;
        float gq[16], gk[16], gc[16]; unsigned short vraw[16]; float run = 0.f;
#pragma unroll
        for (int i = 0; i < 16; ++i) { const int tk = t0 + (dir ? 63 - (i0 + i) : (i0 + i)); const bf16_t* pr = Pb + (size_t)tk * HGP + h * 128 + dcol;
            const float q = bf2f(pr[0]), fr_ = bf2f(pr[1024 * (1 + dir)]); vraw[i] = pr[3072];
            const float f = lbv + (1.0f - lbv) * sigmoidf_(fr_); run += __logf(f); gq[i] = q; gk[i] = 1.0f - f; gc[i] = run; }
        totS[qtr * 128 + dcol] = run;
        { unsigned* vt = (unsigned*)nullptr; (void)vt; }
#pragma unroll
        for (int i = 0; i < 16; i += 2) *(LAS unsigned*)(VT + dcol * HLS + i0 + i) = (unsigned)vraw[i] | ((unsigned)vraw[i + 1] << 16);
        __syncthreads();
        { float pre = 0.f, tot = 0.f;
#pragma unroll
          for (int q4 = 0; q4 < 4; ++q4) { const float tq = totS[q4 * 128 + dcol]; if (q4 < qtr) pre += tq; tot += tq; }
          if (qtr == 0) lastS[dcol] = __expf(tot);
#pragma unroll
          for (int i = 0; i < 16; i += 2) { const float b0 = pre + gc[i], b1 = pre + gc[i + 1];
              const float e0 = __expf(b0), e1 = __expf(b1), n0 = __expf(-b0), n1 = __expf(-b1), l0 = __expf(tot - b0), l1 = __expf(tot - b1);
              QE[(i0 + i) * HLD + dcol] = (bf16_t)f2bf(gq[i] * e0); QE[(i0 + i + 1) * HLD + dcol] = (bf16_t)f2bf(gq[i + 1] * e1);
              KE[(i0 + i) * HLD + dcol] = (bf16_t)f2bf(gk[i] * n0); KE[(i0 + i + 1) * HLD + dcol] = (bf16_t)f2bf(gk[i + 1] * n1);
              *(LAS unsigned*)(KLT + dcol * HLS + i0 + i) = pk2(gk[i] * l0, gk[i + 1] * l1); } }
        __syncthreads();
        { const int mt = w >> 1;
#pragma unroll
          for (int n2 = 0; n2 < 2; ++n2) { const int nt = (w & 1) * 2 + n2; f32x4 acc = (f32x4){0.f, 0.f, 0.f, 0.f};
#pragma unroll
              for (int ks = 0; ks < 4; ++ks) acc = mfma16(ldsfrag(KE, HLD, nt * 16, ks * 32, fr, fq), ldsfrag(QE, HLD, mt * 16, ks * 32, fr, fq), acc);
              const int lrow = mt * 16 + fr; float mv[4];
#pragma unroll
              for (int i = 0; i < 4; ++i) { const int s = nt * 16 + fq * 4 + i; mv[i] = (s <= lrow) ? acc[i] : 0.f; }
              u32x2 o; o.x = pk2(mv[0], mv[1]); o.y = pk2(mv[2], mv[3]); *(LAS u32x2*)(AT + lrow * HLS + nt * 16 + fq * 4) = o; } }
        __syncthreads();
        { const int mt = w >> 1;
#pragma unroll
          for (int n4 = 0; n4 < 4; ++n4) { const int nt = (w & 1) * 4 + n4; f32x4 acc = (f32x4){0.f, 0.f, 0.f, 0.f};
#pragma unroll
              for (int ks = 0; ks < 2; ++ks) acc = mfma16(ldsfrag(VT, HLS, nt * 16, ks * 32, fr, fq), ldsfrag(AT, HLS, mt * 16, ks * 32, fr, fq), acc);
#pragma unroll
              for (int ks = 0; ks < 4; ++ks) acc = mfma16(ldsfrag(ST, HLD, nt * 16, ks * 32, fr, fq), ldsfrag(QE, HLD, mt * 16, ks * 32, fr, fq), acc);
              const int i = mt * 16 + fr, tk = t0 + (dir ? 63 - i : i);
              u32x2 o; o.x = pk2(acc[0], acc[1]); o.y = pk2(acc[2], acc[3]);
              *(u32x2*)(Pb + (size_t)tk * HGP + 1024 * (1 + dir) + h * 128 + nt * 16 + fq * 4) = o; } }
#pragma unroll
        for (int nt = 0; nt < 8; ++nt) { const f32x4 el = *(const LAS f32x4*)(lastS + nt * 16 + fq * 4); st[nt] = st[nt] * el;
#pragma unroll
            for (int ks = 0; ks < 2; ++ks) st[nt] = mfma16(ldsfrag(KLT, HLS, nt * 16, ks * 32, fr, fq), ldsfrag(VT, HLS, w * 16, ks * 32, fr, fq), st[nt]); }
        __syncthreads();
#pragma unroll
        for (int nt = 0; nt < 8; ++nt) { u32x2 o; o.x = pk2(st[nt][0], st[nt][1]); o.y = pk2(st[nt][2], st[nt][3]); *(LAS u32x2*)(ST + (w * 16 + fr) * HLD + nt * 16 + fq * 4) = o; }
    }
    __syncthreads();
}
__device__ __forceinline__ void hgrn_combine(const bf16_t* P1, const float* norm_w, bf16_t* OMIX, int gw, int NGW, int lane) {
    const int c0 = lane * 16;
    for (int tk = gw; tk < T; tk += NGW) {
        const bf16_t* pr = P1 + (size_t)tk * HGP + c0; float o[16]; float ss = 0.f;
#pragma unroll
        for (int hh = 0; hh < 2; ++hh) { const u32x4 uf = *(const u32x4*)(pr + 1024 + hh * 8), ub = *(const u32x4*)(pr + 2048 + hh * 8);
#pragma unroll
            for (int i = 0; i < 4; ++i) { o[hh * 8 + 2 * i] = bflo(uf[i]) + bflo(ub[i]); o[hh * 8 + 2 * i + 1] = bfhi(uf[i]) + bfhi(ub[i]); } }
#pragma unroll
        for (int i = 0; i < 16; ++i) ss += o[i] * o[i];
        const float rs = rsqrtf(sum8(ss) * (1.f / 128.f) + 1e-6f);
#pragma unroll
        for (int hh = 0; hh < 2; ++hh) { const u32x4 ug = *(const u32x4*)(pr + 4096 + hh * 8); float r[8];
#pragma unroll
            for (int i = 0; i < 4; ++i) { const float g0 = bflo(ug[i]), g1 = bfhi(ug[i]);
                r[2 * i] = o[hh * 8 + 2 * i] * rs * norm_w[c0 + hh * 8 + 2 * i] * (g0 / (1.0f + __expf(-g0)));
                r[2 * i + 1] = o[hh * 8 + 2 * i + 1] * rs * norm_w[c0 + hh * 8 + 2 * i + 1] * (g1 / (1.0f + __expf(-g1))); }
            u32x4 wv; wv.x = pk2(r[0], r[1]); wv.y = pk2(r[2], r[3]); wv.z = pk2(r[4], r[5]); wv.w = pk2(r[6], r[7]);
            *(u32x4*)(OMIX + (size_t)tk * D + c0 + hh * 8) = wv; }
    }
}

struct Args { const float* in[35]; float* out; unsigned char* ws; int ph_lo, ph_hi; };
static_assert(sizeof(Args) == 304, "Args layout");

__global__ void __launch_bounds__(512, 2) mk_fwd(Args args) {
    extern __shared__ __attribute__((aligned(16))) unsigned char lds_raw[];
    LAS unsigned char* lds = (LAS unsigned char*)lds_raw; LAS unsigned char* xl = lds + XLDS_OFF;
    const int G = gridDim.x, bx = blockIdx.x, NGW = G * 8;
#define LOCAL_IDS int tid = threadIdx.x; asm volatile("" : "+v"(tid)); const int lane = tid & 63, wave = __builtin_amdgcn_readfirstlane(tid >> 6), gw = bx * 8 + wave; (void)lane; (void)gw;
    typedef const __attribute__((address_space(4))) unsigned char* kaptr_t;
    kaptr_t ka = (kaptr_t)__builtin_amdgcn_kernarg_segment_ptr();
#define INP(k) (*(const float* const volatile __attribute__((address_space(4)))*)(ka + 8 * (k)))
    unsigned char* ws = *(unsigned char* const volatile __attribute__((address_space(4)))*)(ka + 288); float* out = *(float* const volatile __attribute__((address_space(4)))*)(ka + 280);
    const float* x = INP(0);
    bf16_t* WAB = (bf16_t*)(ws + WS_WAB); bf16_t* WABO = (bf16_t*)(ws + WS_WABO); bf16_t* WHG = (bf16_t*)(ws + WS_WHG); bf16_t* WHGO = (bf16_t*)(ws + WS_WHGO);
    bf16_t* WQ = (bf16_t*)(ws + WS_WQ); bf16_t* WKV = (bf16_t*)(ws + WS_WKV); bf16_t* WO = (bf16_t*)(ws + WS_WO); bf16_t* WF1 = (bf16_t*)(ws + WS_WF1); bf16_t* WF2 = (bf16_t*)(ws + WS_WF2);
    bf16_t* G2T = (bf16_t*)(ws + WS_G2T); bf16_t* MEMN = (bf16_t*)(ws + WS_MEMN); bf16_t* KMEM = (bf16_t*)(ws + WS_KMEM); bf16_t* VT = (bf16_t*)(ws + WS_VT);
    bf16_t* H = (bf16_t*)(ws + WS_H); bf16_t* P = (bf16_t*)(ws + WS_P); bf16_t* PATT = (bf16_t*)(ws + WS_PATT); bf16_t* OMIX0 = (bf16_t*)(ws + WS_OMIX0);
    bf16_t* STATES = (bf16_t*)((unsigned char*)out + DO_STATES); bf16_t* GG = (bf16_t*)((unsigned char*)out + DO_G); bf16_t* SG = (bf16_t*)((unsigned char*)out + DO_SG);
    float* BONUS = (float*)((unsigned char*)out + DO_BONUS); float* TOT = (float*)((unsigned char*)out + DO_TOT);
    cg::grid_group grid = cg::this_grid();
    const int lo = *(const int volatile __attribute__((address_space(4)))*)(ka + 296), hi = *(const int volatile __attribute__((address_space(4)))*)(ka + 300);
#ifndef PH_EN
#define PH_EN(k) 1
#endif
#define IN(k) (PH_EN(k) && lo <= (k) && (k) < hi)
#define SEAM(k) do { if (IN(k) && IN((k) + 1)) grid.sync(); } while (0)
#define RUN_GEMM(EPI, ALIGN, gd, ep) do { pg8::Order S_; S_.init(gd, G, bx); pg8::gemm_phase<EPI, ALIGN>(lds, xl, gd, S_, ep); } while (0)

    if (IN(0)) { LOCAL_IDS
        LAS float* scr = (LAS float*)(lds + wave * 16384);
        constexpr int I_AB = 16 * 112, I_SQ = 16 * 32, I_HG = 16 * 160, I_KV = 16 * 64, I_F1 = 16 * 176, I_F2 = 44 * 32, I_G2 = 2 * 16;
        constexpr int NIT = I_AB + I_SQ + I_HG + I_SQ + 2 * I_SQ + 2 * I_KV + 2 * I_SQ + 2 * I_F1 + 2 * I_F2 + I_G2;
        for (int it = gw; it < NIT; it += NGW) {
            int r = it;
            if (r < I_AB) { transpose_item<0>(INP(3), 1024, ABP, WAB, scr, r, 112, lane); continue; } r -= I_AB;
            if (r < I_SQ) { transpose_item<0>(INP(4), 1024, 1024, WABO, scr, r, 32, lane); continue; } r -= I_SQ;
            if (r < I_HG) { transpose_item<0>(INP(22), 1024, HGP, WHG, scr, r, 160, lane); continue; } r -= I_HG;
            if (r < I_SQ) { transpose_item<0>(INP(23), 1024, 1024, WHGO, scr, r, 32, lane); continue; } r -= I_SQ;
            if (r < 2 * I_SQ) { const int l = r / I_SQ; transpose_item<0>(INP(28) + (size_t)l * D * D, 1024, 1024, WQ + (size_t)l * D * D, scr, r % I_SQ, 32, lane); continue; } r -= 2 * I_SQ;
            if (r < 2 * I_KV) { const int l = r / I_KV; transpose_item<0>(INP(29) + (size_t)l * D * 2048, 1024, 2048, WKV + (size_t)l * D * 2048, scr, r % I_KV, 64, lane); continue; } r -= 2 * I_KV;
            if (r < 2 * I_SQ) { const int l = r / I_SQ; transpose_item<0>(INP(30) + (size_t)l * D * D, 1024, 1024, WO + (size_t)l * D * D, scr, r % I_SQ, 32, lane); continue; } r -= 2 * I_SQ;
            if (r < 2 * I_F1) { const int l = r / I_F1; transpose_item<1>(INP(32) + (size_t)l * D * 2 * FFN, 1024, 2 * FFN, WF1 + (size_t)l * D * 2 * FFN, scr, r % I_F1, 176, lane); continue; } r -= 2 * I_F1;
            if (r < 2 * I_F2) { const int l = r / I_F2; transpose_item<0>(INP(33) + (size_t)l * FFN * D, FFN, 1024, WF2 + (size_t)l * FFN * D, scr, r % I_F2, 32, lane); continue; } r -= 2 * I_F2;
            transpose_item<0>(INP(10), 128, 512, G2T, scr, r, 16, lane);
        }
        rms_rows_phase(x, INP(2), H, T, gw, NGW, lane);
        for (int m = gw; m < 2 * 4096; m += NGW) { const int l = m >> 12, r = m & 4095; rms_row_bf16(INP(1) + (size_t)r * D, INP(27) + l * D, MEMN + (size_t)m * D, lane); }
        __syncthreads();
    }
    SEAM(0);
    if (IN(1)) {
        { pg8::Gemm g = pg8::make_gemm(H, WAB, T, ABPAD, 1024, 1024, 1024); pg8::EpiBf16 E{P, ABPAD, 1.0f}; RUN_GEMM(pg8::EpiBf16, true, g, E); }
        for (int l = 0; l < 2; ++l) {
            { pg8::Gemm g = pg8::make_gemm(MEMN + (size_t)l * 4096 * D, WKV + (size_t)l * 2048 * D, 4096, 1024, 1024, 1024, 1024); pg8::EpiBf16 E{KMEM + (size_t)l * 4096 * D, 1024, 1.0f}; RUN_GEMM(pg8::EpiBf16, true, g, E); }
            { pg8::Gemm g = pg8::make_gemm(WKV + (size_t)l * 2048 * D + (size_t)1024 * D, MEMN + (size_t)l * 4096 * D, 1024, 4096, 1024, 1024, 1024); pg8::EpiBf16 E{VT + (size_t)l * 4096 * D, 4096, 1.0f}; RUN_GEMM(pg8::EpiBf16, true, g, E); }
        }
    }
    SEAM(1);
    if (IN(2)) {
#ifndef NO_RWKV
        for (int cid = bx; cid < 256; cid += G)
            rwkv_chain(lds, cid, P, INP(5), INP(6), INP(7), INP(8), INP(9), INP(11), INP(12), INP(13), H, SG, BONUS);
#endif
#ifndef NO_S1
        for (int u = bx; u < 1024; u += G) ssd_s1_unit(lds, u, P, INP(16), INP(17), INP(18), INP(19), STATES, TOT);
#endif
        __syncthreads();
    }
    SEAM(2);
    if (IN(3)) {
        { pg8::Gemm g = pg8::make_gemm(SG, G2T, T, 512, 128, 128, 128); pg8::EpiBf16 E{GG, 512, 1.0f}; RUN_GEMM(pg8::EpiBf16, true, g, E); }
        { LOCAL_IDS ssd_s2(STATES, TOT, bx * 512 + tid, G * 512); }
    }
    SEAM(3);
    if (IN(4)) {
        for (int u = bx; u < 1024; u += G) ssd_s3_unit(lds, u, P, INP(16), INP(17), INP(18), INP(19), INP(20), INP(21), STATES, OMIX0);
        __syncthreads();
        { LOCAL_IDS rwkv_combine(P, H, BONUS, GG, INP(5), INP(14), INP(15), OMIX0, gw, NGW, lane); }
    }
    SEAM(4);
    if (IN(5)) { pg8::Gemm g = pg8::make_gemm(OMIX0, WABO, T, 1024, 1024, 1024, 1024); pg8::EpiResid E{x, out, 1024}; RUN_GEMM(pg8::EpiResid, true, g, E); }
    SEAM(5);

#define ATTN_FFN(base, L) \
    if (IN(base)) { LOCAL_IDS rms_rows_phase(out, INP(26) + (L) * D, H, T, gw, NGW, lane); } \
    SEAM(base); \
    if (IN(base + 1)) { pg8::Gemm g = pg8::make_gemm(H, WQ + (size_t)(L) * D * D, T, 1024, 1024, 1024, 1024); pg8::EpiBf16 E{P, 1024, 0.0625f}; RUN_GEMM(pg8::EpiBf16, true, g, E); } \
    SEAM(base + 1); \
    if (IN(base + 2)) { pg8::Gemm g = pg8::make_gemm(P, KMEM + (size_t)(L) * 4096 * D, SEQ, 256, 256, 1024, 1024); g.nZ = 64; g.zdiv = 4; \
        g.sAo = (long)SEQ * D; g.sAi = 256; g.sBo = 256L * D; g.sBi = 256; g.sCo = (long)SEQ * D; g.sCi = 256; pg8::EpiSoftmax E{PATT, 1024}; RUN_GEMM(pg8::EpiSoftmax, true, g, E); } \
    SEAM(base + 2); \
    if (IN(base + 3)) { pg8::Gemm g = pg8::make_gemm(PATT, VT + (size_t)(L) * 4096 * D, SEQ, 256, 256, 1024, 4096); g.nZ = 64; g.zdiv = 4; \
        g.sAo = (long)SEQ * D; g.sAi = 256; g.sBo = 256; g.sBi = 256L * 4096; g.sCo = (long)SEQ * D; g.sCi = 256; pg8::EpiBf16 E{P, 1024, 1.0f}; RUN_GEMM(pg8::EpiBf16, true, g, E); } \
    SEAM(base + 3); \
    if (IN(base + 4)) { pg8::Gemm g = pg8::make_gemm(P, WO + (size_t)(L) * D * D, T, 1024, 1024, 1024, 1024); pg8::EpiResid E{out, out, 1024}; RUN_GEMM(pg8::EpiResid, true, g, E); } \
    SEAM(base + 4); \
    if (IN(base + 5)) { LOCAL_IDS rms_rows_phase(out, INP(31) + (L) * D, H, T, gw, NGW, lane); } \
    SEAM(base + 5); \
    if (IN(base + 6)) { pg8::Gemm g = pg8::make_gemm(H, WF1 + (size_t)(L) * D * 2 * FFN, T, 2 * FFN, 1024, 1024, 1024); pg8::EpiSwiglu E{P, FFN}; RUN_GEMM(pg8::EpiSwiglu, true, g, E); } \
    SEAM(base + 6); \
    if (IN(base + 7)) { pg8::Gemm g = pg8::make_gemm(P, WF2 + (size_t)(L) * FFN * D, T, 1024, FFN, FFN, FFN); pg8::EpiResid E{out, out, 1024}; RUN_GEMM(pg8::EpiResid, true, g, E); } \
    SEAM(base + 7);

    ATTN_FFN(6, 0)

    if (IN(14)) { LOCAL_IDS rms_rows_phase(out, INP(2) + D, H, T, gw, NGW, lane); }
    SEAM(14);
    if (IN(15)) { pg8::Gemm g = pg8::make_gemm(H, WHG, T, HGP, 1024, 1024, 1024); pg8::EpiBf16 E{P, HGP, 1.0f}; RUN_GEMM(pg8::EpiBf16, true, g, E); }
    SEAM(15);
    if (IN(16)) { for (int cid = bx; cid < 256; cid += G) hgrn_chain(lds, cid, P, INP(25)); }
    SEAM(16);
    if (IN(17)) { LOCAL_IDS hgrn_combine(P, INP(24), H, gw, NGW, lane); }
    SEAM(17);
    if (IN(18)) { pg8::Gemm g = pg8::make_gemm(H, WHGO, T, 1024, 1024, 1024, 1024); pg8::EpiResid E{out, out, 1024}; RUN_GEMM(pg8::EpiResid, true, g, E); }
    SEAM(18);

    ATTN_FFN(19, 1)

    if (IN(27)) { LOCAL_IDS
        const float* fg = INP(34);
        for (int m = gw; m < T; m += NGW) { f32x4* xr = (f32x4*)(out + (size_t)m * D) + lane; f32x4 v[4]; float s = 0.f;
#pragma unroll
            for (int j = 0; j < 4; ++j) { v[j] = xr[64 * j]; s += (v[j].x * v[j].x + v[j].y * v[j].y) + (v[j].z * v[j].z + v[j].w * v[j].w); }
            const float rs = rsqrtf(wave_sum(s) * (1.f / D) + 1e-6f);
#pragma unroll
            for (int j = 0; j < 4; ++j) { const f32x4 g = ((const f32x4*)fg)[lane + 64 * j]; xr[64 * j] = v[j] * rs * g; } }
    }
#undef IN
#undef SEAM
#undef RUN_GEMM
}

extern "C" void kernel_launch(void* const* d_in, const int* in_sizes, int n_in, void* d_out, int out_size, void* d_ws, size_t ws_size, hipStream_t stream) {
    static int grid = 0;
    if (grid == 0) {
        if (n_in != 35 || out_size != T * D || ws_size < WS_END) { fprintf(stderr, "kernel_launch: unexpected shapes (n_in %d out %d ws %zu)\n", n_in, out_size, ws_size); grid = -1; return; }
        int dev = 0, cus = 0, per_cu = 0;
        hipGetDevice(&dev); hipDeviceGetAttribute(&cus, hipDeviceAttributeMultiprocessorCount, dev);
        hipFuncSetAttribute((const void*)mk_fwd, hipFuncAttributeMaxDynamicSharedMemorySize, LDS_BYTES);
        hipOccupancyMaxActiveBlocksPerMultiprocessor(&per_cu, (const void*)mk_fwd, 512, LDS_BYTES);
        if (per_cu < 1) { fprintf(stderr, "kernel_launch: occupancy query says %d blocks per CU\n", per_cu); per_cu = 1; }
        (void)hipGetLastError();
        grid = cus * 1;
    }
    if (grid < 0) return;
    Args a{};
    for (int i = 0; i < 35; ++i) a.in[i] = (const float*)d_in[i];
    a.out = (float*)d_out; a.ws = (unsigned char*)d_ws;
#if MK_COOP
    a.ph_lo = 0; a.ph_hi = NPHASE;
    void* kargs[] = {&a};
    hipError_t e = hipLaunchCooperativeKernel((const void*)mk_fwd, dim3(grid), dim3(512), kargs, LDS_BYTES, stream);
    if (e != hipSuccess) fprintf(stderr, "cooperative launch failed: %s (grid %d)\n", hipGetErrorString(e), grid);
#else
    for (int ph = 0; ph < NPHASE; ++ph) { a.ph_lo = ph; a.ph_hi = ph + 1; hipLaunchKernelGGL(mk_fwd, dim3(grid), dim3(512), LDS_BYTES, stream, a); }
#endif
}
```

```cpp
#include <hip/hip_runtime.h>
#include <hip/hip_cooperative_groups.h>
#include <cstdio>
#include <cstdint>
namespace cg = cooperative_groups;

#ifndef MK_COOP
#define MK_COOP 1
#endif

#define LAS __attribute__((address_space(3)))
typedef unsigned short bf16_t;
typedef short bf16x8 __attribute__((ext_vector_type(8)));
typedef float f32x4 __attribute__((ext_vector_type(4)));
typedef float f32x2 __attribute__((ext_vector_type(2)));
typedef unsigned u32x4 __attribute__((ext_vector_type(4)));
typedef unsigned u32x2 __attribute__((ext_vector_type(2)));

constexpr int NB = 16, SEQ = 4096, T = NB * SEQ, D = 1024;
constexpr int ABPAD = 3584, ABP = 3336;
constexpr int HGP = 5120;
constexpr int FFN = 2816;
constexpr int NPHASE = 28;

constexpr size_t MiB = 1u << 20;
constexpr size_t WS_WAB = 1 * MiB, WS_WABO = 8 * MiB, WS_WHG = 10 * MiB, WS_WHGO = 20 * MiB, WS_WQ = 22 * MiB, WS_WKV = 26 * MiB, WS_WO = 34 * MiB,
                 WS_WF1 = 38 * MiB, WS_WF2 = 60 * MiB, WS_G2T = 71 * MiB, WS_MEMN = 72 * MiB, WS_KMEM = 88 * MiB, WS_VT = 104 * MiB,
                 WS_H = 128 * MiB, WS_P = 256 * MiB, WS_PATT = 384 * MiB, WS_OMIX0 = 704 * MiB, WS_END = 832 * MiB;
constexpr size_t DO_STATES = 0, DO_G = 128 * MiB, DO_SG = 192 * MiB, DO_BONUS = 208 * MiB, DO_TOT = 210 * MiB;

constexpr int LDS_BYTES = 151552;
constexpr int XLDS_OFF = 131072;

__device__ __forceinline__ unsigned f2bf(float f) { unsigned u = __builtin_bit_cast(unsigned, f); return (u + 0x7fffu + ((u >> 16) & 1u)) >> 16; }
__device__ __forceinline__ unsigned pk2(float lo, float hi) { return f2bf(lo) | (f2bf(hi) << 16); }
__device__ __forceinline__ float bf2f(unsigned short b) { return __builtin_bit_cast(float, (unsigned)b << 16); }
__device__ __forceinline__ float bflo(unsigned u) { return __builtin_bit_cast(float, u << 16); }
__device__ __forceinline__ float bfhi(unsigned u) { return __builtin_bit_cast(float, u & 0xffff0000u); }
__device__ __forceinline__ float frcp(float x) { return __builtin_amdgcn_rcpf(x); }
__device__ __forceinline__ float sigmoidf_(float x) { return frcp(1.0f + __expf(-x)); }
__device__ __forceinline__ float siluf_(float x) { return x * frcp(1.0f + __expf(-x)); }
__device__ __forceinline__ float wave_sum(float v) {
#pragma unroll
    for (int o = 1; o < 64; o <<= 1) v += __shfl_xor(v, o);
    return v;
}
template <int CTRL> __device__ __forceinline__ float dppf(float x) { return __builtin_bit_cast(float, __builtin_amdgcn_mov_dpp(__builtin_bit_cast(int, x), CTRL, 0xf, 0xf, true)); }
__device__ __forceinline__ float sum8(float v) { v += dppf<0xB1>(v); v += dppf<0x4E>(v); v += dppf<0x141>(v); return v; }
#define LDS_WAIT() asm volatile("s_waitcnt lgkmcnt(0)" ::: "memory")

namespace pg8 {
constexpr int BM = 256, BK = 64, HALF = 128, HTB = HALF * BK * 2, STAGE_BYTES = 8 * HTB, NXCD = 8, WGM = 8;
__host__ __device__ __forceinline__ int lds_byte(int r, int c) { const int st = (r >> 4) * 2 + (c >> 5), rr = r & 15, cc = c & 31, ob = rr * 64 + cc * 2; return st * 1024 + (ob ^ (((ob >> 9) & 1) << 5)); }
__host__ __device__ __forceinline__ void stage_rc(int b, int& R, int& C) { const int st = b / 1024, sb = b % 1024, swz = sb ^ (((sb >> 9) & 1) << 5); R = (st >> 1) * 16 + swz / 64; C = (st & 1) * 32 + (swz % 64) / 2; }
__host__ __device__ __forceinline__ int perm32(int rho) { const int n = rho >> 4, i = rho & 15; return 8 * (i >> 2) + 4 * n + (i & 3); }

struct Unit { int pm, pn, z; };
struct Gemm {
    const bf16_t* A; const bf16_t* Bt; int lda, ldb, K, nM, nN, nZ, zdiv; long sAo, sAi, sBo, sBi, sCo, sCi;
    __device__ __forceinline__ long offA(const Unit& u) const { return (long)(u.z / zdiv) * sAo + (long)(u.z % zdiv) * sAi + (long)u.pm * BM * lda; }
    __device__ __forceinline__ long offB(const Unit& u) const { return (long)(u.z / zdiv) * sBo + (long)(u.z % zdiv) * sBi + (long)u.pn * BM * ldb; }
    __device__ __forceinline__ long offC(const Unit& u) const { return (long)(u.z / zdiv) * sCo + (long)(u.z % zdiv) * sCi; }
};
__device__ __forceinline__ Gemm make_gemm(const bf16_t* A, const bf16_t* Bt, int M, int N, int K, int lda, int ldb) {
    Gemm g; g.A = A; g.Bt = Bt; g.lda = lda; g.ldb = ldb; g.K = K; g.nM = M / BM; g.nN = N / BM; g.nZ = 1; g.zdiv = 1; g.sAo = g.sAi = g.sBo = g.sBi = g.sCo = g.sCi = 0; return g;
}
struct Order {
    int nM, nN, nwg, total, G, c;
    __device__ __forceinline__ void init(const Gemm& g, int G_, int c_) { nM = g.nM; nN = g.nN; nwg = nM * nN; total = nwg * g.nZ; G = G_; c = c_; }
    __device__ __forceinline__ bool next(int i, Unit& u) const {
        const long L = (long)i * G + c; if (L >= total) return false;
        u.z = (int)(L / nwg); int wgid = (int)(L % nwg);
        { const int q = nwg / NXCD, r = nwg % NXCD, xcd = wgid % NXCD, off = wgid / NXCD; wgid = (xcd < r ? xcd * (q + 1) : r * (q + 1) + (xcd - r) * q) + off; }
        const int nig = WGM * nN, gid = wgid / nig, fm = gid * WGM, gsz = (nM - fm) < WGM ? (nM - fm) : WGM;
        u.pm = fm + ((wgid % nig) % gsz); u.pn = (wgid % nig) / gsz; return true;
    }
};

__device__ __forceinline__ unsigned cvt_pk_bf16(float lo, float hi) { unsigned r; asm volatile("v_cvt_pk_bf16_f32 %0, %1, %2" : "=v"(r) : "v"(lo), "v"(hi)); return r; }

struct EpiBf16 {
    static constexpr bool PERM = true;
    bf16_t* O; int ldc; float scale;
    __device__ __forceinline__ void operator()(const f32x4 (&acc)[2][2][4][2], const Unit& u, long coff, int wr, int wc, int fr, int fq, LAS unsigned char* xl) const {
        const int row0 = u.pm * BM + wr * 64 + fr, col0 = u.pn * BM + wc * 32 + 8 * fq; bf16_t* base = O + coff;
#pragma unroll
        for (int ai = 0; ai < 2; ++ai)
#pragma unroll
            for (int m = 0; m < 4; ++m) { bf16_t* rowp = base + (size_t)(row0 + ai * HALF + m * 16) * ldc + col0;
#pragma unroll
                for (int bj = 0; bj < 2; ++bj) { const f32x4 v0 = acc[ai][bj][m][0] * scale, v1 = acc[ai][bj][m][1] * scale;
                    u32x4 w; w.x = cvt_pk_bf16(v0[0], v0[1]); w.y = cvt_pk_bf16(v0[2], v0[3]); w.z = cvt_pk_bf16(v1[0], v1[1]); w.w = cvt_pk_bf16(v1[2], v1[3]);
                    *(u32x4*)(rowp + bj * HALF) = w; } }
    }
};
struct EpiResid {
    static constexpr bool PERM = false;
    const float* base; float* out; int ldc;
    __device__ __forceinline__ void operator()(const f32x4 (&acc)[2][2][4][2], const Unit& u, long coff, int wr, int wc, int fr, int fq, LAS unsigned char* xl) const {
        const int col0 = u.pn * BM + wc * 32 + 4 * fq;
#pragma unroll
        for (int ai = 0; ai < 2; ++ai)
#pragma unroll
            for (int m = 0; m < 4; ++m) { const size_t off = (size_t)(u.pm * BM + ai * HALF + wr * 64 + m * 16 + fr) * ldc + col0;
#pragma unroll
                for (int bj = 0; bj < 2; ++bj)
#pragma unroll
                    for (int n = 0; n < 2; ++n) { const f32x4 bs = *(const f32x4*)(base + off + bj * HALF + n * 16); *(f32x4*)(out + off + bj * HALF + n * 16) = bs + acc[ai][bj][m][n]; } }
    }
};
struct EpiSwiglu {
    static constexpr bool PERM = true;
    bf16_t* O; int ldc;
    __device__ __forceinline__ void operator()(const f32x4 (&acc)[2][2][4][2], const Unit& u, long coff, int wr, int wc, int fr, int fq, LAS unsigned char* xl) const {
        const int row0 = u.pm * BM + wr * 64 + fr, col0 = u.pn * HALF + wc * 32 + 8 * fq;
#pragma unroll
        for (int ai = 0; ai < 2; ++ai)
#pragma unroll
            for (int m = 0; m < 4; ++m) { bf16_t* rowp = O + (size_t)(row0 + ai * HALF + m * 16) * ldc + col0; float r[8];
#pragma unroll
                for (int n = 0; n < 2; ++n)
#pragma unroll
                    for (int i = 0; i < 4; ++i) { const float g = acc[ai][0][m][n][i], uu = acc[ai][1][m][n][i]; r[n * 4 + i] = siluf_(g) * uu; }
                u32x4 w; w.x = cvt_pk_bf16(r[0], r[1]); w.y = cvt_pk_bf16(r[2], r[3]); w.z = cvt_pk_bf16(r[4], r[5]); w.w = cvt_pk_bf16(r[6], r[7]);
                *(u32x4*)rowp = w; }
    }
};
struct EpiSoftmax {
    static constexpr bool PERM = true;
    bf16_t* O; int ldc;
    __device__ __forceinline__ void operator()(f32x4 (&acc)[2][2][4][2], const Unit& u, long coff, int wr, int wc, int fr, int fq, LAS unsigned char* xl) const {
        LAS float* XM = (LAS float*)xl; LAS float* XS = (LAS float*)(xl + 4096);
#pragma unroll
        for (int ai = 0; ai < 2; ++ai)
#pragma unroll
            for (int m = 0; m < 4; ++m) { float mx = -3.0e38f;
#pragma unroll
                for (int bj = 0; bj < 2; ++bj)
#pragma unroll
                    for (int n = 0; n < 2; ++n)
#pragma unroll
                        for (int i = 0; i < 4; ++i) mx = fmaxf(mx, acc[ai][bj][m][n][i]);
                mx = fmaxf(mx, __shfl_xor(mx, 16)); mx = fmaxf(mx, __shfl_xor(mx, 32));
                if (fq == 0) XM[(ai * HALF + wr * 64 + m * 16 + fr) * 4 + wc] = mx; }
        LDS_WAIT(); __builtin_amdgcn_s_barrier(); asm volatile("" ::: "memory");
#pragma unroll
        for (int ai = 0; ai < 2; ++ai)
#pragma unroll
            for (int m = 0; m < 4; ++m) { const f32x4 mm = *(const LAS f32x4*)(XM + (ai * HALF + wr * 64 + m * 16 + fr) * 4);
                const float mx = fmaxf(fmaxf(mm[0], mm[1]), fmaxf(mm[2], mm[3])); float s = 0.f;
#pragma unroll
                for (int bj = 0; bj < 2; ++bj)
#pragma unroll
                    for (int n = 0; n < 2; ++n)
#pragma unroll
                        for (int i = 0; i < 4; ++i) { const float e = __expf(acc[ai][bj][m][n][i] - mx); acc[ai][bj][m][n][i] = e; s += e; }
                s += __shfl_xor(s, 16); s += __shfl_xor(s, 32);
                if (fq == 0) XS[(ai * HALF + wr * 64 + m * 16 + fr) * 4 + wc] = s; }
        LDS_WAIT(); __builtin_amdgcn_s_barrier(); asm volatile("" ::: "memory");
        const int row0 = u.pm * BM + wr * 64 + fr, col0 = wc * 32 + 8 * fq; bf16_t* base = O + coff;
#pragma unroll
        for (int ai = 0; ai < 2; ++ai)
#pragma unroll
            for (int m = 0; m < 4; ++m) { const f32x4 ss = *(const LAS f32x4*)(XS + (ai * HALF + wr * 64 + m * 16 + fr) * 4);
                const float inv = frcp((ss[0] + ss[1]) + (ss[2] + ss[3])); bf16_t* rowp = base + (size_t)(row0 + ai * HALF + m * 16) * ldc + col0;
#pragma unroll
                for (int bj = 0; bj < 2; ++bj) { const f32x4 v0 = acc[ai][bj][m][0] * inv, v1 = acc[ai][bj][m][1] * inv;
                    u32x4 w; w.x = cvt_pk_bf16(v0[0], v0[1]); w.y = cvt_pk_bf16(v0[2], v0[3]); w.z = cvt_pk_bf16(v1[0], v1[1]); w.w = cvt_pk_bf16(v1[2], v1[3]);
                    *(u32x4*)(rowp + bj * HALF) = w; } }
    }
};

template <class Epi, bool ALIGN_EPI>
__device__ __forceinline__ void gemm_phase(LAS unsigned char* lds, LAS unsigned char* xl, const Gemm g, const Order& S, Epi& E) {
    const int tid = threadIdx.x, wid = __builtin_amdgcn_readfirstlane(tid >> 6), lane = tid & 63, wr = wid >> 2, wc = wid & 3, fr = lane & 15, fq = lane >> 4;
    const int K = g.K, nt = K / BK;
    unsigned voffA[2], voffB[2];
#pragma unroll
    for (int i = 0; i < 2; ++i) { int R, C; stage_rc(tid * 16 + i * 8192, R, C); const int Rb = Epi::PERM ? ((R & ~31) + perm32(R & 31)) : R;
        voffA[i] = (unsigned)(R * g.lda + C) * 2u; voffB[i] = (unsigned)(Rb * g.ldb + C) * 2u; }
    const size_t kstep = (size_t)(BK * 2);
    const size_t hstepA = (size_t)HALF * g.lda * 2, hstepB = (size_t)HALF * g.ldb * 2;
    const unsigned ldsw = (unsigned)wid * 1024u;
    const int aoff = lds_byte(wr * 64 + fr, fq * 8), boff = lds_byte(wc * 32 + fr, fq * 8);
#define PG8_SA(b, h) (((b) * 2 + (h)) * HTB)
#define PG8_SB(b, h) ((4 + (b) * 2 + (h)) * HTB)
#define PG8_STAGE(bufoff, gbase, voff) do { _Pragma("unroll") for (int _i = 0; _i < 2; ++_i) \
        __builtin_amdgcn_global_load_lds((const unsigned*)((const char*)(gbase) + (voff)[_i]), (LAS unsigned*)(lds + (bufoff) + ldsw + _i * 8192), 16, 0, 0); } while (0)
#define PG8_LDA(dst, b, h) do { _Pragma("unroll") for (int m = 0; m < 4; ++m) _Pragma("unroll") for (int k = 0; k < 2; ++k) dst[m][k] = *(const LAS bf16x8*)(lds + PG8_SA(b, h) + aoff + m * 2048 + k * 1024); } while (0)
#define PG8_LDB(dst, b, h) do { _Pragma("unroll") for (int n = 0; n < 2; ++n) _Pragma("unroll") for (int k = 0; k < 2; ++k) dst[n][k] = *(const LAS bf16x8*)(lds + PG8_SB(b, h) + boff + n * 2048 + k * 1024); } while (0)
#define PG8_MMA(ai, bj, At, Bt) do { __builtin_amdgcn_s_setprio(1); _Pragma("unroll") for (int m = 0; m < 4; ++m) _Pragma("unroll") for (int n = 0; n < 2; ++n) _Pragma("unroll") for (int k = 0; k < 2; ++k) \
        acc[ai][bj][m][n] = __builtin_amdgcn_mfma_f32_16x16x32_bf16(Bt[n][k], At[m][k], acc[ai][bj][m][n], 0, 0, 0); __builtin_amdgcn_s_setprio(0); } while (0)
#define PG8_WAIT_V(n) asm volatile("s_waitcnt vmcnt(" #n ")" ::: "memory")
#define PG8_WAIT_L(n) asm volatile("s_waitcnt lgkmcnt(" #n ")" ::: "memory")
#define PG8_BAR __builtin_amdgcn_s_barrier()
#define PG8_SCHED __builtin_amdgcn_sched_barrier(0)
    Unit cur, nxt; int ui = 0;
    if (!S.next(0, cur)) return;
    f32x4 acc[2][2][4][2];
#pragma unroll
    for (int a = 0; a < 2; ++a)
#pragma unroll
        for (int b = 0; b < 2; ++b)
#pragma unroll
            for (int m = 0; m < 4; ++m)
#pragma unroll
                for (int n = 0; n < 2; ++n) acc[a][b][m][n] = (f32x4){0.f, 0.f, 0.f, 0.f};
    bf16x8 At[4][2], B0[2][2], B1[2][2];
    const char* cA = (const char*)g.A + 2 * g.offA(cur); const char* cB = (const char*)g.Bt + 2 * g.offB(cur);
    PG8_STAGE(PG8_SB(0, 0), cB, voffB); PG8_STAGE(PG8_SB(0, 1), cB + hstepB, voffB); PG8_STAGE(PG8_SA(0, 0), cA, voffA); PG8_STAGE(PG8_SA(0, 1), cA + hstepA, voffA);
    if (wr == 1) PG8_BAR;
    PG8_WAIT_V(2); PG8_BAR;
    PG8_STAGE(PG8_SB(1, 0), cB + kstep, voffB); PG8_STAGE(PG8_SA(1, 0), cA + kstep, voffA); PG8_STAGE(PG8_SB(1, 1), cB + hstepB + kstep, voffB);
    PG8_WAIT_V(6); PG8_BAR;
    for (;;) {
        const bool has_next = S.next(ui + 1, nxt);
        const char* nA = has_next ? (const char*)g.A + 2 * g.offA(nxt) : cA; const char* nB = has_next ? (const char*)g.Bt + 2 * g.offB(nxt) : cB;
        for (int t = 0; t < nt; t += 2) {
            const bool last = (t == nt - 2);
            const char* a1 = cA + (size_t)(t + 1) * kstep;
            const char* a2 = last ? nA : cA + (size_t)(t + 2) * kstep; const char* b2 = last ? nB : cB + (size_t)(t + 2) * kstep;
            const char* a3 = a2 + kstep; const char* b3 = b2 + kstep;
            PG8_LDB(B0, 0, 0); PG8_LDB(B1, 0, 1); PG8_SCHED; PG8_LDA(At, 0, 0); PG8_STAGE(PG8_SA(1, 1), a1 + hstepA, voffA);
            PG8_WAIT_V(8); PG8_WAIT_L(0); PG8_BAR; PG8_MMA(0, 0, At, B0); PG8_MMA(0, 1, At, B1); PG8_BAR; PG8_SCHED;
            PG8_LDA(At, 0, 1); PG8_STAGE(PG8_SB(0, 0), b2, voffB); PG8_STAGE(PG8_SB(0, 1), b2 + hstepB, voffB); PG8_STAGE(PG8_SA(0, 0), a2, voffA);
            PG8_WAIT_V(8); PG8_WAIT_L(0); PG8_BAR; PG8_MMA(1, 0, At, B0); PG8_MMA(1, 1, At, B1); PG8_BAR; PG8_SCHED;
            PG8_LDB(B0, 1, 0); PG8_LDB(B1, 1, 1); PG8_SCHED; PG8_LDA(At, 1, 0); PG8_STAGE(PG8_SA(0, 1), a2 + hstepA, voffA);
            PG8_WAIT_V(8); PG8_WAIT_L(0); PG8_BAR; PG8_MMA(0, 0, At, B0); PG8_MMA(0, 1, At, B1); PG8_BAR; PG8_SCHED;
            PG8_LDA(At, 1, 1); PG8_STAGE(PG8_SB(1, 0), b3, voffB); PG8_STAGE(PG8_SB(1, 1), b3 + hstepB, voffB); PG8_STAGE(PG8_SA(1, 0), a3, voffA);
            PG8_WAIT_V(8); PG8_WAIT_L(0); PG8_BAR; PG8_MMA(1, 0, At, B0); PG8_MMA(1, 1, At, B1); PG8_BAR; PG8_SCHED;
        }
        if constexpr (ALIGN_EPI) { if (wr == 0) PG8_BAR; }
        E(acc, cur, g.offC(cur), wr, wc, fr, fq, xl);
        if (!has_next) break;
#pragma unroll
        for (int a = 0; a < 2; ++a)
#pragma unroll
            for (int b = 0; b < 2; ++b)
#pragma unroll
                for (int m = 0; m < 4; ++m)
#pragma unroll
                    for (int n = 0; n < 2; ++n) acc[a][b][m][n] = (f32x4){0.f, 0.f, 0.f, 0.f};
        cur = nxt; cA = nA; cB = nB; ++ui;
        if constexpr (ALIGN_EPI) { if (wr == 1) PG8_BAR; }
    }
    PG8_WAIT_V(0);
    if constexpr (!ALIGN_EPI) { if (wr == 0) PG8_BAR; }
    PG8_BAR;
#undef PG8_SA
#undef PG8_SB
#undef PG8_STAGE
#undef PG8_LDA
#undef PG8_LDB
#undef PG8_MMA
#undef PG8_WAIT_V
#undef PG8_WAIT_L
#undef PG8_BAR
#undef PG8_SCHED
}
}

__device__ __forceinline__ f32x4 mfma16(bf16x8 bfrag, bf16x8 afrag, f32x4 acc) { return __builtin_amdgcn_mfma_f32_16x16x32_bf16(bfrag, afrag, acc, 0, 0, 0); }
__device__ __forceinline__ bf16x8 ldsfrag(const LAS bf16_t* base, int ld, int r0, int k0, int fr, int fq) { return *(const LAS bf16x8*)(base + (r0 + fr) * ld + k0 + fq * 8); }

template <int MODE> __device__ __forceinline__ void transpose_item(const float* W, int K, int N, bf16_t* WT, LAS float* scr, int item, int nblk, int lane) {
    const int kb = item / nblk, nb = item % nblk, k0 = 64 * kb, n0 = 32 * nb; const int nsrc = n0 + (lane & 31);
#pragma unroll 8
    for (int i = 0; i < 32; ++i) { const int kk = 2 * i + (lane >> 5); scr[kk * 33 + (lane & 31)] = (nsrc < N) ? W[(size_t)(k0 + kk) * N + nsrc] : 0.f; }
    LDS_WAIT();
    const int c = lane & 7;
#pragma unroll
    for (int j = 0; j < 4; ++j) { const int n = (lane >> 3) + 8 * j; const LAS float* s = scr + (8 * c) * 33 + n;
        u32x4 o; o.x = pk2(s[0 * 33], s[1 * 33]); o.y = pk2(s[2 * 33], s[3 * 33]); o.z = pk2(s[4 * 33], s[5 * 33]); o.w = pk2(s[6 * 33], s[7 * 33]);
        int drow = n0 + n; if (MODE == 1) { const int jn = drow % FFN, isu = drow / FFN; drow = (jn / 128) * 256 + isu * 128 + (jn % 128); }
        *(u32x4*)(WT + (size_t)drow * K + k0 + 8 * c) = o; }
    LDS_WAIT();
}
__device__ __forceinline__ void rms_row_bf16(const float* xrow, const float* gain, bf16_t* orow, int lane) {
    const f32x4* xr = (const f32x4*)xrow + lane; f32x4 v[4]; float s = 0.f;
#pragma unroll
    for (int j = 0; j < 4; ++j) { v[j] = xr[64 * j]; s += (v[j].x * v[j].x + v[j].y * v[j].y) + (v[j].z * v[j].z + v[j].w * v[j].w); }
    const float rs = rsqrtf(wave_sum(s) * (1.f / D) + 1e-6f);
    const f32x4* gr = (const f32x4*)gain + lane; u32x2* o8 = (u32x2*)orow + lane;
#pragma unroll
    for (int j = 0; j < 4; ++j) { const f32x4 g = gr[64 * j]; u32x2 w; w.x = pk2(v[j].x * rs * g.x, v[j].y * rs * g.y); w.y = pk2(v[j].z * rs * g.z, v[j].w * rs * g.w); o8[64 * j] = w; }
}
__device__ __forceinline__ void rms_rows_phase(const float* X, const float* gain, bf16_t* H, int nrows, int gw, int NGW, int lane) {
    for (int m = gw; m < nrows; m += NGW) rms_row_bf16(X + (size_t)m * D, gain, H + (size_t)m * D, lane);
}

__device__ __forceinline__ void rwkv_chain(LAS unsigned char* lds, int cid, const bf16_t* P0, const float* mu, const float* w0, const float* w2, const float* a0, const float* a2,
                                           const float* k_k, const float* k_a, const float* r_k, bf16_t* ORW, bf16_t* SG, float* BONUS) {
    const int tid = threadIdx.x, lane = tid & 63, wid = tid >> 6, fr = lane & 15, fq = lane >> 4;
    const int b = cid >> 4, h = (cid >> 1) & 7, dir = cid & 1;
    LAS float* rS = (LAS float*)(lds); LAS float* kS = (LAS float*)(lds + 8192); LAS float* vS = (LAS float*)(lds + 16384); LAS float* wS = (LAS float*)(lds + 24576);
    LAS float* nkS = (LAS float*)(lds + 32768); LAS float* bS = (LAS float*)(lds + 40960); LAS float* preA = (LAS float*)(lds + 49152); LAS float* preW = (LAS float*)(lds + 57344);
    LAS float* oS = (LAS float*)(lds + 106496); LAS bf16_t* adB = (LAS bf16_t*)(lds + 73728); LAS bf16_t* wdB = (LAS bf16_t*)(lds + 78336);
    LAS bf16_t* a2B = (LAS bf16_t*)(lds + 82944); LAS bf16_t* w2B = (LAS bf16_t*)(lds + 92160); LAS float* cst = (LAS float*)(lds + 101376);
    __syncthreads();
    for (int e = tid; e < 64 * 64; e += 512) { const int j = e & 63, r = e >> 6;
        a2B[j * 72 + r] = (bf16_t)f2bf(a2[r * 512 + h * 64 + j]); w2B[j * 72 + r] = (bf16_t)f2bf(w2[(dir * 64 + r) * 512 + h * 64 + j]); }
    if (tid < 64) { const int j = tid, c = h * 64 + j;
        cst[0 * 64 + j] = a0[c]; cst[1 * 64 + j] = w0[dir * 512 + c]; cst[2 * 64 + j] = k_k[c]; cst[3 * 64 + j] = k_a[c]; cst[4 * 64 + j] = r_k[c];
        cst[5 * 64 + j] = mu[c]; cst[6 * 64 + j] = mu[512 + c]; cst[7 * 64 + j] = mu[1024 + c]; cst[8 * 64 + j] = mu[1536 + j]; cst[9 * 64 + j] = mu[1600 + j];
        cst[10 * 64 + j] = (j < 16) ? mu[1664 + h * 16 + j] : 0.f; }
    f32x2 Sa0 = (f32x2){0.f, 0.f}, Sa1 = Sa0, Sb0 = Sa0, Sb1 = Sa0;
    const int rp2 = tid >> 4, part = tid & 15;
    __syncthreads();
    const bf16_t* Pb = P0 + (size_t)b * SEQ * ABPAD;
    unsigned rc[10], rpv[10], rnx[10]; unsigned short gcv = 0, gpv = 0, gnv = 0;
#define RW_IDX(i) const int grp = (i) >> 1; const int idx_ = tid + 512 * ((i) & 1); const int tok = idx_ >> 5, c2 = (idx_ & 31) * 2; \
                  const int gcol = (grp == 0 ? h * 64 : grp == 1 ? 512 + h * 64 : grp == 2 ? 1024 + h * 64 : grp == 3 ? 1536 : 1600) + c2;
#define RW_ISSUE(t0n) do { _Pragma("unroll") for (int i = 0; i < 10; ++i) { RW_IDX(i) const int t = (t0n) + tok; const bf16_t* p = Pb + (size_t)t * ABPAD + gcol; \
            rc[i] = *(const unsigned*)p; rpv[i] = (t > 0) ? *(const unsigned*)(p - ABPAD) : 0u; rnx[i] = (t < SEQ - 1) ? *(const unsigned*)(p + ABPAD) : 0u; } \
        if (dir == 0) { const int tok = tid >> 4, c = tid & 15, t = (t0n) + tok; const bf16_t* p = Pb + (size_t)t * ABPAD + 1664 + h * 16 + c; \
            gcv = *p; gpv = (t > 0) ? *(p - ABPAD) : (unsigned short)0; gnv = (t < SEQ - 1) ? *(p + ABPAD) : (unsigned short)0; } } while (0)
    RW_ISSUE(dir ? 127 * 32 : 0);
    for (int cc = 0; cc < 128; ++cc) {
        const int t0 = dir ? (127 - cc) * 32 : cc * 32;
#pragma unroll
        for (int i = 0; i < 10; ++i) { RW_IDX(i) (void)gcol;
            const unsigned cur = rc[i], prv = rpv[i], nxt = rnx[i];
            const float m0 = cst[(5 + grp) * 64 + c2], m1 = cst[(5 + grp) * 64 + c2 + 1];
            const float c0 = bflo(cur), c1 = bfhi(cur);
            const float x0 = c0 + m0 * (0.5f * (bflo(prv) + bflo(nxt)) - c0), x1 = c1 + m1 * (0.5f * (bfhi(prv) + bfhi(nxt)) - c1);
            if (grp == 0) { *(LAS f32x2*)(rS + tok * 64 + c2) = (f32x2){x0, x1}; }
            else if (grp == 1) { *(LAS f32x2*)(kS + tok * 64 + c2) = (f32x2){x0, x1}; }
            else if (grp == 2) { *(LAS f32x2*)(vS + tok * 64 + c2) = (f32x2){x0, x1}; }
            else if (grp == 3) { const float e0 = __expf(2.f * x0), e1 = __expf(2.f * x1); *(LAS unsigned*)(wdB + tok * 72 + c2) = pk2(1.f - 2.f * frcp(e0 + 1.f), 1.f - 2.f * frcp(e1 + 1.f)); }
            else { *(LAS unsigned*)(adB + tok * 72 + c2) = pk2(x0, x1); }
        }
        if (dir == 0) {
            const int tok = tid >> 4, c = tid & 15, t = t0 + tok;
            const float cur = bf2f(gcv), prv = bf2f(gpv), nxt = bf2f(gnv);
            const float x = cur + cst[10 * 64 + c] * (0.5f * (prv + nxt) - cur);
            SG[((size_t)b * SEQ + t) * 128 + h * 16 + c] = (bf16_t)f2bf(sigmoidf_(x));
        }
        __syncthreads();
        if (cc + 1 < 128) { const int t0n = dir ? (126 - cc) * 32 : (cc + 1) * 32; RW_ISSUE(t0n); }
        { const int mat = wid >> 2, ntile = wid & 3; const LAS bf16_t* Aop = mat ? wdB : adB; const LAS bf16_t* Bop = mat ? w2B : a2B; LAS float* pre = mat ? preW : preA;
#pragma unroll
          for (int mt = 0; mt < 2; ++mt) { f32x4 acc = (f32x4){0.f, 0.f, 0.f, 0.f};
#pragma unroll
              for (int ks = 0; ks < 2; ++ks) acc = mfma16(ldsfrag(Bop, 72, ntile * 16, ks * 32, fr, fq), ldsfrag(Aop, 72, mt * 16, ks * 32, fr, fq), acc);
              *(LAS f32x4*)(pre + (mt * 16 + fr) * 64 + ntile * 16 + fq * 4) = acc; } }
        __syncthreads();
        { const int tok = tid >> 4, c0 = (tid & 15) * 4; float kkr[4], av[4], kp[4], wv[4]; float ss = 0.f, bon = 0.f;
#pragma unroll
          for (int i = 0; i < 4; ++i) { const int c = c0 + i, ix = tok * 64 + c;
              const float a = sigmoidf_(cst[c] + preA[ix]); const float sg = sigmoidf_(cst[64 + c] + preW[ix]);
              wv[i] = __expf(-0.60653065971f * sg);
              const float kraw = kS[ix]; kkr[i] = kraw * cst[128 + c]; ss += kkr[i] * kkr[i];
              kp[i] = kraw * (1.0f + (a - 1.0f) * cst[192 + c]); av[i] = a; bon += rS[ix] * kp[i] * cst[256 + c]; }
          ss += dppf<0xB1>(ss); bon += dppf<0xB1>(bon); ss += dppf<0x4E>(ss); bon += dppf<0x4E>(bon);
          ss += dppf<0x141>(ss); bon += dppf<0x141>(bon); ss += dppf<0x140>(ss); bon += dppf<0x140>(bon);
          const float inv = frcp(fmaxf(__builtin_amdgcn_sqrtf(ss), 1e-12f));
          f32x4 o_nk, o_b, o_k, o_w;
#pragma unroll
          for (int i = 0; i < 4; ++i) { const float kk = kkr[i] * inv; o_nk[i] = -kk; o_b[i] = kk * av[i]; o_k[i] = kp[i]; o_w[i] = wv[i]; }
          *(LAS f32x4*)(nkS + tok * 64 + c0) = o_nk; *(LAS f32x4*)(bS + tok * 64 + c0) = o_b; *(LAS f32x4*)(kS + tok * 64 + c0) = o_k; *(LAS f32x4*)(wS + tok * 64 + c0) = o_w;
          if (dir == 0 && (tid & 15) == 0) BONUS[((size_t)b * SEQ + t0 + tok) * 8 + h] = bon; }
        __syncthreads();
#pragma unroll 4
        for (int s = 0; s < 32; ++s) {
            const int tt = dir ? 31 - s : s; const int o4 = tt * 64 + part * 4;
            const f32x4 wv = *(const LAS f32x4*)(wS + o4), nv = *(const LAS f32x4*)(nkS + o4), bv = *(const LAS f32x4*)(bS + o4), kv = *(const LAS f32x4*)(kS + o4), rv = *(const LAS f32x4*)(rS + o4);
            const f32x2 vv = *(const LAS f32x2*)(vS + tt * 64 + 2 * rp2);
            const f32x2 w0 = (f32x2){wv[0], wv[1]}, w1 = (f32x2){wv[2], wv[3]}, n0 = (f32x2){nv[0], nv[1]}, n1 = (f32x2){nv[2], nv[3]};
            const f32x2 b0 = (f32x2){bv[0], bv[1]}, b1 = (f32x2){bv[2], bv[3]}, k0 = (f32x2){kv[0], kv[1]}, k1 = (f32x2){kv[2], kv[3]}, r0 = (f32x2){rv[0], rv[1]}, r1 = (f32x2){rv[2], rv[3]};
            const f32x2 pa = Sa0 * n0 + Sa1 * n1, pb = Sb0 * n0 + Sb1 * n1;
            float saA = pa.x + pa.y, saB = pb.x + pb.y;
            saA += dppf<0xB1>(saA); saB += dppf<0xB1>(saB); saA += dppf<0x4E>(saA); saB += dppf<0x4E>(saB);
            saA += dppf<0x141>(saA); saB += dppf<0x141>(saB); saA += dppf<0x140>(saA); saB += dppf<0x140>(saB);
            const f32x2 sA = (f32x2){saA, saA}, sB = (f32x2){saB, saB}, vA = (f32x2){vv.x, vv.x}, vB = (f32x2){vv.y, vv.y};
            Sa0 = Sa0 * w0 + (b0 * sA + k0 * vA); Sa1 = Sa1 * w1 + (b1 * sA + k1 * vA);
            Sb0 = Sb0 * w0 + (b0 * sB + k0 * vB); Sb1 = Sb1 * w1 + (b1 * sB + k1 * vB);
            const f32x2 qa = Sa0 * r0 + Sa1 * r1, qb = Sb0 * r0 + Sb1 * r1;
            float oA = qa.x + qa.y, oB = qb.x + qb.y;
            oA += dppf<0xB1>(oA); oB += dppf<0xB1>(oB); oA += dppf<0x4E>(oA); oB += dppf<0x4E>(oB);
            if ((part & 3) == 0) *(LAS f32x2*)(oS + (part >> 2) * 2048 + tt * 64 + 2 * rp2) = (f32x2){oA, oB};
        }
        __syncthreads();
        { const int tok = tid >> 4, c0 = (tid & 15) * 4; const f32x4 o = (*(const LAS f32x4*)(oS + tok * 64 + c0) + *(const LAS f32x4*)(oS + 2048 + tok * 64 + c0)) + (*(const LAS f32x4*)(oS + 4096 + tok * 64 + c0) + *(const LAS f32x4*)(oS + 6144 + tok * 64 + c0));
          u32x2 w; w.x = pk2(o[0], o[1]); w.y = pk2(o[2], o[3]);
          *(u32x2*)(ORW + (size_t)dir * T * 512 + ((size_t)b * SEQ + t0 + tok) * 512 + h * 64 + c0) = w; }
    }
#undef RW_IDX
#undef RW_ISSUE
    __syncthreads();
}

__device__ __forceinline__ void rwkv_combine(const bf16_t* P0, const bf16_t* ORW, const float* BONUS, const bf16_t* G, const float* mu, const float* gn_w, const float* gn_b, bf16_t* OMIX, int gw, int NGW, int lane) {
    const int c0 = lane * 8, head = lane >> 3;
    float muv[8], gw8[8], gb8[8];
#pragma unroll
    for (int i = 0; i < 8; ++i) { muv[i] = mu[1024 + c0 + i]; gw8[i] = gn_w[c0 + i]; gb8[i] = gn_b[c0 + i]; }
    for (int tk = gw; tk < T; tk += NGW) {
        const int t = tk & (SEQ - 1);
        const u32x4 uf = *(const u32x4*)(ORW + (size_t)tk * 512 + c0), ub = *(const u32x4*)(ORW + (size_t)T * 512 + (size_t)tk * 512 + c0);
        float o[8];
#pragma unroll
        for (int i = 0; i < 4; ++i) { o[2 * i] = bflo(uf[i]) + bflo(ub[i]); o[2 * i + 1] = bfhi(uf[i]) + bfhi(ub[i]); }
        float s = 0.f;
#pragma unroll
        for (int i = 0; i < 8; ++i) s += o[i];
        const float mean = sum8(s) * (1.f / 64.f); float q = 0.f;
#pragma unroll
        for (int i = 0; i < 8; ++i) { o[i] -= mean; q += o[i] * o[i]; }
        const float rstd = rsqrtf(sum8(q) * (1.f / 64.f) + 64e-5f);
        const bf16_t* pv = P0 + (size_t)tk * ABPAD + 1024 + c0;
        const u32x4 vc = *(const u32x4*)pv; u32x4 vp = (u32x4){0u, 0u, 0u, 0u}, vn = (u32x4){0u, 0u, 0u, 0u};
        if (t > 0) vp = *(const u32x4*)(pv - ABPAD);
        if (t < SEQ - 1) vn = *(const u32x4*)(pv + ABPAD);
        const u32x4 gg = *(const u32x4*)(G + (size_t)tk * 512 + c0);
        const float bon = BONUS[(size_t)tk * 8 + head];
        float r[8];
#pragma unroll
        for (int i = 0; i < 4; ++i) {
            const float c_lo = bflo(vc[i]), c_hi = bfhi(vc[i]);
            const float v_lo = c_lo + muv[2 * i] * (0.5f * (bflo(vp[i]) + bflo(vn[i])) - c_lo), v_hi = c_hi + muv[2 * i + 1] * (0.5f * (bfhi(vp[i]) + bfhi(vn[i])) - c_hi);
            r[2 * i] = (o[2 * i] * rstd * gw8[2 * i] + gb8[2 * i] + bon * v_lo) * bflo(gg[i]);
            r[2 * i + 1] = (o[2 * i + 1] * rstd * gw8[2 * i + 1] + gb8[2 * i + 1] + bon * v_hi) * bfhi(gg[i]); }
        u32x4 w; w.x = pk2(r[0], r[1]); w.y = pk2(r[2], r[3]); w.z = pk2(r[4], r[5]); w.w = pk2(r[6], r[7]);
        *(u32x4*)(OMIX + (size_t)tk * D + c0) = w;
    }
}

constexpr int SLD = 136;
__device__ __forceinline__ float softplusf_(float x) { return x > 20.f ? x : log1pf(__expf(x)); }
__device__ __forceinline__ void ssd_dt_cum(LAS float* dtS, LAS float* cumS, LAS float* totS, const bf16_t* Prow0, int g, int w, int lane, const float* dt_bias, const float* a_log) {
    const int j = w >> 1, d = w & 1, head = g * 4 + j;
    const float bias = dt_bias[d * 8 + head], A = -__expf(a_log[d * 8 + head]);
    const float x0 = bf2f(Prow0[(size_t)(2 * lane) * ABPAD + 3328 + head]), x1 = bf2f(Prow0[(size_t)(2 * lane + 1) * ABPAD + 3328 + head]);
    const float dt0 = softplusf_(x0 + bias), dt1 = softplusf_(x1 + bias), la0 = dt0 * A, la1 = dt1 * A;
    const float s = la0 + la1; float inc = s;
#pragma unroll
    for (int off = 1; off < 64; off <<= 1) { const float n = __shfl_up(inc, off); if (lane >= off) inc += n; }
    const float tot = __shfl(inc, 63), exc = inc - s;
    float c0, c1; if (d == 0) { c0 = exc + la0; c1 = inc; } else { c0 = tot - exc; c1 = tot - exc - la0; }
    dtS[w * 128 + 2 * lane] = dt0; dtS[w * 128 + 2 * lane + 1] = dt1; cumS[w * 128 + 2 * lane] = c0; cumS[w * 128 + 2 * lane + 1] = c1;
    if (lane == 0) totS[w] = tot;
}
template <int NR, bool TR> __device__ __forceinline__ void ssd_conv_col(LAS bf16_t* dst, int col, int cx, int l0, const bf16_t* Pb, int t0, const float* cw, const float* cb) {
    const float w0 = cw[cx], w1 = cw[1024 + cx], w2 = cw[2048 + cx], bias = cb[cx];
    const bf16_t* p = Pb + (size_t)(t0 + l0) * ABPAD + 2304 + cx;
    float um = (t0 + l0 > 0) ? bf2f(*(p - ABPAD)) : 0.f, u0 = bf2f(*p);
#pragma unroll 4
    for (int i = 0; i < NR; i += 2) {
        const int t = t0 + l0 + i;
        const float u1 = bf2f(*(p + (size_t)(i + 1) * ABPAD));
        const float u2 = (t + 2 < SEQ) ? bf2f(*(p + (size_t)(i + 2) * ABPAD)) : 0.f;
        float va = w0 * um + w1 * u0 + w2 * u1 + bias, vb = w0 * u0 + w1 * u1 + w2 * u2 + bias;
        va = siluf_(va); vb = siluf_(vb);
        if (TR) *(LAS unsigned*)(dst + col * SLD + l0 + i) = pk2(va, vb);
        else { dst[(l0 + i) * SLD + col] = (bf16_t)f2bf(va); dst[(l0 + i + 1) * SLD + col] = (bf16_t)f2bf(vb); }
        um = u1; u0 = u2;
    }
}
__device__ __forceinline__ void ssd_s1_unit(LAS unsigned char* lds, int unit, const bf16_t* P0, const float* cw, const float* cb, const float* dt_bias, const float* a_log, bf16_t* STATES, float* TOT) {
    const int tid = threadIdx.x, lane = tid & 63, w = tid >> 6, fr = lane & 15, fq = lane >> 4;
    const int g = unit & 1, c = (unit >> 1) & 31, b = unit >> 6, t0 = c * 128;
    LAS bf16_t* BT = (LAS bf16_t*)lds; LAS bf16_t* XT = (LAS bf16_t*)(lds + 34816); LAS float* dtS = (LAS float*)(lds + 104448); LAS float* cumS = (LAS float*)(lds + 108544);
    LAS float* scS = (LAS float*)(lds + 112640); LAS float* totS = (LAS float*)(lds + 116736);
    const bf16_t* Pb = P0 + (size_t)b * SEQ * ABPAD;
    __syncthreads();
    ssd_conv_col<32, true>(BT, tid & 127, 512 + g * 128 + (tid & 127), (tid >> 7) * 32, Pb, t0, cw, cb);
    ssd_conv_col<64, true>(XT, tid & 255, g * 256 + (tid & 255), (tid >> 8) * 64, Pb, t0, cw, cb);
    ssd_dt_cum(dtS, cumS, totS, Pb + (size_t)t0 * ABPAD, g, w, lane, dt_bias, a_log);
    __syncthreads();
    for (int e = tid; e < 1024; e += 512) scS[e] = dtS[e] * __expf(totS[e >> 7] - cumS[e]);
    if (tid < 8) TOT[((size_t)(b * 32 + c) * 2 + (tid & 1)) * 8 + g * 4 + (tid >> 1)] = totS[tid];
    __syncthreads();
    const int j = w >> 1;
#pragma unroll 1
    for (int d = 0; d < 2; ++d) {
        f32x4 acc[2][8];
#pragma unroll
        for (int mt = 0; mt < 2; ++mt)
#pragma unroll
            for (int nt = 0; nt < 8; ++nt) acc[mt][nt] = (f32x4){0.f, 0.f, 0.f, 0.f};
#pragma unroll 1
        for (int ks = 0; ks < 4; ++ks) {
            const int k0 = ks * 32; const LAS float* sp = scS + (j * 2 + d) * 128 + k0 + fq * 8;
            const f32x4 s0 = *(const LAS f32x4*)sp, s1 = *(const LAS f32x4*)(sp + 4);
            bf16x8 afr[2];
#pragma unroll
            for (int mt = 0; mt < 2; ++mt) { const u32x4 raw = *(const LAS u32x4*)(XT + (32 * w + mt * 16 + fr) * SLD + k0 + fq * 8); u32x4 o;
                o.x = pk2(bflo(raw.x) * s0[0], bfhi(raw.x) * s0[1]); o.y = pk2(bflo(raw.y) * s0[2], bfhi(raw.y) * s0[3]);
                o.z = pk2(bflo(raw.z) * s1[0], bfhi(raw.z) * s1[1]); o.w = pk2(bflo(raw.w) * s1[2], bfhi(raw.w) * s1[3]);
                afr[mt] = __builtin_bit_cast(bf16x8, o); }
#pragma unroll
            for (int nt = 0; nt < 8; ++nt) { const bf16x8 bfr = ldsfrag(BT, SLD, nt * 16, k0, fr, fq);
#pragma unroll
                for (int mt = 0; mt < 2; ++mt) acc[mt][nt] = mfma16(bfr, afr[mt], acc[mt][nt]); }
        }
        bf16_t* dst = STATES + (((size_t)(b * 32 + c) * 2 + d) * 8 + g * 4 + j) * 8192;
#pragma unroll
        for (int mt = 0; mt < 2; ++mt) { const int p = (w & 1) * 32 + mt * 16 + fr;
#pragma unroll
            for (int nt = 0; nt < 8; ++nt) { u32x2 o; o.x = pk2(acc[mt][nt][0], acc[mt][nt][1]); o.y = pk2(acc[mt][nt][2], acc[mt][nt][3]);
                *(u32x2*)(dst + p * 128 + nt * 16 + fq * 4) = o; } }
    }
}
__device__ __forceinline__ void ssd_s2(bf16_t* STATES, const float* TOT, int gtid, int NGT) {
    for (int it = gtid; it < 16 * 2 * 8 * 1024; it += NGT) {
        const int e8 = it & 1023, head = (it >> 10) & 7, d = (it >> 13) & 1, b = it >> 14;
        float run[8];
#pragma unroll
        for (int i = 0; i < 8; ++i) run[i] = 0.f;
#pragma unroll 2
        for (int cc = 0; cc < 32; ++cc) {
            const int c = d ? 31 - cc : cc; const size_t sidx = ((size_t)(b * 32 + c) * 2 + d) * 8 + head;
            u32x4* p = (u32x4*)(STATES + sidx * 8192 + e8 * 8); const u32x4 loc = *p; const float dec = __expf(TOT[sidx]);
            u32x4 o; o.x = pk2(run[0], run[1]); o.y = pk2(run[2], run[3]); o.z = pk2(run[4], run[5]); o.w = pk2(run[6], run[7]); *p = o;
#pragma unroll
            for (int i = 0; i < 4; ++i) { run[2 * i] = run[2 * i] * dec + bflo(loc[i]); run[2 * i + 1] = run[2 * i + 1] * dec + bfhi(loc[i]); }
        }
    }
}
__device__ __forceinline__ void ssd_s3_unit(LAS unsigned char* lds, int unit, const bf16_t* P0, const float* cw, const float* cb, const float* dt_bias, const float* a_log, const float* dskip, const float* norm_w,
                                            const bf16_t* STATES, bf16_t* OMIX) {
    const int tid = threadIdx.x, lane = tid & 63, w = tid >> 6, fr = lane & 15, fq = lane >> 4;
    const int g = unit & 1, c = (unit >> 1) & 31, b = unit >> 6, t0 = c * 128;
    LAS bf16_t* CS = (LAS bf16_t*)lds; LAS bf16_t* BS = (LAS bf16_t*)(lds + 34816); LAS bf16_t* XT = (LAS bf16_t*)(lds + 69632);
    LAS float* dtS = (LAS float*)(lds + 139264); LAS float* cumS = (LAS float*)(lds + 143360); LAS float* totS = (LAS float*)(lds + 147456);
    const bf16_t* Pb = P0 + (size_t)b * SEQ * ABPAD;
    __syncthreads();
    ssd_conv_col<32, false>(BS, tid & 127, 512 + g * 128 + (tid & 127), (tid >> 7) * 32, Pb, t0, cw, cb);
    ssd_conv_col<32, false>(CS, tid & 127, 768 + g * 128 + (tid & 127), (tid >> 7) * 32, Pb, t0, cw, cb);
    ssd_conv_col<64, true>(XT, tid & 255, g * 256 + (tid & 255), (tid >> 8) * 64, Pb, t0, cw, cb);
    ssd_dt_cum(dtS, cumS, totS, Pb + (size_t)t0 * ABPAD, g, w, lane, dt_bias, a_log);
    __syncthreads();
    const int l = 16 * w + fr;
    f32x4 sc[8];
#pragma unroll
    for (int nt = 0; nt < 8; ++nt) sc[nt] = (f32x4){0.f, 0.f, 0.f, 0.f};
#pragma unroll
    for (int ks = 0; ks < 4; ++ks) { const bf16x8 afr = ldsfrag(CS, SLD, 16 * w, ks * 32, fr, fq);
#pragma unroll
        for (int nt = 0; nt < 8; ++nt) sc[nt] = mfma16(ldsfrag(BS, SLD, nt * 16, ks * 32, fr, fq), afr, sc[nt]); }
    __syncthreads();
    LAS bf16_t* Mw = BS + w * 16 * SLD;
    const size_t row = (size_t)b * SEQ + t0 + l; float ss = 0.f;
#pragma unroll 1
    for (int j = 0; j < 4; ++j) {
        const LAS float* cf = cumS + (j * 2) * 128; const LAS float* cbw = cumS + (j * 2 + 1) * 128; const LAS float* df = dtS + (j * 2) * 128; const LAS float* db = dtS + (j * 2 + 1) * 128;
        const float cfl = cf[l], cbl = cbw[l];
#pragma unroll
        for (int nt = 0; nt < 8; ++nt) { float mv[4];
#pragma unroll
            for (int i = 0; i < 4; ++i) { const int s = nt * 16 + fq * 4 + i;
                const float ff = (s <= l) ? __expf(cfl - cf[s]) * df[s] : 0.f; const float fb = (s >= l) ? __expf(cbl - cbw[s]) * db[s] : 0.f;
                mv[i] = sc[nt][i] * (ff + fb); }
            u32x2 o; o.x = pk2(mv[0], mv[1]); o.y = pk2(mv[2], mv[3]); *(LAS u32x2*)(Mw + fr * SLD + nt * 16 + fq * 4) = o; }
        LDS_WAIT();
        f32x4 yd[4], yf[4], yb[4];
#pragma unroll
        for (int pt = 0; pt < 4; ++pt) { yd[pt] = (f32x4){0.f, 0.f, 0.f, 0.f}; yf[pt] = yd[pt]; yb[pt] = yd[pt]; }
        const size_t sbase = ((size_t)(b * 32 + c) * 2) * 8 + g * 4 + j;
        const bf16_t* carf = STATES + sbase * 8192; const bf16_t* carb = STATES + (sbase + 8) * 8192;
#pragma unroll 1
        for (int ks = 0; ks < 4; ++ks) {
            const bf16x8 am = *(const LAS bf16x8*)(Mw + fr * SLD + ks * 32 + fq * 8); const bf16x8 ac = ldsfrag(CS, SLD, 16 * w, ks * 32, fr, fq);
#pragma unroll
            for (int pt = 0; pt < 4; ++pt) {
                yd[pt] = mfma16(ldsfrag(XT, SLD, j * 64 + pt * 16, ks * 32, fr, fq), am, yd[pt]);
                const bf16x8 bfv = *(const bf16x8*)(carf + (pt * 16 + fr) * 128 + ks * 32 + fq * 8), bbv = *(const bf16x8*)(carb + (pt * 16 + fr) * 128 + ks * 32 + fq * 8);
                yf[pt] = mfma16(bfv, ac, yf[pt]); yb[pt] = mfma16(bbv, ac, yb[pt]); }
        }
        const float ef = __expf(cfl), eb = __expf(cbl), dsk = dskip[g * 4 + j];
#pragma unroll
        for (int pt = 0; pt < 4; ++pt) { const f32x4 yv = yd[pt] + yf[pt] * ef + yb[pt] * eb;
            const int col = j * 64 + pt * 16 + fq * 4; const u32x2 zz = *(const u32x2*)(P0 + row * ABPAD + 1792 + g * 256 + col);
            const float z4[4] = {bflo(zz.x), bfhi(zz.x), bflo(zz.y), bfhi(zz.y)}; float v4[4];
#pragma unroll
            for (int i = 0; i < 4; ++i) { const float xs = bf2f(XT[(col + i) * SLD + l]); float v = yv[i] + dsk * xs; const float z = z4[i]; v = v * siluf_(z);
                v4[i] = v; ss += v * v; }
            u32x2 o; o.x = pk2(v4[0], v4[1]); o.y = pk2(v4[2], v4[3]); *(u32x2*)(OMIX + row * D + 512 + g * 256 + col) = o; }
        asm volatile("" ::: "memory");
    }
    ss += __shfl_xor(ss, 16); ss += __shfl_xor(ss, 32);
    const float rs = rsqrtf(ss * (1.f / 256.f) + 1e-6f);
    asm volatile("s_waitcnt vmcnt(0)" ::: "memory");
#pragma unroll 4
    for (int q = 0; q < 16; ++q) { const int col = g * 256 + q * 16 + fq * 4; const f32x4 nw = *(const f32x4*)(norm_w + col);
        u32x2* p = (u32x2*)(OMIX + row * D + 512 + col); const u32x2 v = *p;
        u32x2 o; o.x = pk2(bflo(v.x) * rs * nw[0], bfhi(v.x) * rs * nw[1]); o.y = pk2(bflo(v.y) * rs * nw[2], bfhi(v.y) * rs * nw[3]); *p = o; }
}

constexpr int HLD = 136, HLS = 72;
__device__ __forceinline__ void hgrn_chain(LAS unsigned char* lds, int cid, bf16_t* P1, const float* hg_lb, bf16_t* Ob, int ldo, int ocbase, int ocdir) {
    const int tid = threadIdx.x, lane = tid & 63, w = tid >> 6, fr = lane & 15, fq = lane >> 4;
    const int b = cid >> 4, h = (cid >> 1) & 7, dir = cid & 1;
    LAS bf16_t* QE = (LAS bf16_t*)lds;
    LAS bf16_t* KE = (LAS bf16_t*)(lds + 17408);
    LAS bf16_t* KLT = (LAS bf16_t*)(lds + 34816);
    LAS bf16_t* VT = (LAS bf16_t*)(lds + 53248);
    LAS bf16_t* AT = (LAS bf16_t*)(lds + 71680);
    LAS bf16_t* ST = (LAS bf16_t*)(lds + 80896);
    LAS float* totS = (LAS float*)(lds + 115712);
    LAS float* lastS = (LAS float*)(lds + 117760);
    __syncthreads();
    for (int e = tid; e < 128 * HLD / 2; e += 512) ((LAS unsigned*)ST)[e] = 0u;
    const int dcol = tid & 127, qtr = tid >> 7, i0 = qtr * 16;
    const float lbv = frcp(1.0f + __expf(hg_lb[h * 128 + dcol] - hg_lb[1024 + h * 128 + dcol]));
    f32x4 st[8];
#pragma unroll
    for (int i = 0; i < 8; ++i) st[i] = (f32x4){0.f, 0.f, 0.f, 0.f};
    bf16_t* Pb = P1 + (size_t)b * SEQ * HGP;
    __syncthreads();
    for (int cc = 0; cc < 64; ++cc) {
        const int t0 = (dir ? 63 - cc : cc) * 64;
        float gq[16], gk[16], gc[16]; unsigned short vraw[16]; float run = 0.f;
#pragma unroll
        for (int i = 0; i < 16; ++i) { const int tk = t0 + (dir ? 63 - (i0 + i) : (i0 + i)); const bf16_t* pr = Pb + (size_t)tk * HGP + h * 128 + dcol;
            const float q = bf2f(pr[0]), fr_ = bf2f(pr[1024 * (1 + dir)]); vraw[i] = pr[3072];
            const float f = lbv + (1.0f - lbv) * sigmoidf_(fr_); run += __logf(f); gq[i] = q; gk[i] = 1.0f - f; gc[i] = run; }
        totS[qtr * 128 + dcol] = run;
        { unsigned* vt = (unsigned*)nullptr; (void)vt; }
#pragma unroll
        for (int i = 0; i < 16; i += 2) *(LAS unsigned*)(VT + dcol * HLS + i0 + i) = (unsigned)vraw[i] | ((unsigned)vraw[i + 1] << 16);
        __syncthreads();
        { float pre = 0.f, tot = 0.f;
#pragma unroll
          for (int q4 = 0; q4 < 4; ++q4) { const float tq = totS[q4 * 128 + dcol]; if (q4 < qtr) pre += tq; tot += tq; }
          if (qtr == 0) lastS[dcol] = __expf(tot);
#pragma unroll
          for (int i = 0; i < 16; i += 2) { const float b0 = pre + gc[i], b1 = pre + gc[i + 1];
              const float e0 = __expf(b0), e1 = __expf(b1), n0 = __expf(-b0), n1 = __expf(-b1), l0 = __expf(tot - b0), l1 = __expf(tot - b1);
              QE[(i0 + i) * HLD + dcol] = (bf16_t)f2bf(gq[i] * e0); QE[(i0 + i + 1) * HLD + dcol] = (bf16_t)f2bf(gq[i + 1] * e1);
              KE[(i0 + i) * HLD + dcol] = (bf16_t)f2bf(gk[i] * n0); KE[(i0 + i + 1) * HLD + dcol] = (bf16_t)f2bf(gk[i + 1] * n1);
              *(LAS unsigned*)(KLT + dcol * HLS + i0 + i) = pk2(gk[i] * l0, gk[i + 1] * l1); } }
        __syncthreads();
        { const int mt = w >> 1;
#pragma unroll
          for (int n2 = 0; n2 < 2; ++n2) { const int nt = (w & 1) * 2 + n2; f32x4 acc = (f32x4){0.f, 0.f, 0.f, 0.f};
#pragma unroll
              for (int ks = 0; ks < 4; ++ks) acc = mfma16(ldsfrag(KE, HLD, nt * 16, ks * 32, fr, fq), ldsfrag(QE, HLD, mt * 16, ks * 32, fr, fq), acc);
              const int lrow = mt * 16 + fr; float mv[4];
#pragma unroll
              for (int i = 0; i < 4; ++i) { const int s = nt * 16 + fq * 4 + i; mv[i] = (s <= lrow) ? acc[i] : 0.f; }
              u32x2 o; o.x = pk2(mv[0], mv[1]); o.y = pk2(mv[2], mv[3]); *(LAS u32x2*)(AT + lrow * HLS + nt * 16 + fq * 4) = o; } }
        __syncthreads();
        { const int mt = w >> 1;
#pragma unroll
          for (int n4 = 0; n4 < 4; ++n4) { const int nt = (w & 1) * 4 + n4; f32x4 acc = (f32x4){0.f, 0.f, 0.f, 0.f};
#pragma unroll
              for (int ks = 0; ks < 2; ++ks) acc = mfma16(ldsfrag(VT, HLS, nt * 16, ks * 32, fr, fq), ldsfrag(AT, HLS, mt * 16, ks * 32, fr, fq), acc);
#pragma unroll
              for (int ks = 0; ks < 4; ++ks) acc = mfma16(ldsfrag(ST, HLD, nt * 16, ks * 32, fr, fq), ldsfrag(QE, HLD, mt * 16, ks * 32, fr, fq), acc);
              const int i = mt * 16 + fr, tk = t0 + (dir ? 63 - i : i);
              u32x2 o; o.x = pk2(acc[0], acc[1]); o.y = pk2(acc[2], acc[3]);
              *(u32x2*)(Ob + ((size_t)b * SEQ + tk) * ldo + ocbase + ocdir * dir + h * 128 + nt * 16 + fq * 4) = o; } }
#pragma unroll
        for (int nt = 0; nt < 8; ++nt) { const f32x4 el = *(const LAS f32x4*)(lastS + nt * 16 + fq * 4); st[nt] = st[nt] * el;
#pragma unroll
            for (int ks = 0; ks < 2; ++ks) st[nt] = mfma16(ldsfrag(KLT, HLS, nt * 16, ks * 32, fr, fq), ldsfrag(VT, HLS, w * 16, ks * 32, fr, fq), st[nt]); }
        __syncthreads();
#pragma unroll
        for (int nt = 0; nt < 8; ++nt) { u32x2 o; o.x = pk2(st[nt][0], st[nt][1]); o.y = pk2(st[nt][2], st[nt][3]); *(LAS u32x2*)(ST + (w * 16 + fr) * HLD + nt * 16 + fq * 4) = o; }
    }
    __syncthreads();
}
__device__ __forceinline__ void hgrn_combine(const bf16_t* P1, const float* norm_w, bf16_t* OMIX, int gw, int NGW, int lane) {
    const int c0 = lane * 16;
    for (int tk = gw; tk < T; tk += NGW) {
        const bf16_t* pr = P1 + (size_t)tk * HGP + c0; float o[16]; float ss = 0.f;
#pragma unroll
        for (int hh = 0; hh < 2; ++hh) { const u32x4 uf = *(const u32x4*)(pr + 1024 + hh * 8), ub = *(const u32x4*)(pr + 2048 + hh * 8);
#pragma unroll
            for (int i = 0; i < 4; ++i) { o[hh * 8 + 2 * i] = bflo(uf[i]) + bflo(ub[i]); o[hh * 8 + 2 * i + 1] = bfhi(uf[i]) + bfhi(ub[i]); } }
#pragma unroll
        for (int i = 0; i < 16; ++i) ss += o[i] * o[i];
        const float rs = rsqrtf(sum8(ss) * (1.f / 128.f) + 1e-6f);
#pragma unroll
        for (int hh = 0; hh < 2; ++hh) { const u32x4 ug = *(const u32x4*)(pr + 4096 + hh * 8); float r[8];
#pragma unroll
            for (int i = 0; i < 4; ++i) { const float g0 = bflo(ug[i]), g1 = bfhi(ug[i]);
                r[2 * i] = o[hh * 8 + 2 * i] * rs * norm_w[c0 + hh * 8 + 2 * i] * siluf_(g0);
                r[2 * i + 1] = o[hh * 8 + 2 * i + 1] * rs * norm_w[c0 + hh * 8 + 2 * i + 1] * siluf_(g1); }
            u32x4 wv; wv.x = pk2(r[0], r[1]); wv.y = pk2(r[2], r[3]); wv.z = pk2(r[4], r[5]); wv.w = pk2(r[6], r[7]);
            *(u32x4*)(OMIX + (size_t)tk * D + c0 + hh * 8) = wv; }
    }
}

struct Args { const float* in[35]; float* out; unsigned char* ws; int ph_lo, ph_hi; };
static_assert(sizeof(Args) == 304, "Args layout");

__global__ void __launch_bounds__(512, 2) mk_fwd(Args args) {
    extern __shared__ __attribute__((aligned(16))) unsigned char lds_raw[];
    LAS unsigned char* lds = (LAS unsigned char*)lds_raw; LAS unsigned char* xl = lds + XLDS_OFF;
    const int G = gridDim.x, bx = blockIdx.x, NGW = G * 8;
#define LOCAL_IDS int tid = threadIdx.x; asm volatile("" : "+v"(tid)); const int lane = tid & 63, wave = __builtin_amdgcn_readfirstlane(tid >> 6), gw = bx * 8 + wave; (void)lane; (void)gw;
    typedef const __attribute__((address_space(4))) unsigned char* kaptr_t;
    kaptr_t ka = (kaptr_t)__builtin_amdgcn_kernarg_segment_ptr();
#define INP(k) (*(const float* const volatile __attribute__((address_space(4)))*)(ka + 8 * (k)))
    unsigned char* ws = *(unsigned char* const volatile __attribute__((address_space(4)))*)(ka + 288); float* out = *(float* const volatile __attribute__((address_space(4)))*)(ka + 280);
    const float* x = INP(0);
    bf16_t* WAB = (bf16_t*)(ws + WS_WAB); bf16_t* WABO = (bf16_t*)(ws + WS_WABO); bf16_t* WHG = (bf16_t*)(ws + WS_WHG); bf16_t* WHGO = (bf16_t*)(ws + WS_WHGO);
    bf16_t* WQ = (bf16_t*)(ws + WS_WQ); bf16_t* WKV = (bf16_t*)(ws + WS_WKV); bf16_t* WO = (bf16_t*)(ws + WS_WO); bf16_t* WF1 = (bf16_t*)(ws + WS_WF1); bf16_t* WF2 = (bf16_t*)(ws + WS_WF2);
    bf16_t* G2T = (bf16_t*)(ws + WS_G2T); bf16_t* MEMN = (bf16_t*)(ws + WS_MEMN); bf16_t* KMEM = (bf16_t*)(ws + WS_KMEM); bf16_t* VT = (bf16_t*)(ws + WS_VT);
    bf16_t* H = (bf16_t*)(ws + WS_H); bf16_t* P = (bf16_t*)(ws + WS_P); bf16_t* PATT = (bf16_t*)(ws + WS_PATT); bf16_t* OMIX0 = (bf16_t*)(ws + WS_OMIX0);
    bf16_t* STATES = (bf16_t*)((unsigned char*)out + DO_STATES); bf16_t* GG = (bf16_t*)((unsigned char*)out + DO_G); bf16_t* SG = (bf16_t*)((unsigned char*)out + DO_SG);
    float* BONUS = (float*)((unsigned char*)out + DO_BONUS); float* TOT = (float*)((unsigned char*)out + DO_TOT);
    cg::grid_group grid = cg::this_grid();
    const int lo = *(const int volatile __attribute__((address_space(4)))*)(ka + 296), hi = *(const int volatile __attribute__((address_space(4)))*)(ka + 300);
#ifndef PH_EN
#define PH_EN(k) 1
#endif
#define IN(k) (PH_EN(k) && lo <= (k) && (k) < hi)
#ifndef DUP_MASK
#define DUP_MASK 0ull
#endif
#define REPS(k) (1 + (int)(((unsigned long long)(DUP_MASK) >> (k)) & 1ull))
#define PHASE(k) for (int rep_ = 0; rep_ < (IN(k) ? REPS(k) : 0); ++rep_, ((REPS(k) > 1) ? (grid.sync(), 0) : 0))
#define SEAM(k) do { if (IN(k) && IN((k) + 1)) grid.sync(); } while (0)
#define RUN_GEMM(EPI, ALIGN, gd, ep) do { pg8::Order S_; S_.init(gd, G, bx); pg8::gemm_phase<EPI, ALIGN>(lds, xl, gd, S_, ep); } while (0)

    PHASE(0) { LOCAL_IDS
        LAS float* scr = (LAS float*)(lds + wave * 16384);
        constexpr int I_AB = 16 * 112, I_SQ = 16 * 32, I_HG = 16 * 160, I_KV = 16 * 64, I_F1 = 16 * 176, I_F2 = 44 * 32, I_G2 = 2 * 16;
        constexpr int NIT = I_AB + I_SQ + I_HG + I_SQ + 2 * I_SQ + 2 * I_KV + 2 * I_SQ + 2 * I_F1 + 2 * I_F2 + I_G2;
        for (int it = gw; it < NIT; it += NGW) {
            int r = it;
            if (r < I_AB) { transpose_item<0>(INP(3), 1024, ABP, WAB, scr, r, 112, lane); continue; } r -= I_AB;
            if (r < I_SQ) { transpose_item<0>(INP(4), 1024, 1024, WABO, scr, r, 32, lane); continue; } r -= I_SQ;
            if (r < I_HG) { transpose_item<0>(INP(22), 1024, HGP, WHG, scr, r, 160, lane); continue; } r -= I_HG;
            if (r < I_SQ) { transpose_item<0>(INP(23), 1024, 1024, WHGO, scr, r, 32, lane); continue; } r -= I_SQ;
            if (r < 2 * I_SQ) { const int l = r / I_SQ; transpose_item<0>(INP(28) + (size_t)l * D * D, 1024, 1024, WQ + (size_t)l * D * D, scr, r % I_SQ, 32, lane); continue; } r -= 2 * I_SQ;
            if (r < 2 * I_KV) { const int l = r / I_KV; transpose_item<0>(INP(29) + (size_t)l * D * 2048, 1024, 2048, WKV + (size_t)l * D * 2048, scr, r % I_KV, 64, lane); continue; } r -= 2 * I_KV;
            if (r < 2 * I_SQ) { const int l = r / I_SQ; transpose_item<0>(INP(30) + (size_t)l * D * D, 1024, 1024, WO + (size_t)l * D * D, scr, r % I_SQ, 32, lane); continue; } r -= 2 * I_SQ;
            if (r < 2 * I_F1) { const int l = r / I_F1; transpose_item<1>(INP(32) + (size_t)l * D * 2 * FFN, 1024, 2 * FFN, WF1 + (size_t)l * D * 2 * FFN, scr, r % I_F1, 176, lane); continue; } r -= 2 * I_F1;
            if (r < 2 * I_F2) { const int l = r / I_F2; transpose_item<0>(INP(33) + (size_t)l * FFN * D, FFN, 1024, WF2 + (size_t)l * FFN * D, scr, r % I_F2, 32, lane); continue; } r -= 2 * I_F2;
            transpose_item<0>(INP(10), 128, 512, G2T, scr, r, 16, lane);
        }
        rms_rows_phase(x, INP(2), H, T, gw, NGW, lane);
        for (int m = gw; m < 2 * 4096; m += NGW) { const int l = m >> 12, r = m & 4095; rms_row_bf16(INP(1) + (size_t)r * D, INP(27) + l * D, MEMN + (size_t)m * D, lane); }
        __syncthreads();
    }
    SEAM(0);
    PHASE(1) {
        { pg8::Gemm g = pg8::make_gemm(H, WAB, T, ABPAD, 1024, 1024, 1024); pg8::EpiBf16 E{P, ABPAD, 1.0f}; RUN_GEMM(pg8::EpiBf16, true, g, E); }
        for (int l = 0; l < 2; ++l) {
            { pg8::Gemm g = pg8::make_gemm(MEMN + (size_t)l * 4096 * D, WKV + (size_t)l * 2048 * D, 4096, 1024, 1024, 1024, 1024); pg8::EpiBf16 E{KMEM + (size_t)l * 4096 * D, 1024, 1.0f}; RUN_GEMM(pg8::EpiBf16, true, g, E); }
            { pg8::Gemm g = pg8::make_gemm(WKV + (size_t)l * 2048 * D + (size_t)1024 * D, MEMN + (size_t)l * 4096 * D, 1024, 4096, 1024, 1024, 1024); pg8::EpiBf16 E{VT + (size_t)l * 4096 * D, 4096, 1.0f}; RUN_GEMM(pg8::EpiBf16, true, g, E); }
        }
    }
    SEAM(1);
    PHASE(2) {
#ifndef DUP_RWKV
#define DUP_RWKV 0
#endif
#ifndef DUP_S1
#define DUP_S1 0
#endif
        for (int r2 = 0; r2 <= DUP_RWKV; ++r2)
        for (int cid = bx; cid < 256; cid += G)
            rwkv_chain(lds, cid, P, INP(5), INP(6), INP(7), INP(8), INP(9), INP(11), INP(12), INP(13), H, SG, BONUS);
        for (int r2 = 0; r2 <= DUP_S1; ++r2)
        for (int u = bx; u < 1024; u += G) ssd_s1_unit(lds, u, P, INP(16), INP(17), INP(18), INP(19), STATES, TOT);
        __syncthreads();
    }
    SEAM(2);
    PHASE(3) {
        { int k128 = 128; asm volatile("" : "+s"(k128)); pg8::Gemm g = pg8::make_gemm(SG, G2T, T, 512, k128, 128, 128); pg8::EpiBf16 E{GG, 512, 1.0f}; RUN_GEMM(pg8::EpiBf16, true, g, E); }
        { LOCAL_IDS ssd_s2(STATES, TOT, bx * 512 + tid, G * 512); }
    }
    SEAM(3);
    PHASE(4) {
        for (int u = bx; u < 1024; u += G) ssd_s3_unit(lds, u, P, INP(16), INP(17), INP(18), INP(19), INP(20), INP(21), STATES, OMIX0);
        __syncthreads();
        { LOCAL_IDS rwkv_combine(P, H, BONUS, GG, INP(5), INP(14), INP(15), OMIX0, gw, NGW, lane); }
    }
    SEAM(4);
    PHASE(5) { pg8::Gemm g = pg8::make_gemm(OMIX0, WABO, T, 1024, 1024, 1024, 1024); pg8::EpiResid E{x, out, 1024}; RUN_GEMM(pg8::EpiResid, true, g, E); }
    SEAM(5);

#define ATTN_FFN(base, L) \
    PHASE(base) { LOCAL_IDS rms_rows_phase(out, INP(26) + (L) * D, H, T, gw, NGW, lane); } \
    SEAM(base); \
    PHASE(base + 1) { pg8::Gemm g = pg8::make_gemm(H, WQ + (size_t)(L) * D * D, T, 1024, 1024, 1024, 1024); pg8::EpiBf16 E{P, 1024, 0.0625f}; RUN_GEMM(pg8::EpiBf16, true, g, E); } \
    SEAM(base + 1); \
    PHASE(base + 2) { pg8::Gemm g = pg8::make_gemm(P, KMEM + (size_t)(L) * 4096 * D, SEQ, 256, 256, 1024, 1024); g.nZ = 64; g.zdiv = 4; \
        g.sAo = (long)SEQ * D; g.sAi = 256; g.sBo = 256L * D; g.sBi = 256; g.sCo = (long)SEQ * D; g.sCi = 256; pg8::EpiSoftmax E{PATT, 1024}; RUN_GEMM(pg8::EpiSoftmax, true, g, E); } \
    SEAM(base + 2); \
    PHASE(base + 3) { pg8::Gemm g = pg8::make_gemm(PATT, VT + (size_t)(L) * 4096 * D, SEQ, 256, 256, 1024, 4096); g.nZ = 64; g.zdiv = 4; \
        g.sAo = (long)SEQ * D; g.sAi = 256; g.sBo = 256; g.sBi = 256L * 4096; g.sCo = (long)SEQ * D; g.sCi = 256; pg8::EpiBf16 E{P, 1024, 1.0f}; RUN_GEMM(pg8::EpiBf16, true, g, E); } \
    SEAM(base + 3); \
    PHASE(base + 4) { pg8::Gemm g = pg8::make_gemm(P, WO + (size_t)(L) * D * D, T, 1024, 1024, 1024, 1024); pg8::EpiResid E{out, out, 1024}; RUN_GEMM(pg8::EpiResid, true, g, E); } \
    SEAM(base + 4); \
    PHASE(base + 5) { LOCAL_IDS rms_rows_phase(out, INP(31) + (L) * D, H, T, gw, NGW, lane); } \
    SEAM(base + 5); \
    PHASE(base + 6) { pg8::Gemm g = pg8::make_gemm(H, WF1 + (size_t)(L) * D * 2 * FFN, T, 2 * FFN, 1024, 1024, 1024); pg8::EpiSwiglu E{P, FFN}; RUN_GEMM(pg8::EpiSwiglu, true, g, E); } \
    SEAM(base + 6); \
    PHASE(base + 7) { pg8::Gemm g = pg8::make_gemm(P, WF2 + (size_t)(L) * FFN * D, T, 1024, FFN, FFN, FFN); pg8::EpiResid E{out, out, 1024}; RUN_GEMM(pg8::EpiResid, true, g, E); } \
    SEAM(base + 7);

    ATTN_FFN(6, 0)

    PHASE(14) { LOCAL_IDS rms_rows_phase(out, INP(2) + D, H, T, gw, NGW, lane); }
    SEAM(14);
    PHASE(15) { pg8::Gemm g = pg8::make_gemm(H, WHG, T, HGP, 1024, 1024, 1024); pg8::EpiBf16 E{P, HGP, 1.0f}; RUN_GEMM(pg8::EpiBf16, true, g, E); }
    SEAM(15);
    PHASE(16) {
#ifdef DUP_HGRN
        for (int cid = bx; cid < 256; cid += G) hgrn_chain(lds, cid, P, INP(25), OMIX0, 1024, 0, 0);
        grid.sync();
#endif
        for (int cid = bx; cid < 256; cid += G) hgrn_chain(lds, cid, P, INP(25), P, HGP, 1024, 1024); }
    SEAM(16);
    PHASE(17) { LOCAL_IDS hgrn_combine(P, INP(24), H, gw, NGW, lane); }
    SEAM(17);
    PHASE(18) { pg8::Gemm g = pg8::make_gemm(H, WHGO, T, 1024, 1024, 1024, 1024); pg8::EpiResid E{out, out, 1024}; RUN_GEMM(pg8::EpiResid, true, g, E); }
    SEAM(18);

    ATTN_FFN(19, 1)

    PHASE(27) { LOCAL_IDS
        const float* fg = INP(34);
        for (int m = gw; m < T; m += NGW) { f32x4* xr = (f32x4*)(out + (size_t)m * D) + lane; f32x4 v[4]; float s = 0.f;
#pragma unroll
            for (int j = 0; j < 4; ++j) { v[j] = xr[64 * j]; s += (v[j].x * v[j].x + v[j].y * v[j].y) + (v[j].z * v[j].z + v[j].w * v[j].w); }
            const float rs = rsqrtf(wave_sum(s) * (1.f / D) + 1e-6f);
#pragma unroll
            for (int j = 0; j < 4; ++j) { const f32x4 g = ((const f32x4*)fg)[lane + 64 * j]; f32x4 o = v[j] * rs * g;
                xr[64 * j] = o; } }
    }
#undef IN
#undef SEAM
#undef RUN_GEMM
}

extern "C" void kernel_launch(void* const* d_in, const int* in_sizes, int n_in, void* d_out, int out_size, void* d_ws, size_t ws_size, hipStream_t stream) {
    static int grid = 0;
    if (grid == 0) {
        if (n_in != 35 || out_size != T * D || ws_size < WS_END) { fprintf(stderr, "kernel_launch: unexpected shapes (n_in %d out %d ws %zu)\n", n_in, out_size, ws_size); grid = -1; return; }
        int dev = 0, cus = 0, per_cu = 0;
        hipGetDevice(&dev); hipDeviceGetAttribute(&cus, hipDeviceAttributeMultiprocessorCount, dev);
        hipFuncSetAttribute((const void*)mk_fwd, hipFuncAttributeMaxDynamicSharedMemorySize, LDS_BYTES);
        hipOccupancyMaxActiveBlocksPerMultiprocessor(&per_cu, (const void*)mk_fwd, 512, LDS_BYTES);
        if (per_cu < 1) { fprintf(stderr, "kernel_launch: occupancy query says %d blocks per CU\n", per_cu); per_cu = 1; }
        (void)hipGetLastError();
        grid = cus * 1;
    }
    if (grid < 0) return;
    Args a{};
    for (int i = 0; i < 35; ++i) a.in[i] = (const float*)d_in[i];
    a.out = (float*)d_out; a.ws = (unsigned char*)d_ws;
#if MK_COOP
    a.ph_lo = 0; a.ph_hi = NPHASE;
    void* kargs[] = {&a};
    hipError_t e = hipLaunchCooperativeKernel((const void*)mk_fwd, dim3(grid), dim3(512), kargs, LDS_BYTES, stream);
    if (e != hipSuccess) fprintf(stderr, "cooperative launch failed: %s (grid %d)\n", hipGetErrorString(e), grid);
#else
    for (int ph = 0; ph < NPHASE; ++ph) { a.ph_lo = ph; a.ph_hi = ph + 1; hipLaunchKernelGGL(mk_fwd, dim3(grid), dim3(512), LDS_BYTES, stream, a); }
#endif
}
```

```cpp
#include <hip/hip_runtime.h>
#include <hip/hip_cooperative_groups.h>
#include <cstdio>
#include <cstdint>
namespace cg = cooperative_groups;

#ifndef MK_COOP
#define MK_COOP 1
#endif

#define LAS __attribute__((address_space(3)))
typedef unsigned short bf16_t;
typedef short bf16x8 __attribute__((ext_vector_type(8)));
typedef float f32x4 __attribute__((ext_vector_type(4)));
typedef float f32x2 __attribute__((ext_vector_type(2)));
typedef unsigned u32x4 __attribute__((ext_vector_type(4)));
typedef unsigned u32x2 __attribute__((ext_vector_type(2)));

constexpr int NB = 16, SEQ = 4096, T = NB * SEQ, D = 1024;
constexpr int ABPAD = 3584, ABP = 3336;
constexpr int HGP = 5120;
constexpr int FFN = 2816;
constexpr int NPHASE = 23;

constexpr size_t MiB = 1u << 20;
constexpr size_t WS_WAB = 1 * MiB, WS_WABO = 8 * MiB, WS_WHG = 10 * MiB, WS_WHGO = 20 * MiB, WS_WQ = 22 * MiB, WS_WKV = 26 * MiB, WS_WO = 34 * MiB,
                 WS_WF1 = 38 * MiB, WS_WF2 = 60 * MiB, WS_G2T = 71 * MiB, WS_MEMN = 72 * MiB, WS_KMEM = 88 * MiB, WS_VT = 104 * MiB,
                 WS_PS = 120 * MiB, WS_H = 128 * MiB, WS_P = 256 * MiB, WS_PATT = 384 * MiB, WS_OMIX0 = 704 * MiB, WS_OMIX1 = 896 * MiB, WS_END = 1024 * MiB;
constexpr size_t DO_STATES = 0, DO_G = 128 * MiB, DO_SG = 192 * MiB, DO_BONUS = 208 * MiB, DO_TOT = 210 * MiB;

constexpr int LDS_BYTES = 151552;
constexpr int XLDS_OFF = 131072;

__device__ __forceinline__ unsigned f2bf(float f) { unsigned u = __builtin_bit_cast(unsigned, f); return (u + 0x7fffu + ((u >> 16) & 1u)) >> 16; }
__device__ __forceinline__ unsigned pk2(float lo, float hi) { return f2bf(lo) | (f2bf(hi) << 16); }
__device__ __forceinline__ float bf2f(unsigned short b) { return __builtin_bit_cast(float, (unsigned)b << 16); }
__device__ __forceinline__ float bflo(unsigned u) { return __builtin_bit_cast(float, u << 16); }
__device__ __forceinline__ float bfhi(unsigned u) { return __builtin_bit_cast(float, u & 0xffff0000u); }
__device__ __forceinline__ float frcp(float x) { return __builtin_amdgcn_rcpf(x); }
__device__ __forceinline__ float sigmoidf_(float x) { return frcp(1.0f + __expf(-x)); }
__device__ __forceinline__ float siluf_(float x) { return x * frcp(1.0f + __expf(-x)); }
__device__ __forceinline__ float wave_sum(float v) {
#pragma unroll
    for (int o = 1; o < 64; o <<= 1) v += __shfl_xor(v, o);
    return v;
}
template <int CTRL> __device__ __forceinline__ float dppf(float x) { return __builtin_bit_cast(float, __builtin_amdgcn_mov_dpp(__builtin_bit_cast(int, x), CTRL, 0xf, 0xf, true)); }
__device__ __forceinline__ float sum8(float v) { v += dppf<0xB1>(v); v += dppf<0x4E>(v); v += dppf<0x141>(v); return v; }
#define LDS_WAIT() asm volatile("s_waitcnt lgkmcnt(0)" ::: "memory")

namespace pg8 {
constexpr int BM = 256, BK = 64, HALF = 128, HTB = HALF * BK * 2, STAGE_BYTES = 8 * HTB, NXCD = 8, WGM = 8;
__host__ __device__ __forceinline__ int lds_byte(int r, int c) { const int st = (r >> 4) * 2 + (c >> 5), rr = r & 15, cc = c & 31, ob = rr * 64 + cc * 2; return st * 1024 + (ob ^ (((ob >> 9) & 1) << 5)); }
__host__ __device__ __forceinline__ void stage_rc(int b, int& R, int& C) { const int st = b / 1024, sb = b % 1024, swz = sb ^ (((sb >> 9) & 1) << 5); R = (st >> 1) * 16 + swz / 64; C = (st & 1) * 32 + (swz % 64) / 2; }
__host__ __device__ __forceinline__ int perm32(int rho) { const int n = rho >> 4, i = rho & 15; return 8 * (i >> 2) + 4 * n + (i & 3); }

struct Unit { int pm, pn, z; };
struct Gemm {
    const bf16_t* A; const bf16_t* Bt; int lda, ldb, K, nM, nN, nZ, zdiv; long sAo, sAi, sBo, sBi, sCo, sCi;
    __device__ __forceinline__ long offA(const Unit& u) const { return (long)(u.z / zdiv) * sAo + (long)(u.z % zdiv) * sAi + (long)u.pm * BM * lda; }
    __device__ __forceinline__ long offB(const Unit& u) const { return (long)(u.z / zdiv) * sBo + (long)(u.z % zdiv) * sBi + (long)u.pn * BM * ldb; }
    __device__ __forceinline__ long offC(const Unit& u) const { return (long)(u.z / zdiv) * sCo + (long)(u.z % zdiv) * sCi; }
};
__device__ __forceinline__ Gemm make_gemm(const bf16_t* A, const bf16_t* Bt, int M, int N, int K, int lda, int ldb) {
    Gemm g; g.A = A; g.Bt = Bt; g.lda = lda; g.ldb = ldb; g.K = K; g.nM = M / BM; g.nN = N / BM; g.nZ = 1; g.zdiv = 1; g.sAo = g.sAi = g.sBo = g.sBi = g.sCo = g.sCi = 0; return g;
}
struct Order {
    int nM, nN, nwg, total, G, c;
    __device__ __forceinline__ void init(const Gemm& g, int G_, int c_) { nM = g.nM; nN = g.nN; nwg = nM * nN; total = nwg * g.nZ; G = G_; c = c_; }
    __device__ __forceinline__ bool next(int i, Unit& u) const {
        const long L = (long)i * G + c; if (L >= total) return false;
        u.z = (int)(L / nwg); int wgid = (int)(L % nwg);
        { const int q = nwg / NXCD, r = nwg % NXCD, xcd = wgid % NXCD, off = wgid / NXCD; wgid = (xcd < r ? xcd * (q + 1) : r * (q + 1) + (xcd - r) * q) + off; }
        const int nig = WGM * nN, gid = wgid / nig, fm = gid * WGM, gsz = (nM - fm) < WGM ? (nM - fm) : WGM;
        u.pm = fm + ((wgid % nig) % gsz); u.pn = (wgid % nig) / gsz; return true;
    }
};

__device__ __forceinline__ unsigned cvt_pk_bf16(float lo, float hi) { unsigned r; asm volatile("v_cvt_pk_bf16_f32 %0, %1, %2" : "=v"(r) : "v"(lo), "v"(hi)); return r; }

__device__ __forceinline__ void row_scales(const float* PS, int rowbase, int fq, float (&rs)[2][4]) {
#pragma unroll
    for (int ai = 0; ai < 2; ++ai)
#pragma unroll
        for (int m = 0; m < 4; ++m) { const f32x4 p = *(const f32x4*)(PS + (size_t)(rowbase + ai * HALF + m * 16) * 16 + fq * 4);
            float s = (p[0] + p[1]) + (p[2] + p[3]); s += __shfl_xor(s, 16); s += __shfl_xor(s, 32); rs[ai][m] = rsqrtf(s * (1.f / 1024.f) + 1e-6f); }
}
struct EpiBf16 {
    static constexpr bool PERM = true;
    bf16_t* O; int ldc; float scale; const float* PS;
    __device__ __forceinline__ void operator()(const f32x4 (&acc)[2][2][4][2], const Unit& u, long coff, int wr, int wc, int fr, int fq, LAS unsigned char* xl) const {
        const int row0 = u.pm * BM + wr * 64 + fr, col0 = u.pn * BM + wc * 32 + 8 * fq; bf16_t* base = O + coff;
        float rs[2][4];
        if (PS) row_scales(PS, row0, fq, rs);
        else {
#pragma unroll
            for (int ai = 0; ai < 2; ++ai)
#pragma unroll
                for (int m = 0; m < 4; ++m) rs[ai][m] = 1.f; }
#pragma unroll
        for (int ai = 0; ai < 2; ++ai)
#pragma unroll
            for (int m = 0; m < 4; ++m) { bf16_t* rowp = base + (size_t)(row0 + ai * HALF + m * 16) * ldc + col0; const float sc_ = scale * rs[ai][m];
#pragma unroll
                for (int bj = 0; bj < 2; ++bj) { const f32x4 v0 = acc[ai][bj][m][0] * sc_, v1 = acc[ai][bj][m][1] * sc_;
                    u32x4 w; w.x = cvt_pk_bf16(v0[0], v0[1]); w.y = cvt_pk_bf16(v0[2], v0[3]); w.z = cvt_pk_bf16(v1[0], v1[1]); w.w = cvt_pk_bf16(v1[2], v1[3]);
                    *(u32x4*)(rowp + bj * HALF) = w; } }
    }
};
struct EpiResid {
    static constexpr bool PERM = false;
    const float* base; float* out; int ldc;
    __device__ __forceinline__ void operator()(const f32x4 (&acc)[2][2][4][2], const Unit& u, long coff, int wr, int wc, int fr, int fq, LAS unsigned char* xl) const {
        const int col0 = u.pn * BM + wc * 32 + 4 * fq;
#pragma unroll
        for (int ai = 0; ai < 2; ++ai)
#pragma unroll
            for (int m = 0; m < 4; ++m) { const size_t off = (size_t)(u.pm * BM + ai * HALF + wr * 64 + m * 16 + fr) * ldc + col0;
#pragma unroll
                for (int bj = 0; bj < 2; ++bj)
#pragma unroll
                    for (int n = 0; n < 2; ++n) { const f32x4 bs = *(const f32x4*)(base + off + bj * HALF + n * 16); *(f32x4*)(out + off + bj * HALF + n * 16) = bs + acc[ai][bj][m][n]; } }
    }
};
struct EpiResidH {
    static constexpr bool PERM = false;
    const float* base; float* out; bf16_t* HB; float* PS; int ldc;
    __device__ __forceinline__ void operator()(const f32x4 (&acc)[2][2][4][2], const Unit& u, long coff, int wr, int wc, int fr, int fq, LAS unsigned char* xl) const {
        const int col0 = u.pn * BM + wc * 32 + 4 * fq;
#pragma unroll
        for (int ai = 0; ai < 2; ++ai)
#pragma unroll
            for (int m = 0; m < 4; ++m) { const int row = u.pm * BM + ai * HALF + wr * 64 + m * 16 + fr; const size_t off = (size_t)row * ldc + col0; float ss = 0.f;
#pragma unroll
                for (int bj = 0; bj < 2; ++bj)
#pragma unroll
                    for (int n = 0; n < 2; ++n) { const f32x4 bs = *(const f32x4*)(base + off + bj * HALF + n * 16); const f32x4 o = bs + acc[ai][bj][m][n]; *(f32x4*)(out + off + bj * HALF + n * 16) = o;
                        ss += (o[0] * o[0] + o[1] * o[1]) + (o[2] * o[2] + o[3] * o[3]);
                        u32x2 w; w.x = cvt_pk_bf16(o[0], o[1]); w.y = cvt_pk_bf16(o[2], o[3]); *(u32x2*)(HB + off + bj * HALF + n * 16) = w; }
                ss += __shfl_xor(ss, 16); ss += __shfl_xor(ss, 32);
                if (fq == 0) PS[(size_t)row * 16 + u.pn * 4 + wc] = ss; }
    }
};
struct EpiSwiglu {
    static constexpr bool PERM = true;
    bf16_t* O; int ldc; const float* PS;
    __device__ __forceinline__ void operator()(const f32x4 (&acc)[2][2][4][2], const Unit& u, long coff, int wr, int wc, int fr, int fq, LAS unsigned char* xl) const {
        const int row0 = u.pm * BM + wr * 64 + fr, col0 = u.pn * HALF + wc * 32 + 8 * fq;
        float rs[2][4]; row_scales(PS, row0, fq, rs);
#pragma unroll
        for (int ai = 0; ai < 2; ++ai)
#pragma unroll
            for (int m = 0; m < 4; ++m) { bf16_t* rowp = O + (size_t)(row0 + ai * HALF + m * 16) * ldc + col0; float r[8]; const float sc_ = rs[ai][m];
#pragma unroll
                for (int n = 0; n < 2; ++n)
#pragma unroll
                    for (int i = 0; i < 4; ++i) { const float g = acc[ai][0][m][n][i] * sc_, uu = acc[ai][1][m][n][i] * sc_; r[n * 4 + i] = siluf_(g) * uu; }
                u32x4 w; w.x = cvt_pk_bf16(r[0], r[1]); w.y = cvt_pk_bf16(r[2], r[3]); w.z = cvt_pk_bf16(r[4], r[5]); w.w = cvt_pk_bf16(r[6], r[7]);
                *(u32x4*)rowp = w; }
    }
};
struct EpiSoftmax {
    static constexpr bool PERM = true;
    bf16_t* O; int ldc;
    __device__ __forceinline__ void operator()(f32x4 (&acc)[2][2][4][2], const Unit& u, long coff, int wr, int wc, int fr, int fq, LAS unsigned char* xl) const {
        LAS float* XM = (LAS float*)xl; LAS float* XS = (LAS float*)(xl + 4096);
#pragma unroll
        for (int ai = 0; ai < 2; ++ai)
#pragma unroll
            for (int m = 0; m < 4; ++m) { float mx = -3.0e38f;
#pragma unroll
                for (int bj = 0; bj < 2; ++bj)
#pragma unroll
                    for (int n = 0; n < 2; ++n)
#pragma unroll
                        for (int i = 0; i < 4; ++i) mx = fmaxf(mx, acc[ai][bj][m][n][i]);
                mx = fmaxf(mx, __shfl_xor(mx, 16)); mx = fmaxf(mx, __shfl_xor(mx, 32));
                if (fq == 0) XM[(ai * HALF + wr * 64 + m * 16 + fr) * 4 + wc] = mx; }
        LDS_WAIT(); __builtin_amdgcn_s_barrier(); asm volatile("" ::: "memory");
#pragma unroll
        for (int ai = 0; ai < 2; ++ai)
#pragma unroll
            for (int m = 0; m < 4; ++m) { const f32x4 mm = *(const LAS f32x4*)(XM + (ai * HALF + wr * 64 + m * 16 + fr) * 4);
                const float mx = fmaxf(fmaxf(mm[0], mm[1]), fmaxf(mm[2], mm[3])); float s = 0.f;
#pragma unroll
                for (int bj = 0; bj < 2; ++bj)
#pragma unroll
                    for (int n = 0; n < 2; ++n)
#pragma unroll
                        for (int i = 0; i < 4; ++i) { const float e = __expf(acc[ai][bj][m][n][i] - mx); acc[ai][bj][m][n][i] = e; s += e; }
                s += __shfl_xor(s, 16); s += __shfl_xor(s, 32);
                if (fq == 0) XS[(ai * HALF + wr * 64 + m * 16 + fr) * 4 + wc] = s; }
        LDS_WAIT(); __builtin_amdgcn_s_barrier(); asm volatile("" ::: "memory");
        const int row0 = u.pm * BM + wr * 64 + fr, col0 = wc * 32 + 8 * fq; bf16_t* base = O + coff;
#pragma unroll
        for (int ai = 0; ai < 2; ++ai)
#pragma unroll
            for (int m = 0; m < 4; ++m) { const f32x4 ss = *(const LAS f32x4*)(XS + (ai * HALF + wr * 64 + m * 16 + fr) * 4);
                const float inv = frcp((ss[0] + ss[1]) + (ss[2] + ss[3])); bf16_t* rowp = base + (size_t)(row0 + ai * HALF + m * 16) * ldc + col0;
#pragma unroll
                for (int bj = 0; bj < 2; ++bj) { const f32x4 v0 = acc[ai][bj][m][0] * inv, v1 = acc[ai][bj][m][1] * inv;
                    u32x4 w; w.x = cvt_pk_bf16(v0[0], v0[1]); w.y = cvt_pk_bf16(v0[2], v0[3]); w.z = cvt_pk_bf16(v1[0], v1[1]); w.w = cvt_pk_bf16(v1[2], v1[3]);
                    *(u32x4*)(rowp + bj * HALF) = w; } }
    }
};

template <class Epi, bool ALIGN_EPI>
__device__ __forceinline__ void gemm_phase(LAS unsigned char* lds, LAS unsigned char* xl, const Gemm g, const Order& S, Epi& E) {
    const int tid = threadIdx.x, wid = __builtin_amdgcn_readfirstlane(tid >> 6), lane = tid & 63, wr = wid >> 2, wc = wid & 3, fr = lane & 15, fq = lane >> 4;
    const int K = g.K, nt = K / BK;
    unsigned voffA[2], voffB[2];
#pragma unroll
    for (int i = 0; i < 2; ++i) { int R, C; stage_rc(tid * 16 + i * 8192, R, C); const int Rb = Epi::PERM ? ((R & ~31) + perm32(R & 31)) : R;
        voffA[i] = (unsigned)(R * g.lda + C) * 2u; voffB[i] = (unsigned)(Rb * g.ldb + C) * 2u; }
    const size_t kstep = (size_t)(BK * 2);
    const size_t hstepA = (size_t)HALF * g.lda * 2, hstepB = (size_t)HALF * g.ldb * 2;
    const unsigned ldsw = (unsigned)wid * 1024u;
    const int aoff = lds_byte(wr * 64 + fr, fq * 8), boff = lds_byte(wc * 32 + fr, fq * 8);
#define PG8_SA(b, h) (((b) * 2 + (h)) * HTB)
#define PG8_SB(b, h) ((4 + (b) * 2 + (h)) * HTB)
#define PG8_STAGE(bufoff, gbase, voff) do { _Pragma("unroll") for (int _i = 0; _i < 2; ++_i) \
        __builtin_amdgcn_global_load_lds((const unsigned*)((const char*)(gbase) + (voff)[_i]), (LAS unsigned*)(lds + (bufoff) + ldsw + _i * 8192), 16, 0, 0); } while (0)
#define PG8_LDA(dst, b, h) do { _Pragma("unroll") for (int m = 0; m < 4; ++m) _Pragma("unroll") for (int k = 0; k < 2; ++k) dst[m][k] = *(const LAS bf16x8*)(lds + PG8_SA(b, h) + aoff + m * 2048 + k * 1024); } while (0)
#define PG8_LDB(dst, b, h) do { _Pragma("unroll") for (int n = 0; n < 2; ++n) _Pragma("unroll") for (int k = 0; k < 2; ++k) dst[n][k] = *(const LAS bf16x8*)(lds + PG8_SB(b, h) + boff + n * 2048 + k * 1024); } while (0)
#define PG8_MMA(ai, bj, At, Bt) do { __builtin_amdgcn_s_setprio(1); _Pragma("unroll") for (int m = 0; m < 4; ++m) _Pragma("unroll") for (int n = 0; n < 2; ++n) _Pragma("unroll") for (int k = 0; k < 2; ++k) \
        acc[ai][bj][m][n] = __builtin_amdgcn_mfma_f32_16x16x32_bf16(Bt[n][k], At[m][k], acc[ai][bj][m][n], 0, 0, 0); __builtin_amdgcn_s_setprio(0); } while (0)
#define PG8_WAIT_V(n) asm volatile("s_waitcnt vmcnt(" #n ")" ::: "memory")
#define PG8_WAIT_L(n) asm volatile("s_waitcnt lgkmcnt(" #n ")" ::: "memory")
#define PG8_BAR __builtin_amdgcn_s_barrier()
#define PG8_SCHED __builtin_amdgcn_sched_barrier(0)
    Unit cur, nxt; int ui = 0;
    if (!S.next(0, cur)) return;
    f32x4 acc[2][2][4][2];
#pragma unroll
    for (int a = 0; a < 2; ++a)
#pragma unroll
        for (int b = 0; b < 2; ++b)
#pragma unroll
            for (int m = 0; m < 4; ++m)
#pragma unroll
                for (int n = 0; n < 2; ++n) acc[a][b][m][n] = (f32x4){0.f, 0.f, 0.f, 0.f};
    bf16x8 At[4][2], B0[2][2], B1[2][2];
    const char* cA = (const char*)g.A + 2 * g.offA(cur); const char* cB = (const char*)g.Bt + 2 * g.offB(cur);
    PG8_STAGE(PG8_SB(0, 0), cB, voffB); PG8_STAGE(PG8_SB(0, 1), cB + hstepB, voffB); PG8_STAGE(PG8_SA(0, 0), cA, voffA); PG8_STAGE(PG8_SA(0, 1), cA + hstepA, voffA);
    if (wr == 1) PG8_BAR;
    PG8_WAIT_V(2); PG8_BAR;
    PG8_STAGE(PG8_SB(1, 0), cB + kstep, voffB); PG8_STAGE(PG8_SA(1, 0), cA + kstep, voffA); PG8_STAGE(PG8_SB(1, 1), cB + hstepB + kstep, voffB);
    PG8_WAIT_V(6); PG8_BAR;
    for (;;) {
        const bool has_next = S.next(ui + 1, nxt);
        const char* nA = has_next ? (const char*)g.A + 2 * g.offA(nxt) : cA; const char* nB = has_next ? (const char*)g.Bt + 2 * g.offB(nxt) : cB;
        for (int t = 0; t < nt; t += 2) {
            const bool last = (t == nt - 2);
            const char* a1 = cA + (size_t)(t + 1) * kstep;
            const char* a2 = last ? nA : cA + (size_t)(t + 2) * kstep; const char* b2 = last ? nB : cB + (size_t)(t + 2) * kstep;
            const char* a3 = a2 + kstep; const char* b3 = b2 + kstep;
            PG8_LDB(B0, 0, 0); PG8_LDB(B1, 0, 1); PG8_SCHED; PG8_LDA(At, 0, 0); PG8_STAGE(PG8_SA(1, 1), a1 + hstepA, voffA);
            PG8_WAIT_V(8); PG8_WAIT_L(0); PG8_BAR; PG8_MMA(0, 0, At, B0); PG8_MMA(0, 1, At, B1); PG8_BAR; PG8_SCHED;
            PG8_LDA(At, 0, 1); PG8_STAGE(PG8_SB(0, 0), b2, voffB); PG8_STAGE(PG8_SB(0, 1), b2 + hstepB, voffB); PG8_STAGE(PG8_SA(0, 0), a2, voffA);
            PG8_WAIT_V(8); PG8_WAIT_L(0); PG8_BAR; PG8_MMA(1, 0, At, B0); PG8_MMA(1, 1, At, B1); PG8_BAR; PG8_SCHED;
            PG8_LDB(B0, 1, 0); PG8_LDB(B1, 1, 1); PG8_SCHED; PG8_LDA(At, 1, 0); PG8_STAGE(PG8_SA(0, 1), a2 + hstepA, voffA);
            PG8_WAIT_V(8); PG8_WAIT_L(0); PG8_BAR; PG8_MMA(0, 0, At, B0); PG8_MMA(0, 1, At, B1); PG8_BAR; PG8_SCHED;
            PG8_LDA(At, 1, 1); PG8_STAGE(PG8_SB(1, 0), b3, voffB); PG8_STAGE(PG8_SB(1, 1), b3 + hstepB, voffB); PG8_STAGE(PG8_SA(1, 0), a3, voffA);
            PG8_WAIT_V(8); PG8_WAIT_L(0); PG8_BAR; PG8_MMA(1, 0, At, B0); PG8_MMA(1, 1, At, B1); PG8_BAR; PG8_SCHED;
        }
        if constexpr (ALIGN_EPI) { if (wr == 0) PG8_BAR; }
        E(acc, cur, g.offC(cur), wr, wc, fr, fq, xl);
        if (!has_next) break;
#pragma unroll
        for (int a = 0; a < 2; ++a)
#pragma unroll
            for (int b = 0; b < 2; ++b)
#pragma unroll
                for (int m = 0; m < 4; ++m)
#pragma unroll
                    for (int n = 0; n < 2; ++n) acc[a][b][m][n] = (f32x4){0.f, 0.f, 0.f, 0.f};
        cur = nxt; cA = nA; cB = nB; ++ui;
        if constexpr (ALIGN_EPI) { if (wr == 1) PG8_BAR; }
    }
    PG8_WAIT_V(0);
    if constexpr (!ALIGN_EPI) { if (wr == 0) PG8_BAR; }
    PG8_BAR;
#undef PG8_SA
#undef PG8_SB
#undef PG8_STAGE
#undef PG8_LDA
#undef PG8_LDB
#undef PG8_MMA
#undef PG8_WAIT_V
#undef PG8_WAIT_L
#undef PG8_BAR
#undef PG8_SCHED
}
}

__device__ __forceinline__ f32x4 mfma16(bf16x8 bfrag, bf16x8 afrag, f32x4 acc) { return __builtin_amdgcn_mfma_f32_16x16x32_bf16(bfrag, afrag, acc, 0, 0, 0); }
__device__ __forceinline__ bf16x8 ldsfrag(const LAS bf16_t* base, int ld, int r0, int k0, int fr, int fq) { return *(const LAS bf16x8*)(base + (r0 + fr) * ld + k0 + fq * 8); }

template <int MODE> __device__ __forceinline__ void transpose_item(const float* W, int K, int N, bf16_t* WT, LAS float* scr, int item, int nblk, int lane, const float* gain = nullptr) {
    const int kb = item / nblk, nb = item % nblk, k0 = 64 * kb, n0 = 32 * nb; const int nsrc = n0 + (lane & 31);
#pragma unroll 8
    for (int i = 0; i < 32; ++i) { const int kk = 2 * i + (lane >> 5); scr[kk * 33 + (lane & 31)] = (nsrc < N) ? W[(size_t)(k0 + kk) * N + nsrc] * (gain ? gain[k0 + kk] : 1.f) : 0.f; }
    LDS_WAIT();
    const int c = lane & 7;
#pragma unroll
    for (int j = 0; j < 4; ++j) { const int n = (lane >> 3) + 8 * j; const LAS float* s = scr + (8 * c) * 33 + n;
        u32x4 o; o.x = pk2(s[0 * 33], s[1 * 33]); o.y = pk2(s[2 * 33], s[3 * 33]); o.z = pk2(s[4 * 33], s[5 * 33]); o.w = pk2(s[6 * 33], s[7 * 33]);
        int drow = n0 + n; if (MODE == 1) { const int jn = drow % FFN, isu = drow / FFN; drow = (jn / 128) * 256 + isu * 128 + (jn % 128); }
        *(u32x4*)(WT + (size_t)drow * K + k0 + 8 * c) = o; }
    LDS_WAIT();
}
__device__ __forceinline__ void rms_row_bf16(const float* xrow, const float* gain, bf16_t* orow, int lane) {
    const f32x4* xr = (const f32x4*)xrow + lane; f32x4 v[4]; float s = 0.f;
#pragma unroll
    for (int j = 0; j < 4; ++j) { v[j] = xr[64 * j]; s += (v[j].x * v[j].x + v[j].y * v[j].y) + (v[j].z * v[j].z + v[j].w * v[j].w); }
    const float rs = rsqrtf(wave_sum(s) * (1.f / D) + 1e-6f);
    const f32x4* gr = (const f32x4*)gain + lane; u32x2* o8 = (u32x2*)orow + lane;
#pragma unroll
    for (int j = 0; j < 4; ++j) { const f32x4 g = gr[64 * j]; u32x2 w; w.x = pk2(v[j].x * rs * g.x, v[j].y * rs * g.y); w.y = pk2(v[j].z * rs * g.z, v[j].w * rs * g.w); o8[64 * j] = w; }
}
__device__ __forceinline__ void rms_rows_phase(const float* X, const float* gain, bf16_t* H, int nrows, int gw, int NGW, int lane) {
    for (int m = gw; m < nrows; m += NGW) rms_row_bf16(X + (size_t)m * D, gain, H + (size_t)m * D, lane);
}

__device__ __forceinline__ void rwkv_chain(LAS unsigned char* lds, int cid, const bf16_t* P0, const float* mu, const float* w0, const float* w2, const float* a0, const float* a2,
                                           const float* k_k, const float* k_a, const float* r_k, bf16_t* ORW, bf16_t* SG, float* BONUS) {
    const int tid = threadIdx.x, lane = tid & 63, wid = tid >> 6, fr = lane & 15, fq = lane >> 4;
    const int b = cid >> 4, h = (cid >> 1) & 7, dir = cid & 1;
    LAS float* rS = (LAS float*)(lds); LAS float* kS = (LAS float*)(lds + 8192); LAS float* vS = (LAS float*)(lds + 16384); LAS float* wS = (LAS float*)(lds + 24576);
    LAS float* nkS = (LAS float*)(lds + 32768); LAS float* bS = (LAS float*)(lds + 40960); LAS float* preA = (LAS float*)(lds + 49152); LAS float* preW = (LAS float*)(lds + 57344);
    LAS float* oS = (LAS float*)(lds + 106496); LAS bf16_t* adB = (LAS bf16_t*)(lds + 73728); LAS bf16_t* wdB = (LAS bf16_t*)(lds + 78336);
    LAS bf16_t* a2B = (LAS bf16_t*)(lds + 82944); LAS bf16_t* w2B = (LAS bf16_t*)(lds + 92160); LAS float* cst = (LAS float*)(lds + 101376);
    __syncthreads();
    for (int e = tid; e < 64 * 64; e += 512) { const int j = e & 63, r = e >> 6;
        a2B[j * 72 + r] = (bf16_t)f2bf(a2[r * 512 + h * 64 + j]); w2B[j * 72 + r] = (bf16_t)f2bf(w2[(dir * 64 + r) * 512 + h * 64 + j]); }
    if (tid < 64) { const int j = tid, c = h * 64 + j;
        cst[0 * 64 + j] = a0[c]; cst[1 * 64 + j] = w0[dir * 512 + c]; cst[2 * 64 + j] = k_k[c]; cst[3 * 64 + j] = k_a[c]; cst[4 * 64 + j] = r_k[c];
        cst[5 * 64 + j] = mu[c]; cst[6 * 64 + j] = mu[512 + c]; cst[7 * 64 + j] = mu[1024 + c]; cst[8 * 64 + j] = mu[1536 + j]; cst[9 * 64 + j] = mu[1600 + j];
        cst[10 * 64 + j] = (j < 16) ? mu[1664 + h * 16 + j] : 0.f; }
    f32x2 Sa0 = (f32x2){0.f, 0.f}, Sa1 = Sa0, Sb0 = Sa0, Sb1 = Sa0;
    const int rp2 = tid >> 4, part = tid & 15;
    __syncthreads();
    const bf16_t* Pb = P0 + (size_t)b * SEQ * ABPAD;
    unsigned rc[10], rpv[10], rnx[10]; unsigned short gcv = 0, gpv = 0, gnv = 0;
#define RW_IDX(i) const int grp = (i) >> 1; const int idx_ = tid + 512 * ((i) & 1); const int tok = idx_ >> 5, c2 = (idx_ & 31) * 2; \
                  const int gcol = (grp == 0 ? h * 64 : grp == 1 ? 512 + h * 64 : grp == 2 ? 1024 + h * 64 : grp == 3 ? 1536 : 1600) + c2;
#define RW_ISSUE(t0n) do { _Pragma("unroll") for (int i = 0; i < 10; ++i) { RW_IDX(i) const int t = (t0n) + tok; const bf16_t* p = Pb + (size_t)t * ABPAD + gcol; \
            rc[i] = *(const unsigned*)p; rpv[i] = (t > 0) ? *(const unsigned*)(p - ABPAD) : 0u; rnx[i] = (t < SEQ - 1) ? *(const unsigned*)(p + ABPAD) : 0u; } \
        if (dir == 0) { const int tok = tid >> 4, c = tid & 15, t = (t0n) + tok; const bf16_t* p = Pb + (size_t)t * ABPAD + 1664 + h * 16 + c; \
            gcv = *p; gpv = (t > 0) ? *(p - ABPAD) : (unsigned short)0; gnv = (t < SEQ - 1) ? *(p + ABPAD) : (unsigned short)0; } } while (0)
    RW_ISSUE(dir ? 127 * 32 : 0);
    for (int cc = 0; cc < 128; ++cc) {
        const int t0 = dir ? (127 - cc) * 32 : cc * 32;
#pragma unroll
        for (int i = 0; i < 10; ++i) { RW_IDX(i) (void)gcol;
            const unsigned cur = rc[i], prv = rpv[i], nxt = rnx[i];
            const float m0 = cst[(5 + grp) * 64 + c2], m1 = cst[(5 + grp) * 64 + c2 + 1];
            const float c0 = bflo(cur), c1 = bfhi(cur);
            const float x0 = c0 + m0 * (0.5f * (bflo(prv) + bflo(nxt)) - c0), x1 = c1 + m1 * (0.5f * (bfhi(prv) + bfhi(nxt)) - c1);
            if (grp == 0) { *(LAS f32x2*)(rS + tok * 64 + c2) = (f32x2){x0, x1}; }
            else if (grp == 1) { *(LAS f32x2*)(kS + tok * 64 + c2) = (f32x2){x0, x1}; }
            else if (grp == 2) { *(LAS f32x2*)(vS + tok * 64 + c2) = (f32x2){x0, x1}; }
            else if (grp == 3) { const float e0 = __expf(2.f * x0), e1 = __expf(2.f * x1); *(LAS unsigned*)(wdB + tok * 72 + c2) = pk2(1.f - 2.f * frcp(e0 + 1.f), 1.f - 2.f * frcp(e1 + 1.f)); }
            else { *(LAS unsigned*)(adB + tok * 72 + c2) = pk2(x0, x1); }
        }
        if (dir == 0) {
            const int tok = tid >> 4, c = tid & 15, t = t0 + tok;
            const float cur = bf2f(gcv), prv = bf2f(gpv), nxt = bf2f(gnv);
            const float x = cur + cst[10 * 64 + c] * (0.5f * (prv + nxt) - cur);
            SG[((size_t)b * SEQ + t) * 128 + h * 16 + c] = (bf16_t)f2bf(sigmoidf_(x));
        }
        __syncthreads();
        if (cc + 1 < 128) { const int t0n = dir ? (126 - cc) * 32 : (cc + 1) * 32; RW_ISSUE(t0n); }
        { const int mat = wid >> 2, ntile = wid & 3; const LAS bf16_t* Aop = mat ? wdB : adB; const LAS bf16_t* Bop = mat ? w2B : a2B; LAS float* pre = mat ? preW : preA;
#pragma unroll
          for (int mt = 0; mt < 2; ++mt) { f32x4 acc = (f32x4){0.f, 0.f, 0.f, 0.f};
#pragma unroll
              for (int ks = 0; ks < 2; ++ks) acc = mfma16(ldsfrag(Bop, 72, ntile * 16, ks * 32, fr, fq), ldsfrag(Aop, 72, mt * 16, ks * 32, fr, fq), acc);
              *(LAS f32x4*)(pre + (mt * 16 + fr) * 64 + ntile * 16 + fq * 4) = acc; } }
        __syncthreads();
        { const int tok = tid >> 4, c0 = (tid & 15) * 4; float kkr[4], av[4], kp[4], wv[4]; float ss = 0.f, bon = 0.f;
#pragma unroll
          for (int i = 0; i < 4; ++i) { const int c = c0 + i, ix = tok * 64 + c;
              const float a = sigmoidf_(cst[c] + preA[ix]); const float sg = sigmoidf_(cst[64 + c] + preW[ix]);
              wv[i] = __expf(-0.60653065971f * sg);
              const float kraw = kS[ix]; kkr[i] = kraw * cst[128 + c]; ss += kkr[i] * kkr[i];
              kp[i] = kraw * (1.0f + (a - 1.0f) * cst[192 + c]); av[i] = a; bon += rS[ix] * kp[i] * cst[256 + c]; }
          ss += dppf<0xB1>(ss); bon += dppf<0xB1>(bon); ss += dppf<0x4E>(ss); bon += dppf<0x4E>(bon);
          ss += dppf<0x141>(ss); bon += dppf<0x141>(bon); ss += dppf<0x140>(ss); bon += dppf<0x140>(bon);
          const float inv = frcp(fmaxf(__builtin_amdgcn_sqrtf(ss), 1e-12f));
          f32x4 o_nk, o_b, o_k, o_w;
#pragma unroll
          for (int i = 0; i < 4; ++i) { const float kk = kkr[i] * inv; o_nk[i] = -kk; o_b[i] = kk * av[i]; o_k[i] = kp[i]; o_w[i] = wv[i]; }
          *(LAS f32x4*)(nkS + tok * 64 + c0) = o_nk; *(LAS f32x4*)(bS + tok * 64 + c0) = o_b; *(LAS f32x4*)(kS + tok * 64 + c0) = o_k; *(LAS f32x4*)(wS + tok * 64 + c0) = o_w;
          if (dir == 0 && (tid & 15) == 0) BONUS[((size_t)b * SEQ + t0 + tok) * 8 + h] = bon; }
        __syncthreads();
#pragma unroll 4
        for (int s = 0; s < 32; ++s) {
            const int tt = dir ? 31 - s : s; const int o4 = tt * 64 + part * 4;
            const f32x4 wv = *(const LAS f32x4*)(wS + o4), nv = *(const LAS f32x4*)(nkS + o4), bv = *(const LAS f32x4*)(bS + o4), kv = *(const LAS f32x4*)(kS + o4), rv = *(const LAS f32x4*)(rS + o4);
            const f32x2 vv = *(const LAS f32x2*)(vS + tt * 64 + 2 * rp2);
            const f32x2 w0 = (f32x2){wv[0], wv[1]}, w1 = (f32x2){wv[2], wv[3]}, n0 = (f32x2){nv[0], nv[1]}, n1 = (f32x2){nv[2], nv[3]};
            const f32x2 b0 = (f32x2){bv[0], bv[1]}, b1 = (f32x2){bv[2], bv[3]}, k0 = (f32x2){kv[0], kv[1]}, k1 = (f32x2){kv[2], kv[3]}, r0 = (f32x2){rv[0], rv[1]}, r1 = (f32x2){rv[2], rv[3]};
            const f32x2 pa = Sa0 * n0 + Sa1 * n1, pb = Sb0 * n0 + Sb1 * n1;
            float saA = pa.x + pa.y, saB = pb.x + pb.y;
            saA += dppf<0xB1>(saA); saB += dppf<0xB1>(saB); saA += dppf<0x4E>(saA); saB += dppf<0x4E>(saB);
            saA += dppf<0x141>(saA); saB += dppf<0x141>(saB); saA += dppf<0x140>(saA); saB += dppf<0x140>(saB);
            const f32x2 sA = (f32x2){saA, saA}, sB = (f32x2){saB, saB}, vA = (f32x2){vv.x, vv.x}, vB = (f32x2){vv.y, vv.y};
            Sa0 = Sa0 * w0 + (b0 * sA + k0 * vA); Sa1 = Sa1 * w1 + (b1 * sA + k1 * vA);
            Sb0 = Sb0 * w0 + (b0 * sB + k0 * vB); Sb1 = Sb1 * w1 + (b1 * sB + k1 * vB);
            const f32x2 qa = Sa0 * r0 + Sa1 * r1, qb = Sb0 * r0 + Sb1 * r1;
            float oA = qa.x + qa.y, oB = qb.x + qb.y;
            oA += dppf<0xB1>(oA); oB += dppf<0xB1>(oB); oA += dppf<0x4E>(oA); oB += dppf<0x4E>(oB);
            if ((part & 3) == 0) *(LAS f32x2*)(oS + (part >> 2) * 2048 + tt * 64 + 2 * rp2) = (f32x2){oA, oB};
        }
        __syncthreads();
        { const int tok = tid >> 4, c0 = (tid & 15) * 4; const f32x4 o = (*(const LAS f32x4*)(oS + tok * 64 + c0) + *(const LAS f32x4*)(oS + 2048 + tok * 64 + c0)) + (*(const LAS f32x4*)(oS + 4096 + tok * 64 + c0) + *(const LAS f32x4*)(oS + 6144 + tok * 64 + c0));
          u32x2 w; w.x = pk2(o[0], o[1]); w.y = pk2(o[2], o[3]);
          *(u32x2*)(ORW + (size_t)dir * T * 512 + ((size_t)b * SEQ + t0 + tok) * 512 + h * 64 + c0) = w; }
    }
#undef RW_IDX
#undef RW_ISSUE
    __syncthreads();
}

__device__ __forceinline__ void rwkv_combine(const bf16_t* P0, const bf16_t* ORW, const float* BONUS, const bf16_t* G, const float* mu, const float* gn_w, const float* gn_b, bf16_t* OMIX, int gw, int NGW, int lane) {
    const int c0 = lane * 8, head = lane >> 3;
    float muv[8], gw8[8], gb8[8];
#pragma unroll
    for (int i = 0; i < 8; ++i) { muv[i] = mu[1024 + c0 + i]; gw8[i] = gn_w[c0 + i]; gb8[i] = gn_b[c0 + i]; }
    for (int tk = gw; tk < T; tk += NGW) {
        const int t = tk & (SEQ - 1);
        const u32x4 uf = *(const u32x4*)(ORW + (size_t)tk * 512 + c0), ub = *(const u32x4*)(ORW + (size_t)T * 512 + (size_t)tk * 512 + c0);
        float o[8];
#pragma unroll
        for (int i = 0; i < 4; ++i) { o[2 * i] = bflo(uf[i]) + bflo(ub[i]); o[2 * i + 1] = bfhi(uf[i]) + bfhi(ub[i]); }
        float s = 0.f;
#pragma unroll
        for (int i = 0; i < 8; ++i) s += o[i];
        const float mean = sum8(s) * (1.f / 64.f); float q = 0.f;
#pragma unroll
        for (int i = 0; i < 8; ++i) { o[i] -= mean; q += o[i] * o[i]; }
        const float rstd = rsqrtf(sum8(q) * (1.f / 64.f) + 64e-5f);
        const bf16_t* pv = P0 + (size_t)tk * ABPAD + 1024 + c0;
        const u32x4 vc = *(const u32x4*)pv; u32x4 vp = (u32x4){0u, 0u, 0u, 0u}, vn = (u32x4){0u, 0u, 0u, 0u};
        if (t > 0) vp = *(const u32x4*)(pv - ABPAD);
        if (t < SEQ - 1) vn = *(const u32x4*)(pv + ABPAD);
        const u32x4 gg = *(const u32x4*)(G + (size_t)tk * 512 + c0);
        const float bon = BONUS[(size_t)tk * 8 + head];
        float r[8];
#pragma unroll
        for (int i = 0; i < 4; ++i) {
            const float c_lo = bflo(vc[i]), c_hi = bfhi(vc[i]);
            const float v_lo = c_lo + muv[2 * i] * (0.5f * (bflo(vp[i]) + bflo(vn[i])) - c_lo), v_hi = c_hi + muv[2 * i + 1] * (0.5f * (bfhi(vp[i]) + bfhi(vn[i])) - c_hi);
            r[2 * i] = (o[2 * i] * rstd * gw8[2 * i] + gb8[2 * i] + bon * v_lo) * bflo(gg[i]);
            r[2 * i + 1] = (o[2 * i + 1] * rstd * gw8[2 * i + 1] + gb8[2 * i + 1] + bon * v_hi) * bfhi(gg[i]); }
        u32x4 w; w.x = pk2(r[0], r[1]); w.y = pk2(r[2], r[3]); w.z = pk2(r[4], r[5]); w.w = pk2(r[6], r[7]);
        *(u32x4*)(OMIX + (size_t)tk * D + c0) = w;
    }
}

constexpr int SLD = 136;
__device__ __forceinline__ float softplusf_(float x) { return x > 20.f ? x : log1pf(__expf(x)); }
__device__ __forceinline__ void ssd_dt_cum(LAS float* dtS, LAS float* cumS, LAS float* totS, const bf16_t* Prow0, int g, int w, int lane, const float* dt_bias, const float* a_log) {
    const int j = w >> 1, d = w & 1, head = g * 4 + j;
    const float bias = dt_bias[d * 8 + head], A = -__expf(a_log[d * 8 + head]);
    const float x0 = bf2f(Prow0[(size_t)(2 * lane) * ABPAD + 3328 + head]), x1 = bf2f(Prow0[(size_t)(2 * lane + 1) * ABPAD + 3328 + head]);
    const float dt0 = softplusf_(x0 + bias), dt1 = softplusf_(x1 + bias), la0 = dt0 * A, la1 = dt1 * A;
    const float s = la0 + la1; float inc = s;
#pragma unroll
    for (int off = 1; off < 64; off <<= 1) { const float n = __shfl_up(inc, off); if (lane >= off) inc += n; }
    const float tot = __shfl(inc, 63), exc = inc - s;
    float c0, c1; if (d == 0) { c0 = exc + la0; c1 = inc; } else { c0 = tot - exc; c1 = tot - exc - la0; }
    dtS[w * 128 + 2 * lane] = dt0; dtS[w * 128 + 2 * lane + 1] = dt1; cumS[w * 128 + 2 * lane] = c0; cumS[w * 128 + 2 * lane + 1] = c1;
    if (lane == 0) totS[w] = tot;
}
template <int NR, bool TR> __device__ __forceinline__ void ssd_conv8(LAS bf16_t* dst, int col0, int cx0, int l0, const bf16_t* Pb, int t0, const float* cw, const float* cb) {
    u32x4 raw[NR + 2];
    const bf16_t* p = Pb + (size_t)(t0 + l0) * ABPAD + 2304 + cx0;
#pragma unroll
    for (int i = 0; i < NR + 2; ++i) { const int t = t0 + l0 + i - 1; raw[i] = (t >= 0 && t < SEQ) ? *(const u32x4*)(p + (long)(i - 1) * ABPAD) : (u32x4){0u, 0u, 0u, 0u}; }
    float w0[8], w1[8], w2[8], bs[8];
#pragma unroll
    for (int q = 0; q < 2; ++q) { const f32x4 a = *(const f32x4*)(cw + cx0 + 4 * q), bq = *(const f32x4*)(cw + 1024 + cx0 + 4 * q), c = *(const f32x4*)(cw + 2048 + cx0 + 4 * q), d = *(const f32x4*)(cb + cx0 + 4 * q);
#pragma unroll
        for (int i = 0; i < 4; ++i) { w0[4 * q + i] = a[i]; w1[4 * q + i] = bq[i]; w2[4 * q + i] = c[i]; bs[4 * q + i] = d[i]; } }
    float o[NR][8];
#pragma unroll
    for (int i = 0; i < NR; ++i)
#pragma unroll
        for (int c = 0; c < 8; ++c) { const unsigned um = raw[i][c >> 1], u0 = raw[i + 1][c >> 1], up = raw[i + 2][c >> 1];
            const float fm = (c & 1) ? bfhi(um) : bflo(um), f0 = (c & 1) ? bfhi(u0) : bflo(u0), fp = (c & 1) ? bfhi(up) : bflo(up);
            o[i][c] = siluf_(w0[c] * fm + w1[c] * f0 + w2[c] * fp + bs[c]); }
    if (TR) {
#pragma unroll
        for (int c = 0; c < 8; ++c) { LAS bf16_t* q = dst + (col0 + c) * SLD + l0;
            if (NR == 8) { u32x4 w; w.x = pk2(o[0][c], o[1][c]); w.y = pk2(o[2][c], o[3][c]); w.z = pk2(o[4 % NR][c], o[5 % NR][c]); w.w = pk2(o[6 % NR][c], o[7 % NR][c]); *(LAS u32x4*)q = w; }
            else { u32x2 w; w.x = pk2(o[0][c], o[1][c]); w.y = pk2(o[2][c], o[3][c]); *(LAS u32x2*)q = w; } }
    } else {
#pragma unroll
        for (int i = 0; i < NR; ++i) { u32x4 w; w.x = pk2(o[i][0], o[i][1]); w.y = pk2(o[i][2], o[i][3]); w.z = pk2(o[i][4], o[i][5]); w.w = pk2(o[i][6], o[i][7]); *(LAS u32x4*)(dst + (l0 + i) * SLD + col0) = w; }
    }
}
__device__ __forceinline__ void ssd_s1_unit(LAS unsigned char* lds, int unit, const bf16_t* P0, const float* cw, const float* cb, const float* dt_bias, const float* a_log, bf16_t* STATES, float* TOT) {
    const int tid = threadIdx.x, lane = tid & 63, w = tid >> 6, fr = lane & 15, fq = lane >> 4;
    const int g = unit & 1, c = (unit >> 1) & 31, b = unit >> 6, t0 = c * 128;
    LAS bf16_t* BT = (LAS bf16_t*)lds; LAS bf16_t* XT = (LAS bf16_t*)(lds + 34816); LAS float* dtS = (LAS float*)(lds + 104448); LAS float* cumS = (LAS float*)(lds + 108544);
    LAS float* scS = (LAS float*)(lds + 112640); LAS float* totS = (LAS float*)(lds + 116736);
    const bf16_t* Pb = P0 + (size_t)b * SEQ * ABPAD;
    __syncthreads();
    ssd_conv8<4, true>(BT, (tid & 15) * 8, 512 + g * 128 + (tid & 15) * 8, (tid >> 4) * 4, Pb, t0, cw, cb);
    ssd_conv8<8, true>(XT, (tid & 31) * 8, g * 256 + (tid & 31) * 8, (tid >> 5) * 8, Pb, t0, cw, cb);
    ssd_dt_cum(dtS, cumS, totS, Pb + (size_t)t0 * ABPAD, g, w, lane, dt_bias, a_log);
    __syncthreads();
    for (int e = tid; e < 1024; e += 512) scS[e] = dtS[e] * __expf(totS[e >> 7] - cumS[e]);
    if (tid < 8) TOT[((size_t)(b * 32 + c) * 2 + (tid & 1)) * 8 + g * 4 + (tid >> 1)] = totS[tid];
    __syncthreads();
    const int j = w >> 1;
#pragma unroll 1
    for (int d = 0; d < 2; ++d) {
        f32x4 acc[2][8];
#pragma unroll
        for (int mt = 0; mt < 2; ++mt)
#pragma unroll
            for (int nt = 0; nt < 8; ++nt) acc[mt][nt] = (f32x4){0.f, 0.f, 0.f, 0.f};
#pragma unroll 1
        for (int ks = 0; ks < 4; ++ks) {
            const int k0 = ks * 32; const LAS float* sp = scS + (j * 2 + d) * 128 + k0 + fq * 8;
            const f32x4 s0 = *(const LAS f32x4*)sp, s1 = *(const LAS f32x4*)(sp + 4);
            bf16x8 afr[2];
#pragma unroll
            for (int mt = 0; mt < 2; ++mt) { const u32x4 raw = *(const LAS u32x4*)(XT + (32 * w + mt * 16 + fr) * SLD + k0 + fq * 8); u32x4 o;
                o.x = pk2(bflo(raw.x) * s0[0], bfhi(raw.x) * s0[1]); o.y = pk2(bflo(raw.y) * s0[2], bfhi(raw.y) * s0[3]);
                o.z = pk2(bflo(raw.z) * s1[0], bfhi(raw.z) * s1[1]); o.w = pk2(bflo(raw.w) * s1[2], bfhi(raw.w) * s1[3]);
                afr[mt] = __builtin_bit_cast(bf16x8, o); }
#pragma unroll
            for (int nt = 0; nt < 8; ++nt) { const bf16x8 bfr = ldsfrag(BT, SLD, nt * 16, k0, fr, fq);
#pragma unroll
                for (int mt = 0; mt < 2; ++mt) acc[mt][nt] = mfma16(bfr, afr[mt], acc[mt][nt]); }
        }
        bf16_t* dst = STATES + (((size_t)(b * 32 + c) * 2 + d) * 8 + g * 4 + j) * 8192;
#pragma unroll
        for (int mt = 0; mt < 2; ++mt) { const int p = (w & 1) * 32 + mt * 16 + fr;
#pragma unroll
            for (int nt = 0; nt < 8; ++nt) { u32x2 o; o.x = pk2(acc[mt][nt][0], acc[mt][nt][1]); o.y = pk2(acc[mt][nt][2], acc[mt][nt][3]);
                *(u32x2*)(dst + p * 128 + nt * 16 + fq * 4) = o; } }
    }
}
__device__ __forceinline__ void ssd_s2(bf16_t* STATES, const float* TOT, int gtid, int NGT) {
    for (int it = gtid; it < 16 * 2 * 8 * 1024; it += NGT) {
        const int e8 = it & 1023, head = (it >> 10) & 7, d = (it >> 13) & 1, b = it >> 14;
        float run[8];
#pragma unroll
        for (int i = 0; i < 8; ++i) run[i] = 0.f;
#pragma unroll 8
        for (int cc = 0; cc < 32; ++cc) {
            const int c = d ? 31 - cc : cc; const size_t sidx = ((size_t)(b * 32 + c) * 2 + d) * 8 + head;
            u32x4* p = (u32x4*)(STATES + sidx * 8192 + e8 * 8); const u32x4 loc = *p; const float dec = __expf(TOT[sidx]);
            u32x4 o; o.x = pk2(run[0], run[1]); o.y = pk2(run[2], run[3]); o.z = pk2(run[4], run[5]); o.w = pk2(run[6], run[7]); *p = o;
#pragma unroll
            for (int i = 0; i < 4; ++i) { run[2 * i] = run[2 * i] * dec + bflo(loc[i]); run[2 * i + 1] = run[2 * i + 1] * dec + bfhi(loc[i]); }
        }
    }
}
__device__ __forceinline__ void ssd_s3_unit(LAS unsigned char* lds, int unit, const bf16_t* P0, const float* cw, const float* cb, const float* dt_bias, const float* a_log, const float* dskip, const float* norm_w,
                                            const bf16_t* STATES, bf16_t* OMIX) {
    const int tid = threadIdx.x, lane = tid & 63, w = tid >> 6, fr = lane & 15, fq = lane >> 4;
    const int g = unit & 1, c = (unit >> 1) & 31, b = unit >> 6, t0 = c * 128;
    LAS bf16_t* CS = (LAS bf16_t*)lds; LAS bf16_t* BS = (LAS bf16_t*)(lds + 34816); LAS bf16_t* XT = (LAS bf16_t*)(lds + 69632);
    LAS float* dtS = (LAS float*)(lds + 139264); LAS float* cumS = (LAS float*)(lds + 143360); LAS float* totS = (LAS float*)(lds + 147456);
    const bf16_t* Pb = P0 + (size_t)b * SEQ * ABPAD;
    __syncthreads();
    ssd_conv8<4, false>(BS, (tid & 15) * 8, 512 + g * 128 + (tid & 15) * 8, (tid >> 4) * 4, Pb, t0, cw, cb);
    ssd_conv8<4, false>(CS, (tid & 15) * 8, 768 + g * 128 + (tid & 15) * 8, (tid >> 4) * 4, Pb, t0, cw, cb);
    ssd_conv8<8, true>(XT, (tid & 31) * 8, g * 256 + (tid & 31) * 8, (tid >> 5) * 8, Pb, t0, cw, cb);
    ssd_dt_cum(dtS, cumS, totS, Pb + (size_t)t0 * ABPAD, g, w, lane, dt_bias, a_log);
    __syncthreads();
    const int l = 16 * w + fr;
    f32x4 sc[8];
#pragma unroll
    for (int nt = 0; nt < 8; ++nt) sc[nt] = (f32x4){0.f, 0.f, 0.f, 0.f};
#pragma unroll
    for (int ks = 0; ks < 4; ++ks) { const bf16x8 afr = ldsfrag(CS, SLD, 16 * w, ks * 32, fr, fq);
#pragma unroll
        for (int nt = 0; nt < 8; ++nt) sc[nt] = mfma16(ldsfrag(BS, SLD, nt * 16, ks * 32, fr, fq), afr, sc[nt]); }
    __syncthreads();
    LAS bf16_t* Mw = BS + w * 16 * SLD;
    const size_t row = (size_t)b * SEQ + t0 + l; float ss = 0.f;
#pragma unroll 1
    for (int j = 0; j < 4; ++j) {
        const LAS float* cf = cumS + (j * 2) * 128; const LAS float* cbw = cumS + (j * 2 + 1) * 128; const LAS float* df = dtS + (j * 2) * 128; const LAS float* db = dtS + (j * 2 + 1) * 128;
        const float cfl = cf[l], cbl = cbw[l];
        const size_t sbase = ((size_t)(b * 32 + c) * 2) * 8 + g * 4 + j;
        const bf16_t* carf = STATES + sbase * 8192; const bf16_t* carb = STATES + (sbase + 8) * 8192;
        bf16x8 cF[4][4], cB[4][4]; u32x2 zz4[4];
#pragma unroll
        for (int ks = 0; ks < 4; ++ks)
#pragma unroll
            for (int pt = 0; pt < 4; ++pt) cF[ks][pt] = *(const bf16x8*)(carf + (pt * 16 + fr) * 128 + ks * 32 + fq * 8);
#pragma unroll
        for (int pt = 0; pt < 4; ++pt) zz4[pt] = *(const u32x2*)(P0 + row * ABPAD + 1792 + g * 256 + j * 64 + pt * 16 + fq * 4);
#pragma unroll
        for (int nt = 0; nt < 8; ++nt) { float mv[4];
#pragma unroll
            for (int i = 0; i < 4; ++i) { const int s = nt * 16 + fq * 4 + i;
                const float ff = (s <= l) ? __expf(cfl - cf[s]) * df[s] : 0.f; const float fb = (s >= l) ? __expf(cbl - cbw[s]) * db[s] : 0.f;
                mv[i] = sc[nt][i] * (ff + fb); }
            u32x2 o; o.x = pk2(mv[0], mv[1]); o.y = pk2(mv[2], mv[3]); *(LAS u32x2*)(Mw + fr * SLD + nt * 16 + fq * 4) = o; }
        LDS_WAIT();
#pragma unroll
        for (int ks = 0; ks < 4; ++ks)
#pragma unroll
            for (int pt = 0; pt < 4; ++pt) cB[ks][pt] = *(const bf16x8*)(carb + (pt * 16 + fr) * 128 + ks * 32 + fq * 8);
        f32x4 yd[4], yf[4], yb[4];
#pragma unroll
        for (int pt = 0; pt < 4; ++pt) { yd[pt] = (f32x4){0.f, 0.f, 0.f, 0.f}; yf[pt] = yd[pt]; yb[pt] = yd[pt]; }
        bf16x8 acs[4];
#pragma unroll
        for (int ks = 0; ks < 4; ++ks) {
            const bf16x8 am = *(const LAS bf16x8*)(Mw + fr * SLD + ks * 32 + fq * 8); acs[ks] = ldsfrag(CS, SLD, 16 * w, ks * 32, fr, fq);
#pragma unroll
            for (int pt = 0; pt < 4; ++pt) {
                yd[pt] = mfma16(ldsfrag(XT, SLD, j * 64 + pt * 16, ks * 32, fr, fq), am, yd[pt]);
                yf[pt] = mfma16(cF[ks][pt], acs[ks], yf[pt]); }
        }
#pragma unroll
        for (int ks = 0; ks < 4; ++ks)
#pragma unroll
            for (int pt = 0; pt < 4; ++pt) yb[pt] = mfma16(cB[ks][pt], acs[ks], yb[pt]);
        const float ef = __expf(cfl), eb = __expf(cbl), dsk = dskip[g * 4 + j];
#pragma unroll
        for (int pt = 0; pt < 4; ++pt) { const f32x4 yv = yd[pt] + yf[pt] * ef + yb[pt] * eb;
            const int col = j * 64 + pt * 16 + fq * 4; const u32x2 zz = zz4[pt];
            const float z4[4] = {bflo(zz.x), bfhi(zz.x), bflo(zz.y), bfhi(zz.y)}; float v4[4];
#pragma unroll
            for (int i = 0; i < 4; ++i) { const float xs = bf2f(XT[(col + i) * SLD + l]); float v = yv[i] + dsk * xs; const float z = z4[i]; v = v * siluf_(z);
                v4[i] = v; ss += v * v; }
            u32x2 o; o.x = pk2(v4[0], v4[1]); o.y = pk2(v4[2], v4[3]); *(u32x2*)(OMIX + row * D + 512 + g * 256 + col) = o; }
        asm volatile("" ::: "memory");
    }
    ss += __shfl_xor(ss, 16); ss += __shfl_xor(ss, 32);
    const float rs = rsqrtf(ss * (1.f / 256.f) + 1e-6f);
    asm volatile("s_waitcnt vmcnt(0)" ::: "memory");
#pragma unroll 4
    for (int q = 0; q < 16; ++q) { const int col = g * 256 + q * 16 + fq * 4; const f32x4 nw = *(const f32x4*)(norm_w + col);
        u32x2* p = (u32x2*)(OMIX + row * D + 512 + col); const u32x2 v = *p;
        u32x2 o; o.x = pk2(bflo(v.x) * rs * nw[0], bfhi(v.x) * rs * nw[1]); o.y = pk2(bflo(v.y) * rs * nw[2], bfhi(v.y) * rs * nw[3]); *p = o; }
}

constexpr int HLD = 136, HLS = 72;
__device__ __forceinline__ void hgrn_chain(LAS unsigned char* lds, int cid, bf16_t* P1, const float* hg_lb, bf16_t* Ob, int ldo, int ocbase, int ocdir) {
    const int tid = threadIdx.x, lane = tid & 63, w = tid >> 6, fr = lane & 15, fq = lane >> 4;
    const int b = cid >> 4, h = (cid >> 1) & 7, dir = cid & 1;
    LAS bf16_t* QE = (LAS bf16_t*)lds;
    LAS bf16_t* KE = (LAS bf16_t*)(lds + 17408);
    LAS bf16_t* KLT = (LAS bf16_t*)(lds + 34816);
    LAS bf16_t* VT = (LAS bf16_t*)(lds + 53248);
    LAS bf16_t* AT = (LAS bf16_t*)(lds + 71680);
    LAS bf16_t* ST = (LAS bf16_t*)(lds + 80896);
    LAS float* totS = (LAS float*)(lds + 115712);
    LAS float* lastS = (LAS float*)(lds + 117760);
    __syncthreads();
    for (int e = tid; e < 128 * HLD / 2; e += 512) ((LAS unsigned*)ST)[e] = 0u;
    const int dcol = tid & 127, qtr = tid >> 7, i0 = qtr * 16;
    const float lbv = frcp(1.0f + __expf(hg_lb[h * 128 + dcol] - hg_lb[1024 + h * 128 + dcol]));
    f32x4 st[8];
#pragma unroll
    for (int i = 0; i < 8; ++i) st[i] = (f32x4){0.f, 0.f, 0.f, 0.f};
    bf16_t* Pb = P1 + (size_t)b * SEQ * HGP;
    __syncthreads();
    unsigned short rq[16], rf[16], rv[16];
#define HG_ISSUE(t0n) do { _Pragma("unroll") for (int i = 0; i < 16; ++i) { const int tk = (t0n) + (dir ? 63 - (i0 + i) : (i0 + i)); const bf16_t* pr = Pb + (size_t)tk * HGP + h * 128 + dcol; \
        rq[i] = pr[0]; rf[i] = pr[1024 * (1 + dir)]; rv[i] = pr[3072]; } } while (0)
    HG_ISSUE((dir ? 63 : 0) * 64);
    for (int cc = 0; cc < 64; ++cc) {
        const int t0 = (dir ? 63 - cc : cc) * 64;
        float gq[16], gk[16], gc[16]; float run = 0.f;
#pragma unroll
        for (int i = 0; i < 16; ++i) { const float q = bf2f(rq[i]), fr_ = bf2f(rf[i]);
            const float f = lbv + (1.0f - lbv) * sigmoidf_(fr_); run += __logf(f); gq[i] = q; gk[i] = 1.0f - f; gc[i] = run; }
        totS[qtr * 128 + dcol] = run;
#pragma unroll
        for (int i = 0; i < 16; i += 2) *(LAS unsigned*)(VT + dcol * HLS + i0 + i) = (unsigned)rv[i] | ((unsigned)rv[i + 1] << 16);
        __syncthreads();
        { float pre = 0.f, tot = 0.f;
#pragma unroll
          for (int q4 = 0; q4 < 4; ++q4) { const float tq = totS[q4 * 128 + dcol]; if (q4 < qtr) pre += tq; tot += tq; }
          if (qtr == 0) lastS[dcol] = __expf(tot);
#pragma unroll
          for (int i = 0; i < 16; i += 2) { const float b0 = pre + gc[i], b1 = pre + gc[i + 1];
              const float e0 = __expf(b0), e1 = __expf(b1), n0 = __expf(-b0), n1 = __expf(-b1), l0 = __expf(tot - b0), l1 = __expf(tot - b1);
              QE[(i0 + i) * HLD + dcol] = (bf16_t)f2bf(gq[i] * e0); QE[(i0 + i + 1) * HLD + dcol] = (bf16_t)f2bf(gq[i + 1] * e1);
              KE[(i0 + i) * HLD + dcol] = (bf16_t)f2bf(gk[i] * n0); KE[(i0 + i + 1) * HLD + dcol] = (bf16_t)f2bf(gk[i + 1] * n1);
              *(LAS unsigned*)(KLT + dcol * HLS + i0 + i) = pk2(gk[i] * l0, gk[i + 1] * l1); } }
        if (cc + 1 < 64) HG_ISSUE((dir ? 62 - cc : cc + 1) * 64);
        __syncthreads();
        { const int mt = w >> 1;
#pragma unroll
          for (int n2 = 0; n2 < 2; ++n2) { const int nt = (w & 1) * 2 + n2; f32x4 acc = (f32x4){0.f, 0.f, 0.f, 0.f};
#pragma unroll
              for (int ks = 0; ks < 4; ++ks) acc = mfma16(ldsfrag(KE, HLD, nt * 16, ks * 32, fr, fq), ldsfrag(QE, HLD, mt * 16, ks * 32, fr, fq), acc);
              const int lrow = mt * 16 + fr; float mv[4];
#pragma unroll
              for (int i = 0; i < 4; ++i) { const int s = nt * 16 + fq * 4 + i; mv[i] = (s <= lrow) ? acc[i] : 0.f; }
              u32x2 o; o.x = pk2(mv[0], mv[1]); o.y = pk2(mv[2], mv[3]); *(LAS u32x2*)(AT + lrow * HLS + nt * 16 + fq * 4) = o; } }
        __syncthreads();
        { const int mt = w >> 1;
#pragma unroll
          for (int n4 = 0; n4 < 4; ++n4) { const int nt = (w & 1) * 4 + n4; f32x4 acc = (f32x4){0.f, 0.f, 0.f, 0.f};
#pragma unroll
              for (int ks = 0; ks < 2; ++ks) acc = mfma16(ldsfrag(VT, HLS, nt * 16, ks * 32, fr, fq), ldsfrag(AT, HLS, mt * 16, ks * 32, fr, fq), acc);
#pragma unroll
              for (int ks = 0; ks < 4; ++ks) acc = mfma16(ldsfrag(ST, HLD, nt * 16, ks * 32, fr, fq), ldsfrag(QE, HLD, mt * 16, ks * 32, fr, fq), acc);
              const int i = mt * 16 + fr, tk = t0 + (dir ? 63 - i : i);
              u32x2 o; o.x = pk2(acc[0], acc[1]); o.y = pk2(acc[2], acc[3]);
              *(u32x2*)(Ob + ((size_t)b * SEQ + tk) * ldo + ocbase + ocdir * dir + h * 128 + nt * 16 + fq * 4) = o; } }
#pragma unroll
        for (int nt = 0; nt < 8; ++nt) { const f32x4 el = *(const LAS f32x4*)(lastS + nt * 16 + fq * 4); st[nt] = st[nt] * el;
#pragma unroll
            for (int ks = 0; ks < 2; ++ks) st[nt] = mfma16(ldsfrag(KLT, HLS, nt * 16, ks * 32, fr, fq), ldsfrag(VT, HLS, w * 16, ks * 32, fr, fq), st[nt]); }
        __syncthreads();
#pragma unroll
        for (int nt = 0; nt < 8; ++nt) { u32x2 o; o.x = pk2(st[nt][0], st[nt][1]); o.y = pk2(st[nt][2], st[nt][3]); *(LAS u32x2*)(ST + (w * 16 + fr) * HLD + nt * 16 + fq * 4) = o; }
    }
    __syncthreads();
}
__device__ __forceinline__ void hgrn_combine(const bf16_t* P1, const float* norm_w, bf16_t* OMIX, int gw, int NGW, int lane) {
    const int c0 = lane * 16;
    for (int tk = gw; tk < T; tk += NGW) {
        const bf16_t* pr = P1 + (size_t)tk * HGP + c0; float o[16]; float ss = 0.f;
#pragma unroll
        for (int hh = 0; hh < 2; ++hh) { const u32x4 uf = *(const u32x4*)(pr + 1024 + hh * 8), ub = *(const u32x4*)(pr + 2048 + hh * 8);
#pragma unroll
            for (int i = 0; i < 4; ++i) { o[hh * 8 + 2 * i] = bflo(uf[i]) + bflo(ub[i]); o[hh * 8 + 2 * i + 1] = bfhi(uf[i]) + bfhi(ub[i]); } }
#pragma unroll
        for (int i = 0; i < 16; ++i) ss += o[i] * o[i];
        const float rs = rsqrtf(sum8(ss) * (1.f / 128.f) + 1e-6f);
#pragma unroll
        for (int hh = 0; hh < 2; ++hh) { const u32x4 ug = *(const u32x4*)(pr + 4096 + hh * 8); float r[8];
#pragma unroll
            for (int i = 0; i < 4; ++i) { const float g0 = bflo(ug[i]), g1 = bfhi(ug[i]);
                r[2 * i] = o[hh * 8 + 2 * i] * rs * norm_w[c0 + hh * 8 + 2 * i] * siluf_(g0);
                r[2 * i + 1] = o[hh * 8 + 2 * i + 1] * rs * norm_w[c0 + hh * 8 + 2 * i + 1] * siluf_(g1); }
            u32x4 wv; wv.x = pk2(r[0], r[1]); wv.y = pk2(r[2], r[3]); wv.z = pk2(r[4], r[5]); wv.w = pk2(r[6], r[7]);
            *(u32x4*)(OMIX + (size_t)tk * D + c0 + hh * 8) = wv; }
    }
}

#define XB_TMO      128
#define XB_XCNT(j)  (256  + 64 * (j))
#define XB_XSUB(j)  (1280 + 64 * (j))
#define XB_XGEN(j)  (2304 + 64 * (j))
#define XB_TOP      3328
#define XB_TOPGEN   3392
#define XCD_BAR_WORDS 3456
#define XB_SPIN_CAP (1u << 18)

__device__ __forceinline__ unsigned xb_ld(unsigned* p)              { return __hip_atomic_load(p, __ATOMIC_RELAXED, __HIP_MEMORY_SCOPE_AGENT); }
__device__ __forceinline__ unsigned xb_add(unsigned* p, unsigned v) { return __hip_atomic_fetch_add(p, v, __ATOMIC_RELAXED, __HIP_MEMORY_SCOPE_AGENT); }
__device__ __forceinline__ unsigned xb_xcc_id() { return (unsigned)__builtin_amdgcn_s_getreg((3 << 11) | 20) & 0xFu; }
#define XB_SPIN(cond, bar) do { unsigned _sp = 0; while (cond) { __builtin_amdgcn_s_sleep(1); \
    if ((++_sp & 255u) == 0u) { if (xb_ld(&(bar)[XB_TMO])) break; if (_sp > XB_SPIN_CAP) { atomicAdd(&(bar)[XB_TMO], 1u); break; } } } } while (0)

struct XcdBarrier {
    unsigned* bar; unsigned x;
    volatile LAS unsigned* st;
};

__device__ __forceinline__ XcdBarrier xcd_barrier_post(unsigned* bar, volatile LAS unsigned* st) {
    XcdBarrier b; b.bar = bar; b.x = xb_xcc_id(); b.st = st;
    if (threadIdx.x == 0) (void)xb_add(&bar[XB_XCNT(b.x)], 1u);
    return b;
}
__device__ __forceinline__ void xcd_barrier_complete(unsigned* bar, unsigned x, unsigned& nloc, unsigned& nx) {
    const unsigned G = gridDim.x * gridDim.y * gridDim.z;
    unsigned sum, cnt, mine, sp = 0u;
    for (;;) {
        sum = 0u; cnt = 0u; mine = 0u;
#pragma unroll
        for (unsigned j = 0; j < 16; ++j) { const unsigned c = xb_ld(&bar[XB_XCNT(j)]); sum += c; cnt += (c > 0u) ? 1u : 0u; mine = (j == x) ? c : mine; }
        if (sum == G) break;
        __builtin_amdgcn_s_sleep(1);
        if ((++sp & 255u) == 0u) { if (xb_ld(&bar[XB_TMO])) break; if (sp > XB_SPIN_CAP) { atomicAdd(&bar[XB_TMO], 1u); break; } }
    }
    nloc = mine > 0u ? mine : 1u; nx = cnt > 0u ? cnt : 1u;
}

__device__ __forceinline__ void xcd_barrier(const XcdBarrier& b) {
    asm volatile("s_waitcnt vmcnt(0)" ::: "memory");
    __syncthreads();
    if (threadIdx.x == 0) {
        unsigned* bar = b.bar;
        __builtin_amdgcn_s_waitcnt(0);
        unsigned nloc = b.st[0], nx = b.st[1];
        if (nloc == 0u) { xcd_barrier_complete(bar, b.x, nloc, nx); b.st[0] = nloc; b.st[1] = nx; }
        const unsigned old = xb_add(&bar[XB_XSUB(b.x)], 1u);
        const unsigned gen = old / nloc;
        if (old + 1u == (gen + 1u) * nloc) {
            __builtin_amdgcn_fence(__ATOMIC_RELEASE, "agent");
            asm volatile("s_waitcnt vmcnt(0)" ::: "memory");
            const unsigned og = xb_add(&bar[XB_TOP], 1u);
            const unsigned tg = og / nx;
            if (og + 1u == (tg + 1u) * nx) xb_add(&bar[XB_TOPGEN], 1u);
            else XB_SPIN(xb_ld(&bar[XB_TOPGEN]) == tg, bar);
            __builtin_amdgcn_fence(__ATOMIC_ACQUIRE, "agent");
            xb_add(&bar[XB_XGEN(b.x)], 1u);
            asm volatile("s_waitcnt vmcnt(0)" ::: "memory");
        } else {
            XB_SPIN(xb_ld(&bar[XB_XGEN(b.x)]) == gen, bar);
            __builtin_amdgcn_fence(__ATOMIC_ACQUIRE, "agent");
            asm volatile("s_waitcnt vmcnt(0)" ::: "memory");
        }
    }
    __syncthreads();
}


struct Args { const float* in[35]; float* out; unsigned char* ws; int ph_lo, ph_hi; };
static_assert(sizeof(Args) == 304, "Args layout");

__global__ void __launch_bounds__(512, 2) mk_fwd(Args args) {
    extern __shared__ __attribute__((aligned(16))) unsigned char lds_raw[];
    LAS unsigned char* lds = (LAS unsigned char*)lds_raw; LAS unsigned char* xl = lds + XLDS_OFF;
    const int G = gridDim.x, bx = blockIdx.x, NGW = G * 8;
#define LOCAL_IDS int tid = threadIdx.x; asm volatile("" : "+v"(tid)); const int lane = tid & 63, wave = __builtin_amdgcn_readfirstlane(tid >> 6), gw = bx * 8 + wave; (void)lane; (void)gw;
    typedef const __attribute__((address_space(4))) unsigned char* kaptr_t;
    kaptr_t ka = (kaptr_t)__builtin_amdgcn_kernarg_segment_ptr();
#define INP(k) (*(const float* const volatile __attribute__((address_space(4)))*)(ka + 8 * (k)))
    unsigned char* ws = *(unsigned char* const volatile __attribute__((address_space(4)))*)(ka + 288); float* out = *(float* const volatile __attribute__((address_space(4)))*)(ka + 280);
    const float* x = INP(0);
    bf16_t* WAB = (bf16_t*)(ws + WS_WAB); bf16_t* WABO = (bf16_t*)(ws + WS_WABO); bf16_t* WHG = (bf16_t*)(ws + WS_WHG); bf16_t* WHGO = (bf16_t*)(ws + WS_WHGO);
    bf16_t* WQ = (bf16_t*)(ws + WS_WQ); bf16_t* WKV = (bf16_t*)(ws + WS_WKV); bf16_t* WO = (bf16_t*)(ws + WS_WO); bf16_t* WF1 = (bf16_t*)(ws + WS_WF1); bf16_t* WF2 = (bf16_t*)(ws + WS_WF2);
    bf16_t* G2T = (bf16_t*)(ws + WS_G2T); bf16_t* MEMN = (bf16_t*)(ws + WS_MEMN); bf16_t* KMEM = (bf16_t*)(ws + WS_KMEM); bf16_t* VT = (bf16_t*)(ws + WS_VT);
    bf16_t* H = (bf16_t*)(ws + WS_H); bf16_t* P = (bf16_t*)(ws + WS_P); bf16_t* PATT = (bf16_t*)(ws + WS_PATT); bf16_t* OMIX0 = (bf16_t*)(ws + WS_OMIX0); bf16_t* OMIX1 = (bf16_t*)(ws + WS_OMIX1); float* PSB = (float*)(ws + WS_PS);
#define COMMA ,
    bf16_t* STATES = (bf16_t*)((unsigned char*)out + DO_STATES); bf16_t* GG = (bf16_t*)((unsigned char*)out + DO_G); bf16_t* SG = (bf16_t*)((unsigned char*)out + DO_SG);
    float* BONUS = (float*)((unsigned char*)out + DO_BONUS); float* TOT = (float*)((unsigned char*)out + DO_TOT);
    cg::grid_group grid = cg::this_grid();
    { volatile LAS unsigned* st_ = (volatile LAS unsigned*)(lds + LDS_BYTES - 16); if (threadIdx.x < 4) st_[threadIdx.x] = 0u; }
    __syncthreads();
    const XcdBarrier xbar = xcd_barrier_post((unsigned*)ws, (volatile LAS unsigned*)(lds + LDS_BYTES - 16));
    const int lo = *(const int volatile __attribute__((address_space(4)))*)(ka + 296), hi = *(const int volatile __attribute__((address_space(4)))*)(ka + 300);
#ifndef PH_EN
#define PH_EN(k) 1
#endif
#define IN(k) (PH_EN(k) && lo <= (k) && (k) < hi)
#ifndef DUP_MASK
#define DUP_MASK 0ull
#endif
#define REPS(k) (1 + (int)(((unsigned long long)(DUP_MASK) >> (k)) & 1ull))
#define PHASE(k) for (int rep_ = 0; rep_ < (IN(k) ? REPS(k) : 0); ++rep_, ((REPS(k) > 1) ? (grid.sync(), 0) : 0))
#define SEAM(k) do { if (IN(k) && IN((k) + 1)) { if ((k) == 0) grid.sync(); else xcd_barrier(xbar); } } while (0)
#define RUN_GEMM(EPI, ALIGN, gd, ep) do { pg8::Order S_; S_.init(gd, G, bx); pg8::gemm_phase<EPI, ALIGN>(lds, xl, gd, S_, ep); } while (0)

    PHASE(0) { LOCAL_IDS
        LAS float* scr = (LAS float*)(lds + wave * 16384);
        constexpr int I_AB = 16 * 112, I_SQ = 16 * 32, I_HG = 16 * 160, I_KV = 16 * 64, I_F1 = 16 * 176, I_F2 = 44 * 32, I_G2 = 2 * 16;
        constexpr int NIT = I_AB + I_SQ + I_HG + I_SQ + 2 * I_SQ + 2 * I_KV + 2 * I_SQ + 2 * I_F1 + 2 * I_F2 + I_G2;
        for (int it = gw; it < NIT; it += NGW) {
            int r = it;
            if (r < I_AB) { transpose_item<0>(INP(3), 1024, ABP, WAB, scr, r, 112, lane); continue; } r -= I_AB;
            if (r < I_SQ) { transpose_item<0>(INP(4), 1024, 1024, WABO, scr, r, 32, lane); continue; } r -= I_SQ;
            if (r < I_HG) { transpose_item<0>(INP(22), 1024, HGP, WHG, scr, r, 160, lane, INP(2) + D); continue; } r -= I_HG;
            if (r < I_SQ) { transpose_item<0>(INP(23), 1024, 1024, WHGO, scr, r, 32, lane); continue; } r -= I_SQ;
            if (r < 2 * I_SQ) { const int l = r / I_SQ; transpose_item<0>(INP(28) + (size_t)l * D * D, 1024, 1024, WQ + (size_t)l * D * D, scr, r % I_SQ, 32, lane, INP(26) + l * D); continue; } r -= 2 * I_SQ;
            if (r < 2 * I_KV) { const int l = r / I_KV; transpose_item<0>(INP(29) + (size_t)l * D * 2048, 1024, 2048, WKV + (size_t)l * D * 2048, scr, r % I_KV, 64, lane); continue; } r -= 2 * I_KV;
            if (r < 2 * I_SQ) { const int l = r / I_SQ; transpose_item<0>(INP(30) + (size_t)l * D * D, 1024, 1024, WO + (size_t)l * D * D, scr, r % I_SQ, 32, lane); continue; } r -= 2 * I_SQ;
            if (r < 2 * I_F1) { const int l = r / I_F1; transpose_item<1>(INP(32) + (size_t)l * D * 2 * FFN, 1024, 2 * FFN, WF1 + (size_t)l * D * 2 * FFN, scr, r % I_F1, 176, lane, INP(31) + l * D); continue; } r -= 2 * I_F1;
            if (r < 2 * I_F2) { const int l = r / I_F2; transpose_item<0>(INP(33) + (size_t)l * FFN * D, FFN, 1024, WF2 + (size_t)l * FFN * D, scr, r % I_F2, 32, lane); continue; } r -= 2 * I_F2;
            transpose_item<0>(INP(10), 128, 512, G2T, scr, r, 16, lane);
        }
        rms_rows_phase(x, INP(2), H, T, gw, NGW, lane);
        for (int m = gw; m < 2 * 4096; m += NGW) { const int l = m >> 12, r = m & 4095; rms_row_bf16(INP(1) + (size_t)r * D, INP(27) + l * D, MEMN + (size_t)m * D, lane); }
        __syncthreads();
    }
    SEAM(0);
    PHASE(1) {
        { pg8::Gemm g = pg8::make_gemm(H, WAB, T, ABPAD, 1024, 1024, 1024); pg8::EpiBf16 E{P, ABPAD, 1.0f, nullptr}; RUN_GEMM(pg8::EpiBf16, true, g, E); }
        for (int l = 0; l < 2; ++l) {
            { pg8::Gemm g = pg8::make_gemm(MEMN + (size_t)l * 4096 * D, WKV + (size_t)l * 2048 * D, 4096, 1024, 1024, 1024, 1024); pg8::EpiBf16 E{KMEM + (size_t)l * 4096 * D, 1024, 1.0f, nullptr}; RUN_GEMM(pg8::EpiBf16, true, g, E); }
            { pg8::Gemm g = pg8::make_gemm(WKV + (size_t)l * 2048 * D + (size_t)1024 * D, MEMN + (size_t)l * 4096 * D, 1024, 4096, 1024, 1024, 1024); pg8::EpiBf16 E{VT + (size_t)l * 4096 * D, 4096, 1.0f, nullptr}; RUN_GEMM(pg8::EpiBf16, true, g, E); }
        }
    }
    SEAM(1);
    PHASE(2) {
#ifndef DUP_RWKV
#define DUP_RWKV 0
#endif
#ifndef DUP_S1
#define DUP_S1 0
#endif
        for (int r2 = 0; r2 <= DUP_RWKV; ++r2)
        for (int cid = bx; cid < 256; cid += G)
            rwkv_chain(lds, cid, P, INP(5), INP(6), INP(7), INP(8), INP(9), INP(11), INP(12), INP(13), H, SG, BONUS);
        for (int r2 = 0; r2 <= DUP_S1; ++r2)
        for (int u = bx; u < 1024; u += G) ssd_s1_unit(lds, u, P, INP(16), INP(17), INP(18), INP(19), STATES, TOT);
        __syncthreads();
    }
    SEAM(2);
    PHASE(3) {
        { int k128 = 128; asm volatile("" : "+s"(k128)); pg8::Gemm g = pg8::make_gemm(SG, G2T, T, 512, k128, 128, 128); pg8::EpiBf16 E{GG, 512, 1.0f, nullptr}; RUN_GEMM(pg8::EpiBf16, true, g, E); }
        { LOCAL_IDS ssd_s2(STATES, TOT, bx * 512 + tid, G * 512); }
    }
    SEAM(3);
    PHASE(4) {
#ifndef DUP_S3
#define DUP_S3 0
#endif
        for (int r2 = 0; r2 <= DUP_S3; ++r2)
        for (int u = bx; u < 1024; u += G) ssd_s3_unit(lds, u, P, INP(16), INP(17), INP(18), INP(19), INP(20), INP(21), STATES, OMIX0);
        __syncthreads();
        { LOCAL_IDS rwkv_combine(P, H, BONUS, GG, INP(5), INP(14), INP(15), OMIX0, gw, NGW, lane); }
    }
    SEAM(4);
    PHASE(5) { pg8::Gemm g = pg8::make_gemm(OMIX0, WABO, T, 1024, 1024, 1024, 1024); pg8::EpiResidH E{x, out, H, PSB, 1024}; RUN_GEMM(pg8::EpiResidH, true, g, E); }
    SEAM(5);

#define ATTN_FFN(base, L, LASTEPI) \
    PHASE(base) { pg8::Gemm g = pg8::make_gemm(H, WQ + (size_t)(L) * D * D, T, 1024, 1024, 1024, 1024); pg8::EpiBf16 E{P, 1024, 0.0625f, PSB}; RUN_GEMM(pg8::EpiBf16, true, g, E); } \
    SEAM(base); \
    PHASE(base + 1) { pg8::Gemm g = pg8::make_gemm(P, KMEM + (size_t)(L) * 4096 * D, SEQ, 256, 256, 1024, 1024); g.nZ = 64; g.zdiv = 4; \
        g.sAo = (long)SEQ * D; g.sAi = 256; g.sBo = 256L * D; g.sBi = 256; g.sCo = (long)SEQ * D; g.sCi = 256; pg8::EpiSoftmax E{PATT, 1024}; RUN_GEMM(pg8::EpiSoftmax, true, g, E); } \
    SEAM(base + 1); \
    PHASE(base + 2) { pg8::Gemm g = pg8::make_gemm(PATT, VT + (size_t)(L) * 4096 * D, SEQ, 256, 256, 1024, 4096); g.nZ = 64; g.zdiv = 4; \
        g.sAo = (long)SEQ * D; g.sAi = 256; g.sBo = 256; g.sBi = 256L * 4096; g.sCo = (long)SEQ * D; g.sCi = 256; pg8::EpiBf16 E{P, 1024, 1.0f, nullptr}; RUN_GEMM(pg8::EpiBf16, true, g, E); } \
    SEAM(base + 2); \
    PHASE(base + 3) { pg8::Gemm g = pg8::make_gemm(P, WO + (size_t)(L) * D * D, T, 1024, 1024, 1024, 1024); pg8::EpiResidH E{out, out, H, PSB, 1024}; RUN_GEMM(pg8::EpiResidH, true, g, E); } \
    SEAM(base + 3); \
    PHASE(base + 4) { pg8::Gemm g = pg8::make_gemm(H, WF1 + (size_t)(L) * D * 2 * FFN, T, 2 * FFN, 1024, 1024, 1024); pg8::EpiSwiglu E{P, FFN, PSB}; RUN_GEMM(pg8::EpiSwiglu, true, g, E); } \
    SEAM(base + 4); \
    PHASE(base + 5) { pg8::Gemm g = pg8::make_gemm(P, WF2 + (size_t)(L) * FFN * D, T, 1024, FFN, FFN, FFN); LASTEPI } \
    SEAM(base + 5);

    ATTN_FFN(6, 0, pg8::EpiResidH E{out COMMA out COMMA H COMMA PSB COMMA 1024}; RUN_GEMM(pg8::EpiResidH, true, g, E);)

    PHASE(12) { pg8::Gemm g = pg8::make_gemm(H, WHG, T, HGP, 1024, 1024, 1024); pg8::EpiBf16 E{P, HGP, 1.0f, PSB}; RUN_GEMM(pg8::EpiBf16, true, g, E); }
    SEAM(12);
    PHASE(13) {
#ifdef DUP_HGRN
        for (int cid = bx; cid < 256; cid += G) hgrn_chain(lds, cid, P, INP(25), OMIX0, 1024, 0, 0);
        grid.sync();
#endif
        for (int cid = bx; cid < 256; cid += G) hgrn_chain(lds, cid, P, INP(25), P, HGP, 1024, 1024); }
    SEAM(13);
    PHASE(14) { LOCAL_IDS hgrn_combine(P, INP(24), OMIX1, gw, NGW, lane); }
    SEAM(14);
    PHASE(15) { pg8::Gemm g = pg8::make_gemm(OMIX1, WHGO, T, 1024, 1024, 1024, 1024); pg8::EpiResidH E{out, out, H, PSB, 1024}; RUN_GEMM(pg8::EpiResidH, true, g, E); }
    SEAM(15);

    ATTN_FFN(16, 1, pg8::EpiResid E{out COMMA out COMMA 1024}; RUN_GEMM(pg8::EpiResid, true, g, E);)

    PHASE(22) { LOCAL_IDS
        const float* fg = INP(34);
        for (int m = gw; m < T; m += NGW) { f32x4* xr = (f32x4*)(out + (size_t)m * D) + lane; f32x4 v[4]; float s = 0.f;
#pragma unroll
            for (int j = 0; j < 4; ++j) { v[j] = xr[64 * j]; s += (v[j].x * v[j].x + v[j].y * v[j].y) + (v[j].z * v[j].z + v[j].w * v[j].w); }
            const float rs = rsqrtf(wave_sum(s) * (1.f / D) + 1e-6f);
#pragma unroll
            for (int j = 0; j < 4; ++j) { const f32x4 g = ((const f32x4*)fg)[lane + 64 * j]; f32x4 o = v[j] * rs * g;
                xr[64 * j] = o; } }
    }
#undef IN
#undef SEAM
#undef RUN_GEMM
}

extern "C" void kernel_launch(void* const* d_in, const int* in_sizes, int n_in, void* d_out, int out_size, void* d_ws, size_t ws_size, hipStream_t stream) {
    static int grid = 0;
    if (grid == 0) {
        if (n_in != 35 || out_size != T * D || ws_size < WS_END) { fprintf(stderr, "kernel_launch: unexpected shapes (n_in %d out %d ws %zu)\n", n_in, out_size, ws_size); grid = -1; return; }
        int dev = 0, cus = 0, per_cu = 0;
        hipGetDevice(&dev); hipDeviceGetAttribute(&cus, hipDeviceAttributeMultiprocessorCount, dev);
        hipFuncSetAttribute((const void*)mk_fwd, hipFuncAttributeMaxDynamicSharedMemorySize, LDS_BYTES);
        hipOccupancyMaxActiveBlocksPerMultiprocessor(&per_cu, (const void*)mk_fwd, 512, LDS_BYTES);
        if (per_cu < 1) { fprintf(stderr, "kernel_launch: occupancy query says %d blocks per CU\n", per_cu); per_cu = 1; }
        (void)hipGetLastError();
        grid = cus * 1;
    }
    if (grid < 0) return;
    if (hipMemsetAsync(d_ws, 0, 65536, stream) != hipSuccess) { fprintf(stderr, "kernel_launch: memset of the barrier words failed\n"); return; }
    Args a{};
    for (int i = 0; i < 35; ++i) a.in[i] = (const float*)d_in[i];
    a.out = (float*)d_out; a.ws = (unsigned char*)d_ws;
#if MK_COOP
    a.ph_lo = 0; a.ph_hi = NPHASE;
    void* kargs[] = {&a};
    hipError_t e = hipLaunchCooperativeKernel((const void*)mk_fwd, dim3(grid), dim3(512), kargs, LDS_BYTES, stream);
    if (e != hipSuccess) fprintf(stderr, "cooperative launch failed: %s (grid %d)\n", hipGetErrorString(e), grid);
#else
    for (int ph = 0; ph < NPHASE; ++ph) { a.ph_lo = ph; a.ph_hi = ph + 1; hipLaunchKernelGGL(mk_fwd, dim3(grid), dim3(512), LDS_BYTES, stream, a); }
#endif
}
```

```cpp
#include <hip/hip_runtime.h>
#include <hip/hip_cooperative_groups.h>
#include <cstdio>
#include <cstdint>
namespace cg = cooperative_groups;

#ifndef MK_COOP
#define MK_COOP 1
#endif

#define LAS __attribute__((address_space(3)))
typedef unsigned short bf16_t;
typedef short bf16x8 __attribute__((ext_vector_type(8)));
typedef float f32x4 __attribute__((ext_vector_type(4)));
typedef float f32x2 __attribute__((ext_vector_type(2)));
typedef unsigned u32x4 __attribute__((ext_vector_type(4)));
typedef unsigned u32x2 __attribute__((ext_vector_type(2)));

constexpr int NB = 16, SEQ = 4096, T = NB * SEQ, D = 1024;
constexpr int ABPAD = 3584, ABP = 3336;
constexpr int HGP = 5120;
constexpr int FFN = 2816;
constexpr int NPHASE = 23;

constexpr size_t MiB = 1u << 20;
constexpr size_t WS_WAB = 1 * MiB, WS_WABO = 8 * MiB, WS_WHG = 10 * MiB, WS_WHGO = 20 * MiB, WS_WQ = 22 * MiB, WS_WKV = 26 * MiB, WS_WO = 34 * MiB,
                 WS_WF1 = 38 * MiB, WS_WF2 = 60 * MiB, WS_G2T = 71 * MiB, WS_MEMN = 72 * MiB, WS_KMEM = 88 * MiB, WS_VT = 104 * MiB,
                 WS_PS = 120 * MiB, WS_H = 128 * MiB, WS_P = 256 * MiB, WS_PATT = 384 * MiB, WS_OMIX0 = 704 * MiB, WS_OMIX1 = 896 * MiB, WS_END = 1024 * MiB;
constexpr size_t DO_STATES = 0, DO_G = 128 * MiB, DO_SG = 192 * MiB, DO_BONUS = 208 * MiB, DO_TOT = 210 * MiB;

constexpr int LDS_BYTES = 163840;
constexpr int XLDS_OFF = 131072;

__device__ __forceinline__ unsigned f2bf(float f) { unsigned u = __builtin_bit_cast(unsigned, f); return (u + 0x7fffu + ((u >> 16) & 1u)) >> 16; }
__device__ __forceinline__ unsigned pk2(float lo, float hi) { return f2bf(lo) | (f2bf(hi) << 16); }
__device__ __forceinline__ float bf2f(unsigned short b) { return __builtin_bit_cast(float, (unsigned)b << 16); }
__device__ __forceinline__ float bflo(unsigned u) { return __builtin_bit_cast(float, u << 16); }
__device__ __forceinline__ float bfhi(unsigned u) { return __builtin_bit_cast(float, u & 0xffff0000u); }
__device__ __forceinline__ float frcp(float x) { return __builtin_amdgcn_rcpf(x); }
__device__ __forceinline__ float sigmoidf_(float x) { return frcp(1.0f + __expf(-x)); }
__device__ __forceinline__ float siluf_(float x) { return x * frcp(1.0f + __expf(-x)); }
__device__ __forceinline__ float wave_sum(float v) {
#pragma unroll
    for (int o = 1; o < 64; o <<= 1) v += __shfl_xor(v, o);
    return v;
}
template <int CTRL> __device__ __forceinline__ float dppf(float x) { return __builtin_bit_cast(float, __builtin_amdgcn_mov_dpp(__builtin_bit_cast(int, x), CTRL, 0xf, 0xf, true)); }
__device__ __forceinline__ float sum8(float v) { v += dppf<0xB1>(v); v += dppf<0x4E>(v); v += dppf<0x141>(v); return v; }
#define LDS_WAIT() asm volatile("s_waitcnt lgkmcnt(0)" ::: "memory")

namespace pg8 {
constexpr int BM = 256, BK = 64, HALF = 128, HTB = HALF * BK * 2, STAGE_BYTES = 8 * HTB, NXCD = 8, WGM = 8;
__host__ __device__ __forceinline__ int lds_byte(int r, int c) { const int st = (r >> 4) * 2 + (c >> 5), rr = r & 15, cc = c & 31, ob = rr * 64 + cc * 2; return st * 1024 + (ob ^ (((ob >> 9) & 1) << 5)); }
__host__ __device__ __forceinline__ void stage_rc(int b, int& R, int& C) { const int st = b / 1024, sb = b % 1024, swz = sb ^ (((sb >> 9) & 1) << 5); R = (st >> 1) * 16 + swz / 64; C = (st & 1) * 32 + (swz % 64) / 2; }
__host__ __device__ __forceinline__ int perm32(int rho) { const int n = rho >> 4, i = rho & 15; return 8 * (i >> 2) + 4 * n + (i & 3); }

struct Unit { int pm, pn, z; };
struct Gemm {
    const bf16_t* A; const bf16_t* Bt; int lda, ldb, K, nM, nN, nZ, zdiv; long sAo, sAi, sBo, sBi, sCo, sCi;
    __device__ __forceinline__ long offA(const Unit& u) const { return (long)(u.z / zdiv) * sAo + (long)(u.z % zdiv) * sAi + (long)u.pm * BM * lda; }
    __device__ __forceinline__ long offB(const Unit& u) const { return (long)(u.z / zdiv) * sBo + (long)(u.z % zdiv) * sBi + (long)u.pn * BM * ldb; }
    __device__ __forceinline__ long offC(const Unit& u) const { return (long)(u.z / zdiv) * sCo + (long)(u.z % zdiv) * sCi; }
};
__device__ __forceinline__ Gemm make_gemm(const bf16_t* A, const bf16_t* Bt, int M, int N, int K, int lda, int ldb) {
    Gemm g; g.A = A; g.Bt = Bt; g.lda = lda; g.ldb = ldb; g.K = K; g.nM = M / BM; g.nN = N / BM; g.nZ = 1; g.zdiv = 1; g.sAo = g.sAi = g.sBo = g.sBi = g.sCo = g.sCi = 0; return g;
}
struct Order {
    int nM, nN, nwg, total, G, c;
    __device__ __forceinline__ void init(const Gemm& g, int G_, int c_) { nM = g.nM; nN = g.nN; nwg = nM * nN; total = nwg * g.nZ; G = G_; c = c_; }
    __device__ __forceinline__ bool next(int i, Unit& u) const {
        const long L = (long)i * G + c; if (L >= total) return false;
        u.z = (int)(L / nwg); int wgid = (int)(L % nwg);
        { const int q = nwg / NXCD, r = nwg % NXCD, xcd = wgid % NXCD, off = wgid / NXCD; wgid = (xcd < r ? xcd * (q + 1) : r * (q + 1) + (xcd - r) * q) + off; }
        const int nig = WGM * nN, gid = wgid / nig, fm = gid * WGM, gsz = (nM - fm) < WGM ? (nM - fm) : WGM;
        u.pm = fm + ((wgid % nig) % gsz); u.pn = (wgid % nig) / gsz; return true;
    }
};

__device__ __forceinline__ unsigned cvt_pk_bf16(float lo, float hi) { unsigned r; asm volatile("v_cvt_pk_bf16_f32 %0, %1, %2" : "=v"(r) : "v"(lo), "v"(hi)); return r; }

__device__ __forceinline__ void row_scales(const float* PS, int rowbase, int fq, float (&rs)[2][4]) {
#pragma unroll
    for (int ai = 0; ai < 2; ++ai)
#pragma unroll
        for (int m = 0; m < 4; ++m) { const f32x4 p = *(const f32x4*)(PS + (size_t)(rowbase + ai * HALF + m * 16) * 16 + fq * 4);
            float s = (p[0] + p[1]) + (p[2] + p[3]); s += __shfl_xor(s, 16); s += __shfl_xor(s, 32); rs[ai][m] = rsqrtf(s * (1.f / 1024.f) + 1e-6f); }
}
struct EpiBf16 {
    static constexpr bool PERM = true;
    bf16_t* O; int ldc; float scale; const float* PS;
    __device__ __forceinline__ void operator()(const f32x4 (&acc)[2][2][4][2], const Unit& u, long coff, int wr, int wc, int fr, int fq, LAS unsigned char* xl) const {
        const int row0 = u.pm * BM + wr * 64 + fr, col0 = u.pn * BM + wc * 32 + 8 * fq; bf16_t* base = O + coff;
        float rs[2][4];
        if (PS) row_scales(PS, row0, fq, rs);
        else {
#pragma unroll
            for (int ai = 0; ai < 2; ++ai)
#pragma unroll
                for (int m = 0; m < 4; ++m) rs[ai][m] = 1.f; }
#pragma unroll
        for (int ai = 0; ai < 2; ++ai)
#pragma unroll
            for (int m = 0; m < 4; ++m) { bf16_t* rowp = base + (size_t)(row0 + ai * HALF + m * 16) * ldc + col0; const float sc_ = scale * rs[ai][m];
#pragma unroll
                for (int bj = 0; bj < 2; ++bj) { const f32x4 v0 = acc[ai][bj][m][0] * sc_, v1 = acc[ai][bj][m][1] * sc_;
                    u32x4 w; w.x = cvt_pk_bf16(v0[0], v0[1]); w.y = cvt_pk_bf16(v0[2], v0[3]); w.z = cvt_pk_bf16(v1[0], v1[1]); w.w = cvt_pk_bf16(v1[2], v1[3]);
                    *(u32x4*)(rowp + bj * HALF) = w; } }
    }
};
struct EpiResid {
    static constexpr bool PERM = false;
    const float* base; float* out; int ldc;
    __device__ __forceinline__ void operator()(const f32x4 (&acc)[2][2][4][2], const Unit& u, long coff, int wr, int wc, int fr, int fq, LAS unsigned char* xl) const {
        const int col0 = u.pn * BM + wc * 32 + 4 * fq;
#pragma unroll
        for (int ai = 0; ai < 2; ++ai)
#pragma unroll
            for (int m = 0; m < 4; ++m) { const size_t off = (size_t)(u.pm * BM + ai * HALF + wr * 64 + m * 16 + fr) * ldc + col0;
#pragma unroll
                for (int bj = 0; bj < 2; ++bj)
#pragma unroll
                    for (int n = 0; n < 2; ++n) { const f32x4 bs = *(const f32x4*)(base + off + bj * HALF + n * 16); *(f32x4*)(out + off + bj * HALF + n * 16) = bs + acc[ai][bj][m][n]; } }
    }
};
struct EpiResidH {
    static constexpr bool PERM = false;
    const float* base; float* out; bf16_t* HB; float* PS; int ldc;
    __device__ __forceinline__ void operator()(const f32x4 (&acc)[2][2][4][2], const Unit& u, long coff, int wr, int wc, int fr, int fq, LAS unsigned char* xl) const {
        const int col0 = u.pn * BM + wc * 32 + 4 * fq;
#pragma unroll
        for (int ai = 0; ai < 2; ++ai)
#pragma unroll
            for (int m = 0; m < 4; ++m) { const int row = u.pm * BM + ai * HALF + wr * 64 + m * 16 + fr; const size_t off = (size_t)row * ldc + col0; float ss = 0.f;
#pragma unroll
                for (int bj = 0; bj < 2; ++bj)
#pragma unroll
                    for (int n = 0; n < 2; ++n) { const f32x4 bs = *(const f32x4*)(base + off + bj * HALF + n * 16); const f32x4 o = bs + acc[ai][bj][m][n]; *(f32x4*)(out + off + bj * HALF + n * 16) = o;
                        ss += (o[0] * o[0] + o[1] * o[1]) + (o[2] * o[2] + o[3] * o[3]);
                        u32x2 w; w.x = cvt_pk_bf16(o[0], o[1]); w.y = cvt_pk_bf16(o[2], o[3]); *(u32x2*)(HB + off + bj * HALF + n * 16) = w; }
                ss += __shfl_xor(ss, 16); ss += __shfl_xor(ss, 32);
                if (fq == 0) PS[(size_t)row * 16 + u.pn * 4 + wc] = ss; }
    }
};
struct EpiSwiglu {
    static constexpr bool PERM = true;
    bf16_t* O; int ldc; const float* PS;
    __device__ __forceinline__ void operator()(const f32x4 (&acc)[2][2][4][2], const Unit& u, long coff, int wr, int wc, int fr, int fq, LAS unsigned char* xl) const {
        const int row0 = u.pm * BM + wr * 64 + fr, col0 = u.pn * HALF + wc * 32 + 8 * fq;
        float rs[2][4]; row_scales(PS, row0, fq, rs);
#pragma unroll
        for (int ai = 0; ai < 2; ++ai)
#pragma unroll
            for (int m = 0; m < 4; ++m) { bf16_t* rowp = O + (size_t)(row0 + ai * HALF + m * 16) * ldc + col0; float r[8]; const float sc_ = rs[ai][m];
#pragma unroll
                for (int n = 0; n < 2; ++n)
#pragma unroll
                    for (int i = 0; i < 4; ++i) { const float g = acc[ai][0][m][n][i] * sc_, uu = acc[ai][1][m][n][i] * sc_; r[n * 4 + i] = siluf_(g) * uu; }
                u32x4 w; w.x = cvt_pk_bf16(r[0], r[1]); w.y = cvt_pk_bf16(r[2], r[3]); w.z = cvt_pk_bf16(r[4], r[5]); w.w = cvt_pk_bf16(r[6], r[7]);
                *(u32x4*)rowp = w; }
    }
};
struct EpiSoftmax {
    static constexpr bool PERM = true;
    bf16_t* O; int ldc;
    __device__ __forceinline__ void operator()(f32x4 (&acc)[2][2][4][2], const Unit& u, long coff, int wr, int wc, int fr, int fq, LAS unsigned char* xl) const {
        LAS float* XM = (LAS float*)xl; LAS float* XS = (LAS float*)(xl + 4096);
#pragma unroll
        for (int ai = 0; ai < 2; ++ai)
#pragma unroll
            for (int m = 0; m < 4; ++m) { float mx = -3.0e38f;
#pragma unroll
                for (int bj = 0; bj < 2; ++bj)
#pragma unroll
                    for (int n = 0; n < 2; ++n)
#pragma unroll
                        for (int i = 0; i < 4; ++i) mx = fmaxf(mx, acc[ai][bj][m][n][i]);
                mx = fmaxf(mx, __shfl_xor(mx, 16)); mx = fmaxf(mx, __shfl_xor(mx, 32));
                if (fq == 0) XM[(ai * HALF + wr * 64 + m * 16 + fr) * 4 + wc] = mx; }
        LDS_WAIT(); __builtin_amdgcn_s_barrier(); asm volatile("" ::: "memory");
#pragma unroll
        for (int ai = 0; ai < 2; ++ai)
#pragma unroll
            for (int m = 0; m < 4; ++m) { const f32x4 mm = *(const LAS f32x4*)(XM + (ai * HALF + wr * 64 + m * 16 + fr) * 4);
                const float mx = fmaxf(fmaxf(mm[0], mm[1]), fmaxf(mm[2], mm[3])); float s = 0.f;
#pragma unroll
                for (int bj = 0; bj < 2; ++bj)
#pragma unroll
                    for (int n = 0; n < 2; ++n)
#pragma unroll
                        for (int i = 0; i < 4; ++i) { const float e = __expf(acc[ai][bj][m][n][i] - mx); acc[ai][bj][m][n][i] = e; s += e; }
                s += __shfl_xor(s, 16); s += __shfl_xor(s, 32);
                if (fq == 0) XS[(ai * HALF + wr * 64 + m * 16 + fr) * 4 + wc] = s; }
        LDS_WAIT(); __builtin_amdgcn_s_barrier(); asm volatile("" ::: "memory");
        const int row0 = u.pm * BM + wr * 64 + fr, col0 = wc * 32 + 8 * fq; bf16_t* base = O + coff;
#pragma unroll
        for (int ai = 0; ai < 2; ++ai)
#pragma unroll
            for (int m = 0; m < 4; ++m) { const f32x4 ss = *(const LAS f32x4*)(XS + (ai * HALF + wr * 64 + m * 16 + fr) * 4);
                const float inv = frcp((ss[0] + ss[1]) + (ss[2] + ss[3])); bf16_t* rowp = base + (size_t)(row0 + ai * HALF + m * 16) * ldc + col0;
#pragma unroll
                for (int bj = 0; bj < 2; ++bj) { const f32x4 v0 = acc[ai][bj][m][0] * inv, v1 = acc[ai][bj][m][1] * inv;
                    u32x4 w; w.x = cvt_pk_bf16(v0[0], v0[1]); w.y = cvt_pk_bf16(v0[2], v0[3]); w.z = cvt_pk_bf16(v1[0], v1[1]); w.w = cvt_pk_bf16(v1[2], v1[3]);
                    *(u32x4*)(rowp + bj * HALF) = w; } }
    }
};

template <class Epi, bool ALIGN_EPI>
__device__ __forceinline__ void gemm_phase(LAS unsigned char* lds, LAS unsigned char* xl, const Gemm g, const Order& S, Epi& E) {
    const int tid = threadIdx.x, wid = __builtin_amdgcn_readfirstlane(tid >> 6), lane = tid & 63, wr = wid >> 2, wc = wid & 3, fr = lane & 15, fq = lane >> 4;
    const int K = g.K, nt = K / BK;
    unsigned voffA[2], voffB[2];
#pragma unroll
    for (int i = 0; i < 2; ++i) { int R, C; stage_rc(tid * 16 + i * 8192, R, C); const int Rb = Epi::PERM ? ((R & ~31) + perm32(R & 31)) : R;
        voffA[i] = (unsigned)(R * g.lda + C) * 2u; voffB[i] = (unsigned)(Rb * g.ldb + C) * 2u; }
    const size_t kstep = (size_t)(BK * 2);
    const size_t hstepA = (size_t)HALF * g.lda * 2, hstepB = (size_t)HALF * g.ldb * 2;
    const unsigned ldsw = (unsigned)wid * 1024u;
    const int aoff = lds_byte(wr * 64 + fr, fq * 8), boff = lds_byte(wc * 32 + fr, fq * 8);
#define PG8_SA(b, h) (((b) * 2 + (h)) * HTB)
#define PG8_SB(b, h) ((4 + (b) * 2 + (h)) * HTB)
#define PG8_STAGE(bufoff, gbase, voff) do { _Pragma("unroll") for (int _i = 0; _i < 2; ++_i) \
        __builtin_amdgcn_global_load_lds((const unsigned*)((const char*)(gbase) + (voff)[_i]), (LAS unsigned*)(lds + (bufoff) + ldsw + _i * 8192), 16, 0, 0); } while (0)
#define PG8_LDA(dst, b, h) do { _Pragma("unroll") for (int m = 0; m < 4; ++m) _Pragma("unroll") for (int k = 0; k < 2; ++k) dst[m][k] = *(const LAS bf16x8*)(lds + PG8_SA(b, h) + aoff + m * 2048 + k * 1024); } while (0)
#define PG8_LDB(dst, b, h) do { _Pragma("unroll") for (int n = 0; n < 2; ++n) _Pragma("unroll") for (int k = 0; k < 2; ++k) dst[n][k] = *(const LAS bf16x8*)(lds + PG8_SB(b, h) + boff + n * 2048 + k * 1024); } while (0)
#define PG8_MMA(ai, bj, At, Bt) do { __builtin_amdgcn_s_setprio(1); _Pragma("unroll") for (int m = 0; m < 4; ++m) _Pragma("unroll") for (int n = 0; n < 2; ++n) _Pragma("unroll") for (int k = 0; k < 2; ++k) \
        acc[ai][bj][m][n] = __builtin_amdgcn_mfma_f32_16x16x32_bf16(Bt[n][k], At[m][k], acc[ai][bj][m][n], 0, 0, 0); __builtin_amdgcn_s_setprio(0); } while (0)
#define PG8_WAIT_V(n) asm volatile("s_waitcnt vmcnt(" #n ")" ::: "memory")
#define PG8_WAIT_L(n) asm volatile("s_waitcnt lgkmcnt(" #n ")" ::: "memory")
#define PG8_BAR __builtin_amdgcn_s_barrier()
#define PG8_SCHED __builtin_amdgcn_sched_barrier(0)
    Unit cur, nxt; int ui = 0;
    if (!S.next(0, cur)) return;
    f32x4 acc[2][2][4][2];
#pragma unroll
    for (int a = 0; a < 2; ++a)
#pragma unroll
        for (int b = 0; b < 2; ++b)
#pragma unroll
            for (int m = 0; m < 4; ++m)
#pragma unroll
                for (int n = 0; n < 2; ++n) acc[a][b][m][n] = (f32x4){0.f, 0.f, 0.f, 0.f};
    bf16x8 At[4][2], B0[2][2], B1[2][2];
    const char* cA = (const char*)g.A + 2 * g.offA(cur); const char* cB = (const char*)g.Bt + 2 * g.offB(cur);
    PG8_STAGE(PG8_SB(0, 0), cB, voffB); PG8_STAGE(PG8_SB(0, 1), cB + hstepB, voffB); PG8_STAGE(PG8_SA(0, 0), cA, voffA); PG8_STAGE(PG8_SA(0, 1), cA + hstepA, voffA);
    if (wr == 1) PG8_BAR;
    PG8_WAIT_V(2); PG8_BAR;
    PG8_STAGE(PG8_SB(1, 0), cB + kstep, voffB); PG8_STAGE(PG8_SA(1, 0), cA + kstep, voffA); PG8_STAGE(PG8_SB(1, 1), cB + hstepB + kstep, voffB);
    PG8_WAIT_V(6); PG8_BAR;
    for (;;) {
        const bool has_next = S.next(ui + 1, nxt);
        const char* nA = has_next ? (const char*)g.A + 2 * g.offA(nxt) : cA; const char* nB = has_next ? (const char*)g.Bt + 2 * g.offB(nxt) : cB;
        for (int t = 0; t < nt; t += 2) {
            const bool last = (t == nt - 2);
            const char* a1 = cA + (size_t)(t + 1) * kstep;
            const char* a2 = last ? nA : cA + (size_t)(t + 2) * kstep; const char* b2 = last ? nB : cB + (size_t)(t + 2) * kstep;
            const char* a3 = a2 + kstep; const char* b3 = b2 + kstep;
            PG8_LDB(B0, 0, 0); PG8_LDB(B1, 0, 1); PG8_SCHED; PG8_LDA(At, 0, 0); PG8_STAGE(PG8_SA(1, 1), a1 + hstepA, voffA);
            PG8_WAIT_V(8); PG8_WAIT_L(0); PG8_BAR; PG8_MMA(0, 0, At, B0); PG8_MMA(0, 1, At, B1); PG8_BAR; PG8_SCHED;
            PG8_LDA(At, 0, 1); PG8_STAGE(PG8_SB(0, 0), b2, voffB); PG8_STAGE(PG8_SB(0, 1), b2 + hstepB, voffB); PG8_STAGE(PG8_SA(0, 0), a2, voffA);
            PG8_WAIT_V(8); PG8_WAIT_L(0); PG8_BAR; PG8_MMA(1, 0, At, B0); PG8_MMA(1, 1, At, B1); PG8_BAR; PG8_SCHED;
            PG8_LDB(B0, 1, 0); PG8_LDB(B1, 1, 1); PG8_SCHED; PG8_LDA(At, 1, 0); PG8_STAGE(PG8_SA(0, 1), a2 + hstepA, voffA);
            PG8_WAIT_V(8); PG8_WAIT_L(0); PG8_BAR; PG8_MMA(0, 0, At, B0); PG8_MMA(0, 1, At, B1); PG8_BAR; PG8_SCHED;
            PG8_LDA(At, 1, 1); PG8_STAGE(PG8_SB(1, 0), b3, voffB); PG8_STAGE(PG8_SB(1, 1), b3 + hstepB, voffB); PG8_STAGE(PG8_SA(1, 0), a3, voffA);
            PG8_WAIT_V(8); PG8_WAIT_L(0); PG8_BAR; PG8_MMA(1, 0, At, B0); PG8_MMA(1, 1, At, B1); PG8_BAR; PG8_SCHED;
        }
        if constexpr (ALIGN_EPI) { if (wr == 0) PG8_BAR; }
        E(acc, cur, g.offC(cur), wr, wc, fr, fq, xl);
        if (!has_next) break;
#pragma unroll
        for (int a = 0; a < 2; ++a)
#pragma unroll
            for (int b = 0; b < 2; ++b)
#pragma unroll
                for (int m = 0; m < 4; ++m)
#pragma unroll
                    for (int n = 0; n < 2; ++n) acc[a][b][m][n] = (f32x4){0.f, 0.f, 0.f, 0.f};
        cur = nxt; cA = nA; cB = nB; ++ui;
        if constexpr (ALIGN_EPI) { if (wr == 1) PG8_BAR; }
    }
    PG8_WAIT_V(0);
    if constexpr (!ALIGN_EPI) { if (wr == 0) PG8_BAR; }
    PG8_BAR;
#undef PG8_SA
#undef PG8_SB
#undef PG8_STAGE
#undef PG8_LDA
#undef PG8_LDB
#undef PG8_MMA
#undef PG8_WAIT_V
#undef PG8_WAIT_L
#undef PG8_BAR
#undef PG8_SCHED
}
}

__device__ __forceinline__ f32x4 mfma16(bf16x8 bfrag, bf16x8 afrag, f32x4 acc) { return __builtin_amdgcn_mfma_f32_16x16x32_bf16(bfrag, afrag, acc, 0, 0, 0); }
__device__ __forceinline__ bf16x8 ldsfrag(const LAS bf16_t* base, int ld, int r0, int k0, int fr, int fq) { return *(const LAS bf16x8*)(base + (r0 + fr) * ld + k0 + fq * 8); }

template <int MODE> __device__ __forceinline__ void transpose_item(const float* W, int K, int N, bf16_t* WT, LAS float* scr, int item, int nblk, int lane, const float* gain = nullptr) {
    const int kb = item / nblk, nb = item % nblk, k0 = 64 * kb, n0 = 32 * nb; const int nsrc = n0 + (lane & 31);
#pragma unroll 8
    for (int i = 0; i < 32; ++i) { const int kk = 2 * i + (lane >> 5); scr[kk * 33 + (lane & 31)] = (nsrc < N) ? W[(size_t)(k0 + kk) * N + nsrc] * (gain ? gain[k0 + kk] : 1.f) : 0.f; }
    LDS_WAIT();
    const int c = lane & 7;
#pragma unroll
    for (int j = 0; j < 4; ++j) { const int n = (lane >> 3) + 8 * j; const LAS float* s = scr + (8 * c) * 33 + n;
        u32x4 o; o.x = pk2(s[0 * 33], s[1 * 33]); o.y = pk2(s[2 * 33], s[3 * 33]); o.z = pk2(s[4 * 33], s[5 * 33]); o.w = pk2(s[6 * 33], s[7 * 33]);
        int drow = n0 + n; if (MODE == 1) { const int jn = drow % FFN, isu = drow / FFN; drow = (jn / 128) * 256 + isu * 128 + (jn % 128); }
        *(u32x4*)(WT + (size_t)drow * K + k0 + 8 * c) = o; }
    LDS_WAIT();
}
__device__ __forceinline__ void rms_row_bf16(const float* xrow, const float* gain, bf16_t* orow, int lane) {
    const f32x4* xr = (const f32x4*)xrow + lane; f32x4 v[4]; float s = 0.f;
#pragma unroll
    for (int j = 0; j < 4; ++j) { v[j] = xr[64 * j]; s += (v[j].x * v[j].x + v[j].y * v[j].y) + (v[j].z * v[j].z + v[j].w * v[j].w); }
    const float rs = rsqrtf(wave_sum(s) * (1.f / D) + 1e-6f);
    const f32x4* gr = (const f32x4*)gain + lane; u32x2* o8 = (u32x2*)orow + lane;
#pragma unroll
    for (int j = 0; j < 4; ++j) { const f32x4 g = gr[64 * j]; u32x2 w; w.x = pk2(v[j].x * rs * g.x, v[j].y * rs * g.y); w.y = pk2(v[j].z * rs * g.z, v[j].w * rs * g.w); o8[64 * j] = w; }
}
__device__ __forceinline__ void rms_rows_phase(const float* X, const float* gain, bf16_t* H, int nrows, int gw, int NGW, int lane) {
    for (int m = gw; m < nrows; m += NGW) rms_row_bf16(X + (size_t)m * D, gain, H + (size_t)m * D, lane);
}

__device__ __forceinline__ void rwkv_chain(LAS unsigned char* lds, int cid, const bf16_t* P0, const float* mu, const float* w0, const float* w2, const float* a0, const float* a2,
                                           const float* k_k, const float* k_a, const float* r_k, bf16_t* ORW, bf16_t* SG, float* BONUS) {
    const int tid = threadIdx.x, lane = tid & 63, wid = tid >> 6, fr = lane & 15, fq = lane >> 4;
    const int b = cid >> 4, h = (cid >> 1) & 7, dir = cid & 1;
    LAS float* rS = (LAS float*)(lds); LAS float* kS = (LAS float*)(lds + 8192); LAS float* vS = (LAS float*)(lds + 16384); LAS float* wS = (LAS float*)(lds + 24576);
    LAS float* nkS = (LAS float*)(lds + 32768); LAS float* bS = (LAS float*)(lds + 40960); LAS float* preA = (LAS float*)(lds + 49152); LAS float* preW = (LAS float*)(lds + 57344);
    LAS bf16_t* adB = (LAS bf16_t*)(lds + 65536); LAS bf16_t* wdB = (LAS bf16_t*)(lds + 70144);
    LAS bf16_t* a2B = (LAS bf16_t*)(lds + 74752); LAS bf16_t* w2B = (LAS bf16_t*)(lds + 83968); LAS float* cst = (LAS float*)(lds + 93184);
    LAS bf16_t* At = (LAS bf16_t*)(lds + 97280); LAS bf16_t* Bt = (LAS bf16_t*)(lds + 101888); LAS bf16_t* Kt = (LAS bf16_t*)(lds + 106496); LAS bf16_t* Rt = (LAS bf16_t*)(lds + 111104);
    LAS bf16_t* BtT = (LAS bf16_t*)(lds + 115712); LAS bf16_t* KtT = (LAS bf16_t*)(lds + 120832); LAS bf16_t* VT = (LAS bf16_t*)(lds + 125952); LAS bf16_t* S0b = (LAS bf16_t*)(lds + 131072);
    LAS float* NT4 = (LAS float*)(lds + 140288); LAS bf16_t* NakT = (LAS bf16_t*)(lds + 146432); LAS bf16_t* MbrT = (LAS bf16_t*)(lds + 148992); LAS bf16_t* MkrT = (LAS bf16_t*)(lds + 151552);
    LAS float* gL = (LAS float*)(lds + 154112);
    LAS float* WS = preA;
    LAS bf16_t* Ub = (LAS bf16_t*)preW;
#define RW_IDS int tid_o = threadIdx.x; asm volatile("" : "+v"(tid_o)); const int tid = tid_o, lane = tid & 63, wid = __builtin_amdgcn_readfirstlane(tid >> 6), fr = lane & 15, fq = lane >> 4, vt = wid >> 1, tt2 = wid & 1; (void)lane; (void)wid; (void)fr; (void)fq; (void)vt; (void)tt2;
    __syncthreads();
    for (int e = tid; e < 64 * 64; e += 512) { const int j = e & 63, r = e >> 6;
        a2B[j * 72 + r] = (bf16_t)f2bf(a2[r * 512 + h * 64 + j]); w2B[j * 72 + r] = (bf16_t)f2bf(w2[(dir * 64 + r) * 512 + h * 64 + j]); }
    for (int e = tid; e < 64 * 72 / 2; e += 512) ((LAS unsigned*)S0b)[e] = 0u;
    if (tid < 64) { const int j = tid, c = h * 64 + j;
        cst[0 * 64 + j] = a0[c]; cst[1 * 64 + j] = w0[dir * 512 + c]; cst[2 * 64 + j] = k_k[c]; cst[3 * 64 + j] = k_a[c]; cst[4 * 64 + j] = r_k[c];
        cst[5 * 64 + j] = mu[c]; cst[6 * 64 + j] = mu[512 + c]; cst[7 * 64 + j] = mu[1024 + c]; cst[8 * 64 + j] = mu[1536 + j]; cst[9 * 64 + j] = mu[1600 + j];
        cst[10 * 64 + j] = (j < 16) ? mu[1664 + h * 16 + j] : 0.f; }
    const int vt = wid >> 1, tt2 = wid & 1;
    f32x4 st[2]; st[0] = (f32x4){0.f, 0.f, 0.f, 0.f}; st[1] = st[0];
    __syncthreads();
    const bf16_t* Pb = P0 + (size_t)b * SEQ * ABPAD;
    unsigned rc[10], rpv[10], rnx[10]; unsigned short gcv = 0, gpv = 0, gnv = 0;
#define RW_IDX(i) const int grp = (i) >> 1; const int idx_ = tid + 512 * ((i) & 1); const int tok = idx_ >> 5, c2 = (idx_ & 31) * 2; \
                  const int gcol = (grp == 0 ? h * 64 : grp == 1 ? 512 + h * 64 : grp == 2 ? 1024 + h * 64 : grp == 3 ? 1536 : 1600) + c2;
    const unsigned voff = (unsigned)((((int)threadIdx.x >> 5) * ABPAD + ((int)threadIdx.x & 31) * 2) * 2);
#define RW_CG(g) ((g) == 0 ? h * 128 : (g) == 1 ? 1024 + h * 128 : (g) == 2 ? 2048 + h * 128 : (g) == 3 ? 3072 : 3200)
#define RW_ISSUE(t0n) do { const char* bp_ = (const char*)(Pb + (size_t)(t0n) * ABPAD); const bool first_ = ((t0n) == 0) && (tid < 32), last_ = ((t0n) == SEQ - 32) && (tid >= 480); \
        _Pragma("unroll") for (int i = 0; i < 10; ++i) { const char* p = bp_ + (RW_CG(i >> 1) + (i & 1) * 16 * ABPAD * 2) + voff; \
            rc[i] = *(const unsigned*)p; \
            if ((i & 1) == 0) { const unsigned v_ = *(const unsigned*)(p - (first_ ? 0 : ABPAD * 2)); rpv[i] = first_ ? 0u : v_; rnx[i] = *(const unsigned*)(p + ABPAD * 2); } \
            else { const unsigned v_ = *(const unsigned*)(p + (last_ ? 0 : ABPAD * 2)); rnx[i] = last_ ? 0u : v_; rpv[i] = *(const unsigned*)(p - ABPAD * 2); } } \
        if (dir == 0) { const bool fg_ = ((t0n) == 0) && (tid < 16), lg_ = ((t0n) == SEQ - 32) && (tid >= 496); \
            const bf16_t* p = (const bf16_t*)bp_ + (size_t)(tid >> 4) * ABPAD + 1664 + h * 16 + (tid & 15); \
            gcv = *p; { const unsigned short v_ = *(p - (fg_ ? 0 : ABPAD)); gpv = fg_ ? (unsigned short)0 : v_; } { const unsigned short v_ = *(p + (lg_ ? 0 : ABPAD)); gnv = lg_ ? (unsigned short)0 : v_; } } } while (0)
    RW_ISSUE(dir ? 127 * 32 : 0);
    for (int cc = 0; cc < 128; ++cc) {
        const int t0 = dir ? (127 - cc) * 32 : cc * 32;
        { RW_IDS
#pragma unroll
        for (int i = 0; i < 10; ++i) { RW_IDX(i) (void)gcol;
            const unsigned cur = rc[i], prv = rpv[i], nxt = rnx[i];
            const float m0 = cst[(5 + grp) * 64 + c2], m1 = cst[(5 + grp) * 64 + c2 + 1];
            const float c0 = bflo(cur), c1 = bfhi(cur);
            const float x0 = c0 + m0 * (0.5f * (bflo(prv) + bflo(nxt)) - c0), x1 = c1 + m1 * (0.5f * (bfhi(prv) + bfhi(nxt)) - c1);
            if (grp == 0) { *(LAS f32x2*)(rS + tok * 64 + c2) = (f32x2){x0, x1}; }
            else if (grp == 1) { *(LAS f32x2*)(kS + tok * 64 + c2) = (f32x2){x0, x1}; }
            else if (grp == 2) { *(LAS f32x2*)(vS + tok * 64 + c2) = (f32x2){x0, x1}; }
            else if (grp == 3) { const float e0 = __expf(2.f * x0), e1 = __expf(2.f * x1); *(LAS unsigned*)(wdB + tok * 72 + c2) = pk2(1.f - 2.f * frcp(e0 + 1.f), 1.f - 2.f * frcp(e1 + 1.f)); }
            else { *(LAS unsigned*)(adB + tok * 72 + c2) = pk2(x0, x1); }
        }
        if (dir == 0) {
            const int tok = tid >> 4, c = tid & 15, t = t0 + tok;
            const float cur = bf2f(gcv), prv = bf2f(gpv), nxt = bf2f(gnv);
            const float x = cur + cst[10 * 64 + c] * (0.5f * (prv + nxt) - cur);
            SG[((size_t)b * SEQ + t) * 128 + h * 16 + c] = (bf16_t)f2bf(sigmoidf_(x));
        } }
        __syncthreads();
        if (cc + 1 < 128) { RW_IDS const int t0n = dir ? (126 - cc) * 32 : (cc + 1) * 32; RW_ISSUE(t0n); }
        { RW_IDS const int mat = wid >> 2, ntile = wid & 3; const LAS bf16_t* Aop = mat ? wdB : adB; const LAS bf16_t* Bop = mat ? w2B : a2B; LAS float* pre = mat ? preW : preA;
#pragma unroll
          for (int mt = 0; mt < 2; ++mt) { f32x4 acc = (f32x4){0.f, 0.f, 0.f, 0.f};
#pragma unroll
              for (int ks = 0; ks < 2; ++ks) acc = mfma16(ldsfrag(Bop, 72, ntile * 16, ks * 32, fr, fq), ldsfrag(Aop, 72, mt * 16, ks * 32, fr, fq), acc);
              *(LAS f32x4*)(pre + (mt * 16 + fr) * 64 + ntile * 16 + fq * 4) = acc; } }
        __syncthreads();
        { RW_IDS const int tok = tid >> 4, c0 = (tid & 15) * 4; float kkr[4], av[4], kp[4], wv[4]; float ss = 0.f, bon = 0.f;
#pragma unroll
          for (int i = 0; i < 4; ++i) { const int c = c0 + i, ix = tok * 64 + c;
              const float a = sigmoidf_(cst[c] + preA[ix]); const float sg = sigmoidf_(cst[64 + c] + preW[ix]);
              wv[i] = -0.60653065971f * sg;
              const float kraw = kS[ix]; kkr[i] = kraw * cst[128 + c]; ss += kkr[i] * kkr[i];
              kp[i] = kraw * (1.0f + (a - 1.0f) * cst[192 + c]); av[i] = a; bon += rS[ix] * kp[i] * cst[256 + c]; }
          ss += dppf<0xB1>(ss); bon += dppf<0xB1>(bon); ss += dppf<0x4E>(ss); bon += dppf<0x4E>(bon);
          ss += dppf<0x141>(ss); bon += dppf<0x141>(bon); ss += dppf<0x140>(ss); bon += dppf<0x140>(bon);
          const float inv = frcp(fmaxf(__builtin_amdgcn_sqrtf(ss), 1e-12f));
          f32x4 o_nk, o_b, o_k, o_w;
#pragma unroll
          for (int i = 0; i < 4; ++i) { const float kk = kkr[i] * inv; o_nk[i] = -kk; o_b[i] = kk * av[i]; o_k[i] = kp[i]; o_w[i] = wv[i]; }
          *(LAS f32x4*)(nkS + tok * 64 + c0) = o_nk; *(LAS f32x4*)(bS + tok * 64 + c0) = o_b; *(LAS f32x4*)(kS + tok * 64 + c0) = o_k; *(LAS f32x4*)(wS + tok * 64 + c0) = o_w;
          if (dir == 0 && (tid & 15) == 0) BONUS[((size_t)b * SEQ + t0 + tok) * 8 + h] = bon; }
        __syncthreads();
        { RW_IDS if (tid < 64) { float lw[32];
#pragma unroll
            for (int s = 0; s < 32; ++s) lw[s] = wS[(dir ? 31 - s : s) * 64 + tid];
#pragma unroll
            for (int s = 1; s < 32; ++s) lw[s] += lw[s - 1];
#pragma unroll
            for (int s = 0; s < 32; ++s) wS[(dir ? 31 - s : s) * 64 + tid] = lw[s]; } }
        __syncthreads();
        { RW_IDS const int s = tid >> 4, c0 = (tid & 15) * 4; const int tok = dir ? 31 - s : s, tokp = dir ? tok + 1 : tok - 1;
          const f32x4 cum = *(const LAS f32x4*)(wS + tok * 64 + c0); f32x4 cump = (f32x4){0.f, 0.f, 0.f, 0.f}; if (s > 0) cump = *(const LAS f32x4*)(wS + tokp * 64 + c0);
          const f32x4 nk4 = *(const LAS f32x4*)(nkS + tok * 64 + c0), b4 = *(const LAS f32x4*)(bS + tok * 64 + c0), k4 = *(const LAS f32x4*)(kS + tok * 64 + c0), r4 = *(const LAS f32x4*)(rS + tok * 64 + c0), v4 = *(const LAS f32x4*)(vS + tok * 64 + c0);
          float ta[4], tb[4], tk[4], tr[4];
#pragma unroll
          for (int i = 0; i < 4; ++i) { const float g = __expf(cum[i]), gp = __expf(cump[i]), ig = __expf(-cum[i]);
              ta[i] = nk4[i] * gp; tb[i] = b4[i] * ig; tk[i] = k4[i] * ig; tr[i] = r4[i] * g;
              BtT[(c0 + i) * 40 + s] = (bf16_t)f2bf(tb[i]); KtT[(c0 + i) * 40 + s] = (bf16_t)f2bf(tk[i]); VT[(c0 + i) * 40 + s] = (bf16_t)f2bf(v4[i]);
              if (s == 31) gL[c0 + i] = g; }
          u32x2 w; w.x = pk2(ta[0], ta[1]); w.y = pk2(ta[2], ta[3]); *(LAS u32x2*)(At + s * 72 + c0) = w;
          w.x = pk2(tb[0], tb[1]); w.y = pk2(tb[2], tb[3]); *(LAS u32x2*)(Bt + s * 72 + c0) = w;
          w.x = pk2(tk[0], tk[1]); w.y = pk2(tk[2], tk[3]); *(LAS u32x2*)(Kt + s * 72 + c0) = w;
          w.x = pk2(tr[0], tr[1]); w.y = pk2(tr[2], tr[3]); *(LAS u32x2*)(Rt + s * 72 + c0) = w; }
        __syncthreads();
        { RW_IDS const int mat = wid >> 1, mt = wid & 1; const LAS bf16_t* Aop = (mat < 2) ? At : Rt; const LAS bf16_t* Bop = (mat & 1) ? Kt : Bt;
#pragma unroll
          for (int nt = 0; nt < 2; ++nt) { f32x4 acc = (f32x4){0.f, 0.f, 0.f, 0.f};
#pragma unroll
              for (int ks = 0; ks < 2; ++ks) acc = mfma16(ldsfrag(Bop, 72, nt * 16, ks * 32, fr, fq), ldsfrag(Aop, 72, mt * 16, ks * 32, fr, fq), acc);
              const int srow = mt * 16 + fr;
#pragma unroll
              for (int e = 0; e < 4; ++e) { const int i = nt * 16 + fq * 4 + e; const bool keep = (mat < 2) ? (i < srow) : (i <= srow); if (!keep) acc[e] = 0.f; }
              if (mat == 0) {
#pragma unroll
                  for (int e = 0; e < 4; ++e) NT4[e * 384 + srow * 12 + nt * 4 + fq] = acc[e]; }
              else { LAS bf16_t* X = (mat == 1) ? NakT : (mat == 2) ? MbrT : MkrT; u32x2 o; o.x = pk2(acc[0], acc[1]); o.y = pk2(acc[2], acc[3]); *(LAS u32x2*)(X + srow * 40 + nt * 16 + fq * 4) = o; } } }
        __syncthreads();
        f32x4 oacc = (f32x4){0.f, 0.f, 0.f, 0.f};
        { RW_IDS f32x4 wacc = (f32x4){0.f, 0.f, 0.f, 0.f};
#pragma unroll
          for (int ks = 0; ks < 2; ++ks) { const bf16x8 sf = ldsfrag(S0b, 72, vt * 16, ks * 32, fr, fq);
              wacc = mfma16(ldsfrag(At, 72, tt2 * 16, ks * 32, fr, fq), sf, wacc); oacc = mfma16(ldsfrag(Rt, 72, tt2 * 16, ks * 32, fr, fq), sf, oacc); }
          const bf16x8 vf = ldsfrag(VT, 40, vt * 16, 0, fr, fq);
          wacc = mfma16(ldsfrag(NakT, 40, tt2 * 16, 0, fr, fq), vf, wacc); oacc = mfma16(ldsfrag(MkrT, 40, tt2 * 16, 0, fr, fq), vf, oacc);
#pragma unroll
          for (int n2 = 0; n2 < 2; ++n2) st[n2] = mfma16(ldsfrag(KtT, 40, (tt2 * 2 + n2) * 16, 0, fr, fq), vf, st[n2]);
#pragma unroll
          for (int e = 0; e < 4; ++e) WS[(tt2 * 16 + fq * 4 + e) * 64 + vt * 16 + fr] = wacc[e]; }
        __syncthreads();
        { RW_IDS if (wid < 4) { const int v = wid * 16 + (lane >> 2), p = lane & 3; const LAS float* NTp = NT4 + p * 384; float u[8];
#pragma unroll
            for (int j = 0; j < 8; ++j) u[j] = 0.f;
#pragma unroll
            for (int t = 0; t < 32; ++t) { float q0 = (p == 0) ? WS[t * 64 + v] : 0.f, q1 = 0.f;
#pragma unroll
                for (int j4 = 0; j4 < ((t + 3) / 4 + 3) / 4; ++j4) { const f32x4 nv = *(const LAS f32x4*)(NTp + t * 12 + j4 * 4);
                    q0 += u[j4 * 4] * nv[0]; q1 += u[j4 * 4 + 1] * nv[1]; q0 += u[j4 * 4 + 2] * nv[2]; q1 += u[j4 * 4 + 3] * nv[3]; }
                float q = q0 + q1; q += dppf<0xB1>(q); q += dppf<0x4E>(q);
                u[t >> 2] = ((t & 3) == p) ? q : u[t >> 2]; asm volatile("" ::: "memory"); }
#pragma unroll
            for (int j = 0; j < 8; ++j) Ub[v * 40 + 4 * j + p] = (bf16_t)f2bf(u[j]); } }
        __syncthreads();
        { RW_IDS const bf16x8 uf = ldsfrag(Ub, 40, vt * 16, 0, fr, fq);
          oacc = mfma16(ldsfrag(MbrT, 40, tt2 * 16, 0, fr, fq), uf, oacc);
#pragma unroll
          for (int e = 0; e < 4; ++e) { const int sidx = tt2 * 16 + fq * 4 + e, tok = dir ? 31 - sidx : sidx;
              ORW[(size_t)dir * T * 512 + ((size_t)b * SEQ + t0 + tok) * 512 + h * 64 + vt * 16 + fr] = (bf16_t)f2bf(oacc[e]); }
#pragma unroll
          for (int n2 = 0; n2 < 2; ++n2) { const int kt = tt2 * 2 + n2; st[n2] = mfma16(ldsfrag(BtT, 40, kt * 16, 0, fr, fq), uf, st[n2]);
              const f32x4 gl = *(const LAS f32x4*)(gL + kt * 16 + fq * 4); st[n2] = st[n2] * gl;
              u32x2 o; o.x = pk2(st[n2][0], st[n2][1]); o.y = pk2(st[n2][2], st[n2][3]); *(LAS u32x2*)(S0b + (vt * 16 + fr) * 72 + kt * 16 + fq * 4) = o; } }
    }
#undef RW_IDX
#undef RW_ISSUE
#undef RW_IDS
#undef RW_CG
    __syncthreads();
}

__device__ __forceinline__ void rwkv_combine(const bf16_t* P0, const bf16_t* ORW, const float* BONUS, const bf16_t* G, const float* mu, const float* gn_w, const float* gn_b, bf16_t* OMIX, int gw, int NGW, int lane) {
    const int c0 = lane * 8, head = lane >> 3;
    float muv[8], gw8[8], gb8[8];
#pragma unroll
    for (int i = 0; i < 8; ++i) { muv[i] = mu[1024 + c0 + i]; gw8[i] = gn_w[c0 + i]; gb8[i] = gn_b[c0 + i]; }
    for (int tk = gw; tk < T; tk += NGW) {
        const int t = tk & (SEQ - 1);
        const u32x4 uf = *(const u32x4*)(ORW + (size_t)tk * 512 + c0), ub = *(const u32x4*)(ORW + (size_t)T * 512 + (size_t)tk * 512 + c0);
        float o[8];
#pragma unroll
        for (int i = 0; i < 4; ++i) { o[2 * i] = bflo(uf[i]) + bflo(ub[i]); o[2 * i + 1] = bfhi(uf[i]) + bfhi(ub[i]); }
        float s = 0.f;
#pragma unroll
        for (int i = 0; i < 8; ++i) s += o[i];
        const float mean = sum8(s) * (1.f / 64.f); float q = 0.f;
#pragma unroll
        for (int i = 0; i < 8; ++i) { o[i] -= mean; q += o[i] * o[i]; }
        const float rstd = rsqrtf(sum8(q) * (1.f / 64.f) + 64e-5f);
        const bf16_t* pv = P0 + (size_t)tk * ABPAD + 1024 + c0;
        const u32x4 vc = *(const u32x4*)pv; u32x4 vp = (u32x4){0u, 0u, 0u, 0u}, vn = (u32x4){0u, 0u, 0u, 0u};
        if (t > 0) vp = *(const u32x4*)(pv - ABPAD);
        if (t < SEQ - 1) vn = *(const u32x4*)(pv + ABPAD);
        const u32x4 gg = *(const u32x4*)(G + (size_t)tk * 512 + c0);
        const float bon = BONUS[(size_t)tk * 8 + head];
        float r[8];
#pragma unroll
        for (int i = 0; i < 4; ++i) {
            const float c_lo = bflo(vc[i]), c_hi = bfhi(vc[i]);
            const float v_lo = c_lo + muv[2 * i] * (0.5f * (bflo(vp[i]) + bflo(vn[i])) - c_lo), v_hi = c_hi + muv[2 * i + 1] * (0.5f * (bfhi(vp[i]) + bfhi(vn[i])) - c_hi);
            r[2 * i] = (o[2 * i] * rstd * gw8[2 * i] + gb8[2 * i] + bon * v_lo) * bflo(gg[i]);
            r[2 * i + 1] = (o[2 * i + 1] * rstd * gw8[2 * i + 1] + gb8[2 * i + 1] + bon * v_hi) * bfhi(gg[i]); }
        u32x4 w; w.x = pk2(r[0], r[1]); w.y = pk2(r[2], r[3]); w.z = pk2(r[4], r[5]); w.w = pk2(r[6], r[7]);
        *(u32x4*)(OMIX + (size_t)tk * D + c0) = w;
    }
}

constexpr int SLD = 136;
__device__ __forceinline__ float softplusf_(float x) { return x > 20.f ? x : log1pf(__expf(x)); }
__device__ __forceinline__ void ssd_dt_cum(LAS float* dtS, LAS float* cumS, LAS float* totS, const bf16_t* Prow0, int g, int w, int lane, const float* dt_bias, const float* a_log) {
    const int j = w >> 1, d = w & 1, head = g * 4 + j;
    const float bias = dt_bias[d * 8 + head], A = -__expf(a_log[d * 8 + head]);
    const float x0 = bf2f(Prow0[(size_t)(2 * lane) * ABPAD + 3328 + head]), x1 = bf2f(Prow0[(size_t)(2 * lane + 1) * ABPAD + 3328 + head]);
    const float dt0 = softplusf_(x0 + bias), dt1 = softplusf_(x1 + bias), la0 = dt0 * A, la1 = dt1 * A;
    const float s = la0 + la1; float inc = s;
#pragma unroll
    for (int off = 1; off < 64; off <<= 1) { const float n = __shfl_up(inc, off); if (lane >= off) inc += n; }
    const float tot = __shfl(inc, 63), exc = inc - s;
    float c0, c1; if (d == 0) { c0 = exc + la0; c1 = inc; } else { c0 = tot - exc; c1 = tot - exc - la0; }
    dtS[w * 128 + 2 * lane] = dt0; dtS[w * 128 + 2 * lane + 1] = dt1; cumS[w * 128 + 2 * lane] = c0; cumS[w * 128 + 2 * lane + 1] = c1;
    if (lane == 0) totS[w] = tot;
}
template <int NR, bool TR> __device__ __forceinline__ void ssd_conv8(LAS bf16_t* dst, int col0, int cx0, int l0, const bf16_t* Pb, int t0, const float* cw, const float* cb) {
    u32x4 raw[NR + 2];
    const bf16_t* p = Pb + (size_t)(t0 + l0) * ABPAD + 2304 + cx0;
#pragma unroll
    for (int i = 0; i < NR + 2; ++i) { const int t = t0 + l0 + i - 1; raw[i] = (t >= 0 && t < SEQ) ? *(const u32x4*)(p + (long)(i - 1) * ABPAD) : (u32x4){0u, 0u, 0u, 0u}; }
    float w0[8], w1[8], w2[8], bs[8];
#pragma unroll
    for (int q = 0; q < 2; ++q) { const f32x4 a = *(const f32x4*)(cw + cx0 + 4 * q), bq = *(const f32x4*)(cw + 1024 + cx0 + 4 * q), c = *(const f32x4*)(cw + 2048 + cx0 + 4 * q), d = *(const f32x4*)(cb + cx0 + 4 * q);
#pragma unroll
        for (int i = 0; i < 4; ++i) { w0[4 * q + i] = a[i]; w1[4 * q + i] = bq[i]; w2[4 * q + i] = c[i]; bs[4 * q + i] = d[i]; } }
    float o[NR][8];
#pragma unroll
    for (int i = 0; i < NR; ++i)
#pragma unroll
        for (int c = 0; c < 8; ++c) { const unsigned um = raw[i][c >> 1], u0 = raw[i + 1][c >> 1], up = raw[i + 2][c >> 1];
            const float fm = (c & 1) ? bfhi(um) : bflo(um), f0 = (c & 1) ? bfhi(u0) : bflo(u0), fp = (c & 1) ? bfhi(up) : bflo(up);
            o[i][c] = siluf_(w0[c] * fm + w1[c] * f0 + w2[c] * fp + bs[c]); }
    if (TR) {
#pragma unroll
        for (int c = 0; c < 8; ++c) { LAS bf16_t* q = dst + (col0 + c) * SLD + l0;
            if (NR == 8) { u32x4 w; w.x = pk2(o[0][c], o[1][c]); w.y = pk2(o[2][c], o[3][c]); w.z = pk2(o[4 % NR][c], o[5 % NR][c]); w.w = pk2(o[6 % NR][c], o[7 % NR][c]); *(LAS u32x4*)q = w; }
            else { u32x2 w; w.x = pk2(o[0][c], o[1][c]); w.y = pk2(o[2][c], o[3][c]); *(LAS u32x2*)q = w; } }
    } else {
#pragma unroll
        for (int i = 0; i < NR; ++i) { u32x4 w; w.x = pk2(o[i][0], o[i][1]); w.y = pk2(o[i][2], o[i][3]); w.z = pk2(o[i][4], o[i][5]); w.w = pk2(o[i][6], o[i][7]); *(LAS u32x4*)(dst + (l0 + i) * SLD + col0) = w; }
    }
}
__device__ __forceinline__ void ssd_s1_unit(LAS unsigned char* lds, int unit, const bf16_t* P0, const float* cw, const float* cb, const float* dt_bias, const float* a_log, bf16_t* STATES, float* TOT) {
    const int tid = threadIdx.x, lane = tid & 63, w = tid >> 6, fr = lane & 15, fq = lane >> 4;
    const int g = unit & 1, c = (unit >> 1) & 31, b = unit >> 6, t0 = c * 128;
    LAS bf16_t* BT = (LAS bf16_t*)lds; LAS bf16_t* XT = (LAS bf16_t*)(lds + 34816); LAS float* dtS = (LAS float*)(lds + 104448); LAS float* cumS = (LAS float*)(lds + 108544);
    LAS float* scS = (LAS float*)(lds + 112640); LAS float* totS = (LAS float*)(lds + 116736);
    const bf16_t* Pb = P0 + (size_t)b * SEQ * ABPAD;
    __syncthreads();
    ssd_conv8<4, true>(BT, (tid & 15) * 8, 512 + g * 128 + (tid & 15) * 8, (tid >> 4) * 4, Pb, t0, cw, cb);
    ssd_conv8<8, true>(XT, (tid & 31) * 8, g * 256 + (tid & 31) * 8, (tid >> 5) * 8, Pb, t0, cw, cb);
    ssd_dt_cum(dtS, cumS, totS, Pb + (size_t)t0 * ABPAD, g, w, lane, dt_bias, a_log);
    __syncthreads();
    for (int e = tid; e < 1024; e += 512) scS[e] = dtS[e] * __expf(totS[e >> 7] - cumS[e]);
    if (tid < 8) TOT[((size_t)(b * 32 + c) * 2 + (tid & 1)) * 8 + g * 4 + (tid >> 1)] = totS[tid];
    __syncthreads();
    const int j = w >> 1;
#pragma unroll 1
    for (int d = 0; d < 2; ++d) {
        f32x4 acc[2][8];
#pragma unroll
        for (int mt = 0; mt < 2; ++mt)
#pragma unroll
            for (int nt = 0; nt < 8; ++nt) acc[mt][nt] = (f32x4){0.f, 0.f, 0.f, 0.f};
#pragma unroll 1
        for (int ks = 0; ks < 4; ++ks) {
            const int k0 = ks * 32; const LAS float* sp = scS + (j * 2 + d) * 128 + k0 + fq * 8;
            const f32x4 s0 = *(const LAS f32x4*)sp, s1 = *(const LAS f32x4*)(sp + 4);
            bf16x8 afr[2];
#pragma unroll
            for (int mt = 0; mt < 2; ++mt) { const u32x4 raw = *(const LAS u32x4*)(XT + (32 * w + mt * 16 + fr) * SLD + k0 + fq * 8); u32x4 o;
                o.x = pk2(bflo(raw.x) * s0[0], bfhi(raw.x) * s0[1]); o.y = pk2(bflo(raw.y) * s0[2], bfhi(raw.y) * s0[3]);
                o.z = pk2(bflo(raw.z) * s1[0], bfhi(raw.z) * s1[1]); o.w = pk2(bflo(raw.w) * s1[2], bfhi(raw.w) * s1[3]);
                afr[mt] = __builtin_bit_cast(bf16x8, o); }
#pragma unroll
            for (int nt = 0; nt < 8; ++nt) { const bf16x8 bfr = ldsfrag(BT, SLD, nt * 16, k0, fr, fq);
#pragma unroll
                for (int mt = 0; mt < 2; ++mt) acc[mt][nt] = mfma16(bfr, afr[mt], acc[mt][nt]); }
        }
        bf16_t* dst = STATES + (((size_t)(b * 32 + c) * 2 + d) * 8 + g * 4 + j) * 8192;
#pragma unroll
        for (int mt = 0; mt < 2; ++mt) { const int p = (w & 1) * 32 + mt * 16 + fr;
#pragma unroll
            for (int nt = 0; nt < 8; ++nt) { u32x2 o; o.x = pk2(acc[mt][nt][0], acc[mt][nt][1]); o.y = pk2(acc[mt][nt][2], acc[mt][nt][3]);
                *(u32x2*)(dst + p * 128 + nt * 16 + fq * 4) = o; } }
    }
}
__device__ __forceinline__ void ssd_s2(const bf16_t* __restrict__ STATES, bf16_t* __restrict__ CARR, const float* __restrict__ TOT, int gtid, int NGT) {
    for (int it = gtid; it < 16 * 2 * 8 * 1024; it += NGT) {
        const int e8 = it & 1023, head = (it >> 10) & 7, d = (it >> 13) & 1, b = it >> 14;
        float run[8];
#pragma unroll
        for (int i = 0; i < 8; ++i) run[i] = 0.f;
#pragma unroll 1
        for (int c8 = 0; c8 < 32; c8 += 8) {
            u32x4 loc[8]; float dec[8];
#pragma unroll
            for (int q = 0; q < 8; ++q) { const int cc = c8 + q, c = d ? 31 - cc : cc; const size_t sidx = ((size_t)(b * 32 + c) * 2 + d) * 8 + head;
                loc[q] = *(const u32x4*)(STATES + sidx * 8192 + e8 * 8); dec[q] = TOT[sidx]; }
#pragma unroll
            for (int q = 0; q < 8; ++q) { const int cc = c8 + q, c = d ? 31 - cc : cc; const size_t sidx = ((size_t)(b * 32 + c) * 2 + d) * 8 + head;
                u32x4 o; o.x = pk2(run[0], run[1]); o.y = pk2(run[2], run[3]); o.z = pk2(run[4], run[5]); o.w = pk2(run[6], run[7]); *(u32x4*)(CARR + sidx * 8192 + e8 * 8) = o;
                const float dq = __expf(dec[q]);
#pragma unroll
                for (int i = 0; i < 4; ++i) { run[2 * i] = run[2 * i] * dq + bflo(loc[q][i]); run[2 * i + 1] = run[2 * i + 1] * dq + bfhi(loc[q][i]); } }
        }
    }
}
__device__ __forceinline__ void ssd_s3_unit(LAS unsigned char* lds, int unit, const bf16_t* P0, const float* cw, const float* cb, const float* dt_bias, const float* a_log, const float* dskip, const float* norm_w,
                                            const bf16_t* STATES, bf16_t* OMIX) {
    const int tid = threadIdx.x, lane = tid & 63, w = tid >> 6, fr = lane & 15, fq = lane >> 4;
    const int g = unit & 1, c = (unit >> 1) & 31, b = unit >> 6, t0 = c * 128;
    LAS bf16_t* CS = (LAS bf16_t*)lds; LAS bf16_t* BS = (LAS bf16_t*)(lds + 34816); LAS bf16_t* XT = (LAS bf16_t*)(lds + 69632);
    LAS float* dtS = (LAS float*)(lds + 139264); LAS float* cumS = (LAS float*)(lds + 143360); LAS float* totS = (LAS float*)(lds + 147456);
    const bf16_t* Pb = P0 + (size_t)b * SEQ * ABPAD;
    __syncthreads();
    ssd_conv8<4, false>(BS, (tid & 15) * 8, 512 + g * 128 + (tid & 15) * 8, (tid >> 4) * 4, Pb, t0, cw, cb);
    ssd_conv8<4, false>(CS, (tid & 15) * 8, 768 + g * 128 + (tid & 15) * 8, (tid >> 4) * 4, Pb, t0, cw, cb);
    ssd_conv8<8, true>(XT, (tid & 31) * 8, g * 256 + (tid & 31) * 8, (tid >> 5) * 8, Pb, t0, cw, cb);
    ssd_dt_cum(dtS, cumS, totS, Pb + (size_t)t0 * ABPAD, g, w, lane, dt_bias, a_log);
    __syncthreads();
    const int l = 16 * w + fr;
    f32x4 sc[8];
#pragma unroll
    for (int nt = 0; nt < 8; ++nt) sc[nt] = (f32x4){0.f, 0.f, 0.f, 0.f};
#pragma unroll
    for (int ks = 0; ks < 4; ++ks) { const bf16x8 afr = ldsfrag(CS, SLD, 16 * w, ks * 32, fr, fq);
#pragma unroll
        for (int nt = 0; nt < 8; ++nt) sc[nt] = mfma16(ldsfrag(BS, SLD, nt * 16, ks * 32, fr, fq), afr, sc[nt]); }
    __syncthreads();
    LAS bf16_t* Mw = BS + w * 16 * SLD;
    const size_t row = (size_t)b * SEQ + t0 + l; float ss = 0.f;
#pragma unroll 1
    for (int j = 0; j < 4; ++j) {
        const LAS float* cf = cumS + (j * 2) * 128; const LAS float* cbw = cumS + (j * 2 + 1) * 128; const LAS float* df = dtS + (j * 2) * 128; const LAS float* db = dtS + (j * 2 + 1) * 128;
        const float cfl = cf[l], cbl = cbw[l];
        const size_t sbase = ((size_t)(b * 32 + c) * 2) * 8 + g * 4 + j;
        const bf16_t* carf = STATES + sbase * 8192; const bf16_t* carb = STATES + (sbase + 8) * 8192;
        bf16x8 cF[4][4], cB[4][4]; u32x2 zz4[4];
#pragma unroll
        for (int ks = 0; ks < 4; ++ks)
#pragma unroll
            for (int pt = 0; pt < 4; ++pt) cF[ks][pt] = *(const bf16x8*)(carf + (pt * 16 + fr) * 128 + ks * 32 + fq * 8);
#pragma unroll
        for (int pt = 0; pt < 4; ++pt) zz4[pt] = *(const u32x2*)(P0 + row * ABPAD + 1792 + g * 256 + j * 64 + pt * 16 + fq * 4);
#pragma unroll
        for (int nt = 0; nt < 8; ++nt) { float mv[4];
#pragma unroll
            for (int i = 0; i < 4; ++i) { const int s = nt * 16 + fq * 4 + i;
                const float ff = (s <= l) ? __expf(cfl - cf[s]) * df[s] : 0.f; const float fb = (s >= l) ? __expf(cbl - cbw[s]) * db[s] : 0.f;
                mv[i] = sc[nt][i] * (ff + fb); }
            u32x2 o; o.x = pk2(mv[0], mv[1]); o.y = pk2(mv[2], mv[3]); *(LAS u32x2*)(Mw + fr * SLD + nt * 16 + fq * 4) = o; }
        LDS_WAIT();
#pragma unroll
        for (int ks = 0; ks < 4; ++ks)
#pragma unroll
            for (int pt = 0; pt < 4; ++pt) cB[ks][pt] = *(const bf16x8*)(carb + (pt * 16 + fr) * 128 + ks * 32 + fq * 8);
        f32x4 yd[4], yf[4], yb[4];
#pragma unroll
        for (int pt = 0; pt < 4; ++pt) { yd[pt] = (f32x4){0.f, 0.f, 0.f, 0.f}; yf[pt] = yd[pt]; yb[pt] = yd[pt]; }
        bf16x8 acs[4];
#pragma unroll
        for (int ks = 0; ks < 4; ++ks) {
            const bf16x8 am = *(const LAS bf16x8*)(Mw + fr * SLD + ks * 32 + fq * 8); acs[ks] = ldsfrag(CS, SLD, 16 * w, ks * 32, fr, fq);
#pragma unroll
            for (int pt = 0; pt < 4; ++pt) {
                yd[pt] = mfma16(ldsfrag(XT, SLD, j * 64 + pt * 16, ks * 32, fr, fq), am, yd[pt]);
                yf[pt] = mfma16(cF[ks][pt], acs[ks], yf[pt]); }
        }
#pragma unroll
        for (int ks = 0; ks < 4; ++ks)
#pragma unroll
            for (int pt = 0; pt < 4; ++pt) yb[pt] = mfma16(cB[ks][pt], acs[ks], yb[pt]);
        const float ef = __expf(cfl), eb = __expf(cbl), dsk = dskip[g * 4 + j];
#pragma unroll
        for (int pt = 0; pt < 4; ++pt) { const f32x4 yv = yd[pt] + yf[pt] * ef + yb[pt] * eb;
            const int col = j * 64 + pt * 16 + fq * 4; const u32x2 zz = zz4[pt];
            const float z4[4] = {bflo(zz.x), bfhi(zz.x), bflo(zz.y), bfhi(zz.y)}; float v4[4];
#pragma unroll
            for (int i = 0; i < 4; ++i) { const float xs = bf2f(XT[(col + i) * SLD + l]); float v = yv[i] + dsk * xs; const float z = z4[i]; v = v * siluf_(z);
                v4[i] = v; ss += v * v; }
            u32x2 o; o.x = pk2(v4[0], v4[1]); o.y = pk2(v4[2], v4[3]); *(u32x2*)(OMIX + row * D + 512 + g * 256 + col) = o; }
        asm volatile("" ::: "memory");
    }
    ss += __shfl_xor(ss, 16); ss += __shfl_xor(ss, 32);
    const float rs = rsqrtf(ss * (1.f / 256.f) + 1e-6f);
    asm volatile("s_waitcnt vmcnt(0)" ::: "memory");
#pragma unroll 4
    for (int q = 0; q < 16; ++q) { const int col = g * 256 + q * 16 + fq * 4; const f32x4 nw = *(const f32x4*)(norm_w + col);
        u32x2* p = (u32x2*)(OMIX + row * D + 512 + col); const u32x2 v = *p;
        u32x2 o; o.x = pk2(bflo(v.x) * rs * nw[0], bfhi(v.x) * rs * nw[1]); o.y = pk2(bflo(v.y) * rs * nw[2], bfhi(v.y) * rs * nw[3]); *p = o; }
}

constexpr int HLD = 136, HLS = 72;
__device__ __forceinline__ void hgrn_chain(LAS unsigned char* lds, int cid, bf16_t* P1, const float* hg_lb, bf16_t* Ob, int ldo, int ocbase, int ocdir) {
    const int tid = threadIdx.x, lane = tid & 63, w = tid >> 6, fr = lane & 15, fq = lane >> 4;
    const int b = cid >> 4, h = (cid >> 1) & 7, dir = cid & 1;
    LAS bf16_t* QE = (LAS bf16_t*)lds;
    LAS bf16_t* KE = (LAS bf16_t*)(lds + 17408);
    LAS bf16_t* KLT = (LAS bf16_t*)(lds + 34816);
    LAS bf16_t* VT = (LAS bf16_t*)(lds + 53248);
    LAS bf16_t* AT = (LAS bf16_t*)(lds + 71680);
    LAS bf16_t* ST = (LAS bf16_t*)(lds + 80896);
    LAS float* totS = (LAS float*)(lds + 115712);
    LAS float* lastS = (LAS float*)(lds + 117760);
    __syncthreads();
    for (int e = tid; e < 128 * HLD / 2; e += 512) ((LAS unsigned*)ST)[e] = 0u;
    const int dcol = tid & 127, qtr = tid >> 7, i0 = qtr * 16;
    const float lbv = frcp(1.0f + __expf(hg_lb[h * 128 + dcol] - hg_lb[1024 + h * 128 + dcol]));
    f32x4 st[8];
#pragma unroll
    for (int i = 0; i < 8; ++i) st[i] = (f32x4){0.f, 0.f, 0.f, 0.f};
    bf16_t* Pb = P1 + (size_t)b * SEQ * HGP;
    __syncthreads();
    unsigned short rq[16], rf[16], rv[16];
#define HG_ISSUE(t0n) do { _Pragma("unroll") for (int i = 0; i < 16; ++i) { const int tk = (t0n) + (dir ? 63 - (i0 + i) : (i0 + i)); const bf16_t* pr = Pb + (size_t)tk * HGP + h * 128 + dcol; \
        rq[i] = pr[0]; rf[i] = pr[1024 * (1 + dir)]; rv[i] = pr[3072]; } } while (0)
    HG_ISSUE((dir ? 63 : 0) * 64);
    for (int cc = 0; cc < 64; ++cc) {
        const int t0 = (dir ? 63 - cc : cc) * 64;
        float gq[16], gk[16], gc[16]; float run = 0.f;
#pragma unroll
        for (int i = 0; i < 16; ++i) { const float q = bf2f(rq[i]), fr_ = bf2f(rf[i]);
            const float f = lbv + (1.0f - lbv) * sigmoidf_(fr_); run += __logf(f); gq[i] = q; gk[i] = 1.0f - f; gc[i] = run; }
        totS[qtr * 128 + dcol] = run;
#pragma unroll
        for (int i = 0; i < 16; i += 2) *(LAS unsigned*)(VT + dcol * HLS + i0 + i) = (unsigned)rv[i] | ((unsigned)rv[i + 1] << 16);
        __syncthreads();
        { float pre = 0.f, tot = 0.f;
#pragma unroll
          for (int q4 = 0; q4 < 4; ++q4) { const float tq = totS[q4 * 128 + dcol]; if (q4 < qtr) pre += tq; tot += tq; }
          if (qtr == 0) lastS[dcol] = __expf(tot);
#pragma unroll
          for (int i = 0; i < 16; i += 2) { const float b0 = pre + gc[i], b1 = pre + gc[i + 1];
              const float e0 = __expf(b0), e1 = __expf(b1), n0 = __expf(-b0), n1 = __expf(-b1), l0 = __expf(tot - b0), l1 = __expf(tot - b1);
              QE[(i0 + i) * HLD + dcol] = (bf16_t)f2bf(gq[i] * e0); QE[(i0 + i + 1) * HLD + dcol] = (bf16_t)f2bf(gq[i + 1] * e1);
              KE[(i0 + i) * HLD + dcol] = (bf16_t)f2bf(gk[i] * n0); KE[(i0 + i + 1) * HLD + dcol] = (bf16_t)f2bf(gk[i + 1] * n1);
              *(LAS unsigned*)(KLT + dcol * HLS + i0 + i) = pk2(gk[i] * l0, gk[i + 1] * l1); } }
        if (cc + 1 < 64) HG_ISSUE((dir ? 62 - cc : cc + 1) * 64);
        __syncthreads();
        { const int mt = w >> 1;
#pragma unroll
          for (int n2 = 0; n2 < 2; ++n2) { const int nt = (w & 1) * 2 + n2; f32x4 acc = (f32x4){0.f, 0.f, 0.f, 0.f};
#pragma unroll
              for (int ks = 0; ks < 4; ++ks) acc = mfma16(ldsfrag(KE, HLD, nt * 16, ks * 32, fr, fq), ldsfrag(QE, HLD, mt * 16, ks * 32, fr, fq), acc);
              const int lrow = mt * 16 + fr; float mv[4];
#pragma unroll
              for (int i = 0; i < 4; ++i) { const int s = nt * 16 + fq * 4 + i; mv[i] = (s <= lrow) ? acc[i] : 0.f; }
              u32x2 o; o.x = pk2(mv[0], mv[1]); o.y = pk2(mv[2], mv[3]); *(LAS u32x2*)(AT + lrow * HLS + nt * 16 + fq * 4) = o; } }
        __syncthreads();
        { const int mt = w >> 1;
#pragma unroll
          for (int n4 = 0; n4 < 4; ++n4) { const int nt = (w & 1) * 4 + n4; f32x4 acc = (f32x4){0.f, 0.f, 0.f, 0.f};
#pragma unroll
              for (int ks = 0; ks < 2; ++ks) acc = mfma16(ldsfrag(VT, HLS, nt * 16, ks * 32, fr, fq), ldsfrag(AT, HLS, mt * 16, ks * 32, fr, fq), acc);
#pragma unroll
              for (int ks = 0; ks < 4; ++ks) acc = mfma16(ldsfrag(ST, HLD, nt * 16, ks * 32, fr, fq), ldsfrag(QE, HLD, mt * 16, ks * 32, fr, fq), acc);
              const int i = mt * 16 + fr, tk = t0 + (dir ? 63 - i : i);
              u32x2 o; o.x = pk2(acc[0], acc[1]); o.y = pk2(acc[2], acc[3]);
              *(u32x2*)(Ob + ((size_t)b * SEQ + tk) * ldo + ocbase + ocdir * dir + h * 128 + nt * 16 + fq * 4) = o; } }
#pragma unroll
        for (int nt = 0; nt < 8; ++nt) { const f32x4 el = *(const LAS f32x4*)(lastS + nt * 16 + fq * 4); st[nt] = st[nt] * el;
#pragma unroll
            for (int ks = 0; ks < 2; ++ks) st[nt] = mfma16(ldsfrag(KLT, HLS, nt * 16, ks * 32, fr, fq), ldsfrag(VT, HLS, w * 16, ks * 32, fr, fq), st[nt]); }
        __syncthreads();
#pragma unroll
        for (int nt = 0; nt < 8; ++nt) { u32x2 o; o.x = pk2(st[nt][0], st[nt][1]); o.y = pk2(st[nt][2], st[nt][3]); *(LAS u32x2*)(ST + (w * 16 + fr) * HLD + nt * 16 + fq * 4) = o; }
    }
    __syncthreads();
}
__device__ __forceinline__ void hgrn_combine(const bf16_t* P1, const float* norm_w, bf16_t* OMIX, int gw, int NGW, int lane) {
    const int c0 = lane * 16;
    for (int tk = gw; tk < T; tk += NGW) {
        const bf16_t* pr = P1 + (size_t)tk * HGP + c0; float o[16]; float ss = 0.f;
#pragma unroll
        for (int hh = 0; hh < 2; ++hh) { const u32x4 uf = *(const u32x4*)(pr + 1024 + hh * 8), ub = *(const u32x4*)(pr + 2048 + hh * 8);
#pragma unroll
            for (int i = 0; i < 4; ++i) { o[hh * 8 + 2 * i] = bflo(uf[i]) + bflo(ub[i]); o[hh * 8 + 2 * i + 1] = bfhi(uf[i]) + bfhi(ub[i]); } }
#pragma unroll
        for (int i = 0; i < 16; ++i) ss += o[i] * o[i];
        const float rs = rsqrtf(sum8(ss) * (1.f / 128.f) + 1e-6f);
#pragma unroll
        for (int hh = 0; hh < 2; ++hh) { const u32x4 ug = *(const u32x4*)(pr + 4096 + hh * 8); float r[8];
#pragma unroll
            for (int i = 0; i < 4; ++i) { const float g0 = bflo(ug[i]), g1 = bfhi(ug[i]);
                r[2 * i] = o[hh * 8 + 2 * i] * rs * norm_w[c0 + hh * 8 + 2 * i] * siluf_(g0);
                r[2 * i + 1] = o[hh * 8 + 2 * i + 1] * rs * norm_w[c0 + hh * 8 + 2 * i + 1] * siluf_(g1); }
            u32x4 wv; wv.x = pk2(r[0], r[1]); wv.y = pk2(r[2], r[3]); wv.z = pk2(r[4], r[5]); wv.w = pk2(r[6], r[7]);
            *(u32x4*)(OMIX + (size_t)tk * D + c0 + hh * 8) = wv; }
    }
}

#define XB_TMO      128
#define XB_XCNT(j)  (256  + 64 * (j))
#define XB_XSUB(j)  (1280 + 64 * (j))
#define XB_XGEN(j)  (2304 + 64 * (j))
#define XB_TOP      3328
#define XB_TOPGEN   3392
#define XCD_BAR_WORDS 3456
#define XB_SPIN_CAP (1u << 18)

__device__ __forceinline__ unsigned xb_ld(unsigned* p)              { return __hip_atomic_load(p, __ATOMIC_RELAXED, __HIP_MEMORY_SCOPE_AGENT); }
__device__ __forceinline__ unsigned xb_add(unsigned* p, unsigned v) { return __hip_atomic_fetch_add(p, v, __ATOMIC_RELAXED, __HIP_MEMORY_SCOPE_AGENT); }
__device__ __forceinline__ unsigned xb_xcc_id() { return (unsigned)__builtin_amdgcn_s_getreg((3 << 11) | 20) & 0xFu; }
#define XB_SPIN(cond, bar) do { unsigned _sp = 0; while (cond) { __builtin_amdgcn_s_sleep(1); \
    if ((++_sp & 255u) == 0u) { if (xb_ld(&(bar)[XB_TMO])) break; if (_sp > XB_SPIN_CAP) { atomicAdd(&(bar)[XB_TMO], 1u); break; } } } } while (0)

struct XcdBarrier {
    unsigned* bar; unsigned x;
    volatile LAS unsigned* st;
};

__device__ __forceinline__ XcdBarrier xcd_barrier_post(unsigned* bar, volatile LAS unsigned* st) {
    XcdBarrier b; b.bar = bar; b.x = xb_xcc_id(); b.st = st;
    if (threadIdx.x == 0) (void)xb_add(&bar[XB_XCNT(b.x)], 1u);
    return b;
}
__device__ __forceinline__ void xcd_barrier_complete(unsigned* bar, unsigned x, unsigned& nloc, unsigned& nx) {
    const unsigned G = gridDim.x * gridDim.y * gridDim.z;
    unsigned sum, cnt, mine, sp = 0u;
    for (;;) {
        sum = 0u; cnt = 0u; mine = 0u;
#pragma unroll
        for (unsigned j = 0; j < 16; ++j) { const unsigned c = xb_ld(&bar[XB_XCNT(j)]); sum += c; cnt += (c > 0u) ? 1u : 0u; mine = (j == x) ? c : mine; }
        if (sum == G) break;
        __builtin_amdgcn_s_sleep(1);
        if ((++sp & 255u) == 0u) { if (xb_ld(&bar[XB_TMO])) break; if (sp > XB_SPIN_CAP) { atomicAdd(&bar[XB_TMO], 1u); break; } }
    }
    nloc = mine > 0u ? mine : 1u; nx = cnt > 0u ? cnt : 1u;
}

__device__ __forceinline__ void xcd_barrier(const XcdBarrier& b) {
    asm volatile("s_waitcnt vmcnt(0)" ::: "memory");
    __syncthreads();
    if (threadIdx.x == 0) {
        unsigned* bar = b.bar;
        __builtin_amdgcn_s_waitcnt(0);
        unsigned nloc = b.st[0], nx = b.st[1];
        if (nloc == 0u) { xcd_barrier_complete(bar, b.x, nloc, nx); b.st[0] = nloc; b.st[1] = nx; }
        const unsigned old = xb_add(&bar[XB_XSUB(b.x)], 1u);
        const unsigned gen = old / nloc;
        if (old + 1u == (gen + 1u) * nloc) {
            __builtin_amdgcn_fence(__ATOMIC_RELEASE, "agent");
            asm volatile("s_waitcnt vmcnt(0)" ::: "memory");
            const unsigned og = xb_add(&bar[XB_TOP], 1u);
            const unsigned tg = og / nx;
            if (og + 1u == (tg + 1u) * nx) xb_add(&bar[XB_TOPGEN], 1u);
            else XB_SPIN(xb_ld(&bar[XB_TOPGEN]) == tg, bar);
            __builtin_amdgcn_fence(__ATOMIC_ACQUIRE, "agent");
            xb_add(&bar[XB_XGEN(b.x)], 1u);
            asm volatile("s_waitcnt vmcnt(0)" ::: "memory");
        } else {
            XB_SPIN(xb_ld(&bar[XB_XGEN(b.x)]) == gen, bar);
            __builtin_amdgcn_fence(__ATOMIC_ACQUIRE, "agent");
            asm volatile("s_waitcnt vmcnt(0)" ::: "memory");
        }
    }
    __syncthreads();
}


struct Args { const float* in[35]; float* out; unsigned char* ws; int ph_lo, ph_hi; };
static_assert(sizeof(Args) == 304, "Args layout");

__global__ void __launch_bounds__(512, 2) mk_fwd(Args args) {
    extern __shared__ __attribute__((aligned(16))) unsigned char lds_raw[];
    LAS unsigned char* lds = (LAS unsigned char*)lds_raw; LAS unsigned char* xl = lds + XLDS_OFF;
    const int G = gridDim.x, bx = blockIdx.x, NGW = G * 8;
#define LOCAL_IDS int tid = threadIdx.x; asm volatile("" : "+v"(tid)); const int lane = tid & 63, wave = __builtin_amdgcn_readfirstlane(tid >> 6), gw = bx * 8 + wave; (void)lane; (void)gw;
    typedef const __attribute__((address_space(4))) unsigned char* kaptr_t;
    kaptr_t ka = (kaptr_t)__builtin_amdgcn_kernarg_segment_ptr();
#define INP(k) (*(const float* const volatile __attribute__((address_space(4)))*)(ka + 8 * (k)))
    unsigned char* ws = *(unsigned char* const volatile __attribute__((address_space(4)))*)(ka + 288); float* out = *(float* const volatile __attribute__((address_space(4)))*)(ka + 280);
    const float* x = INP(0);
    bf16_t* WAB = (bf16_t*)(ws + WS_WAB); bf16_t* WABO = (bf16_t*)(ws + WS_WABO); bf16_t* WHG = (bf16_t*)(ws + WS_WHG); bf16_t* WHGO = (bf16_t*)(ws + WS_WHGO);
    bf16_t* WQ = (bf16_t*)(ws + WS_WQ); bf16_t* WKV = (bf16_t*)(ws + WS_WKV); bf16_t* WO = (bf16_t*)(ws + WS_WO); bf16_t* WF1 = (bf16_t*)(ws + WS_WF1); bf16_t* WF2 = (bf16_t*)(ws + WS_WF2);
    bf16_t* G2T = (bf16_t*)(ws + WS_G2T); bf16_t* MEMN = (bf16_t*)(ws + WS_MEMN); bf16_t* KMEM = (bf16_t*)(ws + WS_KMEM); bf16_t* VT = (bf16_t*)(ws + WS_VT);
    bf16_t* H = (bf16_t*)(ws + WS_H); bf16_t* P = (bf16_t*)(ws + WS_P); bf16_t* PATT = (bf16_t*)(ws + WS_PATT); bf16_t* OMIX0 = (bf16_t*)(ws + WS_OMIX0); bf16_t* OMIX1 = (bf16_t*)(ws + WS_OMIX1); float* PSB = (float*)(ws + WS_PS);
#define COMMA ,
    bf16_t* STATES = (bf16_t*)((unsigned char*)out + DO_STATES); bf16_t* GG = (bf16_t*)((unsigned char*)out + DO_G); bf16_t* SG = (bf16_t*)((unsigned char*)out + DO_SG);
    float* BONUS = (float*)((unsigned char*)out + DO_BONUS); float* TOT = (float*)((unsigned char*)out + DO_TOT);
    cg::grid_group grid = cg::this_grid();
    { volatile LAS unsigned* st_ = (volatile LAS unsigned*)(lds + LDS_BYTES - 16); if (threadIdx.x < 4) st_[threadIdx.x] = 0u; }
    __syncthreads();
    const XcdBarrier xbar = xcd_barrier_post((unsigned*)ws, (volatile LAS unsigned*)(lds + LDS_BYTES - 16));
    const int lo = *(const int volatile __attribute__((address_space(4)))*)(ka + 296), hi = *(const int volatile __attribute__((address_space(4)))*)(ka + 300);
#ifndef PH_EN
#define PH_EN(k) 1
#endif
#define IN(k) (PH_EN(k) && lo <= (k) && (k) < hi)
#ifndef DUP_MASK
#define DUP_MASK 0ull
#endif
#define REPS(k) (1 + (int)(((unsigned long long)(DUP_MASK) >> (k)) & 1ull))
#define PHASE(k) for (int rep_ = 0; rep_ < (IN(k) ? REPS(k) : 0); ++rep_, ((REPS(k) > 1) ? (grid.sync(), 0) : 0))
#define SEAM(k) do { if (IN(k) && IN((k) + 1)) { if ((k) == 0) grid.sync(); else xcd_barrier(xbar); } } while (0)
#define RUN_GEMM(EPI, ALIGN, gd, ep) do { pg8::Order S_; S_.init(gd, G, bx); pg8::gemm_phase<EPI, ALIGN>(lds, xl, gd, S_, ep); } while (0)

    PHASE(0) { LOCAL_IDS
        LAS float* scr = (LAS float*)(lds + wave * 16384);
        constexpr int I_AB = 16 * 112, I_SQ = 16 * 32, I_HG = 16 * 160, I_KV = 16 * 64, I_F1 = 16 * 176, I_F2 = 44 * 32, I_G2 = 2 * 16;
        constexpr int NIT = I_AB + I_SQ + I_HG + I_SQ + 2 * I_SQ + 2 * I_KV + 2 * I_SQ + 2 * I_F1 + 2 * I_F2 + I_G2;
        for (int it = gw; it < NIT; it += NGW) {
            int r = it;
            if (r < I_AB) { transpose_item<0>(INP(3), 1024, ABP, WAB, scr, r, 112, lane); continue; } r -= I_AB;
            if (r < I_SQ) { transpose_item<0>(INP(4), 1024, 1024, WABO, scr, r, 32, lane); continue; } r -= I_SQ;
            if (r < I_HG) { transpose_item<0>(INP(22), 1024, HGP, WHG, scr, r, 160, lane, INP(2) + D); continue; } r -= I_HG;
            if (r < I_SQ) { transpose_item<0>(INP(23), 1024, 1024, WHGO, scr, r, 32, lane); continue; } r -= I_SQ;
            if (r < 2 * I_SQ) { const int l = r / I_SQ; transpose_item<0>(INP(28) + (size_t)l * D * D, 1024, 1024, WQ + (size_t)l * D * D, scr, r % I_SQ, 32, lane, INP(26) + l * D); continue; } r -= 2 * I_SQ;
            if (r < 2 * I_KV) { const int l = r / I_KV; transpose_item<0>(INP(29) + (size_t)l * D * 2048, 1024, 2048, WKV + (size_t)l * D * 2048, scr, r % I_KV, 64, lane); continue; } r -= 2 * I_KV;
            if (r < 2 * I_SQ) { const int l = r / I_SQ; transpose_item<0>(INP(30) + (size_t)l * D * D, 1024, 1024, WO + (size_t)l * D * D, scr, r % I_SQ, 32, lane); continue; } r -= 2 * I_SQ;
            if (r < 2 * I_F1) { const int l = r / I_F1; transpose_item<1>(INP(32) + (size_t)l * D * 2 * FFN, 1024, 2 * FFN, WF1 + (size_t)l * D * 2 * FFN, scr, r % I_F1, 176, lane, INP(31) + l * D); continue; } r -= 2 * I_F1;
            if (r < 2 * I_F2) { const int l = r / I_F2; transpose_item<0>(INP(33) + (size_t)l * FFN * D, FFN, 1024, WF2 + (size_t)l * FFN * D, scr, r % I_F2, 32, lane); continue; } r -= 2 * I_F2;
            transpose_item<0>(INP(10), 128, 512, G2T, scr, r, 16, lane);
        }
        rms_rows_phase(x, INP(2), H, T, gw, NGW, lane);
        for (int m = gw; m < 2 * 4096; m += NGW) { const int l = m >> 12, r = m & 4095; rms_row_bf16(INP(1) + (size_t)r * D, INP(27) + l * D, MEMN + (size_t)m * D, lane); }
        __syncthreads();
    }
    SEAM(0);
    PHASE(1) {
        { pg8::Gemm g = pg8::make_gemm(H, WAB, T, ABPAD, 1024, 1024, 1024); pg8::EpiBf16 E{P, ABPAD, 1.0f, nullptr}; RUN_GEMM(pg8::EpiBf16, true, g, E); }
        for (int l = 0; l < 2; ++l) {
            { pg8::Gemm g = pg8::make_gemm(MEMN + (size_t)l * 4096 * D, WKV + (size_t)l * 2048 * D, 4096, 1024, 1024, 1024, 1024); pg8::EpiBf16 E{KMEM + (size_t)l * 4096 * D, 1024, 1.0f, nullptr}; RUN_GEMM(pg8::EpiBf16, true, g, E); }
            { pg8::Gemm g = pg8::make_gemm(WKV + (size_t)l * 2048 * D + (size_t)1024 * D, MEMN + (size_t)l * 4096 * D, 1024, 4096, 1024, 1024, 1024); pg8::EpiBf16 E{VT + (size_t)l * 4096 * D, 4096, 1.0f, nullptr}; RUN_GEMM(pg8::EpiBf16, true, g, E); }
        }
    }
    SEAM(1);
    PHASE(2) {
#ifndef DUP_RWKV
#define DUP_RWKV 0
#endif
#ifndef DUP_S1
#define DUP_S1 0
#endif
        for (int r2 = 0; r2 <= DUP_RWKV; ++r2)
        for (int cid = bx; cid < 256; cid += G)
            rwkv_chain(lds, cid, P, INP(5), INP(6), INP(7), INP(8), INP(9), INP(11), INP(12), INP(13), H, SG, BONUS);
        for (int r2 = 0; r2 <= DUP_S1; ++r2)
        for (int u = bx; u < 1024; u += G) ssd_s1_unit(lds, u, P, INP(16), INP(17), INP(18), INP(19), STATES, TOT);
        __syncthreads();
    }
    SEAM(2);
    PHASE(3) {
        { int k128 = 128; asm volatile("" : "+s"(k128)); pg8::Gemm g = pg8::make_gemm(SG, G2T, T, 512, k128, 128, 128); pg8::EpiBf16 E{GG, 512, 1.0f, nullptr}; RUN_GEMM(pg8::EpiBf16, true, g, E); }
        { LOCAL_IDS ssd_s2(STATES, OMIX1, TOT, bx * 512 + tid, G * 512); }
    }
    SEAM(3);
    PHASE(4) {
#ifndef DUP_S3
#define DUP_S3 0
#endif
        for (int r2 = 0; r2 <= DUP_S3; ++r2)
        for (int u = bx; u < 1024; u += G) ssd_s3_unit(lds, u, P, INP(16), INP(17), INP(18), INP(19), INP(20), INP(21), OMIX1, OMIX0);
        __syncthreads();
        { LOCAL_IDS rwkv_combine(P, H, BONUS, GG, INP(5), INP(14), INP(15), OMIX0, gw, NGW, lane); }
    }
    SEAM(4);
    PHASE(5) { pg8::Gemm g = pg8::make_gemm(OMIX0, WABO, T, 1024, 1024, 1024, 1024); pg8::EpiResidH E{x, out, H, PSB, 1024}; RUN_GEMM(pg8::EpiResidH, true, g, E); }
    SEAM(5);

#define ATTN_FFN(base, L, LASTEPI) \
    PHASE(base) { pg8::Gemm g = pg8::make_gemm(H, WQ + (size_t)(L) * D * D, T, 1024, 1024, 1024, 1024); pg8::EpiBf16 E{P, 1024, 0.0625f, PSB}; RUN_GEMM(pg8::EpiBf16, true, g, E); } \
    SEAM(base); \
    PHASE(base + 1) { pg8::Gemm g = pg8::make_gemm(P, KMEM + (size_t)(L) * 4096 * D, SEQ, 256, 256, 1024, 1024); g.nZ = 64; g.zdiv = 4; \
        g.sAo = (long)SEQ * D; g.sAi = 256; g.sBo = 256L * D; g.sBi = 256; g.sCo = (long)SEQ * D; g.sCi = 256; pg8::EpiSoftmax E{PATT, 1024}; RUN_GEMM(pg8::EpiSoftmax, true, g, E); } \
    SEAM(base + 1); \
    PHASE(base + 2) { pg8::Gemm g = pg8::make_gemm(PATT, VT + (size_t)(L) * 4096 * D, SEQ, 256, 256, 1024, 4096); g.nZ = 64; g.zdiv = 4; \
        g.sAo = (long)SEQ * D; g.sAi = 256; g.sBo = 256; g.sBi = 256L * 4096; g.sCo = (long)SEQ * D; g.sCi = 256; pg8::EpiBf16 E{P, 1024, 1.0f, nullptr}; RUN_GEMM(pg8::EpiBf16, true, g, E); } \
    SEAM(base + 2); \
    PHASE(base + 3) { pg8::Gemm g = pg8::make_gemm(P, WO + (size_t)(L) * D * D, T, 1024, 1024, 1024, 1024); pg8::EpiResidH E{out, out, H, PSB, 1024}; RUN_GEMM(pg8::EpiResidH, true, g, E); } \
    SEAM(base + 3); \
    PHASE(base + 4) { pg8::Gemm g = pg8::make_gemm(H, WF1 + (size_t)(L) * D * 2 * FFN, T, 2 * FFN, 1024, 1024, 1024); pg8::EpiSwiglu E{P, FFN, PSB}; RUN_GEMM(pg8::EpiSwiglu, true, g, E); } \
    SEAM(base + 4); \
    PHASE(base + 5) { pg8::Gemm g = pg8::make_gemm(P, WF2 + (size_t)(L) * FFN * D, T, 1024, FFN, FFN, FFN); LASTEPI } \
    SEAM(base + 5);

    ATTN_FFN(6, 0, pg8::EpiResidH E{out COMMA out COMMA H COMMA PSB COMMA 1024}; RUN_GEMM(pg8::EpiResidH, true, g, E);)

    PHASE(12) { pg8::Gemm g = pg8::make_gemm(H, WHG, T, HGP, 1024, 1024, 1024); pg8::EpiBf16 E{P, HGP, 1.0f, PSB}; RUN_GEMM(pg8::EpiBf16, true, g, E); }
    SEAM(12);
    PHASE(13) {
#ifdef DUP_HGRN
        for (int cid = bx; cid < 256; cid += G) hgrn_chain(lds, cid, P, INP(25), OMIX1, 1024, 0, 0);
        grid.sync();
#endif
        for (int cid = bx; cid < 256; cid += G) hgrn_chain(lds, cid, P, INP(25), P, HGP, 1024, 1024); }
    SEAM(13);
    PHASE(14) { LOCAL_IDS hgrn_combine(P, INP(24), OMIX1, gw, NGW, lane); }
    SEAM(14);
    PHASE(15) { pg8::Gemm g = pg8::make_gemm(OMIX1, WHGO, T, 1024, 1024, 1024, 1024); pg8::EpiResidH E{out, out, H, PSB, 1024}; RUN_GEMM(pg8::EpiResidH, true, g, E); }
    SEAM(15);

    ATTN_FFN(16, 1, pg8::EpiResid E{out COMMA out COMMA 1024}; RUN_GEMM(pg8::EpiResid, true, g, E);)

    PHASE(22) { LOCAL_IDS
        const float* fg = INP(34);
        for (int m = gw; m < T; m += NGW) { f32x4* xr = (f32x4*)(out + (size_t)m * D) + lane; f32x4 v[4]; float s = 0.f;
#pragma unroll
            for (int j = 0; j < 4; ++j) { v[j] = xr[64 * j]; s += (v[j].x * v[j].x + v[j].y * v[j].y) + (v[j].z * v[j].z + v[j].w * v[j].w); }
            const float rs = rsqrtf(wave_sum(s) * (1.f / D) + 1e-6f);
#pragma unroll
            for (int j = 0; j < 4; ++j) { const f32x4 g = ((const f32x4*)fg)[lane + 64 * j]; f32x4 o = v[j] * rs * g;
                xr[64 * j] = o; } }
    }
#undef IN
#undef SEAM
#undef RUN_GEMM
}

extern "C" void kernel_launch(void* const* d_in, const int* in_sizes, int n_in, void* d_out, int out_size, void* d_ws, size_t ws_size, hipStream_t stream) {
    static int grid = 0;
    if (grid == 0) {
        if (n_in != 35 || out_size != T * D || ws_size < WS_END) { fprintf(stderr, "kernel_launch: unexpected shapes (n_in %d out %d ws %zu)\n", n_in, out_size, ws_size); grid = -1; return; }
        int dev = 0, cus = 0, per_cu = 0;
        hipGetDevice(&dev); hipDeviceGetAttribute(&cus, hipDeviceAttributeMultiprocessorCount, dev);
        hipFuncSetAttribute((const void*)mk_fwd, hipFuncAttributeMaxDynamicSharedMemorySize, LDS_BYTES);
        hipOccupancyMaxActiveBlocksPerMultiprocessor(&per_cu, (const void*)mk_fwd, 512, LDS_BYTES);
        if (per_cu < 1) { fprintf(stderr, "kernel_launch: occupancy query says %d blocks per CU\n", per_cu); per_cu = 1; }
        (void)hipGetLastError();
        grid = cus * 1;
    }
    if (grid < 0) return;
    if (hipMemsetAsync(d_ws, 0, 65536, stream) != hipSuccess) { fprintf(stderr, "kernel_launch: memset of the barrier words failed\n"); return; }
    Args a{};
    for (int i = 0; i < 35; ++i) a.in[i] = (const float*)d_in[i];
    a.out = (float*)d_out; a.ws = (unsigned char*)d_ws;
#if MK_COOP
    a.ph_lo = 0; a.ph_hi = NPHASE;
    void* kargs[] = {&a};
    hipError_t e = hipLaunchCooperativeKernel((const void*)mk_fwd, dim3(grid), dim3(512), kargs, LDS_BYTES, stream);
    if (e != hipSuccess) fprintf(stderr, "cooperative launch failed: %s (grid %d)\n", hipGetErrorString(e), grid);
#else
    for (int ph = 0; ph < NPHASE; ++ph) { a.ph_lo = ph; a.ph_hi = ph + 1; hipLaunchKernelGGL(mk_fwd, dim3(grid), dim3(512), LDS_BYTES, stream, a); }
#endif
}
```

```cpp
#include <hip/hip_runtime.h>
#include <hip/hip_cooperative_groups.h>
#include <cstdio>
#include <cstdint>
namespace cg = cooperative_groups;

#ifndef MK_COOP
#define MK_COOP 1
#endif

#define LAS __attribute__((address_space(3)))
typedef unsigned short bf16_t;
typedef short bf16x8 __attribute__((ext_vector_type(8)));
typedef float f32x4 __attribute__((ext_vector_type(4)));
typedef float f32x2 __attribute__((ext_vector_type(2)));
typedef unsigned u32x4 __attribute__((ext_vector_type(4)));
typedef unsigned u32x2 __attribute__((ext_vector_type(2)));

constexpr int NB = 16, SEQ = 4096, T = NB * SEQ, D = 1024;
constexpr int ABPAD = 3584, ABP = 3336;
constexpr int HGP = 5120;
constexpr int FFN = 2816;
constexpr int NPHASE = 23;

constexpr size_t MiB = 1u << 20;
constexpr size_t WS_WAB = 1 * MiB, WS_WABO = 8 * MiB, WS_WHG = 10 * MiB, WS_WHGO = 20 * MiB, WS_WQ = 22 * MiB, WS_WKV = 26 * MiB, WS_WO = 34 * MiB,
                 WS_WF1 = 38 * MiB, WS_WF2 = 60 * MiB, WS_G2T = 71 * MiB, WS_MEMN = 72 * MiB, WS_KMEM = 88 * MiB, WS_VT = 104 * MiB,
                 WS_PS = 120 * MiB, WS_H = 128 * MiB, WS_P = 256 * MiB, WS_PATT = 384 * MiB, WS_OMIX0 = 704 * MiB, WS_OMIX1 = 896 * MiB, WS_END = 1024 * MiB;
constexpr size_t DO_STATES = 0, DO_G = 128 * MiB, DO_SG = 192 * MiB, DO_BONUS = 208 * MiB, DO_TOT = 210 * MiB;

constexpr int LDS_BYTES = 163840;
constexpr int XLDS_OFF = 131072;

__device__ __forceinline__ unsigned f2bf(float f) { unsigned u = __builtin_bit_cast(unsigned, f); return (u + 0x7fffu + ((u >> 16) & 1u)) >> 16; }
__device__ __forceinline__ unsigned pk2(float lo, float hi) { return f2bf(lo) | (f2bf(hi) << 16); }
__device__ __forceinline__ float bf2f(unsigned short b) { return __builtin_bit_cast(float, (unsigned)b << 16); }
__device__ __forceinline__ float bflo(unsigned u) { return __builtin_bit_cast(float, u << 16); }
__device__ __forceinline__ float bfhi(unsigned u) { return __builtin_bit_cast(float, u & 0xffff0000u); }
__device__ __forceinline__ float frcp(float x) { return __builtin_amdgcn_rcpf(x); }
__device__ __forceinline__ float sigmoidf_(float x) { return frcp(1.0f + __expf(-x)); }
__device__ __forceinline__ float siluf_(float x) { return x * frcp(1.0f + __expf(-x)); }
__device__ __forceinline__ float wave_sum(float v) {
#pragma unroll
    for (int o = 1; o < 64; o <<= 1) v += __shfl_xor(v, o);
    return v;
}
template <int CTRL> __device__ __forceinline__ float dppf(float x) { return __builtin_bit_cast(float, __builtin_amdgcn_mov_dpp(__builtin_bit_cast(int, x), CTRL, 0xf, 0xf, true)); }
__device__ __forceinline__ float sum8(float v) { v += dppf<0xB1>(v); v += dppf<0x4E>(v); v += dppf<0x141>(v); return v; }
#define LDS_WAIT() asm volatile("s_waitcnt lgkmcnt(0)" ::: "memory")

namespace pg8 {
constexpr int BM = 256, BK = 64, HALF = 128, HTB = HALF * BK * 2, STAGE_BYTES = 8 * HTB, NXCD = 8, WGM = 8;
__host__ __device__ __forceinline__ int lds_byte(int r, int c) { const int st = (r >> 4) * 2 + (c >> 5), rr = r & 15, cc = c & 31, ob = rr * 64 + cc * 2; return st * 1024 + (ob ^ (((ob >> 9) & 1) << 5)); }
__host__ __device__ __forceinline__ void stage_rc(int b, int& R, int& C) { const int st = b / 1024, sb = b % 1024, swz = sb ^ (((sb >> 9) & 1) << 5); R = (st >> 1) * 16 + swz / 64; C = (st & 1) * 32 + (swz % 64) / 2; }
__host__ __device__ __forceinline__ int perm32(int rho) { const int n = rho >> 4, i = rho & 15; return 8 * (i >> 2) + 4 * n + (i & 3); }

struct Unit { int pm, pn, z; };
struct Gemm {
    const bf16_t* A; const bf16_t* Bt; int lda, ldb, K, nM, nN, nZ, zdiv; long sAo, sAi, sBo, sBi, sCo, sCi;
    __device__ __forceinline__ long offA(const Unit& u) const { return (long)(u.z / zdiv) * sAo + (long)(u.z % zdiv) * sAi + (long)u.pm * BM * lda; }
    __device__ __forceinline__ long offB(const Unit& u) const { return (long)(u.z / zdiv) * sBo + (long)(u.z % zdiv) * sBi + (long)u.pn * BM * ldb; }
    __device__ __forceinline__ long offC(const Unit& u) const { return (long)(u.z / zdiv) * sCo + (long)(u.z % zdiv) * sCi; }
};
__device__ __forceinline__ Gemm make_gemm(const bf16_t* A, const bf16_t* Bt, int M, int N, int K, int lda, int ldb) {
    Gemm g; g.A = A; g.Bt = Bt; g.lda = lda; g.ldb = ldb; g.K = K; g.nM = M / BM; g.nN = N / BM; g.nZ = 1; g.zdiv = 1; g.sAo = g.sAi = g.sBo = g.sBi = g.sCo = g.sCi = 0; return g;
}
struct Order {
    int nM, nN, nwg, total, G, c;
    __device__ __forceinline__ void init(const Gemm& g, int G_, int c_) { nM = g.nM; nN = g.nN; nwg = nM * nN; total = nwg * g.nZ; G = G_; c = c_; }
    __device__ __forceinline__ bool next(int i, Unit& u) const {
        const long L = (long)i * G + c; if (L >= total) return false;
        u.z = (int)(L / nwg); int wgid = (int)(L % nwg);
        { const int q = nwg / NXCD, r = nwg % NXCD, xcd = wgid % NXCD, off = wgid / NXCD; wgid = (xcd < r ? xcd * (q + 1) : r * (q + 1) + (xcd - r) * q) + off; }
        const int nig = WGM * nN, gid = wgid / nig, fm = gid * WGM, gsz = (nM - fm) < WGM ? (nM - fm) : WGM;
        u.pm = fm + ((wgid % nig) % gsz); u.pn = (wgid % nig) / gsz; return true;
    }
};

__device__ __forceinline__ unsigned cvt_pk_bf16(float lo, float hi) { unsigned r; asm volatile("v_cvt_pk_bf16_f32 %0, %1, %2" : "=v"(r) : "v"(lo), "v"(hi)); return r; }

__device__ __forceinline__ void row_scales(const float* PS, int rowbase, int fq, float (&rs)[2][4]) {
#pragma unroll
    for (int ai = 0; ai < 2; ++ai)
#pragma unroll
        for (int m = 0; m < 4; ++m) { const f32x4 p = *(const f32x4*)(PS + (size_t)(rowbase + ai * HALF + m * 16) * 16 + fq * 4);
            float s = (p[0] + p[1]) + (p[2] + p[3]); s += __shfl_xor(s, 16); s += __shfl_xor(s, 32); rs[ai][m] = rsqrtf(s * (1.f / 1024.f) + 1e-6f); }
}
struct EpiBf16 {
    static constexpr bool PERM = true;
    bf16_t* O; int ldc; float scale; const float* PS;
    __device__ __forceinline__ void operator()(const f32x4 (&acc)[2][2][4][2], const Unit& u, long coff, int wr, int wc, int fr, int fq, LAS unsigned char* xl) const {
        const int row0 = u.pm * BM + wr * 64 + fr, col0 = u.pn * BM + wc * 32 + 8 * fq; bf16_t* base = O + coff;
        float rs[2][4];
        if (PS) row_scales(PS, row0, fq, rs);
        else {
#pragma unroll
            for (int ai = 0; ai < 2; ++ai)
#pragma unroll
                for (int m = 0; m < 4; ++m) rs[ai][m] = 1.f; }
#pragma unroll
        for (int ai = 0; ai < 2; ++ai)
#pragma unroll
            for (int m = 0; m < 4; ++m) { bf16_t* rowp = base + (size_t)(row0 + ai * HALF + m * 16) * ldc + col0; const float sc_ = scale * rs[ai][m];
#pragma unroll
                for (int bj = 0; bj < 2; ++bj) { const f32x4 v0 = acc[ai][bj][m][0] * sc_, v1 = acc[ai][bj][m][1] * sc_;
                    u32x4 w; w.x = cvt_pk_bf16(v0[0], v0[1]); w.y = cvt_pk_bf16(v0[2], v0[3]); w.z = cvt_pk_bf16(v1[0], v1[1]); w.w = cvt_pk_bf16(v1[2], v1[3]);
                    *(u32x4*)(rowp + bj * HALF) = w; } }
    }
};
struct EpiResid {
    static constexpr bool PERM = false;
    const float* base; float* out; int ldc;
    __device__ __forceinline__ void operator()(const f32x4 (&acc)[2][2][4][2], const Unit& u, long coff, int wr, int wc, int fr, int fq, LAS unsigned char* xl) const {
        const int col0 = u.pn * BM + wc * 32 + 4 * fq;
#pragma unroll
        for (int ai = 0; ai < 2; ++ai)
#pragma unroll
            for (int m = 0; m < 4; ++m) { const size_t off = (size_t)(u.pm * BM + ai * HALF + wr * 64 + m * 16 + fr) * ldc + col0;
#pragma unroll
                for (int bj = 0; bj < 2; ++bj)
#pragma unroll
                    for (int n = 0; n < 2; ++n) { const f32x4 bs = *(const f32x4*)(base + off + bj * HALF + n * 16); *(f32x4*)(out + off + bj * HALF + n * 16) = bs + acc[ai][bj][m][n]; } }
    }
};
struct EpiResidH {
    static constexpr bool PERM = false;
    const float* base; float* out; bf16_t* HB; float* PS; int ldc;
    __device__ __forceinline__ void operator()(const f32x4 (&acc)[2][2][4][2], const Unit& u, long coff, int wr, int wc, int fr, int fq, LAS unsigned char* xl) const {
        const int col0 = u.pn * BM + wc * 32 + 4 * fq;
#pragma unroll
        for (int ai = 0; ai < 2; ++ai)
#pragma unroll
            for (int m = 0; m < 4; ++m) { const int row = u.pm * BM + ai * HALF + wr * 64 + m * 16 + fr; const size_t off = (size_t)row * ldc + col0; float ss = 0.f;
#pragma unroll
                for (int bj = 0; bj < 2; ++bj)
#pragma unroll
                    for (int n = 0; n < 2; ++n) { const f32x4 bs = *(const f32x4*)(base + off + bj * HALF + n * 16); const f32x4 o = bs + acc[ai][bj][m][n]; *(f32x4*)(out + off + bj * HALF + n * 16) = o;
                        ss += (o[0] * o[0] + o[1] * o[1]) + (o[2] * o[2] + o[3] * o[3]);
                        u32x2 w; w.x = cvt_pk_bf16(o[0], o[1]); w.y = cvt_pk_bf16(o[2], o[3]); *(u32x2*)(HB + off + bj * HALF + n * 16) = w; }
                ss += __shfl_xor(ss, 16); ss += __shfl_xor(ss, 32);
                if (fq == 0) PS[(size_t)row * 16 + u.pn * 4 + wc] = ss; }
    }
};
struct EpiSwiglu {
    static constexpr bool PERM = true;
    bf16_t* O; int ldc; const float* PS;
    __device__ __forceinline__ void operator()(const f32x4 (&acc)[2][2][4][2], const Unit& u, long coff, int wr, int wc, int fr, int fq, LAS unsigned char* xl) const {
        const int row0 = u.pm * BM + wr * 64 + fr, col0 = u.pn * HALF + wc * 32 + 8 * fq;
        float rs[2][4]; row_scales(PS, row0, fq, rs);
#pragma unroll
        for (int ai = 0; ai < 2; ++ai)
#pragma unroll
            for (int m = 0; m < 4; ++m) { bf16_t* rowp = O + (size_t)(row0 + ai * HALF + m * 16) * ldc + col0; float r[8]; const float sc_ = rs[ai][m];
#pragma unroll
                for (int n = 0; n < 2; ++n)
#pragma unroll
                    for (int i = 0; i < 4; ++i) { const float g = acc[ai][0][m][n][i] * sc_, uu = acc[ai][1][m][n][i] * sc_; r[n * 4 + i] = siluf_(g) * uu; }
                u32x4 w; w.x = cvt_pk_bf16(r[0], r[1]); w.y = cvt_pk_bf16(r[2], r[3]); w.z = cvt_pk_bf16(r[4], r[5]); w.w = cvt_pk_bf16(r[6], r[7]);
                *(u32x4*)rowp = w; }
    }
};
struct EpiSoftmax {
    static constexpr bool PERM = true;
    bf16_t* O; int ldc;
    __device__ __forceinline__ void operator()(f32x4 (&acc)[2][2][4][2], const Unit& u, long coff, int wr, int wc, int fr, int fq, LAS unsigned char* xl) const {
        LAS float* XM = (LAS float*)xl; LAS float* XS = (LAS float*)(xl + 4096);
#pragma unroll
        for (int ai = 0; ai < 2; ++ai)
#pragma unroll
            for (int m = 0; m < 4; ++m) { float mx = -3.0e38f;
#pragma unroll
                for (int bj = 0; bj < 2; ++bj)
#pragma unroll
                    for (int n = 0; n < 2; ++n)
#pragma unroll
                        for (int i = 0; i < 4; ++i) mx = fmaxf(mx, acc[ai][bj][m][n][i]);
                mx = fmaxf(mx, __shfl_xor(mx, 16)); mx = fmaxf(mx, __shfl_xor(mx, 32));
                if (fq == 0) XM[(ai * HALF + wr * 64 + m * 16 + fr) * 4 + wc] = mx; }
        LDS_WAIT(); __builtin_amdgcn_s_barrier(); asm volatile("" ::: "memory");
#pragma unroll
        for (int ai = 0; ai < 2; ++ai)
#pragma unroll
            for (int m = 0; m < 4; ++m) { const f32x4 mm = *(const LAS f32x4*)(XM + (ai * HALF + wr * 64 + m * 16 + fr) * 4);
                const float mx = fmaxf(fmaxf(mm[0], mm[1]), fmaxf(mm[2], mm[3])); float s = 0.f;
#pragma unroll
                for (int bj = 0; bj < 2; ++bj)
#pragma unroll
                    for (int n = 0; n < 2; ++n)
#pragma unroll
                        for (int i = 0; i < 4; ++i) { const float e = __expf(acc[ai][bj][m][n][i] - mx); acc[ai][bj][m][n][i] = e; s += e; }
                s += __shfl_xor(s, 16); s += __shfl_xor(s, 32);
                if (fq == 0) XS[(ai * HALF + wr * 64 + m * 16 + fr) * 4 + wc] = s; }
        LDS_WAIT(); __builtin_amdgcn_s_barrier(); asm volatile("" ::: "memory");
        const int row0 = u.pm * BM + wr * 64 + fr, col0 = wc * 32 + 8 * fq; bf16_t* base = O + coff;
#pragma unroll
        for (int ai = 0; ai < 2; ++ai)
#pragma unroll
            for (int m = 0; m < 4; ++m) { const f32x4 ss = *(const LAS f32x4*)(XS + (ai * HALF + wr * 64 + m * 16 + fr) * 4);
                const float inv = frcp((ss[0] + ss[1]) + (ss[2] + ss[3])); bf16_t* rowp = base + (size_t)(row0 + ai * HALF + m * 16) * ldc + col0;
#pragma unroll
                for (int bj = 0; bj < 2; ++bj) { const f32x4 v0 = acc[ai][bj][m][0] * inv, v1 = acc[ai][bj][m][1] * inv;
                    u32x4 w; w.x = cvt_pk_bf16(v0[0], v0[1]); w.y = cvt_pk_bf16(v0[2], v0[3]); w.z = cvt_pk_bf16(v1[0], v1[1]); w.w = cvt_pk_bf16(v1[2], v1[3]);
                    *(u32x4*)(rowp + bj * HALF) = w; } }
    }
};

template <class Epi, bool ALIGN_EPI>
__device__ __forceinline__ void gemm_phase(LAS unsigned char* lds, LAS unsigned char* xl, const Gemm g, const Order& S, Epi& E) {
    const int tid = threadIdx.x, wid = __builtin_amdgcn_readfirstlane(tid >> 6), lane = tid & 63, wr = wid >> 2, wc = wid & 3, fr = lane & 15, fq = lane >> 4;
    const int K = g.K, nt = K / BK;
    unsigned voffA[2], voffB[2];
#pragma unroll
    for (int i = 0; i < 2; ++i) { int R, C; stage_rc(tid * 16 + i * 8192, R, C); const int Rb = Epi::PERM ? ((R & ~31) + perm32(R & 31)) : R;
        voffA[i] = (unsigned)(R * g.lda + C) * 2u; voffB[i] = (unsigned)(Rb * g.ldb + C) * 2u; }
    const size_t kstep = (size_t)(BK * 2);
    const size_t hstepA = (size_t)HALF * g.lda * 2, hstepB = (size_t)HALF * g.ldb * 2;
    const unsigned ldsw = (unsigned)wid * 1024u;
    const int aoff = lds_byte(wr * 64 + fr, fq * 8), boff = lds_byte(wc * 32 + fr, fq * 8);
#define PG8_SA(b, h) (((b) * 2 + (h)) * HTB)
#define PG8_SB(b, h) ((4 + (b) * 2 + (h)) * HTB)
#define PG8_STAGE(bufoff, gbase, voff) do { _Pragma("unroll") for (int _i = 0; _i < 2; ++_i) \
        __builtin_amdgcn_global_load_lds((const unsigned*)((const char*)(gbase) + (voff)[_i]), (LAS unsigned*)(lds + (bufoff) + ldsw + _i * 8192), 16, 0, 0); } while (0)
#define PG8_LDA(dst, b, h) do { _Pragma("unroll") for (int m = 0; m < 4; ++m) _Pragma("unroll") for (int k = 0; k < 2; ++k) dst[m][k] = *(const LAS bf16x8*)(lds + PG8_SA(b, h) + aoff + m * 2048 + k * 1024); } while (0)
#define PG8_LDB(dst, b, h) do { _Pragma("unroll") for (int n = 0; n < 2; ++n) _Pragma("unroll") for (int k = 0; k < 2; ++k) dst[n][k] = *(const LAS bf16x8*)(lds + PG8_SB(b, h) + boff + n * 2048 + k * 1024); } while (0)
#define PG8_MMA(ai, bj, At, Bt) do { __builtin_amdgcn_s_setprio(1); _Pragma("unroll") for (int m = 0; m < 4; ++m) _Pragma("unroll") for (int n = 0; n < 2; ++n) _Pragma("unroll") for (int k = 0; k < 2; ++k) \
        acc[ai][bj][m][n] = __builtin_amdgcn_mfma_f32_16x16x32_bf16(Bt[n][k], At[m][k], acc[ai][bj][m][n], 0, 0, 0); __builtin_amdgcn_s_setprio(0); } while (0)
#define PG8_WAIT_V(n) asm volatile("s_waitcnt vmcnt(" #n ")" ::: "memory")
#define PG8_WAIT_L(n) asm volatile("s_waitcnt lgkmcnt(" #n ")" ::: "memory")
#define PG8_BAR __builtin_amdgcn_s_barrier()
#define PG8_SCHED __builtin_amdgcn_sched_barrier(0)
    Unit cur, nxt; int ui = 0;
    if (!S.next(0, cur)) return;
    f32x4 acc[2][2][4][2];
#pragma unroll
    for (int a = 0; a < 2; ++a)
#pragma unroll
        for (int b = 0; b < 2; ++b)
#pragma unroll
            for (int m = 0; m < 4; ++m)
#pragma unroll
                for (int n = 0; n < 2; ++n) acc[a][b][m][n] = (f32x4){0.f, 0.f, 0.f, 0.f};
    bf16x8 At[4][2], B0[2][2], B1[2][2];
    const char* cA = (const char*)g.A + 2 * g.offA(cur); const char* cB = (const char*)g.Bt + 2 * g.offB(cur);
    PG8_STAGE(PG8_SB(0, 0), cB, voffB); PG8_STAGE(PG8_SB(0, 1), cB + hstepB, voffB); PG8_STAGE(PG8_SA(0, 0), cA, voffA); PG8_STAGE(PG8_SA(0, 1), cA + hstepA, voffA);
    if (wr == 1) PG8_BAR;
    PG8_WAIT_V(2); PG8_BAR;
    PG8_STAGE(PG8_SB(1, 0), cB + kstep, voffB); PG8_STAGE(PG8_SA(1, 0), cA + kstep, voffA); PG8_STAGE(PG8_SB(1, 1), cB + hstepB + kstep, voffB);
    PG8_WAIT_V(6); PG8_BAR;
    for (;;) {
        const bool has_next = S.next(ui + 1, nxt);
        const char* nA = has_next ? (const char*)g.A + 2 * g.offA(nxt) : cA; const char* nB = has_next ? (const char*)g.Bt + 2 * g.offB(nxt) : cB;
        for (int t = 0; t < nt; t += 2) {
            const bool last = (t == nt - 2);
            const char* a1 = cA + (size_t)(t + 1) * kstep;
            const char* a2 = last ? nA : cA + (size_t)(t + 2) * kstep; const char* b2 = last ? nB : cB + (size_t)(t + 2) * kstep;
            const char* a3 = a2 + kstep; const char* b3 = b2 + kstep;
            PG8_LDB(B0, 0, 0); PG8_LDB(B1, 0, 1); PG8_SCHED; PG8_LDA(At, 0, 0); PG8_STAGE(PG8_SA(1, 1), a1 + hstepA, voffA);
            PG8_WAIT_V(8); PG8_WAIT_L(0); PG8_BAR; PG8_MMA(0, 0, At, B0); PG8_MMA(0, 1, At, B1); PG8_BAR; PG8_SCHED;
            PG8_LDA(At, 0, 1); PG8_STAGE(PG8_SB(0, 0), b2, voffB); PG8_STAGE(PG8_SB(0, 1), b2 + hstepB, voffB); PG8_STAGE(PG8_SA(0, 0), a2, voffA);
            PG8_WAIT_V(8); PG8_WAIT_L(0); PG8_BAR; PG8_MMA(1, 0, At, B0); PG8_MMA(1, 1, At, B1); PG8_BAR; PG8_SCHED;
            PG8_LDB(B0, 1, 0); PG8_LDB(B1, 1, 1); PG8_SCHED; PG8_LDA(At, 1, 0); PG8_STAGE(PG8_SA(0, 1), a2 + hstepA, voffA);
            PG8_WAIT_V(8); PG8_WAIT_L(0); PG8_BAR; PG8_MMA(0, 0, At, B0); PG8_MMA(0, 1, At, B1); PG8_BAR; PG8_SCHED;
            PG8_LDA(At, 1, 1); PG8_STAGE(PG8_SB(1, 0), b3, voffB); PG8_STAGE(PG8_SB(1, 1), b3 + hstepB, voffB); PG8_STAGE(PG8_SA(1, 0), a3, voffA);
            PG8_WAIT_V(8); PG8_WAIT_L(0); PG8_BAR; PG8_MMA(1, 0, At, B0); PG8_MMA(1, 1, At, B1); PG8_BAR; PG8_SCHED;
        }
        if constexpr (ALIGN_EPI) { if (wr == 0) PG8_BAR; }
        E(acc, cur, g.offC(cur), wr, wc, fr, fq, xl);
        if (!has_next) break;
#pragma unroll
        for (int a = 0; a < 2; ++a)
#pragma unroll
            for (int b = 0; b < 2; ++b)
#pragma unroll
                for (int m = 0; m < 4; ++m)
#pragma unroll
                    for (int n = 0; n < 2; ++n) acc[a][b][m][n] = (f32x4){0.f, 0.f, 0.f, 0.f};
        cur = nxt; cA = nA; cB = nB; ++ui;
        if constexpr (ALIGN_EPI) { if (wr == 1) PG8_BAR; }
    }
    PG8_WAIT_V(0);
    if constexpr (!ALIGN_EPI) { if (wr == 0) PG8_BAR; }
    PG8_BAR;
#undef PG8_SA
#undef PG8_SB
#undef PG8_STAGE
#undef PG8_LDA
#undef PG8_LDB
#undef PG8_MMA
#undef PG8_WAIT_V
#undef PG8_WAIT_L
#undef PG8_BAR
#undef PG8_SCHED
}
}

__device__ __forceinline__ f32x4 mfma16(bf16x8 bfrag, bf16x8 afrag, f32x4 acc) { return __builtin_amdgcn_mfma_f32_16x16x32_bf16(bfrag, afrag, acc, 0, 0, 0); }
__device__ __forceinline__ bf16x8 ldsfrag(const LAS bf16_t* base, int ld, int r0, int k0, int fr, int fq) { return *(const LAS bf16x8*)(base + (r0 + fr) * ld + k0 + fq * 8); }

template <int MODE> __device__ __forceinline__ void transpose_item(const float* W, int K, int N, bf16_t* WT, LAS float* scr, int item, int nblk, int lane, const float* gain = nullptr) {
    const int kb = item / nblk, nb = item % nblk, k0 = 64 * kb, n0 = 32 * nb; const int nsrc = n0 + (lane & 31);
#pragma unroll 8
    for (int i = 0; i < 32; ++i) { const int kk = 2 * i + (lane >> 5); scr[kk * 33 + (lane & 31)] = (nsrc < N) ? W[(size_t)(k0 + kk) * N + nsrc] * (gain ? gain[k0 + kk] : 1.f) : 0.f; }
    LDS_WAIT();
    const int c = lane & 7;
#pragma unroll
    for (int j = 0; j < 4; ++j) { const int n = (lane >> 3) + 8 * j; const LAS float* s = scr + (8 * c) * 33 + n;
        u32x4 o; o.x = pk2(s[0 * 33], s[1 * 33]); o.y = pk2(s[2 * 33], s[3 * 33]); o.z = pk2(s[4 * 33], s[5 * 33]); o.w = pk2(s[6 * 33], s[7 * 33]);
        int drow = n0 + n; if (MODE == 1) { const int jn = drow % FFN, isu = drow / FFN; drow = (jn / 128) * 256 + isu * 128 + (jn % 128); }
        *(u32x4*)(WT + (size_t)drow * K + k0 + 8 * c) = o; }
    LDS_WAIT();
}
__device__ __forceinline__ void rms_row_bf16(const float* xrow, const float* gain, bf16_t* orow, int lane) {
    const f32x4* xr = (const f32x4*)xrow + lane; f32x4 v[4]; float s = 0.f;
#pragma unroll
    for (int j = 0; j < 4; ++j) { v[j] = xr[64 * j]; s += (v[j].x * v[j].x + v[j].y * v[j].y) + (v[j].z * v[j].z + v[j].w * v[j].w); }
    const float rs = rsqrtf(wave_sum(s) * (1.f / D) + 1e-6f);
    const f32x4* gr = (const f32x4*)gain + lane; u32x2* o8 = (u32x2*)orow + lane;
#pragma unroll
    for (int j = 0; j < 4; ++j) { const f32x4 g = gr[64 * j]; u32x2 w; w.x = pk2(v[j].x * rs * g.x, v[j].y * rs * g.y); w.y = pk2(v[j].z * rs * g.z, v[j].w * rs * g.w); o8[64 * j] = w; }
}
__device__ __forceinline__ void rms_rows_phase(const float* X, const float* gain, bf16_t* H, int nrows, int gw, int NGW, int lane) {
    for (int m = gw; m < nrows; m += NGW) rms_row_bf16(X + (size_t)m * D, gain, H + (size_t)m * D, lane);
}

__device__ __forceinline__ void rwkv_chain(LAS unsigned char* lds, int cid, const bf16_t* P0, const float* mu, const float* w0, const float* w2, const float* a0, const float* a2,
                                           const float* k_k, const float* k_a, const float* r_k, bf16_t* ORW, bf16_t* SG, float* BONUS) {
    const int tid = threadIdx.x, lane = tid & 63, wid = tid >> 6, fr = lane & 15, fq = lane >> 4;
    const int b = cid >> 4, h = (cid >> 1) & 7, dir = cid & 1;
    LAS float* rS = (LAS float*)(lds); LAS float* kS = (LAS float*)(lds + 8192); LAS float* vS = (LAS float*)(lds + 16384); LAS float* wS = (LAS float*)(lds + 24576);
    LAS float* nkS = (LAS float*)(lds + 32768); LAS float* bS = (LAS float*)(lds + 40960); LAS float* preA = (LAS float*)(lds + 49152); LAS float* preW = (LAS float*)(lds + 57344);
    LAS bf16_t* adB = (LAS bf16_t*)(lds + 65536); LAS bf16_t* wdB = (LAS bf16_t*)(lds + 70144);
    LAS bf16_t* a2B = (LAS bf16_t*)(lds + 74752); LAS bf16_t* w2B = (LAS bf16_t*)(lds + 83968); LAS float* cst = (LAS float*)(lds + 93184);
    LAS bf16_t* At = (LAS bf16_t*)(lds + 97280); LAS bf16_t* Bt = (LAS bf16_t*)(lds + 101888); LAS bf16_t* Kt = (LAS bf16_t*)(lds + 106496); LAS bf16_t* Rt = (LAS bf16_t*)(lds + 111104);
    LAS bf16_t* BtT = (LAS bf16_t*)(lds + 115712); LAS bf16_t* KtT = (LAS bf16_t*)(lds + 120832); LAS bf16_t* VT = (LAS bf16_t*)(lds + 125952); LAS bf16_t* S0b = (LAS bf16_t*)(lds + 131072);
    LAS float* NT4 = (LAS float*)(lds + 140288); LAS bf16_t* NakT = (LAS bf16_t*)(lds + 146432); LAS bf16_t* MbrT = (LAS bf16_t*)(lds + 148992); LAS bf16_t* MkrT = (LAS bf16_t*)(lds + 151552);
    LAS float* gL = (LAS float*)(lds + 154112);
    LAS float* WS = preA;
    LAS bf16_t* Ub = (LAS bf16_t*)preW;
#define RW_IDS int tid_o = threadIdx.x; asm volatile("" : "+v"(tid_o)); const int tid = tid_o, lane = tid & 63, wid = __builtin_amdgcn_readfirstlane(tid >> 6), fr = lane & 15, fq = lane >> 4, vt = wid >> 1, tt2 = wid & 1; (void)lane; (void)wid; (void)fr; (void)fq; (void)vt; (void)tt2;
    __syncthreads();
    for (int e = tid; e < 64 * 64; e += 512) { const int j = e & 63, r = e >> 6;
        a2B[j * 72 + r] = (bf16_t)f2bf(a2[r * 512 + h * 64 + j]); w2B[j * 72 + r] = (bf16_t)f2bf(w2[(dir * 64 + r) * 512 + h * 64 + j]); }
    for (int e = tid; e < 64 * 72 / 2; e += 512) ((LAS unsigned*)S0b)[e] = 0u;
    if (tid < 64) { const int j = tid, c = h * 64 + j;
        cst[0 * 64 + j] = a0[c]; cst[1 * 64 + j] = w0[dir * 512 + c]; cst[2 * 64 + j] = k_k[c]; cst[3 * 64 + j] = k_a[c]; cst[4 * 64 + j] = r_k[c];
        cst[5 * 64 + j] = mu[c]; cst[6 * 64 + j] = mu[512 + c]; cst[7 * 64 + j] = mu[1024 + c]; cst[8 * 64 + j] = mu[1536 + j]; cst[9 * 64 + j] = mu[1600 + j];
        cst[10 * 64 + j] = (j < 16) ? mu[1664 + h * 16 + j] : 0.f; }
    const int vt = wid >> 1, tt2 = wid & 1;
    f32x4 st[2]; st[0] = (f32x4){0.f, 0.f, 0.f, 0.f}; st[1] = st[0];
    __syncthreads();
    const bf16_t* Pb = P0 + (size_t)b * SEQ * ABPAD;
    unsigned rc[10], rpv[10], rnx[10]; unsigned short gcv = 0, gpv = 0, gnv = 0;
#define RW_IDX(i) const int grp = (i) >> 1; const int idx_ = tid + 512 * ((i) & 1); const int tok = idx_ >> 5, c2 = (idx_ & 31) * 2; \
                  const int gcol = (grp == 0 ? h * 64 : grp == 1 ? 512 + h * 64 : grp == 2 ? 1024 + h * 64 : grp == 3 ? 1536 : 1600) + c2;
    const unsigned voff = (unsigned)((((int)threadIdx.x >> 5) * ABPAD + ((int)threadIdx.x & 31) * 2) * 2);
#define RW_CG(g) ((g) == 0 ? h * 128 : (g) == 1 ? 1024 + h * 128 : (g) == 2 ? 2048 + h * 128 : (g) == 3 ? 3072 : 3200)
#define RW_ISSUE(t0n) do { const char* bp_ = (const char*)(Pb + (size_t)(t0n) * ABPAD); const bool first_ = ((t0n) == 0) && (tid < 32), last_ = ((t0n) == SEQ - 32) && (tid >= 480); \
        _Pragma("unroll") for (int i = 0; i < 10; ++i) { const char* p = bp_ + (RW_CG(i >> 1) + (i & 1) * 16 * ABPAD * 2) + voff; \
            rc[i] = *(const unsigned*)p; \
            if ((i & 1) == 0) { const unsigned v_ = *(const unsigned*)(p - (first_ ? 0 : ABPAD * 2)); rpv[i] = first_ ? 0u : v_; rnx[i] = *(const unsigned*)(p + ABPAD * 2); } \
            else { const unsigned v_ = *(const unsigned*)(p + (last_ ? 0 : ABPAD * 2)); rnx[i] = last_ ? 0u : v_; rpv[i] = *(const unsigned*)(p - ABPAD * 2); } } \
        if (dir == 0) { const bool fg_ = ((t0n) == 0) && (tid < 16), lg_ = ((t0n) == SEQ - 32) && (tid >= 496); \
            const bf16_t* p = (const bf16_t*)bp_ + (size_t)(tid >> 4) * ABPAD + 1664 + h * 16 + (tid & 15); \
            gcv = *p; { const unsigned short v_ = *(p - (fg_ ? 0 : ABPAD)); gpv = fg_ ? (unsigned short)0 : v_; } { const unsigned short v_ = *(p + (lg_ ? 0 : ABPAD)); gnv = lg_ ? (unsigned short)0 : v_; } } } while (0)
    RW_ISSUE(dir ? 127 * 32 : 0);
    for (int cc = 0; cc < 128; ++cc) {
        const int t0 = dir ? (127 - cc) * 32 : cc * 32;
        { RW_IDS
#pragma unroll
        for (int i = 0; i < 10; ++i) { RW_IDX(i) (void)gcol;
            const unsigned cur = rc[i], prv = rpv[i], nxt = rnx[i];
            const float m0 = cst[(5 + grp) * 64 + c2], m1 = cst[(5 + grp) * 64 + c2 + 1];
            const float c0 = bflo(cur), c1 = bfhi(cur);
            const float x0 = c0 + m0 * (0.5f * (bflo(prv) + bflo(nxt)) - c0), x1 = c1 + m1 * (0.5f * (bfhi(prv) + bfhi(nxt)) - c1);
            if (grp == 0) { *(LAS f32x2*)(rS + tok * 64 + c2) = (f32x2){x0, x1}; }
            else if (grp == 1) { *(LAS f32x2*)(kS + tok * 64 + c2) = (f32x2){x0, x1}; }
            else if (grp == 2) { *(LAS f32x2*)(vS + tok * 64 + c2) = (f32x2){x0, x1}; }
            else if (grp == 3) { const float e0 = __expf(2.f * x0), e1 = __expf(2.f * x1); *(LAS unsigned*)(wdB + tok * 72 + c2) = pk2(1.f - 2.f * frcp(e0 + 1.f), 1.f - 2.f * frcp(e1 + 1.f)); }
            else { *(LAS unsigned*)(adB + tok * 72 + c2) = pk2(x0, x1); }
        }
        if (dir == 0) {
            const int tok = tid >> 4, c = tid & 15, t = t0 + tok;
            const float cur = bf2f(gcv), prv = bf2f(gpv), nxt = bf2f(gnv);
            const float x = cur + cst[10 * 64 + c] * (0.5f * (prv + nxt) - cur);
            SG[((size_t)b * SEQ + t) * 128 + h * 16 + c] = (bf16_t)f2bf(sigmoidf_(x));
        } }
        __syncthreads();
        if (cc + 1 < 128) { RW_IDS const int t0n = dir ? (126 - cc) * 32 : (cc + 1) * 32; RW_ISSUE(t0n); }
        { RW_IDS const int mat = wid >> 2, ntile = wid & 3; const LAS bf16_t* Aop = mat ? wdB : adB; const LAS bf16_t* Bop = mat ? w2B : a2B; LAS float* pre = mat ? preW : preA;
#pragma unroll
          for (int mt = 0; mt < 2; ++mt) { f32x4 acc = (f32x4){0.f, 0.f, 0.f, 0.f};
#pragma unroll
              for (int ks = 0; ks < 2; ++ks) acc = mfma16(ldsfrag(Bop, 72, ntile * 16, ks * 32, fr, fq), ldsfrag(Aop, 72, mt * 16, ks * 32, fr, fq), acc);
              *(LAS f32x4*)(pre + (mt * 16 + fr) * 64 + ntile * 16 + fq * 4) = acc; } }
        __syncthreads();
        { RW_IDS const int tok = tid >> 4, c0 = (tid & 15) * 4; float kkr[4], av[4], kp[4], wv[4]; float ss = 0.f, bon = 0.f;
#pragma unroll
          for (int i = 0; i < 4; ++i) { const int c = c0 + i, ix = tok * 64 + c;
              const float a = sigmoidf_(cst[c] + preA[ix]); const float sg = sigmoidf_(cst[64 + c] + preW[ix]);
              wv[i] = -0.60653065971f * sg;
              const float kraw = kS[ix]; kkr[i] = kraw * cst[128 + c]; ss += kkr[i] * kkr[i];
              kp[i] = kraw * (1.0f + (a - 1.0f) * cst[192 + c]); av[i] = a; bon += rS[ix] * kp[i] * cst[256 + c]; }
          ss += dppf<0xB1>(ss); bon += dppf<0xB1>(bon); ss += dppf<0x4E>(ss); bon += dppf<0x4E>(bon);
          ss += dppf<0x141>(ss); bon += dppf<0x141>(bon); ss += dppf<0x140>(ss); bon += dppf<0x140>(bon);
          const float inv = frcp(fmaxf(__builtin_amdgcn_sqrtf(ss), 1e-12f));
          f32x4 o_nk, o_b, o_k, o_w;
#pragma unroll
          for (int i = 0; i < 4; ++i) { const float kk = kkr[i] * inv; o_nk[i] = -kk; o_b[i] = kk * av[i]; o_k[i] = kp[i]; o_w[i] = wv[i]; }
          *(LAS f32x4*)(nkS + tok * 64 + c0) = o_nk; *(LAS f32x4*)(bS + tok * 64 + c0) = o_b; *(LAS f32x4*)(kS + tok * 64 + c0) = o_k; *(LAS f32x4*)(wS + tok * 64 + c0) = o_w;
          if (dir == 0 && (tid & 15) == 0) BONUS[((size_t)b * SEQ + t0 + tok) * 8 + h] = bon; }
        __syncthreads();
        { RW_IDS if (tid < 64) { float lw[32];
#pragma unroll
            for (int s = 0; s < 32; ++s) lw[s] = wS[(dir ? 31 - s : s) * 64 + tid];
#pragma unroll
            for (int s = 1; s < 32; ++s) lw[s] += lw[s - 1];
#pragma unroll
            for (int s = 0; s < 32; ++s) wS[(dir ? 31 - s : s) * 64 + tid] = lw[s]; } }
        __syncthreads();
        { RW_IDS const int s = tid >> 4, c0 = (tid & 15) * 4; const int tok = dir ? 31 - s : s, tokp = dir ? tok + 1 : tok - 1;
          const f32x4 cum = *(const LAS f32x4*)(wS + tok * 64 + c0); f32x4 cump = (f32x4){0.f, 0.f, 0.f, 0.f}; if (s > 0) cump = *(const LAS f32x4*)(wS + tokp * 64 + c0);
          const f32x4 nk4 = *(const LAS f32x4*)(nkS + tok * 64 + c0), b4 = *(const LAS f32x4*)(bS + tok * 64 + c0), k4 = *(const LAS f32x4*)(kS + tok * 64 + c0), r4 = *(const LAS f32x4*)(rS + tok * 64 + c0), v4 = *(const LAS f32x4*)(vS + tok * 64 + c0);
          float ta[4], tb[4], tk[4], tr[4];
#pragma unroll
          for (int i = 0; i < 4; ++i) { const float g = __expf(cum[i]), gp = __expf(cump[i]), ig = __expf(-cum[i]);
              ta[i] = nk4[i] * gp; tb[i] = b4[i] * ig; tk[i] = k4[i] * ig; tr[i] = r4[i] * g;
              BtT[(c0 + i) * 40 + s] = (bf16_t)f2bf(tb[i]); KtT[(c0 + i) * 40 + s] = (bf16_t)f2bf(tk[i]); VT[(c0 + i) * 40 + s] = (bf16_t)f2bf(v4[i]);
              if (s == 31) gL[c0 + i] = g; }
          u32x2 w; w.x = pk2(ta[0], ta[1]); w.y = pk2(ta[2], ta[3]); *(LAS u32x2*)(At + s * 72 + c0) = w;
          w.x = pk2(tb[0], tb[1]); w.y = pk2(tb[2], tb[3]); *(LAS u32x2*)(Bt + s * 72 + c0) = w;
          w.x = pk2(tk[0], tk[1]); w.y = pk2(tk[2], tk[3]); *(LAS u32x2*)(Kt + s * 72 + c0) = w;
          w.x = pk2(tr[0], tr[1]); w.y = pk2(tr[2], tr[3]); *(LAS u32x2*)(Rt + s * 72 + c0) = w; }
        __syncthreads();
        { RW_IDS const int mat = wid >> 1, mt = wid & 1; const LAS bf16_t* Aop = (mat < 2) ? At : Rt; const LAS bf16_t* Bop = (mat & 1) ? Kt : Bt;
#pragma unroll
          for (int nt = 0; nt < 2; ++nt) { f32x4 acc = (f32x4){0.f, 0.f, 0.f, 0.f};
#pragma unroll
              for (int ks = 0; ks < 2; ++ks) acc = mfma16(ldsfrag(Bop, 72, nt * 16, ks * 32, fr, fq), ldsfrag(Aop, 72, mt * 16, ks * 32, fr, fq), acc);
              const int srow = mt * 16 + fr;
#pragma unroll
              for (int e = 0; e < 4; ++e) { const int i = nt * 16 + fq * 4 + e; const bool keep = (mat < 2) ? (i < srow) : (i <= srow); if (!keep) acc[e] = 0.f; }
              if (mat == 0) {
#pragma unroll
                  for (int e = 0; e < 4; ++e) NT4[e * 384 + srow * 12 + nt * 4 + fq] = acc[e]; }
              else { LAS bf16_t* X = (mat == 1) ? NakT : (mat == 2) ? MbrT : MkrT; u32x2 o; o.x = pk2(acc[0], acc[1]); o.y = pk2(acc[2], acc[3]); *(LAS u32x2*)(X + srow * 40 + nt * 16 + fq * 4) = o; } } }
        __syncthreads();
        f32x4 oacc = (f32x4){0.f, 0.f, 0.f, 0.f};
        { RW_IDS f32x4 wacc = (f32x4){0.f, 0.f, 0.f, 0.f};
#pragma unroll
          for (int ks = 0; ks < 2; ++ks) { const bf16x8 sf = ldsfrag(S0b, 72, vt * 16, ks * 32, fr, fq);
              wacc = mfma16(ldsfrag(At, 72, tt2 * 16, ks * 32, fr, fq), sf, wacc); oacc = mfma16(ldsfrag(Rt, 72, tt2 * 16, ks * 32, fr, fq), sf, oacc); }
          const bf16x8 vf = ldsfrag(VT, 40, vt * 16, 0, fr, fq);
          wacc = mfma16(ldsfrag(NakT, 40, tt2 * 16, 0, fr, fq), vf, wacc); oacc = mfma16(ldsfrag(MkrT, 40, tt2 * 16, 0, fr, fq), vf, oacc);
#pragma unroll
          for (int n2 = 0; n2 < 2; ++n2) st[n2] = mfma16(ldsfrag(KtT, 40, (tt2 * 2 + n2) * 16, 0, fr, fq), vf, st[n2]);
#pragma unroll
          for (int e = 0; e < 4; ++e) WS[(tt2 * 16 + fq * 4 + e) * 64 + vt * 16 + fr] = wacc[e]; }
        __syncthreads();
        { RW_IDS if (wid < 4) { const int v = wid * 16 + (lane >> 2), p = lane & 3; const LAS float* NTp = NT4 + p * 384; float u[8];
#pragma unroll
            for (int j = 0; j < 8; ++j) u[j] = 0.f;
#pragma unroll
            for (int t = 0; t < 32; ++t) { float q0 = (p == 0) ? WS[t * 64 + v] : 0.f, q1 = 0.f;
#pragma unroll
                for (int j4 = 0; j4 < ((t + 3) / 4 + 3) / 4; ++j4) { const f32x4 nv = *(const LAS f32x4*)(NTp + t * 12 + j4 * 4);
                    q0 += u[j4 * 4] * nv[0]; q1 += u[j4 * 4 + 1] * nv[1]; q0 += u[j4 * 4 + 2] * nv[2]; q1 += u[j4 * 4 + 3] * nv[3]; }
                float q = q0 + q1; q += dppf<0xB1>(q); q += dppf<0x4E>(q);
                u[t >> 2] = ((t & 3) == p) ? q : u[t >> 2]; asm volatile("" ::: "memory"); }
#pragma unroll
            for (int j = 0; j < 8; ++j) Ub[v * 40 + 4 * j + p] = (bf16_t)f2bf(u[j]); } }
        __syncthreads();
        { RW_IDS const bf16x8 uf = ldsfrag(Ub, 40, vt * 16, 0, fr, fq);
          oacc = mfma16(ldsfrag(MbrT, 40, tt2 * 16, 0, fr, fq), uf, oacc);
#pragma unroll
          for (int e = 0; e < 4; ++e) { const int sidx = tt2 * 16 + fq * 4 + e, tok = dir ? 31 - sidx : sidx;
              ORW[(size_t)dir * T * 512 + ((size_t)b * SEQ + t0 + tok) * 512 + h * 64 + vt * 16 + fr] = (bf16_t)f2bf(oacc[e]); }
#pragma unroll
          for (int n2 = 0; n2 < 2; ++n2) { const int kt = tt2 * 2 + n2; st[n2] = mfma16(ldsfrag(BtT, 40, kt * 16, 0, fr, fq), uf, st[n2]);
              const f32x4 gl = *(const LAS f32x4*)(gL + kt * 16 + fq * 4); st[n2] = st[n2] * gl;
              u32x2 o; o.x = pk2(st[n2][0], st[n2][1]); o.y = pk2(st[n2][2], st[n2][3]); *(LAS u32x2*)(S0b + (vt * 16 + fr) * 72 + kt * 16 + fq * 4) = o; } }
    }
#undef RW_IDX
#undef RW_ISSUE
#undef RW_IDS
#undef RW_CG
    __syncthreads();
}

__device__ __forceinline__ void rwkv_combine(const bf16_t* P0, const bf16_t* ORW, const float* BONUS, const bf16_t* G, const float* mu, const float* gn_w, const float* gn_b, bf16_t* OMIX, int gw, int NGW, int lane) {
    const int c0 = lane * 8, head = lane >> 3;
    float muv[8], gw8[8], gb8[8];
#pragma unroll
    for (int i = 0; i < 8; ++i) { muv[i] = mu[1024 + c0 + i]; gw8[i] = gn_w[c0 + i]; gb8[i] = gn_b[c0 + i]; }
    for (int tk = gw; tk < T; tk += NGW) {
        const int t = tk & (SEQ - 1);
        const u32x4 uf = *(const u32x4*)(ORW + (size_t)tk * 512 + c0), ub = *(const u32x4*)(ORW + (size_t)T * 512 + (size_t)tk * 512 + c0);
        float o[8];
#pragma unroll
        for (int i = 0; i < 4; ++i) { o[2 * i] = bflo(uf[i]) + bflo(ub[i]); o[2 * i + 1] = bfhi(uf[i]) + bfhi(ub[i]); }
        float s = 0.f;
#pragma unroll
        for (int i = 0; i < 8; ++i) s += o[i];
        const float mean = sum8(s) * (1.f / 64.f); float q = 0.f;
#pragma unroll
        for (int i = 0; i < 8; ++i) { o[i] -= mean; q += o[i] * o[i]; }
        const float rstd = rsqrtf(sum8(q) * (1.f / 64.f) + 64e-5f);
        const bf16_t* pv = P0 + (size_t)tk * ABPAD + 1024 + c0;
        const u32x4 vc = *(const u32x4*)pv; u32x4 vp = (u32x4){0u, 0u, 0u, 0u}, vn = (u32x4){0u, 0u, 0u, 0u};
        if (t > 0) vp = *(const u32x4*)(pv - ABPAD);
        if (t < SEQ - 1) vn = *(const u32x4*)(pv + ABPAD);
        const u32x4 gg = *(const u32x4*)(G + (size_t)tk * 512 + c0);
        const float bon = BONUS[(size_t)tk * 8 + head];
        float r[8];
#pragma unroll
        for (int i = 0; i < 4; ++i) {
            const float c_lo = bflo(vc[i]), c_hi = bfhi(vc[i]);
            const float v_lo = c_lo + muv[2 * i] * (0.5f * (bflo(vp[i]) + bflo(vn[i])) - c_lo), v_hi = c_hi + muv[2 * i + 1] * (0.5f * (bfhi(vp[i]) + bfhi(vn[i])) - c_hi);
            r[2 * i] = (o[2 * i] * rstd * gw8[2 * i] + gb8[2 * i] + bon * v_lo) * bflo(gg[i]);
            r[2 * i + 1] = (o[2 * i + 1] * rstd * gw8[2 * i + 1] + gb8[2 * i + 1] + bon * v_hi) * bfhi(gg[i]); }
        u32x4 w; w.x = pk2(r[0], r[1]); w.y = pk2(r[2], r[3]); w.z = pk2(r[4], r[5]); w.w = pk2(r[6], r[7]);
        *(u32x4*)(OMIX + (size_t)tk * D + c0) = w;
    }
}

constexpr int SLD = 136;
__device__ __forceinline__ float softplusf_(float x) { return x > 20.f ? x : log1pf(__expf(x)); }
__device__ __forceinline__ void ssd_dt_cum(LAS float* dtS, LAS float* cumS, LAS float* totS, const bf16_t* Prow0, int g, int w, int lane, const float* dt_bias, const float* a_log) {
    const int j = w >> 1, d = w & 1, head = g * 4 + j;
    const float bias = dt_bias[d * 8 + head], A = -__expf(a_log[d * 8 + head]);
    const float x0 = bf2f(Prow0[(size_t)(2 * lane) * ABPAD + 3328 + head]), x1 = bf2f(Prow0[(size_t)(2 * lane + 1) * ABPAD + 3328 + head]);
    const float dt0 = softplusf_(x0 + bias), dt1 = softplusf_(x1 + bias), la0 = dt0 * A, la1 = dt1 * A;
    const float s = la0 + la1; float inc = s;
#pragma unroll
    for (int off = 1; off < 64; off <<= 1) { const float n = __shfl_up(inc, off); if (lane >= off) inc += n; }
    const float tot = __shfl(inc, 63), exc = inc - s;
    float c0, c1; if (d == 0) { c0 = exc + la0; c1 = inc; } else { c0 = tot - exc; c1 = tot - exc - la0; }
    dtS[w * 128 + 2 * lane] = dt0; dtS[w * 128 + 2 * lane + 1] = dt1; cumS[w * 128 + 2 * lane] = c0; cumS[w * 128 + 2 * lane + 1] = c1;
    if (lane == 0) totS[w] = tot;
}
template <int NR, bool TR> __device__ __forceinline__ void ssd_conv8(LAS bf16_t* dst, int col0, int cx0, int l0, const bf16_t* Pb, int t0, const float* cw, const float* cb) {
    u32x4 raw[NR + 2];
    const bf16_t* p = Pb + (size_t)(t0 + l0) * ABPAD + 2304 + cx0;
#pragma unroll
    for (int i = 0; i < NR + 2; ++i) { const int t = t0 + l0 + i - 1; raw[i] = (t >= 0 && t < SEQ) ? *(const u32x4*)(p + (long)(i - 1) * ABPAD) : (u32x4){0u, 0u, 0u, 0u}; }
    float w0[8], w1[8], w2[8], bs[8];
#pragma unroll
    for (int q = 0; q < 2; ++q) { const f32x4 a = *(const f32x4*)(cw + cx0 + 4 * q), bq = *(const f32x4*)(cw + 1024 + cx0 + 4 * q), c = *(const f32x4*)(cw + 2048 + cx0 + 4 * q), d = *(const f32x4*)(cb + cx0 + 4 * q);
#pragma unroll
        for (int i = 0; i < 4; ++i) { w0[4 * q + i] = a[i]; w1[4 * q + i] = bq[i]; w2[4 * q + i] = c[i]; bs[4 * q + i] = d[i]; } }
    float o[NR][8];
#pragma unroll
    for (int i = 0; i < NR; ++i)
#pragma unroll
        for (int c = 0; c < 8; ++c) { const unsigned um = raw[i][c >> 1], u0 = raw[i + 1][c >> 1], up = raw[i + 2][c >> 1];
            const float fm = (c & 1) ? bfhi(um) : bflo(um), f0 = (c & 1) ? bfhi(u0) : bflo(u0), fp = (c & 1) ? bfhi(up) : bflo(up);
            o[i][c] = siluf_(w0[c] * fm + w1[c] * f0 + w2[c] * fp + bs[c]); }
    if (TR) {
#pragma unroll
        for (int c = 0; c < 8; ++c) { LAS bf16_t* q = dst + (col0 + c) * SLD + l0;
            if (NR == 8) { u32x4 w; w.x = pk2(o[0][c], o[1][c]); w.y = pk2(o[2][c], o[3][c]); w.z = pk2(o[4 % NR][c], o[5 % NR][c]); w.w = pk2(o[6 % NR][c], o[7 % NR][c]); *(LAS u32x4*)q = w; }
            else { u32x2 w; w.x = pk2(o[0][c], o[1][c]); w.y = pk2(o[2][c], o[3][c]); *(LAS u32x2*)q = w; } }
    } else {
#pragma unroll
        for (int i = 0; i < NR; ++i) { u32x4 w; w.x = pk2(o[i][0], o[i][1]); w.y = pk2(o[i][2], o[i][3]); w.z = pk2(o[i][4], o[i][5]); w.w = pk2(o[i][6], o[i][7]); *(LAS u32x4*)(dst + (l0 + i) * SLD + col0) = w; }
    }
}
__device__ __forceinline__ void ssd_s1_unit(LAS unsigned char* lds, int unit, const bf16_t* P0, const float* cw, const float* cb, const float* dt_bias, const float* a_log, bf16_t* STATES, float* TOT) {
    const int tid = threadIdx.x, lane = tid & 63, w = tid >> 6, fr = lane & 15, fq = lane >> 4;
    const int g = unit & 1, c = (unit >> 1) & 31, b = unit >> 6, t0 = c * 128;
    LAS bf16_t* BT = (LAS bf16_t*)lds; LAS bf16_t* XT = (LAS bf16_t*)(lds + 34816); LAS float* dtS = (LAS float*)(lds + 104448); LAS float* cumS = (LAS float*)(lds + 108544);
    LAS float* scS = (LAS float*)(lds + 112640); LAS float* totS = (LAS float*)(lds + 116736);
    const bf16_t* Pb = P0 + (size_t)b * SEQ * ABPAD;
    __syncthreads();
    ssd_conv8<4, true>(BT, (tid & 15) * 8, 512 + g * 128 + (tid & 15) * 8, (tid >> 4) * 4, Pb, t0, cw, cb);
    ssd_conv8<8, true>(XT, (tid & 31) * 8, g * 256 + (tid & 31) * 8, (tid >> 5) * 8, Pb, t0, cw, cb);
    ssd_dt_cum(dtS, cumS, totS, Pb + (size_t)t0 * ABPAD, g, w, lane, dt_bias, a_log);
    __syncthreads();
    for (int e = tid; e < 1024; e += 512) scS[e] = dtS[e] * __expf(totS[e >> 7] - cumS[e]);
    if (tid < 8) TOT[((size_t)(b * 32 + c) * 2 + (tid & 1)) * 8 + g * 4 + (tid >> 1)] = totS[tid];
    __syncthreads();
    const int j = w >> 1;
#pragma unroll 1
    for (int d = 0; d < 2; ++d) {
        f32x4 acc[2][8];
#pragma unroll
        for (int mt = 0; mt < 2; ++mt)
#pragma unroll
            for (int nt = 0; nt < 8; ++nt) acc[mt][nt] = (f32x4){0.f, 0.f, 0.f, 0.f};
#pragma unroll 1
        for (int ks = 0; ks < 4; ++ks) {
            const int k0 = ks * 32; const LAS float* sp = scS + (j * 2 + d) * 128 + k0 + fq * 8;
            const f32x4 s0 = *(const LAS f32x4*)sp, s1 = *(const LAS f32x4*)(sp + 4);
            bf16x8 afr[2];
#pragma unroll
            for (int mt = 0; mt < 2; ++mt) { const u32x4 raw = *(const LAS u32x4*)(XT + (32 * w + mt * 16 + fr) * SLD + k0 + fq * 8); u32x4 o;
                o.x = pk2(bflo(raw.x) * s0[0], bfhi(raw.x) * s0[1]); o.y = pk2(bflo(raw.y) * s0[2], bfhi(raw.y) * s0[3]);
                o.z = pk2(bflo(raw.z) * s1[0], bfhi(raw.z) * s1[1]); o.w = pk2(bflo(raw.w) * s1[2], bfhi(raw.w) * s1[3]);
                afr[mt] = __builtin_bit_cast(bf16x8, o); }
#pragma unroll
            for (int nt = 0; nt < 8; ++nt) { const bf16x8 bfr = ldsfrag(BT, SLD, nt * 16, k0, fr, fq);
#pragma unroll
                for (int mt = 0; mt < 2; ++mt) acc[mt][nt] = mfma16(bfr, afr[mt], acc[mt][nt]); }
        }
        bf16_t* dst = STATES + (((size_t)(b * 32 + c) * 2 + d) * 8 + g * 4 + j) * 8192;
#pragma unroll
        for (int mt = 0; mt < 2; ++mt) { const int p = (w & 1) * 32 + mt * 16 + fr;
#pragma unroll
            for (int nt = 0; nt < 8; ++nt) { u32x2 o; o.x = pk2(acc[mt][nt][0], acc[mt][nt][1]); o.y = pk2(acc[mt][nt][2], acc[mt][nt][3]);
                *(u32x2*)(dst + p * 128 + nt * 16 + fq * 4) = o; } }
    }
}
__device__ __forceinline__ void ssd_s2(const bf16_t* __restrict__ STATES, bf16_t* __restrict__ CARR, const float* __restrict__ TOT, int gtid, int NGT) {
    for (int it = gtid; it < 16 * 2 * 8 * 1024; it += NGT) {
        const int e8 = it & 1023, head = (it >> 10) & 7, d = (it >> 13) & 1, b = it >> 14;
        float run[8];
#pragma unroll
        for (int i = 0; i < 8; ++i) run[i] = 0.f;
#pragma unroll 1
        for (int c8 = 0; c8 < 32; c8 += 8) {
            u32x4 loc[8]; float dec[8];
#pragma unroll
            for (int q = 0; q < 8; ++q) { const int cc = c8 + q, c = d ? 31 - cc : cc; const size_t sidx = ((size_t)(b * 32 + c) * 2 + d) * 8 + head;
                loc[q] = *(const u32x4*)(STATES + sidx * 8192 + e8 * 8); dec[q] = TOT[sidx]; }
#pragma unroll
            for (int q = 0; q < 8; ++q) { const int cc = c8 + q, c = d ? 31 - cc : cc; const size_t sidx = ((size_t)(b * 32 + c) * 2 + d) * 8 + head;
                u32x4 o; o.x = pk2(run[0], run[1]); o.y = pk2(run[2], run[3]); o.z = pk2(run[4], run[5]); o.w = pk2(run[6], run[7]); *(u32x4*)(CARR + sidx * 8192 + e8 * 8) = o;
                const float dq = __expf(dec[q]);
#pragma unroll
                for (int i = 0; i < 4; ++i) { run[2 * i] = run[2 * i] * dq + bflo(loc[q][i]); run[2 * i + 1] = run[2 * i + 1] * dq + bfhi(loc[q][i]); } }
        }
    }
}
__device__ __forceinline__ void ssd_s3_unit(LAS unsigned char* lds, int unit, const bf16_t* P0, const float* cw, const float* cb, const float* dt_bias, const float* a_log, const float* dskip, const float* norm_w,
                                            const bf16_t* STATES, bf16_t* OMIX) {
    const int tid = threadIdx.x, lane = tid & 63, w = tid >> 6, fr = lane & 15, fq = lane >> 4;
    const int g = unit & 1, c = (unit >> 1) & 31, b = unit >> 6, t0 = c * 128;
    LAS bf16_t* CS = (LAS bf16_t*)lds; LAS bf16_t* BS = (LAS bf16_t*)(lds + 34816); LAS bf16_t* XT = (LAS bf16_t*)(lds + 69632);
    LAS float* dtS = (LAS float*)(lds + 139264); LAS float* cumS = (LAS float*)(lds + 143360); LAS float* totS = (LAS float*)(lds + 147456);
    const bf16_t* Pb = P0 + (size_t)b * SEQ * ABPAD;
    __syncthreads();
    ssd_conv8<4, false>(BS, (tid & 15) * 8, 512 + g * 128 + (tid & 15) * 8, (tid >> 4) * 4, Pb, t0, cw, cb);
    ssd_conv8<4, false>(CS, (tid & 15) * 8, 768 + g * 128 + (tid & 15) * 8, (tid >> 4) * 4, Pb, t0, cw, cb);
    ssd_conv8<8, true>(XT, (tid & 31) * 8, g * 256 + (tid & 31) * 8, (tid >> 5) * 8, Pb, t0, cw, cb);
    ssd_dt_cum(dtS, cumS, totS, Pb + (size_t)t0 * ABPAD, g, w, lane, dt_bias, a_log);
    __syncthreads();
    const int l = 16 * w + fr;
    f32x4 sc[8];
#pragma unroll
    for (int nt = 0; nt < 8; ++nt) sc[nt] = (f32x4){0.f, 0.f, 0.f, 0.f};
#pragma unroll
    for (int ks = 0; ks < 4; ++ks) { const bf16x8 afr = ldsfrag(CS, SLD, 16 * w, ks * 32, fr, fq);
#pragma unroll
        for (int nt = 0; nt < 8; ++nt) sc[nt] = mfma16(ldsfrag(BS, SLD, nt * 16, ks * 32, fr, fq), afr, sc[nt]); }
    __syncthreads();
    LAS bf16_t* Mw = BS + w * 16 * SLD;
    const size_t row = (size_t)b * SEQ + t0 + l; float ss = 0.f;
#pragma unroll 1
    for (int j = 0; j < 4; ++j) {
        const LAS float* cf = cumS + (j * 2) * 128; const LAS float* cbw = cumS + (j * 2 + 1) * 128; const LAS float* df = dtS + (j * 2) * 128; const LAS float* db = dtS + (j * 2 + 1) * 128;
        const float cfl = cf[l], cbl = cbw[l];
        const size_t sbase = ((size_t)(b * 32 + c) * 2) * 8 + g * 4 + j;
        const bf16_t* carf = STATES + sbase * 8192; const bf16_t* carb = STATES + (sbase + 8) * 8192;
        bf16x8 cF[4][4], cB[4][4]; u32x2 zz4[4];
#pragma unroll
        for (int ks = 0; ks < 4; ++ks)
#pragma unroll
            for (int pt = 0; pt < 4; ++pt) cF[ks][pt] = *(const bf16x8*)(carf + (pt * 16 + fr) * 128 + ks * 32 + fq * 8);
#pragma unroll
        for (int pt = 0; pt < 4; ++pt) zz4[pt] = *(const u32x2*)(P0 + row * ABPAD + 1792 + g * 256 + j * 64 + pt * 16 + fq * 4);
#pragma unroll
        for (int nt = 0; nt < 8; ++nt) { float mv[4];
#pragma unroll
            for (int i = 0; i < 4; ++i) { const int s = nt * 16 + fq * 4 + i;
                const float ff = (s <= l) ? __expf(cfl - cf[s]) * df[s] : 0.f; const float fb = (s >= l) ? __expf(cbl - cbw[s]) * db[s] : 0.f;
                mv[i] = sc[nt][i] * (ff + fb); }
            u32x2 o; o.x = pk2(mv[0], mv[1]); o.y = pk2(mv[2], mv[3]); *(LAS u32x2*)(Mw + fr * SLD + nt * 16 + fq * 4) = o; }
        LDS_WAIT();
#pragma unroll
        for (int ks = 0; ks < 4; ++ks)
#pragma unroll
            for (int pt = 0; pt < 4; ++pt) cB[ks][pt] = *(const bf16x8*)(carb + (pt * 16 + fr) * 128 + ks * 32 + fq * 8);
        f32x4 yd[4], yf[4], yb[4];
#pragma unroll
        for (int pt = 0; pt < 4; ++pt) { yd[pt] = (f32x4){0.f, 0.f, 0.f, 0.f}; yf[pt] = yd[pt]; yb[pt] = yd[pt]; }
        bf16x8 acs[4];
#pragma unroll
        for (int ks = 0; ks < 4; ++ks) {
            const bf16x8 am = *(const LAS bf16x8*)(Mw + fr * SLD + ks * 32 + fq * 8); acs[ks] = ldsfrag(CS, SLD, 16 * w, ks * 32, fr, fq);
#pragma unroll
            for (int pt = 0; pt < 4; ++pt) {
                yd[pt] = mfma16(ldsfrag(XT, SLD, j * 64 + pt * 16, ks * 32, fr, fq), am, yd[pt]);
                yf[pt] = mfma16(cF[ks][pt], acs[ks], yf[pt]); }
        }
#pragma unroll
        for (int ks = 0; ks < 4; ++ks)
#pragma unroll
            for (int pt = 0; pt < 4; ++pt) yb[pt] = mfma16(cB[ks][pt], acs[ks], yb[pt]);
        const float ef = __expf(cfl), eb = __expf(cbl), dsk = dskip[g * 4 + j];
#pragma unroll
        for (int pt = 0; pt < 4; ++pt) { const f32x4 yv = yd[pt] + yf[pt] * ef + yb[pt] * eb;
            const int col = j * 64 + pt * 16 + fq * 4; const u32x2 zz = zz4[pt];
            const float z4[4] = {bflo(zz.x), bfhi(zz.x), bflo(zz.y), bfhi(zz.y)}; float v4[4];
#pragma unroll
            for (int i = 0; i < 4; ++i) { const float xs = bf2f(XT[(col + i) * SLD + l]); float v = yv[i] + dsk * xs; const float z = z4[i]; v = v * siluf_(z);
                v4[i] = v; ss += v * v; }
            u32x2 o; o.x = pk2(v4[0], v4[1]); o.y = pk2(v4[2], v4[3]); *(u32x2*)(OMIX + row * D + 512 + g * 256 + col) = o; }
        asm volatile("" ::: "memory");
    }
    ss += __shfl_xor(ss, 16); ss += __shfl_xor(ss, 32);
    const float rs = rsqrtf(ss * (1.f / 256.f) + 1e-6f);
    asm volatile("s_waitcnt vmcnt(0)" ::: "memory");
#pragma unroll 4
    for (int q = 0; q < 16; ++q) { const int col = g * 256 + q * 16 + fq * 4; const f32x4 nw = *(const f32x4*)(norm_w + col);
        u32x2* p = (u32x2*)(OMIX + row * D + 512 + col); const u32x2 v = *p;
        u32x2 o; o.x = pk2(bflo(v.x) * rs * nw[0], bfhi(v.x) * rs * nw[1]); o.y = pk2(bflo(v.y) * rs * nw[2], bfhi(v.y) * rs * nw[3]); *p = o; }
}

constexpr int HLD = 136, HLS = 72;
__device__ __forceinline__ void hgrn_chain(LAS unsigned char* lds, int cid, bf16_t* P1, const float* hg_lb, bf16_t* Ob, int ldo, int ocbase, int ocdir) {
    const int tid = threadIdx.x, lane = tid & 63, w = tid >> 6, fr = lane & 15, fq = lane >> 4;
    const int b = cid >> 4, h = (cid >> 1) & 7, dir = cid & 1;
    LAS bf16_t* QE = (LAS bf16_t*)lds;
    LAS bf16_t* KE = (LAS bf16_t*)(lds + 17408);
    LAS bf16_t* KLT = (LAS bf16_t*)(lds + 34816);
    LAS bf16_t* VT = (LAS bf16_t*)(lds + 53248);
    LAS bf16_t* AT = (LAS bf16_t*)(lds + 71680);
    LAS bf16_t* ST = (LAS bf16_t*)(lds + 80896);
    LAS float* totS = (LAS float*)(lds + 115712);
    LAS float* lastS = (LAS float*)(lds + 117760);
    __syncthreads();
    for (int e = tid; e < 128 * HLD / 2; e += 512) ((LAS unsigned*)ST)[e] = 0u;
    const int dcol = tid & 127, qtr = tid >> 7, i0 = qtr * 16;
    const float lbv = frcp(1.0f + __expf(hg_lb[h * 128 + dcol] - hg_lb[1024 + h * 128 + dcol]));
    f32x4 st[8];
#pragma unroll
    for (int i = 0; i < 8; ++i) st[i] = (f32x4){0.f, 0.f, 0.f, 0.f};
    bf16_t* Pb = P1 + (size_t)b * SEQ * HGP;
    __syncthreads();
    unsigned short rq[16], rf[16], rv[16];
#define HG_ISSUE(t0n) do { _Pragma("unroll") for (int i = 0; i < 16; ++i) { const int tk = (t0n) + (dir ? 63 - (i0 + i) : (i0 + i)); const bf16_t* pr = Pb + (size_t)tk * HGP + h * 128 + dcol; \
        rq[i] = pr[0]; rf[i] = pr[1024 * (1 + dir)]; rv[i] = pr[3072]; } } while (0)
    HG_ISSUE((dir ? 63 : 0) * 64);
    for (int cc = 0; cc < 64; ++cc) {
        const int t0 = (dir ? 63 - cc : cc) * 64;
        float gq[16], gk[16], gc[16]; float run = 0.f;
#pragma unroll
        for (int i = 0; i < 16; ++i) { const float q = bf2f(rq[i]), fr_ = bf2f(rf[i]);
            const float f = lbv + (1.0f - lbv) * sigmoidf_(fr_); run += __logf(f); gq[i] = q; gk[i] = 1.0f - f; gc[i] = run; }
        totS[qtr * 128 + dcol] = run;
#pragma unroll
        for (int i = 0; i < 16; i += 2) *(LAS unsigned*)(VT + dcol * HLS + i0 + i) = (unsigned)rv[i] | ((unsigned)rv[i + 1] << 16);
        __syncthreads();
        { float pre = 0.f, tot = 0.f;
#pragma unroll
          for (int q4 = 0; q4 < 4; ++q4) { const float tq = totS[q4 * 128 + dcol]; if (q4 < qtr) pre += tq; tot += tq; }
          const float etot = __expf(tot);
          if (qtr == 0) lastS[dcol] = etot;
#pragma unroll
          for (int i = 0; i < 16; i += 2) { const float b0 = pre + gc[i], b1 = pre + gc[i + 1];
              const float e0 = __expf(b0), e1 = __expf(b1), n0 = frcp(e0), n1 = frcp(e1), l0 = etot * n0, l1 = etot * n1;
              QE[(i0 + i) * HLD + dcol] = (bf16_t)f2bf(gq[i] * e0); QE[(i0 + i + 1) * HLD + dcol] = (bf16_t)f2bf(gq[i + 1] * e1);
              KE[(i0 + i) * HLD + dcol] = (bf16_t)f2bf(gk[i] * n0); KE[(i0 + i + 1) * HLD + dcol] = (bf16_t)f2bf(gk[i + 1] * n1);
              *(LAS unsigned*)(KLT + dcol * HLS + i0 + i) = pk2(gk[i] * l0, gk[i + 1] * l1); } }
        if (cc + 1 < 64) HG_ISSUE((dir ? 62 - cc : cc + 1) * 64);
        __syncthreads();
        { const int mt = w >> 1;
#pragma unroll
          for (int n2 = 0; n2 < 2; ++n2) { const int nt = (w & 1) * 2 + n2; f32x4 acc = (f32x4){0.f, 0.f, 0.f, 0.f};
#pragma unroll
              for (int ks = 0; ks < 4; ++ks) acc = mfma16(ldsfrag(KE, HLD, nt * 16, ks * 32, fr, fq), ldsfrag(QE, HLD, mt * 16, ks * 32, fr, fq), acc);
              const int lrow = mt * 16 + fr; float mv[4];
#pragma unroll
              for (int i = 0; i < 4; ++i) { const int s = nt * 16 + fq * 4 + i; mv[i] = (s <= lrow) ? acc[i] : 0.f; }
              u32x2 o; o.x = pk2(mv[0], mv[1]); o.y = pk2(mv[2], mv[3]); *(LAS u32x2*)(AT + lrow * HLS + nt * 16 + fq * 4) = o; } }
        __syncthreads();
        { const int mt = w >> 1;
#pragma unroll
          for (int n4 = 0; n4 < 4; ++n4) { const int nt = (w & 1) * 4 + n4; f32x4 acc = (f32x4){0.f, 0.f, 0.f, 0.f};
#pragma unroll
              for (int ks = 0; ks < 2; ++ks) acc = mfma16(ldsfrag(VT, HLS, nt * 16, ks * 32, fr, fq), ldsfrag(AT, HLS, mt * 16, ks * 32, fr, fq), acc);
#pragma unroll
              for (int ks = 0; ks < 4; ++ks) acc = mfma16(ldsfrag(ST, HLD, nt * 16, ks * 32, fr, fq), ldsfrag(QE, HLD, mt * 16, ks * 32, fr, fq), acc);
              const int i = mt * 16 + fr, tk = t0 + (dir ? 63 - i : i);
              u32x2 o; o.x = pk2(acc[0], acc[1]); o.y = pk2(acc[2], acc[3]);
              *(u32x2*)(Ob + ((size_t)b * SEQ + tk) * ldo + ocbase + ocdir * dir + h * 128 + nt * 16 + fq * 4) = o; } }
#pragma unroll
        for (int nt = 0; nt < 8; ++nt) { const f32x4 el = *(const LAS f32x4*)(lastS + nt * 16 + fq * 4); st[nt] = st[nt] * el;
#pragma unroll
            for (int ks = 0; ks < 2; ++ks) st[nt] = mfma16(ldsfrag(KLT, HLS, nt * 16, ks * 32, fr, fq), ldsfrag(VT, HLS, w * 16, ks * 32, fr, fq), st[nt]); }
        __syncthreads();
#pragma unroll
        for (int nt = 0; nt < 8; ++nt) { u32x2 o; o.x = pk2(st[nt][0], st[nt][1]); o.y = pk2(st[nt][2], st[nt][3]); *(LAS u32x2*)(ST + (w * 16 + fr) * HLD + nt * 16 + fq * 4) = o; }
    }
    __syncthreads();
}
__device__ __forceinline__ void hgrn_combine(const bf16_t* P1, const float* norm_w, bf16_t* OMIX, int gw, int NGW, int lane) {
    const int c0 = lane * 16;
    for (int tk = gw; tk < T; tk += NGW) {
        const bf16_t* pr = P1 + (size_t)tk * HGP + c0; float o[16]; float ss = 0.f;
#pragma unroll
        for (int hh = 0; hh < 2; ++hh) { const u32x4 uf = *(const u32x4*)(pr + 1024 + hh * 8), ub = *(const u32x4*)(pr + 2048 + hh * 8);
#pragma unroll
            for (int i = 0; i < 4; ++i) { o[hh * 8 + 2 * i] = bflo(uf[i]) + bflo(ub[i]); o[hh * 8 + 2 * i + 1] = bfhi(uf[i]) + bfhi(ub[i]); } }
#pragma unroll
        for (int i = 0; i < 16; ++i) ss += o[i] * o[i];
        const float rs = rsqrtf(sum8(ss) * (1.f / 128.f) + 1e-6f);
#pragma unroll
        for (int hh = 0; hh < 2; ++hh) { const u32x4 ug = *(const u32x4*)(pr + 4096 + hh * 8); float r[8];
#pragma unroll
            for (int i = 0; i < 4; ++i) { const float g0 = bflo(ug[i]), g1 = bfhi(ug[i]);
                r[2 * i] = o[hh * 8 + 2 * i] * rs * norm_w[c0 + hh * 8 + 2 * i] * siluf_(g0);
                r[2 * i + 1] = o[hh * 8 + 2 * i + 1] * rs * norm_w[c0 + hh * 8 + 2 * i + 1] * siluf_(g1); }
            u32x4 wv; wv.x = pk2(r[0], r[1]); wv.y = pk2(r[2], r[3]); wv.z = pk2(r[4], r[5]); wv.w = pk2(r[6], r[7]);
            *(u32x4*)(OMIX + (size_t)tk * D + c0 + hh * 8) = wv; }
    }
}

#define XB_TMO      128
#define XB_XCNT(j)  (256  + 64 * (j))
#define XB_XSUB(j)  (1280 + 64 * (j))
#define XB_XGEN(j)  (2304 + 64 * (j))
#define XB_TOP      3328
#define XB_TOPGEN   3392
#define XCD_BAR_WORDS 3456
#define XB_SPIN_CAP (1u << 18)

__device__ __forceinline__ unsigned xb_ld(unsigned* p)              { return __hip_atomic_load(p, __ATOMIC_RELAXED, __HIP_MEMORY_SCOPE_AGENT); }
__device__ __forceinline__ unsigned xb_add(unsigned* p, unsigned v) { return __hip_atomic_fetch_add(p, v, __ATOMIC_RELAXED, __HIP_MEMORY_SCOPE_AGENT); }
__device__ __forceinline__ unsigned xb_xcc_id() { return (unsigned)__builtin_amdgcn_s_getreg((3 << 11) | 20) & 0xFu; }
#define XB_SPIN(cond, bar) do { unsigned _sp = 0; while (cond) { __builtin_amdgcn_s_sleep(1); \
    if ((++_sp & 255u) == 0u) { if (xb_ld(&(bar)[XB_TMO])) break; if (_sp > XB_SPIN_CAP) { atomicAdd(&(bar)[XB_TMO], 1u); break; } } } } while (0)

struct XcdBarrier {
    unsigned* bar; unsigned x;
    volatile LAS unsigned* st;
};

__device__ __forceinline__ XcdBarrier xcd_barrier_post(unsigned* bar, volatile LAS unsigned* st) {
    XcdBarrier b; b.bar = bar; b.x = xb_xcc_id(); b.st = st;
    if (threadIdx.x == 0) (void)xb_add(&bar[XB_XCNT(b.x)], 1u);
    return b;
}
__device__ __forceinline__ void xcd_barrier_complete(unsigned* bar, unsigned x, unsigned& nloc, unsigned& nx) {
    const unsigned G = gridDim.x * gridDim.y * gridDim.z;
    unsigned sum, cnt, mine, sp = 0u;
    for (;;) {
        sum = 0u; cnt = 0u; mine = 0u;
#pragma unroll
        for (unsigned j = 0; j < 16; ++j) { const unsigned c = xb_ld(&bar[XB_XCNT(j)]); sum += c; cnt += (c > 0u) ? 1u : 0u; mine = (j == x) ? c : mine; }
        if (sum == G) break;
        __builtin_amdgcn_s_sleep(1);
        if ((++sp & 255u) == 0u) { if (xb_ld(&bar[XB_TMO])) break; if (sp > XB_SPIN_CAP) { atomicAdd(&bar[XB_TMO], 1u); break; } }
    }
    nloc = mine > 0u ? mine : 1u; nx = cnt > 0u ? cnt : 1u;
}

__device__ __forceinline__ void xcd_barrier(const XcdBarrier& b) {
    asm volatile("s_waitcnt vmcnt(0)" ::: "memory");
    __syncthreads();
    if (threadIdx.x == 0) {
        unsigned* bar = b.bar;
        __builtin_amdgcn_s_waitcnt(0);
        unsigned nloc = b.st[0], nx = b.st[1];
        if (nloc == 0u) { xcd_barrier_complete(bar, b.x, nloc, nx); b.st[0] = nloc; b.st[1] = nx; }
        const unsigned old = xb_add(&bar[XB_XSUB(b.x)], 1u);
        const unsigned gen = old / nloc;
        if (old + 1u == (gen + 1u) * nloc) {
            __builtin_amdgcn_fence(__ATOMIC_RELEASE, "agent");
            asm volatile("s_waitcnt vmcnt(0)" ::: "memory");
            const unsigned og = xb_add(&bar[XB_TOP], 1u);
            const unsigned tg = og / nx;
            if (og + 1u == (tg + 1u) * nx) xb_add(&bar[XB_TOPGEN], 1u);
            else XB_SPIN(xb_ld(&bar[XB_TOPGEN]) == tg, bar);
            __builtin_amdgcn_fence(__ATOMIC_ACQUIRE, "agent");
            xb_add(&bar[XB_XGEN(b.x)], 1u);
            asm volatile("s_waitcnt vmcnt(0)" ::: "memory");
        } else {
            XB_SPIN(xb_ld(&bar[XB_XGEN(b.x)]) == gen, bar);
            __builtin_amdgcn_fence(__ATOMIC_ACQUIRE, "agent");
            asm volatile("s_waitcnt vmcnt(0)" ::: "memory");
        }
    }
    __syncthreads();
}


struct Args { const float* in[35]; float* out; unsigned char* ws; int ph_lo, ph_hi; };
static_assert(sizeof(Args) == 304, "Args layout");

__global__ void __launch_bounds__(512, 2) mk_fwd(Args args) {
    extern __shared__ __attribute__((aligned(16))) unsigned char lds_raw[];
    LAS unsigned char* lds = (LAS unsigned char*)lds_raw; LAS unsigned char* xl = lds + XLDS_OFF;
    const int G = gridDim.x, bx = blockIdx.x, NGW = G * 8;
#define LOCAL_IDS int tid = threadIdx.x; asm volatile("" : "+v"(tid)); const int lane = tid & 63, wave = __builtin_amdgcn_readfirstlane(tid >> 6), gw = bx * 8 + wave; (void)lane; (void)gw;
    typedef const __attribute__((address_space(4))) unsigned char* kaptr_t;
    kaptr_t ka = (kaptr_t)__builtin_amdgcn_kernarg_segment_ptr();
#define INP(k) (*(const float* const volatile __attribute__((address_space(4)))*)(ka + 8 * (k)))
    unsigned char* ws = *(unsigned char* const volatile __attribute__((address_space(4)))*)(ka + 288); float* out = *(float* const volatile __attribute__((address_space(4)))*)(ka + 280);
    const float* x = INP(0);
    bf16_t* WAB = (bf16_t*)(ws + WS_WAB); bf16_t* WABO = (bf16_t*)(ws + WS_WABO); bf16_t* WHG = (bf16_t*)(ws + WS_WHG); bf16_t* WHGO = (bf16_t*)(ws + WS_WHGO);
    bf16_t* WQ = (bf16_t*)(ws + WS_WQ); bf16_t* WKV = (bf16_t*)(ws + WS_WKV); bf16_t* WO = (bf16_t*)(ws + WS_WO); bf16_t* WF1 = (bf16_t*)(ws + WS_WF1); bf16_t* WF2 = (bf16_t*)(ws + WS_WF2);
    bf16_t* G2T = (bf16_t*)(ws + WS_G2T); bf16_t* MEMN = (bf16_t*)(ws + WS_MEMN); bf16_t* KMEM = (bf16_t*)(ws + WS_KMEM); bf16_t* VT = (bf16_t*)(ws + WS_VT);
    bf16_t* H = (bf16_t*)(ws + WS_H); bf16_t* P = (bf16_t*)(ws + WS_P); bf16_t* PATT = (bf16_t*)(ws + WS_PATT); bf16_t* OMIX0 = (bf16_t*)(ws + WS_OMIX0); bf16_t* OMIX1 = (bf16_t*)(ws + WS_OMIX1); float* PSB = (float*)(ws + WS_PS);
#define COMMA ,
    bf16_t* STATES = (bf16_t*)((unsigned char*)out + DO_STATES); bf16_t* GG = (bf16_t*)((unsigned char*)out + DO_G); bf16_t* SG = (bf16_t*)((unsigned char*)out + DO_SG);
    float* BONUS = (float*)((unsigned char*)out + DO_BONUS); float* TOT = (float*)((unsigned char*)out + DO_TOT);
    cg::grid_group grid = cg::this_grid();
    { volatile LAS unsigned* st_ = (volatile LAS unsigned*)(lds + LDS_BYTES - 16); if (threadIdx.x < 4) st_[threadIdx.x] = 0u; }
    __syncthreads();
    const XcdBarrier xbar = xcd_barrier_post((unsigned*)ws, (volatile LAS unsigned*)(lds + LDS_BYTES - 16));
    const int lo = *(const int volatile __attribute__((address_space(4)))*)(ka + 296), hi = *(const int volatile __attribute__((address_space(4)))*)(ka + 300);
#ifndef PH_EN
#define PH_EN(k) 1
#endif
#define IN(k) (PH_EN(k) && lo <= (k) && (k) < hi)
#ifndef DUP_MASK
#define DUP_MASK 0ull
#endif
#define REPS(k) (1 + (int)(((unsigned long long)(DUP_MASK) >> (k)) & 1ull))
#define PHASE(k) for (int rep_ = 0; rep_ < (IN(k) ? REPS(k) : 0); ++rep_, ((REPS(k) > 1) ? (grid.sync(), 0) : 0))
#define SEAM(k) do { if (IN(k) && IN((k) + 1)) { if ((k) == 0) grid.sync(); else xcd_barrier(xbar); } } while (0)
#define RUN_GEMM(EPI, ALIGN, gd, ep) do { pg8::Order S_; S_.init(gd, G, bx); pg8::gemm_phase<EPI, ALIGN>(lds, xl, gd, S_, ep); } while (0)

    PHASE(0) { LOCAL_IDS
        LAS float* scr = (LAS float*)(lds + wave * 16384);
        constexpr int I_AB = 16 * 112, I_SQ = 16 * 32, I_HG = 16 * 160, I_KV = 16 * 64, I_F1 = 16 * 176, I_F2 = 44 * 32, I_G2 = 2 * 16;
        constexpr int NIT = I_AB + I_SQ + I_HG + I_SQ + 2 * I_SQ + 2 * I_KV + 2 * I_SQ + 2 * I_F1 + 2 * I_F2 + I_G2;
        for (int it = gw; it < NIT; it += NGW) {
            int r = it;
            if (r < I_AB) { transpose_item<0>(INP(3), 1024, ABP, WAB, scr, r, 112, lane); continue; } r -= I_AB;
            if (r < I_SQ) { transpose_item<0>(INP(4), 1024, 1024, WABO, scr, r, 32, lane); continue; } r -= I_SQ;
            if (r < I_HG) { transpose_item<0>(INP(22), 1024, HGP, WHG, scr, r, 160, lane, INP(2) + D); continue; } r -= I_HG;
            if (r < I_SQ) { transpose_item<0>(INP(23), 1024, 1024, WHGO, scr, r, 32, lane); continue; } r -= I_SQ;
            if (r < 2 * I_SQ) { const int l = r / I_SQ; transpose_item<0>(INP(28) + (size_t)l * D * D, 1024, 1024, WQ + (size_t)l * D * D, scr, r % I_SQ, 32, lane, INP(26) + l * D); continue; } r -= 2 * I_SQ;
            if (r < 2 * I_KV) { const int l = r / I_KV; transpose_item<0>(INP(29) + (size_t)l * D * 2048, 1024, 2048, WKV + (size_t)l * D * 2048, scr, r % I_KV, 64, lane); continue; } r -= 2 * I_KV;
            if (r < 2 * I_SQ) { const int l = r / I_SQ; transpose_item<0>(INP(30) + (size_t)l * D * D, 1024, 1024, WO + (size_t)l * D * D, scr, r % I_SQ, 32, lane); continue; } r -= 2 * I_SQ;
            if (r < 2 * I_F1) { const int l = r / I_F1; transpose_item<1>(INP(32) + (size_t)l * D * 2 * FFN, 1024, 2 * FFN, WF1 + (size_t)l * D * 2 * FFN, scr, r % I_F1, 176, lane, INP(31) + l * D); continue; } r -= 2 * I_F1;
            if (r < 2 * I_F2) { const int l = r / I_F2; transpose_item<0>(INP(33) + (size_t)l * FFN * D, FFN, 1024, WF2 + (size_t)l * FFN * D, scr, r % I_F2, 32, lane); continue; } r -= 2 * I_F2;
            transpose_item<0>(INP(10), 128, 512, G2T, scr, r, 16, lane);
        }
        rms_rows_phase(x, INP(2), H, T, gw, NGW, lane);
        for (int m = gw; m < 2 * 4096; m += NGW) { const int l = m >> 12, r = m & 4095; rms_row_bf16(INP(1) + (size_t)r * D, INP(27) + l * D, MEMN + (size_t)m * D, lane); }
        __syncthreads();
    }
    SEAM(0);
    PHASE(1) {
        { pg8::Gemm g = pg8::make_gemm(H, WAB, T, ABPAD, 1024, 1024, 1024); pg8::EpiBf16 E{P, ABPAD, 1.0f, nullptr}; RUN_GEMM(pg8::EpiBf16, true, g, E); }
        { pg8::Gemm g = pg8::make_gemm(MEMN, WKV, 4096, 1024, 1024, 1024, 1024); g.nZ = 2; g.sAo = 4096L * D; g.sBo = 2048L * D; g.sCo = 4096L * D; pg8::EpiBf16 E{KMEM, 1024, 1.0f, nullptr}; RUN_GEMM(pg8::EpiBf16, true, g, E); }
        { pg8::Gemm g = pg8::make_gemm(WKV + (size_t)1024 * D, MEMN, 1024, 4096, 1024, 1024, 1024); g.nZ = 2; g.sAo = 2048L * D; g.sBo = 4096L * D; g.sCo = 4096L * D; pg8::EpiBf16 E{VT, 4096, 1.0f, nullptr}; RUN_GEMM(pg8::EpiBf16, true, g, E); }
    }
    SEAM(1);
    PHASE(2) {
#ifndef DUP_RWKV
#define DUP_RWKV 0
#endif
#ifndef DUP_S1
#define DUP_S1 0
#endif
        for (int r2 = 0; r2 <= DUP_RWKV; ++r2)
        for (int cid = bx; cid < 256; cid += G)
            rwkv_chain(lds, cid, P, INP(5), INP(6), INP(7), INP(8), INP(9), INP(11), INP(12), INP(13), H, SG, BONUS);
        for (int r2 = 0; r2 <= DUP_S1; ++r2)
        for (int u = bx; u < 1024; u += G) ssd_s1_unit(lds, u, P, INP(16), INP(17), INP(18), INP(19), STATES, TOT);
        __syncthreads();
    }
    SEAM(2);
    PHASE(3) {
        { int k128 = 128; asm volatile("" : "+s"(k128)); pg8::Gemm g = pg8::make_gemm(SG, G2T, T, 512, k128, 128, 128); pg8::EpiBf16 E{GG, 512, 1.0f, nullptr}; RUN_GEMM(pg8::EpiBf16, true, g, E); }
        { LOCAL_IDS ssd_s2(STATES, OMIX1, TOT, bx * 512 + tid, G * 512); }
    }
    SEAM(3);
    PHASE(4) {
#ifndef DUP_S3
#define DUP_S3 0
#endif
        for (int r2 = 0; r2 <= DUP_S3; ++r2)
        for (int u = bx; u < 1024; u += G) ssd_s3_unit(lds, u, P, INP(16), INP(17), INP(18), INP(19), INP(20), INP(21), OMIX1, OMIX0);
        __syncthreads();
        { LOCAL_IDS rwkv_combine(P, H, BONUS, GG, INP(5), INP(14), INP(15), OMIX0, gw, NGW, lane); }
    }
    SEAM(4);
    PHASE(5) { pg8::Gemm g = pg8::make_gemm(OMIX0, WABO, T, 1024, 1024, 1024, 1024); pg8::EpiResidH E{x, out, H, PSB, 1024}; RUN_GEMM(pg8::EpiResidH, true, g, E); }
    SEAM(5);

#define ATTN_FFN(base, L, LASTEPI) \
    PHASE(base) { pg8::Gemm g = pg8::make_gemm(H, WQ + (size_t)(L) * D * D, T, 1024, 1024, 1024, 1024); pg8::EpiBf16 E{P, 1024, 0.0625f, PSB}; RUN_GEMM(pg8::EpiBf16, true, g, E); } \
    SEAM(base); \
    PHASE(base + 1) { pg8::Gemm g = pg8::make_gemm(P, KMEM + (size_t)(L) * 4096 * D, SEQ, 256, 256, 1024, 1024); g.nZ = 64; g.zdiv = 4; \
        g.sAo = (long)SEQ * D; g.sAi = 256; g.sBo = 256L * D; g.sBi = 256; g.sCo = (long)SEQ * D; g.sCi = 256; pg8::EpiSoftmax E{PATT, 1024}; RUN_GEMM(pg8::EpiSoftmax, true, g, E); } \
    SEAM(base + 1); \
    PHASE(base + 2) { pg8::Gemm g = pg8::make_gemm(PATT, VT + (size_t)(L) * 4096 * D, SEQ, 256, 256, 1024, 4096); g.nZ = 64; g.zdiv = 4; \
        g.sAo = (long)SEQ * D; g.sAi = 256; g.sBo = 256; g.sBi = 256L * 4096; g.sCo = (long)SEQ * D; g.sCi = 256; pg8::EpiBf16 E{P, 1024, 1.0f, nullptr}; RUN_GEMM(pg8::EpiBf16, true, g, E); } \
    SEAM(base + 2); \
    PHASE(base + 3) { pg8::Gemm g = pg8::make_gemm(P, WO + (size_t)(L) * D * D, T, 1024, 1024, 1024, 1024); pg8::EpiResidH E{out, out, H, PSB, 1024}; RUN_GEMM(pg8::EpiResidH, true, g, E); } \
    SEAM(base + 3); \
    PHASE(base + 4) { pg8::Gemm g = pg8::make_gemm(H, WF1 + (size_t)(L) * D * 2 * FFN, T, 2 * FFN, 1024, 1024, 1024); pg8::EpiSwiglu E{P, FFN, PSB}; RUN_GEMM(pg8::EpiSwiglu, true, g, E); } \
    SEAM(base + 4); \
    PHASE(base + 5) { pg8::Gemm g = pg8::make_gemm(P, WF2 + (size_t)(L) * FFN * D, T, 1024, FFN, FFN, FFN); LASTEPI } \
    SEAM(base + 5);

    ATTN_FFN(6, 0, pg8::EpiResidH E{out COMMA out COMMA H COMMA PSB COMMA 1024}; RUN_GEMM(pg8::EpiResidH, true, g, E);)

    PHASE(12) { pg8::Gemm g = pg8::make_gemm(H, WHG, T, HGP, 1024, 1024, 1024); pg8::EpiBf16 E{P, HGP, 1.0f, PSB}; RUN_GEMM(pg8::EpiBf16, true, g, E); }
    SEAM(12);
    PHASE(13) {
#ifdef DUP_HGRN
        for (int cid = bx; cid < 256; cid += G) hgrn_chain(lds, cid, P, INP(25), OMIX1, 1024, 0, 0);
        grid.sync();
#endif
        for (int cid = bx; cid < 256; cid += G) hgrn_chain(lds, cid, P, INP(25), P, HGP, 1024, 1024); }
    SEAM(13);
    PHASE(14) { LOCAL_IDS hgrn_combine(P, INP(24), OMIX1, gw, NGW, lane); }
    SEAM(14);
    PHASE(15) { pg8::Gemm g = pg8::make_gemm(OMIX1, WHGO, T, 1024, 1024, 1024, 1024); pg8::EpiResidH E{out, out, H, PSB, 1024}; RUN_GEMM(pg8::EpiResidH, true, g, E); }
    SEAM(15);

    ATTN_FFN(16, 1, pg8::EpiResid E{out COMMA out COMMA 1024}; RUN_GEMM(pg8::EpiResid, true, g, E);)

    PHASE(22) { LOCAL_IDS
        const float* fg = INP(34);
        for (int m = gw; m < T; m += NGW) { f32x4* xr = (f32x4*)(out + (size_t)m * D) + lane; f32x4 v[4]; float s = 0.f;
#pragma unroll
            for (int j = 0; j < 4; ++j) { v[j] = xr[64 * j]; s += (v[j].x * v[j].x + v[j].y * v[j].y) + (v[j].z * v[j].z + v[j].w * v[j].w); }
            const float rs = rsqrtf(wave_sum(s) * (1.f / D) + 1e-6f);
#pragma unroll
            for (int j = 0; j < 4; ++j) { const f32x4 g = ((const f32x4*)fg)[lane + 64 * j]; f32x4 o = v[j] * rs * g;
                xr[64 * j] = o; } }
    }
#undef IN
#undef SEAM
#undef RUN_GEMM
}

extern "C" void kernel_launch(void* const* d_in, const int* in_sizes, int n_in, void* d_out, int out_size, void* d_ws, size_t ws_size, hipStream_t stream) {
    static int grid = 0;
    if (grid == 0) {
        if (n_in != 35 || out_size != T * D || ws_size < WS_END) { fprintf(stderr, "kernel_launch: unexpected shapes (n_in %d out %d ws %zu)\n", n_in, out_size, ws_size); grid = -1; return; }
        int dev = 0, cus = 0, per_cu = 0;
        hipGetDevice(&dev); hipDeviceGetAttribute(&cus, hipDeviceAttributeMultiprocessorCount, dev);
        hipFuncSetAttribute((const void*)mk_fwd, hipFuncAttributeMaxDynamicSharedMemorySize, LDS_BYTES);
        hipOccupancyMaxActiveBlocksPerMultiprocessor(&per_cu, (const void*)mk_fwd, 512, LDS_BYTES);
        if (per_cu < 1) { fprintf(stderr, "kernel_launch: occupancy query says %d blocks per CU\n", per_cu); per_cu = 1; }
        (void)hipGetLastError();
        grid = cus * 1;
    }
    if (grid < 0) return;
    if (hipMemsetAsync(d_ws, 0, 65536, stream) != hipSuccess) { fprintf(stderr, "kernel_launch: memset of the barrier words failed\n"); return; }
    Args a{};
    for (int i = 0; i < 35; ++i) a.in[i] = (const float*)d_in[i];
    a.out = (float*)d_out; a.ws = (unsigned char*)d_ws;
#if MK_COOP
    a.ph_lo = 0; a.ph_hi = NPHASE;
    void* kargs[] = {&a};
    hipError_t e = hipLaunchCooperativeKernel((const void*)mk_fwd, dim3(grid), dim3(512), kargs, LDS_BYTES, stream);
    if (e != hipSuccess) fprintf(stderr, "cooperative launch failed: %s (grid %d)\n", hipGetErrorString(e), grid);
#else
    for (int ph = 0; ph < NPHASE; ++ph) { a.ph_lo = ph; a.ph_hi = ph + 1; hipLaunchKernelGGL(mk_fwd, dim3(grid), dim3(512), LDS_BYTES, stream, a); }
#endif
}
```

```cpp
#include <hip/hip_runtime.h>
#include <hip/hip_cooperative_groups.h>
#include <cstdio>
#include <cstdint>
namespace cg = cooperative_groups;

#ifndef MK_COOP
#define MK_COOP 1
#endif

#define LAS __attribute__((address_space(3)))
typedef unsigned short bf16_t;
typedef short bf16x8 __attribute__((ext_vector_type(8)));
typedef float f32x4 __attribute__((ext_vector_type(4)));
typedef float f32x2 __attribute__((ext_vector_type(2)));
typedef unsigned u32x4 __attribute__((ext_vector_type(4)));
typedef unsigned u32x2 __attribute__((ext_vector_type(2)));

constexpr int NB = 16, SEQ = 4096, T = NB * SEQ, D = 1024;
constexpr int ABPAD = 3584, ABP = 3336;
constexpr int HGP = 5120;
constexpr int FFN = 2816;
constexpr int NPHASE = 23;

constexpr size_t MiB = 1u << 20;
constexpr size_t WS_WAB = 1 * MiB, WS_WABO = 8 * MiB, WS_WHG = 10 * MiB, WS_WHGO = 20 * MiB, WS_WQ = 22 * MiB, WS_WKV = 26 * MiB, WS_WO = 34 * MiB,
                 WS_WF1 = 38 * MiB, WS_WF2 = 60 * MiB, WS_G2T = 71 * MiB, WS_MEMN = 72 * MiB, WS_KMEM = 88 * MiB, WS_VT = 104 * MiB,
                 WS_PS = 120 * MiB, WS_H = 128 * MiB, WS_P = 256 * MiB, WS_PATT = 384 * MiB, WS_OMIX0 = 704 * MiB, WS_OMIX1 = 896 * MiB, WS_END = 1024 * MiB;
constexpr size_t DO_STATES = 0, DO_G = 128 * MiB, DO_SG = 192 * MiB, DO_BONUS = 208 * MiB, DO_TOT = 210 * MiB;

constexpr int LDS_BYTES = 163840;
constexpr int XLDS_OFF = 131072;

typedef __bf16 bf16x2_t __attribute__((ext_vector_type(2)));
__device__ __forceinline__ unsigned pk2(float lo, float hi) { const f32x2 v = {lo, hi}; return __builtin_bit_cast(unsigned, __builtin_convertvector(v, bf16x2_t)); }
__device__ __forceinline__ unsigned f2bf(float f) { return pk2(f, 0.f) & 0xffffu; }
__device__ __forceinline__ float bf2f(unsigned short b) { return __builtin_bit_cast(float, (unsigned)b << 16); }
__device__ __forceinline__ float bflo(unsigned u) { return __builtin_bit_cast(float, u << 16); }
__device__ __forceinline__ float bfhi(unsigned u) { return __builtin_bit_cast(float, u & 0xffff0000u); }
__device__ __forceinline__ float frcp(float x) { return __builtin_amdgcn_rcpf(x); }
__device__ __forceinline__ float sigmoidf_(float x) { return frcp(1.0f + __expf(-x)); }
__device__ __forceinline__ float siluf_(float x) { return x * frcp(1.0f + __expf(-x)); }
__device__ __forceinline__ float wave_sum(float v) {
#pragma unroll
    for (int o = 1; o < 64; o <<= 1) v += __shfl_xor(v, o);
    return v;
}
template <int CTRL> __device__ __forceinline__ float dppf(float x) { return __builtin_bit_cast(float, __builtin_amdgcn_mov_dpp(__builtin_bit_cast(int, x), CTRL, 0xf, 0xf, true)); }
__device__ __forceinline__ float sum8(float v) { v += dppf<0xB1>(v); v += dppf<0x4E>(v); v += dppf<0x141>(v); return v; }
#define LDS_WAIT() asm volatile("s_waitcnt lgkmcnt(0)" ::: "memory")

namespace pg8 {
constexpr int BM = 256, BK = 64, HALF = 128, HTB = HALF * BK * 2, STAGE_BYTES = 8 * HTB, NXCD = 8, WGM = 8;
__host__ __device__ __forceinline__ int lds_byte(int r, int c) { const int st = (r >> 4) * 2 + (c >> 5), rr = r & 15, cc = c & 31, ob = rr * 64 + cc * 2; return st * 1024 + (ob ^ (((ob >> 9) & 1) << 5)); }
__host__ __device__ __forceinline__ void stage_rc(int b, int& R, int& C) { const int st = b / 1024, sb = b % 1024, swz = sb ^ (((sb >> 9) & 1) << 5); R = (st >> 1) * 16 + swz / 64; C = (st & 1) * 32 + (swz % 64) / 2; }
__host__ __device__ __forceinline__ int perm32(int rho) { const int n = rho >> 4, i = rho & 15; return 8 * (i >> 2) + 4 * n + (i & 3); }

struct Unit { int pm, pn, z; };
struct Gemm {
    const bf16_t* A; const bf16_t* Bt; int lda, ldb, K, nM, nN, nZ, zdiv; long sAo, sAi, sBo, sBi, sCo, sCi;
    __device__ __forceinline__ long offA(const Unit& u) const { return (long)(u.z / zdiv) * sAo + (long)(u.z % zdiv) * sAi + (long)u.pm * BM * lda; }
    __device__ __forceinline__ long offB(const Unit& u) const { return (long)(u.z / zdiv) * sBo + (long)(u.z % zdiv) * sBi + (long)u.pn * BM * ldb; }
    __device__ __forceinline__ long offC(const Unit& u) const { return (long)(u.z / zdiv) * sCo + (long)(u.z % zdiv) * sCi; }
};
__device__ __forceinline__ Gemm make_gemm(const bf16_t* A, const bf16_t* Bt, int M, int N, int K, int lda, int ldb) {
    Gemm g; g.A = A; g.Bt = Bt; g.lda = lda; g.ldb = ldb; g.K = K; g.nM = M / BM; g.nN = N / BM; g.nZ = 1; g.zdiv = 1; g.sAo = g.sAi = g.sBo = g.sBi = g.sCo = g.sCi = 0; return g;
}
struct Order {
    int nM, nN, nwg, total, G, c;
    __device__ __forceinline__ void init(const Gemm& g, int G_, int c_) { nM = g.nM; nN = g.nN; nwg = nM * nN; total = nwg * g.nZ; G = G_; c = c_; }
    __device__ __forceinline__ bool next(int i, Unit& u) const {
        const long L = (long)i * G + c; if (L >= total) return false;
        u.z = (int)(L / nwg); int wgid = (int)(L % nwg);
        { const int q = nwg / NXCD, r = nwg % NXCD, xcd = wgid % NXCD, off = wgid / NXCD; wgid = (xcd < r ? xcd * (q + 1) : r * (q + 1) + (xcd - r) * q) + off; }
        const int nig = WGM * nN, gid = wgid / nig, fm = gid * WGM, gsz = (nM - fm) < WGM ? (nM - fm) : WGM;
        u.pm = fm + ((wgid % nig) % gsz); u.pn = (wgid % nig) / gsz; return true;
    }
};

__device__ __forceinline__ unsigned cvt_pk_bf16(float lo, float hi) { return pk2(lo, hi); }

__device__ __forceinline__ void row_scales(const float* PS, int rowbase, int fq, float (&rs)[2][4]) {
#pragma unroll
    for (int ai = 0; ai < 2; ++ai)
#pragma unroll
        for (int m = 0; m < 4; ++m) { const f32x4 p = *(const f32x4*)(PS + (size_t)(rowbase + ai * HALF + m * 16) * 16 + fq * 4);
            float s = (p[0] + p[1]) + (p[2] + p[3]); s += __shfl_xor(s, 16); s += __shfl_xor(s, 32); rs[ai][m] = rsqrtf(s * (1.f / 1024.f) + 1e-6f); }
}
struct EpiBf16 {
    static constexpr bool PERM = true;
    bf16_t* O; int ldc; float scale; const float* PS;
    __device__ __forceinline__ void operator()(const f32x4 (&acc)[2][2][4][2], const Unit& u, long coff, int wr, int wc, int fr, int fq, LAS unsigned char* xl) const {
        const int row0 = u.pm * BM + wr * 64 + fr, col0 = u.pn * BM + wc * 32 + 8 * fq; bf16_t* base = O + coff;
        float rs[2][4];
        if (PS) row_scales(PS, row0, fq, rs);
        else {
#pragma unroll
            for (int ai = 0; ai < 2; ++ai)
#pragma unroll
                for (int m = 0; m < 4; ++m) rs[ai][m] = 1.f; }
#pragma unroll
        for (int ai = 0; ai < 2; ++ai)
#pragma unroll
            for (int m = 0; m < 4; ++m) { bf16_t* rowp = base + (size_t)(row0 + ai * HALF + m * 16) * ldc + col0; const float sc_ = scale * rs[ai][m];
#pragma unroll
                for (int bj = 0; bj < 2; ++bj) { const f32x4 v0 = acc[ai][bj][m][0] * sc_, v1 = acc[ai][bj][m][1] * sc_;
                    u32x4 w; w.x = cvt_pk_bf16(v0[0], v0[1]); w.y = cvt_pk_bf16(v0[2], v0[3]); w.z = cvt_pk_bf16(v1[0], v1[1]); w.w = cvt_pk_bf16(v1[2], v1[3]);
                    *(u32x4*)(rowp + bj * HALF) = w; } }
    }
};
struct EpiResid {
    static constexpr bool PERM = false;
    const float* base; float* out; int ldc;
    __device__ __forceinline__ void operator()(const f32x4 (&acc)[2][2][4][2], const Unit& u, long coff, int wr, int wc, int fr, int fq, LAS unsigned char* xl) const {
        const int col0 = u.pn * BM + wc * 32 + 4 * fq;
#pragma unroll
        for (int ai = 0; ai < 2; ++ai)
#pragma unroll
            for (int m = 0; m < 4; ++m) { const size_t off = (size_t)(u.pm * BM + ai * HALF + wr * 64 + m * 16 + fr) * ldc + col0;
#pragma unroll
                for (int bj = 0; bj < 2; ++bj)
#pragma unroll
                    for (int n = 0; n < 2; ++n) { const f32x4 bs = *(const f32x4*)(base + off + bj * HALF + n * 16); *(f32x4*)(out + off + bj * HALF + n * 16) = bs + acc[ai][bj][m][n]; } }
    }
};
struct EpiResidH {
    static constexpr bool PERM = false;
    const float* base; float* out; bf16_t* HB; float* PS; int ldc;
    __device__ __forceinline__ void operator()(const f32x4 (&acc)[2][2][4][2], const Unit& u, long coff, int wr, int wc, int fr, int fq, LAS unsigned char* xl) const {
        const int col0 = u.pn * BM + wc * 32 + 4 * fq;
#pragma unroll
        for (int ai = 0; ai < 2; ++ai)
#pragma unroll
            for (int m = 0; m < 4; ++m) { const int row = u.pm * BM + ai * HALF + wr * 64 + m * 16 + fr; const size_t off = (size_t)row * ldc + col0; float ss = 0.f;
#pragma unroll
                for (int bj = 0; bj < 2; ++bj)
#pragma unroll
                    for (int n = 0; n < 2; ++n) { const f32x4 bs = *(const f32x4*)(base + off + bj * HALF + n * 16); const f32x4 o = bs + acc[ai][bj][m][n]; *(f32x4*)(out + off + bj * HALF + n * 16) = o;
                        ss += (o[0] * o[0] + o[1] * o[1]) + (o[2] * o[2] + o[3] * o[3]);
                        u32x2 w; w.x = cvt_pk_bf16(o[0], o[1]); w.y = cvt_pk_bf16(o[2], o[3]); *(u32x2*)(HB + off + bj * HALF + n * 16) = w; }
                ss += __shfl_xor(ss, 16); ss += __shfl_xor(ss, 32);
                if (fq == 0) PS[(size_t)row * 16 + u.pn * 4 + wc] = ss; }
    }
};
struct EpiResidB {
    static constexpr bool PERM = false;
    const float* basef; bf16_t* HB; float* PS; int ldc;
    __device__ __forceinline__ void operator()(const f32x4 (&acc)[2][2][4][2], const Unit& u, long coff, int wr, int wc, int fr, int fq, LAS unsigned char* xl) const {
        const int col0 = u.pn * BM + wc * 32 + 4 * fq;
#pragma unroll
        for (int ai = 0; ai < 2; ++ai)
#pragma unroll
            for (int m = 0; m < 4; ++m) { const int row = u.pm * BM + ai * HALF + wr * 64 + m * 16 + fr; const size_t off = (size_t)row * ldc + col0; float ss = 0.f;
#pragma unroll
                for (int bj = 0; bj < 2; ++bj)
#pragma unroll
                    for (int n = 0; n < 2; ++n) { f32x4 bs;
                        if (basef) bs = *(const f32x4*)(basef + off + bj * HALF + n * 16);
                        else { const u32x2 hb = *(const u32x2*)(HB + off + bj * HALF + n * 16); bs = (f32x4){bflo(hb.x), bfhi(hb.x), bflo(hb.y), bfhi(hb.y)}; }
                        const f32x4 o = bs + acc[ai][bj][m][n];
                        ss += (o[0] * o[0] + o[1] * o[1]) + (o[2] * o[2] + o[3] * o[3]);
                        u32x2 w; w.x = cvt_pk_bf16(o[0], o[1]); w.y = cvt_pk_bf16(o[2], o[3]); *(u32x2*)(HB + off + bj * HALF + n * 16) = w; }
                ss += __shfl_xor(ss, 16); ss += __shfl_xor(ss, 32);
                if (fq == 0) PS[(size_t)row * 16 + u.pn * 4 + wc] = ss; }
    }
};
struct EpiSwiglu {
    static constexpr bool PERM = true;
    bf16_t* O; int ldc; const float* PS;
    __device__ __forceinline__ void operator()(const f32x4 (&acc)[2][2][4][2], const Unit& u, long coff, int wr, int wc, int fr, int fq, LAS unsigned char* xl) const {
        const int row0 = u.pm * BM + wr * 64 + fr, col0 = u.pn * HALF + wc * 32 + 8 * fq;
        float rs[2][4]; row_scales(PS, row0, fq, rs);
#pragma unroll
        for (int ai = 0; ai < 2; ++ai)
#pragma unroll
            for (int m = 0; m < 4; ++m) { bf16_t* rowp = O + (size_t)(row0 + ai * HALF + m * 16) * ldc + col0; float r[8]; const float sc_ = rs[ai][m];
#pragma unroll
                for (int n = 0; n < 2; ++n)
#pragma unroll
                    for (int i = 0; i < 4; ++i) { const float g = acc[ai][0][m][n][i] * sc_, uu = acc[ai][1][m][n][i] * sc_; r[n * 4 + i] = siluf_(g) * uu; }
                u32x4 w; w.x = cvt_pk_bf16(r[0], r[1]); w.y = cvt_pk_bf16(r[2], r[3]); w.z = cvt_pk_bf16(r[4], r[5]); w.w = cvt_pk_bf16(r[6], r[7]);
                *(u32x4*)rowp = w; }
    }
};
struct EpiSoftmax {
    static constexpr bool PERM = true;
    bf16_t* O; int ldc;
    __device__ __forceinline__ void operator()(f32x4 (&acc)[2][2][4][2], const Unit& u, long coff, int wr, int wc, int fr, int fq, LAS unsigned char* xl) const {
        LAS float* XM = (LAS float*)xl; LAS float* XS = (LAS float*)(xl + 4096);
#pragma unroll
        for (int ai = 0; ai < 2; ++ai)
#pragma unroll
            for (int m = 0; m < 4; ++m) { float mx = -3.0e38f;
#pragma unroll
                for (int bj = 0; bj < 2; ++bj)
#pragma unroll
                    for (int n = 0; n < 2; ++n)
#pragma unroll
                        for (int i = 0; i < 4; ++i) mx = fmaxf(mx, acc[ai][bj][m][n][i]);
                mx = fmaxf(mx, __shfl_xor(mx, 16)); mx = fmaxf(mx, __shfl_xor(mx, 32));
                if (fq == 0) XM[(ai * HALF + wr * 64 + m * 16 + fr) * 4 + wc] = mx; }
        LDS_WAIT(); __builtin_amdgcn_s_barrier(); asm volatile("" ::: "memory");
#pragma unroll
        for (int ai = 0; ai < 2; ++ai)
#pragma unroll
            for (int m = 0; m < 4; ++m) { const f32x4 mm = *(const LAS f32x4*)(XM + (ai * HALF + wr * 64 + m * 16 + fr) * 4);
                const float mx = fmaxf(fmaxf(mm[0], mm[1]), fmaxf(mm[2], mm[3])); float s = 0.f;
#pragma unroll
                for (int bj = 0; bj < 2; ++bj)
#pragma unroll
                    for (int n = 0; n < 2; ++n)
#pragma unroll
                        for (int i = 0; i < 4; ++i) { const float e = __expf(acc[ai][bj][m][n][i] - mx); acc[ai][bj][m][n][i] = e; s += e; }
                s += __shfl_xor(s, 16); s += __shfl_xor(s, 32);
                if (fq == 0) XS[(ai * HALF + wr * 64 + m * 16 + fr) * 4 + wc] = s; }
        LDS_WAIT(); __builtin_amdgcn_s_barrier(); asm volatile("" ::: "memory");
        const int row0 = u.pm * BM + wr * 64 + fr, col0 = wc * 32 + 8 * fq; bf16_t* base = O + coff;
#pragma unroll
        for (int ai = 0; ai < 2; ++ai)
#pragma unroll
            for (int m = 0; m < 4; ++m) { const f32x4 ss = *(const LAS f32x4*)(XS + (ai * HALF + wr * 64 + m * 16 + fr) * 4);
                const float inv = frcp((ss[0] + ss[1]) + (ss[2] + ss[3])); bf16_t* rowp = base + (size_t)(row0 + ai * HALF + m * 16) * ldc + col0;
#pragma unroll
                for (int bj = 0; bj < 2; ++bj) { const f32x4 v0 = acc[ai][bj][m][0] * inv, v1 = acc[ai][bj][m][1] * inv;
                    u32x4 w; w.x = cvt_pk_bf16(v0[0], v0[1]); w.y = cvt_pk_bf16(v0[2], v0[3]); w.z = cvt_pk_bf16(v1[0], v1[1]); w.w = cvt_pk_bf16(v1[2], v1[3]);
                    *(u32x4*)(rowp + bj * HALF) = w; } }
    }
};

template <class Epi, bool ALIGN_EPI>
__device__ __forceinline__ void gemm_phase(LAS unsigned char* lds, LAS unsigned char* xl, const Gemm g, const Order& S, Epi& E) {
    const int tid = threadIdx.x, wid = __builtin_amdgcn_readfirstlane(tid >> 6), lane = tid & 63, wr = wid >> 2, wc = wid & 3, fr = lane & 15, fq = lane >> 4;
    const int K = g.K, nt = K / BK;
    unsigned voffA[2], voffB[2];
#pragma unroll
    for (int i = 0; i < 2; ++i) { int R, C; stage_rc(tid * 16 + i * 8192, R, C); const int Rb = Epi::PERM ? ((R & ~31) + perm32(R & 31)) : R;
        voffA[i] = (unsigned)(R * g.lda + C) * 2u; voffB[i] = (unsigned)(Rb * g.ldb + C) * 2u; }
    const size_t kstep = (size_t)(BK * 2);
    const size_t hstepA = (size_t)HALF * g.lda * 2, hstepB = (size_t)HALF * g.ldb * 2;
    const unsigned ldsw = (unsigned)wid * 1024u;
    const int aoff = lds_byte(wr * 64 + fr, fq * 8), boff = lds_byte(wc * 32 + fr, fq * 8);
#define PG8_SA(b, h) (((b) * 2 + (h)) * HTB)
#define PG8_SB(b, h) ((4 + (b) * 2 + (h)) * HTB)
#define PG8_STAGE(bufoff, gbase, voff) do { _Pragma("unroll") for (int _i = 0; _i < 2; ++_i) \
        __builtin_amdgcn_global_load_lds((const unsigned*)((const char*)(gbase) + (voff)[_i]), (LAS unsigned*)(lds + (bufoff) + ldsw + _i * 8192), 16, 0, 0); } while (0)
#define PG8_LDA(dst, b, h) do { _Pragma("unroll") for (int m = 0; m < 4; ++m) _Pragma("unroll") for (int k = 0; k < 2; ++k) dst[m][k] = *(const LAS bf16x8*)(lds + PG8_SA(b, h) + aoff + m * 2048 + k * 1024); } while (0)
#define PG8_LDB(dst, b, h) do { _Pragma("unroll") for (int n = 0; n < 2; ++n) _Pragma("unroll") for (int k = 0; k < 2; ++k) dst[n][k] = *(const LAS bf16x8*)(lds + PG8_SB(b, h) + boff + n * 2048 + k * 1024); } while (0)
#define PG8_MMA(ai, bj, At, Bt) do { __builtin_amdgcn_s_setprio(1); _Pragma("unroll") for (int m = 0; m < 4; ++m) _Pragma("unroll") for (int n = 0; n < 2; ++n) _Pragma("unroll") for (int k = 0; k < 2; ++k) \
        acc[ai][bj][m][n] = __builtin_amdgcn_mfma_f32_16x16x32_bf16(Bt[n][k], At[m][k], acc[ai][bj][m][n], 0, 0, 0); __builtin_amdgcn_s_setprio(0); } while (0)
#define PG8_WAIT_V(n) asm volatile("s_waitcnt vmcnt(" #n ")" ::: "memory")
#define PG8_WAIT_L(n) asm volatile("s_waitcnt lgkmcnt(" #n ")" ::: "memory")
#define PG8_BAR __builtin_amdgcn_s_barrier()
#define PG8_SCHED __builtin_amdgcn_sched_barrier(0)
    Unit cur, nxt; int ui = 0;
    if (!S.next(0, cur)) return;
    f32x4 acc[2][2][4][2];
#pragma unroll
    for (int a = 0; a < 2; ++a)
#pragma unroll
        for (int b = 0; b < 2; ++b)
#pragma unroll
            for (int m = 0; m < 4; ++m)
#pragma unroll
                for (int n = 0; n < 2; ++n) acc[a][b][m][n] = (f32x4){0.f, 0.f, 0.f, 0.f};
    bf16x8 At[4][2], B0[2][2], B1[2][2];
    const char* cA = (const char*)g.A + 2 * g.offA(cur); const char* cB = (const char*)g.Bt + 2 * g.offB(cur);
    PG8_STAGE(PG8_SB(0, 0), cB, voffB); PG8_STAGE(PG8_SB(0, 1), cB + hstepB, voffB); PG8_STAGE(PG8_SA(0, 0), cA, voffA); PG8_STAGE(PG8_SA(0, 1), cA + hstepA, voffA);
    if (wr == 1) PG8_BAR;
    PG8_WAIT_V(2); PG8_BAR;
    PG8_STAGE(PG8_SB(1, 0), cB + kstep, voffB); PG8_STAGE(PG8_SA(1, 0), cA + kstep, voffA); PG8_STAGE(PG8_SB(1, 1), cB + hstepB + kstep, voffB);
    PG8_WAIT_V(6); PG8_BAR;
    for (;;) {
        const bool has_next = S.next(ui + 1, nxt);
        const char* nA = has_next ? (const char*)g.A + 2 * g.offA(nxt) : cA; const char* nB = has_next ? (const char*)g.Bt + 2 * g.offB(nxt) : cB;
        for (int t = 0; t < nt; t += 2) {
            const bool last = (t == nt - 2);
            const char* a1 = cA + (size_t)(t + 1) * kstep;
            const char* a2 = last ? nA : cA + (size_t)(t + 2) * kstep; const char* b2 = last ? nB : cB + (size_t)(t + 2) * kstep;
            const char* a3 = a2 + kstep; const char* b3 = b2 + kstep;
            PG8_LDB(B0, 0, 0); PG8_LDB(B1, 0, 1); PG8_SCHED; PG8_LDA(At, 0, 0); PG8_STAGE(PG8_SA(1, 1), a1 + hstepA, voffA);
            PG8_WAIT_V(8); PG8_WAIT_L(0); PG8_BAR; PG8_MMA(0, 0, At, B0); PG8_MMA(0, 1, At, B1); PG8_BAR; PG8_SCHED;
            PG8_LDA(At, 0, 1); PG8_STAGE(PG8_SB(0, 0), b2, voffB); PG8_STAGE(PG8_SB(0, 1), b2 + hstepB, voffB); PG8_STAGE(PG8_SA(0, 0), a2, voffA);
            PG8_WAIT_V(8); PG8_WAIT_L(0); PG8_BAR; PG8_MMA(1, 0, At, B0); PG8_MMA(1, 1, At, B1); PG8_BAR; PG8_SCHED;
            PG8_LDB(B0, 1, 0); PG8_LDB(B1, 1, 1); PG8_SCHED; PG8_LDA(At, 1, 0); PG8_STAGE(PG8_SA(0, 1), a2 + hstepA, voffA);
            PG8_WAIT_V(8); PG8_WAIT_L(0); PG8_BAR; PG8_MMA(0, 0, At, B0); PG8_MMA(0, 1, At, B1); PG8_BAR; PG8_SCHED;
            PG8_LDA(At, 1, 1); PG8_STAGE(PG8_SB(1, 0), b3, voffB); PG8_STAGE(PG8_SB(1, 1), b3 + hstepB, voffB); PG8_STAGE(PG8_SA(1, 0), a3, voffA);
            PG8_WAIT_V(8); PG8_WAIT_L(0); PG8_BAR; PG8_MMA(1, 0, At, B0); PG8_MMA(1, 1, At, B1); PG8_BAR; PG8_SCHED;
        }
        if constexpr (ALIGN_EPI) { if (wr == 0) PG8_BAR; }
        E(acc, cur, g.offC(cur), wr, wc, fr, fq, xl);
        if (!has_next) break;
#pragma unroll
        for (int a = 0; a < 2; ++a)
#pragma unroll
            for (int b = 0; b < 2; ++b)
#pragma unroll
                for (int m = 0; m < 4; ++m)
#pragma unroll
                    for (int n = 0; n < 2; ++n) acc[a][b][m][n] = (f32x4){0.f, 0.f, 0.f, 0.f};
        cur = nxt; cA = nA; cB = nB; ++ui;
        if constexpr (ALIGN_EPI) { if (wr == 1) PG8_BAR; }
    }
    PG8_WAIT_V(0);
    if constexpr (!ALIGN_EPI) { if (wr == 0) PG8_BAR; }
    PG8_BAR;
#undef PG8_SA
#undef PG8_SB
#undef PG8_STAGE
#undef PG8_LDA
#undef PG8_LDB
#undef PG8_MMA
#undef PG8_WAIT_V
#undef PG8_WAIT_L
#undef PG8_BAR
#undef PG8_SCHED
}
}

__device__ __forceinline__ f32x4 mfma16(bf16x8 bfrag, bf16x8 afrag, f32x4 acc) { return __builtin_amdgcn_mfma_f32_16x16x32_bf16(bfrag, afrag, acc, 0, 0, 0); }
__device__ __forceinline__ bf16x8 ldsfrag(const LAS bf16_t* base, int ld, int r0, int k0, int fr, int fq) { return *(const LAS bf16x8*)(base + (r0 + fr) * ld + k0 + fq * 8); }

template <int MODE> __device__ __forceinline__ void transpose_item(const float* W, int K, int N, bf16_t* WT, LAS float* scr, int item, int nblk, int lane, const float* gain = nullptr) {
    const int kb = item / nblk, nb = item % nblk, k0 = 64 * kb, n0 = 32 * nb; const int nsrc = n0 + (lane & 31);
#pragma unroll 8
    for (int i = 0; i < 32; ++i) { const int kk = 2 * i + (lane >> 5); scr[kk * 33 + (lane & 31)] = (nsrc < N) ? W[(size_t)(k0 + kk) * N + nsrc] * (gain ? gain[k0 + kk] : 1.f) : 0.f; }
    LDS_WAIT();
    const int c = lane & 7;
#pragma unroll
    for (int j = 0; j < 4; ++j) { const int n = (lane >> 3) + 8 * j; const LAS float* s = scr + (8 * c) * 33 + n;
        u32x4 o; o.x = pk2(s[0 * 33], s[1 * 33]); o.y = pk2(s[2 * 33], s[3 * 33]); o.z = pk2(s[4 * 33], s[5 * 33]); o.w = pk2(s[6 * 33], s[7 * 33]);
        int drow = n0 + n; if (MODE == 1) { const int jn = drow % FFN, isu = drow / FFN; drow = (jn / 128) * 256 + isu * 128 + (jn % 128); }
        *(u32x4*)(WT + (size_t)drow * K + k0 + 8 * c) = o; }
    LDS_WAIT();
}
__device__ __forceinline__ void rms_row_bf16(const float* xrow, const float* gain, bf16_t* orow, int lane) {
    const f32x4* xr = (const f32x4*)xrow + lane; f32x4 v[4]; float s = 0.f;
#pragma unroll
    for (int j = 0; j < 4; ++j) { v[j] = xr[64 * j]; s += (v[j].x * v[j].x + v[j].y * v[j].y) + (v[j].z * v[j].z + v[j].w * v[j].w); }
    const float rs = rsqrtf(wave_sum(s) * (1.f / D) + 1e-6f);
    const f32x4* gr = (const f32x4*)gain + lane; u32x2* o8 = (u32x2*)orow + lane;
#pragma unroll
    for (int j = 0; j < 4; ++j) { const f32x4 g = gr[64 * j]; u32x2 w; w.x = pk2(v[j].x * rs * g.x, v[j].y * rs * g.y); w.y = pk2(v[j].z * rs * g.z, v[j].w * rs * g.w); o8[64 * j] = w; }
}
__device__ __forceinline__ void rms_rows_phase(const float* X, const float* gain, bf16_t* H, int nrows, int gw, int NGW, int lane) {
    for (int m = gw; m < nrows; m += NGW) rms_row_bf16(X + (size_t)m * D, gain, H + (size_t)m * D, lane);
}

__device__ __forceinline__ void rwkv_chain(LAS unsigned char* lds, int cid, const bf16_t* P0, const float* mu, const float* w0, const float* w2, const float* a0, const float* a2,
                                           const float* k_k, const float* k_a, const float* r_k, bf16_t* ORW, bf16_t* SG, float* BONUS) {
    const int tid = threadIdx.x, lane = tid & 63, wid = tid >> 6, fr = lane & 15, fq = lane >> 4;
    const int b = cid >> 4, h = (cid >> 1) & 7, dir = cid & 1;
    LAS float* rS = (LAS float*)(lds); LAS float* kS = (LAS float*)(lds + 8192); LAS float* vS = (LAS float*)(lds + 16384); LAS float* wS = (LAS float*)(lds + 24576);
    LAS float* nkS = (LAS float*)(lds + 32768); LAS float* bS = (LAS float*)(lds + 40960); LAS float* preA = (LAS float*)(lds + 49152); LAS float* preW = (LAS float*)(lds + 57344);
    LAS bf16_t* adB = (LAS bf16_t*)(lds + 65536); LAS bf16_t* wdB = (LAS bf16_t*)(lds + 70144);
    LAS bf16_t* a2B = (LAS bf16_t*)(lds + 74752); LAS bf16_t* w2B = (LAS bf16_t*)(lds + 83968); LAS float* cst = (LAS float*)(lds + 93184);
    LAS bf16_t* At = (LAS bf16_t*)(lds + 97280); LAS bf16_t* Bt = (LAS bf16_t*)(lds + 101888); LAS bf16_t* Kt = (LAS bf16_t*)(lds + 106496); LAS bf16_t* Rt = (LAS bf16_t*)(lds + 111104);
    LAS bf16_t* BtT = (LAS bf16_t*)(lds + 115712); LAS bf16_t* KtT = (LAS bf16_t*)(lds + 120832); LAS bf16_t* VT = (LAS bf16_t*)(lds + 125952); LAS bf16_t* S0b = (LAS bf16_t*)(lds + 131072);
    LAS float* NT4 = (LAS float*)(lds + 140288); LAS bf16_t* NakT = (LAS bf16_t*)(lds + 146432); LAS bf16_t* MbrT = (LAS bf16_t*)(lds + 148992); LAS bf16_t* MkrT = (LAS bf16_t*)(lds + 151552);
    LAS float* gL = (LAS float*)(lds + 154112);
    LAS float* WS = preA;
    LAS bf16_t* Ub = (LAS bf16_t*)preW;
#define RW_IDS int tid_o = threadIdx.x; asm volatile("" : "+v"(tid_o)); const int tid = tid_o, lane = tid & 63, wid = __builtin_amdgcn_readfirstlane(tid >> 6), fr = lane & 15, fq = lane >> 4, vt = wid >> 1, tt2 = wid & 1; (void)lane; (void)wid; (void)fr; (void)fq; (void)vt; (void)tt2;
    __syncthreads();
    for (int e = tid; e < 64 * 64; e += 512) { const int j = e & 63, r = e >> 6;
        a2B[j * 72 + r] = (bf16_t)f2bf(a2[r * 512 + h * 64 + j]); w2B[j * 72 + r] = (bf16_t)f2bf(w2[(dir * 64 + r) * 512 + h * 64 + j]); }
    for (int e = tid; e < 64 * 72 / 2; e += 512) ((LAS unsigned*)S0b)[e] = 0u;
    if (tid < 64) { const int j = tid, c = h * 64 + j;
        cst[0 * 64 + j] = a0[c]; cst[1 * 64 + j] = w0[dir * 512 + c]; cst[2 * 64 + j] = k_k[c]; cst[3 * 64 + j] = k_a[c]; cst[4 * 64 + j] = r_k[c];
        cst[5 * 64 + j] = mu[c]; cst[6 * 64 + j] = mu[512 + c]; cst[7 * 64 + j] = mu[1024 + c]; cst[8 * 64 + j] = mu[1536 + j]; cst[9 * 64 + j] = mu[1600 + j];
        cst[10 * 64 + j] = (j < 16) ? mu[1664 + h * 16 + j] : 0.f; }
    const int vt = wid >> 1, tt2 = wid & 1;
    f32x4 st[2]; st[0] = (f32x4){0.f, 0.f, 0.f, 0.f}; st[1] = st[0];
    __syncthreads();
    const bf16_t* Pb = P0 + (size_t)b * SEQ * ABPAD;
    unsigned rc[10], rpv[10], rnx[10]; unsigned short gcv = 0, gpv = 0, gnv = 0;
#define RW_IDX(i) const int grp = (i) >> 1; const int idx_ = tid + 512 * ((i) & 1); const int tok = idx_ >> 5, c2 = (idx_ & 31) * 2; \
                  const int gcol = (grp == 0 ? h * 64 : grp == 1 ? 512 + h * 64 : grp == 2 ? 1024 + h * 64 : grp == 3 ? 1536 : 1600) + c2;
    const unsigned voff = (unsigned)((((int)threadIdx.x >> 5) * ABPAD + ((int)threadIdx.x & 31) * 2) * 2);
#define RW_CG(g) ((g) == 0 ? h * 128 : (g) == 1 ? 1024 + h * 128 : (g) == 2 ? 2048 + h * 128 : (g) == 3 ? 3072 : 3200)
#define RW_ISSUE(t0n) do { const char* bp_ = (const char*)(Pb + (size_t)(t0n) * ABPAD); const bool first_ = ((t0n) == 0) && (tid < 32), last_ = ((t0n) == SEQ - 32) && (tid >= 480); \
        _Pragma("unroll") for (int i = 0; i < 10; ++i) { const char* p = bp_ + (RW_CG(i >> 1) + (i & 1) * 16 * ABPAD * 2) + voff; \
            rc[i] = *(const unsigned*)p; \
            if ((i & 1) == 0) { const unsigned v_ = *(const unsigned*)(p - (first_ ? 0 : ABPAD * 2)); rpv[i] = first_ ? 0u : v_; rnx[i] = *(const unsigned*)(p + ABPAD * 2); } \
            else { const unsigned v_ = *(const unsigned*)(p + (last_ ? 0 : ABPAD * 2)); rnx[i] = last_ ? 0u : v_; rpv[i] = *(const unsigned*)(p - ABPAD * 2); } } \
        if (dir == 0) { const bool fg_ = ((t0n) == 0) && (tid < 16), lg_ = ((t0n) == SEQ - 32) && (tid >= 496); \
            const bf16_t* p = (const bf16_t*)bp_ + (size_t)(tid >> 4) * ABPAD + 1664 + h * 16 + (tid & 15); \
            gcv = *p; { const unsigned short v_ = *(p - (fg_ ? 0 : ABPAD)); gpv = fg_ ? (unsigned short)0 : v_; } { const unsigned short v_ = *(p + (lg_ ? 0 : ABPAD)); gnv = lg_ ? (unsigned short)0 : v_; } } } while (0)
    RW_ISSUE(dir ? 127 * 32 : 0);
    for (int cc = 0; cc < 128; ++cc) {
        const int t0 = dir ? (127 - cc) * 32 : cc * 32;
        { RW_IDS
#pragma unroll
        for (int i = 0; i < 10; ++i) { RW_IDX(i) (void)gcol;
            const unsigned cur = rc[i], prv = rpv[i], nxt = rnx[i];
            const float m0 = cst[(5 + grp) * 64 + c2], m1 = cst[(5 + grp) * 64 + c2 + 1];
            const float c0 = bflo(cur), c1 = bfhi(cur);
            const float x0 = c0 + m0 * (0.5f * (bflo(prv) + bflo(nxt)) - c0), x1 = c1 + m1 * (0.5f * (bfhi(prv) + bfhi(nxt)) - c1);
            if (grp == 0) { *(LAS f32x2*)(rS + tok * 64 + c2) = (f32x2){x0, x1}; }
            else if (grp == 1) { *(LAS f32x2*)(kS + tok * 64 + c2) = (f32x2){x0, x1}; }
            else if (grp == 2) { *(LAS f32x2*)(vS + tok * 64 + c2) = (f32x2){x0, x1}; }
            else if (grp == 3) { const float e0 = __expf(2.f * x0), e1 = __expf(2.f * x1); *(LAS unsigned*)(wdB + tok * 72 + c2) = pk2(1.f - 2.f * frcp(e0 + 1.f), 1.f - 2.f * frcp(e1 + 1.f)); }
            else { *(LAS unsigned*)(adB + tok * 72 + c2) = pk2(x0, x1); }
        }
        if (dir == 0) {
            const int tok = tid >> 4, c = tid & 15, t = t0 + tok;
            const float cur = bf2f(gcv), prv = bf2f(gpv), nxt = bf2f(gnv);
            const float x = cur + cst[10 * 64 + c] * (0.5f * (prv + nxt) - cur);
            SG[((size_t)b * SEQ + t) * 128 + h * 16 + c] = (bf16_t)f2bf(sigmoidf_(x));
        } }
        __syncthreads();
        if (cc + 1 < 128) { RW_IDS const int t0n = dir ? (126 - cc) * 32 : (cc + 1) * 32; RW_ISSUE(t0n); }
        { RW_IDS const int mat = wid >> 2, ntile = wid & 3; const LAS bf16_t* Aop = mat ? wdB : adB; const LAS bf16_t* Bop = mat ? w2B : a2B; LAS float* pre = mat ? preW : preA;
#pragma unroll
          for (int mt = 0; mt < 2; ++mt) { f32x4 acc = (f32x4){0.f, 0.f, 0.f, 0.f};
#pragma unroll
              for (int ks = 0; ks < 2; ++ks) acc = mfma16(ldsfrag(Bop, 72, ntile * 16, ks * 32, fr, fq), ldsfrag(Aop, 72, mt * 16, ks * 32, fr, fq), acc);
              *(LAS f32x4*)(pre + (mt * 16 + fr) * 64 + ntile * 16 + fq * 4) = acc; } }
        __syncthreads();
        { RW_IDS const int tok = tid >> 4, c0 = (tid & 15) * 4; float kkr[4], av[4], kp[4], wv[4]; float ss = 0.f, bon = 0.f;
#pragma unroll
          for (int i = 0; i < 4; ++i) { const int c = c0 + i, ix = tok * 64 + c;
              const float a = sigmoidf_(cst[c] + preA[ix]); const float sg = sigmoidf_(cst[64 + c] + preW[ix]);
              wv[i] = -0.60653065971f * sg;
              const float kraw = kS[ix]; kkr[i] = kraw * cst[128 + c]; ss += kkr[i] * kkr[i];
              kp[i] = kraw * (1.0f + (a - 1.0f) * cst[192 + c]); av[i] = a; bon += rS[ix] * kp[i] * cst[256 + c]; }
          ss += dppf<0xB1>(ss); bon += dppf<0xB1>(bon); ss += dppf<0x4E>(ss); bon += dppf<0x4E>(bon);
          ss += dppf<0x141>(ss); bon += dppf<0x141>(bon); ss += dppf<0x140>(ss); bon += dppf<0x140>(bon);
          const float inv = frcp(fmaxf(__builtin_amdgcn_sqrtf(ss), 1e-12f));
          f32x4 o_nk, o_b, o_k, o_w;
#pragma unroll
          for (int i = 0; i < 4; ++i) { const float kk = kkr[i] * inv; o_nk[i] = -kk; o_b[i] = kk * av[i]; o_k[i] = kp[i]; o_w[i] = wv[i]; }
          *(LAS f32x4*)(nkS + tok * 64 + c0) = o_nk; *(LAS f32x4*)(bS + tok * 64 + c0) = o_b; *(LAS f32x4*)(kS + tok * 64 + c0) = o_k; *(LAS f32x4*)(wS + tok * 64 + c0) = o_w;
          if (dir == 0 && (tid & 15) == 0) BONUS[((size_t)b * SEQ + t0 + tok) * 8 + h] = bon; }
        __syncthreads();
        { RW_IDS if (tid < 64) { float lw[32];
#pragma unroll
            for (int s = 0; s < 32; ++s) lw[s] = wS[(dir ? 31 - s : s) * 64 + tid];
#pragma unroll
            for (int s = 1; s < 32; ++s) lw[s] += lw[s - 1];
#pragma unroll
            for (int s = 0; s < 32; ++s) wS[(dir ? 31 - s : s) * 64 + tid] = lw[s]; } }
        __syncthreads();
        { RW_IDS const int s = tid >> 4, c0 = (tid & 15) * 4; const int tok = dir ? 31 - s : s, tokp = dir ? tok + 1 : tok - 1;
          const f32x4 cum = *(const LAS f32x4*)(wS + tok * 64 + c0); f32x4 cump = (f32x4){0.f, 0.f, 0.f, 0.f}; if (s > 0) cump = *(const LAS f32x4*)(wS + tokp * 64 + c0);
          const f32x4 nk4 = *(const LAS f32x4*)(nkS + tok * 64 + c0), b4 = *(const LAS f32x4*)(bS + tok * 64 + c0), k4 = *(const LAS f32x4*)(kS + tok * 64 + c0), r4 = *(const LAS f32x4*)(rS + tok * 64 + c0), v4 = *(const LAS f32x4*)(vS + tok * 64 + c0);
          float ta[4], tb[4], tk[4], tr[4];
#pragma unroll
          for (int i = 0; i < 4; ++i) { const float g = __expf(cum[i]), gp = __expf(cump[i]), ig = __expf(-cum[i]);
              ta[i] = nk4[i] * gp; tb[i] = b4[i] * ig; tk[i] = k4[i] * ig; tr[i] = r4[i] * g;
              BtT[(c0 + i) * 40 + s] = (bf16_t)f2bf(tb[i]); KtT[(c0 + i) * 40 + s] = (bf16_t)f2bf(tk[i]); VT[(c0 + i) * 40 + s] = (bf16_t)f2bf(v4[i]);
              if (s == 31) gL[c0 + i] = g; }
          u32x2 w; w.x = pk2(ta[0], ta[1]); w.y = pk2(ta[2], ta[3]); *(LAS u32x2*)(At + s * 72 + c0) = w;
          w.x = pk2(tb[0], tb[1]); w.y = pk2(tb[2], tb[3]); *(LAS u32x2*)(Bt + s * 72 + c0) = w;
          w.x = pk2(tk[0], tk[1]); w.y = pk2(tk[2], tk[3]); *(LAS u32x2*)(Kt + s * 72 + c0) = w;
          w.x = pk2(tr[0], tr[1]); w.y = pk2(tr[2], tr[3]); *(LAS u32x2*)(Rt + s * 72 + c0) = w; }
        __syncthreads();
        { RW_IDS const int mat = wid >> 1, mt = wid & 1; const LAS bf16_t* Aop = (mat < 2) ? At : Rt; const LAS bf16_t* Bop = (mat & 1) ? Kt : Bt;
#pragma unroll
          for (int nt = 0; nt < 2; ++nt) { f32x4 acc = (f32x4){0.f, 0.f, 0.f, 0.f};
#pragma unroll
              for (int ks = 0; ks < 2; ++ks) acc = mfma16(ldsfrag(Bop, 72, nt * 16, ks * 32, fr, fq), ldsfrag(Aop, 72, mt * 16, ks * 32, fr, fq), acc);
              const int srow = mt * 16 + fr;
#pragma unroll
              for (int e = 0; e < 4; ++e) { const int i = nt * 16 + fq * 4 + e; const bool keep = (mat < 2) ? (i < srow) : (i <= srow); if (!keep) acc[e] = 0.f; }
              if (mat == 0) {
#pragma unroll
                  for (int e = 0; e < 4; ++e) NT4[e * 384 + srow * 12 + nt * 4 + fq] = acc[e]; }
              else { LAS bf16_t* X = (mat == 1) ? NakT : (mat == 2) ? MbrT : MkrT; u32x2 o; o.x = pk2(acc[0], acc[1]); o.y = pk2(acc[2], acc[3]); *(LAS u32x2*)(X + srow * 40 + nt * 16 + fq * 4) = o; } } }
        __syncthreads();
        f32x4 oacc = (f32x4){0.f, 0.f, 0.f, 0.f};
        { RW_IDS f32x4 wacc = (f32x4){0.f, 0.f, 0.f, 0.f};
#pragma unroll
          for (int ks = 0; ks < 2; ++ks) { const bf16x8 sf = ldsfrag(S0b, 72, vt * 16, ks * 32, fr, fq);
              wacc = mfma16(ldsfrag(At, 72, tt2 * 16, ks * 32, fr, fq), sf, wacc); oacc = mfma16(ldsfrag(Rt, 72, tt2 * 16, ks * 32, fr, fq), sf, oacc); }
          const bf16x8 vf = ldsfrag(VT, 40, vt * 16, 0, fr, fq);
          wacc = mfma16(ldsfrag(NakT, 40, tt2 * 16, 0, fr, fq), vf, wacc); oacc = mfma16(ldsfrag(MkrT, 40, tt2 * 16, 0, fr, fq), vf, oacc);
#pragma unroll
          for (int n2 = 0; n2 < 2; ++n2) st[n2] = mfma16(ldsfrag(KtT, 40, (tt2 * 2 + n2) * 16, 0, fr, fq), vf, st[n2]);
#pragma unroll
          for (int e = 0; e < 4; ++e) WS[(tt2 * 16 + fq * 4 + e) * 64 + vt * 16 + fr] = wacc[e]; }
        __syncthreads();
        { RW_IDS if (wid < 4) { const int v = wid * 16 + (lane >> 2), p = lane & 3; const LAS float* NTp = NT4 + p * 384; float u[8];
#pragma unroll
            for (int j = 0; j < 8; ++j) u[j] = 0.f;
#pragma unroll
            for (int t = 0; t < 32; ++t) { float q0 = (p == 0) ? WS[t * 64 + v] : 0.f, q1 = 0.f;
#pragma unroll
                for (int j4 = 0; j4 < ((t + 3) / 4 + 3) / 4; ++j4) { const f32x4 nv = *(const LAS f32x4*)(NTp + t * 12 + j4 * 4);
                    q0 += u[j4 * 4] * nv[0]; q1 += u[j4 * 4 + 1] * nv[1]; q0 += u[j4 * 4 + 2] * nv[2]; q1 += u[j4 * 4 + 3] * nv[3]; }
                float q = q0 + q1; q += dppf<0xB1>(q); q += dppf<0x4E>(q);
                u[t >> 2] = ((t & 3) == p) ? q : u[t >> 2]; asm volatile("" ::: "memory"); }
#pragma unroll
            for (int j = 0; j < 8; ++j) Ub[v * 40 + 4 * j + p] = (bf16_t)f2bf(u[j]); } }
        __syncthreads();
        { RW_IDS const bf16x8 uf = ldsfrag(Ub, 40, vt * 16, 0, fr, fq);
          oacc = mfma16(ldsfrag(MbrT, 40, tt2 * 16, 0, fr, fq), uf, oacc);
#pragma unroll
          for (int e = 0; e < 4; ++e) { const int sidx = tt2 * 16 + fq * 4 + e, tok = dir ? 31 - sidx : sidx;
              ORW[(size_t)dir * T * 512 + ((size_t)b * SEQ + t0 + tok) * 512 + h * 64 + vt * 16 + fr] = (bf16_t)f2bf(oacc[e]); }
#pragma unroll
          for (int n2 = 0; n2 < 2; ++n2) { const int kt = tt2 * 2 + n2; st[n2] = mfma16(ldsfrag(BtT, 40, kt * 16, 0, fr, fq), uf, st[n2]);
              const f32x4 gl = *(const LAS f32x4*)(gL + kt * 16 + fq * 4); st[n2] = st[n2] * gl;
              u32x2 o; o.x = pk2(st[n2][0], st[n2][1]); o.y = pk2(st[n2][2], st[n2][3]); *(LAS u32x2*)(S0b + (vt * 16 + fr) * 72 + kt * 16 + fq * 4) = o; } }
    }
#undef RW_IDX
#undef RW_ISSUE
#undef RW_IDS
#undef RW_CG
    __syncthreads();
}

__device__ __forceinline__ void rwkv_combine(const bf16_t* P0, const bf16_t* ORW, const float* BONUS, const bf16_t* G, const float* mu, const float* gn_w, const float* gn_b, bf16_t* OMIX, int gw, int NGW, int lane) {
    const int c0 = lane * 8, head = lane >> 3;
    float muv[8], gw8[8], gb8[8];
#pragma unroll
    for (int i = 0; i < 8; ++i) { muv[i] = mu[1024 + c0 + i]; gw8[i] = gn_w[c0 + i]; gb8[i] = gn_b[c0 + i]; }
    for (int tk = gw; tk < T; tk += NGW) {
        const int t = tk & (SEQ - 1);
        const u32x4 uf = *(const u32x4*)(ORW + (size_t)tk * 512 + c0), ub = *(const u32x4*)(ORW + (size_t)T * 512 + (size_t)tk * 512 + c0);
        float o[8];
#pragma unroll
        for (int i = 0; i < 4; ++i) { o[2 * i] = bflo(uf[i]) + bflo(ub[i]); o[2 * i + 1] = bfhi(uf[i]) + bfhi(ub[i]); }
        float s = 0.f;
#pragma unroll
        for (int i = 0; i < 8; ++i) s += o[i];
        const float mean = sum8(s) * (1.f / 64.f); float q = 0.f;
#pragma unroll
        for (int i = 0; i < 8; ++i) { o[i] -= mean; q += o[i] * o[i]; }
        const float rstd = rsqrtf(sum8(q) * (1.f / 64.f) + 64e-5f);
        const bf16_t* pv = P0 + (size_t)tk * ABPAD + 1024 + c0;
        const u32x4 vc = *(const u32x4*)pv; u32x4 vp = (u32x4){0u, 0u, 0u, 0u}, vn = (u32x4){0u, 0u, 0u, 0u};
        if (t > 0) vp = *(const u32x4*)(pv - ABPAD);
        if (t < SEQ - 1) vn = *(const u32x4*)(pv + ABPAD);
        const u32x4 gg = *(const u32x4*)(G + (size_t)tk * 512 + c0);
        const float bon = BONUS[(size_t)tk * 8 + head];
        float r[8];
#pragma unroll
        for (int i = 0; i < 4; ++i) {
            const float c_lo = bflo(vc[i]), c_hi = bfhi(vc[i]);
            const float v_lo = c_lo + muv[2 * i] * (0.5f * (bflo(vp[i]) + bflo(vn[i])) - c_lo), v_hi = c_hi + muv[2 * i + 1] * (0.5f * (bfhi(vp[i]) + bfhi(vn[i])) - c_hi);
            r[2 * i] = (o[2 * i] * rstd * gw8[2 * i] + gb8[2 * i] + bon * v_lo) * bflo(gg[i]);
            r[2 * i + 1] = (o[2 * i + 1] * rstd * gw8[2 * i + 1] + gb8[2 * i + 1] + bon * v_hi) * bfhi(gg[i]); }
        u32x4 w; w.x = pk2(r[0], r[1]); w.y = pk2(r[2], r[3]); w.z = pk2(r[4], r[5]); w.w = pk2(r[6], r[7]);
        *(u32x4*)(OMIX + (size_t)tk * D + c0) = w;
    }
}

constexpr int SLD = 136;
__device__ __forceinline__ float softplusf_(float x) { return x > 20.f ? x : log1pf(__expf(x)); }
__device__ __forceinline__ void ssd_dt_cum(LAS float* dtS, LAS float* cumS, LAS float* totS, const bf16_t* Prow0, int g, int w, int lane, const float* dt_bias, const float* a_log) {
    const int j = w >> 1, d = w & 1, head = g * 4 + j;
    const float bias = dt_bias[d * 8 + head], A = -__expf(a_log[d * 8 + head]);
    const float x0 = bf2f(Prow0[(size_t)(2 * lane) * ABPAD + 3328 + head]), x1 = bf2f(Prow0[(size_t)(2 * lane + 1) * ABPAD + 3328 + head]);
    const float dt0 = softplusf_(x0 + bias), dt1 = softplusf_(x1 + bias), la0 = dt0 * A, la1 = dt1 * A;
    const float s = la0 + la1; float inc = s;
#pragma unroll
    for (int off = 1; off < 64; off <<= 1) { const float n = __shfl_up(inc, off); if (lane >= off) inc += n; }
    const float tot = __shfl(inc, 63), exc = inc - s;
    float c0, c1; if (d == 0) { c0 = exc + la0; c1 = inc; } else { c0 = tot - exc; c1 = tot - exc - la0; }
    dtS[w * 128 + 2 * lane] = dt0; dtS[w * 128 + 2 * lane + 1] = dt1; cumS[w * 128 + 2 * lane] = c0; cumS[w * 128 + 2 * lane + 1] = c1;
    if (lane == 0) totS[w] = tot;
}
template <int NR, bool TR> __device__ __forceinline__ void ssd_conv8(LAS bf16_t* dst, int col0, int cx0, int l0, const bf16_t* Pb, int t0, const float* cw, const float* cb) {
    u32x4 raw[NR + 2];
    const bf16_t* p = Pb + (size_t)(t0 + l0) * ABPAD + 2304 + cx0;
#pragma unroll
    for (int i = 0; i < NR + 2; ++i) { const int t = t0 + l0 + i - 1; raw[i] = (t >= 0 && t < SEQ) ? *(const u32x4*)(p + (long)(i - 1) * ABPAD) : (u32x4){0u, 0u, 0u, 0u}; }
    float w0[8], w1[8], w2[8], bs[8];
#pragma unroll
    for (int q = 0; q < 2; ++q) { const f32x4 a = *(const f32x4*)(cw + cx0 + 4 * q), bq = *(const f32x4*)(cw + 1024 + cx0 + 4 * q), c = *(const f32x4*)(cw + 2048 + cx0 + 4 * q), d = *(const f32x4*)(cb + cx0 + 4 * q);
#pragma unroll
        for (int i = 0; i < 4; ++i) { w0[4 * q + i] = a[i]; w1[4 * q + i] = bq[i]; w2[4 * q + i] = c[i]; bs[4 * q + i] = d[i]; } }
    float o[NR][8];
#pragma unroll
    for (int i = 0; i < NR; ++i)
#pragma unroll
        for (int c = 0; c < 8; ++c) { const unsigned um = raw[i][c >> 1], u0 = raw[i + 1][c >> 1], up = raw[i + 2][c >> 1];
            const float fm = (c & 1) ? bfhi(um) : bflo(um), f0 = (c & 1) ? bfhi(u0) : bflo(u0), fp = (c & 1) ? bfhi(up) : bflo(up);
            o[i][c] = siluf_(w0[c] * fm + w1[c] * f0 + w2[c] * fp + bs[c]); }
    if (TR) {
#pragma unroll
        for (int c = 0; c < 8; ++c) { LAS bf16_t* q = dst + (col0 + c) * SLD + l0;
            if (NR == 8) { u32x4 w; w.x = pk2(o[0][c], o[1][c]); w.y = pk2(o[2][c], o[3][c]); w.z = pk2(o[4 % NR][c], o[5 % NR][c]); w.w = pk2(o[6 % NR][c], o[7 % NR][c]); *(LAS u32x4*)q = w; }
            else { u32x2 w; w.x = pk2(o[0][c], o[1][c]); w.y = pk2(o[2][c], o[3][c]); *(LAS u32x2*)q = w; } }
    } else {
#pragma unroll
        for (int i = 0; i < NR; ++i) { u32x4 w; w.x = pk2(o[i][0], o[i][1]); w.y = pk2(o[i][2], o[i][3]); w.z = pk2(o[i][4], o[i][5]); w.w = pk2(o[i][6], o[i][7]); *(LAS u32x4*)(dst + (l0 + i) * SLD + col0) = w; }
    }
}
__device__ __forceinline__ void ssd_s1_unit(LAS unsigned char* lds, int unit, const bf16_t* P0, const float* cw, const float* cb, const float* dt_bias, const float* a_log, bf16_t* STATES, float* TOT) {
    const int tid = threadIdx.x, lane = tid & 63, w = tid >> 6, fr = lane & 15, fq = lane >> 4;
    const int g = unit & 1, c = (unit >> 1) & 31, b = unit >> 6, t0 = c * 128;
    LAS bf16_t* BT = (LAS bf16_t*)lds; LAS bf16_t* XT = (LAS bf16_t*)(lds + 34816); LAS float* dtS = (LAS float*)(lds + 104448); LAS float* cumS = (LAS float*)(lds + 108544);
    LAS float* scS = (LAS float*)(lds + 112640); LAS float* totS = (LAS float*)(lds + 116736);
    const bf16_t* Pb = P0 + (size_t)b * SEQ * ABPAD;
    __syncthreads();
    ssd_conv8<4, true>(BT, (tid & 15) * 8, 512 + g * 128 + (tid & 15) * 8, (tid >> 4) * 4, Pb, t0, cw, cb);
    ssd_conv8<8, true>(XT, (tid & 31) * 8, g * 256 + (tid & 31) * 8, (tid >> 5) * 8, Pb, t0, cw, cb);
    ssd_dt_cum(dtS, cumS, totS, Pb + (size_t)t0 * ABPAD, g, w, lane, dt_bias, a_log);
    __syncthreads();
    for (int e = tid; e < 1024; e += 512) scS[e] = dtS[e] * __expf(totS[e >> 7] - cumS[e]);
    if (tid < 8) TOT[((size_t)(b * 32 + c) * 2 + (tid & 1)) * 8 + g * 4 + (tid >> 1)] = totS[tid];
    __syncthreads();
    const int j = w >> 1;
#pragma unroll 1
    for (int d = 0; d < 2; ++d) {
        f32x4 acc[2][8];
#pragma unroll
        for (int mt = 0; mt < 2; ++mt)
#pragma unroll
            for (int nt = 0; nt < 8; ++nt) acc[mt][nt] = (f32x4){0.f, 0.f, 0.f, 0.f};
#pragma unroll 1
        for (int ks = 0; ks < 4; ++ks) {
            const int k0 = ks * 32; const LAS float* sp = scS + (j * 2 + d) * 128 + k0 + fq * 8;
            const f32x4 s0 = *(const LAS f32x4*)sp, s1 = *(const LAS f32x4*)(sp + 4);
            bf16x8 afr[2];
#pragma unroll
            for (int mt = 0; mt < 2; ++mt) { const u32x4 raw = *(const LAS u32x4*)(XT + (32 * w + mt * 16 + fr) * SLD + k0 + fq * 8); u32x4 o;
                o.x = pk2(bflo(raw.x) * s0[0], bfhi(raw.x) * s0[1]); o.y = pk2(bflo(raw.y) * s0[2], bfhi(raw.y) * s0[3]);
                o.z = pk2(bflo(raw.z) * s1[0], bfhi(raw.z) * s1[1]); o.w = pk2(bflo(raw.w) * s1[2], bfhi(raw.w) * s1[3]);
                afr[mt] = __builtin_bit_cast(bf16x8, o); }
#pragma unroll
            for (int nt = 0; nt < 8; ++nt) { const bf16x8 bfr = ldsfrag(BT, SLD, nt * 16, k0, fr, fq);
#pragma unroll
                for (int mt = 0; mt < 2; ++mt) acc[mt][nt] = mfma16(bfr, afr[mt], acc[mt][nt]); }
        }
        bf16_t* dst = STATES + (((size_t)(b * 32 + c) * 2 + d) * 8 + g * 4 + j) * 8192;
#pragma unroll
        for (int mt = 0; mt < 2; ++mt) { const int p = (w & 1) * 32 + mt * 16 + fr;
#pragma unroll
            for (int nt = 0; nt < 8; ++nt) { u32x2 o; o.x = pk2(acc[mt][nt][0], acc[mt][nt][1]); o.y = pk2(acc[mt][nt][2], acc[mt][nt][3]);
                *(u32x2*)(dst + p * 128 + nt * 16 + fq * 4) = o; } }
    }
}
__device__ __forceinline__ void ssd_s2(const bf16_t* __restrict__ STATES, bf16_t* __restrict__ CARR, const float* __restrict__ TOT, int gtid, int NGT) {
    for (int it = gtid; it < 16 * 2 * 8 * 1024; it += NGT) {
        const int e8 = it & 1023, head = (it >> 10) & 7, d = (it >> 13) & 1, b = it >> 14;
        float run[8];
#pragma unroll
        for (int i = 0; i < 8; ++i) run[i] = 0.f;
#pragma unroll 1
        for (int c8 = 0; c8 < 32; c8 += 8) {
            u32x4 loc[8]; float dec[8];
#pragma unroll
            for (int q = 0; q < 8; ++q) { const int cc = c8 + q, c = d ? 31 - cc : cc; const size_t sidx = ((size_t)(b * 32 + c) * 2 + d) * 8 + head;
                loc[q] = *(const u32x4*)(STATES + sidx * 8192 + e8 * 8); dec[q] = TOT[sidx]; }
#pragma unroll
            for (int q = 0; q < 8; ++q) { const int cc = c8 + q, c = d ? 31 - cc : cc; const size_t sidx = ((size_t)(b * 32 + c) * 2 + d) * 8 + head;
                u32x4 o; o.x = pk2(run[0], run[1]); o.y = pk2(run[2], run[3]); o.z = pk2(run[4], run[5]); o.w = pk2(run[6], run[7]); *(u32x4*)(CARR + sidx * 8192 + e8 * 8) = o;
                const float dq = __expf(dec[q]);
#pragma unroll
                for (int i = 0; i < 4; ++i) { run[2 * i] = run[2 * i] * dq + bflo(loc[q][i]); run[2 * i + 1] = run[2 * i + 1] * dq + bfhi(loc[q][i]); } }
        }
    }
}
__device__ __forceinline__ void ssd_s3_unit(LAS unsigned char* lds, int unit, const bf16_t* P0, const float* cw, const float* cb, const float* dt_bias, const float* a_log, const float* dskip, const float* norm_w,
                                            const bf16_t* STATES, bf16_t* OMIX) {
    const int tid = threadIdx.x, lane = tid & 63, w = tid >> 6, fr = lane & 15, fq = lane >> 4;
    const int g = unit & 1, c = (unit >> 1) & 31, b = unit >> 6, t0 = c * 128;
    LAS bf16_t* CS = (LAS bf16_t*)lds; LAS bf16_t* BS = (LAS bf16_t*)(lds + 34816); LAS bf16_t* XT = (LAS bf16_t*)(lds + 69632);
    LAS float* dtS = (LAS float*)(lds + 139264); LAS float* cumS = (LAS float*)(lds + 143360); LAS float* totS = (LAS float*)(lds + 147456);
    const bf16_t* Pb = P0 + (size_t)b * SEQ * ABPAD;
    __syncthreads();
    ssd_conv8<4, false>(BS, (tid & 15) * 8, 512 + g * 128 + (tid & 15) * 8, (tid >> 4) * 4, Pb, t0, cw, cb);
    ssd_conv8<4, false>(CS, (tid & 15) * 8, 768 + g * 128 + (tid & 15) * 8, (tid >> 4) * 4, Pb, t0, cw, cb);
    ssd_conv8<8, true>(XT, (tid & 31) * 8, g * 256 + (tid & 31) * 8, (tid >> 5) * 8, Pb, t0, cw, cb);
    ssd_dt_cum(dtS, cumS, totS, Pb + (size_t)t0 * ABPAD, g, w, lane, dt_bias, a_log);
    __syncthreads();
    const int l = 16 * w + fr;
    f32x4 sc[8];
#pragma unroll
    for (int nt = 0; nt < 8; ++nt) sc[nt] = (f32x4){0.f, 0.f, 0.f, 0.f};
#pragma unroll
    for (int ks = 0; ks < 4; ++ks) { const bf16x8 afr = ldsfrag(CS, SLD, 16 * w, ks * 32, fr, fq);
#pragma unroll
        for (int nt = 0; nt < 8; ++nt) sc[nt] = mfma16(ldsfrag(BS, SLD, nt * 16, ks * 32, fr, fq), afr, sc[nt]); }
    __syncthreads();
    LAS bf16_t* Mw = BS + w * 16 * SLD;
    const size_t row = (size_t)b * SEQ + t0 + l; float ss = 0.f;
#pragma unroll 1
    for (int j = 0; j < 4; ++j) {
        const LAS float* cf = cumS + (j * 2) * 128; const LAS float* cbw = cumS + (j * 2 + 1) * 128; const LAS float* df = dtS + (j * 2) * 128; const LAS float* db = dtS + (j * 2 + 1) * 128;
        const float cfl = cf[l], cbl = cbw[l];
        const size_t sbase = ((size_t)(b * 32 + c) * 2) * 8 + g * 4 + j;
        const bf16_t* carf = STATES + sbase * 8192; const bf16_t* carb = STATES + (sbase + 8) * 8192;
        bf16x8 cF[4][4], cB[4][4]; u32x2 zz4[4];
#pragma unroll
        for (int ks = 0; ks < 4; ++ks)
#pragma unroll
            for (int pt = 0; pt < 4; ++pt) cF[ks][pt] = *(const bf16x8*)(carf + (pt * 16 + fr) * 128 + ks * 32 + fq * 8);
#pragma unroll
        for (int pt = 0; pt < 4; ++pt) zz4[pt] = *(const u32x2*)(P0 + row * ABPAD + 1792 + g * 256 + j * 64 + pt * 16 + fq * 4);
#pragma unroll
        for (int nt = 0; nt < 8; ++nt) { float mv[4];
#pragma unroll
            for (int i = 0; i < 4; ++i) { const int s = nt * 16 + fq * 4 + i;
                const float ff = (s <= l) ? __expf(cfl - cf[s]) * df[s] : 0.f; const float fb = (s >= l) ? __expf(cbl - cbw[s]) * db[s] : 0.f;
                mv[i] = sc[nt][i] * (ff + fb); }
            u32x2 o; o.x = pk2(mv[0], mv[1]); o.y = pk2(mv[2], mv[3]); *(LAS u32x2*)(Mw + fr * SLD + nt * 16 + fq * 4) = o; }
        LDS_WAIT();
#pragma unroll
        for (int ks = 0; ks < 4; ++ks)
#pragma unroll
            for (int pt = 0; pt < 4; ++pt) cB[ks][pt] = *(const bf16x8*)(carb + (pt * 16 + fr) * 128 + ks * 32 + fq * 8);
        f32x4 yd[4], yf[4], yb[4];
#pragma unroll
        for (int pt = 0; pt < 4; ++pt) { yd[pt] = (f32x4){0.f, 0.f, 0.f, 0.f}; yf[pt] = yd[pt]; yb[pt] = yd[pt]; }
        bf16x8 acs[4];
#pragma unroll
        for (int ks = 0; ks < 4; ++ks) {
            const bf16x8 am = *(const LAS bf16x8*)(Mw + fr * SLD + ks * 32 + fq * 8); acs[ks] = ldsfrag(CS, SLD, 16 * w, ks * 32, fr, fq);
#pragma unroll
            for (int pt = 0; pt < 4; ++pt) {
                yd[pt] = mfma16(ldsfrag(XT, SLD, j * 64 + pt * 16, ks * 32, fr, fq), am, yd[pt]);
                yf[pt] = mfma16(cF[ks][pt], acs[ks], yf[pt]); }
        }
#pragma unroll
        for (int ks = 0; ks < 4; ++ks)
#pragma unroll
            for (int pt = 0; pt < 4; ++pt) yb[pt] = mfma16(cB[ks][pt], acs[ks], yb[pt]);
        const float ef = __expf(cfl), eb = __expf(cbl), dsk = dskip[g * 4 + j];
#pragma unroll
        for (int pt = 0; pt < 4; ++pt) { const f32x4 yv = yd[pt] + yf[pt] * ef + yb[pt] * eb;
            const int col = j * 64 + pt * 16 + fq * 4; const u32x2 zz = zz4[pt];
            const float z4[4] = {bflo(zz.x), bfhi(zz.x), bflo(zz.y), bfhi(zz.y)}; float v4[4];
#pragma unroll
            for (int i = 0; i < 4; ++i) { const float xs = bf2f(XT[(col + i) * SLD + l]); float v = yv[i] + dsk * xs; const float z = z4[i]; v = v * siluf_(z);
                v4[i] = v; ss += v * v; }
            u32x2 o; o.x = pk2(v4[0], v4[1]); o.y = pk2(v4[2], v4[3]); *(u32x2*)(OMIX + row * D + 512 + g * 256 + col) = o; }
        asm volatile("" ::: "memory");
    }
    ss += __shfl_xor(ss, 16); ss += __shfl_xor(ss, 32);
    const float rs = rsqrtf(ss * (1.f / 256.f) + 1e-6f);
    asm volatile("s_waitcnt vmcnt(0)" ::: "memory");
#pragma unroll 4
    for (int q = 0; q < 16; ++q) { const int col = g * 256 + q * 16 + fq * 4; const f32x4 nw = *(const f32x4*)(norm_w + col);
        u32x2* p = (u32x2*)(OMIX + row * D + 512 + col); const u32x2 v = *p;
        u32x2 o; o.x = pk2(bflo(v.x) * rs * nw[0], bfhi(v.x) * rs * nw[1]); o.y = pk2(bflo(v.y) * rs * nw[2], bfhi(v.y) * rs * nw[3]); *p = o; }
}

constexpr int HLD = 136, HLS = 72;
__device__ __forceinline__ void hgrn_chain(LAS unsigned char* lds, int cid, bf16_t* P1, const float* hg_lb, bf16_t* Ob, int ldo, int ocbase, int ocdir) {
    const int tid = threadIdx.x, lane = tid & 63, w = tid >> 6, fr = lane & 15, fq = lane >> 4;
    const int b = cid >> 4, h = (cid >> 1) & 7, dir = cid & 1;
    LAS bf16_t* QE = (LAS bf16_t*)lds;
    LAS bf16_t* KE = (LAS bf16_t*)(lds + 17408);
    LAS bf16_t* KLT = (LAS bf16_t*)(lds + 34816);
    LAS bf16_t* VT = (LAS bf16_t*)(lds + 53248);
    LAS bf16_t* AT = (LAS bf16_t*)(lds + 71680);
    LAS bf16_t* ST = (LAS bf16_t*)(lds + 80896);
    LAS float* totS = (LAS float*)(lds + 115712);
    LAS float* lastS = (LAS float*)(lds + 117760);
    __syncthreads();
    for (int e = tid; e < 128 * HLD / 2; e += 512) ((LAS unsigned*)ST)[e] = 0u;
    const int dcol = tid & 127, qtr = tid >> 7, i0 = qtr * 16;
    const float lbv = frcp(1.0f + __expf(hg_lb[h * 128 + dcol] - hg_lb[1024 + h * 128 + dcol]));
    f32x4 st[8];
#pragma unroll
    for (int i = 0; i < 8; ++i) st[i] = (f32x4){0.f, 0.f, 0.f, 0.f};
    bf16_t* Pb = P1 + (size_t)b * SEQ * HGP;
    __syncthreads();
    unsigned short rq[16], rf[16], rv[16];
#define HG_ISSUE(t0n) do { _Pragma("unroll") for (int i = 0; i < 16; ++i) { const int tk = (t0n) + (dir ? 63 - (i0 + i) : (i0 + i)); const bf16_t* pr = Pb + (size_t)tk * HGP + h * 128 + dcol; \
        rq[i] = pr[0]; rf[i] = pr[1024 * (1 + dir)]; rv[i] = pr[3072]; } } while (0)
    HG_ISSUE((dir ? 63 : 0) * 64);
    for (int cc = 0; cc < 64; ++cc) {
        const int t0 = (dir ? 63 - cc : cc) * 64;
        float gq[16], gk[16], gc[16]; float run = 0.f;
#pragma unroll
        for (int i = 0; i < 16; ++i) { const float q = bf2f(rq[i]), fr_ = bf2f(rf[i]);
            const float f = lbv + (1.0f - lbv) * sigmoidf_(fr_); run += __logf(f); gq[i] = q; gk[i] = 1.0f - f; gc[i] = run; }
        totS[qtr * 128 + dcol] = run;
#pragma unroll
        for (int i = 0; i < 16; i += 2) *(LAS unsigned*)(VT + dcol * HLS + i0 + i) = (unsigned)rv[i] | ((unsigned)rv[i + 1] << 16);
        __syncthreads();
        { float pre = 0.f, tot = 0.f;
#pragma unroll
          for (int q4 = 0; q4 < 4; ++q4) { const float tq = totS[q4 * 128 + dcol]; if (q4 < qtr) pre += tq; tot += tq; }
          const float etot = __expf(tot);
          if (qtr == 0) lastS[dcol] = etot;
#pragma unroll
          for (int i = 0; i < 16; i += 2) { const float b0 = pre + gc[i], b1 = pre + gc[i + 1];
              const float e0 = __expf(b0), e1 = __expf(b1), n0 = frcp(e0), n1 = frcp(e1), l0 = etot * n0, l1 = etot * n1;
              QE[(i0 + i) * HLD + dcol] = (bf16_t)f2bf(gq[i] * e0); QE[(i0 + i + 1) * HLD + dcol] = (bf16_t)f2bf(gq[i + 1] * e1);
              KE[(i0 + i) * HLD + dcol] = (bf16_t)f2bf(gk[i] * n0); KE[(i0 + i + 1) * HLD + dcol] = (bf16_t)f2bf(gk[i + 1] * n1);
              *(LAS unsigned*)(KLT + dcol * HLS + i0 + i) = pk2(gk[i] * l0, gk[i + 1] * l1); } }
        if (cc + 1 < 64) HG_ISSUE((dir ? 62 - cc : cc + 1) * 64);
        __syncthreads();
        { const int mt = w >> 1;
#pragma unroll
          for (int n2 = 0; n2 < 2; ++n2) { const int nt = (w & 1) * 2 + n2; f32x4 acc = (f32x4){0.f, 0.f, 0.f, 0.f};
#pragma unroll
              for (int ks = 0; ks < 4; ++ks) acc = mfma16(ldsfrag(KE, HLD, nt * 16, ks * 32, fr, fq), ldsfrag(QE, HLD, mt * 16, ks * 32, fr, fq), acc);
              const int lrow = mt * 16 + fr; float mv[4];
#pragma unroll
              for (int i = 0; i < 4; ++i) { const int s = nt * 16 + fq * 4 + i; mv[i] = (s <= lrow) ? acc[i] : 0.f; }
              u32x2 o; o.x = pk2(mv[0], mv[1]); o.y = pk2(mv[2], mv[3]); *(LAS u32x2*)(AT + lrow * HLS + nt * 16 + fq * 4) = o; } }
        __syncthreads();
        { const int mt = w >> 1;
#pragma unroll
          for (int n4 = 0; n4 < 4; ++n4) { const int nt = (w & 1) * 4 + n4; f32x4 acc = (f32x4){0.f, 0.f, 0.f, 0.f};
#pragma unroll
              for (int ks = 0; ks < 2; ++ks) acc = mfma16(ldsfrag(VT, HLS, nt * 16, ks * 32, fr, fq), ldsfrag(AT, HLS, mt * 16, ks * 32, fr, fq), acc);
#pragma unroll
              for (int ks = 0; ks < 4; ++ks) acc = mfma16(ldsfrag(ST, HLD, nt * 16, ks * 32, fr, fq), ldsfrag(QE, HLD, mt * 16, ks * 32, fr, fq), acc);
              const int i = mt * 16 + fr, tk = t0 + (dir ? 63 - i : i);
              u32x2 o; o.x = pk2(acc[0], acc[1]); o.y = pk2(acc[2], acc[3]);
              *(u32x2*)(Ob + ((size_t)b * SEQ + tk) * ldo + ocbase + ocdir * dir + h * 128 + nt * 16 + fq * 4) = o; } }
#pragma unroll
        for (int nt = 0; nt < 8; ++nt) { const f32x4 el = *(const LAS f32x4*)(lastS + nt * 16 + fq * 4); st[nt] = st[nt] * el;
#pragma unroll
            for (int ks = 0; ks < 2; ++ks) st[nt] = mfma16(ldsfrag(KLT, HLS, nt * 16, ks * 32, fr, fq), ldsfrag(VT, HLS, w * 16, ks * 32, fr, fq), st[nt]); }
        __syncthreads();
#pragma unroll
        for (int nt = 0; nt < 8; ++nt) { u32x2 o; o.x = pk2(st[nt][0], st[nt][1]); o.y = pk2(st[nt][2], st[nt][3]); *(LAS u32x2*)(ST + (w * 16 + fr) * HLD + nt * 16 + fq * 4) = o; }
    }
    __syncthreads();
}
__device__ __forceinline__ void hgrn_combine(const bf16_t* P1, const float* norm_w, bf16_t* OMIX, int gw, int NGW, int lane) {
    const int c0 = lane * 16;
    for (int tk = gw; tk < T; tk += NGW) {
        const bf16_t* pr = P1 + (size_t)tk * HGP + c0; float o[16]; float ss = 0.f;
#pragma unroll
        for (int hh = 0; hh < 2; ++hh) { const u32x4 uf = *(const u32x4*)(pr + 1024 + hh * 8), ub = *(const u32x4*)(pr + 2048 + hh * 8);
#pragma unroll
            for (int i = 0; i < 4; ++i) { o[hh * 8 + 2 * i] = bflo(uf[i]) + bflo(ub[i]); o[hh * 8 + 2 * i + 1] = bfhi(uf[i]) + bfhi(ub[i]); } }
#pragma unroll
        for (int i = 0; i < 16; ++i) ss += o[i] * o[i];
        const float rs = rsqrtf(sum8(ss) * (1.f / 128.f) + 1e-6f);
#pragma unroll
        for (int hh = 0; hh < 2; ++hh) { const u32x4 ug = *(const u32x4*)(pr + 4096 + hh * 8); float r[8];
#pragma unroll
            for (int i = 0; i < 4; ++i) { const float g0 = bflo(ug[i]), g1 = bfhi(ug[i]);
                r[2 * i] = o[hh * 8 + 2 * i] * rs * norm_w[c0 + hh * 8 + 2 * i] * siluf_(g0);
                r[2 * i + 1] = o[hh * 8 + 2 * i + 1] * rs * norm_w[c0 + hh * 8 + 2 * i + 1] * siluf_(g1); }
            u32x4 wv; wv.x = pk2(r[0], r[1]); wv.y = pk2(r[2], r[3]); wv.z = pk2(r[4], r[5]); wv.w = pk2(r[6], r[7]);
            *(u32x4*)(OMIX + (size_t)tk * D + c0 + hh * 8) = wv; }
    }
}

#define XB_TMO      128
#define XB_XCNT(j)  (256  + 64 * (j))
#define XB_XSUB(j)  (1280 + 64 * (j))
#define XB_XGEN(j)  (2304 + 64 * (j))
#define XB_TOP      3328
#define XB_TOPGEN   3392
#define XCD_BAR_WORDS 3456
#define XB_SPIN_CAP (1u << 18)

__device__ __forceinline__ unsigned xb_ld(unsigned* p)              { return __hip_atomic_load(p, __ATOMIC_RELAXED, __HIP_MEMORY_SCOPE_AGENT); }
__device__ __forceinline__ unsigned xb_add(unsigned* p, unsigned v) { return __hip_atomic_fetch_add(p, v, __ATOMIC_RELAXED, __HIP_MEMORY_SCOPE_AGENT); }
__device__ __forceinline__ unsigned xb_xcc_id() { return (unsigned)__builtin_amdgcn_s_getreg((3 << 11) | 20) & 0xFu; }
#define XB_SPIN(cond, bar) do { unsigned _sp = 0; while (cond) { __builtin_amdgcn_s_sleep(1); \
    if ((++_sp & 255u) == 0u) { if (xb_ld(&(bar)[XB_TMO])) break; if (_sp > XB_SPIN_CAP) { atomicAdd(&(bar)[XB_TMO], 1u); break; } } } } while (0)

struct XcdBarrier {
    unsigned* bar; unsigned x;
    volatile LAS unsigned* st;
};

__device__ __forceinline__ XcdBarrier xcd_barrier_post(unsigned* bar, volatile LAS unsigned* st) {
    XcdBarrier b; b.bar = bar; b.x = xb_xcc_id(); b.st = st;
    if (threadIdx.x == 0) (void)xb_add(&bar[XB_XCNT(b.x)], 1u);
    return b;
}
__device__ __forceinline__ void xcd_barrier_complete(unsigned* bar, unsigned x, unsigned& nloc, unsigned& nx) {
    const unsigned G = gridDim.x * gridDim.y * gridDim.z;
    unsigned sum, cnt, mine, sp = 0u;
    for (;;) {
        sum = 0u; cnt = 0u; mine = 0u;
#pragma unroll
        for (unsigned j = 0; j < 16; ++j) { const unsigned c = xb_ld(&bar[XB_XCNT(j)]); sum += c; cnt += (c > 0u) ? 1u : 0u; mine = (j == x) ? c : mine; }
        if (sum == G) break;
        __builtin_amdgcn_s_sleep(1);
        if ((++sp & 255u) == 0u) { if (xb_ld(&bar[XB_TMO])) break; if (sp > XB_SPIN_CAP) { atomicAdd(&bar[XB_TMO], 1u); break; } }
    }
    nloc = mine > 0u ? mine : 1u; nx = cnt > 0u ? cnt : 1u;
}

__device__ __forceinline__ void xcd_barrier(const XcdBarrier& b) {
    asm volatile("s_waitcnt vmcnt(0)" ::: "memory");
    __syncthreads();
    if (threadIdx.x == 0) {
        unsigned* bar = b.bar;
        __builtin_amdgcn_s_waitcnt(0);
        unsigned nloc = b.st[0], nx = b.st[1];
        if (nloc == 0u) { xcd_barrier_complete(bar, b.x, nloc, nx); b.st[0] = nloc; b.st[1] = nx; }
        const unsigned old = xb_add(&bar[XB_XSUB(b.x)], 1u);
        const unsigned gen = old / nloc;
        if (old + 1u == (gen + 1u) * nloc) {
            __builtin_amdgcn_fence(__ATOMIC_RELEASE, "agent");
            asm volatile("s_waitcnt vmcnt(0)" ::: "memory");
            const unsigned og = xb_add(&bar[XB_TOP], 1u);
            const unsigned tg = og / nx;
            if (og + 1u == (tg + 1u) * nx) xb_add(&bar[XB_TOPGEN], 1u);
            else XB_SPIN(xb_ld(&bar[XB_TOPGEN]) == tg, bar);
            __builtin_amdgcn_fence(__ATOMIC_ACQUIRE, "agent");
            xb_add(&bar[XB_XGEN(b.x)], 1u);
            asm volatile("s_waitcnt vmcnt(0)" ::: "memory");
        } else {
            XB_SPIN(xb_ld(&bar[XB_XGEN(b.x)]) == gen, bar);
            __builtin_amdgcn_fence(__ATOMIC_ACQUIRE, "agent");
            asm volatile("s_waitcnt vmcnt(0)" ::: "memory");
        }
    }
    __syncthreads();
}


struct Args { const float* in[35]; float* out; unsigned char* ws; int ph_lo, ph_hi; };
static_assert(sizeof(Args) == 304, "Args layout");

__global__ void __launch_bounds__(512, 2) mk_fwd(Args args) {
    extern __shared__ __attribute__((aligned(16))) unsigned char lds_raw[];
    LAS unsigned char* lds = (LAS unsigned char*)lds_raw; LAS unsigned char* xl = lds + XLDS_OFF;
    const int G = gridDim.x, bx = blockIdx.x, NGW = G * 8;
#define LOCAL_IDS int tid = threadIdx.x; asm volatile("" : "+v"(tid)); const int lane = tid & 63, wave = __builtin_amdgcn_readfirstlane(tid >> 6), gw = bx * 8 + wave; (void)lane; (void)gw;
    typedef const __attribute__((address_space(4))) unsigned char* kaptr_t;
    kaptr_t ka = (kaptr_t)__builtin_amdgcn_kernarg_segment_ptr();
#define INP(k) (*(const float* const volatile __attribute__((address_space(4)))*)(ka + 8 * (k)))
    unsigned char* ws = *(unsigned char* const volatile __attribute__((address_space(4)))*)(ka + 288); float* out = *(float* const volatile __attribute__((address_space(4)))*)(ka + 280);
    const float* x = INP(0);
    bf16_t* WAB = (bf16_t*)(ws + WS_WAB); bf16_t* WABO = (bf16_t*)(ws + WS_WABO); bf16_t* WHG = (bf16_t*)(ws + WS_WHG); bf16_t* WHGO = (bf16_t*)(ws + WS_WHGO);
    bf16_t* WQ = (bf16_t*)(ws + WS_WQ); bf16_t* WKV = (bf16_t*)(ws + WS_WKV); bf16_t* WO = (bf16_t*)(ws + WS_WO); bf16_t* WF1 = (bf16_t*)(ws + WS_WF1); bf16_t* WF2 = (bf16_t*)(ws + WS_WF2);
    bf16_t* G2T = (bf16_t*)(ws + WS_G2T); bf16_t* MEMN = (bf16_t*)(ws + WS_MEMN); bf16_t* KMEM = (bf16_t*)(ws + WS_KMEM); bf16_t* VT = (bf16_t*)(ws + WS_VT);
    bf16_t* H = (bf16_t*)(ws + WS_H); bf16_t* P = (bf16_t*)(ws + WS_P); bf16_t* PATT = (bf16_t*)(ws + WS_PATT); bf16_t* OMIX0 = (bf16_t*)(ws + WS_OMIX0); bf16_t* OMIX1 = (bf16_t*)(ws + WS_OMIX1); float* PSB = (float*)(ws + WS_PS);
#define COMMA ,
    bf16_t* STATES = (bf16_t*)((unsigned char*)out + DO_STATES); bf16_t* GG = (bf16_t*)((unsigned char*)out + DO_G); bf16_t* SG = (bf16_t*)((unsigned char*)out + DO_SG);
    float* BONUS = (float*)((unsigned char*)out + DO_BONUS); float* TOT = (float*)((unsigned char*)out + DO_TOT);
    cg::grid_group grid = cg::this_grid();
    { volatile LAS unsigned* st_ = (volatile LAS unsigned*)(lds + LDS_BYTES - 16); if (threadIdx.x < 4) st_[threadIdx.x] = 0u; }
    __syncthreads();
    const XcdBarrier xbar = xcd_barrier_post((unsigned*)ws, (volatile LAS unsigned*)(lds + LDS_BYTES - 16));
    const int lo = *(const int volatile __attribute__((address_space(4)))*)(ka + 296), hi = *(const int volatile __attribute__((address_space(4)))*)(ka + 300);
#ifndef PH_EN
#define PH_EN(k) 1
#endif
#define IN(k) (PH_EN(k) && lo <= (k) && (k) < hi)
#ifndef DUP_MASK
#define DUP_MASK 0ull
#endif
#define REPS(k) (1 + (int)(((unsigned long long)(DUP_MASK) >> (k)) & 1ull))
#define PHASE(k) for (int rep_ = 0; rep_ < (IN(k) ? REPS(k) : 0); ++rep_, ((REPS(k) > 1) ? (grid.sync(), 0) : 0))
#define SEAM(k) do { if (IN(k) && IN((k) + 1)) { if ((k) == 0) grid.sync(); else xcd_barrier(xbar); } } while (0)
#define RUN_GEMM(EPI, ALIGN, gd, ep) do { pg8::Order S_; S_.init(gd, G, bx); pg8::gemm_phase<EPI, ALIGN>(lds, xl, gd, S_, ep); } while (0)

    PHASE(0) { LOCAL_IDS
        LAS float* scr = (LAS float*)(lds + wave * 16384);
        constexpr int I_AB = 16 * 112, I_SQ = 16 * 32, I_HG = 16 * 160, I_KV = 16 * 64, I_F1 = 16 * 176, I_F2 = 44 * 32, I_G2 = 2 * 16;
        constexpr int NIT = I_AB + I_SQ + I_HG + I_SQ + 2 * I_SQ + 2 * I_KV + 2 * I_SQ + 2 * I_F1 + 2 * I_F2 + I_G2;
        for (int it = gw; it < NIT; it += NGW) {
            int r = it;
            if (r < I_AB) { transpose_item<0>(INP(3), 1024, ABP, WAB, scr, r, 112, lane); continue; } r -= I_AB;
            if (r < I_SQ) { transpose_item<0>(INP(4), 1024, 1024, WABO, scr, r, 32, lane); continue; } r -= I_SQ;
            if (r < I_HG) { transpose_item<0>(INP(22), 1024, HGP, WHG, scr, r, 160, lane, INP(2) + D); continue; } r -= I_HG;
            if (r < I_SQ) { transpose_item<0>(INP(23), 1024, 1024, WHGO, scr, r, 32, lane); continue; } r -= I_SQ;
            if (r < 2 * I_SQ) { const int l = r / I_SQ; transpose_item<0>(INP(28) + (size_t)l * D * D, 1024, 1024, WQ + (size_t)l * D * D, scr, r % I_SQ, 32, lane, INP(26) + l * D); continue; } r -= 2 * I_SQ;
            if (r < 2 * I_KV) { const int l = r / I_KV; transpose_item<0>(INP(29) + (size_t)l * D * 2048, 1024, 2048, WKV + (size_t)l * D * 2048, scr, r % I_KV, 64, lane); continue; } r -= 2 * I_KV;
            if (r < 2 * I_SQ) { const int l = r / I_SQ; transpose_item<0>(INP(30) + (size_t)l * D * D, 1024, 1024, WO + (size_t)l * D * D, scr, r % I_SQ, 32, lane); continue; } r -= 2 * I_SQ;
            if (r < 2 * I_F1) { const int l = r / I_F1; transpose_item<1>(INP(32) + (size_t)l * D * 2 * FFN, 1024, 2 * FFN, WF1 + (size_t)l * D * 2 * FFN, scr, r % I_F1, 176, lane, INP(31) + l * D); continue; } r -= 2 * I_F1;
            if (r < 2 * I_F2) { const int l = r / I_F2; transpose_item<0>(INP(33) + (size_t)l * FFN * D, FFN, 1024, WF2 + (size_t)l * FFN * D, scr, r % I_F2, 32, lane); continue; } r -= 2 * I_F2;
            transpose_item<0>(INP(10), 128, 512, G2T, scr, r, 16, lane);
        }
        rms_rows_phase(x, INP(2), H, T, gw, NGW, lane);
        for (int m = gw; m < 2 * 4096; m += NGW) { const int l = m >> 12, r = m & 4095; rms_row_bf16(INP(1) + (size_t)r * D, INP(27) + l * D, MEMN + (size_t)m * D, lane); }
        __syncthreads();
    }
    SEAM(0);
    PHASE(1) {
        { pg8::Gemm g = pg8::make_gemm(H, WAB, T, ABPAD, 1024, 1024, 1024); pg8::EpiBf16 E{P, ABPAD, 1.0f, nullptr}; RUN_GEMM(pg8::EpiBf16, true, g, E); }
        { pg8::Gemm g = pg8::make_gemm(MEMN, WKV, 4096, 1024, 1024, 1024, 1024); g.nZ = 2; g.sAo = 4096L * D; g.sBo = 2048L * D; g.sCo = 4096L * D; pg8::EpiBf16 E{KMEM, 1024, 1.0f, nullptr}; RUN_GEMM(pg8::EpiBf16, true, g, E); }
        { pg8::Gemm g = pg8::make_gemm(WKV + (size_t)1024 * D, MEMN, 1024, 4096, 1024, 1024, 1024); g.nZ = 2; g.sAo = 2048L * D; g.sBo = 4096L * D; g.sCo = 4096L * D; pg8::EpiBf16 E{VT, 4096, 1.0f, nullptr}; RUN_GEMM(pg8::EpiBf16, true, g, E); }
    }
    SEAM(1);
    PHASE(2) {
#ifndef DUP_RWKV
#define DUP_RWKV 0
#endif
#ifndef DUP_S1
#define DUP_S1 0
#endif
        for (int r2 = 0; r2 <= DUP_RWKV; ++r2)
        for (int cid = bx; cid < 256; cid += G)
            rwkv_chain(lds, cid, P, INP(5), INP(6), INP(7), INP(8), INP(9), INP(11), INP(12), INP(13), H, SG, BONUS);
        for (int r2 = 0; r2 <= DUP_S1; ++r2)
        for (int u = bx; u < 1024; u += G) ssd_s1_unit(lds, u, P, INP(16), INP(17), INP(18), INP(19), STATES, TOT);
        __syncthreads();
    }
    SEAM(2);
    PHASE(3) {
        { int k128 = 128; asm volatile("" : "+s"(k128)); pg8::Gemm g = pg8::make_gemm(SG, G2T, T, 512, k128, 128, 128); pg8::EpiBf16 E{GG, 512, 1.0f, nullptr}; RUN_GEMM(pg8::EpiBf16, true, g, E); }
        { LOCAL_IDS ssd_s2(STATES, OMIX1, TOT, bx * 512 + tid, G * 512); }
    }
    SEAM(3);
    PHASE(4) {
#ifndef DUP_S3
#define DUP_S3 0
#endif
        for (int r2 = 0; r2 <= DUP_S3; ++r2)
        for (int u = bx; u < 1024; u += G) ssd_s3_unit(lds, u, P, INP(16), INP(17), INP(18), INP(19), INP(20), INP(21), OMIX1, OMIX0);
        __syncthreads();
        { LOCAL_IDS rwkv_combine(P, H, BONUS, GG, INP(5), INP(14), INP(15), OMIX0, gw, NGW, lane); }
    }
    SEAM(4);
    PHASE(5) { pg8::Gemm g = pg8::make_gemm(OMIX0, WABO, T, 1024, 1024, 1024, 1024); pg8::EpiResidB E{x, H, PSB, 1024}; RUN_GEMM(pg8::EpiResidB, true, g, E); }
    SEAM(5);

#define ATTN_FFN(base, L, LASTEPI) \
    PHASE(base) { pg8::Gemm g = pg8::make_gemm(H, WQ + (size_t)(L) * D * D, T, 1024, 1024, 1024, 1024); pg8::EpiBf16 E{P, 1024, 0.0625f, PSB}; RUN_GEMM(pg8::EpiBf16, true, g, E); } \
    SEAM(base); \
    PHASE(base + 1) { pg8::Gemm g = pg8::make_gemm(P, KMEM + (size_t)(L) * 4096 * D, SEQ, 256, 256, 1024, 1024); g.nZ = 64; g.zdiv = 4; \
        g.sAo = (long)SEQ * D; g.sAi = 256; g.sBo = 256L * D; g.sBi = 256; g.sCo = (long)SEQ * D; g.sCi = 256; pg8::EpiSoftmax E{PATT, 1024}; RUN_GEMM(pg8::EpiSoftmax, true, g, E); } \
    SEAM(base + 1); \
    PHASE(base + 2) { pg8::Gemm g = pg8::make_gemm(PATT, VT + (size_t)(L) * 4096 * D, SEQ, 256, 256, 1024, 4096); g.nZ = 64; g.zdiv = 4; \
        g.sAo = (long)SEQ * D; g.sAi = 256; g.sBo = 256; g.sBi = 256L * 4096; g.sCo = (long)SEQ * D; g.sCi = 256; pg8::EpiBf16 E{P, 1024, 1.0f, nullptr}; RUN_GEMM(pg8::EpiBf16, true, g, E); } \
    SEAM(base + 2); \
    PHASE(base + 3) { pg8::Gemm g = pg8::make_gemm(P, WO + (size_t)(L) * D * D, T, 1024, 1024, 1024, 1024); pg8::EpiResidB E{nullptr, H, PSB, 1024}; RUN_GEMM(pg8::EpiResidB, true, g, E); } \
    SEAM(base + 3); \
    PHASE(base + 4) { pg8::Gemm g = pg8::make_gemm(H, WF1 + (size_t)(L) * D * 2 * FFN, T, 2 * FFN, 1024, 1024, 1024); pg8::EpiSwiglu E{P, FFN, PSB}; RUN_GEMM(pg8::EpiSwiglu, true, g, E); } \
    SEAM(base + 4); \
    PHASE(base + 5) { pg8::Gemm g = pg8::make_gemm(P, WF2 + (size_t)(L) * FFN * D, T, 1024, FFN, FFN, FFN); LASTEPI } \
    SEAM(base + 5);

    ATTN_FFN(6, 0, pg8::EpiResidB E{nullptr COMMA H COMMA PSB COMMA 1024}; RUN_GEMM(pg8::EpiResidB, true, g, E);)

    PHASE(12) { pg8::Gemm g = pg8::make_gemm(H, WHG, T, HGP, 1024, 1024, 1024); pg8::EpiBf16 E{P, HGP, 1.0f, PSB}; RUN_GEMM(pg8::EpiBf16, true, g, E); }
    SEAM(12);
    PHASE(13) {
#ifdef DUP_HGRN
        for (int cid = bx; cid < 256; cid += G) hgrn_chain(lds, cid, P, INP(25), OMIX1, 1024, 0, 0);
        grid.sync();
#endif
        for (int cid = bx; cid < 256; cid += G) hgrn_chain(lds, cid, P, INP(25), P, HGP, 1024, 1024); }
    SEAM(13);
    PHASE(14) { LOCAL_IDS hgrn_combine(P, INP(24), OMIX1, gw, NGW, lane); }
    SEAM(14);
    PHASE(15) { pg8::Gemm g = pg8::make_gemm(OMIX1, WHGO, T, 1024, 1024, 1024, 1024); pg8::EpiResidB E{nullptr, H, PSB, 1024}; RUN_GEMM(pg8::EpiResidB, true, g, E); }
    SEAM(15);

    ATTN_FFN(16, 1, pg8::EpiResidB E{nullptr COMMA H COMMA PSB COMMA 1024}; RUN_GEMM(pg8::EpiResidB, true, g, E);)

    PHASE(22) { LOCAL_IDS
        const float* fg = INP(34);
        for (int m = gw; m < T; m += NGW) {
            const f32x4 pa = *(const f32x4*)(PSB + (size_t)m * 16 + (lane & 3) * 4); float sq = (pa[0] + pa[1]) + (pa[2] + pa[3]); sq += __shfl_xor(sq, 1); sq += __shfl_xor(sq, 2);
            const float rs = rsqrtf(sq * (1.f / D) + 1e-6f);
            const bf16_t* hr = H + (size_t)m * D; float* orow = out + (size_t)m * D;
#pragma unroll
            for (int j = 0; j < 2; ++j) { const int c = (lane + 64 * j) * 8; const u32x4 hv = *(const u32x4*)(hr + c); const f32x4 g0 = *(const f32x4*)(fg + c), g1 = *(const f32x4*)(fg + c + 4);
                *(f32x4*)(orow + c) = (f32x4){bflo(hv.x) * rs * g0[0], bfhi(hv.x) * rs * g0[1], bflo(hv.y) * rs * g0[2], bfhi(hv.y) * rs * g0[3]};
                *(f32x4*)(orow + c + 4) = (f32x4){bflo(hv.z) * rs * g1[0], bfhi(hv.z) * rs * g1[1], bflo(hv.w) * rs * g1[2], bfhi(hv.w) * rs * g1[3]}; } }
    }
#undef IN
#undef SEAM
#undef RUN_GEMM
}

extern "C" void kernel_launch(void* const* d_in, const int* in_sizes, int n_in, void* d_out, int out_size, void* d_ws, size_t ws_size, hipStream_t stream) {
    static int grid = 0;
    if (grid == 0) {
        if (n_in != 35 || out_size != T * D || ws_size < WS_END) { fprintf(stderr, "kernel_launch: unexpected shapes (n_in %d out %d ws %zu)\n", n_in, out_size, ws_size); grid = -1; return; }
        int dev = 0, cus = 0, per_cu = 0;
        hipGetDevice(&dev); hipDeviceGetAttribute(&cus, hipDeviceAttributeMultiprocessorCount, dev);
        hipFuncSetAttribute((const void*)mk_fwd, hipFuncAttributeMaxDynamicSharedMemorySize, LDS_BYTES);
        hipOccupancyMaxActiveBlocksPerMultiprocessor(&per_cu, (const void*)mk_fwd, 512, LDS_BYTES);
        if (per_cu < 1) { fprintf(stderr, "kernel_launch: occupancy query says %d blocks per CU\n", per_cu); per_cu = 1; }
        (void)hipGetLastError();
        grid = cus * 1;
    }
    if (grid < 0) return;
    if (hipMemsetAsync(d_ws, 0, 65536, stream) != hipSuccess) { fprintf(stderr, "kernel_launch: memset of the barrier words failed\n"); return; }
    Args a{};
    for (int i = 0; i < 35; ++i) a.in[i] = (const float*)d_in[i];
    a.out = (float*)d_out; a.ws = (unsigned char*)d_ws;
#if MK_COOP
    a.ph_lo = 0; a.ph_hi = NPHASE;
    void* kargs[] = {&a};
    hipError_t e = hipLaunchCooperativeKernel((const void*)mk_fwd, dim3(grid), dim3(512), kargs, LDS_BYTES, stream);
    if (e != hipSuccess) fprintf(stderr, "cooperative launch failed: %s (grid %d)\n", hipGetErrorString(e), grid);
#else
    for (int ph = 0; ph < NPHASE; ++ph) { a.ph_lo = ph; a.ph_hi = ph + 1; hipLaunchKernelGGL(mk_fwd, dim3(grid), dim3(512), LDS_BYTES, stream, a); }
#endif
}
```

```cpp
#include <hip/hip_runtime.h>
#include <hip/hip_cooperative_groups.h>
#include <cstdio>
#include <cstdint>
namespace cg = cooperative_groups;

#ifndef MK_COOP
#define MK_COOP 1
#endif

#define LAS __attribute__((address_space(3)))
typedef unsigned short bf16_t;
typedef short bf16x8 __attribute__((ext_vector_type(8)));
typedef float f32x4 __attribute__((ext_vector_type(4)));
typedef float f32x2 __attribute__((ext_vector_type(2)));
typedef unsigned u32x4 __attribute__((ext_vector_type(4)));
typedef unsigned u32x2 __attribute__((ext_vector_type(2)));

constexpr int NB = 16, SEQ = 4096, T = NB * SEQ, D = 1024;
constexpr int ABPAD = 3584, ABP = 3336;
constexpr int HGP = 5120;
constexpr int FFN = 2816;
constexpr int NPHASE = 23;

constexpr size_t MiB = 1u << 20;
constexpr size_t WS_WAB = 1 * MiB, WS_WABO = 8 * MiB, WS_WHG = 10 * MiB, WS_WHGO = 20 * MiB, WS_WQ = 22 * MiB, WS_WKV = 26 * MiB, WS_WO = 34 * MiB,
                 WS_WF1 = 38 * MiB, WS_WF2 = 60 * MiB, WS_G2T = 71 * MiB, WS_MEMN = 72 * MiB, WS_KMEM = 88 * MiB, WS_VT = 104 * MiB,
                 WS_PS = 120 * MiB, WS_H = 128 * MiB, WS_P = 256 * MiB, WS_PATT = 384 * MiB, WS_OMIX0 = 704 * MiB, WS_OMIX1 = 896 * MiB, WS_END = 1024 * MiB;
constexpr size_t DO_STATES = 0, DO_G = 128 * MiB, DO_SG = 192 * MiB, DO_BONUS = 208 * MiB, DO_TOT = 210 * MiB;

constexpr int LDS_BYTES = 163840;
constexpr int XLDS_OFF = 131072;

typedef __bf16 bf16x2_t __attribute__((ext_vector_type(2)));
__device__ __forceinline__ unsigned pk2(float lo, float hi) { const f32x2 v = {lo, hi}; return __builtin_bit_cast(unsigned, __builtin_convertvector(v, bf16x2_t)); }
__device__ __forceinline__ unsigned f2bf(float f) { return pk2(f, 0.f) & 0xffffu; }
__device__ __forceinline__ float bf2f(unsigned short b) { return __builtin_bit_cast(float, (unsigned)b << 16); }
__device__ __forceinline__ float bflo(unsigned u) { return __builtin_bit_cast(float, u << 16); }
__device__ __forceinline__ float bfhi(unsigned u) { return __builtin_bit_cast(float, u & 0xffff0000u); }
__device__ __forceinline__ float frcp(float x) { return __builtin_amdgcn_rcpf(x); }
__device__ __forceinline__ float sigmoidf_(float x) { return frcp(1.0f + __expf(-x)); }
__device__ __forceinline__ float siluf_(float x) { return x * frcp(1.0f + __expf(-x)); }
__device__ __forceinline__ float wave_sum(float v) {
#pragma unroll
    for (int o = 1; o < 64; o <<= 1) v += __shfl_xor(v, o);
    return v;
}
template <int CTRL> __device__ __forceinline__ float dppf(float x) { return __builtin_bit_cast(float, __builtin_amdgcn_mov_dpp(__builtin_bit_cast(int, x), CTRL, 0xf, 0xf, true)); }
__device__ __forceinline__ float sum8(float v) { v += dppf<0xB1>(v); v += dppf<0x4E>(v); v += dppf<0x141>(v); return v; }
#define LDS_WAIT() asm volatile("s_waitcnt lgkmcnt(0)" ::: "memory")

namespace pg8 {
constexpr int BM = 256, BK = 64, HALF = 128, HTB = HALF * BK * 2, STAGE_BYTES = 8 * HTB, NXCD = 8, WGM = 8;
__host__ __device__ __forceinline__ int lds_byte(int r, int c) { const int st = (r >> 4) * 2 + (c >> 5), rr = r & 15, cc = c & 31, ob = rr * 64 + cc * 2; return st * 1024 + (ob ^ (((ob >> 9) & 1) << 5)); }
__host__ __device__ __forceinline__ void stage_rc(int b, int& R, int& C) { const int st = b / 1024, sb = b % 1024, swz = sb ^ (((sb >> 9) & 1) << 5); R = (st >> 1) * 16 + swz / 64; C = (st & 1) * 32 + (swz % 64) / 2; }
__host__ __device__ __forceinline__ int perm32(int rho) { const int n = rho >> 4, i = rho & 15; return 8 * (i >> 2) + 4 * n + (i & 3); }

struct Unit { int pm, pn, z; };
struct Gemm {
    const bf16_t* A; const bf16_t* Bt; int lda, ldb, K, nM, nN, nZ, zdiv; long sAo, sAi, sBo, sBi, sCo, sCi;
    __device__ __forceinline__ long offA(const Unit& u) const { return (long)(u.z / zdiv) * sAo + (long)(u.z % zdiv) * sAi + (long)u.pm * BM * lda; }
    __device__ __forceinline__ long offB(const Unit& u) const { return (long)(u.z / zdiv) * sBo + (long)(u.z % zdiv) * sBi + (long)u.pn * BM * ldb; }
    __device__ __forceinline__ long offC(const Unit& u) const { return (long)(u.z / zdiv) * sCo + (long)(u.z % zdiv) * sCi; }
};
__device__ __forceinline__ Gemm make_gemm(const bf16_t* A, const bf16_t* Bt, int M, int N, int K, int lda, int ldb) {
    Gemm g; g.A = A; g.Bt = Bt; g.lda = lda; g.ldb = ldb; g.K = K; g.nM = M / BM; g.nN = N / BM; g.nZ = 1; g.zdiv = 1; g.sAo = g.sAi = g.sBo = g.sBi = g.sCo = g.sCi = 0; return g;
}
struct Order {
    int nM, nN, nwg, total, G, c;
    __device__ __forceinline__ void init(const Gemm& g, int G_, int c_) { nM = g.nM; nN = g.nN; nwg = nM * nN; total = nwg * g.nZ; G = G_; c = c_; }
    __device__ __forceinline__ bool next(int i, Unit& u) const {
        const long L = (long)i * G + c; if (L >= total) return false;
        u.z = (int)(L / nwg); int wgid = (int)(L % nwg);
        { const int q = nwg / NXCD, r = nwg % NXCD, xcd = wgid % NXCD, off = wgid / NXCD; wgid = (xcd < r ? xcd * (q + 1) : r * (q + 1) + (xcd - r) * q) + off; }
        const int nig = WGM * nN, gid = wgid / nig, fm = gid * WGM, gsz = (nM - fm) < WGM ? (nM - fm) : WGM;
        u.pm = fm + ((wgid % nig) % gsz); u.pn = (wgid % nig) / gsz; return true;
    }
};

__device__ __forceinline__ unsigned cvt_pk_bf16(float lo, float hi) { return pk2(lo, hi); }

__device__ __forceinline__ void row_scales(const float* PS, int rowbase, int fq, float (&rs)[2][4]) {
#pragma unroll
    for (int ai = 0; ai < 2; ++ai)
#pragma unroll
        for (int m = 0; m < 4; ++m) { const f32x4 p = *(const f32x4*)(PS + (size_t)(rowbase + ai * HALF + m * 16) * 16 + fq * 4);
            float s = (p[0] + p[1]) + (p[2] + p[3]); s += __shfl_xor(s, 16); s += __shfl_xor(s, 32); rs[ai][m] = rsqrtf(s * (1.f / 1024.f) + 1e-6f); }
}
struct EpiBf16 {
    static constexpr bool PERM = true;
    bf16_t* O; int ldc; float scale; const float* PS;
    __device__ __forceinline__ void operator()(const f32x4 (&acc)[2][2][4][2], const Unit& u, long coff, int wr, int wc, int fr, int fq, LAS unsigned char* xl) const {
        const int row0 = u.pm * BM + wr * 64 + fr, col0 = u.pn * BM + wc * 32 + 8 * fq; bf16_t* base = O + coff;
        float rs[2][4];
        if (PS) row_scales(PS, row0, fq, rs);
        else {
#pragma unroll
            for (int ai = 0; ai < 2; ++ai)
#pragma unroll
                for (int m = 0; m < 4; ++m) rs[ai][m] = 1.f; }
#pragma unroll
        for (int ai = 0; ai < 2; ++ai)
#pragma unroll
            for (int m = 0; m < 4; ++m) { bf16_t* rowp = base + (size_t)(row0 + ai * HALF + m * 16) * ldc + col0; const float sc_ = scale * rs[ai][m];
#pragma unroll
                for (int bj = 0; bj < 2; ++bj) { const f32x4 v0 = acc[ai][bj][m][0] * sc_, v1 = acc[ai][bj][m][1] * sc_;
                    u32x4 w; w.x = cvt_pk_bf16(v0[0], v0[1]); w.y = cvt_pk_bf16(v0[2], v0[3]); w.z = cvt_pk_bf16(v1[0], v1[1]); w.w = cvt_pk_bf16(v1[2], v1[3]);
                    *(u32x4*)(rowp + bj * HALF) = w; } }
    }
};
struct EpiResid {
    static constexpr bool PERM = false;
    const float* base; float* out; int ldc;
    __device__ __forceinline__ void operator()(const f32x4 (&acc)[2][2][4][2], const Unit& u, long coff, int wr, int wc, int fr, int fq, LAS unsigned char* xl) const {
        const int col0 = u.pn * BM + wc * 32 + 4 * fq;
#pragma unroll
        for (int ai = 0; ai < 2; ++ai)
#pragma unroll
            for (int m = 0; m < 4; ++m) { const size_t off = (size_t)(u.pm * BM + ai * HALF + wr * 64 + m * 16 + fr) * ldc + col0;
#pragma unroll
                for (int bj = 0; bj < 2; ++bj)
#pragma unroll
                    for (int n = 0; n < 2; ++n) { const f32x4 bs = *(const f32x4*)(base + off + bj * HALF + n * 16); *(f32x4*)(out + off + bj * HALF + n * 16) = bs + acc[ai][bj][m][n]; } }
    }
};
struct EpiResidH {
    static constexpr bool PERM = false;
    const float* base; float* out; bf16_t* HB; float* PS; int ldc;
    __device__ __forceinline__ void operator()(const f32x4 (&acc)[2][2][4][2], const Unit& u, long coff, int wr, int wc, int fr, int fq, LAS unsigned char* xl) const {
        const int col0 = u.pn * BM + wc * 32 + 4 * fq;
#pragma unroll
        for (int ai = 0; ai < 2; ++ai)
#pragma unroll
            for (int m = 0; m < 4; ++m) { const int row = u.pm * BM + ai * HALF + wr * 64 + m * 16 + fr; const size_t off = (size_t)row * ldc + col0; float ss = 0.f;
#pragma unroll
                for (int bj = 0; bj < 2; ++bj)
#pragma unroll
                    for (int n = 0; n < 2; ++n) { const f32x4 bs = *(const f32x4*)(base + off + bj * HALF + n * 16); const f32x4 o = bs + acc[ai][bj][m][n]; *(f32x4*)(out + off + bj * HALF + n * 16) = o;
                        ss += (o[0] * o[0] + o[1] * o[1]) + (o[2] * o[2] + o[3] * o[3]);
                        u32x2 w; w.x = cvt_pk_bf16(o[0], o[1]); w.y = cvt_pk_bf16(o[2], o[3]); *(u32x2*)(HB + off + bj * HALF + n * 16) = w; }
                ss += __shfl_xor(ss, 16); ss += __shfl_xor(ss, 32);
                if (fq == 0) PS[(size_t)row * 16 + u.pn * 4 + wc] = ss; }
    }
};
struct EpiResidB {
    static constexpr bool PERM = false;
    const float* basef; bf16_t* HB; float* PS; int ldc;
    __device__ __forceinline__ void operator()(const f32x4 (&acc)[2][2][4][2], const Unit& u, long coff, int wr, int wc, int fr, int fq, LAS unsigned char* xl) const {
        const int col0 = u.pn * BM + wc * 32 + 4 * fq;
#pragma unroll
        for (int ai = 0; ai < 2; ++ai)
#pragma unroll
            for (int m = 0; m < 4; ++m) { const int row = u.pm * BM + ai * HALF + wr * 64 + m * 16 + fr; const size_t off = (size_t)row * ldc + col0; float ss = 0.f;
#pragma unroll
                for (int bj = 0; bj < 2; ++bj)
#pragma unroll
                    for (int n = 0; n < 2; ++n) { f32x4 bs;
                        if (basef) bs = *(const f32x4*)(basef + off + bj * HALF + n * 16);
                        else { const u32x2 hb = *(const u32x2*)(HB + off + bj * HALF + n * 16); bs = (f32x4){bflo(hb.x), bfhi(hb.x), bflo(hb.y), bfhi(hb.y)}; }
                        const f32x4 o = bs + acc[ai][bj][m][n];
                        ss += (o[0] * o[0] + o[1] * o[1]) + (o[2] * o[2] + o[3] * o[3]);
                        u32x2 w; w.x = cvt_pk_bf16(o[0], o[1]); w.y = cvt_pk_bf16(o[2], o[3]); *(u32x2*)(HB + off + bj * HALF + n * 16) = w; }
                ss += __shfl_xor(ss, 16); ss += __shfl_xor(ss, 32);
                if (fq == 0) PS[(size_t)row * 16 + u.pn * 4 + wc] = ss; }
    }
};
struct EpiSwiglu {
    static constexpr bool PERM = true;
    bf16_t* O; int ldc; const float* PS;
    __device__ __forceinline__ void operator()(const f32x4 (&acc)[2][2][4][2], const Unit& u, long coff, int wr, int wc, int fr, int fq, LAS unsigned char* xl) const {
        const int row0 = u.pm * BM + wr * 64 + fr, col0 = u.pn * HALF + wc * 32 + 8 * fq;
        float rs[2][4]; row_scales(PS, row0, fq, rs);
#pragma unroll
        for (int ai = 0; ai < 2; ++ai)
#pragma unroll
            for (int m = 0; m < 4; ++m) { bf16_t* rowp = O + (size_t)(row0 + ai * HALF + m * 16) * ldc + col0; float r[8]; const float sc_ = rs[ai][m];
#pragma unroll
                for (int n = 0; n < 2; ++n)
#pragma unroll
                    for (int i = 0; i < 4; ++i) { const float g = acc[ai][0][m][n][i] * sc_, uu = acc[ai][1][m][n][i] * sc_; r[n * 4 + i] = siluf_(g) * uu; }
                u32x4 w; w.x = cvt_pk_bf16(r[0], r[1]); w.y = cvt_pk_bf16(r[2], r[3]); w.z = cvt_pk_bf16(r[4], r[5]); w.w = cvt_pk_bf16(r[6], r[7]);
                *(u32x4*)rowp = w; }
    }
};
struct EpiSoftmax {
    static constexpr bool PERM = true;
    bf16_t* O; int ldc;
    __device__ __forceinline__ void operator()(f32x4 (&acc)[2][2][4][2], const Unit& u, long coff, int wr, int wc, int fr, int fq, LAS unsigned char* xl) const {
        LAS float* XM = (LAS float*)xl; LAS float* XS = (LAS float*)(xl + 4096);
#pragma unroll
        for (int ai = 0; ai < 2; ++ai)
#pragma unroll
            for (int m = 0; m < 4; ++m) { float mx = -3.0e38f;
#pragma unroll
                for (int bj = 0; bj < 2; ++bj)
#pragma unroll
                    for (int n = 0; n < 2; ++n)
#pragma unroll
                        for (int i = 0; i < 4; ++i) mx = fmaxf(mx, acc[ai][bj][m][n][i]);
                mx = fmaxf(mx, __shfl_xor(mx, 16)); mx = fmaxf(mx, __shfl_xor(mx, 32));
                if (fq == 0) XM[(ai * HALF + wr * 64 + m * 16 + fr) * 4 + wc] = mx; }
        LDS_WAIT(); __builtin_amdgcn_s_barrier(); asm volatile("" ::: "memory");
#pragma unroll
        for (int ai = 0; ai < 2; ++ai)
#pragma unroll
            for (int m = 0; m < 4; ++m) { const f32x4 mm = *(const LAS f32x4*)(XM + (ai * HALF + wr * 64 + m * 16 + fr) * 4);
                const float mx = fmaxf(fmaxf(mm[0], mm[1]), fmaxf(mm[2], mm[3])); float s = 0.f;
#pragma unroll
                for (int bj = 0; bj < 2; ++bj)
#pragma unroll
                    for (int n = 0; n < 2; ++n)
#pragma unroll
                        for (int i = 0; i < 4; ++i) { const float e = __expf(acc[ai][bj][m][n][i] - mx); acc[ai][bj][m][n][i] = e; s += e; }
                s += __shfl_xor(s, 16); s += __shfl_xor(s, 32);
                if (fq == 0) XS[(ai * HALF + wr * 64 + m * 16 + fr) * 4 + wc] = s; }
        LDS_WAIT(); __builtin_amdgcn_s_barrier(); asm volatile("" ::: "memory");
        const int row0 = u.pm * BM + wr * 64 + fr, col0 = wc * 32 + 8 * fq; bf16_t* base = O + coff;
#pragma unroll
        for (int ai = 0; ai < 2; ++ai)
#pragma unroll
            for (int m = 0; m < 4; ++m) { const f32x4 ss = *(const LAS f32x4*)(XS + (ai * HALF + wr * 64 + m * 16 + fr) * 4);
                const float inv = frcp((ss[0] + ss[1]) + (ss[2] + ss[3])); bf16_t* rowp = base + (size_t)(row0 + ai * HALF + m * 16) * ldc + col0;
#pragma unroll
                for (int bj = 0; bj < 2; ++bj) { const f32x4 v0 = acc[ai][bj][m][0] * inv, v1 = acc[ai][bj][m][1] * inv;
                    u32x4 w; w.x = cvt_pk_bf16(v0[0], v0[1]); w.y = cvt_pk_bf16(v0[2], v0[3]); w.z = cvt_pk_bf16(v1[0], v1[1]); w.w = cvt_pk_bf16(v1[2], v1[3]);
                    *(u32x4*)(rowp + bj * HALF) = w; } }
    }
};

template <class Epi, bool ALIGN_EPI>
__device__ __forceinline__ void gemm_phase(LAS unsigned char* lds, LAS unsigned char* xl, const Gemm g, const Order& S, Epi& E) {
    const int tid = threadIdx.x, wid = __builtin_amdgcn_readfirstlane(tid >> 6), lane = tid & 63, wr = wid >> 2, wc = wid & 3, fr = lane & 15, fq = lane >> 4;
    const int K = g.K, nt = K / BK;
    unsigned voffA[2], voffB[2];
#pragma unroll
    for (int i = 0; i < 2; ++i) { int R, C; stage_rc(tid * 16 + i * 8192, R, C); const int Rb = Epi::PERM ? ((R & ~31) + perm32(R & 31)) : R;
        voffA[i] = (unsigned)(R * g.lda + C) * 2u; voffB[i] = (unsigned)(Rb * g.ldb + C) * 2u; }
    const size_t kstep = (size_t)(BK * 2);
    const size_t hstepA = (size_t)HALF * g.lda * 2, hstepB = (size_t)HALF * g.ldb * 2;
    const unsigned ldsw = (unsigned)wid * 1024u;
    const int aoff = lds_byte(wr * 64 + fr, fq * 8), boff = lds_byte(wc * 32 + fr, fq * 8);
#define PG8_SA(b, h) (((b) * 2 + (h)) * HTB)
#define PG8_SB(b, h) ((4 + (b) * 2 + (h)) * HTB)
#define PG8_STAGE(bufoff, gbase, voff) do { _Pragma("unroll") for (int _i = 0; _i < 2; ++_i) \
        __builtin_amdgcn_global_load_lds((const unsigned*)((const char*)(gbase) + (voff)[_i]), (LAS unsigned*)(lds + (bufoff) + ldsw + _i * 8192), 16, 0, 0); } while (0)
#define PG8_LDA(dst, b, h) do { _Pragma("unroll") for (int m = 0; m < 4; ++m) _Pragma("unroll") for (int k = 0; k < 2; ++k) dst[m][k] = *(const LAS bf16x8*)(lds + PG8_SA(b, h) + aoff + m * 2048 + k * 1024); } while (0)
#define PG8_LDB(dst, b, h) do { _Pragma("unroll") for (int n = 0; n < 2; ++n) _Pragma("unroll") for (int k = 0; k < 2; ++k) dst[n][k] = *(const LAS bf16x8*)(lds + PG8_SB(b, h) + boff + n * 2048 + k * 1024); } while (0)
#define PG8_MMA(ai, bj, At, Bt) do { __builtin_amdgcn_s_setprio(1); _Pragma("unroll") for (int m = 0; m < 4; ++m) _Pragma("unroll") for (int n = 0; n < 2; ++n) _Pragma("unroll") for (int k = 0; k < 2; ++k) \
        acc[ai][bj][m][n] = __builtin_amdgcn_mfma_f32_16x16x32_bf16(Bt[n][k], At[m][k], acc[ai][bj][m][n], 0, 0, 0); __builtin_amdgcn_s_setprio(0); } while (0)
#define PG8_WAIT_V(n) asm volatile("s_waitcnt vmcnt(" #n ")" ::: "memory")
#define PG8_WAIT_L(n) asm volatile("s_waitcnt lgkmcnt(" #n ")" ::: "memory")
#define PG8_BAR __builtin_amdgcn_s_barrier()
#define PG8_SCHED __builtin_amdgcn_sched_barrier(0)
    Unit cur, nxt; int ui = 0;
    if (!S.next(0, cur)) return;
    f32x4 acc[2][2][4][2];
#pragma unroll
    for (int a = 0; a < 2; ++a)
#pragma unroll
        for (int b = 0; b < 2; ++b)
#pragma unroll
            for (int m = 0; m < 4; ++m)
#pragma unroll
                for (int n = 0; n < 2; ++n) acc[a][b][m][n] = (f32x4){0.f, 0.f, 0.f, 0.f};
    bf16x8 At[4][2], B0[2][2], B1[2][2];
    const char* cA = (const char*)g.A + 2 * g.offA(cur); const char* cB = (const char*)g.Bt + 2 * g.offB(cur);
    PG8_STAGE(PG8_SB(0, 0), cB, voffB); PG8_STAGE(PG8_SB(0, 1), cB + hstepB, voffB); PG8_STAGE(PG8_SA(0, 0), cA, voffA); PG8_STAGE(PG8_SA(0, 1), cA + hstepA, voffA);
    if (wr == 1) PG8_BAR;
    PG8_WAIT_V(2); PG8_BAR;
    PG8_STAGE(PG8_SB(1, 0), cB + kstep, voffB); PG8_STAGE(PG8_SA(1, 0), cA + kstep, voffA); PG8_STAGE(PG8_SB(1, 1), cB + hstepB + kstep, voffB);
    PG8_WAIT_V(6); PG8_BAR;
    for (;;) {
        const bool has_next = S.next(ui + 1, nxt);
        const char* nA = has_next ? (const char*)g.A + 2 * g.offA(nxt) : cA; const char* nB = has_next ? (const char*)g.Bt + 2 * g.offB(nxt) : cB;
        for (int t = 0; t < nt; t += 2) {
            const bool last = (t == nt - 2);
            const char* a1 = cA + (size_t)(t + 1) * kstep;
            const char* a2 = last ? nA : cA + (size_t)(t + 2) * kstep; const char* b2 = last ? nB : cB + (size_t)(t + 2) * kstep;
            const char* a3 = a2 + kstep; const char* b3 = b2 + kstep;
            PG8_LDB(B0, 0, 0); PG8_LDB(B1, 0, 1); PG8_SCHED; PG8_LDA(At, 0, 0); PG8_STAGE(PG8_SA(1, 1), a1 + hstepA, voffA);
            PG8_WAIT_V(8); PG8_WAIT_L(0); PG8_BAR; PG8_MMA(0, 0, At, B0); PG8_MMA(0, 1, At, B1); PG8_BAR; PG8_SCHED;
            PG8_LDA(At, 0, 1); PG8_STAGE(PG8_SB(0, 0), b2, voffB); PG8_STAGE(PG8_SB(0, 1), b2 + hstepB, voffB); PG8_STAGE(PG8_SA(0, 0), a2, voffA);
            PG8_WAIT_V(8); PG8_WAIT_L(0); PG8_BAR; PG8_MMA(1, 0, At, B0); PG8_MMA(1, 1, At, B1); PG8_BAR; PG8_SCHED;
            PG8_LDB(B0, 1, 0); PG8_LDB(B1, 1, 1); PG8_SCHED; PG8_LDA(At, 1, 0); PG8_STAGE(PG8_SA(0, 1), a2 + hstepA, voffA);
            PG8_WAIT_V(8); PG8_WAIT_L(0); PG8_BAR; PG8_MMA(0, 0, At, B0); PG8_MMA(0, 1, At, B1); PG8_BAR; PG8_SCHED;
            PG8_LDA(At, 1, 1); PG8_STAGE(PG8_SB(1, 0), b3, voffB); PG8_STAGE(PG8_SB(1, 1), b3 + hstepB, voffB); PG8_STAGE(PG8_SA(1, 0), a3, voffA);
            PG8_WAIT_V(8); PG8_WAIT_L(0); PG8_BAR; PG8_MMA(1, 0, At, B0); PG8_MMA(1, 1, At, B1); PG8_BAR; PG8_SCHED;
        }
        if constexpr (ALIGN_EPI) { if (wr == 0) PG8_BAR; }
        E(acc, cur, g.offC(cur), wr, wc, fr, fq, xl);
        if (!has_next) break;
#pragma unroll
        for (int a = 0; a < 2; ++a)
#pragma unroll
            for (int b = 0; b < 2; ++b)
#pragma unroll
                for (int m = 0; m < 4; ++m)
#pragma unroll
                    for (int n = 0; n < 2; ++n) acc[a][b][m][n] = (f32x4){0.f, 0.f, 0.f, 0.f};
        cur = nxt; cA = nA; cB = nB; ++ui;
        if constexpr (ALIGN_EPI) { if (wr == 1) PG8_BAR; }
    }
    PG8_WAIT_V(0);
    if constexpr (!ALIGN_EPI) { if (wr == 0) PG8_BAR; }
    PG8_BAR;
#undef PG8_SA
#undef PG8_SB
#undef PG8_STAGE
#undef PG8_LDA
#undef PG8_LDB
#undef PG8_MMA
#undef PG8_WAIT_V
#undef PG8_WAIT_L
#undef PG8_BAR
#undef PG8_SCHED
}
}

__device__ __forceinline__ f32x4 mfma16(bf16x8 bfrag, bf16x8 afrag, f32x4 acc) { return __builtin_amdgcn_mfma_f32_16x16x32_bf16(bfrag, afrag, acc, 0, 0, 0); }
__device__ __forceinline__ bf16x8 ldsfrag(const LAS bf16_t* base, int ld, int r0, int k0, int fr, int fq) { return *(const LAS bf16x8*)(base + (r0 + fr) * ld + k0 + fq * 8); }

template <int MODE> __device__ __forceinline__ void transpose_item(const float* W, int K, int N, bf16_t* WT, LAS float* scr, int item, int nblk, int lane, const float* gain = nullptr) {
    const int kb = item / nblk, nb = item % nblk, k0 = 64 * kb, n0 = 32 * nb; const int nsrc = n0 + (lane & 31);
#pragma unroll 8
    for (int i = 0; i < 32; ++i) { const int kk = 2 * i + (lane >> 5); scr[kk * 33 + (lane & 31)] = (nsrc < N) ? W[(size_t)(k0 + kk) * N + nsrc] * (gain ? gain[k0 + kk] : 1.f) : 0.f; }
    LDS_WAIT();
    const int c = lane & 7;
#pragma unroll
    for (int j = 0; j < 4; ++j) { const int n = (lane >> 3) + 8 * j; const LAS float* s = scr + (8 * c) * 33 + n;
        u32x4 o; o.x = pk2(s[0 * 33], s[1 * 33]); o.y = pk2(s[2 * 33], s[3 * 33]); o.z = pk2(s[4 * 33], s[5 * 33]); o.w = pk2(s[6 * 33], s[7 * 33]);
        int drow = n0 + n; if (MODE == 1) { const int jn = drow % FFN, isu = drow / FFN; drow = (jn / 128) * 256 + isu * 128 + (jn % 128); }
        *(u32x4*)(WT + (size_t)drow * K + k0 + 8 * c) = o; }
    LDS_WAIT();
}
__device__ __forceinline__ void rms_row_bf16(const float* xrow, const float* gain, bf16_t* orow, int lane) {
    const f32x4* xr = (const f32x4*)xrow + lane; f32x4 v[4]; float s = 0.f;
#pragma unroll
    for (int j = 0; j < 4; ++j) { v[j] = xr[64 * j]; s += (v[j].x * v[j].x + v[j].y * v[j].y) + (v[j].z * v[j].z + v[j].w * v[j].w); }
    const float rs = rsqrtf(wave_sum(s) * (1.f / D) + 1e-6f);
    const f32x4* gr = (const f32x4*)gain + lane; u32x2* o8 = (u32x2*)orow + lane;
#pragma unroll
    for (int j = 0; j < 4; ++j) { const f32x4 g = gr[64 * j]; u32x2 w; w.x = pk2(v[j].x * rs * g.x, v[j].y * rs * g.y); w.y = pk2(v[j].z * rs * g.z, v[j].w * rs * g.w); o8[64 * j] = w; }
}
__device__ __forceinline__ void rms_rows_phase(const float* X, const float* gain, bf16_t* H, int nrows, int gw, int NGW, int lane) {
    for (int m = gw; m < nrows; m += NGW) rms_row_bf16(X + (size_t)m * D, gain, H + (size_t)m * D, lane);
}

__device__ __forceinline__ void rwkv_chain(LAS unsigned char* lds, int cid, const bf16_t* P0, const float* mu, const float* w0, const float* w2, const float* a0, const float* a2,
                                           const float* k_k, const float* k_a, const float* r_k, bf16_t* ORW, bf16_t* SG, float* BONUS) {
    const int tid = threadIdx.x, lane = tid & 63, wid = tid >> 6, fr = lane & 15, fq = lane >> 4;
    const int b = cid >> 4, h = (cid >> 1) & 7, dir = cid & 1;
    LAS float* rS = (LAS float*)(lds); LAS float* kS = (LAS float*)(lds + 8192); LAS float* vS = (LAS float*)(lds + 16384); LAS float* wS = (LAS float*)(lds + 24576);
    LAS float* nkS = (LAS float*)(lds + 32768); LAS float* bS = (LAS float*)(lds + 40960); LAS float* preA = (LAS float*)(lds + 49152); LAS float* preW = (LAS float*)(lds + 57344);
    LAS bf16_t* adB = (LAS bf16_t*)(lds + 65536); LAS bf16_t* wdB = (LAS bf16_t*)(lds + 70144);
    LAS bf16_t* a2B = (LAS bf16_t*)(lds + 74752); LAS bf16_t* w2B = (LAS bf16_t*)(lds + 83968); LAS float* cst = (LAS float*)(lds + 93184);
    LAS bf16_t* At = (LAS bf16_t*)(lds + 97280); LAS bf16_t* Bt = (LAS bf16_t*)(lds + 101888); LAS bf16_t* Kt = (LAS bf16_t*)(lds + 106496); LAS bf16_t* Rt = (LAS bf16_t*)(lds + 111104);
    LAS bf16_t* BtT = (LAS bf16_t*)(lds + 115712); LAS bf16_t* KtT = (LAS bf16_t*)(lds + 120832); LAS bf16_t* VT = (LAS bf16_t*)(lds + 125952); LAS bf16_t* S0b = (LAS bf16_t*)(lds + 131072);
    LAS float* NT4 = (LAS float*)(lds + 140288); LAS bf16_t* NakT = (LAS bf16_t*)(lds + 146432); LAS bf16_t* MbrT = (LAS bf16_t*)(lds + 148992); LAS bf16_t* MkrT = (LAS bf16_t*)(lds + 151552);
    LAS float* gL = (LAS float*)(lds + 154112);
    LAS float* WS = preA;
    LAS bf16_t* Ub = (LAS bf16_t*)preW;
#define RW_IDS int tid_o = threadIdx.x; asm volatile("" : "+v"(tid_o)); const int tid = tid_o, lane = tid & 63, wid = __builtin_amdgcn_readfirstlane(tid >> 6), fr = lane & 15, fq = lane >> 4, vt = wid >> 1, tt2 = wid & 1; (void)lane; (void)wid; (void)fr; (void)fq; (void)vt; (void)tt2;
    __syncthreads();
    for (int e = tid; e < 64 * 64; e += 512) { const int j = e & 63, r = e >> 6;
        a2B[j * 72 + r] = (bf16_t)f2bf(a2[r * 512 + h * 64 + j]); w2B[j * 72 + r] = (bf16_t)f2bf(w2[(dir * 64 + r) * 512 + h * 64 + j]); }
    for (int e = tid; e < 64 * 72 / 2; e += 512) ((LAS unsigned*)S0b)[e] = 0u;
    if (tid < 64) { const int j = tid, c = h * 64 + j;
        cst[0 * 64 + j] = a0[c]; cst[1 * 64 + j] = w0[dir * 512 + c]; cst[2 * 64 + j] = k_k[c]; cst[3 * 64 + j] = k_a[c]; cst[4 * 64 + j] = r_k[c];
        cst[5 * 64 + j] = mu[c]; cst[6 * 64 + j] = mu[512 + c]; cst[7 * 64 + j] = mu[1024 + c]; cst[8 * 64 + j] = mu[1536 + j]; cst[9 * 64 + j] = mu[1600 + j];
        cst[10 * 64 + j] = (j < 16) ? mu[1664 + h * 16 + j] : 0.f; }
    const int vt = wid >> 1, tt2 = wid & 1;
    f32x4 st[2]; st[0] = (f32x4){0.f, 0.f, 0.f, 0.f}; st[1] = st[0];
    __syncthreads();
    const bf16_t* Pb = P0 + (size_t)b * SEQ * ABPAD;
    unsigned rc[10], rpv[10], rnx[10]; unsigned short gcv = 0, gpv = 0, gnv = 0;
#define RW_IDX(i) const int grp = (i) >> 1; const int idx_ = tid + 512 * ((i) & 1); const int tok = idx_ >> 5, c2 = (idx_ & 31) * 2; \
                  const int gcol = (grp == 0 ? h * 64 : grp == 1 ? 512 + h * 64 : grp == 2 ? 1024 + h * 64 : grp == 3 ? 1536 : 1600) + c2;
    const unsigned voff = (unsigned)((((int)threadIdx.x >> 5) * ABPAD + ((int)threadIdx.x & 31) * 2) * 2);
#define RW_CG(g) ((g) == 0 ? h * 128 : (g) == 1 ? 1024 + h * 128 : (g) == 2 ? 2048 + h * 128 : (g) == 3 ? 3072 : 3200)
#define RW_ISSUE(t0n) do { const char* bp_ = (const char*)(Pb + (size_t)(t0n) * ABPAD); const bool first_ = ((t0n) == 0) && (tid < 32), last_ = ((t0n) == SEQ - 32) && (tid >= 480); \
        _Pragma("unroll") for (int i = 0; i < 10; ++i) { const char* p = bp_ + (RW_CG(i >> 1) + (i & 1) * 16 * ABPAD * 2) + voff; \
            rc[i] = *(const unsigned*)p; \
            if ((i & 1) == 0) { const unsigned v_ = *(const unsigned*)(p - (first_ ? 0 : ABPAD * 2)); rpv[i] = first_ ? 0u : v_; rnx[i] = *(const unsigned*)(p + ABPAD * 2); } \
            else { const unsigned v_ = *(const unsigned*)(p + (last_ ? 0 : ABPAD * 2)); rnx[i] = last_ ? 0u : v_; rpv[i] = *(const unsigned*)(p - ABPAD * 2); } } \
        if (dir == 0) { const bool fg_ = ((t0n) == 0) && (tid < 16), lg_ = ((t0n) == SEQ - 32) && (tid >= 496); \
            const bf16_t* p = (const bf16_t*)bp_ + (size_t)(tid >> 4) * ABPAD + 1664 + h * 16 + (tid & 15); \
            gcv = *p; { const unsigned short v_ = *(p - (fg_ ? 0 : ABPAD)); gpv = fg_ ? (unsigned short)0 : v_; } { const unsigned short v_ = *(p + (lg_ ? 0 : ABPAD)); gnv = lg_ ? (unsigned short)0 : v_; } } } while (0)
    RW_ISSUE(dir ? 127 * 32 : 0);
    for (int cc = 0; cc < 128; ++cc) {
        const int t0 = dir ? (127 - cc) * 32 : cc * 32;
        { RW_IDS
#pragma unroll
        for (int i = 0; i < 10; ++i) { RW_IDX(i) (void)gcol;
            const unsigned cur = rc[i], prv = rpv[i], nxt = rnx[i];
            const float m0 = cst[(5 + grp) * 64 + c2], m1 = cst[(5 + grp) * 64 + c2 + 1];
            const float c0 = bflo(cur), c1 = bfhi(cur);
            const float x0 = c0 + m0 * (0.5f * (bflo(prv) + bflo(nxt)) - c0), x1 = c1 + m1 * (0.5f * (bfhi(prv) + bfhi(nxt)) - c1);
            if (grp == 0) { *(LAS f32x2*)(rS + tok * 64 + c2) = (f32x2){x0, x1}; }
            else if (grp == 1) { *(LAS f32x2*)(kS + tok * 64 + c2) = (f32x2){x0, x1}; }
            else if (grp == 2) { *(LAS f32x2*)(vS + tok * 64 + c2) = (f32x2){x0, x1}; }
            else if (grp == 3) { const float e0 = __expf(2.f * x0), e1 = __expf(2.f * x1); *(LAS unsigned*)(wdB + tok * 72 + c2) = pk2(1.f - 2.f * frcp(e0 + 1.f), 1.f - 2.f * frcp(e1 + 1.f)); }
            else { *(LAS unsigned*)(adB + tok * 72 + c2) = pk2(x0, x1); }
        }
        if (dir == 0) {
            const int tok = tid >> 4, c = tid & 15, t = t0 + tok;
            const float cur = bf2f(gcv), prv = bf2f(gpv), nxt = bf2f(gnv);
            const float x = cur + cst[10 * 64 + c] * (0.5f * (prv + nxt) - cur);
            SG[((size_t)b * SEQ + t) * 128 + h * 16 + c] = (bf16_t)f2bf(sigmoidf_(x));
        } }
        __syncthreads();
        if (cc + 1 < 128) { RW_IDS const int t0n = dir ? (126 - cc) * 32 : (cc + 1) * 32; RW_ISSUE(t0n); }
        { RW_IDS const int mat = wid >> 2, ntile = wid & 3; const LAS bf16_t* Aop = mat ? wdB : adB; const LAS bf16_t* Bop = mat ? w2B : a2B; LAS float* pre = mat ? preW : preA;
#pragma unroll
          for (int mt = 0; mt < 2; ++mt) { f32x4 acc = (f32x4){0.f, 0.f, 0.f, 0.f};
#pragma unroll
              for (int ks = 0; ks < 2; ++ks) acc = mfma16(ldsfrag(Bop, 72, ntile * 16, ks * 32, fr, fq), ldsfrag(Aop, 72, mt * 16, ks * 32, fr, fq), acc);
              *(LAS f32x4*)(pre + (mt * 16 + fr) * 64 + ntile * 16 + fq * 4) = acc; } }
        __syncthreads();
        { RW_IDS const int tok = tid >> 4, c0 = (tid & 15) * 4; float kkr[4], av[4], kp[4], wv[4]; float ss = 0.f, bon = 0.f;
#pragma unroll
          for (int i = 0; i < 4; ++i) { const int c = c0 + i, ix = tok * 64 + c;
              const float a = sigmoidf_(cst[c] + preA[ix]); const float sg = sigmoidf_(cst[64 + c] + preW[ix]);
              wv[i] = -0.60653065971f * sg;
              const float kraw = kS[ix]; kkr[i] = kraw * cst[128 + c]; ss += kkr[i] * kkr[i];
              kp[i] = kraw * (1.0f + (a - 1.0f) * cst[192 + c]); av[i] = a; bon += rS[ix] * kp[i] * cst[256 + c]; }
          ss += dppf<0xB1>(ss); bon += dppf<0xB1>(bon); ss += dppf<0x4E>(ss); bon += dppf<0x4E>(bon);
          ss += dppf<0x141>(ss); bon += dppf<0x141>(bon); ss += dppf<0x140>(ss); bon += dppf<0x140>(bon);
          const float inv = frcp(fmaxf(__builtin_amdgcn_sqrtf(ss), 1e-12f));
          f32x4 o_nk, o_b, o_k, o_w;
#pragma unroll
          for (int i = 0; i < 4; ++i) { const float kk = kkr[i] * inv; o_nk[i] = -kk; o_b[i] = kk * av[i]; o_k[i] = kp[i]; o_w[i] = wv[i]; }
          *(LAS f32x4*)(nkS + tok * 64 + c0) = o_nk; *(LAS f32x4*)(bS + tok * 64 + c0) = o_b; *(LAS f32x4*)(kS + tok * 64 + c0) = o_k; *(LAS f32x4*)(wS + tok * 64 + c0) = o_w;
          if (dir == 0 && (tid & 15) == 0) BONUS[((size_t)b * SEQ + t0 + tok) * 8 + h] = bon; }
        __syncthreads();
        { RW_IDS if (tid < 64) { float lw[32];
#pragma unroll
            for (int s = 0; s < 32; ++s) lw[s] = wS[(dir ? 31 - s : s) * 64 + tid];
#pragma unroll
            for (int s = 1; s < 32; ++s) lw[s] += lw[s - 1];
#pragma unroll
            for (int s = 0; s < 32; ++s) wS[(dir ? 31 - s : s) * 64 + tid] = lw[s]; } }
        __syncthreads();
        { RW_IDS const int s = tid >> 4, c0 = (tid & 15) * 4; const int tok = dir ? 31 - s : s, tokp = dir ? tok + 1 : tok - 1;
          const f32x4 cum = *(const LAS f32x4*)(wS + tok * 64 + c0); f32x4 cump = (f32x4){0.f, 0.f, 0.f, 0.f}; if (s > 0) cump = *(const LAS f32x4*)(wS + tokp * 64 + c0);
          const f32x4 nk4 = *(const LAS f32x4*)(nkS + tok * 64 + c0), b4 = *(const LAS f32x4*)(bS + tok * 64 + c0), k4 = *(const LAS f32x4*)(kS + tok * 64 + c0), r4 = *(const LAS f32x4*)(rS + tok * 64 + c0), v4 = *(const LAS f32x4*)(vS + tok * 64 + c0);
          float ta[4], tb[4], tk[4], tr[4];
#pragma unroll
          for (int i = 0; i < 4; ++i) { const float g = __expf(cum[i]), gp = __expf(cump[i]), ig = __expf(-cum[i]);
              ta[i] = nk4[i] * gp; tb[i] = b4[i] * ig; tk[i] = k4[i] * ig; tr[i] = r4[i] * g;
              BtT[(c0 + i) * 40 + s] = (bf16_t)f2bf(tb[i]); KtT[(c0 + i) * 40 + s] = (bf16_t)f2bf(tk[i]); VT[(c0 + i) * 40 + s] = (bf16_t)f2bf(v4[i]);
              if (s == 31) gL[c0 + i] = g; }
          u32x2 w; w.x = pk2(ta[0], ta[1]); w.y = pk2(ta[2], ta[3]); *(LAS u32x2*)(At + s * 72 + c0) = w;
          w.x = pk2(tb[0], tb[1]); w.y = pk2(tb[2], tb[3]); *(LAS u32x2*)(Bt + s * 72 + c0) = w;
          w.x = pk2(tk[0], tk[1]); w.y = pk2(tk[2], tk[3]); *(LAS u32x2*)(Kt + s * 72 + c0) = w;
          w.x = pk2(tr[0], tr[1]); w.y = pk2(tr[2], tr[3]); *(LAS u32x2*)(Rt + s * 72 + c0) = w; }
        __syncthreads();
        { RW_IDS const int mat = wid >> 1, mt = wid & 1; const LAS bf16_t* Aop = (mat < 2) ? At : Rt; const LAS bf16_t* Bop = (mat & 1) ? Kt : Bt;
#pragma unroll
          for (int nt = 0; nt < 2; ++nt) { f32x4 acc = (f32x4){0.f, 0.f, 0.f, 0.f};
#pragma unroll
              for (int ks = 0; ks < 2; ++ks) acc = mfma16(ldsfrag(Bop, 72, nt * 16, ks * 32, fr, fq), ldsfrag(Aop, 72, mt * 16, ks * 32, fr, fq), acc);
              const int srow = mt * 16 + fr;
#pragma unroll
              for (int e = 0; e < 4; ++e) { const int i = nt * 16 + fq * 4 + e; const bool keep = (mat < 2) ? (i < srow) : (i <= srow); if (!keep) acc[e] = 0.f; }
              if (mat == 0) {
#pragma unroll
                  for (int e = 0; e < 4; ++e) NT4[e * 384 + srow * 12 + nt * 4 + fq] = acc[e]; }
              else { LAS bf16_t* X = (mat == 1) ? NakT : (mat == 2) ? MbrT : MkrT; u32x2 o; o.x = pk2(acc[0], acc[1]); o.y = pk2(acc[2], acc[3]); *(LAS u32x2*)(X + srow * 40 + nt * 16 + fq * 4) = o; } } }
        __syncthreads();
        f32x4 oacc = (f32x4){0.f, 0.f, 0.f, 0.f};
        { RW_IDS f32x4 wacc = (f32x4){0.f, 0.f, 0.f, 0.f};
#pragma unroll
          for (int ks = 0; ks < 2; ++ks) { const bf16x8 sf = ldsfrag(S0b, 72, vt * 16, ks * 32, fr, fq);
              wacc = mfma16(ldsfrag(At, 72, tt2 * 16, ks * 32, fr, fq), sf, wacc); oacc = mfma16(ldsfrag(Rt, 72, tt2 * 16, ks * 32, fr, fq), sf, oacc); }
          const bf16x8 vf = ldsfrag(VT, 40, vt * 16, 0, fr, fq);
          wacc = mfma16(ldsfrag(NakT, 40, tt2 * 16, 0, fr, fq), vf, wacc); oacc = mfma16(ldsfrag(MkrT, 40, tt2 * 16, 0, fr, fq), vf, oacc);
#pragma unroll
          for (int n2 = 0; n2 < 2; ++n2) st[n2] = mfma16(ldsfrag(KtT, 40, (tt2 * 2 + n2) * 16, 0, fr, fq), vf, st[n2]);
#pragma unroll
          for (int e = 0; e < 4; ++e) WS[(tt2 * 16 + fq * 4 + e) * 64 + vt * 16 + fr] = wacc[e]; }
        __syncthreads();
        { RW_IDS if (wid < 4) { const int v = wid * 16 + (lane >> 2), p = lane & 3; const LAS float* NTp = NT4 + p * 384; float u[8];
#pragma unroll
            for (int j = 0; j < 8; ++j) u[j] = 0.f;
#pragma unroll
            for (int t = 0; t < 32; ++t) { float q0 = (p == 0) ? WS[t * 64 + v] : 0.f, q1 = 0.f;
#pragma unroll
                for (int j4 = 0; j4 < ((t + 3) / 4 + 3) / 4; ++j4) { const f32x4 nv = *(const LAS f32x4*)(NTp + t * 12 + j4 * 4);
                    q0 += u[j4 * 4] * nv[0]; q1 += u[j4 * 4 + 1] * nv[1]; q0 += u[j4 * 4 + 2] * nv[2]; q1 += u[j4 * 4 + 3] * nv[3]; }
                float q = q0 + q1; q += dppf<0xB1>(q); q += dppf<0x4E>(q);
                u[t >> 2] = ((t & 3) == p) ? q : u[t >> 2]; asm volatile("" ::: "memory"); }
#pragma unroll
            for (int j = 0; j < 8; ++j) Ub[v * 40 + 4 * j + p] = (bf16_t)f2bf(u[j]); } }
        __syncthreads();
        { RW_IDS const bf16x8 uf = ldsfrag(Ub, 40, vt * 16, 0, fr, fq);
          oacc = mfma16(ldsfrag(MbrT, 40, tt2 * 16, 0, fr, fq), uf, oacc);
#pragma unroll
          for (int e = 0; e < 4; ++e) { const int sidx = tt2 * 16 + fq * 4 + e, tok = dir ? 31 - sidx : sidx;
              ORW[(size_t)dir * T * 512 + ((size_t)b * SEQ + t0 + tok) * 512 + h * 64 + vt * 16 + fr] = (bf16_t)f2bf(oacc[e]); }
#pragma unroll
          for (int n2 = 0; n2 < 2; ++n2) { const int kt = tt2 * 2 + n2; st[n2] = mfma16(ldsfrag(BtT, 40, kt * 16, 0, fr, fq), uf, st[n2]);
              const f32x4 gl = *(const LAS f32x4*)(gL + kt * 16 + fq * 4); st[n2] = st[n2] * gl;
              u32x2 o; o.x = pk2(st[n2][0], st[n2][1]); o.y = pk2(st[n2][2], st[n2][3]); *(LAS u32x2*)(S0b + (vt * 16 + fr) * 72 + kt * 16 + fq * 4) = o; } }
    }
#undef RW_IDX
#undef RW_ISSUE
#undef RW_IDS
#undef RW_CG
    __syncthreads();
}

__device__ __forceinline__ void rwkv_combine(const bf16_t* P0, const bf16_t* ORW, const float* BONUS, const bf16_t* G, const float* mu, const float* gn_w, const float* gn_b, bf16_t* OMIX, int gw, int NGW, int lane) {
    const int c0 = lane * 8, head = lane >> 3;
    float muv[8], gw8[8], gb8[8];
#pragma unroll
    for (int i = 0; i < 8; ++i) { muv[i] = mu[1024 + c0 + i]; gw8[i] = gn_w[c0 + i]; gb8[i] = gn_b[c0 + i]; }
    for (int tk = gw; tk < T; tk += NGW) {
        const int t = tk & (SEQ - 1);
        const u32x4 uf = *(const u32x4*)(ORW + (size_t)tk * 512 + c0), ub = *(const u32x4*)(ORW + (size_t)T * 512 + (size_t)tk * 512 + c0);
        float o[8];
#pragma unroll
        for (int i = 0; i < 4; ++i) { o[2 * i] = bflo(uf[i]) + bflo(ub[i]); o[2 * i + 1] = bfhi(uf[i]) + bfhi(ub[i]); }
        float s = 0.f;
#pragma unroll
        for (int i = 0; i < 8; ++i) s += o[i];
        const float mean = sum8(s) * (1.f / 64.f); float q = 0.f;
#pragma unroll
        for (int i = 0; i < 8; ++i) { o[i] -= mean; q += o[i] * o[i]; }
        const float rstd = rsqrtf(sum8(q) * (1.f / 64.f) + 64e-5f);
        const bf16_t* pv = P0 + (size_t)tk * ABPAD + 1024 + c0;
        const u32x4 vc = *(const u32x4*)pv; u32x4 vp = (u32x4){0u, 0u, 0u, 0u}, vn = (u32x4){0u, 0u, 0u, 0u};
        if (t > 0) vp = *(const u32x4*)(pv - ABPAD);
        if (t < SEQ - 1) vn = *(const u32x4*)(pv + ABPAD);
        const u32x4 gg = *(const u32x4*)(G + (size_t)tk * 512 + c0);
        const float bon = BONUS[(size_t)tk * 8 + head];
        float r[8];
#pragma unroll
        for (int i = 0; i < 4; ++i) {
            const float c_lo = bflo(vc[i]), c_hi = bfhi(vc[i]);
            const float v_lo = c_lo + muv[2 * i] * (0.5f * (bflo(vp[i]) + bflo(vn[i])) - c_lo), v_hi = c_hi + muv[2 * i + 1] * (0.5f * (bfhi(vp[i]) + bfhi(vn[i])) - c_hi);
            r[2 * i] = (o[2 * i] * rstd * gw8[2 * i] + gb8[2 * i] + bon * v_lo) * bflo(gg[i]);
            r[2 * i + 1] = (o[2 * i + 1] * rstd * gw8[2 * i + 1] + gb8[2 * i + 1] + bon * v_hi) * bfhi(gg[i]); }
        u32x4 w; w.x = pk2(r[0], r[1]); w.y = pk2(r[2], r[3]); w.z = pk2(r[4], r[5]); w.w = pk2(r[6], r[7]);
        *(u32x4*)(OMIX + (size_t)tk * D + c0) = w;
    }
}

constexpr int SLD = 136;
__device__ __forceinline__ float softplusf_(float x) { return x > 20.f ? x : log1pf(__expf(x)); }
__device__ __forceinline__ void ssd_dt_cum(LAS float* dtS, LAS float* cumS, LAS float* totS, const bf16_t* Prow0, int g, int w, int lane, const float* dt_bias, const float* a_log) {
    const int j = w >> 1, d = w & 1, head = g * 4 + j;
    const float bias = dt_bias[d * 8 + head], A = -__expf(a_log[d * 8 + head]);
    const float x0 = bf2f(Prow0[(size_t)(2 * lane) * ABPAD + 3328 + head]), x1 = bf2f(Prow0[(size_t)(2 * lane + 1) * ABPAD + 3328 + head]);
    const float dt0 = softplusf_(x0 + bias), dt1 = softplusf_(x1 + bias), la0 = dt0 * A, la1 = dt1 * A;
    const float s = la0 + la1; float inc = s;
#pragma unroll
    for (int off = 1; off < 64; off <<= 1) { const float n = __shfl_up(inc, off); if (lane >= off) inc += n; }
    const float tot = __shfl(inc, 63), exc = inc - s;
    float c0, c1; if (d == 0) { c0 = exc + la0; c1 = inc; } else { c0 = tot - exc; c1 = tot - exc - la0; }
    dtS[w * 128 + 2 * lane] = dt0; dtS[w * 128 + 2 * lane + 1] = dt1; cumS[w * 128 + 2 * lane] = c0; cumS[w * 128 + 2 * lane + 1] = c1;
    if (lane == 0) totS[w] = tot;
}
template <int NR, bool TR> __device__ __forceinline__ void ssd_conv8(LAS bf16_t* dst, int col0, int cx0, int l0, const bf16_t* Pb, int t0, const float* cw, const float* cb) {
    u32x4 raw[NR + 2];
    const bf16_t* p = Pb + (size_t)(t0 + l0) * ABPAD + 2304 + cx0;
#pragma unroll
    for (int i = 0; i < NR + 2; ++i) { const int t = t0 + l0 + i - 1; raw[i] = (t >= 0 && t < SEQ) ? *(const u32x4*)(p + (long)(i - 1) * ABPAD) : (u32x4){0u, 0u, 0u, 0u}; }
    float w0[8], w1[8], w2[8], bs[8];
#pragma unroll
    for (int q = 0; q < 2; ++q) { const f32x4 a = *(const f32x4*)(cw + cx0 + 4 * q), bq = *(const f32x4*)(cw + 1024 + cx0 + 4 * q), c = *(const f32x4*)(cw + 2048 + cx0 + 4 * q), d = *(const f32x4*)(cb + cx0 + 4 * q);
#pragma unroll
        for (int i = 0; i < 4; ++i) { w0[4 * q + i] = a[i]; w1[4 * q + i] = bq[i]; w2[4 * q + i] = c[i]; bs[4 * q + i] = d[i]; } }
    float o[NR][8];
#pragma unroll
    for (int i = 0; i < NR; ++i)
#pragma unroll
        for (int c = 0; c < 8; ++c) { const unsigned um = raw[i][c >> 1], u0 = raw[i + 1][c >> 1], up = raw[i + 2][c >> 1];
            const float fm = (c & 1) ? bfhi(um) : bflo(um), f0 = (c & 1) ? bfhi(u0) : bflo(u0), fp = (c & 1) ? bfhi(up) : bflo(up);
            o[i][c] = siluf_(w0[c] * fm + w1[c] * f0 + w2[c] * fp + bs[c]); }
    if (TR) {
#pragma unroll
        for (int c = 0; c < 8; ++c) { LAS bf16_t* q = dst + (col0 + c) * SLD + l0;
            if (NR == 8) { u32x4 w; w.x = pk2(o[0][c], o[1][c]); w.y = pk2(o[2][c], o[3][c]); w.z = pk2(o[4 % NR][c], o[5 % NR][c]); w.w = pk2(o[6 % NR][c], o[7 % NR][c]); *(LAS u32x4*)q = w; }
            else { u32x2 w; w.x = pk2(o[0][c], o[1][c]); w.y = pk2(o[2][c], o[3][c]); *(LAS u32x2*)q = w; } }
    } else {
#pragma unroll
        for (int i = 0; i < NR; ++i) { u32x4 w; w.x = pk2(o[i][0], o[i][1]); w.y = pk2(o[i][2], o[i][3]); w.z = pk2(o[i][4], o[i][5]); w.w = pk2(o[i][6], o[i][7]); *(LAS u32x4*)(dst + (l0 + i) * SLD + col0) = w; }
    }
}
__device__ __forceinline__ void ssd_s1_unit(LAS unsigned char* lds, int unit, const bf16_t* P0, const float* cw, const float* cb, const float* dt_bias, const float* a_log, bf16_t* STATES, float* TOT) {
    const int tid = threadIdx.x, lane = tid & 63, w = tid >> 6, fr = lane & 15, fq = lane >> 4;
    const int g = unit & 1, c = (unit >> 1) & 31, b = unit >> 6, t0 = c * 128;
    LAS bf16_t* BT = (LAS bf16_t*)lds; LAS bf16_t* XT = (LAS bf16_t*)(lds + 34816); LAS float* dtS = (LAS float*)(lds + 104448); LAS float* cumS = (LAS float*)(lds + 108544);
    LAS float* scS = (LAS float*)(lds + 112640); LAS float* totS = (LAS float*)(lds + 116736);
    const bf16_t* Pb = P0 + (size_t)b * SEQ * ABPAD;
    __syncthreads();
    ssd_conv8<4, true>(BT, (tid & 15) * 8, 512 + g * 128 + (tid & 15) * 8, (tid >> 4) * 4, Pb, t0, cw, cb);
    ssd_conv8<8, true>(XT, (tid & 31) * 8, g * 256 + (tid & 31) * 8, (tid >> 5) * 8, Pb, t0, cw, cb);
    ssd_dt_cum(dtS, cumS, totS, Pb + (size_t)t0 * ABPAD, g, w, lane, dt_bias, a_log);
    __syncthreads();
    for (int e = tid; e < 1024; e += 512) scS[e] = dtS[e] * __expf(totS[e >> 7] - cumS[e]);
    if (tid < 8) TOT[((size_t)(b * 32 + c) * 2 + (tid & 1)) * 8 + g * 4 + (tid >> 1)] = totS[tid];
    __syncthreads();
    const int j = w >> 1;
#pragma unroll 1
    for (int d = 0; d < 2; ++d) {
        f32x4 acc[2][8];
#pragma unroll
        for (int mt = 0; mt < 2; ++mt)
#pragma unroll
            for (int nt = 0; nt < 8; ++nt) acc[mt][nt] = (f32x4){0.f, 0.f, 0.f, 0.f};
#pragma unroll 1
        for (int ks = 0; ks < 4; ++ks) {
            const int k0 = ks * 32; const LAS float* sp = scS + (j * 2 + d) * 128 + k0 + fq * 8;
            const f32x4 s0 = *(const LAS f32x4*)sp, s1 = *(const LAS f32x4*)(sp + 4);
            bf16x8 afr[2];
#pragma unroll
            for (int mt = 0; mt < 2; ++mt) { const u32x4 raw = *(const LAS u32x4*)(XT + (32 * w + mt * 16 + fr) * SLD + k0 + fq * 8); u32x4 o;
                o.x = pk2(bflo(raw.x) * s0[0], bfhi(raw.x) * s0[1]); o.y = pk2(bflo(raw.y) * s0[2], bfhi(raw.y) * s0[3]);
                o.z = pk2(bflo(raw.z) * s1[0], bfhi(raw.z) * s1[1]); o.w = pk2(bflo(raw.w) * s1[2], bfhi(raw.w) * s1[3]);
                afr[mt] = __builtin_bit_cast(bf16x8, o); }
#pragma unroll
            for (int nt = 0; nt < 8; ++nt) { const bf16x8 bfr = ldsfrag(BT, SLD, nt * 16, k0, fr, fq);
#pragma unroll
                for (int mt = 0; mt < 2; ++mt) acc[mt][nt] = mfma16(bfr, afr[mt], acc[mt][nt]); }
        }
        bf16_t* dst = STATES + (((size_t)(b * 32 + c) * 2 + d) * 8 + g * 4 + j) * 8192;
#pragma unroll
        for (int mt = 0; mt < 2; ++mt) { const int p = (w & 1) * 32 + mt * 16 + fr;
#pragma unroll
            for (int nt = 0; nt < 8; ++nt) { u32x2 o; o.x = pk2(acc[mt][nt][0], acc[mt][nt][1]); o.y = pk2(acc[mt][nt][2], acc[mt][nt][3]);
                *(u32x2*)(dst + p * 128 + nt * 16 + fq * 4) = o; } }
    }
}
__device__ __forceinline__ void ssd_s2(const bf16_t* __restrict__ STATES, bf16_t* __restrict__ CARR, const float* __restrict__ TOT, int gtid, int NGT) {
    for (int it = gtid; it < 16 * 2 * 8 * 1024; it += NGT) {
        const int e8 = it & 1023, head = (it >> 10) & 7, d = (it >> 13) & 1, b = it >> 14;
        float run[8];
#pragma unroll
        for (int i = 0; i < 8; ++i) run[i] = 0.f;
#pragma unroll 1
        for (int c8 = 0; c8 < 32; c8 += 8) {
            u32x4 loc[8]; float dec[8];
#pragma unroll
            for (int q = 0; q < 8; ++q) { const int cc = c8 + q, c = d ? 31 - cc : cc; const size_t sidx = ((size_t)(b * 32 + c) * 2 + d) * 8 + head;
                loc[q] = *(const u32x4*)(STATES + sidx * 8192 + e8 * 8); dec[q] = TOT[sidx]; }
#pragma unroll
            for (int q = 0; q < 8; ++q) { const int cc = c8 + q, c = d ? 31 - cc : cc; const size_t sidx = ((size_t)(b * 32 + c) * 2 + d) * 8 + head;
                u32x4 o; o.x = pk2(run[0], run[1]); o.y = pk2(run[2], run[3]); o.z = pk2(run[4], run[5]); o.w = pk2(run[6], run[7]); *(u32x4*)(CARR + sidx * 8192 + e8 * 8) = o;
                const float dq = __expf(dec[q]);
#pragma unroll
                for (int i = 0; i < 4; ++i) { run[2 * i] = run[2 * i] * dq + bflo(loc[q][i]); run[2 * i + 1] = run[2 * i + 1] * dq + bfhi(loc[q][i]); } }
        }
    }
}
__device__ __forceinline__ void ssd_s3_unit(LAS unsigned char* lds, int unit, const bf16_t* P0, const float* cw, const float* cb, const float* dt_bias, const float* a_log, const float* dskip, const float* norm_w,
                                            const bf16_t* STATES, bf16_t* OMIX) {
    const int tid = threadIdx.x, lane = tid & 63, w = tid >> 6, fr = lane & 15, fq = lane >> 4;
    const int g = unit & 1, c = (unit >> 1) & 31, b = unit >> 6, t0 = c * 128;
    LAS bf16_t* CS = (LAS bf16_t*)lds; LAS bf16_t* BS = (LAS bf16_t*)(lds + 34816); LAS bf16_t* XT = (LAS bf16_t*)(lds + 69632);
    LAS float* dtS = (LAS float*)(lds + 139264); LAS float* cumS = (LAS float*)(lds + 143360); LAS float* totS = (LAS float*)(lds + 147456);
    const bf16_t* Pb = P0 + (size_t)b * SEQ * ABPAD;
    __syncthreads();
    ssd_conv8<4, false>(BS, (tid & 15) * 8, 512 + g * 128 + (tid & 15) * 8, (tid >> 4) * 4, Pb, t0, cw, cb);
    ssd_conv8<4, false>(CS, (tid & 15) * 8, 768 + g * 128 + (tid & 15) * 8, (tid >> 4) * 4, Pb, t0, cw, cb);
    ssd_conv8<8, true>(XT, (tid & 31) * 8, g * 256 + (tid & 31) * 8, (tid >> 5) * 8, Pb, t0, cw, cb);
    ssd_dt_cum(dtS, cumS, totS, Pb + (size_t)t0 * ABPAD, g, w, lane, dt_bias, a_log);
    __syncthreads();
    const int l = 16 * w + fr;
    f32x4 sc[8];
#pragma unroll
    for (int nt = 0; nt < 8; ++nt) sc[nt] = (f32x4){0.f, 0.f, 0.f, 0.f};
#pragma unroll
    for (int ks = 0; ks < 4; ++ks) { const bf16x8 afr = ldsfrag(CS, SLD, 16 * w, ks * 32, fr, fq);
#pragma unroll
        for (int nt = 0; nt < 8; ++nt) sc[nt] = mfma16(ldsfrag(BS, SLD, nt * 16, ks * 32, fr, fq), afr, sc[nt]); }
    __syncthreads();
    LAS bf16_t* Mw = BS + w * 16 * SLD;
    const size_t row = (size_t)b * SEQ + t0 + l; float ss = 0.f;
#pragma unroll 1
    for (int j = 0; j < 4; ++j) {
        const LAS float* cf = cumS + (j * 2) * 128; const LAS float* cbw = cumS + (j * 2 + 1) * 128; const LAS float* df = dtS + (j * 2) * 128; const LAS float* db = dtS + (j * 2 + 1) * 128;
        const float cfl = cf[l], cbl = cbw[l];
        const size_t sbase = ((size_t)(b * 32 + c) * 2) * 8 + g * 4 + j;
        const bf16_t* carf = STATES + sbase * 8192; const bf16_t* carb = STATES + (sbase + 8) * 8192;
        bf16x8 cF[4][4], cB[4][4]; u32x2 zz4[4];
#pragma unroll
        for (int ks = 0; ks < 4; ++ks)
#pragma unroll
            for (int pt = 0; pt < 4; ++pt) cF[ks][pt] = *(const bf16x8*)(carf + (pt * 16 + fr) * 128 + ks * 32 + fq * 8);
#pragma unroll
        for (int pt = 0; pt < 4; ++pt) zz4[pt] = *(const u32x2*)(P0 + row * ABPAD + 1792 + g * 256 + j * 64 + pt * 16 + fq * 4);
#pragma unroll
        for (int nt = 0; nt < 8; ++nt) { float mv[4];
#pragma unroll
            for (int i = 0; i < 4; ++i) { const int s = nt * 16 + fq * 4 + i;
                const float ff = (s <= l) ? __expf(cfl - cf[s]) * df[s] : 0.f; const float fb = (s >= l) ? __expf(cbl - cbw[s]) * db[s] : 0.f;
                mv[i] = sc[nt][i] * (ff + fb); }
            u32x2 o; o.x = pk2(mv[0], mv[1]); o.y = pk2(mv[2], mv[3]); *(LAS u32x2*)(Mw + fr * SLD + nt * 16 + fq * 4) = o; }
        LDS_WAIT();
#pragma unroll
        for (int ks = 0; ks < 4; ++ks)
#pragma unroll
            for (int pt = 0; pt < 4; ++pt) cB[ks][pt] = *(const bf16x8*)(carb + (pt * 16 + fr) * 128 + ks * 32 + fq * 8);
        f32x4 yd[4], yf[4], yb[4];
#pragma unroll
        for (int pt = 0; pt < 4; ++pt) { yd[pt] = (f32x4){0.f, 0.f, 0.f, 0.f}; yf[pt] = yd[pt]; yb[pt] = yd[pt]; }
        bf16x8 acs[4];
#pragma unroll
        for (int ks = 0; ks < 4; ++ks) {
            const bf16x8 am = *(const LAS bf16x8*)(Mw + fr * SLD + ks * 32 + fq * 8); acs[ks] = ldsfrag(CS, SLD, 16 * w, ks * 32, fr, fq);
#pragma unroll
            for (int pt = 0; pt < 4; ++pt) {
                yd[pt] = mfma16(ldsfrag(XT, SLD, j * 64 + pt * 16, ks * 32, fr, fq), am, yd[pt]);
                yf[pt] = mfma16(cF[ks][pt], acs[ks], yf[pt]); }
        }
#pragma unroll
        for (int ks = 0; ks < 4; ++ks)
#pragma unroll
            for (int pt = 0; pt < 4; ++pt) yb[pt] = mfma16(cB[ks][pt], acs[ks], yb[pt]);
        const float ef = __expf(cfl), eb = __expf(cbl), dsk = dskip[g * 4 + j];
#pragma unroll
        for (int pt = 0; pt < 4; ++pt) { const f32x4 yv = yd[pt] + yf[pt] * ef + yb[pt] * eb;
            const int col = j * 64 + pt * 16 + fq * 4; const u32x2 zz = zz4[pt];
            const float z4[4] = {bflo(zz.x), bfhi(zz.x), bflo(zz.y), bfhi(zz.y)}; float v4[4];
#pragma unroll
            for (int i = 0; i < 4; ++i) { const float xs = bf2f(XT[(col + i) * SLD + l]); float v = yv[i] + dsk * xs; const float z = z4[i]; v = v * siluf_(z);
                v4[i] = v; ss += v * v; }
            u32x2 o; o.x = pk2(v4[0], v4[1]); o.y = pk2(v4[2], v4[3]); *(u32x2*)(OMIX + row * D + 512 + g * 256 + col) = o; }
        asm volatile("" ::: "memory");
    }
    ss += __shfl_xor(ss, 16); ss += __shfl_xor(ss, 32);
    const float rs = rsqrtf(ss * (1.f / 256.f) + 1e-6f);
    asm volatile("s_waitcnt vmcnt(0)" ::: "memory");
#pragma unroll 4
    for (int q = 0; q < 16; ++q) { const int col = g * 256 + q * 16 + fq * 4; const f32x4 nw = *(const f32x4*)(norm_w + col);
        u32x2* p = (u32x2*)(OMIX + row * D + 512 + col); const u32x2 v = *p;
        u32x2 o; o.x = pk2(bflo(v.x) * rs * nw[0], bfhi(v.x) * rs * nw[1]); o.y = pk2(bflo(v.y) * rs * nw[2], bfhi(v.y) * rs * nw[3]); *p = o; }
}

constexpr int HLD = 136, HLS = 72;
__device__ __forceinline__ void hgrn_chain(LAS unsigned char* lds, int cid, bf16_t* P1, const float* hg_lb, bf16_t* Ob, int ldo, int ocbase, int ocdir) {
    const int tid = threadIdx.x, lane = tid & 63, w = tid >> 6, fr = lane & 15, fq = lane >> 4;
    const int b = cid >> 4, h = (cid >> 1) & 7, dir = cid & 1;
    LAS bf16_t* QE = (LAS bf16_t*)lds;
    LAS bf16_t* KE = (LAS bf16_t*)(lds + 17408);
    LAS bf16_t* KLT = (LAS bf16_t*)(lds + 34816);
    LAS bf16_t* VT = (LAS bf16_t*)(lds + 53248);
    LAS bf16_t* AT = (LAS bf16_t*)(lds + 71680);
    LAS bf16_t* ST = (LAS bf16_t*)(lds + 80896);
    LAS float* totS = (LAS float*)(lds + 115712);
    LAS float* lastS = (LAS float*)(lds + 117760);
    __syncthreads();
    for (int e = tid; e < 128 * HLD / 2; e += 512) ((LAS unsigned*)ST)[e] = 0u;
    const int dcol = tid & 127, qtr = tid >> 7, i0 = qtr * 16;
    const float lbv = frcp(1.0f + __expf(hg_lb[h * 128 + dcol] - hg_lb[1024 + h * 128 + dcol]));
    f32x4 st[8];
#pragma unroll
    for (int i = 0; i < 8; ++i) st[i] = (f32x4){0.f, 0.f, 0.f, 0.f};
    bf16_t* Pb = P1 + (size_t)b * SEQ * HGP;
    __syncthreads();
    unsigned short rq[16], rf[16], rv[16];
#define HG_ISSUE(t0n) do { _Pragma("unroll") for (int i = 0; i < 16; ++i) { const int tk = (t0n) + (dir ? 63 - (i0 + i) : (i0 + i)); const bf16_t* pr = Pb + (size_t)tk * HGP + h * 128 + dcol; \
        rq[i] = pr[0]; rf[i] = pr[1024 * (1 + dir)]; rv[i] = pr[3072]; } } while (0)
    HG_ISSUE((dir ? 63 : 0) * 64);
    for (int cc = 0; cc < 64; ++cc) {
        const int t0 = (dir ? 63 - cc : cc) * 64;
        float gq[16], gk[16], gc[16]; float run = 0.f;
#pragma unroll
        for (int i = 0; i < 16; ++i) { const float q = bf2f(rq[i]), fr_ = bf2f(rf[i]);
            const float f = lbv + (1.0f - lbv) * sigmoidf_(fr_); run += __logf(f); gq[i] = q; gk[i] = 1.0f - f; gc[i] = run; }
        totS[qtr * 128 + dcol] = run;
#pragma unroll
        for (int i = 0; i < 16; i += 2) *(LAS unsigned*)(VT + dcol * HLS + i0 + i) = (unsigned)rv[i] | ((unsigned)rv[i + 1] << 16);
        __syncthreads();
        { float pre = 0.f, tot = 0.f;
#pragma unroll
          for (int q4 = 0; q4 < 4; ++q4) { const float tq = totS[q4 * 128 + dcol]; if (q4 < qtr) pre += tq; tot += tq; }
          const float etot = __expf(tot);
          if (qtr == 0) lastS[dcol] = etot;
#pragma unroll
          for (int i = 0; i < 16; i += 2) { const float b0 = pre + gc[i], b1 = pre + gc[i + 1];
              const float e0 = __expf(b0), e1 = __expf(b1), n0 = frcp(e0), n1 = frcp(e1), l0 = etot * n0, l1 = etot * n1;
              QE[(i0 + i) * HLD + dcol] = (bf16_t)f2bf(gq[i] * e0); QE[(i0 + i + 1) * HLD + dcol] = (bf16_t)f2bf(gq[i + 1] * e1);
              KE[(i0 + i) * HLD + dcol] = (bf16_t)f2bf(gk[i] * n0); KE[(i0 + i + 1) * HLD + dcol] = (bf16_t)f2bf(gk[i + 1] * n1);
              *(LAS unsigned*)(KLT + dcol * HLS + i0 + i) = pk2(gk[i] * l0, gk[i + 1] * l1); } }
        if (cc + 1 < 64) HG_ISSUE((dir ? 62 - cc : cc + 1) * 64);
        __syncthreads();
        { const int mt = w >> 1;
#pragma unroll
          for (int n2 = 0; n2 < 2; ++n2) { const int nt = (w & 1) * 2 + n2; f32x4 acc = (f32x4){0.f, 0.f, 0.f, 0.f};
#pragma unroll
              for (int ks = 0; ks < 4; ++ks) acc = mfma16(ldsfrag(KE, HLD, nt * 16, ks * 32, fr, fq), ldsfrag(QE, HLD, mt * 16, ks * 32, fr, fq), acc);
              const int lrow = mt * 16 + fr; float mv[4];
#pragma unroll
              for (int i = 0; i < 4; ++i) { const int s = nt * 16 + fq * 4 + i; mv[i] = (s <= lrow) ? acc[i] : 0.f; }
              u32x2 o; o.x = pk2(mv[0], mv[1]); o.y = pk2(mv[2], mv[3]); *(LAS u32x2*)(AT + lrow * HLS + nt * 16 + fq * 4) = o; } }
        __syncthreads();
        { const int mt = w >> 1;
#pragma unroll
          for (int n4 = 0; n4 < 4; ++n4) { const int nt = (w & 1) * 4 + n4; f32x4 acc = (f32x4){0.f, 0.f, 0.f, 0.f};
#pragma unroll
              for (int ks = 0; ks < 2; ++ks) acc = mfma16(ldsfrag(VT, HLS, nt * 16, ks * 32, fr, fq), ldsfrag(AT, HLS, mt * 16, ks * 32, fr, fq), acc);
#pragma unroll
              for (int ks = 0; ks < 4; ++ks) acc = mfma16(ldsfrag(ST, HLD, nt * 16, ks * 32, fr, fq), ldsfrag(QE, HLD, mt * 16, ks * 32, fr, fq), acc);
              const int i = mt * 16 + fr, tk = t0 + (dir ? 63 - i : i);
              u32x2 o; o.x = pk2(acc[0], acc[1]); o.y = pk2(acc[2], acc[3]);
              *(u32x2*)(Ob + ((size_t)b * SEQ + tk) * ldo + ocbase + ocdir * dir + h * 128 + nt * 16 + fq * 4) = o; } }
#pragma unroll
        for (int nt = 0; nt < 8; ++nt) { const f32x4 el = *(const LAS f32x4*)(lastS + nt * 16 + fq * 4); st[nt] = st[nt] * el;
#pragma unroll
            for (int ks = 0; ks < 2; ++ks) st[nt] = mfma16(ldsfrag(KLT, HLS, nt * 16, ks * 32, fr, fq), ldsfrag(VT, HLS, w * 16, ks * 32, fr, fq), st[nt]); }
        __syncthreads();
#pragma unroll
        for (int nt = 0; nt < 8; ++nt) { u32x2 o; o.x = pk2(st[nt][0], st[nt][1]); o.y = pk2(st[nt][2], st[nt][3]); *(LAS u32x2*)(ST + (w * 16 + fr) * HLD + nt * 16 + fq * 4) = o; }
    }
    __syncthreads();
}
__device__ __forceinline__ void hgrn_combine(const bf16_t* P1, const float* norm_w, bf16_t* OMIX, int gw, int NGW, int lane) {
    const int c0 = lane * 16;
    for (int tk = gw; tk < T; tk += NGW) {
        const bf16_t* pr = P1 + (size_t)tk * HGP + c0; float o[16]; float ss = 0.f;
#pragma unroll
        for (int hh = 0; hh < 2; ++hh) { const u32x4 uf = *(const u32x4*)(pr + 1024 + hh * 8), ub = *(const u32x4*)(pr + 2048 + hh * 8);
#pragma unroll
            for (int i = 0; i < 4; ++i) { o[hh * 8 + 2 * i] = bflo(uf[i]) + bflo(ub[i]); o[hh * 8 + 2 * i + 1] = bfhi(uf[i]) + bfhi(ub[i]); } }
#pragma unroll
        for (int i = 0; i < 16; ++i) ss += o[i] * o[i];
        const float rs = rsqrtf(sum8(ss) * (1.f / 128.f) + 1e-6f);
#pragma unroll
        for (int hh = 0; hh < 2; ++hh) { const u32x4 ug = *(const u32x4*)(pr + 4096 + hh * 8); float r[8];
#pragma unroll
            for (int i = 0; i < 4; ++i) { const float g0 = bflo(ug[i]), g1 = bfhi(ug[i]);
                r[2 * i] = o[hh * 8 + 2 * i] * rs * norm_w[c0 + hh * 8 + 2 * i] * siluf_(g0);
                r[2 * i + 1] = o[hh * 8 + 2 * i + 1] * rs * norm_w[c0 + hh * 8 + 2 * i + 1] * siluf_(g1); }
            u32x4 wv; wv.x = pk2(r[0], r[1]); wv.y = pk2(r[2], r[3]); wv.z = pk2(r[4], r[5]); wv.w = pk2(r[6], r[7]);
            *(u32x4*)(OMIX + (size_t)tk * D + c0 + hh * 8) = wv; }
    }
}

#define XB_TMO      128
#define XB_XCNT(j)  (256  + 64 * (j))
#define XB_XSUB(j)  (1280 + 64 * (j))
#define XB_XGEN(j)  (2304 + 64 * (j))
#define XB_TOP      3328
#define XB_TOPGEN   3392
#define XCD_BAR_WORDS 3456
#define XB_SPIN_CAP (1u << 18)

__device__ __forceinline__ unsigned xb_ld(unsigned* p)              { return __hip_atomic_load(p, __ATOMIC_RELAXED, __HIP_MEMORY_SCOPE_AGENT); }
__device__ __forceinline__ unsigned xb_add(unsigned* p, unsigned v) { return __hip_atomic_fetch_add(p, v, __ATOMIC_RELAXED, __HIP_MEMORY_SCOPE_AGENT); }
__device__ __forceinline__ unsigned xb_xcc_id() { return (unsigned)__builtin_amdgcn_s_getreg((3 << 11) | 20) & 0xFu; }
#define XB_SPIN(cond, bar) do { unsigned _sp = 0; while (cond) { __builtin_amdgcn_s_sleep(1); \
    if ((++_sp & 255u) == 0u) { if (xb_ld(&(bar)[XB_TMO])) break; if (_sp > XB_SPIN_CAP) { atomicAdd(&(bar)[XB_TMO], 1u); break; } } } } while (0)

struct XcdBarrier {
    unsigned* bar; unsigned x;
    volatile LAS unsigned* st;
};

__device__ __forceinline__ XcdBarrier xcd_barrier_post(unsigned* bar, volatile LAS unsigned* st) {
    XcdBarrier b; b.bar = bar; b.x = xb_xcc_id(); b.st = st;
    if (threadIdx.x == 0) (void)xb_add(&bar[XB_XCNT(b.x)], 1u);
    return b;
}
__device__ __forceinline__ void xcd_barrier_complete(unsigned* bar, unsigned x, unsigned& nloc, unsigned& nx) {
    const unsigned G = gridDim.x * gridDim.y * gridDim.z;
    unsigned sum, cnt, mine, sp = 0u;
    for (;;) {
        sum = 0u; cnt = 0u; mine = 0u;
#pragma unroll
        for (unsigned j = 0; j < 16; ++j) { const unsigned c = xb_ld(&bar[XB_XCNT(j)]); sum += c; cnt += (c > 0u) ? 1u : 0u; mine = (j == x) ? c : mine; }
        if (sum == G) break;
        __builtin_amdgcn_s_sleep(1);
        if ((++sp & 255u) == 0u) { if (xb_ld(&bar[XB_TMO])) break; if (sp > XB_SPIN_CAP) { atomicAdd(&bar[XB_TMO], 1u); break; } }
    }
    nloc = mine > 0u ? mine : 1u; nx = cnt > 0u ? cnt : 1u;
}

__device__ __forceinline__ void xcd_barrier(const XcdBarrier& b) {
    asm volatile("s_waitcnt vmcnt(0)" ::: "memory");
    __syncthreads();
    if (threadIdx.x == 0) {
        unsigned* bar = b.bar;
        __builtin_amdgcn_s_waitcnt(0);
        unsigned nloc = b.st[0], nx = b.st[1];
        if (nloc == 0u) { xcd_barrier_complete(bar, b.x, nloc, nx); b.st[0] = nloc; b.st[1] = nx; }
        const unsigned old = xb_add(&bar[XB_XSUB(b.x)], 1u);
        const unsigned gen = old / nloc;
        if (old + 1u == (gen + 1u) * nloc) {
            __builtin_amdgcn_fence(__ATOMIC_RELEASE, "agent");
            asm volatile("s_waitcnt vmcnt(0)" ::: "memory");
            const unsigned og = xb_add(&bar[XB_TOP], 1u);
            const unsigned tg = og / nx;
            if (og + 1u == (tg + 1u) * nx) xb_add(&bar[XB_TOPGEN], 1u);
            else XB_SPIN(xb_ld(&bar[XB_TOPGEN]) == tg, bar);
            __builtin_amdgcn_fence(__ATOMIC_ACQUIRE, "agent");
            xb_add(&bar[XB_XGEN(b.x)], 1u);
            asm volatile("s_waitcnt vmcnt(0)" ::: "memory");
        } else {
            XB_SPIN(xb_ld(&bar[XB_XGEN(b.x)]) == gen, bar);
            __builtin_amdgcn_fence(__ATOMIC_ACQUIRE, "agent");
            asm volatile("s_waitcnt vmcnt(0)" ::: "memory");
        }
    }
    __syncthreads();
}


struct Args { const float* in[35]; float* out; unsigned char* ws; int ph_lo, ph_hi; };
static_assert(sizeof(Args) == 304, "Args layout");

__global__ void __launch_bounds__(512, 2) mk_fwd(Args args) {
    extern __shared__ __attribute__((aligned(16))) unsigned char lds_raw[];
    LAS unsigned char* lds = (LAS unsigned char*)lds_raw; LAS unsigned char* xl = lds + XLDS_OFF;
    const int G = gridDim.x, bx = blockIdx.x, NGW = G * 8;
#define LOCAL_IDS int tid = threadIdx.x; asm volatile("" : "+v"(tid)); const int lane = tid & 63, wave = __builtin_amdgcn_readfirstlane(tid >> 6), gw = bx * 8 + wave; (void)lane; (void)gw;
    typedef const __attribute__((address_space(4))) unsigned char* kaptr_t;
    kaptr_t ka = (kaptr_t)__builtin_amdgcn_kernarg_segment_ptr();
#define INP(k) (*(const float* const volatile __attribute__((address_space(4)))*)(ka + 8 * (k)))
    unsigned char* ws = *(unsigned char* const volatile __attribute__((address_space(4)))*)(ka + 288); float* out = *(float* const volatile __attribute__((address_space(4)))*)(ka + 280);
    const float* x = INP(0);
    bf16_t* WAB = (bf16_t*)(ws + WS_WAB); bf16_t* WABO = (bf16_t*)(ws + WS_WABO); bf16_t* WHG = (bf16_t*)(ws + WS_WHG); bf16_t* WHGO = (bf16_t*)(ws + WS_WHGO);
    bf16_t* WQ = (bf16_t*)(ws + WS_WQ); bf16_t* WKV = (bf16_t*)(ws + WS_WKV); bf16_t* WO = (bf16_t*)(ws + WS_WO); bf16_t* WF1 = (bf16_t*)(ws + WS_WF1); bf16_t* WF2 = (bf16_t*)(ws + WS_WF2);
    bf16_t* G2T = (bf16_t*)(ws + WS_G2T); bf16_t* MEMN = (bf16_t*)(ws + WS_MEMN); bf16_t* KMEM = (bf16_t*)(ws + WS_KMEM); bf16_t* VT = (bf16_t*)(ws + WS_VT);
    bf16_t* H = (bf16_t*)(ws + WS_H); bf16_t* P = (bf16_t*)(ws + WS_P); bf16_t* PATT = (bf16_t*)(ws + WS_PATT); bf16_t* OMIX0 = (bf16_t*)(ws + WS_OMIX0); bf16_t* OMIX1 = (bf16_t*)(ws + WS_OMIX1); float* PSB = (float*)(ws + WS_PS);
#define COMMA ,
    bf16_t* STATES = (bf16_t*)((unsigned char*)out + DO_STATES); bf16_t* GG = (bf16_t*)((unsigned char*)out + DO_G); bf16_t* SG = (bf16_t*)((unsigned char*)out + DO_SG);
    float* BONUS = (float*)((unsigned char*)out + DO_BONUS); float* TOT = (float*)((unsigned char*)out + DO_TOT);
    cg::grid_group grid = cg::this_grid();
    { volatile LAS unsigned* st_ = (volatile LAS unsigned*)(lds + LDS_BYTES - 16); if (threadIdx.x < 4) st_[threadIdx.x] = 0u; }
    __syncthreads();
    const XcdBarrier xbar = xcd_barrier_post((unsigned*)ws, (volatile LAS unsigned*)(lds + LDS_BYTES - 16));
    const int lo = *(const int volatile __attribute__((address_space(4)))*)(ka + 296), hi = *(const int volatile __attribute__((address_space(4)))*)(ka + 300);
#ifndef PH_EN
#define PH_EN(k) 1
#endif
#define IN(k) (PH_EN(k) && lo <= (k) && (k) < hi)
#ifndef DUP_MASK
#define DUP_MASK 0ull
#endif
#define REPS(k) (1 + (int)(((unsigned long long)(DUP_MASK) >> (k)) & 1ull))
#define PHASE(k) for (int rep_ = 0; rep_ < (IN(k) ? REPS(k) : 0); ++rep_, ((REPS(k) > 1) ? (grid.sync(), 0) : 0))
#define SEAM(k) do { if (IN(k) && IN((k) + 1)) xcd_barrier(xbar); } while (0)
    if (lo < 0) grid.sync();
#define RUN_GEMM(EPI, ALIGN, gd, ep) do { pg8::Order S_; S_.init(gd, G, bx); pg8::gemm_phase<EPI, ALIGN>(lds, xl, gd, S_, ep); } while (0)

    PHASE(0) { LOCAL_IDS
        LAS float* scr = (LAS float*)(lds + wave * 16384);
        constexpr int I_AB = 16 * 112, I_SQ = 16 * 32, I_HG = 16 * 160, I_KV = 16 * 64, I_F1 = 16 * 176, I_F2 = 44 * 32, I_G2 = 2 * 16;
        constexpr int NIT = I_AB + I_SQ + I_HG + I_SQ + 2 * I_SQ + 2 * I_KV + 2 * I_SQ + 2 * I_F1 + 2 * I_F2 + I_G2;
        for (int it = gw; it < NIT; it += NGW) {
            int r = it;
            if (r < I_AB) { transpose_item<0>(INP(3), 1024, ABP, WAB, scr, r, 112, lane); continue; } r -= I_AB;
            if (r < I_SQ) { transpose_item<0>(INP(4), 1024, 1024, WABO, scr, r, 32, lane); continue; } r -= I_SQ;
            if (r < I_HG) { transpose_item<0>(INP(22), 1024, HGP, WHG, scr, r, 160, lane, INP(2) + D); continue; } r -= I_HG;
            if (r < I_SQ) { transpose_item<0>(INP(23), 1024, 1024, WHGO, scr, r, 32, lane); continue; } r -= I_SQ;
            if (r < 2 * I_SQ) { const int l = r / I_SQ; transpose_item<0>(INP(28) + (size_t)l * D * D, 1024, 1024, WQ + (size_t)l * D * D, scr, r % I_SQ, 32, lane, INP(26) + l * D); continue; } r -= 2 * I_SQ;
            if (r < 2 * I_KV) { const int l = r / I_KV; transpose_item<0>(INP(29) + (size_t)l * D * 2048, 1024, 2048, WKV + (size_t)l * D * 2048, scr, r % I_KV, 64, lane); continue; } r -= 2 * I_KV;
            if (r < 2 * I_SQ) { const int l = r / I_SQ; transpose_item<0>(INP(30) + (size_t)l * D * D, 1024, 1024, WO + (size_t)l * D * D, scr, r % I_SQ, 32, lane); continue; } r -= 2 * I_SQ;
            if (r < 2 * I_F1) { const int l = r / I_F1; transpose_item<1>(INP(32) + (size_t)l * D * 2 * FFN, 1024, 2 * FFN, WF1 + (size_t)l * D * 2 * FFN, scr, r % I_F1, 176, lane, INP(31) + l * D); continue; } r -= 2 * I_F1;
            if (r < 2 * I_F2) { const int l = r / I_F2; transpose_item<0>(INP(33) + (size_t)l * FFN * D, FFN, 1024, WF2 + (size_t)l * FFN * D, scr, r % I_F2, 32, lane); continue; } r -= 2 * I_F2;
            transpose_item<0>(INP(10), 128, 512, G2T, scr, r, 16, lane);
        }
        rms_rows_phase(x, INP(2), H, T, gw, NGW, lane);
        for (int m = gw; m < 2 * 4096; m += NGW) { const int l = m >> 12, r = m & 4095; rms_row_bf16(INP(1) + (size_t)r * D, INP(27) + l * D, MEMN + (size_t)m * D, lane); }
        __syncthreads();
    }
    SEAM(0);
    PHASE(1) {
        { pg8::Gemm g = pg8::make_gemm(H, WAB, T, ABPAD, 1024, 1024, 1024); pg8::EpiBf16 E{P, ABPAD, 1.0f, nullptr}; RUN_GEMM(pg8::EpiBf16, true, g, E); }
        { pg8::Gemm g = pg8::make_gemm(MEMN, WKV, 4096, 1024, 1024, 1024, 1024); g.nZ = 2; g.sAo = 4096L * D; g.sBo = 2048L * D; g.sCo = 4096L * D; pg8::EpiBf16 E{KMEM, 1024, 1.0f, nullptr}; RUN_GEMM(pg8::EpiBf16, true, g, E); }
        { pg8::Gemm g = pg8::make_gemm(WKV + (size_t)1024 * D, MEMN, 1024, 4096, 1024, 1024, 1024); g.nZ = 2; g.sAo = 2048L * D; g.sBo = 4096L * D; g.sCo = 4096L * D; pg8::EpiBf16 E{VT, 4096, 1.0f, nullptr}; RUN_GEMM(pg8::EpiBf16, true, g, E); }
    }
    SEAM(1);
    PHASE(2) {
#ifndef DUP_RWKV
#define DUP_RWKV 0
#endif
#ifndef DUP_S1
#define DUP_S1 0
#endif
        for (int r2 = 0; r2 <= DUP_RWKV; ++r2)
        for (int cid = bx; cid < 256; cid += G)
            rwkv_chain(lds, cid, P, INP(5), INP(6), INP(7), INP(8), INP(9), INP(11), INP(12), INP(13), H, SG, BONUS);
        for (int r2 = 0; r2 <= DUP_S1; ++r2)
        for (int u = bx; u < 1024; u += G) ssd_s1_unit(lds, u, P, INP(16), INP(17), INP(18), INP(19), STATES, TOT);
        __syncthreads();
    }
    SEAM(2);
    PHASE(3) {
        { int k128 = 128; asm volatile("" : "+s"(k128)); pg8::Gemm g = pg8::make_gemm(SG, G2T, T, 512, k128, 128, 128); pg8::EpiBf16 E{GG, 512, 1.0f, nullptr}; RUN_GEMM(pg8::EpiBf16, true, g, E); }
        { LOCAL_IDS ssd_s2(STATES, OMIX1, TOT, bx * 512 + tid, G * 512); }
    }
    SEAM(3);
    PHASE(4) {
#ifndef DUP_S3
#define DUP_S3 0
#endif
        for (int r2 = 0; r2 <= DUP_S3; ++r2)
        for (int u = bx; u < 1024; u += G) ssd_s3_unit(lds, u, P, INP(16), INP(17), INP(18), INP(19), INP(20), INP(21), OMIX1, OMIX0);
        __syncthreads();
        { LOCAL_IDS rwkv_combine(P, H, BONUS, GG, INP(5), INP(14), INP(15), OMIX0, gw, NGW, lane); }
    }
    SEAM(4);
    PHASE(5) { pg8::Gemm g = pg8::make_gemm(OMIX0, WABO, T, 1024, 1024, 1024, 1024); pg8::EpiResidB E{x, H, PSB, 1024}; RUN_GEMM(pg8::EpiResidB, true, g, E); }
    SEAM(5);

#define ATTN_FFN(base, L, LASTEPI) \
    PHASE(base) { pg8::Gemm g = pg8::make_gemm(H, WQ + (size_t)(L) * D * D, T, 1024, 1024, 1024, 1024); pg8::EpiBf16 E{P, 1024, 0.0625f, PSB}; RUN_GEMM(pg8::EpiBf16, true, g, E); } \
    SEAM(base); \
    PHASE(base + 1) { pg8::Gemm g = pg8::make_gemm(P, KMEM + (size_t)(L) * 4096 * D, SEQ, 256, 256, 1024, 1024); g.nZ = 64; g.zdiv = 4; \
        g.sAo = (long)SEQ * D; g.sAi = 256; g.sBo = 256L * D; g.sBi = 256; g.sCo = (long)SEQ * D; g.sCi = 256; pg8::EpiSoftmax E{PATT, 1024}; RUN_GEMM(pg8::EpiSoftmax, true, g, E); } \
    SEAM(base + 1); \
    PHASE(base + 2) { pg8::Gemm g = pg8::make_gemm(PATT, VT + (size_t)(L) * 4096 * D, SEQ, 256, 256, 1024, 4096); g.nZ = 64; g.zdiv = 4; \
        g.sAo = (long)SEQ * D; g.sAi = 256; g.sBo = 256; g.sBi = 256L * 4096; g.sCo = (long)SEQ * D; g.sCi = 256; pg8::EpiBf16 E{P, 1024, 1.0f, nullptr}; RUN_GEMM(pg8::EpiBf16, true, g, E); } \
    SEAM(base + 2); \
    PHASE(base + 3) { pg8::Gemm g = pg8::make_gemm(P, WO + (size_t)(L) * D * D, T, 1024, 1024, 1024, 1024); pg8::EpiResidB E{nullptr, H, PSB, 1024}; RUN_GEMM(pg8::EpiResidB, true, g, E); } \
    SEAM(base + 3); \
    PHASE(base + 4) { pg8::Gemm g = pg8::make_gemm(H, WF1 + (size_t)(L) * D * 2 * FFN, T, 2 * FFN, 1024, 1024, 1024); pg8::EpiSwiglu E{P, FFN, PSB}; RUN_GEMM(pg8::EpiSwiglu, true, g, E); } \
    SEAM(base + 4); \
    PHASE(base + 5) { pg8::Gemm g = pg8::make_gemm(P, WF2 + (size_t)(L) * FFN * D, T, 1024, FFN, FFN, FFN); LASTEPI } \
    SEAM(base + 5);

    ATTN_FFN(6, 0, pg8::EpiResidB E{nullptr COMMA H COMMA PSB COMMA 1024}; RUN_GEMM(pg8::EpiResidB, true, g, E);)

    PHASE(12) { pg8::Gemm g = pg8::make_gemm(H, WHG, T, HGP, 1024, 1024, 1024); pg8::EpiBf16 E{P, HGP, 1.0f, PSB}; RUN_GEMM(pg8::EpiBf16, true, g, E); }
    SEAM(12);
    PHASE(13) {
#ifdef DUP_HGRN
        for (int cid = bx; cid < 256; cid += G) hgrn_chain(lds, cid, P, INP(25), OMIX1, 1024, 0, 0);
        grid.sync();
#endif
        for (int cid = bx; cid < 256; cid += G) hgrn_chain(lds, cid, P, INP(25), P, HGP, 1024, 1024); }
    SEAM(13);
    PHASE(14) { LOCAL_IDS hgrn_combine(P, INP(24), OMIX1, gw, NGW, lane); }
    SEAM(14);
    PHASE(15) { pg8::Gemm g = pg8::make_gemm(OMIX1, WHGO, T, 1024, 1024, 1024, 1024); pg8::EpiResidB E{nullptr, H, PSB, 1024}; RUN_GEMM(pg8::EpiResidB, true, g, E); }
    SEAM(15);

    ATTN_FFN(16, 1, pg8::EpiResidB E{nullptr COMMA H COMMA PSB COMMA 1024}; RUN_GEMM(pg8::EpiResidB, true, g, E);)

    PHASE(22) { LOCAL_IDS
        const float* fg = INP(34);
        for (int m = gw; m < T; m += NGW) {
            const f32x4 pa = *(const f32x4*)(PSB + (size_t)m * 16 + (lane & 3) * 4); float sq = (pa[0] + pa[1]) + (pa[2] + pa[3]); sq += __shfl_xor(sq, 1); sq += __shfl_xor(sq, 2);
            const float rs = rsqrtf(sq * (1.f / D) + 1e-6f);
            const bf16_t* hr = H + (size_t)m * D; float* orow = out + (size_t)m * D;
#pragma unroll
            for (int j = 0; j < 2; ++j) { const int c = (lane + 64 * j) * 8; const u32x4 hv = *(const u32x4*)(hr + c); const f32x4 g0 = *(const f32x4*)(fg + c), g1 = *(const f32x4*)(fg + c + 4);
                *(f32x4*)(orow + c) = (f32x4){bflo(hv.x) * rs * g0[0], bfhi(hv.x) * rs * g0[1], bflo(hv.y) * rs * g0[2], bfhi(hv.y) * rs * g0[3]};
                *(f32x4*)(orow + c + 4) = (f32x4){bflo(hv.z) * rs * g1[0], bfhi(hv.z) * rs * g1[1], bflo(hv.w) * rs * g1[2], bfhi(hv.w) * rs * g1[3]}; } }
    }
#undef IN
#undef SEAM
#undef RUN_GEMM
}

extern "C" void kernel_launch(void* const* d_in, const int* in_sizes, int n_in, void* d_out, int out_size, void* d_ws, size_t ws_size, hipStream_t stream) {
    static int grid = 0;
    if (grid == 0) {
        if (n_in != 35 || out_size != T * D || ws_size < WS_END) { fprintf(stderr, "kernel_launch: unexpected shapes (n_in %d out %d ws %zu)\n", n_in, out_size, ws_size); grid = -1; return; }
        int dev = 0, cus = 0, per_cu = 0;
        hipGetDevice(&dev); hipDeviceGetAttribute(&cus, hipDeviceAttributeMultiprocessorCount, dev);
        hipFuncSetAttribute((const void*)mk_fwd, hipFuncAttributeMaxDynamicSharedMemorySize, LDS_BYTES);
        hipOccupancyMaxActiveBlocksPerMultiprocessor(&per_cu, (const void*)mk_fwd, 512, LDS_BYTES);
        if (per_cu < 1) { fprintf(stderr, "kernel_launch: occupancy query says %d blocks per CU\n", per_cu); per_cu = 1; }
        (void)hipGetLastError();
        grid = cus * 1;
    }
    if (grid < 0) return;
    if (hipMemsetAsync(d_ws, 0, 65536, stream) != hipSuccess) { fprintf(stderr, "kernel_launch: memset of the barrier words failed\n"); return; }
    Args a{};
    for (int i = 0; i < 35; ++i) a.in[i] = (const float*)d_in[i];
    a.out = (float*)d_out; a.ws = (unsigned char*)d_ws;
#if MK_COOP
    a.ph_lo = 0; a.ph_hi = NPHASE;
    void* kargs[] = {&a};
    hipError_t e = hipLaunchCooperativeKernel((const void*)mk_fwd, dim3(grid), dim3(512), kargs, LDS_BYTES, stream);
    if (e != hipSuccess) fprintf(stderr, "cooperative launch failed: %s (grid %d)\n", hipGetErrorString(e), grid);
#else
    for (int ph = 0; ph < NPHASE; ++ph) { a.ph_lo = ph; a.ph_hi = ph + 1; hipLaunchKernelGGL(mk_fwd, dim3(grid), dim3(512), LDS_BYTES, stream, a); }
#endif
}
```

```cpp
#include <hip/hip_runtime.h>
#include <hip/hip_cooperative_groups.h>
#include <cstdio>
#include <cstdint>
namespace cg = cooperative_groups;

#ifndef MK_COOP
#define MK_COOP 1
#endif

#define LAS __attribute__((address_space(3)))
typedef unsigned short bf16_t;
typedef short bf16x8 __attribute__((ext_vector_type(8)));
typedef float f32x4 __attribute__((ext_vector_type(4)));
typedef float f32x2 __attribute__((ext_vector_type(2)));
typedef unsigned u32x4 __attribute__((ext_vector_type(4)));
typedef unsigned u32x2 __attribute__((ext_vector_type(2)));

constexpr int NB = 16, SEQ = 4096, T = NB * SEQ, D = 1024;
constexpr int ABPAD = 3584, ABP = 3336;
constexpr int HGP = 5120;
constexpr int FFN = 2816;
constexpr int NPHASE = 23;

constexpr size_t MiB = 1u << 20;
constexpr size_t WS_WAB = 1 * MiB, WS_WABO = 8 * MiB, WS_WHG = 10 * MiB, WS_WHGO = 20 * MiB, WS_WQ = 22 * MiB, WS_WKV = 26 * MiB, WS_WO = 34 * MiB,
                 WS_WF1 = 38 * MiB, WS_WF2 = 60 * MiB, WS_G2T = 71 * MiB, WS_MEMN = 72 * MiB, WS_KMEM = 88 * MiB, WS_VT = 104 * MiB,
                 WS_PS = 120 * MiB, WS_H = 128 * MiB, WS_P = 256 * MiB, WS_PATT = 384 * MiB, WS_OMIX0 = 704 * MiB, WS_OMIX1 = 896 * MiB, WS_END = 1024 * MiB;
constexpr size_t DO_STATES = 0, DO_G = 128 * MiB, DO_SG = 192 * MiB, DO_BONUS = 208 * MiB, DO_TOT = 210 * MiB;

constexpr int LDS_BYTES = 163840;
constexpr int XLDS_OFF = 131072;

typedef __bf16 bf16x2_t __attribute__((ext_vector_type(2)));
__device__ __forceinline__ unsigned pk2(float lo, float hi) { const f32x2 v = {lo, hi}; return __builtin_bit_cast(unsigned, __builtin_convertvector(v, bf16x2_t)); }
__device__ __forceinline__ unsigned f2bf(float f) { return pk2(f, 0.f) & 0xffffu; }
__device__ __forceinline__ float bf2f(unsigned short b) { return __builtin_bit_cast(float, (unsigned)b << 16); }
__device__ __forceinline__ float bflo(unsigned u) { return __builtin_bit_cast(float, u << 16); }
__device__ __forceinline__ float bfhi(unsigned u) { return __builtin_bit_cast(float, u & 0xffff0000u); }
__device__ __forceinline__ float frcp(float x) { return __builtin_amdgcn_rcpf(x); }
__device__ __forceinline__ float sigmoidf_(float x) { return frcp(1.0f + __expf(-x)); }
__device__ __forceinline__ float siluf_(float x) { return x * frcp(1.0f + __expf(-x)); }
__device__ __forceinline__ float wave_sum(float v) {
#pragma unroll
    for (int o = 1; o < 64; o <<= 1) v += __shfl_xor(v, o);
    return v;
}
template <int CTRL> __device__ __forceinline__ float dppf(float x) { return __builtin_bit_cast(float, __builtin_amdgcn_mov_dpp(__builtin_bit_cast(int, x), CTRL, 0xf, 0xf, true)); }
__device__ __forceinline__ float sum8(float v) { v += dppf<0xB1>(v); v += dppf<0x4E>(v); v += dppf<0x141>(v); return v; }
#define LDS_WAIT() asm volatile("s_waitcnt lgkmcnt(0)" ::: "memory")

namespace pg8 {
constexpr int BM = 256, BK = 64, HALF = 128, HTB = HALF * BK * 2, STAGE_BYTES = 8 * HTB, NXCD = 8, WGM = 8;
__host__ __device__ __forceinline__ int lds_byte(int r, int c) { const int st = (r >> 4) * 2 + (c >> 5), rr = r & 15, cc = c & 31, ob = rr * 64 + cc * 2; return st * 1024 + (ob ^ (((ob >> 9) & 1) << 5)); }
__host__ __device__ __forceinline__ void stage_rc(int b, int& R, int& C) { const int st = b / 1024, sb = b % 1024, swz = sb ^ (((sb >> 9) & 1) << 5); R = (st >> 1) * 16 + swz / 64; C = (st & 1) * 32 + (swz % 64) / 2; }
__host__ __device__ __forceinline__ int perm32(int rho) { const int n = rho >> 4, i = rho & 15; return 8 * (i >> 2) + 4 * n + (i & 3); }

struct Unit { int pm, pn, z; };
struct Gemm {
    const bf16_t* A; const bf16_t* Bt; int lda, ldb, K, nM, nN, nZ, zdiv; long sAo, sAi, sBo, sBi, sCo, sCi;
    __device__ __forceinline__ long offA(const Unit& u) const { return (long)(u.z / zdiv) * sAo + (long)(u.z % zdiv) * sAi + (long)u.pm * BM * lda; }
    __device__ __forceinline__ long offB(const Unit& u) const { return (long)(u.z / zdiv) * sBo + (long)(u.z % zdiv) * sBi + (long)u.pn * BM * ldb; }
    __device__ __forceinline__ long offC(const Unit& u) const { return (long)(u.z / zdiv) * sCo + (long)(u.z % zdiv) * sCi; }
};
__device__ __forceinline__ Gemm make_gemm(const bf16_t* A, const bf16_t* Bt, int M, int N, int K, int lda, int ldb) {
    Gemm g; g.A = A; g.Bt = Bt; g.lda = lda; g.ldb = ldb; g.K = K; g.nM = M / BM; g.nN = N / BM; g.nZ = 1; g.zdiv = 1; g.sAo = g.sAi = g.sBo = g.sBi = g.sCo = g.sCi = 0; return g;
}
struct Order {
    int nM, nN, nwg, total, G, c;
    __device__ __forceinline__ void init(const Gemm& g, int G_, int c_) { nM = g.nM; nN = g.nN; nwg = nM * nN; total = nwg * g.nZ; G = G_; c = c_; }
    __device__ __forceinline__ bool next(int i, Unit& u) const {
        const long L = (long)i * G + c; if (L >= total) return false;
        u.z = (int)(L / nwg); int wgid = (int)(L % nwg);
        { const int q = nwg / NXCD, r = nwg % NXCD, xcd = wgid % NXCD, off = wgid / NXCD; wgid = (xcd < r ? xcd * (q + 1) : r * (q + 1) + (xcd - r) * q) + off; }
        const int nig = WGM * nN, gid = wgid / nig, fm = gid * WGM, gsz = (nM - fm) < WGM ? (nM - fm) : WGM;
        u.pm = fm + ((wgid % nig) % gsz); u.pn = (wgid % nig) / gsz; return true;
    }
};

__device__ __forceinline__ unsigned cvt_pk_bf16(float lo, float hi) { return pk2(lo, hi); }

__device__ __forceinline__ void row_scales(const float* PS, int rowbase, int fq, float (&rs)[2][4]) {
#pragma unroll
    for (int ai = 0; ai < 2; ++ai)
#pragma unroll
        for (int m = 0; m < 4; ++m) { const f32x4 p = *(const f32x4*)(PS + (size_t)(rowbase + ai * HALF + m * 16) * 16 + fq * 4);
            float s = (p[0] + p[1]) + (p[2] + p[3]); s += __shfl_xor(s, 16); s += __shfl_xor(s, 32); rs[ai][m] = rsqrtf(s * (1.f / 1024.f) + 1e-6f); }
}
struct EpiBf16 {
    static constexpr bool PERM = true;
    bf16_t* O; int ldc; float scale; const float* PS;
    __device__ __forceinline__ void operator()(const f32x4 (&acc)[2][2][4][2], const Unit& u, long coff, int wr, int wc, int fr, int fq, LAS unsigned char* xl) const {
        const int row0 = u.pm * BM + wr * 64 + fr, col0 = u.pn * BM + wc * 32 + 8 * fq; bf16_t* base = O + coff;
        float rs[2][4];
        if (PS) row_scales(PS, row0, fq, rs);
        else {
#pragma unroll
            for (int ai = 0; ai < 2; ++ai)
#pragma unroll
                for (int m = 0; m < 4; ++m) rs[ai][m] = 1.f; }
#pragma unroll
        for (int ai = 0; ai < 2; ++ai)
#pragma unroll
            for (int m = 0; m < 4; ++m) { bf16_t* rowp = base + (size_t)(row0 + ai * HALF + m * 16) * ldc + col0; const float sc_ = scale * rs[ai][m];
#pragma unroll
                for (int bj = 0; bj < 2; ++bj) { const f32x4 v0 = acc[ai][bj][m][0] * sc_, v1 = acc[ai][bj][m][1] * sc_;
                    u32x4 w; w.x = cvt_pk_bf16(v0[0], v0[1]); w.y = cvt_pk_bf16(v0[2], v0[3]); w.z = cvt_pk_bf16(v1[0], v1[1]); w.w = cvt_pk_bf16(v1[2], v1[3]);
                    *(u32x4*)(rowp + bj * HALF) = w; } }
    }
};
struct EpiResid {
    static constexpr bool PERM = false;
    const float* base; float* out; int ldc;
    __device__ __forceinline__ void operator()(const f32x4 (&acc)[2][2][4][2], const Unit& u, long coff, int wr, int wc, int fr, int fq, LAS unsigned char* xl) const {
        const int col0 = u.pn * BM + wc * 32 + 4 * fq;
#pragma unroll
        for (int ai = 0; ai < 2; ++ai)
#pragma unroll
            for (int m = 0; m < 4; ++m) { const size_t off = (size_t)(u.pm * BM + ai * HALF + wr * 64 + m * 16 + fr) * ldc + col0;
#pragma unroll
                for (int bj = 0; bj < 2; ++bj)
#pragma unroll
                    for (int n = 0; n < 2; ++n) { const f32x4 bs = *(const f32x4*)(base + off + bj * HALF + n * 16); *(f32x4*)(out + off + bj * HALF + n * 16) = bs + acc[ai][bj][m][n]; } }
    }
};
struct EpiResidH {
    static constexpr bool PERM = false;
    const float* base; float* out; bf16_t* HB; float* PS; int ldc;
    __device__ __forceinline__ void operator()(const f32x4 (&acc)[2][2][4][2], const Unit& u, long coff, int wr, int wc, int fr, int fq, LAS unsigned char* xl) const {
        const int col0 = u.pn * BM + wc * 32 + 4 * fq;
#pragma unroll
        for (int ai = 0; ai < 2; ++ai)
#pragma unroll
            for (int m = 0; m < 4; ++m) { const int row = u.pm * BM + ai * HALF + wr * 64 + m * 16 + fr; const size_t off = (size_t)row * ldc + col0; float ss = 0.f;
#pragma unroll
                for (int bj = 0; bj < 2; ++bj)
#pragma unroll
                    for (int n = 0; n < 2; ++n) { const f32x4 bs = *(const f32x4*)(base + off + bj * HALF + n * 16); const f32x4 o = bs + acc[ai][bj][m][n]; *(f32x4*)(out + off + bj * HALF + n * 16) = o;
                        ss += (o[0] * o[0] + o[1] * o[1]) + (o[2] * o[2] + o[3] * o[3]);
                        u32x2 w; w.x = cvt_pk_bf16(o[0], o[1]); w.y = cvt_pk_bf16(o[2], o[3]); *(u32x2*)(HB + off + bj * HALF + n * 16) = w; }
                ss += __shfl_xor(ss, 16); ss += __shfl_xor(ss, 32);
                if (fq == 0) PS[(size_t)row * 16 + u.pn * 4 + wc] = ss; }
    }
};
struct EpiResidB {
    static constexpr bool PERM = false;
    const float* basef; bf16_t* HB; float* PS; int ldc;
    __device__ __forceinline__ void operator()(const f32x4 (&acc)[2][2][4][2], const Unit& u, long coff, int wr, int wc, int fr, int fq, LAS unsigned char* xl) const {
        const int col0 = u.pn * BM + wc * 32 + 4 * fq;
#pragma unroll
        for (int ai = 0; ai < 2; ++ai)
#pragma unroll
            for (int m = 0; m < 4; ++m) { const int row = u.pm * BM + ai * HALF + wr * 64 + m * 16 + fr; const size_t off = (size_t)row * ldc + col0; float ss = 0.f;
#pragma unroll
                for (int bj = 0; bj < 2; ++bj)
#pragma unroll
                    for (int n = 0; n < 2; ++n) { f32x4 bs;
                        if (basef) bs = *(const f32x4*)(basef + off + bj * HALF + n * 16);
                        else { const u32x2 hb = *(const u32x2*)(HB + off + bj * HALF + n * 16); bs = (f32x4){bflo(hb.x), bfhi(hb.x), bflo(hb.y), bfhi(hb.y)}; }
                        const f32x4 o = bs + acc[ai][bj][m][n];
                        ss += (o[0] * o[0] + o[1] * o[1]) + (o[2] * o[2] + o[3] * o[3]);
                        u32x2 w; w.x = cvt_pk_bf16(o[0], o[1]); w.y = cvt_pk_bf16(o[2], o[3]); *(u32x2*)(HB + off + bj * HALF + n * 16) = w; }
                ss += __shfl_xor(ss, 16); ss += __shfl_xor(ss, 32);
                if (fq == 0) PS[(size_t)row * 16 + u.pn * 4 + wc] = ss; }
    }
};
struct EpiSwiglu {
    static constexpr bool PERM = true;
    bf16_t* O; int ldc; const float* PS;
    __device__ __forceinline__ void operator()(const f32x4 (&acc)[2][2][4][2], const Unit& u, long coff, int wr, int wc, int fr, int fq, LAS unsigned char* xl) const {
        const int row0 = u.pm * BM + wr * 64 + fr, col0 = u.pn * HALF + wc * 32 + 8 * fq;
        float rs[2][4]; row_scales(PS, row0, fq, rs);
#pragma unroll
        for (int ai = 0; ai < 2; ++ai)
#pragma unroll
            for (int m = 0; m < 4; ++m) { bf16_t* rowp = O + (size_t)(row0 + ai * HALF + m * 16) * ldc + col0; float r[8]; const float sc_ = rs[ai][m];
#pragma unroll
                for (int n = 0; n < 2; ++n)
#pragma unroll
                    for (int i = 0; i < 4; ++i) { const float g = acc[ai][0][m][n][i] * sc_, uu = acc[ai][1][m][n][i] * sc_; r[n * 4 + i] = siluf_(g) * uu; }
                u32x4 w; w.x = cvt_pk_bf16(r[0], r[1]); w.y = cvt_pk_bf16(r[2], r[3]); w.z = cvt_pk_bf16(r[4], r[5]); w.w = cvt_pk_bf16(r[6], r[7]);
                *(u32x4*)rowp = w; }
    }
};
struct EpiSoftmax {
    static constexpr bool PERM = true;
    bf16_t* O; int ldc;
    __device__ __forceinline__ void operator()(f32x4 (&acc)[2][2][4][2], const Unit& u, long coff, int wr, int wc, int fr, int fq, LAS unsigned char* xl) const {
        LAS float* XM = (LAS float*)xl; LAS float* XS = (LAS float*)(xl + 4096);
#pragma unroll
        for (int ai = 0; ai < 2; ++ai)
#pragma unroll
            for (int m = 0; m < 4; ++m) { float mx = -3.0e38f;
#pragma unroll
                for (int bj = 0; bj < 2; ++bj)
#pragma unroll
                    for (int n = 0; n < 2; ++n)
#pragma unroll
                        for (int i = 0; i < 4; ++i) mx = fmaxf(mx, acc[ai][bj][m][n][i]);
                mx = fmaxf(mx, __shfl_xor(mx, 16)); mx = fmaxf(mx, __shfl_xor(mx, 32));
                if (fq == 0) XM[(ai * HALF + wr * 64 + m * 16 + fr) * 4 + wc] = mx; }
        LDS_WAIT(); __builtin_amdgcn_s_barrier(); asm volatile("" ::: "memory");
#pragma unroll
        for (int ai = 0; ai < 2; ++ai)
#pragma unroll
            for (int m = 0; m < 4; ++m) { const f32x4 mm = *(const LAS f32x4*)(XM + (ai * HALF + wr * 64 + m * 16 + fr) * 4);
                const float mx = fmaxf(fmaxf(mm[0], mm[1]), fmaxf(mm[2], mm[3])); float s = 0.f;
#pragma unroll
                for (int bj = 0; bj < 2; ++bj)
#pragma unroll
                    for (int n = 0; n < 2; ++n)
#pragma unroll
                        for (int i = 0; i < 4; ++i) { const float e = __expf(acc[ai][bj][m][n][i] - mx); acc[ai][bj][m][n][i] = e; s += e; }
                s += __shfl_xor(s, 16); s += __shfl_xor(s, 32);
                if (fq == 0) XS[(ai * HALF + wr * 64 + m * 16 + fr) * 4 + wc] = s; }
        LDS_WAIT(); __builtin_amdgcn_s_barrier(); asm volatile("" ::: "memory");
        const int row0 = u.pm * BM + wr * 64 + fr, col0 = wc * 32 + 8 * fq; bf16_t* base = O + coff;
#pragma unroll
        for (int ai = 0; ai < 2; ++ai)
#pragma unroll
            for (int m = 0; m < 4; ++m) { const f32x4 ss = *(const LAS f32x4*)(XS + (ai * HALF + wr * 64 + m * 16 + fr) * 4);
                const float inv = frcp((ss[0] + ss[1]) + (ss[2] + ss[3])); bf16_t* rowp = base + (size_t)(row0 + ai * HALF + m * 16) * ldc + col0;
#pragma unroll
                for (int bj = 0; bj < 2; ++bj) { const f32x4 v0 = acc[ai][bj][m][0] * inv, v1 = acc[ai][bj][m][1] * inv;
                    u32x4 w; w.x = cvt_pk_bf16(v0[0], v0[1]); w.y = cvt_pk_bf16(v0[2], v0[3]); w.z = cvt_pk_bf16(v1[0], v1[1]); w.w = cvt_pk_bf16(v1[2], v1[3]);
                    *(u32x4*)(rowp + bj * HALF) = w; } }
    }
};

template <class Epi, bool ALIGN_EPI>
__device__ __forceinline__ void gemm_phase(LAS unsigned char* lds, LAS unsigned char* xl, const Gemm g, const Order& S, Epi& E) {
    const int tid = threadIdx.x, wid = __builtin_amdgcn_readfirstlane(tid >> 6), lane = tid & 63, wr = wid >> 2, wc = wid & 3, fr = lane & 15, fq = lane >> 4;
    const int K = g.K, nt = K / BK;
    unsigned voffA[2], voffB[2];
#pragma unroll
    for (int i = 0; i < 2; ++i) { int R, C; stage_rc(tid * 16 + i * 8192, R, C); const int Rb = Epi::PERM ? ((R & ~31) + perm32(R & 31)) : R;
        voffA[i] = (unsigned)(R * g.lda + C) * 2u; voffB[i] = (unsigned)(Rb * g.ldb + C) * 2u; }
    const size_t kstep = (size_t)(BK * 2);
    const size_t hstepA = (size_t)HALF * g.lda * 2, hstepB = (size_t)HALF * g.ldb * 2;
    const unsigned ldsw = (unsigned)wid * 1024u;
    const int aoff = lds_byte(wr * 64 + fr, fq * 8), boff = lds_byte(wc * 32 + fr, fq * 8);
#define PG8_SA(b, h) (((b) * 2 + (h)) * HTB)
#define PG8_SB(b, h) ((4 + (b) * 2 + (h)) * HTB)
#define PG8_STAGE(bufoff, gbase, voff) do { _Pragma("unroll") for (int _i = 0; _i < 2; ++_i) \
        __builtin_amdgcn_global_load_lds((const unsigned*)((const char*)(gbase) + (voff)[_i]), (LAS unsigned*)(lds + (bufoff) + ldsw + _i * 8192), 16, 0, 0); } while (0)
#define PG8_LDA(dst, b, h) do { _Pragma("unroll") for (int m = 0; m < 4; ++m) _Pragma("unroll") for (int k = 0; k < 2; ++k) dst[m][k] = *(const LAS bf16x8*)(lds + PG8_SA(b, h) + aoff + m * 2048 + k * 1024); } while (0)
#define PG8_LDB(dst, b, h) do { _Pragma("unroll") for (int n = 0; n < 2; ++n) _Pragma("unroll") for (int k = 0; k < 2; ++k) dst[n][k] = *(const LAS bf16x8*)(lds + PG8_SB(b, h) + boff + n * 2048 + k * 1024); } while (0)
#define PG8_MMA(ai, bj, At, Bt) do { __builtin_amdgcn_s_setprio(1); _Pragma("unroll") for (int m = 0; m < 4; ++m) _Pragma("unroll") for (int n = 0; n < 2; ++n) _Pragma("unroll") for (int k = 0; k < 2; ++k) \
        acc[ai][bj][m][n] = __builtin_amdgcn_mfma_f32_16x16x32_bf16(Bt[n][k], At[m][k], acc[ai][bj][m][n], 0, 0, 0); __builtin_amdgcn_s_setprio(0); } while (0)
#define PG8_WAIT_V(n) asm volatile("s_waitcnt vmcnt(" #n ")" ::: "memory")
#define PG8_WAIT_L(n) asm volatile("s_waitcnt lgkmcnt(" #n ")" ::: "memory")
#define PG8_BAR __builtin_amdgcn_s_barrier()
#define PG8_SCHED __builtin_amdgcn_sched_barrier(0)
    Unit cur, nxt; int ui = 0;
    if (!S.next(0, cur)) return;
    f32x4 acc[2][2][4][2];
#pragma unroll
    for (int a = 0; a < 2; ++a)
#pragma unroll
        for (int b = 0; b < 2; ++b)
#pragma unroll
            for (int m = 0; m < 4; ++m)
#pragma unroll
                for (int n = 0; n < 2; ++n) acc[a][b][m][n] = (f32x4){0.f, 0.f, 0.f, 0.f};
    bf16x8 At[4][2], B0[2][2], B1[2][2];
    const char* cA = (const char*)g.A + 2 * g.offA(cur); const char* cB = (const char*)g.Bt + 2 * g.offB(cur);
    PG8_STAGE(PG8_SB(0, 0), cB, voffB); PG8_STAGE(PG8_SB(0, 1), cB + hstepB, voffB); PG8_STAGE(PG8_SA(0, 0), cA, voffA); PG8_STAGE(PG8_SA(0, 1), cA + hstepA, voffA);
    if (wr == 1) PG8_BAR;
    PG8_WAIT_V(2); PG8_BAR;
    PG8_STAGE(PG8_SB(1, 0), cB + kstep, voffB); PG8_STAGE(PG8_SA(1, 0), cA + kstep, voffA); PG8_STAGE(PG8_SB(1, 1), cB + hstepB + kstep, voffB);
    PG8_WAIT_V(6); PG8_BAR;
    for (;;) {
        const bool has_next = S.next(ui + 1, nxt);
        const char* nA = has_next ? (const char*)g.A + 2 * g.offA(nxt) : cA; const char* nB = has_next ? (const char*)g.Bt + 2 * g.offB(nxt) : cB;
        for (int t = 0; t < nt; t += 2) {
            const bool last = (t == nt - 2);
            const char* a1 = cA + (size_t)(t + 1) * kstep;
            const char* a2 = last ? nA : cA + (size_t)(t + 2) * kstep; const char* b2 = last ? nB : cB + (size_t)(t + 2) * kstep;
            const char* a3 = a2 + kstep; const char* b3 = b2 + kstep;
            PG8_LDB(B0, 0, 0); PG8_LDB(B1, 0, 1); PG8_SCHED; PG8_LDA(At, 0, 0); PG8_STAGE(PG8_SA(1, 1), a1 + hstepA, voffA);
            PG8_WAIT_V(8); PG8_WAIT_L(0); PG8_BAR; PG8_MMA(0, 0, At, B0); PG8_MMA(0, 1, At, B1); PG8_BAR; PG8_SCHED;
            PG8_LDA(At, 0, 1); PG8_STAGE(PG8_SB(0, 0), b2, voffB); PG8_STAGE(PG8_SB(0, 1), b2 + hstepB, voffB); PG8_STAGE(PG8_SA(0, 0), a2, voffA);
            PG8_WAIT_V(8); PG8_WAIT_L(0); PG8_BAR; PG8_MMA(1, 0, At, B0); PG8_MMA(1, 1, At, B1); PG8_BAR; PG8_SCHED;
            PG8_LDB(B0, 1, 0); PG8_LDB(B1, 1, 1); PG8_SCHED; PG8_LDA(At, 1, 0); PG8_STAGE(PG8_SA(0, 1), a2 + hstepA, voffA);
            PG8_WAIT_V(8); PG8_WAIT_L(0); PG8_BAR; PG8_MMA(0, 0, At, B0); PG8_MMA(0, 1, At, B1); PG8_BAR; PG8_SCHED;
            PG8_LDA(At, 1, 1); PG8_STAGE(PG8_SB(1, 0), b3, voffB); PG8_STAGE(PG8_SB(1, 1), b3 + hstepB, voffB); PG8_STAGE(PG8_SA(1, 0), a3, voffA);
            PG8_WAIT_V(8); PG8_WAIT_L(0); PG8_BAR; PG8_MMA(1, 0, At, B0); PG8_MMA(1, 1, At, B1); PG8_BAR; PG8_SCHED;
        }
        if constexpr (ALIGN_EPI) { if (wr == 0) PG8_BAR; }
        E(acc, cur, g.offC(cur), wr, wc, fr, fq, xl);
        if (!has_next) break;
#pragma unroll
        for (int a = 0; a < 2; ++a)
#pragma unroll
            for (int b = 0; b < 2; ++b)
#pragma unroll
                for (int m = 0; m < 4; ++m)
#pragma unroll
                    for (int n = 0; n < 2; ++n) acc[a][b][m][n] = (f32x4){0.f, 0.f, 0.f, 0.f};
        cur = nxt; cA = nA; cB = nB; ++ui;
        if constexpr (ALIGN_EPI) { if (wr == 1) PG8_BAR; }
    }
    PG8_WAIT_V(0);
    if constexpr (!ALIGN_EPI) { if (wr == 0) PG8_BAR; }
    PG8_BAR;
#undef PG8_SA
#undef PG8_SB
#undef PG8_STAGE
#undef PG8_LDA
#undef PG8_LDB
#undef PG8_MMA
#undef PG8_WAIT_V
#undef PG8_WAIT_L
#undef PG8_BAR
#undef PG8_SCHED
}
}

__device__ __forceinline__ f32x4 mfma16(bf16x8 bfrag, bf16x8 afrag, f32x4 acc) { return __builtin_amdgcn_mfma_f32_16x16x32_bf16(bfrag, afrag, acc, 0, 0, 0); }
__device__ __forceinline__ bf16x8 ldsfrag(const LAS bf16_t* base, int ld, int r0, int k0, int fr, int fq) { return *(const LAS bf16x8*)(base + (r0 + fr) * ld + k0 + fq * 8); }

template <int MODE> __device__ __forceinline__ void transpose_item(const float* W, int K, int N, bf16_t* WT, LAS float* scr, int item, int nblk, int lane, const float* gain = nullptr) {
    const int kb = item / nblk, nb = item % nblk, k0 = 64 * kb, n0 = 32 * nb; const int nsrc = n0 + (lane & 31);
#pragma unroll 8
    for (int i = 0; i < 32; ++i) { const int kk = 2 * i + (lane >> 5); scr[kk * 33 + (lane & 31)] = (nsrc < N) ? W[(size_t)(k0 + kk) * N + nsrc] * (gain ? gain[k0 + kk] : 1.f) : 0.f; }
    LDS_WAIT();
    const int c = lane & 7;
#pragma unroll
    for (int j = 0; j < 4; ++j) { const int n = (lane >> 3) + 8 * j; const LAS float* s = scr + (8 * c) * 33 + n;
        u32x4 o; o.x = pk2(s[0 * 33], s[1 * 33]); o.y = pk2(s[2 * 33], s[3 * 33]); o.z = pk2(s[4 * 33], s[5 * 33]); o.w = pk2(s[6 * 33], s[7 * 33]);
        int drow = n0 + n; if (MODE == 1) { const int jn = drow % FFN, isu = drow / FFN; drow = (jn / 128) * 256 + isu * 128 + (jn % 128); }
        *(u32x4*)(WT + (size_t)drow * K + k0 + 8 * c) = o; }
    LDS_WAIT();
}
__device__ __forceinline__ void rms_row_bf16(const float* xrow, const float* gain, bf16_t* orow, int lane) {
    const f32x4* xr = (const f32x4*)xrow + lane; f32x4 v[4]; float s = 0.f;
#pragma unroll
    for (int j = 0; j < 4; ++j) { v[j] = xr[64 * j]; s += (v[j].x * v[j].x + v[j].y * v[j].y) + (v[j].z * v[j].z + v[j].w * v[j].w); }
    const float rs = rsqrtf(wave_sum(s) * (1.f / D) + 1e-6f);
    const f32x4* gr = (const f32x4*)gain + lane; u32x2* o8 = (u32x2*)orow + lane;
#pragma unroll
    for (int j = 0; j < 4; ++j) { const f32x4 g = gr[64 * j]; u32x2 w; w.x = pk2(v[j].x * rs * g.x, v[j].y * rs * g.y); w.y = pk2(v[j].z * rs * g.z, v[j].w * rs * g.w); o8[64 * j] = w; }
}
__device__ __forceinline__ void rms_row2_bf16(const float* xa, const float* xb, const float* gain, bf16_t* oa, bf16_t* ob, int lane) {
    const f32x4* ra = (const f32x4*)xa + lane; const f32x4* rb = (const f32x4*)xb + lane; f32x4 va[4], vb[4]; float sa = 0.f, sb = 0.f;
#pragma unroll
    for (int j = 0; j < 4; ++j) { va[j] = ra[64 * j]; vb[j] = rb[64 * j]; }
#pragma unroll
    for (int j = 0; j < 4; ++j) { sa += (va[j].x * va[j].x + va[j].y * va[j].y) + (va[j].z * va[j].z + va[j].w * va[j].w); sb += (vb[j].x * vb[j].x + vb[j].y * vb[j].y) + (vb[j].z * vb[j].z + vb[j].w * vb[j].w); }
#pragma unroll
    for (int o = 1; o < 64; o <<= 1) { sa += __shfl_xor(sa, o); sb += __shfl_xor(sb, o); }
    const float rsa = rsqrtf(sa * (1.f / D) + 1e-6f), rsb = rsqrtf(sb * (1.f / D) + 1e-6f);
    const f32x4* gr = (const f32x4*)gain + lane; u32x2* pa = (u32x2*)oa + lane; u32x2* pb = (u32x2*)ob + lane;
#pragma unroll
    for (int j = 0; j < 4; ++j) { const f32x4 g = gr[64 * j]; u32x2 w;
        w.x = pk2(va[j].x * rsa * g.x, va[j].y * rsa * g.y); w.y = pk2(va[j].z * rsa * g.z, va[j].w * rsa * g.w); pa[64 * j] = w;
        w.x = pk2(vb[j].x * rsb * g.x, vb[j].y * rsb * g.y); w.y = pk2(vb[j].z * rsb * g.z, vb[j].w * rsb * g.w); pb[64 * j] = w; }
}
__device__ __forceinline__ void rms_rows_phase(const float* X, const float* gain, bf16_t* H, int nrows, int gw, int NGW, int lane) {
    int m = gw;
    for (; m + NGW < nrows; m += 2 * NGW) rms_row2_bf16(X + (size_t)m * D, X + (size_t)(m + NGW) * D, gain, H + (size_t)m * D, H + (size_t)(m + NGW) * D, lane);
    if (m < nrows) rms_row_bf16(X + (size_t)m * D, gain, H + (size_t)m * D, lane);
}

__device__ __forceinline__ void rwkv_chain(LAS unsigned char* lds, int cid, const bf16_t* P0, const float* mu, const float* w0, const float* w2, const float* a0, const float* a2,
                                           const float* k_k, const float* k_a, const float* r_k, bf16_t* ORW, bf16_t* SG, float* BONUS) {
    const int tid = threadIdx.x, lane = tid & 63, wid = tid >> 6, fr = lane & 15, fq = lane >> 4;
    const int b = cid >> 4, h = (cid >> 1) & 7, dir = cid & 1;
    LAS float* rS = (LAS float*)(lds); LAS float* kS = (LAS float*)(lds + 8192); LAS float* vS = (LAS float*)(lds + 16384); LAS float* wS = (LAS float*)(lds + 24576);
    LAS float* nkS = (LAS float*)(lds + 32768); LAS float* bS = (LAS float*)(lds + 40960); LAS float* preA = (LAS float*)(lds + 49152); LAS float* preW = (LAS float*)(lds + 57344);
    LAS bf16_t* adB = (LAS bf16_t*)(lds + 65536); LAS bf16_t* wdB = (LAS bf16_t*)(lds + 70144);
    LAS bf16_t* a2B = (LAS bf16_t*)(lds + 74752); LAS bf16_t* w2B = (LAS bf16_t*)(lds + 83968); LAS float* cst = (LAS float*)(lds + 93184);
    LAS bf16_t* At = (LAS bf16_t*)(lds + 97280); LAS bf16_t* Bt = (LAS bf16_t*)(lds + 101888); LAS bf16_t* Kt = (LAS bf16_t*)(lds + 106496); LAS bf16_t* Rt = (LAS bf16_t*)(lds + 111104);
    LAS bf16_t* BtT = (LAS bf16_t*)(lds + 115712); LAS bf16_t* KtT = (LAS bf16_t*)(lds + 120832); LAS bf16_t* VT = (LAS bf16_t*)(lds + 125952); LAS bf16_t* S0b = (LAS bf16_t*)(lds + 131072);
    LAS float* NT4 = (LAS float*)(lds + 140288); LAS bf16_t* NakT = (LAS bf16_t*)(lds + 146432); LAS bf16_t* MbrT = (LAS bf16_t*)(lds + 148992); LAS bf16_t* MkrT = (LAS bf16_t*)(lds + 151552);
    LAS float* gL = (LAS float*)(lds + 154112);
    LAS float* WS = preA;
    LAS bf16_t* Ub = (LAS bf16_t*)preW;
#define RW_IDS int tid_o = threadIdx.x; asm volatile("" : "+v"(tid_o)); const int tid = tid_o, lane = tid & 63, wid = __builtin_amdgcn_readfirstlane(tid >> 6), fr = lane & 15, fq = lane >> 4, vt = wid >> 1, tt2 = wid & 1; (void)lane; (void)wid; (void)fr; (void)fq; (void)vt; (void)tt2;
    __syncthreads();
    for (int e = tid; e < 64 * 64; e += 512) { const int j = e & 63, r = e >> 6;
        a2B[j * 72 + r] = (bf16_t)f2bf(a2[r * 512 + h * 64 + j]); w2B[j * 72 + r] = (bf16_t)f2bf(w2[(dir * 64 + r) * 512 + h * 64 + j]); }
    for (int e = tid; e < 64 * 72 / 2; e += 512) ((LAS unsigned*)S0b)[e] = 0u;
    if (tid < 64) { const int j = tid, c = h * 64 + j;
        cst[0 * 64 + j] = a0[c]; cst[1 * 64 + j] = w0[dir * 512 + c]; cst[2 * 64 + j] = k_k[c]; cst[3 * 64 + j] = k_a[c]; cst[4 * 64 + j] = r_k[c];
        cst[5 * 64 + j] = mu[c]; cst[6 * 64 + j] = mu[512 + c]; cst[7 * 64 + j] = mu[1024 + c]; cst[8 * 64 + j] = mu[1536 + j]; cst[9 * 64 + j] = mu[1600 + j];
        cst[10 * 64 + j] = (j < 16) ? mu[1664 + h * 16 + j] : 0.f; }
    const int vt = wid >> 1, tt2 = wid & 1;
    f32x4 st[2]; st[0] = (f32x4){0.f, 0.f, 0.f, 0.f}; st[1] = st[0];
    __syncthreads();
    const bf16_t* Pb = P0 + (size_t)b * SEQ * ABPAD;
    unsigned rc[10], rpv[10], rnx[10]; unsigned short gcv = 0, gpv = 0, gnv = 0;
#define RW_IDX(i) const int grp = (i) >> 1; const int idx_ = tid + 512 * ((i) & 1); const int tok = idx_ >> 5, c2 = (idx_ & 31) * 2; \
                  const int gcol = (grp == 0 ? h * 64 : grp == 1 ? 512 + h * 64 : grp == 2 ? 1024 + h * 64 : grp == 3 ? 1536 : 1600) + c2;
    const unsigned voff = (unsigned)((((int)threadIdx.x >> 5) * ABPAD + ((int)threadIdx.x & 31) * 2) * 2);
#define RW_CG(g) ((g) == 0 ? h * 128 : (g) == 1 ? 1024 + h * 128 : (g) == 2 ? 2048 + h * 128 : (g) == 3 ? 3072 : 3200)
#define RW_ISSUE(t0n) do { const char* bp_ = (const char*)(Pb + (size_t)(t0n) * ABPAD); const bool first_ = ((t0n) == 0) && (tid < 32), last_ = ((t0n) == SEQ - 32) && (tid >= 480); \
        _Pragma("unroll") for (int i = 0; i < 10; ++i) { const char* p = bp_ + (RW_CG(i >> 1) + (i & 1) * 16 * ABPAD * 2) + voff; \
            rc[i] = *(const unsigned*)p; \
            if ((i & 1) == 0) { const unsigned v_ = *(const unsigned*)(p - (first_ ? 0 : ABPAD * 2)); rpv[i] = first_ ? 0u : v_; rnx[i] = *(const unsigned*)(p + ABPAD * 2); } \
            else { const unsigned v_ = *(const unsigned*)(p + (last_ ? 0 : ABPAD * 2)); rnx[i] = last_ ? 0u : v_; rpv[i] = *(const unsigned*)(p - ABPAD * 2); } } \
        if (dir == 0) { const bool fg_ = ((t0n) == 0) && (tid < 16), lg_ = ((t0n) == SEQ - 32) && (tid >= 496); \
            const bf16_t* p = (const bf16_t*)bp_ + (size_t)(tid >> 4) * ABPAD + 1664 + h * 16 + (tid & 15); \
            gcv = *p; { const unsigned short v_ = *(p - (fg_ ? 0 : ABPAD)); gpv = fg_ ? (unsigned short)0 : v_; } { const unsigned short v_ = *(p + (lg_ ? 0 : ABPAD)); gnv = lg_ ? (unsigned short)0 : v_; } } } while (0)
    RW_ISSUE(dir ? 127 * 32 : 0);
    for (int cc = 0; cc < 128; ++cc) {
        const int t0 = dir ? (127 - cc) * 32 : cc * 32;
        { RW_IDS
#pragma unroll
        for (int i = 0; i < 10; ++i) { RW_IDX(i) (void)gcol;
            const unsigned cur = rc[i], prv = rpv[i], nxt = rnx[i];
            const float m0 = cst[(5 + grp) * 64 + c2], m1 = cst[(5 + grp) * 64 + c2 + 1];
            const float c0 = bflo(cur), c1 = bfhi(cur);
            const float x0 = c0 + m0 * (0.5f * (bflo(prv) + bflo(nxt)) - c0), x1 = c1 + m1 * (0.5f * (bfhi(prv) + bfhi(nxt)) - c1);
            if (grp == 0) { *(LAS f32x2*)(rS + tok * 64 + c2) = (f32x2){x0, x1}; }
            else if (grp == 1) { *(LAS f32x2*)(kS + tok * 64 + c2) = (f32x2){x0, x1}; }
            else if (grp == 2) { *(LAS f32x2*)(vS + tok * 64 + c2) = (f32x2){x0, x1}; }
            else if (grp == 3) { const float e0 = __expf(2.f * x0), e1 = __expf(2.f * x1); *(LAS unsigned*)(wdB + tok * 72 + c2) = pk2(1.f - 2.f * frcp(e0 + 1.f), 1.f - 2.f * frcp(e1 + 1.f)); }
            else { *(LAS unsigned*)(adB + tok * 72 + c2) = pk2(x0, x1); }
        }
        if (dir == 0) {
            const int tok = tid >> 4, c = tid & 15, t = t0 + tok;
            const float cur = bf2f(gcv), prv = bf2f(gpv), nxt = bf2f(gnv);
            const float x = cur + cst[10 * 64 + c] * (0.5f * (prv + nxt) - cur);
            SG[((size_t)b * SEQ + t) * 128 + h * 16 + c] = (bf16_t)f2bf(sigmoidf_(x));
        } }
        __syncthreads();
        if (cc + 1 < 128) { RW_IDS const int t0n = dir ? (126 - cc) * 32 : (cc + 1) * 32; RW_ISSUE(t0n); }
        { RW_IDS const int mat = wid >> 2, ntile = wid & 3; const LAS bf16_t* Aop = mat ? wdB : adB; const LAS bf16_t* Bop = mat ? w2B : a2B; LAS float* pre = mat ? preW : preA;
#pragma unroll
          for (int mt = 0; mt < 2; ++mt) { f32x4 acc = (f32x4){0.f, 0.f, 0.f, 0.f};
#pragma unroll
              for (int ks = 0; ks < 2; ++ks) acc = mfma16(ldsfrag(Bop, 72, ntile * 16, ks * 32, fr, fq), ldsfrag(Aop, 72, mt * 16, ks * 32, fr, fq), acc);
              *(LAS f32x4*)(pre + (mt * 16 + fr) * 64 + ntile * 16 + fq * 4) = acc; } }
        __syncthreads();
        { RW_IDS const int tok = tid >> 4, c0 = (tid & 15) * 4; float kkr[4], av[4], kp[4], wv[4]; float ss = 0.f, bon = 0.f;
#pragma unroll
          for (int i = 0; i < 4; ++i) { const int c = c0 + i, ix = tok * 64 + c;
              const float a = sigmoidf_(cst[c] + preA[ix]); const float sg = sigmoidf_(cst[64 + c] + preW[ix]);
              wv[i] = -0.60653065971f * sg;
              const float kraw = kS[ix]; kkr[i] = kraw * cst[128 + c]; ss += kkr[i] * kkr[i];
              kp[i] = kraw * (1.0f + (a - 1.0f) * cst[192 + c]); av[i] = a; bon += rS[ix] * kp[i] * cst[256 + c]; }
          ss += dppf<0xB1>(ss); bon += dppf<0xB1>(bon); ss += dppf<0x4E>(ss); bon += dppf<0x4E>(bon);
          ss += dppf<0x141>(ss); bon += dppf<0x141>(bon); ss += dppf<0x140>(ss); bon += dppf<0x140>(bon);
          const float inv = frcp(fmaxf(__builtin_amdgcn_sqrtf(ss), 1e-12f));
          f32x4 o_nk, o_b, o_k, o_w;
#pragma unroll
          for (int i = 0; i < 4; ++i) { const float kk = kkr[i] * inv; o_nk[i] = -kk; o_b[i] = kk * av[i]; o_k[i] = kp[i]; o_w[i] = wv[i]; }
          *(LAS f32x4*)(nkS + tok * 64 + c0) = o_nk; *(LAS f32x4*)(bS + tok * 64 + c0) = o_b; *(LAS f32x4*)(kS + tok * 64 + c0) = o_k; *(LAS f32x4*)(wS + tok * 64 + c0) = o_w;
          if (dir == 0 && (tid & 15) == 0) BONUS[((size_t)b * SEQ + t0 + tok) * 8 + h] = bon; }
        __syncthreads();
        { RW_IDS if (tid < 64) { float lw[32];
#pragma unroll
            for (int s = 0; s < 32; ++s) lw[s] = wS[(dir ? 31 - s : s) * 64 + tid];
#pragma unroll
            for (int s = 1; s < 32; ++s) lw[s] += lw[s - 1];
#pragma unroll
            for (int s = 0; s < 32; ++s) wS[(dir ? 31 - s : s) * 64 + tid] = lw[s]; } }
        __syncthreads();
        { RW_IDS const int s = tid >> 4, c0 = (tid & 15) * 4; const int tok = dir ? 31 - s : s, tokp = dir ? tok + 1 : tok - 1;
          const f32x4 cum = *(const LAS f32x4*)(wS + tok * 64 + c0); f32x4 cump = (f32x4){0.f, 0.f, 0.f, 0.f}; if (s > 0) cump = *(const LAS f32x4*)(wS + tokp * 64 + c0);
          const f32x4 nk4 = *(const LAS f32x4*)(nkS + tok * 64 + c0), b4 = *(const LAS f32x4*)(bS + tok * 64 + c0), k4 = *(const LAS f32x4*)(kS + tok * 64 + c0), r4 = *(const LAS f32x4*)(rS + tok * 64 + c0), v4 = *(const LAS f32x4*)(vS + tok * 64 + c0);
          float ta[4], tb[4], tk[4], tr[4];
#pragma unroll
          for (int i = 0; i < 4; ++i) { const float g = __expf(cum[i]), gp = __expf(cump[i]), ig = __expf(-cum[i]);
              ta[i] = nk4[i] * gp; tb[i] = b4[i] * ig; tk[i] = k4[i] * ig; tr[i] = r4[i] * g;
              BtT[(c0 + i) * 40 + s] = (bf16_t)f2bf(tb[i]); KtT[(c0 + i) * 40 + s] = (bf16_t)f2bf(tk[i]); VT[(c0 + i) * 40 + s] = (bf16_t)f2bf(v4[i]);
              if (s == 31) gL[c0 + i] = g; }
          u32x2 w; w.x = pk2(ta[0], ta[1]); w.y = pk2(ta[2], ta[3]); *(LAS u32x2*)(At + s * 72 + c0) = w;
          w.x = pk2(tb[0], tb[1]); w.y = pk2(tb[2], tb[3]); *(LAS u32x2*)(Bt + s * 72 + c0) = w;
          w.x = pk2(tk[0], tk[1]); w.y = pk2(tk[2], tk[3]); *(LAS u32x2*)(Kt + s * 72 + c0) = w;
          w.x = pk2(tr[0], tr[1]); w.y = pk2(tr[2], tr[3]); *(LAS u32x2*)(Rt + s * 72 + c0) = w; }
        __syncthreads();
        { RW_IDS const int mat = wid >> 1, mt = wid & 1; const LAS bf16_t* Aop = (mat < 2) ? At : Rt; const LAS bf16_t* Bop = (mat & 1) ? Kt : Bt;
#pragma unroll
          for (int nt = 0; nt < 2; ++nt) { f32x4 acc = (f32x4){0.f, 0.f, 0.f, 0.f};
#pragma unroll
              for (int ks = 0; ks < 2; ++ks) acc = mfma16(ldsfrag(Bop, 72, nt * 16, ks * 32, fr, fq), ldsfrag(Aop, 72, mt * 16, ks * 32, fr, fq), acc);
              const int srow = mt * 16 + fr;
#pragma unroll
              for (int e = 0; e < 4; ++e) { const int i = nt * 16 + fq * 4 + e; const bool keep = (mat < 2) ? (i < srow) : (i <= srow); if (!keep) acc[e] = 0.f; }
              if (mat == 0) {
#pragma unroll
                  for (int e = 0; e < 4; ++e) NT4[e * 384 + srow * 12 + nt * 4 + fq] = acc[e]; }
              else { LAS bf16_t* X = (mat == 1) ? NakT : (mat == 2) ? MbrT : MkrT; u32x2 o; o.x = pk2(acc[0], acc[1]); o.y = pk2(acc[2], acc[3]); *(LAS u32x2*)(X + srow * 40 + nt * 16 + fq * 4) = o; } } }
        __syncthreads();
        f32x4 oacc = (f32x4){0.f, 0.f, 0.f, 0.f};
        { RW_IDS f32x4 wacc = (f32x4){0.f, 0.f, 0.f, 0.f};
#pragma unroll
          for (int ks = 0; ks < 2; ++ks) { const bf16x8 sf = ldsfrag(S0b, 72, vt * 16, ks * 32, fr, fq);
              wacc = mfma16(ldsfrag(At, 72, tt2 * 16, ks * 32, fr, fq), sf, wacc); oacc = mfma16(ldsfrag(Rt, 72, tt2 * 16, ks * 32, fr, fq), sf, oacc); }
          const bf16x8 vf = ldsfrag(VT, 40, vt * 16, 0, fr, fq);
          wacc = mfma16(ldsfrag(NakT, 40, tt2 * 16, 0, fr, fq), vf, wacc); oacc = mfma16(ldsfrag(MkrT, 40, tt2 * 16, 0, fr, fq), vf, oacc);
#pragma unroll
          for (int n2 = 0; n2 < 2; ++n2) st[n2] = mfma16(ldsfrag(KtT, 40, (tt2 * 2 + n2) * 16, 0, fr, fq), vf, st[n2]);
#pragma unroll
          for (int e = 0; e < 4; ++e) WS[(tt2 * 16 + fq * 4 + e) * 64 + vt * 16 + fr] = wacc[e]; }
        __syncthreads();
        { RW_IDS if (wid < 4) { const int v = wid * 16 + (lane >> 2), p = lane & 3; const LAS float* NTp = NT4 + p * 384; float u[8];
#pragma unroll
            for (int j = 0; j < 8; ++j) u[j] = 0.f;
#pragma unroll
            for (int t = 0; t < 32; ++t) { float q0 = (p == 0) ? WS[t * 64 + v] : 0.f, q1 = 0.f;
#pragma unroll
                for (int j4 = 0; j4 < ((t + 3) / 4 + 3) / 4; ++j4) { const f32x4 nv = *(const LAS f32x4*)(NTp + t * 12 + j4 * 4);
                    q0 += u[j4 * 4] * nv[0]; q1 += u[j4 * 4 + 1] * nv[1]; q0 += u[j4 * 4 + 2] * nv[2]; q1 += u[j4 * 4 + 3] * nv[3]; }
                float q = q0 + q1; q += dppf<0xB1>(q); q += dppf<0x4E>(q);
                u[t >> 2] = ((t & 3) == p) ? q : u[t >> 2]; asm volatile("" ::: "memory"); }
#pragma unroll
            for (int j = 0; j < 8; ++j) Ub[v * 40 + 4 * j + p] = (bf16_t)f2bf(u[j]); } }
        __syncthreads();
        { RW_IDS const bf16x8 uf = ldsfrag(Ub, 40, vt * 16, 0, fr, fq);
          oacc = mfma16(ldsfrag(MbrT, 40, tt2 * 16, 0, fr, fq), uf, oacc);
#pragma unroll
          for (int e = 0; e < 4; ++e) { const int sidx = tt2 * 16 + fq * 4 + e, tok = dir ? 31 - sidx : sidx;
              ORW[(size_t)dir * T * 512 + ((size_t)b * SEQ + t0 + tok) * 512 + h * 64 + vt * 16 + fr] = (bf16_t)f2bf(oacc[e]); }
#pragma unroll
          for (int n2 = 0; n2 < 2; ++n2) { const int kt = tt2 * 2 + n2; st[n2] = mfma16(ldsfrag(BtT, 40, kt * 16, 0, fr, fq), uf, st[n2]);
              const f32x4 gl = *(const LAS f32x4*)(gL + kt * 16 + fq * 4); st[n2] = st[n2] * gl;
              u32x2 o; o.x = pk2(st[n2][0], st[n2][1]); o.y = pk2(st[n2][2], st[n2][3]); *(LAS u32x2*)(S0b + (vt * 16 + fr) * 72 + kt * 16 + fq * 4) = o; } }
    }
#undef RW_IDX
#undef RW_ISSUE
#undef RW_IDS
#undef RW_CG
    __syncthreads();
}

__device__ __forceinline__ void rwkv_combine(const bf16_t* P0, const bf16_t* ORW, const float* BONUS, const bf16_t* G, const float* mu, const float* gn_w, const float* gn_b, bf16_t* OMIX, int gw, int NGW, int lane) {
    const int c0 = lane * 8, head = lane >> 3;
    float muv[8], gw8[8], gb8[8];
#pragma unroll
    for (int i = 0; i < 8; ++i) { muv[i] = mu[1024 + c0 + i]; gw8[i] = gn_w[c0 + i]; gb8[i] = gn_b[c0 + i]; }
#pragma unroll 2
    for (int tk = gw; tk < T; tk += NGW) {
        const int t = tk & (SEQ - 1);
        const u32x4 uf = *(const u32x4*)(ORW + (size_t)tk * 512 + c0), ub = *(const u32x4*)(ORW + (size_t)T * 512 + (size_t)tk * 512 + c0);
        float o[8];
#pragma unroll
        for (int i = 0; i < 4; ++i) { o[2 * i] = bflo(uf[i]) + bflo(ub[i]); o[2 * i + 1] = bfhi(uf[i]) + bfhi(ub[i]); }
        float s = 0.f;
#pragma unroll
        for (int i = 0; i < 8; ++i) s += o[i];
        const float mean = sum8(s) * (1.f / 64.f); float q = 0.f;
#pragma unroll
        for (int i = 0; i < 8; ++i) { o[i] -= mean; q += o[i] * o[i]; }
        const float rstd = rsqrtf(sum8(q) * (1.f / 64.f) + 64e-5f);
        const bf16_t* pv = P0 + (size_t)tk * ABPAD + 1024 + c0;
        const u32x4 vc = *(const u32x4*)pv; u32x4 vp = (u32x4){0u, 0u, 0u, 0u}, vn = (u32x4){0u, 0u, 0u, 0u};
        if (t > 0) vp = *(const u32x4*)(pv - ABPAD);
        if (t < SEQ - 1) vn = *(const u32x4*)(pv + ABPAD);
        const u32x4 gg = *(const u32x4*)(G + (size_t)tk * 512 + c0);
        const float bon = BONUS[(size_t)tk * 8 + head];
        float r[8];
#pragma unroll
        for (int i = 0; i < 4; ++i) {
            const float c_lo = bflo(vc[i]), c_hi = bfhi(vc[i]);
            const float v_lo = c_lo + muv[2 * i] * (0.5f * (bflo(vp[i]) + bflo(vn[i])) - c_lo), v_hi = c_hi + muv[2 * i + 1] * (0.5f * (bfhi(vp[i]) + bfhi(vn[i])) - c_hi);
            r[2 * i] = (o[2 * i] * rstd * gw8[2 * i] + gb8[2 * i] + bon * v_lo) * bflo(gg[i]);
            r[2 * i + 1] = (o[2 * i + 1] * rstd * gw8[2 * i + 1] + gb8[2 * i + 1] + bon * v_hi) * bfhi(gg[i]); }
        u32x4 w; w.x = pk2(r[0], r[1]); w.y = pk2(r[2], r[3]); w.z = pk2(r[4], r[5]); w.w = pk2(r[6], r[7]);
        *(u32x4*)(OMIX + (size_t)tk * D + c0) = w;
    }
}

constexpr int SLD = 136;
__device__ __forceinline__ float softplusf_(float x) { return x > 20.f ? x : log1pf(__expf(x)); }
__device__ __forceinline__ void ssd_dt_cum(LAS float* dtS, LAS float* cumS, LAS float* totS, const bf16_t* Prow0, int g, int w, int lane, const float* dt_bias, const float* a_log) {
    const int j = w >> 1, d = w & 1, head = g * 4 + j;
    const float bias = dt_bias[d * 8 + head], A = -__expf(a_log[d * 8 + head]);
    const float x0 = bf2f(Prow0[(size_t)(2 * lane) * ABPAD + 3328 + head]), x1 = bf2f(Prow0[(size_t)(2 * lane + 1) * ABPAD + 3328 + head]);
    const float dt0 = softplusf_(x0 + bias), dt1 = softplusf_(x1 + bias), la0 = dt0 * A, la1 = dt1 * A;
    const float s = la0 + la1; float inc = s;
#pragma unroll
    for (int off = 1; off < 64; off <<= 1) { const float n = __shfl_up(inc, off); if (lane >= off) inc += n; }
    const float tot = __shfl(inc, 63), exc = inc - s;
    float c0, c1; if (d == 0) { c0 = exc + la0; c1 = inc; } else { c0 = tot - exc; c1 = tot - exc - la0; }
    dtS[w * 128 + 2 * lane] = dt0; dtS[w * 128 + 2 * lane + 1] = dt1; cumS[w * 128 + 2 * lane] = c0; cumS[w * 128 + 2 * lane + 1] = c1;
    if (lane == 0) totS[w] = tot;
}
template <int NR, bool TR> __device__ __forceinline__ void ssd_conv8(LAS bf16_t* dst, int col0, int cx0, int l0, const bf16_t* Pb, int t0, const float* cw, const float* cb) {
    u32x4 raw[NR + 2];
    const bf16_t* p = Pb + (size_t)(t0 + l0) * ABPAD + 2304 + cx0;
#pragma unroll
    for (int i = 0; i < NR + 2; ++i) { const int t = t0 + l0 + i - 1; raw[i] = (t >= 0 && t < SEQ) ? *(const u32x4*)(p + (long)(i - 1) * ABPAD) : (u32x4){0u, 0u, 0u, 0u}; }
    float w0[8], w1[8], w2[8], bs[8];
#pragma unroll
    for (int q = 0; q < 2; ++q) { const f32x4 a = *(const f32x4*)(cw + cx0 + 4 * q), bq = *(const f32x4*)(cw + 1024 + cx0 + 4 * q), c = *(const f32x4*)(cw + 2048 + cx0 + 4 * q), d = *(const f32x4*)(cb + cx0 + 4 * q);
#pragma unroll
        for (int i = 0; i < 4; ++i) { w0[4 * q + i] = a[i]; w1[4 * q + i] = bq[i]; w2[4 * q + i] = c[i]; bs[4 * q + i] = d[i]; } }
    float o[NR][8];
#pragma unroll
    for (int i = 0; i < NR; ++i)
#pragma unroll
        for (int c = 0; c < 8; ++c) { const unsigned um = raw[i][c >> 1], u0 = raw[i + 1][c >> 1], up = raw[i + 2][c >> 1];
            const float fm = (c & 1) ? bfhi(um) : bflo(um), f0 = (c & 1) ? bfhi(u0) : bflo(u0), fp = (c & 1) ? bfhi(up) : bflo(up);
            o[i][c] = siluf_(w0[c] * fm + w1[c] * f0 + w2[c] * fp + bs[c]); }
    if (TR) {
#pragma unroll
        for (int c = 0; c < 8; ++c) { LAS bf16_t* q = dst + (col0 + c) * SLD + l0;
            if (NR == 8) { u32x4 w; w.x = pk2(o[0][c], o[1][c]); w.y = pk2(o[2][c], o[3][c]); w.z = pk2(o[4 % NR][c], o[5 % NR][c]); w.w = pk2(o[6 % NR][c], o[7 % NR][c]); *(LAS u32x4*)q = w; }
            else { u32x2 w; w.x = pk2(o[0][c], o[1][c]); w.y = pk2(o[2][c], o[3][c]); *(LAS u32x2*)q = w; } }
    } else {
#pragma unroll
        for (int i = 0; i < NR; ++i) { u32x4 w; w.x = pk2(o[i][0], o[i][1]); w.y = pk2(o[i][2], o[i][3]); w.z = pk2(o[i][4], o[i][5]); w.w = pk2(o[i][6], o[i][7]); *(LAS u32x4*)(dst + (l0 + i) * SLD + col0) = w; }
    }
}
__device__ __forceinline__ void ssd_s1_unit(LAS unsigned char* lds, int unit, const bf16_t* P0, const float* cw, const float* cb, const float* dt_bias, const float* a_log, bf16_t* STATES, float* TOT) {
    const int tid = threadIdx.x, lane = tid & 63, w = tid >> 6, fr = lane & 15, fq = lane >> 4;
    const int g = unit & 1, c = (unit >> 1) & 31, b = unit >> 6, t0 = c * 128;
    LAS bf16_t* BT = (LAS bf16_t*)lds; LAS bf16_t* XT = (LAS bf16_t*)(lds + 34816); LAS float* dtS = (LAS float*)(lds + 104448); LAS float* cumS = (LAS float*)(lds + 108544);
    LAS float* scS = (LAS float*)(lds + 112640); LAS float* totS = (LAS float*)(lds + 116736);
    const bf16_t* Pb = P0 + (size_t)b * SEQ * ABPAD;
    __syncthreads();
    ssd_conv8<4, true>(BT, (tid & 15) * 8, 512 + g * 128 + (tid & 15) * 8, (tid >> 4) * 4, Pb, t0, cw, cb);
    ssd_conv8<8, true>(XT, (tid & 31) * 8, g * 256 + (tid & 31) * 8, (tid >> 5) * 8, Pb, t0, cw, cb);
    ssd_dt_cum(dtS, cumS, totS, Pb + (size_t)t0 * ABPAD, g, w, lane, dt_bias, a_log);
    __syncthreads();
    for (int e = tid; e < 1024; e += 512) scS[e] = dtS[e] * __expf(totS[e >> 7] - cumS[e]);
    if (tid < 8) TOT[((size_t)(b * 32 + c) * 2 + (tid & 1)) * 8 + g * 4 + (tid >> 1)] = totS[tid];
    __syncthreads();
    const int j = w >> 1;
#pragma unroll 1
    for (int d = 0; d < 2; ++d) {
        f32x4 acc[2][8];
#pragma unroll
        for (int mt = 0; mt < 2; ++mt)
#pragma unroll
            for (int nt = 0; nt < 8; ++nt) acc[mt][nt] = (f32x4){0.f, 0.f, 0.f, 0.f};
#pragma unroll 1
        for (int ks = 0; ks < 4; ++ks) {
            const int k0 = ks * 32; const LAS float* sp = scS + (j * 2 + d) * 128 + k0 + fq * 8;
            const f32x4 s0 = *(const LAS f32x4*)sp, s1 = *(const LAS f32x4*)(sp + 4);
            bf16x8 afr[2];
#pragma unroll
            for (int mt = 0; mt < 2; ++mt) { const u32x4 raw = *(const LAS u32x4*)(XT + (32 * w + mt * 16 + fr) * SLD + k0 + fq * 8); u32x4 o;
                o.x = pk2(bflo(raw.x) * s0[0], bfhi(raw.x) * s0[1]); o.y = pk2(bflo(raw.y) * s0[2], bfhi(raw.y) * s0[3]);
                o.z = pk2(bflo(raw.z) * s1[0], bfhi(raw.z) * s1[1]); o.w = pk2(bflo(raw.w) * s1[2], bfhi(raw.w) * s1[3]);
                afr[mt] = __builtin_bit_cast(bf16x8, o); }
#pragma unroll
            for (int nt = 0; nt < 8; ++nt) { const bf16x8 bfr = ldsfrag(BT, SLD, nt * 16, k0, fr, fq);
#pragma unroll
                for (int mt = 0; mt < 2; ++mt) acc[mt][nt] = mfma16(bfr, afr[mt], acc[mt][nt]); }
        }
        bf16_t* dst = STATES + (((size_t)(b * 32 + c) * 2 + d) * 8 + g * 4 + j) * 8192;
#pragma unroll
        for (int mt = 0; mt < 2; ++mt) { const int p = (w & 1) * 32 + mt * 16 + fr;
#pragma unroll
            for (int nt = 0; nt < 8; ++nt) { u32x2 o; o.x = pk2(acc[mt][nt][0], acc[mt][nt][1]); o.y = pk2(acc[mt][nt][2], acc[mt][nt][3]);
                *(u32x2*)(dst + p * 128 + nt * 16 + fq * 4) = o; } }
    }
}
__device__ __forceinline__ void ssd_s2(const bf16_t* __restrict__ STATES, bf16_t* __restrict__ CARR, const float* __restrict__ TOT, int gtid, int NGT) {
    for (int it = gtid; it < 16 * 2 * 8 * 1024; it += NGT) {
        const int e8 = it & 1023, head = (it >> 10) & 7, d = (it >> 13) & 1, b = it >> 14;
        float run[8];
#pragma unroll
        for (int i = 0; i < 8; ++i) run[i] = 0.f;
#pragma unroll 1
        for (int c8 = 0; c8 < 32; c8 += 8) {
            u32x4 loc[8]; float dec[8];
#pragma unroll
            for (int q = 0; q < 8; ++q) { const int cc = c8 + q, c = d ? 31 - cc : cc; const size_t sidx = ((size_t)(b * 32 + c) * 2 + d) * 8 + head;
                loc[q] = *(const u32x4*)(STATES + sidx * 8192 + e8 * 8); dec[q] = TOT[sidx]; }
#pragma unroll
            for (int q = 0; q < 8; ++q) { const int cc = c8 + q, c = d ? 31 - cc : cc; const size_t sidx = ((size_t)(b * 32 + c) * 2 + d) * 8 + head;
                u32x4 o; o.x = pk2(run[0], run[1]); o.y = pk2(run[2], run[3]); o.z = pk2(run[4], run[5]); o.w = pk2(run[6], run[7]); *(u32x4*)(CARR + sidx * 8192 + e8 * 8) = o;
                const float dq = __expf(dec[q]);
#pragma unroll
                for (int i = 0; i < 4; ++i) { run[2 * i] = run[2 * i] * dq + bflo(loc[q][i]); run[2 * i + 1] = run[2 * i + 1] * dq + bfhi(loc[q][i]); } }
        }
    }
}
__device__ __forceinline__ void ssd_s3_unit(LAS unsigned char* lds, int unit, const bf16_t* P0, const float* cw, const float* cb, const float* dt_bias, const float* a_log, const float* dskip, const float* norm_w,
                                            const bf16_t* STATES, bf16_t* OMIX) {
    const int tid = threadIdx.x, lane = tid & 63, w = tid >> 6, fr = lane & 15, fq = lane >> 4;
    const int g = unit & 1, c = (unit >> 1) & 31, b = unit >> 6, t0 = c * 128;
    LAS bf16_t* CS = (LAS bf16_t*)lds; LAS bf16_t* BS = (LAS bf16_t*)(lds + 34816); LAS bf16_t* XT = (LAS bf16_t*)(lds + 69632);
    LAS float* dtS = (LAS float*)(lds + 139264); LAS float* cumS = (LAS float*)(lds + 143360); LAS float* totS = (LAS float*)(lds + 147456);
    const bf16_t* Pb = P0 + (size_t)b * SEQ * ABPAD;
    __syncthreads();
    ssd_conv8<4, false>(BS, (tid & 15) * 8, 512 + g * 128 + (tid & 15) * 8, (tid >> 4) * 4, Pb, t0, cw, cb);
    ssd_conv8<4, false>(CS, (tid & 15) * 8, 768 + g * 128 + (tid & 15) * 8, (tid >> 4) * 4, Pb, t0, cw, cb);
    ssd_conv8<8, true>(XT, (tid & 31) * 8, g * 256 + (tid & 31) * 8, (tid >> 5) * 8, Pb, t0, cw, cb);
    ssd_dt_cum(dtS, cumS, totS, Pb + (size_t)t0 * ABPAD, g, w, lane, dt_bias, a_log);
    __syncthreads();
    const int l = 16 * w + fr;
    f32x4 sc[8];
#pragma unroll
    for (int nt = 0; nt < 8; ++nt) sc[nt] = (f32x4){0.f, 0.f, 0.f, 0.f};
#pragma unroll
    for (int ks = 0; ks < 4; ++ks) { const bf16x8 afr = ldsfrag(CS, SLD, 16 * w, ks * 32, fr, fq);
#pragma unroll
        for (int nt = 0; nt < 8; ++nt) sc[nt] = mfma16(ldsfrag(BS, SLD, nt * 16, ks * 32, fr, fq), afr, sc[nt]); }
    __syncthreads();
    LAS bf16_t* Mw = BS + w * 16 * SLD;
    const size_t row = (size_t)b * SEQ + t0 + l; float ss = 0.f;
#pragma unroll 1
    for (int j = 0; j < 4; ++j) {
        const LAS float* cf = cumS + (j * 2) * 128; const LAS float* cbw = cumS + (j * 2 + 1) * 128; const LAS float* df = dtS + (j * 2) * 128; const LAS float* db = dtS + (j * 2 + 1) * 128;
        const float cfl = cf[l], cbl = cbw[l];
        const size_t sbase = ((size_t)(b * 32 + c) * 2) * 8 + g * 4 + j;
        const bf16_t* carf = STATES + sbase * 8192; const bf16_t* carb = STATES + (sbase + 8) * 8192;
        bf16x8 cF[4][4], cB[4][4]; u32x2 zz4[4];
#pragma unroll
        for (int ks = 0; ks < 4; ++ks)
#pragma unroll
            for (int pt = 0; pt < 4; ++pt) cF[ks][pt] = *(const bf16x8*)(carf + (pt * 16 + fr) * 128 + ks * 32 + fq * 8);
#pragma unroll
        for (int pt = 0; pt < 4; ++pt) zz4[pt] = *(const u32x2*)(P0 + row * ABPAD + 1792 + g * 256 + j * 64 + pt * 16 + fq * 4);
#pragma unroll
        for (int nt = 0; nt < 8; ++nt) { float mv[4];
#pragma unroll
            for (int i = 0; i < 4; ++i) { const int s = nt * 16 + fq * 4 + i;
                const float ff = (s <= l) ? __expf(cfl - cf[s]) * df[s] : 0.f; const float fb = (s >= l) ? __expf(cbl - cbw[s]) * db[s] : 0.f;
                mv[i] = sc[nt][i] * (ff + fb); }
            u32x2 o; o.x = pk2(mv[0], mv[1]); o.y = pk2(mv[2], mv[3]); *(LAS u32x2*)(Mw + fr * SLD + nt * 16 + fq * 4) = o; }
        LDS_WAIT();
#pragma unroll
        for (int ks = 0; ks < 4; ++ks)
#pragma unroll
            for (int pt = 0; pt < 4; ++pt) cB[ks][pt] = *(const bf16x8*)(carb + (pt * 16 + fr) * 128 + ks * 32 + fq * 8);
        f32x4 yd[4], yf[4], yb[4];
#pragma unroll
        for (int pt = 0; pt < 4; ++pt) { yd[pt] = (f32x4){0.f, 0.f, 0.f, 0.f}; yf[pt] = yd[pt]; yb[pt] = yd[pt]; }
        bf16x8 acs[4];
#pragma unroll
        for (int ks = 0; ks < 4; ++ks) {
            const bf16x8 am = *(const LAS bf16x8*)(Mw + fr * SLD + ks * 32 + fq * 8); acs[ks] = ldsfrag(CS, SLD, 16 * w, ks * 32, fr, fq);
#pragma unroll
            for (int pt = 0; pt < 4; ++pt) {
                yd[pt] = mfma16(ldsfrag(XT, SLD, j * 64 + pt * 16, ks * 32, fr, fq), am, yd[pt]);
                yf[pt] = mfma16(cF[ks][pt], acs[ks], yf[pt]); }
        }
#pragma unroll
        for (int ks = 0; ks < 4; ++ks)
#pragma unroll
            for (int pt = 0; pt < 4; ++pt) yb[pt] = mfma16(cB[ks][pt], acs[ks], yb[pt]);
        const float ef = __expf(cfl), eb = __expf(cbl), dsk = dskip[g * 4 + j];
#pragma unroll
        for (int pt = 0; pt < 4; ++pt) { const f32x4 yv = yd[pt] + yf[pt] * ef + yb[pt] * eb;
            const int col = j * 64 + pt * 16 + fq * 4; const u32x2 zz = zz4[pt];
            const float z4[4] = {bflo(zz.x), bfhi(zz.x), bflo(zz.y), bfhi(zz.y)}; float v4[4];
#pragma unroll
            for (int i = 0; i < 4; ++i) { const float xs = bf2f(XT[(col + i) * SLD + l]); float v = yv[i] + dsk * xs; const float z = z4[i]; v = v * siluf_(z);
                v4[i] = v; ss += v * v; }
            u32x2 o; o.x = pk2(v4[0], v4[1]); o.y = pk2(v4[2], v4[3]); *(u32x2*)(OMIX + row * D + 512 + g * 256 + col) = o; }
        asm volatile("" ::: "memory");
    }
    ss += __shfl_xor(ss, 16); ss += __shfl_xor(ss, 32);
    const float rs = rsqrtf(ss * (1.f / 256.f) + 1e-6f);
    asm volatile("s_waitcnt vmcnt(0)" ::: "memory");
#pragma unroll 4
    for (int q = 0; q < 16; ++q) { const int col = g * 256 + q * 16 + fq * 4; const f32x4 nw = *(const f32x4*)(norm_w + col);
        u32x2* p = (u32x2*)(OMIX + row * D + 512 + col); const u32x2 v = *p;
        u32x2 o; o.x = pk2(bflo(v.x) * rs * nw[0], bfhi(v.x) * rs * nw[1]); o.y = pk2(bflo(v.y) * rs * nw[2], bfhi(v.y) * rs * nw[3]); *p = o; }
}

constexpr int HLD = 136, HLS = 72;
__device__ __forceinline__ void hgrn_chain(LAS unsigned char* lds, int cid, bf16_t* P1, const float* hg_lb, bf16_t* Ob, int ldo, int ocbase, int ocdir) {
    const int tid = threadIdx.x, lane = tid & 63, w = tid >> 6, fr = lane & 15, fq = lane >> 4;
    const int b = cid >> 4, h = (cid >> 1) & 7, dir = cid & 1;
    LAS bf16_t* QE = (LAS bf16_t*)lds;
    LAS bf16_t* KE = (LAS bf16_t*)(lds + 17408);
    LAS bf16_t* KLT = (LAS bf16_t*)(lds + 34816);
    LAS bf16_t* VT = (LAS bf16_t*)(lds + 53248);
    LAS bf16_t* AT = (LAS bf16_t*)(lds + 71680);
    LAS bf16_t* ST = (LAS bf16_t*)(lds + 80896);
    LAS float* totS = (LAS float*)(lds + 115712);
    LAS float* lastS = (LAS float*)(lds + 117760);
    __syncthreads();
    for (int e = tid; e < 128 * HLD / 2; e += 512) ((LAS unsigned*)ST)[e] = 0u;
    const int dcol = tid & 127, qtr = tid >> 7, i0 = qtr * 16;
    const float lbv = frcp(1.0f + __expf(hg_lb[h * 128 + dcol] - hg_lb[1024 + h * 128 + dcol]));
    f32x4 st[8];
#pragma unroll
    for (int i = 0; i < 8; ++i) st[i] = (f32x4){0.f, 0.f, 0.f, 0.f};
    bf16_t* Pb = P1 + (size_t)b * SEQ * HGP;
    __syncthreads();
    unsigned short rq[16], rf[16], rv[16];
#define HG_ISSUE(t0n) do { _Pragma("unroll") for (int i = 0; i < 16; ++i) { const int tk = (t0n) + (dir ? 63 - (i0 + i) : (i0 + i)); const bf16_t* pr = Pb + (size_t)tk * HGP + h * 128 + dcol; \
        rq[i] = pr[0]; rf[i] = pr[1024 * (1 + dir)]; rv[i] = pr[3072]; } } while (0)
    HG_ISSUE((dir ? 63 : 0) * 64);
    for (int cc = 0; cc < 64; ++cc) {
        const int t0 = (dir ? 63 - cc : cc) * 64;
        float gq[16], gk[16], gc[16]; float run = 0.f;
#pragma unroll
        for (int i = 0; i < 16; ++i) { const float q = bf2f(rq[i]), fr_ = bf2f(rf[i]);
            const float f = lbv + (1.0f - lbv) * sigmoidf_(fr_); run += __logf(f); gq[i] = q; gk[i] = 1.0f - f; gc[i] = run; }
        totS[qtr * 128 + dcol] = run;
#pragma unroll
        for (int i = 0; i < 16; i += 2) *(LAS unsigned*)(VT + dcol * HLS + i0 + i) = (unsigned)rv[i] | ((unsigned)rv[i + 1] << 16);
        __syncthreads();
        { float pre = 0.f, tot = 0.f;
#pragma unroll
          for (int q4 = 0; q4 < 4; ++q4) { const float tq = totS[q4 * 128 + dcol]; if (q4 < qtr) pre += tq; tot += tq; }
          const float etot = __expf(tot);
          if (qtr == 0) lastS[dcol] = etot;
#pragma unroll
          for (int i = 0; i < 16; i += 2) { const float b0 = pre + gc[i], b1 = pre + gc[i + 1];
              const float e0 = __expf(b0), e1 = __expf(b1), n0 = frcp(e0), n1 = frcp(e1), l0 = etot * n0, l1 = etot * n1;
              QE[(i0 + i) * HLD + dcol] = (bf16_t)f2bf(gq[i] * e0); QE[(i0 + i + 1) * HLD + dcol] = (bf16_t)f2bf(gq[i + 1] * e1);
              KE[(i0 + i) * HLD + dcol] = (bf16_t)f2bf(gk[i] * n0); KE[(i0 + i + 1) * HLD + dcol] = (bf16_t)f2bf(gk[i + 1] * n1);
              *(LAS unsigned*)(KLT + dcol * HLS + i0 + i) = pk2(gk[i] * l0, gk[i + 1] * l1); } }
        if (cc + 1 < 64) HG_ISSUE((dir ? 62 - cc : cc + 1) * 64);
        __syncthreads();
        { const int mt = w >> 1;
#pragma unroll
          for (int n2 = 0; n2 < 2; ++n2) { const int nt = (w & 1) * 2 + n2; f32x4 acc = (f32x4){0.f, 0.f, 0.f, 0.f};
#pragma unroll
              for (int ks = 0; ks < 4; ++ks) acc = mfma16(ldsfrag(KE, HLD, nt * 16, ks * 32, fr, fq), ldsfrag(QE, HLD, mt * 16, ks * 32, fr, fq), acc);
              const int lrow = mt * 16 + fr; float mv[4];
#pragma unroll
              for (int i = 0; i < 4; ++i) { const int s = nt * 16 + fq * 4 + i; mv[i] = (s <= lrow) ? acc[i] : 0.f; }
              u32x2 o; o.x = pk2(mv[0], mv[1]); o.y = pk2(mv[2], mv[3]); *(LAS u32x2*)(AT + lrow * HLS + nt * 16 + fq * 4) = o; } }
        __syncthreads();
        { const int mt = w >> 1;
#pragma unroll
          for (int n4 = 0; n4 < 4; ++n4) { const int nt = (w & 1) * 4 + n4; f32x4 acc = (f32x4){0.f, 0.f, 0.f, 0.f};
#pragma unroll
              for (int ks = 0; ks < 2; ++ks) acc = mfma16(ldsfrag(VT, HLS, nt * 16, ks * 32, fr, fq), ldsfrag(AT, HLS, mt * 16, ks * 32, fr, fq), acc);
#pragma unroll
              for (int ks = 0; ks < 4; ++ks) acc = mfma16(ldsfrag(ST, HLD, nt * 16, ks * 32, fr, fq), ldsfrag(QE, HLD, mt * 16, ks * 32, fr, fq), acc);
              const int i = mt * 16 + fr, tk = t0 + (dir ? 63 - i : i);
              u32x2 o; o.x = pk2(acc[0], acc[1]); o.y = pk2(acc[2], acc[3]);
              *(u32x2*)(Ob + ((size_t)b * SEQ + tk) * ldo + ocbase + ocdir * dir + h * 128 + nt * 16 + fq * 4) = o; } }
#pragma unroll
        for (int nt = 0; nt < 8; ++nt) { const f32x4 el = *(const LAS f32x4*)(lastS + nt * 16 + fq * 4); st[nt] = st[nt] * el;
#pragma unroll
            for (int ks = 0; ks < 2; ++ks) st[nt] = mfma16(ldsfrag(KLT, HLS, nt * 16, ks * 32, fr, fq), ldsfrag(VT, HLS, w * 16, ks * 32, fr, fq), st[nt]); }
        __syncthreads();
#pragma unroll
        for (int nt = 0; nt < 8; ++nt) { u32x2 o; o.x = pk2(st[nt][0], st[nt][1]); o.y = pk2(st[nt][2], st[nt][3]); *(LAS u32x2*)(ST + (w * 16 + fr) * HLD + nt * 16 + fq * 4) = o; }
    }
    __syncthreads();
}
__device__ __forceinline__ void hgrn_combine(const bf16_t* P1, const float* norm_w, bf16_t* OMIX, int gw, int NGW, int lane) {
    const int c0 = lane * 16;
#pragma unroll 2
    for (int tk = gw; tk < T; tk += NGW) {
        const bf16_t* pr = P1 + (size_t)tk * HGP + c0; float o[16]; float ss = 0.f;
#pragma unroll
        for (int hh = 0; hh < 2; ++hh) { const u32x4 uf = *(const u32x4*)(pr + 1024 + hh * 8), ub = *(const u32x4*)(pr + 2048 + hh * 8);
#pragma unroll
            for (int i = 0; i < 4; ++i) { o[hh * 8 + 2 * i] = bflo(uf[i]) + bflo(ub[i]); o[hh * 8 + 2 * i + 1] = bfhi(uf[i]) + bfhi(ub[i]); } }
#pragma unroll
        for (int i = 0; i < 16; ++i) ss += o[i] * o[i];
        const float rs = rsqrtf(sum8(ss) * (1.f / 128.f) + 1e-6f);
#pragma unroll
        for (int hh = 0; hh < 2; ++hh) { const u32x4 ug = *(const u32x4*)(pr + 4096 + hh * 8); float r[8];
#pragma unroll
            for (int i = 0; i < 4; ++i) { const float g0 = bflo(ug[i]), g1 = bfhi(ug[i]);
                r[2 * i] = o[hh * 8 + 2 * i] * rs * norm_w[c0 + hh * 8 + 2 * i] * siluf_(g0);
                r[2 * i + 1] = o[hh * 8 + 2 * i + 1] * rs * norm_w[c0 + hh * 8 + 2 * i + 1] * siluf_(g1); }
            u32x4 wv; wv.x = pk2(r[0], r[1]); wv.y = pk2(r[2], r[3]); wv.z = pk2(r[4], r[5]); wv.w = pk2(r[6], r[7]);
            *(u32x4*)(OMIX + (size_t)tk * D + c0 + hh * 8) = wv; }
    }
}

#define XB_TMO      128
#define XB_XCNT(j)  (256  + 64 * (j))
#define XB_XSUB(j)  (1280 + 64 * (j))
#define XB_XGEN(j)  (2304 + 64 * (j))
#define XB_TOP      3328
#define XB_TOPGEN   3392
#define XCD_BAR_WORDS 3456
#define XB_SPIN_CAP (1u << 18)

__device__ __forceinline__ unsigned xb_ld(unsigned* p)              { return __hip_atomic_load(p, __ATOMIC_RELAXED, __HIP_MEMORY_SCOPE_AGENT); }
__device__ __forceinline__ unsigned xb_add(unsigned* p, unsigned v) { return __hip_atomic_fetch_add(p, v, __ATOMIC_RELAXED, __HIP_MEMORY_SCOPE_AGENT); }
__device__ __forceinline__ unsigned xb_xcc_id() { return (unsigned)__builtin_amdgcn_s_getreg((3 << 11) | 20) & 0xFu; }
#define XB_SPIN(cond, bar) do { unsigned _sp = 0; while (cond) { __builtin_amdgcn_s_sleep(1); \
    if ((++_sp & 255u) == 0u) { if (xb_ld(&(bar)[XB_TMO])) break; if (_sp > XB_SPIN_CAP) { atomicAdd(&(bar)[XB_TMO], 1u); break; } } } } while (0)

struct XcdBarrier {
    unsigned* bar; unsigned x;
    volatile LAS unsigned* st;
};

__device__ __forceinline__ XcdBarrier xcd_barrier_post(unsigned* bar, volatile LAS unsigned* st) {
    XcdBarrier b; b.bar = bar; b.x = xb_xcc_id(); b.st = st;
    if (threadIdx.x == 0) (void)xb_add(&bar[XB_XCNT(b.x)], 1u);
    return b;
}
__device__ __forceinline__ void xcd_barrier_complete(unsigned* bar, unsigned x, unsigned& nloc, unsigned& nx) {
    const unsigned G = gridDim.x * gridDim.y * gridDim.z;
    unsigned sum, cnt, mine, sp = 0u;
    for (;;) {
        sum = 0u; cnt = 0u; mine = 0u;
#pragma unroll
        for (unsigned j = 0; j < 16; ++j) { const unsigned c = xb_ld(&bar[XB_XCNT(j)]); sum += c; cnt += (c > 0u) ? 1u : 0u; mine = (j == x) ? c : mine; }
        if (sum == G) break;
        __builtin_amdgcn_s_sleep(1);
        if ((++sp & 255u) == 0u) { if (xb_ld(&bar[XB_TMO])) break; if (sp > XB_SPIN_CAP) { atomicAdd(&bar[XB_TMO], 1u); break; } }
    }
    nloc = mine > 0u ? mine : 1u; nx = cnt > 0u ? cnt : 1u;
}

__device__ __forceinline__ void xcd_barrier(const XcdBarrier& b) {
    asm volatile("s_waitcnt vmcnt(0)" ::: "memory");
    __syncthreads();
    if (threadIdx.x == 0) {
        unsigned* bar = b.bar;
        __builtin_amdgcn_s_waitcnt(0);
        unsigned nloc = b.st[0], nx = b.st[1];
        if (nloc == 0u) { xcd_barrier_complete(bar, b.x, nloc, nx); b.st[0] = nloc; b.st[1] = nx; }
        const unsigned old = xb_add(&bar[XB_XSUB(b.x)], 1u);
        const unsigned gen = old / nloc;
        if (old + 1u == (gen + 1u) * nloc) {
            __builtin_amdgcn_fence(__ATOMIC_RELEASE, "agent");
            asm volatile("s_waitcnt vmcnt(0)" ::: "memory");
            const unsigned og = xb_add(&bar[XB_TOP], 1u);
            const unsigned tg = og / nx;
            if (og + 1u == (tg + 1u) * nx) xb_add(&bar[XB_TOPGEN], 1u);
            else XB_SPIN(xb_ld(&bar[XB_TOPGEN]) == tg, bar);
            __builtin_amdgcn_fence(__ATOMIC_ACQUIRE, "agent");
            xb_add(&bar[XB_XGEN(b.x)], 1u);
            asm volatile("s_waitcnt vmcnt(0)" ::: "memory");
        } else {
            XB_SPIN(xb_ld(&bar[XB_XGEN(b.x)]) == gen, bar);
            __builtin_amdgcn_fence(__ATOMIC_ACQUIRE, "agent");
            asm volatile("s_waitcnt vmcnt(0)" ::: "memory");
        }
    }
    __syncthreads();
}


struct Args { const float* in[35]; float* out; unsigned char* ws; int ph_lo, ph_hi; };
static_assert(sizeof(Args) == 304, "Args layout");

__global__ void __launch_bounds__(512, 2) mk_fwd(Args args) {
    extern __shared__ __attribute__((aligned(16))) unsigned char lds_raw[];
    LAS unsigned char* lds = (LAS unsigned char*)lds_raw; LAS unsigned char* xl = lds + XLDS_OFF;
    const int G = gridDim.x, bx = blockIdx.x, NGW = G * 8;
#define LOCAL_IDS int tid = threadIdx.x; asm volatile("" : "+v"(tid)); const int lane = tid & 63, wave = __builtin_amdgcn_readfirstlane(tid >> 6), gw = bx * 8 + wave; (void)lane; (void)gw;
    typedef const __attribute__((address_space(4))) unsigned char* kaptr_t;
    kaptr_t ka = (kaptr_t)__builtin_amdgcn_kernarg_segment_ptr();
#define INP(k) (*(const float* const volatile __attribute__((address_space(4)))*)(ka + 8 * (k)))
    unsigned char* ws = *(unsigned char* const volatile __attribute__((address_space(4)))*)(ka + 288); float* out = *(float* const volatile __attribute__((address_space(4)))*)(ka + 280);
    const float* x = INP(0);
    bf16_t* WAB = (bf16_t*)(ws + WS_WAB); bf16_t* WABO = (bf16_t*)(ws + WS_WABO); bf16_t* WHG = (bf16_t*)(ws + WS_WHG); bf16_t* WHGO = (bf16_t*)(ws + WS_WHGO);
    bf16_t* WQ = (bf16_t*)(ws + WS_WQ); bf16_t* WKV = (bf16_t*)(ws + WS_WKV); bf16_t* WO = (bf16_t*)(ws + WS_WO); bf16_t* WF1 = (bf16_t*)(ws + WS_WF1); bf16_t* WF2 = (bf16_t*)(ws + WS_WF2);
    bf16_t* G2T = (bf16_t*)(ws + WS_G2T); bf16_t* MEMN = (bf16_t*)(ws + WS_MEMN); bf16_t* KMEM = (bf16_t*)(ws + WS_KMEM); bf16_t* VT = (bf16_t*)(ws + WS_VT);
    bf16_t* H = (bf16_t*)(ws + WS_H); bf16_t* P = (bf16_t*)(ws + WS_P); bf16_t* PATT = (bf16_t*)(ws + WS_PATT); bf16_t* OMIX0 = (bf16_t*)(ws + WS_OMIX0); bf16_t* OMIX1 = (bf16_t*)(ws + WS_OMIX1); float* PSB = (float*)(ws + WS_PS);
#define COMMA ,
    bf16_t* STATES = (bf16_t*)((unsigned char*)out + DO_STATES); bf16_t* GG = (bf16_t*)((unsigned char*)out + DO_G); bf16_t* SG = (bf16_t*)((unsigned char*)out + DO_SG);
    float* BONUS = (float*)((unsigned char*)out + DO_BONUS); float* TOT = (float*)((unsigned char*)out + DO_TOT);
    cg::grid_group grid = cg::this_grid();
    { volatile LAS unsigned* st_ = (volatile LAS unsigned*)(lds + LDS_BYTES - 16); if (threadIdx.x < 4) st_[threadIdx.x] = 0u; }
    __syncthreads();
    const XcdBarrier xbar = xcd_barrier_post((unsigned*)ws, (volatile LAS unsigned*)(lds + LDS_BYTES - 16));
    const int lo = *(const int volatile __attribute__((address_space(4)))*)(ka + 296), hi = *(const int volatile __attribute__((address_space(4)))*)(ka + 300);
#ifndef PH_EN
#define PH_EN(k) 1
#endif
#define IN(k) (PH_EN(k) && lo <= (k) && (k) < hi)
#ifndef DUP_MASK
#define DUP_MASK 0ull
#endif
#define REPS(k) (1 + (int)(((unsigned long long)(DUP_MASK) >> (k)) & 1ull))
#define PHASE(k) for (int rep_ = 0; rep_ < (IN(k) ? REPS(k) : 0); ++rep_, ((REPS(k) > 1) ? (grid.sync(), 0) : 0))
#define SEAM(k) do { if (IN(k) && IN((k) + 1)) xcd_barrier(xbar); } while (0)
    if (lo < 0) grid.sync();
#define RUN_GEMM(EPI, ALIGN, gd, ep) do { pg8::Order S_; S_.init(gd, G, bx); pg8::gemm_phase<EPI, ALIGN>(lds, xl, gd, S_, ep); } while (0)

    PHASE(0) { LOCAL_IDS
        LAS float* scr = (LAS float*)(lds + wave * 16384);
        constexpr int I_AB = 16 * 112, I_SQ = 16 * 32, I_HG = 16 * 160, I_KV = 16 * 64, I_F1 = 16 * 176, I_F2 = 44 * 32, I_G2 = 2 * 16;
        constexpr int NIT = I_AB + I_SQ + I_HG + I_SQ + 2 * I_SQ + 2 * I_KV + 2 * I_SQ + 2 * I_F1 + 2 * I_F2 + I_G2;
        for (int it = gw; it < NIT; it += NGW) {
            int r = it;
            if (r < I_AB) { transpose_item<0>(INP(3), 1024, ABP, WAB, scr, r, 112, lane); continue; } r -= I_AB;
            if (r < I_SQ) { transpose_item<0>(INP(4), 1024, 1024, WABO, scr, r, 32, lane); continue; } r -= I_SQ;
            if (r < I_HG) { transpose_item<0>(INP(22), 1024, HGP, WHG, scr, r, 160, lane, INP(2) + D); continue; } r -= I_HG;
            if (r < I_SQ) { transpose_item<0>(INP(23), 1024, 1024, WHGO, scr, r, 32, lane); continue; } r -= I_SQ;
            if (r < 2 * I_SQ) { const int l = r / I_SQ; transpose_item<0>(INP(28) + (size_t)l * D * D, 1024, 1024, WQ + (size_t)l * D * D, scr, r % I_SQ, 32, lane, INP(26) + l * D); continue; } r -= 2 * I_SQ;
            if (r < 2 * I_KV) { const int l = r / I_KV; transpose_item<0>(INP(29) + (size_t)l * D * 2048, 1024, 2048, WKV + (size_t)l * D * 2048, scr, r % I_KV, 64, lane); continue; } r -= 2 * I_KV;
            if (r < 2 * I_SQ) { const int l = r / I_SQ; transpose_item<0>(INP(30) + (size_t)l * D * D, 1024, 1024, WO + (size_t)l * D * D, scr, r % I_SQ, 32, lane); continue; } r -= 2 * I_SQ;
            if (r < 2 * I_F1) { const int l = r / I_F1; transpose_item<1>(INP(32) + (size_t)l * D * 2 * FFN, 1024, 2 * FFN, WF1 + (size_t)l * D * 2 * FFN, scr, r % I_F1, 176, lane, INP(31) + l * D); continue; } r -= 2 * I_F1;
            if (r < 2 * I_F2) { const int l = r / I_F2; transpose_item<0>(INP(33) + (size_t)l * FFN * D, FFN, 1024, WF2 + (size_t)l * FFN * D, scr, r % I_F2, 32, lane); continue; } r -= 2 * I_F2;
            transpose_item<0>(INP(10), 128, 512, G2T, scr, r, 16, lane);
        }
        rms_rows_phase(x, INP(2), H, T, gw, NGW, lane);
        for (int m = gw; m < 2 * 4096; m += NGW) { const int l = m >> 12, r = m & 4095; rms_row_bf16(INP(1) + (size_t)r * D, INP(27) + l * D, MEMN + (size_t)m * D, lane); }
        __syncthreads();
    }
    SEAM(0);
    PHASE(1) {
        { pg8::Gemm g = pg8::make_gemm(H, WAB, T, ABPAD, 1024, 1024, 1024); pg8::EpiBf16 E{P, ABPAD, 1.0f, nullptr}; RUN_GEMM(pg8::EpiBf16, true, g, E); }
        { pg8::Gemm g = pg8::make_gemm(MEMN, WKV, 4096, 1024, 1024, 1024, 1024); g.nZ = 2; g.sAo = 4096L * D; g.sBo = 2048L * D; g.sCo = 4096L * D; pg8::EpiBf16 E{KMEM, 1024, 1.0f, nullptr}; RUN_GEMM(pg8::EpiBf16, true, g, E); }
        { pg8::Gemm g = pg8::make_gemm(WKV + (size_t)1024 * D, MEMN, 1024, 4096, 1024, 1024, 1024); g.nZ = 2; g.sAo = 2048L * D; g.sBo = 4096L * D; g.sCo = 4096L * D; pg8::EpiBf16 E{VT, 4096, 1.0f, nullptr}; RUN_GEMM(pg8::EpiBf16, true, g, E); }
    }
    SEAM(1);
    PHASE(2) {
#ifndef DUP_RWKV
#define DUP_RWKV 0
#endif
#ifndef DUP_S1
#define DUP_S1 0
#endif
        for (int r2 = 0; r2 <= DUP_RWKV; ++r2)
        for (int cid = bx; cid < 256; cid += G)
            rwkv_chain(lds, cid, P, INP(5), INP(6), INP(7), INP(8), INP(9), INP(11), INP(12), INP(13), H, SG, BONUS);
        for (int r2 = 0; r2 <= DUP_S1; ++r2)
        for (int u = bx; u < 1024; u += G) ssd_s1_unit(lds, u, P, INP(16), INP(17), INP(18), INP(19), STATES, TOT);
        __syncthreads();
    }
    SEAM(2);
    PHASE(3) {
        { int k128 = 128; asm volatile("" : "+s"(k128)); pg8::Gemm g = pg8::make_gemm(SG, G2T, T, 512, k128, 128, 128); pg8::EpiBf16 E{GG, 512, 1.0f, nullptr}; RUN_GEMM(pg8::EpiBf16, true, g, E); }
        { LOCAL_IDS ssd_s2(STATES, OMIX1, TOT, bx * 512 + tid, G * 512); }
    }
    SEAM(3);
    PHASE(4) {
#ifndef DUP_S3
#define DUP_S3 0
#endif
        for (int r2 = 0; r2 <= DUP_S3; ++r2)
        for (int u = bx; u < 1024; u += G) ssd_s3_unit(lds, u, P, INP(16), INP(17), INP(18), INP(19), INP(20), INP(21), OMIX1, OMIX0);
        __syncthreads();
        { LOCAL_IDS rwkv_combine(P, H, BONUS, GG, INP(5), INP(14), INP(15), OMIX0, gw, NGW, lane); }
    }
    SEAM(4);
    PHASE(5) { pg8::Gemm g = pg8::make_gemm(OMIX0, WABO, T, 1024, 1024, 1024, 1024); pg8::EpiResidB E{x, H, PSB, 1024}; RUN_GEMM(pg8::EpiResidB, true, g, E); }
    SEAM(5);

#define ATTN_FFN(base, L, LASTEPI) \
    PHASE(base) { pg8::Gemm g = pg8::make_gemm(H, WQ + (size_t)(L) * D * D, T, 1024, 1024, 1024, 1024); pg8::EpiBf16 E{P, 1024, 0.0625f, PSB}; RUN_GEMM(pg8::EpiBf16, true, g, E); } \
    SEAM(base); \
    PHASE(base + 1) { pg8::Gemm g = pg8::make_gemm(P, KMEM + (size_t)(L) * 4096 * D, SEQ, 256, 256, 1024, 1024); g.nZ = 64; g.zdiv = 4; \
        g.sAo = (long)SEQ * D; g.sAi = 256; g.sBo = 256L * D; g.sBi = 256; g.sCo = (long)SEQ * D; g.sCi = 256; pg8::EpiSoftmax E{PATT, 1024}; RUN_GEMM(pg8::EpiSoftmax, true, g, E); } \
    SEAM(base + 1); \
    PHASE(base + 2) { pg8::Gemm g = pg8::make_gemm(PATT, VT + (size_t)(L) * 4096 * D, SEQ, 256, 256, 1024, 4096); g.nZ = 64; g.zdiv = 4; \
        g.sAo = (long)SEQ * D; g.sAi = 256; g.sBo = 256; g.sBi = 256L * 4096; g.sCo = (long)SEQ * D; g.sCi = 256; pg8::EpiBf16 E{P, 1024, 1.0f, nullptr}; RUN_GEMM(pg8::EpiBf16, true, g, E); } \
    SEAM(base + 2); \
    PHASE(base + 3) { pg8::Gemm g = pg8::make_gemm(P, WO + (size_t)(L) * D * D, T, 1024, 1024, 1024, 1024); pg8::EpiResidB E{nullptr, H, PSB, 1024}; RUN_GEMM(pg8::EpiResidB, true, g, E); } \
    SEAM(base + 3); \
    PHASE(base + 4) { pg8::Gemm g = pg8::make_gemm(H, WF1 + (size_t)(L) * D * 2 * FFN, T, 2 * FFN, 1024, 1024, 1024); pg8::EpiSwiglu E{P, FFN, PSB}; RUN_GEMM(pg8::EpiSwiglu, true, g, E); } \
    SEAM(base + 4); \
    PHASE(base + 5) { pg8::Gemm g = pg8::make_gemm(P, WF2 + (size_t)(L) * FFN * D, T, 1024, FFN, FFN, FFN); LASTEPI } \
    SEAM(base + 5);

    ATTN_FFN(6, 0, pg8::EpiResidB E{nullptr COMMA H COMMA PSB COMMA 1024}; RUN_GEMM(pg8::EpiResidB, true, g, E);)

    PHASE(12) { pg8::Gemm g = pg8::make_gemm(H, WHG, T, HGP, 1024, 1024, 1024); pg8::EpiBf16 E{P, HGP, 1.0f, PSB}; RUN_GEMM(pg8::EpiBf16, true, g, E); }
    SEAM(12);
    PHASE(13) {
#ifdef DUP_HGRN
        for (int cid = bx; cid < 256; cid += G) hgrn_chain(lds, cid, P, INP(25), OMIX1, 1024, 0, 0);
        grid.sync();
#endif
        for (int cid = bx; cid < 256; cid += G) hgrn_chain(lds, cid, P, INP(25), P, HGP, 1024, 1024); }
    SEAM(13);
    PHASE(14) { LOCAL_IDS hgrn_combine(P, INP(24), OMIX1, gw, NGW, lane); }
    SEAM(14);
    PHASE(15) { pg8::Gemm g = pg8::make_gemm(OMIX1, WHGO, T, 1024, 1024, 1024, 1024); pg8::EpiResidB E{nullptr, H, PSB, 1024}; RUN_GEMM(pg8::EpiResidB, true, g, E); }
    SEAM(15);

    ATTN_FFN(16, 1, pg8::EpiResidB E{nullptr COMMA H COMMA PSB COMMA 1024}; RUN_GEMM(pg8::EpiResidB, true, g, E);)

    PHASE(22) { LOCAL_IDS
        const float* fg = INP(34);
#pragma unroll 2
        for (int m = gw; m < T; m += NGW) {
            const f32x4 pa = *(const f32x4*)(PSB + (size_t)m * 16 + (lane & 3) * 4); float sq = (pa[0] + pa[1]) + (pa[2] + pa[3]); sq += __shfl_xor(sq, 1); sq += __shfl_xor(sq, 2);
            const float rs = rsqrtf(sq * (1.f / D) + 1e-6f);
            const bf16_t* hr = H + (size_t)m * D; float* orow = out + (size_t)m * D;
#pragma unroll
            for (int j = 0; j < 2; ++j) { const int c = (lane + 64 * j) * 8; const u32x4 hv = *(const u32x4*)(hr + c); const f32x4 g0 = *(const f32x4*)(fg + c), g1 = *(const f32x4*)(fg + c + 4);
                *(f32x4*)(orow + c) = (f32x4){bflo(hv.x) * rs * g0[0], bfhi(hv.x) * rs * g0[1], bflo(hv.y) * rs * g0[2], bfhi(hv.y) * rs * g0[3]};
                *(f32x4*)(orow + c + 4) = (f32x4){bflo(hv.z) * rs * g1[0], bfhi(hv.z) * rs * g1[1], bflo(hv.w) * rs * g1[2], bfhi(hv.w) * rs * g1[3]}; } }
    }
#undef IN
#undef SEAM
#undef RUN_GEMM
}

extern "C" void kernel_launch(void* const* d_in, const int* in_sizes, int n_in, void* d_out, int out_size, void* d_ws, size_t ws_size, hipStream_t stream) {
    static int grid = 0;
    if (grid == 0) {
        if (n_in != 35 || out_size != T * D || ws_size < WS_END) { fprintf(stderr, "kernel_launch: unexpected shapes (n_in %d out %d ws %zu)\n", n_in, out_size, ws_size); grid = -1; return; }
        int dev = 0, cus = 0, per_cu = 0;
        hipGetDevice(&dev); hipDeviceGetAttribute(&cus, hipDeviceAttributeMultiprocessorCount, dev);
        hipFuncSetAttribute((const void*)mk_fwd, hipFuncAttributeMaxDynamicSharedMemorySize, LDS_BYTES);
        hipOccupancyMaxActiveBlocksPerMultiprocessor(&per_cu, (const void*)mk_fwd, 512, LDS_BYTES);
        if (per_cu < 1) { fprintf(stderr, "kernel_launch: occupancy query says %d blocks per CU\n", per_cu); per_cu = 1; }
        (void)hipGetLastError();
        grid = cus * 1;
    }
    if (grid < 0) return;
    if (hipMemsetAsync(d_ws, 0, 65536, stream) != hipSuccess) { fprintf(stderr, "kernel_launch: memset of the barrier words failed\n"); return; }
    Args a{};
    for (int i = 0; i < 35; ++i) a.in[i] = (const float*)d_in[i];
    a.out = (float*)d_out; a.ws = (unsigned char*)d_ws;
#if MK_COOP
    a.ph_lo = 0; a.ph_hi = NPHASE;
    void* kargs[] = {&a};
    hipError_t e = hipLaunchCooperativeKernel((const void*)mk_fwd, dim3(grid), dim3(512), kargs, LDS_BYTES, stream);
    if (e != hipSuccess) fprintf(stderr, "cooperative launch failed: %s (grid %d)\n", hipGetErrorString(e), grid);
#else
    for (int ph = 0; ph < NPHASE; ++ph) { a.ph_lo = ph; a.ph_hi = ph + 1; hipLaunchKernelGGL(mk_fwd, dim3(grid), dim3(512), LDS_BYTES, stream, a); }
#endif
}
```

```cpp
#include <hip/hip_runtime.h>
#include <hip/hip_cooperative_groups.h>
#include <cstdio>
#include <cstdint>
namespace cg = cooperative_groups;

#ifndef MK_COOP
#define MK_COOP 1
#endif

#define LAS __attribute__((address_space(3)))
typedef unsigned short bf16_t;
typedef short bf16x8 __attribute__((ext_vector_type(8)));
typedef float f32x4 __attribute__((ext_vector_type(4)));
typedef float f32x2 __attribute__((ext_vector_type(2)));
typedef unsigned u32x4 __attribute__((ext_vector_type(4)));
typedef unsigned u32x2 __attribute__((ext_vector_type(2)));

constexpr int NB = 16, SEQ = 4096, T = NB * SEQ, D = 1024;
constexpr int ABPAD = 3584, ABP = 3336;
constexpr int HGP = 5120;
constexpr int FFN = 2816;
constexpr int NPHASE = 23;

constexpr size_t MiB = 1u << 20;
constexpr size_t WS_WAB = 1 * MiB, WS_WABO = 8 * MiB, WS_WHG = 10 * MiB, WS_WHGO = 20 * MiB, WS_WQ = 22 * MiB, WS_WKV = 26 * MiB, WS_WO = 34 * MiB,
                 WS_WF1 = 38 * MiB, WS_WF2 = 60 * MiB, WS_G2T = 71 * MiB, WS_MEMN = 72 * MiB, WS_KMEM = 88 * MiB, WS_VT = 104 * MiB,
                 WS_PS = 120 * MiB, WS_H = 128 * MiB, WS_P = 256 * MiB, WS_PATT = 384 * MiB, WS_OMIX0 = 704 * MiB, WS_OMIX1 = 896 * MiB, WS_END = 1024 * MiB;
constexpr size_t DO_STATES = 0, DO_G = 128 * MiB, DO_SG = 192 * MiB, DO_BONUS = 208 * MiB, DO_TOT = 210 * MiB;

constexpr int LDS_BYTES = 163840;
constexpr int XLDS_OFF = 131072;

typedef __bf16 bf16x2_t __attribute__((ext_vector_type(2)));
__device__ __forceinline__ unsigned pk2(float lo, float hi) { const f32x2 v = {lo, hi}; return __builtin_bit_cast(unsigned, __builtin_convertvector(v, bf16x2_t)); }
__device__ __forceinline__ unsigned f2bf(float f) { return pk2(f, 0.f) & 0xffffu; }
__device__ __forceinline__ float bf2f(unsigned short b) { return __builtin_bit_cast(float, (unsigned)b << 16); }
__device__ __forceinline__ float bflo(unsigned u) { return __builtin_bit_cast(float, u << 16); }
__device__ __forceinline__ float bfhi(unsigned u) { return __builtin_bit_cast(float, u & 0xffff0000u); }
__device__ __forceinline__ float frcp(float x) { return __builtin_amdgcn_rcpf(x); }
__device__ __forceinline__ float sigmoidf_(float x) { return frcp(1.0f + __expf(-x)); }
__device__ __forceinline__ float siluf_(float x) { return x * frcp(1.0f + __expf(-x)); }
__device__ __forceinline__ float wave_sum(float v) {
#pragma unroll
    for (int o = 1; o < 64; o <<= 1) v += __shfl_xor(v, o);
    return v;
}
template <int CTRL> __device__ __forceinline__ float dppf(float x) { return __builtin_bit_cast(float, __builtin_amdgcn_mov_dpp(__builtin_bit_cast(int, x), CTRL, 0xf, 0xf, true)); }
__device__ __forceinline__ float sum8(float v) { v += dppf<0xB1>(v); v += dppf<0x4E>(v); v += dppf<0x141>(v); return v; }
#define LDS_WAIT() asm volatile("s_waitcnt lgkmcnt(0)" ::: "memory")

namespace pg8 {
constexpr int BM = 256, BK = 64, HALF = 128, HTB = HALF * BK * 2, STAGE_BYTES = 8 * HTB, NXCD = 8, WGM = 8;
__host__ __device__ __forceinline__ int lds_byte(int r, int c) { const int st = (r >> 4) * 2 + (c >> 5), rr = r & 15, cc = c & 31, ob = rr * 64 + cc * 2; return st * 1024 + (ob ^ (((ob >> 9) & 1) << 5)); }
__host__ __device__ __forceinline__ void stage_rc(int b, int& R, int& C) { const int st = b / 1024, sb = b % 1024, swz = sb ^ (((sb >> 9) & 1) << 5); R = (st >> 1) * 16 + swz / 64; C = (st & 1) * 32 + (swz % 64) / 2; }
__host__ __device__ __forceinline__ int perm32(int rho) { const int n = rho >> 4, i = rho & 15; return 8 * (i >> 2) + 4 * n + (i & 3); }

struct Unit { int pm, pn, z; };
struct Gemm {
    const bf16_t* A; const bf16_t* Bt; int lda, ldb, K, nM, nN, nZ, zdiv; long sAo, sAi, sBo, sBi, sCo, sCi;
    __device__ __forceinline__ long offA(const Unit& u) const { return (long)(u.z / zdiv) * sAo + (long)(u.z % zdiv) * sAi + (long)u.pm * BM * lda; }
    __device__ __forceinline__ long offB(const Unit& u) const { return (long)(u.z / zdiv) * sBo + (long)(u.z % zdiv) * sBi + (long)u.pn * BM * ldb; }
    __device__ __forceinline__ long offC(const Unit& u) const { return (long)(u.z / zdiv) * sCo + (long)(u.z % zdiv) * sCi; }
};
__device__ __forceinline__ Gemm make_gemm(const bf16_t* A, const bf16_t* Bt, int M, int N, int K, int lda, int ldb) {
    Gemm g; g.A = A; g.Bt = Bt; g.lda = lda; g.ldb = ldb; g.K = K; g.nM = M / BM; g.nN = N / BM; g.nZ = 1; g.zdiv = 1; g.sAo = g.sAi = g.sBo = g.sBi = g.sCo = g.sCi = 0; return g;
}
struct Order {
    int nM, nN, nwg, total, G, c;
    __device__ __forceinline__ void init(const Gemm& g, int G_, int c_) { nM = g.nM; nN = g.nN; nwg = nM * nN; total = nwg * g.nZ; G = G_; c = c_; }
    __device__ __forceinline__ bool next(int i, Unit& u) const {
        const long L = (long)i * G + c; if (L >= total) return false;
        u.z = (int)(L / nwg); int wgid = (int)(L % nwg);
        { const int q = nwg / NXCD, r = nwg % NXCD, xcd = wgid % NXCD, off = wgid / NXCD; wgid = (xcd < r ? xcd * (q + 1) : r * (q + 1) + (xcd - r) * q) + off; }
        const int nig = WGM * nN, gid = wgid / nig, fm = gid * WGM, gsz = (nM - fm) < WGM ? (nM - fm) : WGM;
        u.pm = fm + ((wgid % nig) % gsz); u.pn = (wgid % nig) / gsz; return true;
    }
};

__device__ __forceinline__ unsigned cvt_pk_bf16(float lo, float hi) { return pk2(lo, hi); }

__device__ __forceinline__ void row_scales(const float* PS, int rowbase, int fq, float (&rs)[2][4]) {
#pragma unroll
    for (int ai = 0; ai < 2; ++ai)
#pragma unroll
        for (int m = 0; m < 4; ++m) { const f32x4 p = *(const f32x4*)(PS + (size_t)(rowbase + ai * HALF + m * 16) * 16 + fq * 4);
            float s = (p[0] + p[1]) + (p[2] + p[3]); s += __shfl_xor(s, 16); s += __shfl_xor(s, 32); rs[ai][m] = rsqrtf(s * (1.f / 1024.f) + 1e-6f); }
}
__device__ __forceinline__ void row_scales_lds(const LAS float* PSL, int rloc  , int fq, float (&rs)[2][4]) {
#pragma unroll
    for (int ai = 0; ai < 2; ++ai)
#pragma unroll
        for (int m = 0; m < 4; ++m) { const f32x4 p = *(const LAS f32x4*)(PSL + (rloc + ai * HALF + m * 16) * 16 + fq * 4);
            float s = (p[0] + p[1]) + (p[2] + p[3]); s += __shfl_xor(s, 16); s += __shfl_xor(s, 32); rs[ai][m] = rsqrtf(s * (1.f / 1024.f) + 1e-6f); }
}
struct EpiBf16 {
    static constexpr bool PERM = true, PSLDS = false;
    bf16_t* O; int ldc; float scale; const float* PS;
    __device__ __forceinline__ void operator()(const f32x4 (&acc)[2][2][4][2], const Unit& u, long coff, int wr, int wc, int fr, int fq, LAS unsigned char* xl) const {
        const int row0 = u.pm * BM + wr * 64 + fr, col0 = u.pn * BM + wc * 32 + 8 * fq; bf16_t* base = O + coff;
        float rs[2][4];
        if (PS) row_scales(PS, row0, fq, rs);
        else {
#pragma unroll
            for (int ai = 0; ai < 2; ++ai)
#pragma unroll
                for (int m = 0; m < 4; ++m) rs[ai][m] = 1.f; }
#pragma unroll
        for (int ai = 0; ai < 2; ++ai)
#pragma unroll
            for (int m = 0; m < 4; ++m) { bf16_t* rowp = base + (size_t)(row0 + ai * HALF + m * 16) * ldc + col0; const float sc_ = scale * rs[ai][m];
#pragma unroll
                for (int bj = 0; bj < 2; ++bj) { const f32x4 v0 = acc[ai][bj][m][0] * sc_, v1 = acc[ai][bj][m][1] * sc_;
                    u32x4 w; w.x = cvt_pk_bf16(v0[0], v0[1]); w.y = cvt_pk_bf16(v0[2], v0[3]); w.z = cvt_pk_bf16(v1[0], v1[1]); w.w = cvt_pk_bf16(v1[2], v1[3]);
                    *(u32x4*)(rowp + bj * HALF) = w; } }
    }
};
struct EpiBf16PS {
    static constexpr bool PERM = true, PSLDS = true;
    bf16_t* O; int ldc; float scale; const float* PS;
    __device__ __forceinline__ void operator()(const f32x4 (&acc)[2][2][4][2], const Unit& u, long coff, int wr, int wc, int fr, int fq, LAS unsigned char* xl) const {
        const int row0 = u.pm * BM + wr * 64 + fr, col0 = u.pn * BM + wc * 32 + 8 * fq; bf16_t* base = O + coff;
        float rs[2][4];
        row_scales_lds((const LAS float*)(xl + 8192), wr * 64 + fr, fq, rs);
#pragma unroll
        for (int ai = 0; ai < 2; ++ai)
#pragma unroll
            for (int m = 0; m < 4; ++m) { bf16_t* rowp = base + (size_t)(row0 + ai * HALF + m * 16) * ldc + col0; const float sc_ = scale * rs[ai][m];
#pragma unroll
                for (int bj = 0; bj < 2; ++bj) { const f32x4 v0 = acc[ai][bj][m][0] * sc_, v1 = acc[ai][bj][m][1] * sc_;
                    u32x4 w; w.x = cvt_pk_bf16(v0[0], v0[1]); w.y = cvt_pk_bf16(v0[2], v0[3]); w.z = cvt_pk_bf16(v1[0], v1[1]); w.w = cvt_pk_bf16(v1[2], v1[3]);
                    *(u32x4*)(rowp + bj * HALF) = w; } }
    }
};
struct EpiResid {
    static constexpr bool PERM = false, PSLDS = false;
    const float* base; float* out; int ldc;
    __device__ __forceinline__ void operator()(const f32x4 (&acc)[2][2][4][2], const Unit& u, long coff, int wr, int wc, int fr, int fq, LAS unsigned char* xl) const {
        const int col0 = u.pn * BM + wc * 32 + 4 * fq;
#pragma unroll
        for (int ai = 0; ai < 2; ++ai)
#pragma unroll
            for (int m = 0; m < 4; ++m) { const size_t off = (size_t)(u.pm * BM + ai * HALF + wr * 64 + m * 16 + fr) * ldc + col0;
#pragma unroll
                for (int bj = 0; bj < 2; ++bj)
#pragma unroll
                    for (int n = 0; n < 2; ++n) { const f32x4 bs = *(const f32x4*)(base + off + bj * HALF + n * 16); *(f32x4*)(out + off + bj * HALF + n * 16) = bs + acc[ai][bj][m][n]; } }
    }
};
struct EpiResidH {
    static constexpr bool PERM = false, PSLDS = false;
    const float* base; float* out; bf16_t* HB; float* PS; int ldc;
    __device__ __forceinline__ void operator()(const f32x4 (&acc)[2][2][4][2], const Unit& u, long coff, int wr, int wc, int fr, int fq, LAS unsigned char* xl) const {
        const int col0 = u.pn * BM + wc * 32 + 4 * fq;
#pragma unroll
        for (int ai = 0; ai < 2; ++ai)
#pragma unroll
            for (int m = 0; m < 4; ++m) { const int row = u.pm * BM + ai * HALF + wr * 64 + m * 16 + fr; const size_t off = (size_t)row * ldc + col0; float ss = 0.f;
#pragma unroll
                for (int bj = 0; bj < 2; ++bj)
#pragma unroll
                    for (int n = 0; n < 2; ++n) { const f32x4 bs = *(const f32x4*)(base + off + bj * HALF + n * 16); const f32x4 o = bs + acc[ai][bj][m][n]; *(f32x4*)(out + off + bj * HALF + n * 16) = o;
                        ss += (o[0] * o[0] + o[1] * o[1]) + (o[2] * o[2] + o[3] * o[3]);
                        u32x2 w; w.x = cvt_pk_bf16(o[0], o[1]); w.y = cvt_pk_bf16(o[2], o[3]); *(u32x2*)(HB + off + bj * HALF + n * 16) = w; }
                ss += __shfl_xor(ss, 16); ss += __shfl_xor(ss, 32);
                if (fq == 0) PS[(size_t)row * 16 + u.pn * 4 + wc] = ss; }
    }
};
struct EpiResidB {
    static constexpr bool PERM = false, PSLDS = false;
    const float* basef; bf16_t* HB; float* PS; int ldc;
    __device__ __forceinline__ void operator()(const f32x4 (&acc)[2][2][4][2], const Unit& u, long coff, int wr, int wc, int fr, int fq, LAS unsigned char* xl) const {
        const int col0 = u.pn * BM + wc * 32 + 4 * fq;
#pragma unroll
        for (int ai = 0; ai < 2; ++ai)
#pragma unroll
            for (int m = 0; m < 4; ++m) { const int row = u.pm * BM + ai * HALF + wr * 64 + m * 16 + fr; const size_t off = (size_t)row * ldc + col0; float ss = 0.f;
#pragma unroll
                for (int bj = 0; bj < 2; ++bj)
#pragma unroll
                    for (int n = 0; n < 2; ++n) { f32x4 bs;
                        if (basef) bs = *(const f32x4*)(basef + off + bj * HALF + n * 16);
                        else { const u32x2 hb = *(const u32x2*)(HB + off + bj * HALF + n * 16); bs = (f32x4){bflo(hb.x), bfhi(hb.x), bflo(hb.y), bfhi(hb.y)}; }
                        const f32x4 o = bs + acc[ai][bj][m][n];
                        ss += (o[0] * o[0] + o[1] * o[1]) + (o[2] * o[2] + o[3] * o[3]);
                        u32x2 w; w.x = cvt_pk_bf16(o[0], o[1]); w.y = cvt_pk_bf16(o[2], o[3]); *(u32x2*)(HB + off + bj * HALF + n * 16) = w; }
                ss += __shfl_xor(ss, 16); ss += __shfl_xor(ss, 32);
                if (fq == 0) PS[(size_t)row * 16 + u.pn * 4 + wc] = ss; }
    }
};
struct EpiSwiglu {
    static constexpr bool PERM = true, PSLDS = true;
    bf16_t* O; int ldc; const float* PS;
    __device__ __forceinline__ void operator()(const f32x4 (&acc)[2][2][4][2], const Unit& u, long coff, int wr, int wc, int fr, int fq, LAS unsigned char* xl) const {
        const int row0 = u.pm * BM + wr * 64 + fr, col0 = u.pn * HALF + wc * 32 + 8 * fq;
        float rs[2][4]; row_scales_lds((const LAS float*)(xl + 8192), wr * 64 + fr, fq, rs);
#pragma unroll
        for (int ai = 0; ai < 2; ++ai)
#pragma unroll
            for (int m = 0; m < 4; ++m) { bf16_t* rowp = O + (size_t)(row0 + ai * HALF + m * 16) * ldc + col0; float r[8]; const float sc_ = rs[ai][m];
#pragma unroll
                for (int n = 0; n < 2; ++n)
#pragma unroll
                    for (int i = 0; i < 4; ++i) { const float g = acc[ai][0][m][n][i] * sc_, uu = acc[ai][1][m][n][i] * sc_; r[n * 4 + i] = siluf_(g) * uu; }
                u32x4 w; w.x = cvt_pk_bf16(r[0], r[1]); w.y = cvt_pk_bf16(r[2], r[3]); w.z = cvt_pk_bf16(r[4], r[5]); w.w = cvt_pk_bf16(r[6], r[7]);
                *(u32x4*)rowp = w; }
    }
};
struct EpiSoftmax {
    static constexpr bool PERM = true, PSLDS = false;
    bf16_t* O; int ldc;
    __device__ __forceinline__ void operator()(f32x4 (&acc)[2][2][4][2], const Unit& u, long coff, int wr, int wc, int fr, int fq, LAS unsigned char* xl) const {
        LAS float* XM = (LAS float*)xl; LAS float* XS = (LAS float*)(xl + 4096);
#pragma unroll
        for (int ai = 0; ai < 2; ++ai)
#pragma unroll
            for (int m = 0; m < 4; ++m) { float mx = -3.0e38f;
#pragma unroll
                for (int bj = 0; bj < 2; ++bj)
#pragma unroll
                    for (int n = 0; n < 2; ++n)
#pragma unroll
                        for (int i = 0; i < 4; ++i) mx = fmaxf(mx, acc[ai][bj][m][n][i]);
                mx = fmaxf(mx, __shfl_xor(mx, 16)); mx = fmaxf(mx, __shfl_xor(mx, 32));
                if (fq == 0) XM[(ai * HALF + wr * 64 + m * 16 + fr) * 4 + wc] = mx; }
        LDS_WAIT(); __builtin_amdgcn_s_barrier(); asm volatile("" ::: "memory");
#pragma unroll
        for (int ai = 0; ai < 2; ++ai)
#pragma unroll
            for (int m = 0; m < 4; ++m) { const f32x4 mm = *(const LAS f32x4*)(XM + (ai * HALF + wr * 64 + m * 16 + fr) * 4);
                const float mx = fmaxf(fmaxf(mm[0], mm[1]), fmaxf(mm[2], mm[3])); float s = 0.f;
#pragma unroll
                for (int bj = 0; bj < 2; ++bj)
#pragma unroll
                    for (int n = 0; n < 2; ++n)
#pragma unroll
                        for (int i = 0; i < 4; ++i) { const float e = __expf(acc[ai][bj][m][n][i] - mx); acc[ai][bj][m][n][i] = e; s += e; }
                s += __shfl_xor(s, 16); s += __shfl_xor(s, 32);
                if (fq == 0) XS[(ai * HALF + wr * 64 + m * 16 + fr) * 4 + wc] = s; }
        LDS_WAIT(); __builtin_amdgcn_s_barrier(); asm volatile("" ::: "memory");
        const int row0 = u.pm * BM + wr * 64 + fr, col0 = wc * 32 + 8 * fq; bf16_t* base = O + coff;
#pragma unroll
        for (int ai = 0; ai < 2; ++ai)
#pragma unroll
            for (int m = 0; m < 4; ++m) { const f32x4 ss = *(const LAS f32x4*)(XS + (ai * HALF + wr * 64 + m * 16 + fr) * 4);
                const float inv = frcp((ss[0] + ss[1]) + (ss[2] + ss[3])); bf16_t* rowp = base + (size_t)(row0 + ai * HALF + m * 16) * ldc + col0;
#pragma unroll
                for (int bj = 0; bj < 2; ++bj) { const f32x4 v0 = acc[ai][bj][m][0] * inv, v1 = acc[ai][bj][m][1] * inv;
                    u32x4 w; w.x = cvt_pk_bf16(v0[0], v0[1]); w.y = cvt_pk_bf16(v0[2], v0[3]); w.z = cvt_pk_bf16(v1[0], v1[1]); w.w = cvt_pk_bf16(v1[2], v1[3]);
                    *(u32x4*)(rowp + bj * HALF) = w; } }
    }
};

template <class Epi, bool ALIGN_EPI>
__device__ __forceinline__ void gemm_phase(LAS unsigned char* lds, LAS unsigned char* xl, const Gemm g, const Order& S, Epi& E) {
    const int tid = threadIdx.x, wid = __builtin_amdgcn_readfirstlane(tid >> 6), lane = tid & 63, wr = wid >> 2, wc = wid & 3, fr = lane & 15, fq = lane >> 4;
    const int K = g.K, nt = K / BK;
    unsigned voffA[2], voffB[2];
#pragma unroll
    for (int i = 0; i < 2; ++i) { int R, C; stage_rc(tid * 16 + i * 8192, R, C); const int Rb = Epi::PERM ? ((R & ~31) + perm32(R & 31)) : R;
        voffA[i] = (unsigned)(R * g.lda + C) * 2u; voffB[i] = (unsigned)(Rb * g.ldb + C) * 2u; }
    const size_t kstep = (size_t)(BK * 2);
    const size_t hstepA = (size_t)HALF * g.lda * 2, hstepB = (size_t)HALF * g.ldb * 2;
    const unsigned ldsw = (unsigned)wid * 1024u;
    const int aoff = lds_byte(wr * 64 + fr, fq * 8), boff = lds_byte(wc * 32 + fr, fq * 8);
#define PG8_SA(b, h) (((b) * 2 + (h)) * HTB)
#define PG8_SB(b, h) ((4 + (b) * 2 + (h)) * HTB)
#define PG8_STAGE(bufoff, gbase, voff) do { _Pragma("unroll") for (int _i = 0; _i < 2; ++_i) \
        __builtin_amdgcn_global_load_lds((const unsigned*)((const char*)(gbase) + (voff)[_i]), (LAS unsigned*)(lds + (bufoff) + ldsw + _i * 8192), 16, 0, 0); } while (0)
#define PG8_LDA(dst, b, h) do { _Pragma("unroll") for (int m = 0; m < 4; ++m) _Pragma("unroll") for (int k = 0; k < 2; ++k) dst[m][k] = *(const LAS bf16x8*)(lds + PG8_SA(b, h) + aoff + m * 2048 + k * 1024); } while (0)
#define PG8_LDB(dst, b, h) do { _Pragma("unroll") for (int n = 0; n < 2; ++n) _Pragma("unroll") for (int k = 0; k < 2; ++k) dst[n][k] = *(const LAS bf16x8*)(lds + PG8_SB(b, h) + boff + n * 2048 + k * 1024); } while (0)
#define PG8_MMA(ai, bj, At, Bt) do { __builtin_amdgcn_s_setprio(1); _Pragma("unroll") for (int m = 0; m < 4; ++m) _Pragma("unroll") for (int n = 0; n < 2; ++n) _Pragma("unroll") for (int k = 0; k < 2; ++k) \
        acc[ai][bj][m][n] = __builtin_amdgcn_mfma_f32_16x16x32_bf16(Bt[n][k], At[m][k], acc[ai][bj][m][n], 0, 0, 0); __builtin_amdgcn_s_setprio(0); } while (0)
#define PG8_WAIT_V(n) asm volatile("s_waitcnt vmcnt(" #n ")" ::: "memory")
#define PG8_WAIT_L(n) asm volatile("s_waitcnt lgkmcnt(" #n ")" ::: "memory")
#define PG8_BAR __builtin_amdgcn_s_barrier()
#define PG8_SCHED __builtin_amdgcn_sched_barrier(0)
    Unit cur, nxt; int ui = 0;
    if (!S.next(0, cur)) return;
    f32x4 acc[2][2][4][2];
#pragma unroll
    for (int a = 0; a < 2; ++a)
#pragma unroll
        for (int b = 0; b < 2; ++b)
#pragma unroll
            for (int m = 0; m < 4; ++m)
#pragma unroll
                for (int n = 0; n < 2; ++n) acc[a][b][m][n] = (f32x4){0.f, 0.f, 0.f, 0.f};
    bf16x8 At[4][2], B0[2][2], B1[2][2];
    const char* cA = (const char*)g.A + 2 * g.offA(cur); const char* cB = (const char*)g.Bt + 2 * g.offB(cur);
    PG8_STAGE(PG8_SB(0, 0), cB, voffB); PG8_STAGE(PG8_SB(0, 1), cB + hstepB, voffB); PG8_STAGE(PG8_SA(0, 0), cA, voffA); PG8_STAGE(PG8_SA(0, 1), cA + hstepA, voffA);
    if (wr == 1) PG8_BAR;
    PG8_WAIT_V(2); PG8_BAR;
    PG8_STAGE(PG8_SB(1, 0), cB + kstep, voffB); PG8_STAGE(PG8_SA(1, 0), cA + kstep, voffA); PG8_STAGE(PG8_SB(1, 1), cB + hstepB + kstep, voffB);
    PG8_WAIT_V(6); PG8_BAR;
    for (;;) {
        const bool has_next = S.next(ui + 1, nxt);
        const char* nA = has_next ? (const char*)g.A + 2 * g.offA(nxt) : cA; const char* nB = has_next ? (const char*)g.Bt + 2 * g.offB(nxt) : cB;
        for (int t = 0; t < nt; t += 2) {
            const bool last = (t == nt - 2);
            const char* a1 = cA + (size_t)(t + 1) * kstep;
            const char* a2 = last ? nA : cA + (size_t)(t + 2) * kstep; const char* b2 = last ? nB : cB + (size_t)(t + 2) * kstep;
            const char* a3 = a2 + kstep; const char* b3 = b2 + kstep;
            if constexpr (Epi::PSLDS) { if (last) {
                const char* psrc = (const char*)(E.PS + (size_t)cur.pm * (BM * 16)) + tid * 16;
#pragma unroll
                for (int _i = 0; _i < 2; ++_i) __builtin_amdgcn_global_load_lds((const unsigned*)(psrc + _i * 8192), (LAS unsigned*)(xl + 8192 + ldsw + _i * 8192), 16, 0, 0); } }
            PG8_LDB(B0, 0, 0); PG8_LDB(B1, 0, 1); PG8_SCHED; PG8_LDA(At, 0, 0); PG8_STAGE(PG8_SA(1, 1), a1 + hstepA, voffA);
            PG8_WAIT_V(8); PG8_WAIT_L(0); PG8_BAR; PG8_MMA(0, 0, At, B0); PG8_MMA(0, 1, At, B1); PG8_BAR; PG8_SCHED;
            PG8_LDA(At, 0, 1); PG8_STAGE(PG8_SB(0, 0), b2, voffB); PG8_STAGE(PG8_SB(0, 1), b2 + hstepB, voffB); PG8_STAGE(PG8_SA(0, 0), a2, voffA);
            PG8_WAIT_V(8); PG8_WAIT_L(0); PG8_BAR; PG8_MMA(1, 0, At, B0); PG8_MMA(1, 1, At, B1); PG8_BAR; PG8_SCHED;
            PG8_LDB(B0, 1, 0); PG8_LDB(B1, 1, 1); PG8_SCHED; PG8_LDA(At, 1, 0); PG8_STAGE(PG8_SA(0, 1), a2 + hstepA, voffA);
            PG8_WAIT_V(8); PG8_WAIT_L(0); PG8_BAR; PG8_MMA(0, 0, At, B0); PG8_MMA(0, 1, At, B1); PG8_BAR; PG8_SCHED;
            PG8_LDA(At, 1, 1); PG8_STAGE(PG8_SB(1, 0), b3, voffB); PG8_STAGE(PG8_SB(1, 1), b3 + hstepB, voffB); PG8_STAGE(PG8_SA(1, 0), a3, voffA);
            PG8_WAIT_V(8); PG8_WAIT_L(0); PG8_BAR; PG8_MMA(1, 0, At, B0); PG8_MMA(1, 1, At, B1); PG8_BAR; PG8_SCHED;
        }
        if constexpr (ALIGN_EPI) { if (wr == 0) PG8_BAR; }
        E(acc, cur, g.offC(cur), wr, wc, fr, fq, xl);
        if (!has_next) break;
#pragma unroll
        for (int a = 0; a < 2; ++a)
#pragma unroll
            for (int b = 0; b < 2; ++b)
#pragma unroll
                for (int m = 0; m < 4; ++m)
#pragma unroll
                    for (int n = 0; n < 2; ++n) acc[a][b][m][n] = (f32x4){0.f, 0.f, 0.f, 0.f};
        cur = nxt; cA = nA; cB = nB; ++ui;
        if constexpr (ALIGN_EPI) { if (wr == 1) PG8_BAR; }
    }
    PG8_WAIT_V(0);
    if constexpr (!ALIGN_EPI) { if (wr == 0) PG8_BAR; }
    PG8_BAR;
#undef PG8_SA
#undef PG8_SB
#undef PG8_STAGE
#undef PG8_LDA
#undef PG8_LDB
#undef PG8_MMA
#undef PG8_WAIT_V
#undef PG8_WAIT_L
#undef PG8_BAR
#undef PG8_SCHED
}
}

__device__ __forceinline__ f32x4 mfma16(bf16x8 bfrag, bf16x8 afrag, f32x4 acc) { return __builtin_amdgcn_mfma_f32_16x16x32_bf16(bfrag, afrag, acc, 0, 0, 0); }
__device__ __forceinline__ bf16x8 ldsfrag(const LAS bf16_t* base, int ld, int r0, int k0, int fr, int fq) { return *(const LAS bf16x8*)(base + (r0 + fr) * ld + k0 + fq * 8); }

template <int MODE> __device__ __forceinline__ void transpose_item(const float* W, int K, int N, bf16_t* WT, LAS float* scr, int item, int nblk, int lane, const float* gain = nullptr) {
    const int kb = item / nblk, nb = item % nblk, k0 = 64 * kb, n0 = 32 * nb; const int nsrc = n0 + (lane & 31);
#pragma unroll 8
    for (int i = 0; i < 32; ++i) { const int kk = 2 * i + (lane >> 5); scr[kk * 33 + (lane & 31)] = (nsrc < N) ? W[(size_t)(k0 + kk) * N + nsrc] * (gain ? gain[k0 + kk] : 1.f) : 0.f; }
    LDS_WAIT();
    const int c = lane & 7;
#pragma unroll
    for (int j = 0; j < 4; ++j) { const int n = (lane >> 3) + 8 * j; const LAS float* s = scr + (8 * c) * 33 + n;
        u32x4 o; o.x = pk2(s[0 * 33], s[1 * 33]); o.y = pk2(s[2 * 33], s[3 * 33]); o.z = pk2(s[4 * 33], s[5 * 33]); o.w = pk2(s[6 * 33], s[7 * 33]);
        int drow = n0 + n; if (MODE == 1) { const int jn = drow % FFN, isu = drow / FFN; drow = (jn / 128) * 256 + isu * 128 + (jn % 128); }
        *(u32x4*)(WT + (size_t)drow * K + k0 + 8 * c) = o; }
    LDS_WAIT();
}
__device__ __forceinline__ void rms_row_bf16(const float* xrow, const float* gain, bf16_t* orow, int lane) {
    const f32x4* xr = (const f32x4*)xrow + lane; f32x4 v[4]; float s = 0.f;
#pragma unroll
    for (int j = 0; j < 4; ++j) { v[j] = xr[64 * j]; s += (v[j].x * v[j].x + v[j].y * v[j].y) + (v[j].z * v[j].z + v[j].w * v[j].w); }
    const float rs = rsqrtf(wave_sum(s) * (1.f / D) + 1e-6f);
    const f32x4* gr = (const f32x4*)gain + lane; u32x2* o8 = (u32x2*)orow + lane;
#pragma unroll
    for (int j = 0; j < 4; ++j) { const f32x4 g = gr[64 * j]; u32x2 w; w.x = pk2(v[j].x * rs * g.x, v[j].y * rs * g.y); w.y = pk2(v[j].z * rs * g.z, v[j].w * rs * g.w); o8[64 * j] = w; }
}
__device__ __forceinline__ void rms_row2_bf16(const float* xa, const float* xb, const float* gain, bf16_t* oa, bf16_t* ob, int lane) {
    const f32x4* ra = (const f32x4*)xa + lane; const f32x4* rb = (const f32x4*)xb + lane; f32x4 va[4], vb[4]; float sa = 0.f, sb = 0.f;
#pragma unroll
    for (int j = 0; j < 4; ++j) { va[j] = ra[64 * j]; vb[j] = rb[64 * j]; }
#pragma unroll
    for (int j = 0; j < 4; ++j) { sa += (va[j].x * va[j].x + va[j].y * va[j].y) + (va[j].z * va[j].z + va[j].w * va[j].w); sb += (vb[j].x * vb[j].x + vb[j].y * vb[j].y) + (vb[j].z * vb[j].z + vb[j].w * vb[j].w); }
#pragma unroll
    for (int o = 1; o < 64; o <<= 1) { sa += __shfl_xor(sa, o); sb += __shfl_xor(sb, o); }
    const float rsa = rsqrtf(sa * (1.f / D) + 1e-6f), rsb = rsqrtf(sb * (1.f / D) + 1e-6f);
    const f32x4* gr = (const f32x4*)gain + lane; u32x2* pa = (u32x2*)oa + lane; u32x2* pb = (u32x2*)ob + lane;
#pragma unroll
    for (int j = 0; j < 4; ++j) { const f32x4 g = gr[64 * j]; u32x2 w;
        w.x = pk2(va[j].x * rsa * g.x, va[j].y * rsa * g.y); w.y = pk2(va[j].z * rsa * g.z, va[j].w * rsa * g.w); pa[64 * j] = w;
        w.x = pk2(vb[j].x * rsb * g.x, vb[j].y * rsb * g.y); w.y = pk2(vb[j].z * rsb * g.z, vb[j].w * rsb * g.w); pb[64 * j] = w; }
}
__device__ __forceinline__ void rms_rows_phase(const float* X, const float* gain, bf16_t* H, int nrows, int gw, int NGW, int lane) {
    int m = gw;
    for (; m + NGW < nrows; m += 2 * NGW) rms_row2_bf16(X + (size_t)m * D, X + (size_t)(m + NGW) * D, gain, H + (size_t)m * D, H + (size_t)(m + NGW) * D, lane);
    if (m < nrows) rms_row_bf16(X + (size_t)m * D, gain, H + (size_t)m * D, lane);
}

__device__ __forceinline__ void rwkv_chain(LAS unsigned char* lds, int cid, const bf16_t* P0, const float* mu, const float* w0, const float* w2, const float* a0, const float* a2,
                                           const float* k_k, const float* k_a, const float* r_k, bf16_t* ORW, bf16_t* SG, float* BONUS) {
    const int tid = threadIdx.x, lane = tid & 63, wid = tid >> 6, fr = lane & 15, fq = lane >> 4;
    const int b = cid >> 4, h = (cid >> 1) & 7, dir = cid & 1;
    LAS float* rS = (LAS float*)(lds); LAS float* kS = (LAS float*)(lds + 8192); LAS float* vS = (LAS float*)(lds + 16384); LAS float* wS = (LAS float*)(lds + 24576);
    LAS float* nkS = (LAS float*)(lds + 32768); LAS float* bS = (LAS float*)(lds + 40960); LAS float* preA = (LAS float*)(lds + 49152); LAS float* preW = (LAS float*)(lds + 57344);
    LAS bf16_t* adB = (LAS bf16_t*)(lds + 65536); LAS bf16_t* wdB = (LAS bf16_t*)(lds + 70144);
    LAS bf16_t* a2B = (LAS bf16_t*)(lds + 74752); LAS bf16_t* w2B = (LAS bf16_t*)(lds + 83968); LAS float* cst = (LAS float*)(lds + 93184);
    LAS bf16_t* At = (LAS bf16_t*)(lds + 97280); LAS bf16_t* Bt = (LAS bf16_t*)(lds + 101888); LAS bf16_t* Kt = (LAS bf16_t*)(lds + 106496); LAS bf16_t* Rt = (LAS bf16_t*)(lds + 111104);
    LAS bf16_t* BtT = (LAS bf16_t*)(lds + 115712); LAS bf16_t* KtT = (LAS bf16_t*)(lds + 120832); LAS bf16_t* VT = (LAS bf16_t*)(lds + 125952); LAS bf16_t* S0b = (LAS bf16_t*)(lds + 131072);
    LAS float* NT4 = (LAS float*)(lds + 140288); LAS bf16_t* NakT = (LAS bf16_t*)(lds + 146432); LAS bf16_t* MbrT = (LAS bf16_t*)(lds + 148992); LAS bf16_t* MkrT = (LAS bf16_t*)(lds + 151552);
    LAS float* gL = (LAS float*)(lds + 154112);
    LAS float* WS = preA;
    LAS bf16_t* Ub = (LAS bf16_t*)preW;
#define RW_IDS int tid_o = threadIdx.x; asm volatile("" : "+v"(tid_o)); const int tid = tid_o, lane = tid & 63, wid = __builtin_amdgcn_readfirstlane(tid >> 6), fr = lane & 15, fq = lane >> 4, vt = wid >> 1, tt2 = wid & 1; (void)lane; (void)wid; (void)fr; (void)fq; (void)vt; (void)tt2;
    __syncthreads();
    for (int e = tid; e < 64 * 64; e += 512) { const int j = e & 63, r = e >> 6;
        a2B[j * 72 + r] = (bf16_t)f2bf(a2[r * 512 + h * 64 + j]); w2B[j * 72 + r] = (bf16_t)f2bf(w2[(dir * 64 + r) * 512 + h * 64 + j]); }
    for (int e = tid; e < 64 * 72 / 2; e += 512) ((LAS unsigned*)S0b)[e] = 0u;
    if (tid < 64) { const int j = tid, c = h * 64 + j;
        cst[0 * 64 + j] = a0[c]; cst[1 * 64 + j] = w0[dir * 512 + c]; cst[2 * 64 + j] = k_k[c]; cst[3 * 64 + j] = k_a[c]; cst[4 * 64 + j] = r_k[c];
        cst[5 * 64 + j] = mu[c]; cst[6 * 64 + j] = mu[512 + c]; cst[7 * 64 + j] = mu[1024 + c]; cst[8 * 64 + j] = mu[1536 + j]; cst[9 * 64 + j] = mu[1600 + j];
        cst[10 * 64 + j] = (j < 16) ? mu[1664 + h * 16 + j] : 0.f; }
    const int vt = wid >> 1, tt2 = wid & 1;
    f32x4 st[2]; st[0] = (f32x4){0.f, 0.f, 0.f, 0.f}; st[1] = st[0];
    __syncthreads();
    const bf16_t* Pb = P0 + (size_t)b * SEQ * ABPAD;
    unsigned rc[10], rpv[10], rnx[10]; unsigned short gcv = 0, gpv = 0, gnv = 0;
#define RW_IDX(i) const int grp = (i) >> 1; const int idx_ = tid + 512 * ((i) & 1); const int tok = idx_ >> 5, c2 = (idx_ & 31) * 2; \
                  const int gcol = (grp == 0 ? h * 64 : grp == 1 ? 512 + h * 64 : grp == 2 ? 1024 + h * 64 : grp == 3 ? 1536 : 1600) + c2;
    const unsigned voff = (unsigned)((((int)threadIdx.x >> 5) * ABPAD + ((int)threadIdx.x & 31) * 2) * 2);
#define RW_CG(g) ((g) == 0 ? h * 128 : (g) == 1 ? 1024 + h * 128 : (g) == 2 ? 2048 + h * 128 : (g) == 3 ? 3072 : 3200)
#define RW_ISSUE(t0n) do { const char* bp_ = (const char*)(Pb + (size_t)(t0n) * ABPAD); const bool first_ = ((t0n) == 0) && (tid < 32), last_ = ((t0n) == SEQ - 32) && (tid >= 480); \
        _Pragma("unroll") for (int i = 0; i < 10; ++i) { const char* p = bp_ + (RW_CG(i >> 1) + (i & 1) * 16 * ABPAD * 2) + voff; \
            rc[i] = *(const unsigned*)p; \
            if ((i & 1) == 0) { const unsigned v_ = *(const unsigned*)(p - (first_ ? 0 : ABPAD * 2)); rpv[i] = first_ ? 0u : v_; rnx[i] = *(const unsigned*)(p + ABPAD * 2); } \
            else { const unsigned v_ = *(const unsigned*)(p + (last_ ? 0 : ABPAD * 2)); rnx[i] = last_ ? 0u : v_; rpv[i] = *(const unsigned*)(p - ABPAD * 2); } } \
        if (dir == 0) { const bool fg_ = ((t0n) == 0) && (tid < 16), lg_ = ((t0n) == SEQ - 32) && (tid >= 496); \
            const bf16_t* p = (const bf16_t*)bp_ + (size_t)(tid >> 4) * ABPAD + 1664 + h * 16 + (tid & 15); \
            gcv = *p; { const unsigned short v_ = *(p - (fg_ ? 0 : ABPAD)); gpv = fg_ ? (unsigned short)0 : v_; } { const unsigned short v_ = *(p + (lg_ ? 0 : ABPAD)); gnv = lg_ ? (unsigned short)0 : v_; } } } while (0)
    RW_ISSUE(dir ? 127 * 32 : 0);
    for (int cc = 0; cc < 128; ++cc) {
        const int t0 = dir ? (127 - cc) * 32 : cc * 32;
        { RW_IDS
#pragma unroll
        for (int i = 0; i < 10; ++i) { RW_IDX(i) (void)gcol;
            const unsigned cur = rc[i], prv = rpv[i], nxt = rnx[i];
            const float m0 = cst[(5 + grp) * 64 + c2], m1 = cst[(5 + grp) * 64 + c2 + 1];
            const float c0 = bflo(cur), c1 = bfhi(cur);
            const float x0 = c0 + m0 * (0.5f * (bflo(prv) + bflo(nxt)) - c0), x1 = c1 + m1 * (0.5f * (bfhi(prv) + bfhi(nxt)) - c1);
            if (grp == 0) { *(LAS f32x2*)(rS + tok * 64 + c2) = (f32x2){x0, x1}; }
            else if (grp == 1) { *(LAS f32x2*)(kS + tok * 64 + c2) = (f32x2){x0, x1}; }
            else if (grp == 2) { *(LAS f32x2*)(vS + tok * 64 + c2) = (f32x2){x0, x1}; }
            else if (grp == 3) { const float e0 = __expf(2.f * x0), e1 = __expf(2.f * x1); *(LAS unsigned*)(wdB + tok * 72 + c2) = pk2(1.f - 2.f * frcp(e0 + 1.f), 1.f - 2.f * frcp(e1 + 1.f)); }
            else { *(LAS unsigned*)(adB + tok * 72 + c2) = pk2(x0, x1); }
        }
        if (dir == 0) {
            const int tok = tid >> 4, c = tid & 15, t = t0 + tok;
            const float cur = bf2f(gcv), prv = bf2f(gpv), nxt = bf2f(gnv);
            const float x = cur + cst[10 * 64 + c] * (0.5f * (prv + nxt) - cur);
            SG[((size_t)b * SEQ + t) * 128 + h * 16 + c] = (bf16_t)f2bf(sigmoidf_(x));
        } }
        __syncthreads();
        if (cc + 1 < 128) { RW_IDS const int t0n = dir ? (126 - cc) * 32 : (cc + 1) * 32; RW_ISSUE(t0n); }
        { RW_IDS const int mat = wid >> 2, ntile = wid & 3; const LAS bf16_t* Aop = mat ? wdB : adB; const LAS bf16_t* Bop = mat ? w2B : a2B; LAS float* pre = mat ? preW : preA;
#pragma unroll
          for (int mt = 0; mt < 2; ++mt) { f32x4 acc = (f32x4){0.f, 0.f, 0.f, 0.f};
#pragma unroll
              for (int ks = 0; ks < 2; ++ks) acc = mfma16(ldsfrag(Bop, 72, ntile * 16, ks * 32, fr, fq), ldsfrag(Aop, 72, mt * 16, ks * 32, fr, fq), acc);
              *(LAS f32x4*)(pre + (mt * 16 + fr) * 64 + ntile * 16 + fq * 4) = acc; } }
        __syncthreads();
        { RW_IDS const int tok = tid >> 4, c0 = (tid & 15) * 4; float kkr[4], av[4], kp[4], wv[4]; float ss = 0.f, bon = 0.f;
#pragma unroll
          for (int i = 0; i < 4; ++i) { const int c = c0 + i, ix = tok * 64 + c;
              const float a = sigmoidf_(cst[c] + preA[ix]); const float sg = sigmoidf_(cst[64 + c] + preW[ix]);
              wv[i] = -0.60653065971f * sg;
              const float kraw = kS[ix]; kkr[i] = kraw * cst[128 + c]; ss += kkr[i] * kkr[i];
              kp[i] = kraw * (1.0f + (a - 1.0f) * cst[192 + c]); av[i] = a; bon += rS[ix] * kp[i] * cst[256 + c]; }
          ss += dppf<0xB1>(ss); bon += dppf<0xB1>(bon); ss += dppf<0x4E>(ss); bon += dppf<0x4E>(bon);
          ss += dppf<0x141>(ss); bon += dppf<0x141>(bon); ss += dppf<0x140>(ss); bon += dppf<0x140>(bon);
          const float inv = frcp(fmaxf(__builtin_amdgcn_sqrtf(ss), 1e-12f));
          f32x4 o_nk, o_b, o_k, o_w;
#pragma unroll
          for (int i = 0; i < 4; ++i) { const float kk = kkr[i] * inv; o_nk[i] = -kk; o_b[i] = kk * av[i]; o_k[i] = kp[i]; o_w[i] = wv[i]; }
          *(LAS f32x4*)(nkS + tok * 64 + c0) = o_nk; *(LAS f32x4*)(bS + tok * 64 + c0) = o_b; *(LAS f32x4*)(kS + tok * 64 + c0) = o_k; *(LAS f32x4*)(wS + tok * 64 + c0) = o_w;
          if (dir == 0 && (tid & 15) == 0) BONUS[((size_t)b * SEQ + t0 + tok) * 8 + h] = bon; }
        __syncthreads();
        { RW_IDS if (tid < 64) { float lw[32];
#pragma unroll
            for (int s = 0; s < 32; ++s) lw[s] = wS[(dir ? 31 - s : s) * 64 + tid];
#pragma unroll
            for (int s = 1; s < 32; ++s) lw[s] += lw[s - 1];
#pragma unroll
            for (int s = 0; s < 32; ++s) wS[(dir ? 31 - s : s) * 64 + tid] = lw[s]; } }
        __syncthreads();
        { RW_IDS const int s = tid >> 4, c0 = (tid & 15) * 4; const int tok = dir ? 31 - s : s, tokp = dir ? tok + 1 : tok - 1;
          const f32x4 cum = *(const LAS f32x4*)(wS + tok * 64 + c0); f32x4 cump = (f32x4){0.f, 0.f, 0.f, 0.f}; if (s > 0) cump = *(const LAS f32x4*)(wS + tokp * 64 + c0);
          const f32x4 nk4 = *(const LAS f32x4*)(nkS + tok * 64 + c0), b4 = *(const LAS f32x4*)(bS + tok * 64 + c0), k4 = *(const LAS f32x4*)(kS + tok * 64 + c0), r4 = *(const LAS f32x4*)(rS + tok * 64 + c0), v4 = *(const LAS f32x4*)(vS + tok * 64 + c0);
          float ta[4], tb[4], tk[4], tr[4];
#pragma unroll
          for (int i = 0; i < 4; ++i) { const float g = __expf(cum[i]), gp = __expf(cump[i]), ig = __expf(-cum[i]);
              ta[i] = nk4[i] * gp; tb[i] = b4[i] * ig; tk[i] = k4[i] * ig; tr[i] = r4[i] * g;
              BtT[(c0 + i) * 40 + s] = (bf16_t)f2bf(tb[i]); KtT[(c0 + i) * 40 + s] = (bf16_t)f2bf(tk[i]); VT[(c0 + i) * 40 + s] = (bf16_t)f2bf(v4[i]);
              if (s == 31) gL[c0 + i] = g; }
          u32x2 w; w.x = pk2(ta[0], ta[1]); w.y = pk2(ta[2], ta[3]); *(LAS u32x2*)(At + s * 72 + c0) = w;
          w.x = pk2(tb[0], tb[1]); w.y = pk2(tb[2], tb[3]); *(LAS u32x2*)(Bt + s * 72 + c0) = w;
          w.x = pk2(tk[0], tk[1]); w.y = pk2(tk[2], tk[3]); *(LAS u32x2*)(Kt + s * 72 + c0) = w;
          w.x = pk2(tr[0], tr[1]); w.y = pk2(tr[2], tr[3]); *(LAS u32x2*)(Rt + s * 72 + c0) = w; }
        __syncthreads();
        { RW_IDS const int mat = wid >> 1, mt = wid & 1; const LAS bf16_t* Aop = (mat < 2) ? At : Rt; const LAS bf16_t* Bop = (mat & 1) ? Kt : Bt;
#pragma unroll
          for (int nt = 0; nt < 2; ++nt) { f32x4 acc = (f32x4){0.f, 0.f, 0.f, 0.f};
#pragma unroll
              for (int ks = 0; ks < 2; ++ks) acc = mfma16(ldsfrag(Bop, 72, nt * 16, ks * 32, fr, fq), ldsfrag(Aop, 72, mt * 16, ks * 32, fr, fq), acc);
              const int srow = mt * 16 + fr;
#pragma unroll
              for (int e = 0; e < 4; ++e) { const int i = nt * 16 + fq * 4 + e; const bool keep = (mat < 2) ? (i < srow) : (i <= srow); if (!keep) acc[e] = 0.f; }
              if (mat == 0) {
#pragma unroll
                  for (int e = 0; e < 4; ++e) NT4[e * 384 + srow * 12 + nt * 4 + fq] = acc[e]; }
              else { LAS bf16_t* X = (mat == 1) ? NakT : (mat == 2) ? MbrT : MkrT; u32x2 o; o.x = pk2(acc[0], acc[1]); o.y = pk2(acc[2], acc[3]); *(LAS u32x2*)(X + srow * 40 + nt * 16 + fq * 4) = o; } } }
        __syncthreads();
        f32x4 oacc = (f32x4){0.f, 0.f, 0.f, 0.f};
        { RW_IDS f32x4 wacc = (f32x4){0.f, 0.f, 0.f, 0.f};
#pragma unroll
          for (int ks = 0; ks < 2; ++ks) { const bf16x8 sf = ldsfrag(S0b, 72, vt * 16, ks * 32, fr, fq);
              wacc = mfma16(ldsfrag(At, 72, tt2 * 16, ks * 32, fr, fq), sf, wacc); oacc = mfma16(ldsfrag(Rt, 72, tt2 * 16, ks * 32, fr, fq), sf, oacc); }
          const bf16x8 vf = ldsfrag(VT, 40, vt * 16, 0, fr, fq);
          wacc = mfma16(ldsfrag(NakT, 40, tt2 * 16, 0, fr, fq), vf, wacc); oacc = mfma16(ldsfrag(MkrT, 40, tt2 * 16, 0, fr, fq), vf, oacc);
#pragma unroll
          for (int n2 = 0; n2 < 2; ++n2) st[n2] = mfma16(ldsfrag(KtT, 40, (tt2 * 2 + n2) * 16, 0, fr, fq), vf, st[n2]);
#pragma unroll
          for (int e = 0; e < 4; ++e) WS[(tt2 * 16 + fq * 4 + e) * 64 + vt * 16 + fr] = wacc[e]; }
        __syncthreads();
        { RW_IDS if (wid < 4) { const int v = wid * 16 + (lane >> 2), p = lane & 3; const LAS float* NTp = NT4 + p * 384; float u[8];
#pragma unroll
            for (int j = 0; j < 8; ++j) u[j] = 0.f;
#pragma unroll
            for (int t = 0; t < 32; ++t) { float q0 = (p == 0) ? WS[t * 64 + v] : 0.f, q1 = 0.f;
#pragma unroll
                for (int j4 = 0; j4 < ((t + 3) / 4 + 3) / 4; ++j4) { const f32x4 nv = *(const LAS f32x4*)(NTp + t * 12 + j4 * 4);
                    q0 += u[j4 * 4] * nv[0]; q1 += u[j4 * 4 + 1] * nv[1]; q0 += u[j4 * 4 + 2] * nv[2]; q1 += u[j4 * 4 + 3] * nv[3]; }
                float q = q0 + q1; q += dppf<0xB1>(q); q += dppf<0x4E>(q);
                u[t >> 2] = ((t & 3) == p) ? q : u[t >> 2]; asm volatile("" ::: "memory"); }
#pragma unroll
            for (int j = 0; j < 8; ++j) Ub[v * 40 + 4 * j + p] = (bf16_t)f2bf(u[j]); } }
        __syncthreads();
        { RW_IDS const bf16x8 uf = ldsfrag(Ub, 40, vt * 16, 0, fr, fq);
          oacc = mfma16(ldsfrag(MbrT, 40, tt2 * 16, 0, fr, fq), uf, oacc);
#pragma unroll
          for (int e = 0; e < 4; ++e) { const int sidx = tt2 * 16 + fq * 4 + e, tok = dir ? 31 - sidx : sidx;
              ORW[(size_t)dir * T * 512 + ((size_t)b * SEQ + t0 + tok) * 512 + h * 64 + vt * 16 + fr] = (bf16_t)f2bf(oacc[e]); }
#pragma unroll
          for (int n2 = 0; n2 < 2; ++n2) { const int kt = tt2 * 2 + n2; st[n2] = mfma16(ldsfrag(BtT, 40, kt * 16, 0, fr, fq), uf, st[n2]);
              const f32x4 gl = *(const LAS f32x4*)(gL + kt * 16 + fq * 4); st[n2] = st[n2] * gl;
              u32x2 o; o.x = pk2(st[n2][0], st[n2][1]); o.y = pk2(st[n2][2], st[n2][3]); *(LAS u32x2*)(S0b + (vt * 16 + fr) * 72 + kt * 16 + fq * 4) = o; } }
    }
#undef RW_IDX
#undef RW_ISSUE
#undef RW_IDS
#undef RW_CG
    __syncthreads();
}

__device__ __forceinline__ void rwkv_combine(const bf16_t* P0, const bf16_t* ORW, const float* BONUS, const bf16_t* G, const float* mu, const float* gn_w, const float* gn_b, bf16_t* OMIX, int gw, int NGW, int lane) {
    const int c0 = lane * 8, head = lane >> 3;
    float muv[8], gw8[8], gb8[8];
#pragma unroll
    for (int i = 0; i < 8; ++i) { muv[i] = mu[1024 + c0 + i]; gw8[i] = gn_w[c0 + i]; gb8[i] = gn_b[c0 + i]; }
#pragma unroll 2
    for (int tk = gw; tk < T; tk += NGW) {
        const int t = tk & (SEQ - 1);
        const u32x4 uf = *(const u32x4*)(ORW + (size_t)tk * 512 + c0), ub = *(const u32x4*)(ORW + (size_t)T * 512 + (size_t)tk * 512 + c0);
        float o[8];
#pragma unroll
        for (int i = 0; i < 4; ++i) { o[2 * i] = bflo(uf[i]) + bflo(ub[i]); o[2 * i + 1] = bfhi(uf[i]) + bfhi(ub[i]); }
        float s = 0.f;
#pragma unroll
        for (int i = 0; i < 8; ++i) s += o[i];
        const float mean = sum8(s) * (1.f / 64.f); float q = 0.f;
#pragma unroll
        for (int i = 0; i < 8; ++i) { o[i] -= mean; q += o[i] * o[i]; }
        const float rstd = rsqrtf(sum8(q) * (1.f / 64.f) + 64e-5f);
        const bf16_t* pv = P0 + (size_t)tk * ABPAD + 1024 + c0;
        const u32x4 vc = *(const u32x4*)pv; u32x4 vp = (u32x4){0u, 0u, 0u, 0u}, vn = (u32x4){0u, 0u, 0u, 0u};
        if (t > 0) vp = *(const u32x4*)(pv - ABPAD);
        if (t < SEQ - 1) vn = *(const u32x4*)(pv + ABPAD);
        const u32x4 gg = *(const u32x4*)(G + (size_t)tk * 512 + c0);
        const float bon = BONUS[(size_t)tk * 8 + head];
        float r[8];
#pragma unroll
        for (int i = 0; i < 4; ++i) {
            const float c_lo = bflo(vc[i]), c_hi = bfhi(vc[i]);
            const float v_lo = c_lo + muv[2 * i] * (0.5f * (bflo(vp[i]) + bflo(vn[i])) - c_lo), v_hi = c_hi + muv[2 * i + 1] * (0.5f * (bfhi(vp[i]) + bfhi(vn[i])) - c_hi);
            r[2 * i] = (o[2 * i] * rstd * gw8[2 * i] + gb8[2 * i] + bon * v_lo) * bflo(gg[i]);
            r[2 * i + 1] = (o[2 * i + 1] * rstd * gw8[2 * i + 1] + gb8[2 * i + 1] + bon * v_hi) * bfhi(gg[i]); }
        u32x4 w; w.x = pk2(r[0], r[1]); w.y = pk2(r[2], r[3]); w.z = pk2(r[4], r[5]); w.w = pk2(r[6], r[7]);
        *(u32x4*)(OMIX + (size_t)tk * D + c0) = w;
    }
}

constexpr int SLD = 136;
__device__ __forceinline__ float softplusf_(float x) { return x > 20.f ? x : log1pf(__expf(x)); }
__device__ __forceinline__ void ssd_dt_cum(LAS float* dtS, LAS float* cumS, LAS float* totS, const bf16_t* Prow0, int g, int w, int lane, const float* dt_bias, const float* a_log) {
    const int j = w >> 1, d = w & 1, head = g * 4 + j;
    const float bias = dt_bias[d * 8 + head], A = -__expf(a_log[d * 8 + head]);
    const float x0 = bf2f(Prow0[(size_t)(2 * lane) * ABPAD + 3328 + head]), x1 = bf2f(Prow0[(size_t)(2 * lane + 1) * ABPAD + 3328 + head]);
    const float dt0 = softplusf_(x0 + bias), dt1 = softplusf_(x1 + bias), la0 = dt0 * A, la1 = dt1 * A;
    const float s = la0 + la1; float inc = s;
#pragma unroll
    for (int off = 1; off < 64; off <<= 1) { const float n = __shfl_up(inc, off); if (lane >= off) inc += n; }
    const float tot = __shfl(inc, 63), exc = inc - s;
    float c0, c1; if (d == 0) { c0 = exc + la0; c1 = inc; } else { c0 = tot - exc; c1 = tot - exc - la0; }
    dtS[w * 128 + 2 * lane] = dt0; dtS[w * 128 + 2 * lane + 1] = dt1; cumS[w * 128 + 2 * lane] = c0; cumS[w * 128 + 2 * lane + 1] = c1;
    if (lane == 0) totS[w] = tot;
}
template <int NR, bool TR> __device__ __forceinline__ void ssd_conv8(LAS bf16_t* dst, int col0, int cx0, int l0, const bf16_t* Pb, int t0, const float* cw, const float* cb) {
    u32x4 raw[NR + 2];
    const bf16_t* p = Pb + (size_t)(t0 + l0) * ABPAD + 2304 + cx0;
#pragma unroll
    for (int i = 0; i < NR + 2; ++i) { const int t = t0 + l0 + i - 1; raw[i] = (t >= 0 && t < SEQ) ? *(const u32x4*)(p + (long)(i - 1) * ABPAD) : (u32x4){0u, 0u, 0u, 0u}; }
    float w0[8], w1[8], w2[8], bs[8];
#pragma unroll
    for (int q = 0; q < 2; ++q) { const f32x4 a = *(const f32x4*)(cw + cx0 + 4 * q), bq = *(const f32x4*)(cw + 1024 + cx0 + 4 * q), c = *(const f32x4*)(cw + 2048 + cx0 + 4 * q), d = *(const f32x4*)(cb + cx0 + 4 * q);
#pragma unroll
        for (int i = 0; i < 4; ++i) { w0[4 * q + i] = a[i]; w1[4 * q + i] = bq[i]; w2[4 * q + i] = c[i]; bs[4 * q + i] = d[i]; } }
    float o[NR][8];
#pragma unroll
    for (int i = 0; i < NR; ++i)
#pragma unroll
        for (int c = 0; c < 8; ++c) { const unsigned um = raw[i][c >> 1], u0 = raw[i + 1][c >> 1], up = raw[i + 2][c >> 1];
            const float fm = (c & 1) ? bfhi(um) : bflo(um), f0 = (c & 1) ? bfhi(u0) : bflo(u0), fp = (c & 1) ? bfhi(up) : bflo(up);
            o[i][c] = siluf_(w0[c] * fm + w1[c] * f0 + w2[c] * fp + bs[c]); }
    if (TR) {
#pragma unroll
        for (int c = 0; c < 8; ++c) { LAS bf16_t* q = dst + (col0 + c) * SLD + l0;
            if (NR == 8) { u32x4 w; w.x = pk2(o[0][c], o[1][c]); w.y = pk2(o[2][c], o[3][c]); w.z = pk2(o[4 % NR][c], o[5 % NR][c]); w.w = pk2(o[6 % NR][c], o[7 % NR][c]); *(LAS u32x4*)q = w; }
            else { u32x2 w; w.x = pk2(o[0][c], o[1][c]); w.y = pk2(o[2][c], o[3][c]); *(LAS u32x2*)q = w; } }
    } else {
#pragma unroll
        for (int i = 0; i < NR; ++i) { u32x4 w; w.x = pk2(o[i][0], o[i][1]); w.y = pk2(o[i][2], o[i][3]); w.z = pk2(o[i][4], o[i][5]); w.w = pk2(o[i][6], o[i][7]); *(LAS u32x4*)(dst + (l0 + i) * SLD + col0) = w; }
    }
}
__device__ __forceinline__ void ssd_s1_unit(LAS unsigned char* lds, int unit, const bf16_t* P0, const float* cw, const float* cb, const float* dt_bias, const float* a_log, bf16_t* STATES, float* TOT) {
    const int tid = threadIdx.x, lane = tid & 63, w = tid >> 6, fr = lane & 15, fq = lane >> 4;
    const int g = unit & 1, c = (unit >> 1) & 31, b = unit >> 6, t0 = c * 128;
    LAS bf16_t* BT = (LAS bf16_t*)lds; LAS bf16_t* XT = (LAS bf16_t*)(lds + 34816); LAS float* dtS = (LAS float*)(lds + 104448); LAS float* cumS = (LAS float*)(lds + 108544);
    LAS float* scS = (LAS float*)(lds + 112640); LAS float* totS = (LAS float*)(lds + 116736);
    const bf16_t* Pb = P0 + (size_t)b * SEQ * ABPAD;
    __syncthreads();
    ssd_conv8<4, true>(BT, (tid & 15) * 8, 512 + g * 128 + (tid & 15) * 8, (tid >> 4) * 4, Pb, t0, cw, cb);
    ssd_conv8<8, true>(XT, (tid & 31) * 8, g * 256 + (tid & 31) * 8, (tid >> 5) * 8, Pb, t0, cw, cb);
    ssd_dt_cum(dtS, cumS, totS, Pb + (size_t)t0 * ABPAD, g, w, lane, dt_bias, a_log);
    __syncthreads();
    for (int e = tid; e < 1024; e += 512) scS[e] = dtS[e] * __expf(totS[e >> 7] - cumS[e]);
    if (tid < 8) TOT[((size_t)(b * 32 + c) * 2 + (tid & 1)) * 8 + g * 4 + (tid >> 1)] = totS[tid];
    __syncthreads();
    const int j = w >> 1;
#pragma unroll 1
    for (int d = 0; d < 2; ++d) {
        f32x4 acc[2][8];
#pragma unroll
        for (int mt = 0; mt < 2; ++mt)
#pragma unroll
            for (int nt = 0; nt < 8; ++nt) acc[mt][nt] = (f32x4){0.f, 0.f, 0.f, 0.f};
#pragma unroll 1
        for (int ks = 0; ks < 4; ++ks) {
            const int k0 = ks * 32; const LAS float* sp = scS + (j * 2 + d) * 128 + k0 + fq * 8;
            const f32x4 s0 = *(const LAS f32x4*)sp, s1 = *(const LAS f32x4*)(sp + 4);
            bf16x8 afr[2];
#pragma unroll
            for (int mt = 0; mt < 2; ++mt) { const u32x4 raw = *(const LAS u32x4*)(XT + (32 * w + mt * 16 + fr) * SLD + k0 + fq * 8); u32x4 o;
                o.x = pk2(bflo(raw.x) * s0[0], bfhi(raw.x) * s0[1]); o.y = pk2(bflo(raw.y) * s0[2], bfhi(raw.y) * s0[3]);
                o.z = pk2(bflo(raw.z) * s1[0], bfhi(raw.z) * s1[1]); o.w = pk2(bflo(raw.w) * s1[2], bfhi(raw.w) * s1[3]);
                afr[mt] = __builtin_bit_cast(bf16x8, o); }
#pragma unroll
            for (int nt = 0; nt < 8; ++nt) { const bf16x8 bfr = ldsfrag(BT, SLD, nt * 16, k0, fr, fq);
#pragma unroll
                for (int mt = 0; mt < 2; ++mt) acc[mt][nt] = mfma16(bfr, afr[mt], acc[mt][nt]); }
        }
        bf16_t* dst = STATES + (((size_t)(b * 32 + c) * 2 + d) * 8 + g * 4 + j) * 8192;
#pragma unroll
        for (int mt = 0; mt < 2; ++mt) { const int p = (w & 1) * 32 + mt * 16 + fr;
#pragma unroll
            for (int nt = 0; nt < 8; ++nt) { u32x2 o; o.x = pk2(acc[mt][nt][0], acc[mt][nt][1]); o.y = pk2(acc[mt][nt][2], acc[mt][nt][3]);
                *(u32x2*)(dst + p * 128 + nt * 16 + fq * 4) = o; } }
    }
}
__device__ __forceinline__ void ssd_s2(const bf16_t* __restrict__ STATES, bf16_t* __restrict__ CARR, const float* __restrict__ TOT, int gtid, int NGT) {
    for (int it = gtid; it < 16 * 2 * 8 * 1024; it += NGT) {
        const int e8 = it & 1023, head = (it >> 10) & 7, d = (it >> 13) & 1, b = it >> 14;
        float run[8];
#pragma unroll
        for (int i = 0; i < 8; ++i) run[i] = 0.f;
#pragma unroll 1
        for (int c8 = 0; c8 < 32; c8 += 8) {
            u32x4 loc[8]; float dec[8];
#pragma unroll
            for (int q = 0; q < 8; ++q) { const int cc = c8 + q, c = d ? 31 - cc : cc; const size_t sidx = ((size_t)(b * 32 + c) * 2 + d) * 8 + head;
                loc[q] = *(const u32x4*)(STATES + sidx * 8192 + e8 * 8); dec[q] = TOT[sidx]; }
#pragma unroll
            for (int q = 0; q < 8; ++q) { const int cc = c8 + q, c = d ? 31 - cc : cc; const size_t sidx = ((size_t)(b * 32 + c) * 2 + d) * 8 + head;
                u32x4 o; o.x = pk2(run[0], run[1]); o.y = pk2(run[2], run[3]); o.z = pk2(run[4], run[5]); o.w = pk2(run[6], run[7]); *(u32x4*)(CARR + sidx * 8192 + e8 * 8) = o;
                const float dq = __expf(dec[q]);
#pragma unroll
                for (int i = 0; i < 4; ++i) { run[2 * i] = run[2 * i] * dq + bflo(loc[q][i]); run[2 * i + 1] = run[2 * i + 1] * dq + bfhi(loc[q][i]); } }
        }
    }
}
__device__ __forceinline__ void ssd_s3_unit(LAS unsigned char* lds, int unit, const bf16_t* P0, const float* cw, const float* cb, const float* dt_bias, const float* a_log, const float* dskip, const float* norm_w,
                                            const bf16_t* STATES, bf16_t* OMIX) {
    const int tid = threadIdx.x, lane = tid & 63, w = tid >> 6, fr = lane & 15, fq = lane >> 4;
    const int g = unit & 1, c = (unit >> 1) & 31, b = unit >> 6, t0 = c * 128;
    LAS bf16_t* CS = (LAS bf16_t*)lds; LAS bf16_t* BS = (LAS bf16_t*)(lds + 34816); LAS bf16_t* XT = (LAS bf16_t*)(lds + 69632);
    LAS float* dtS = (LAS float*)(lds + 139264); LAS float* cumS = (LAS float*)(lds + 143360); LAS float* totS = (LAS float*)(lds + 147456);
    const bf16_t* Pb = P0 + (size_t)b * SEQ * ABPAD;
    __syncthreads();
    ssd_conv8<4, false>(BS, (tid & 15) * 8, 512 + g * 128 + (tid & 15) * 8, (tid >> 4) * 4, Pb, t0, cw, cb);
    ssd_conv8<4, false>(CS, (tid & 15) * 8, 768 + g * 128 + (tid & 15) * 8, (tid >> 4) * 4, Pb, t0, cw, cb);
    ssd_conv8<8, true>(XT, (tid & 31) * 8, g * 256 + (tid & 31) * 8, (tid >> 5) * 8, Pb, t0, cw, cb);
    ssd_dt_cum(dtS, cumS, totS, Pb + (size_t)t0 * ABPAD, g, w, lane, dt_bias, a_log);
    __syncthreads();
    const int l = 16 * w + fr;
    f32x4 sc[8];
#pragma unroll
    for (int nt = 0; nt < 8; ++nt) sc[nt] = (f32x4){0.f, 0.f, 0.f, 0.f};
#pragma unroll
    for (int ks = 0; ks < 4; ++ks) { const bf16x8 afr = ldsfrag(CS, SLD, 16 * w, ks * 32, fr, fq);
#pragma unroll
        for (int nt = 0; nt < 8; ++nt) sc[nt] = mfma16(ldsfrag(BS, SLD, nt * 16, ks * 32, fr, fq), afr, sc[nt]); }
    __syncthreads();
    LAS bf16_t* Mw = BS + w * 16 * SLD;
    const size_t row = (size_t)b * SEQ + t0 + l; float ss = 0.f;
#pragma unroll 1
    for (int j = 0; j < 4; ++j) {
        const LAS float* cf = cumS + (j * 2) * 128; const LAS float* cbw = cumS + (j * 2 + 1) * 128; const LAS float* df = dtS + (j * 2) * 128; const LAS float* db = dtS + (j * 2 + 1) * 128;
        const float cfl = cf[l], cbl = cbw[l];
        const size_t sbase = ((size_t)(b * 32 + c) * 2) * 8 + g * 4 + j;
        const bf16_t* carf = STATES + sbase * 8192; const bf16_t* carb = STATES + (sbase + 8) * 8192;
        bf16x8 cF[4][4], cB[4][4]; u32x2 zz4[4];
#pragma unroll
        for (int ks = 0; ks < 4; ++ks)
#pragma unroll
            for (int pt = 0; pt < 4; ++pt) cF[ks][pt] = *(const bf16x8*)(carf + (pt * 16 + fr) * 128 + ks * 32 + fq * 8);
#pragma unroll
        for (int pt = 0; pt < 4; ++pt) zz4[pt] = *(const u32x2*)(P0 + row * ABPAD + 1792 + g * 256 + j * 64 + pt * 16 + fq * 4);
#pragma unroll
        for (int nt = 0; nt < 8; ++nt) { float mv[4];
#pragma unroll
            for (int i = 0; i < 4; ++i) { const int s = nt * 16 + fq * 4 + i;
                const float ff = (s <= l) ? __expf(cfl - cf[s]) * df[s] : 0.f; const float fb = (s >= l) ? __expf(cbl - cbw[s]) * db[s] : 0.f;
                mv[i] = sc[nt][i] * (ff + fb); }
            u32x2 o; o.x = pk2(mv[0], mv[1]); o.y = pk2(mv[2], mv[3]); *(LAS u32x2*)(Mw + fr * SLD + nt * 16 + fq * 4) = o; }
        LDS_WAIT();
#pragma unroll
        for (int ks = 0; ks < 4; ++ks)
#pragma unroll
            for (int pt = 0; pt < 4; ++pt) cB[ks][pt] = *(const bf16x8*)(carb + (pt * 16 + fr) * 128 + ks * 32 + fq * 8);
        f32x4 yd[4], yf[4], yb[4];
#pragma unroll
        for (int pt = 0; pt < 4; ++pt) { yd[pt] = (f32x4){0.f, 0.f, 0.f, 0.f}; yf[pt] = yd[pt]; yb[pt] = yd[pt]; }
        bf16x8 acs[4];
#pragma unroll
        for (int ks = 0; ks < 4; ++ks) {
            const bf16x8 am = *(const LAS bf16x8*)(Mw + fr * SLD + ks * 32 + fq * 8); acs[ks] = ldsfrag(CS, SLD, 16 * w, ks * 32, fr, fq);
#pragma unroll
            for (int pt = 0; pt < 4; ++pt) {
                yd[pt] = mfma16(ldsfrag(XT, SLD, j * 64 + pt * 16, ks * 32, fr, fq), am, yd[pt]);
                yf[pt] = mfma16(cF[ks][pt], acs[ks], yf[pt]); }
        }
#pragma unroll
        for (int ks = 0; ks < 4; ++ks)
#pragma unroll
            for (int pt = 0; pt < 4; ++pt) yb[pt] = mfma16(cB[ks][pt], acs[ks], yb[pt]);
        const float ef = __expf(cfl), eb = __expf(cbl), dsk = dskip[g * 4 + j];
#pragma unroll
        for (int pt = 0; pt < 4; ++pt) { const f32x4 yv = yd[pt] + yf[pt] * ef + yb[pt] * eb;
            const int col = j * 64 + pt * 16 + fq * 4; const u32x2 zz = zz4[pt];
            const float z4[4] = {bflo(zz.x), bfhi(zz.x), bflo(zz.y), bfhi(zz.y)}; float v4[4];
#pragma unroll
            for (int i = 0; i < 4; ++i) { const float xs = bf2f(XT[(col + i) * SLD + l]); float v = yv[i] + dsk * xs; const float z = z4[i]; v = v * siluf_(z);
                v4[i] = v; ss += v * v; }
            u32x2 o; o.x = pk2(v4[0], v4[1]); o.y = pk2(v4[2], v4[3]); *(u32x2*)(OMIX + row * D + 512 + g * 256 + col) = o; }
        asm volatile("" ::: "memory");
    }
    ss += __shfl_xor(ss, 16); ss += __shfl_xor(ss, 32);
    const float rs = rsqrtf(ss * (1.f / 256.f) + 1e-6f);
    asm volatile("s_waitcnt vmcnt(0)" ::: "memory");
#pragma unroll 4
    for (int q = 0; q < 16; ++q) { const int col = g * 256 + q * 16 + fq * 4; const f32x4 nw = *(const f32x4*)(norm_w + col);
        u32x2* p = (u32x2*)(OMIX + row * D + 512 + col); const u32x2 v = *p;
        u32x2 o; o.x = pk2(bflo(v.x) * rs * nw[0], bfhi(v.x) * rs * nw[1]); o.y = pk2(bflo(v.y) * rs * nw[2], bfhi(v.y) * rs * nw[3]); *p = o; }
}

constexpr int HLD = 136, HLS = 72;
__device__ __forceinline__ void hgrn_chain(LAS unsigned char* lds, int cid, bf16_t* P1, const float* hg_lb, bf16_t* Ob, int ldo, int ocbase, int ocdir) {
    const int tid = threadIdx.x, lane = tid & 63, w = tid >> 6, fr = lane & 15, fq = lane >> 4;
    const int b = cid >> 4, h = (cid >> 1) & 7, dir = cid & 1;
    LAS bf16_t* QE = (LAS bf16_t*)lds;
    LAS bf16_t* KE = (LAS bf16_t*)(lds + 17408);
    LAS bf16_t* KLT = (LAS bf16_t*)(lds + 34816);
    LAS bf16_t* VT = (LAS bf16_t*)(lds + 53248);
    LAS bf16_t* AT = (LAS bf16_t*)(lds + 71680);
    LAS bf16_t* ST = (LAS bf16_t*)(lds + 80896);
    LAS float* totS = (LAS float*)(lds + 115712);
    LAS float* lastS = (LAS float*)(lds + 117760);
    __syncthreads();
    for (int e = tid; e < 128 * HLD / 2; e += 512) ((LAS unsigned*)ST)[e] = 0u;
    const int dcol = tid & 127, qtr = tid >> 7, i0 = qtr * 16;
    const float lbv = frcp(1.0f + __expf(hg_lb[h * 128 + dcol] - hg_lb[1024 + h * 128 + dcol]));
    f32x4 st[8];
#pragma unroll
    for (int i = 0; i < 8; ++i) st[i] = (f32x4){0.f, 0.f, 0.f, 0.f};
    bf16_t* Pb = P1 + (size_t)b * SEQ * HGP;
    __syncthreads();
    unsigned short rq[16], rf[16], rv[16];
#define HG_ISSUE(t0n) do { _Pragma("unroll") for (int i = 0; i < 16; ++i) { const int tk = (t0n) + (dir ? 63 - (i0 + i) : (i0 + i)); const bf16_t* pr = Pb + (size_t)tk * HGP + h * 128 + dcol; \
        rq[i] = pr[0]; rf[i] = pr[1024 * (1 + dir)]; rv[i] = pr[3072]; } } while (0)
    HG_ISSUE((dir ? 63 : 0) * 64);
    for (int cc = 0; cc < 64; ++cc) {
        const int t0 = (dir ? 63 - cc : cc) * 64;
        float gq[16], gk[16], gc[16]; float run = 0.f;
#pragma unroll
        for (int i = 0; i < 16; ++i) { const float q = bf2f(rq[i]), fr_ = bf2f(rf[i]);
            const float f = lbv + (1.0f - lbv) * sigmoidf_(fr_); run += __logf(f); gq[i] = q; gk[i] = 1.0f - f; gc[i] = run; }
        totS[qtr * 128 + dcol] = run;
#pragma unroll
        for (int i = 0; i < 16; i += 2) *(LAS unsigned*)(VT + dcol * HLS + i0 + i) = (unsigned)rv[i] | ((unsigned)rv[i + 1] << 16);
        __syncthreads();
        { float pre = 0.f, tot = 0.f;
#pragma unroll
          for (int q4 = 0; q4 < 4; ++q4) { const float tq = totS[q4 * 128 + dcol]; if (q4 < qtr) pre += tq; tot += tq; }
          const float etot = __expf(tot);
          if (qtr == 0) lastS[dcol] = etot;
#pragma unroll
          for (int i = 0; i < 16; i += 2) { const float b0 = pre + gc[i], b1 = pre + gc[i + 1];
              const float e0 = __expf(b0), e1 = __expf(b1), n0 = frcp(e0), n1 = frcp(e1), l0 = etot * n0, l1 = etot * n1;
              QE[(i0 + i) * HLD + dcol] = (bf16_t)f2bf(gq[i] * e0); QE[(i0 + i + 1) * HLD + dcol] = (bf16_t)f2bf(gq[i + 1] * e1);
              KE[(i0 + i) * HLD + dcol] = (bf16_t)f2bf(gk[i] * n0); KE[(i0 + i + 1) * HLD + dcol] = (bf16_t)f2bf(gk[i + 1] * n1);
              *(LAS unsigned*)(KLT + dcol * HLS + i0 + i) = pk2(gk[i] * l0, gk[i + 1] * l1); } }
        if (cc + 1 < 64) HG_ISSUE((dir ? 62 - cc : cc + 1) * 64);
        __syncthreads();
        { const int mt = w >> 1;
#pragma unroll
          for (int n2 = 0; n2 < 2; ++n2) { const int nt = (w & 1) * 2 + n2; f32x4 acc = (f32x4){0.f, 0.f, 0.f, 0.f};
#pragma unroll
              for (int ks = 0; ks < 4; ++ks) acc = mfma16(ldsfrag(KE, HLD, nt * 16, ks * 32, fr, fq), ldsfrag(QE, HLD, mt * 16, ks * 32, fr, fq), acc);
              const int lrow = mt * 16 + fr; float mv[4];
#pragma unroll
              for (int i = 0; i < 4; ++i) { const int s = nt * 16 + fq * 4 + i; mv[i] = (s <= lrow) ? acc[i] : 0.f; }
              u32x2 o; o.x = pk2(mv[0], mv[1]); o.y = pk2(mv[2], mv[3]); *(LAS u32x2*)(AT + lrow * HLS + nt * 16 + fq * 4) = o; } }
        __syncthreads();
        { const int mt = w >> 1;
#pragma unroll
          for (int n4 = 0; n4 < 4; ++n4) { const int nt = (w & 1) * 4 + n4; f32x4 acc = (f32x4){0.f, 0.f, 0.f, 0.f};
#pragma unroll
              for (int ks = 0; ks < 2; ++ks) acc = mfma16(ldsfrag(VT, HLS, nt * 16, ks * 32, fr, fq), ldsfrag(AT, HLS, mt * 16, ks * 32, fr, fq), acc);
#pragma unroll
              for (int ks = 0; ks < 4; ++ks) acc = mfma16(ldsfrag(ST, HLD, nt * 16, ks * 32, fr, fq), ldsfrag(QE, HLD, mt * 16, ks * 32, fr, fq), acc);
              const int i = mt * 16 + fr, tk = t0 + (dir ? 63 - i : i);
              u32x2 o; o.x = pk2(acc[0], acc[1]); o.y = pk2(acc[2], acc[3]);
              *(u32x2*)(Ob + ((size_t)b * SEQ + tk) * ldo + ocbase + ocdir * dir + h * 128 + nt * 16 + fq * 4) = o; } }
#pragma unroll
        for (int nt = 0; nt < 8; ++nt) { const f32x4 el = *(const LAS f32x4*)(lastS + nt * 16 + fq * 4); st[nt] = st[nt] * el;
#pragma unroll
            for (int ks = 0; ks < 2; ++ks) st[nt] = mfma16(ldsfrag(KLT, HLS, nt * 16, ks * 32, fr, fq), ldsfrag(VT, HLS, w * 16, ks * 32, fr, fq), st[nt]); }
        __syncthreads();
#pragma unroll
        for (int nt = 0; nt < 8; ++nt) { u32x2 o; o.x = pk2(st[nt][0], st[nt][1]); o.y = pk2(st[nt][2], st[nt][3]); *(LAS u32x2*)(ST + (w * 16 + fr) * HLD + nt * 16 + fq * 4) = o; }
    }
    __syncthreads();
}
__device__ __forceinline__ void hgrn_combine(const bf16_t* P1, const float* norm_w, bf16_t* OMIX, int gw, int NGW, int lane) {
    const int c0 = lane * 16;
#pragma unroll 2
    for (int tk = gw; tk < T; tk += NGW) {
        const bf16_t* pr = P1 + (size_t)tk * HGP + c0; float o[16]; float ss = 0.f;
#pragma unroll
        for (int hh = 0; hh < 2; ++hh) { const u32x4 uf = *(const u32x4*)(pr + 1024 + hh * 8), ub = *(const u32x4*)(pr + 2048 + hh * 8);
#pragma unroll
            for (int i = 0; i < 4; ++i) { o[hh * 8 + 2 * i] = bflo(uf[i]) + bflo(ub[i]); o[hh * 8 + 2 * i + 1] = bfhi(uf[i]) + bfhi(ub[i]); } }
#pragma unroll
        for (int i = 0; i < 16; ++i) ss += o[i] * o[i];
        const float rs = rsqrtf(sum8(ss) * (1.f / 128.f) + 1e-6f);
#pragma unroll
        for (int hh = 0; hh < 2; ++hh) { const u32x4 ug = *(const u32x4*)(pr + 4096 + hh * 8); float r[8];
#pragma unroll
            for (int i = 0; i < 4; ++i) { const float g0 = bflo(ug[i]), g1 = bfhi(ug[i]);
                r[2 * i] = o[hh * 8 + 2 * i] * rs * norm_w[c0 + hh * 8 + 2 * i] * siluf_(g0);
                r[2 * i + 1] = o[hh * 8 + 2 * i + 1] * rs * norm_w[c0 + hh * 8 + 2 * i + 1] * siluf_(g1); }
            u32x4 wv; wv.x = pk2(r[0], r[1]); wv.y = pk2(r[2], r[3]); wv.z = pk2(r[4], r[5]); wv.w = pk2(r[6], r[7]);
            *(u32x4*)(OMIX + (size_t)tk * D + c0 + hh * 8) = wv; }
    }
}

#define XB_TMO      128
#define XB_XCNT(j)  (256  + 64 * (j))
#define XB_XSUB(j)  (1280 + 64 * (j))
#define XB_XGEN(j)  (2304 + 64 * (j))
#define XB_TOP      3328
#define XB_TOPGEN   3392
#define XCD_BAR_WORDS 3456
#define XB_SPIN_CAP (1u << 18)

__device__ __forceinline__ unsigned xb_ld(unsigned* p)              { return __hip_atomic_load(p, __ATOMIC_RELAXED, __HIP_MEMORY_SCOPE_AGENT); }
__device__ __forceinline__ unsigned xb_add(unsigned* p, unsigned v) { return __hip_atomic_fetch_add(p, v, __ATOMIC_RELAXED, __HIP_MEMORY_SCOPE_AGENT); }
__device__ __forceinline__ unsigned xb_xcc_id() { return (unsigned)__builtin_amdgcn_s_getreg((3 << 11) | 20) & 0xFu; }
#define XB_SPIN(cond, bar) do { unsigned _sp = 0; while (cond) { __builtin_amdgcn_s_sleep(1); \
    if ((++_sp & 255u) == 0u) { if (xb_ld(&(bar)[XB_TMO])) break; if (_sp > XB_SPIN_CAP) { atomicAdd(&(bar)[XB_TMO], 1u); break; } } } } while (0)

struct XcdBarrier {
    unsigned* bar; unsigned x;
    volatile LAS unsigned* st;
};

__device__ __forceinline__ XcdBarrier xcd_barrier_post(unsigned* bar, volatile LAS unsigned* st) {
    XcdBarrier b; b.bar = bar; b.x = xb_xcc_id(); b.st = st;
    if (threadIdx.x == 0) (void)xb_add(&bar[XB_XCNT(b.x)], 1u);
    return b;
}
__device__ __forceinline__ void xcd_barrier_complete(unsigned* bar, unsigned x, unsigned& nloc, unsigned& nx) {
    const unsigned G = gridDim.x * gridDim.y * gridDim.z;
    unsigned sum, cnt, mine, sp = 0u;
    for (;;) {
        sum = 0u; cnt = 0u; mine = 0u;
#pragma unroll
        for (unsigned j = 0; j < 16; ++j) { const unsigned c = xb_ld(&bar[XB_XCNT(j)]); sum += c; cnt += (c > 0u) ? 1u : 0u; mine = (j == x) ? c : mine; }
        if (sum == G) break;
        __builtin_amdgcn_s_sleep(1);
        if ((++sp & 255u) == 0u) { if (xb_ld(&bar[XB_TMO])) break; if (sp > XB_SPIN_CAP) { atomicAdd(&bar[XB_TMO], 1u); break; } }
    }
    nloc = mine > 0u ? mine : 1u; nx = cnt > 0u ? cnt : 1u;
}

__device__ __forceinline__ void xcd_barrier(const XcdBarrier& b) {
    asm volatile("s_waitcnt vmcnt(0)" ::: "memory");
    __syncthreads();
    if (threadIdx.x == 0) {
        unsigned* bar = b.bar;
        __builtin_amdgcn_s_waitcnt(0);
        unsigned nloc = b.st[0], nx = b.st[1];
        if (nloc == 0u) { xcd_barrier_complete(bar, b.x, nloc, nx); b.st[0] = nloc; b.st[1] = nx; }
        const unsigned old = xb_add(&bar[XB_XSUB(b.x)], 1u);
        const unsigned gen = old / nloc;
        if (old + 1u == (gen + 1u) * nloc) {
            __builtin_amdgcn_fence(__ATOMIC_RELEASE, "agent");
            asm volatile("s_waitcnt vmcnt(0)" ::: "memory");
            const unsigned og = xb_add(&bar[XB_TOP], 1u);
            const unsigned tg = og / nx;
            if (og + 1u == (tg + 1u) * nx) xb_add(&bar[XB_TOPGEN], 1u);
            else XB_SPIN(xb_ld(&bar[XB_TOPGEN]) == tg, bar);
            __builtin_amdgcn_fence(__ATOMIC_ACQUIRE, "agent");
            xb_add(&bar[XB_XGEN(b.x)], 1u);
            asm volatile("s_waitcnt vmcnt(0)" ::: "memory");
        } else {
            XB_SPIN(xb_ld(&bar[XB_XGEN(b.x)]) == gen, bar);
            __builtin_amdgcn_fence(__ATOMIC_ACQUIRE, "agent");
            asm volatile("s_waitcnt vmcnt(0)" ::: "memory");
        }
    }
    __syncthreads();
}


struct Args { const float* in[35]; float* out; unsigned char* ws; int ph_lo, ph_hi; };
static_assert(sizeof(Args) == 304, "Args layout");

__global__ void __launch_bounds__(512, 2) mk_fwd(Args args) {
    extern __shared__ __attribute__((aligned(16))) unsigned char lds_raw[];
    LAS unsigned char* lds = (LAS unsigned char*)lds_raw; LAS unsigned char* xl = lds + XLDS_OFF;
    const int G = gridDim.x, bx = blockIdx.x, NGW = G * 8;
#define LOCAL_IDS int tid = threadIdx.x; asm volatile("" : "+v"(tid)); const int lane = tid & 63, wave = __builtin_amdgcn_readfirstlane(tid >> 6), gw = bx * 8 + wave; (void)lane; (void)gw;
    typedef const __attribute__((address_space(4))) unsigned char* kaptr_t;
    kaptr_t ka = (kaptr_t)__builtin_amdgcn_kernarg_segment_ptr();
#define INP(k) (*(const float* const volatile __attribute__((address_space(4)))*)(ka + 8 * (k)))
    unsigned char* ws = *(unsigned char* const volatile __attribute__((address_space(4)))*)(ka + 288); float* out = *(float* const volatile __attribute__((address_space(4)))*)(ka + 280);
    const float* x = INP(0);
    bf16_t* WAB = (bf16_t*)(ws + WS_WAB); bf16_t* WABO = (bf16_t*)(ws + WS_WABO); bf16_t* WHG = (bf16_t*)(ws + WS_WHG); bf16_t* WHGO = (bf16_t*)(ws + WS_WHGO);
    bf16_t* WQ = (bf16_t*)(ws + WS_WQ); bf16_t* WKV = (bf16_t*)(ws + WS_WKV); bf16_t* WO = (bf16_t*)(ws + WS_WO); bf16_t* WF1 = (bf16_t*)(ws + WS_WF1); bf16_t* WF2 = (bf16_t*)(ws + WS_WF2);
    bf16_t* G2T = (bf16_t*)(ws + WS_G2T); bf16_t* MEMN = (bf16_t*)(ws + WS_MEMN); bf16_t* KMEM = (bf16_t*)(ws + WS_KMEM); bf16_t* VT = (bf16_t*)(ws + WS_VT);
    bf16_t* H = (bf16_t*)(ws + WS_H); bf16_t* P = (bf16_t*)(ws + WS_P); bf16_t* PATT = (bf16_t*)(ws + WS_PATT); bf16_t* OMIX0 = (bf16_t*)(ws + WS_OMIX0); bf16_t* OMIX1 = (bf16_t*)(ws + WS_OMIX1); float* PSB = (float*)(ws + WS_PS);
#define COMMA ,
    bf16_t* STATES = (bf16_t*)((unsigned char*)out + DO_STATES); bf16_t* GG = (bf16_t*)((unsigned char*)out + DO_G); bf16_t* SG = (bf16_t*)((unsigned char*)out + DO_SG);
    float* BONUS = (float*)((unsigned char*)out + DO_BONUS); float* TOT = (float*)((unsigned char*)out + DO_TOT);
    cg::grid_group grid = cg::this_grid();
    { volatile LAS unsigned* st_ = (volatile LAS unsigned*)(lds + LDS_BYTES - 16); if (threadIdx.x < 4) st_[threadIdx.x] = 0u; }
    __syncthreads();
    const XcdBarrier xbar = xcd_barrier_post((unsigned*)ws, (volatile LAS unsigned*)(lds + LDS_BYTES - 16));
    const int lo = *(const int volatile __attribute__((address_space(4)))*)(ka + 296), hi = *(const int volatile __attribute__((address_space(4)))*)(ka + 300);
#ifndef PH_EN
#define PH_EN(k) 1
#endif
#define IN(k) (PH_EN(k) && lo <= (k) && (k) < hi)
#ifndef DUP_MASK
#define DUP_MASK 0ull
#endif
#define REPS(k) (1 + (int)(((unsigned long long)(DUP_MASK) >> (k)) & 1ull))
#define PHASE(k) for (int rep_ = 0; rep_ < (IN(k) ? REPS(k) : 0); ++rep_, ((REPS(k) > 1) ? (grid.sync(), 0) : 0))
#define SEAM(k) do { if (IN(k) && IN((k) + 1)) xcd_barrier(xbar); } while (0)
    if (lo < 0) grid.sync();
#define RUN_GEMM(EPI, ALIGN, gd, ep) do { pg8::Order S_; S_.init(gd, G, bx); pg8::gemm_phase<EPI, ALIGN>(lds, xl, gd, S_, ep); } while (0)

    PHASE(0) { LOCAL_IDS
        LAS float* scr = (LAS float*)(lds + wave * 16384);
        constexpr int I_AB = 16 * 112, I_SQ = 16 * 32, I_HG = 16 * 160, I_KV = 16 * 64, I_F1 = 16 * 176, I_F2 = 44 * 32, I_G2 = 2 * 16;
        constexpr int NIT = I_AB + I_SQ + I_HG + I_SQ + 2 * I_SQ + 2 * I_KV + 2 * I_SQ + 2 * I_F1 + 2 * I_F2 + I_G2;
        for (int it = gw; it < NIT; it += NGW) {
            int r = it;
            if (r < I_AB) { transpose_item<0>(INP(3), 1024, ABP, WAB, scr, r, 112, lane); continue; } r -= I_AB;
            if (r < I_SQ) { transpose_item<0>(INP(4), 1024, 1024, WABO, scr, r, 32, lane); continue; } r -= I_SQ;
            if (r < I_HG) { transpose_item<0>(INP(22), 1024, HGP, WHG, scr, r, 160, lane, INP(2) + D); continue; } r -= I_HG;
            if (r < I_SQ) { transpose_item<0>(INP(23), 1024, 1024, WHGO, scr, r, 32, lane); continue; } r -= I_SQ;
            if (r < 2 * I_SQ) { const int l = r / I_SQ; transpose_item<0>(INP(28) + (size_t)l * D * D, 1024, 1024, WQ + (size_t)l * D * D, scr, r % I_SQ, 32, lane, INP(26) + l * D); continue; } r -= 2 * I_SQ;
            if (r < 2 * I_KV) { const int l = r / I_KV; transpose_item<0>(INP(29) + (size_t)l * D * 2048, 1024, 2048, WKV + (size_t)l * D * 2048, scr, r % I_KV, 64, lane); continue; } r -= 2 * I_KV;
            if (r < 2 * I_SQ) { const int l = r / I_SQ; transpose_item<0>(INP(30) + (size_t)l * D * D, 1024, 1024, WO + (size_t)l * D * D, scr, r % I_SQ, 32, lane); continue; } r -= 2 * I_SQ;
            if (r < 2 * I_F1) { const int l = r / I_F1; transpose_item<1>(INP(32) + (size_t)l * D * 2 * FFN, 1024, 2 * FFN, WF1 + (size_t)l * D * 2 * FFN, scr, r % I_F1, 176, lane, INP(31) + l * D); continue; } r -= 2 * I_F1;
            if (r < 2 * I_F2) { const int l = r / I_F2; transpose_item<0>(INP(33) + (size_t)l * FFN * D, FFN, 1024, WF2 + (size_t)l * FFN * D, scr, r % I_F2, 32, lane); continue; } r -= 2 * I_F2;
            transpose_item<0>(INP(10), 128, 512, G2T, scr, r, 16, lane);
        }
        rms_rows_phase(x, INP(2), H, T, gw, NGW, lane);
        for (int m = gw; m < 2 * 4096; m += NGW) { const int l = m >> 12, r = m & 4095; rms_row_bf16(INP(1) + (size_t)r * D, INP(27) + l * D, MEMN + (size_t)m * D, lane); }
        __syncthreads();
    }
    SEAM(0);
    PHASE(1) {
        { pg8::Gemm g = pg8::make_gemm(H, WAB, T, ABPAD, 1024, 1024, 1024); pg8::EpiBf16 E{P, ABPAD, 1.0f, nullptr}; RUN_GEMM(pg8::EpiBf16, true, g, E); }
        { pg8::Gemm g = pg8::make_gemm(MEMN, WKV, 4096, 1024, 1024, 1024, 1024); g.nZ = 2; g.sAo = 4096L * D; g.sBo = 2048L * D; g.sCo = 4096L * D; pg8::EpiBf16 E{KMEM, 1024, 1.0f, nullptr}; RUN_GEMM(pg8::EpiBf16, true, g, E); }
        { pg8::Gemm g = pg8::make_gemm(WKV + (size_t)1024 * D, MEMN, 1024, 4096, 1024, 1024, 1024); g.nZ = 2; g.sAo = 2048L * D; g.sBo = 4096L * D; g.sCo = 4096L * D; pg8::EpiBf16 E{VT, 4096, 1.0f, nullptr}; RUN_GEMM(pg8::EpiBf16, true, g, E); }
    }
    SEAM(1);
    PHASE(2) {
#ifndef DUP_RWKV
#define DUP_RWKV 0
#endif
#ifndef DUP_S1
#define DUP_S1 0
#endif
        for (int r2 = 0; r2 <= DUP_RWKV; ++r2)
        for (int cid = bx; cid < 256; cid += G)
            rwkv_chain(lds, cid, P, INP(5), INP(6), INP(7), INP(8), INP(9), INP(11), INP(12), INP(13), H, SG, BONUS);
        for (int r2 = 0; r2 <= DUP_S1; ++r2)
        for (int u = bx; u < 1024; u += G) ssd_s1_unit(lds, u, P, INP(16), INP(17), INP(18), INP(19), STATES, TOT);
        __syncthreads();
    }
    SEAM(2);
    PHASE(3) {
        { int k128 = 128; asm volatile("" : "+s"(k128)); pg8::Gemm g = pg8::make_gemm(SG, G2T, T, 512, k128, 128, 128); pg8::EpiBf16 E{GG, 512, 1.0f, nullptr}; RUN_GEMM(pg8::EpiBf16, true, g, E); }
        { LOCAL_IDS ssd_s2(STATES, OMIX1, TOT, bx * 512 + tid, G * 512); }
    }
    SEAM(3);
    PHASE(4) {
#ifndef DUP_S3
#define DUP_S3 0
#endif
        for (int r2 = 0; r2 <= DUP_S3; ++r2)
        for (int u = bx; u < 1024; u += G) ssd_s3_unit(lds, u, P, INP(16), INP(17), INP(18), INP(19), INP(20), INP(21), OMIX1, OMIX0);
        __syncthreads();
        { LOCAL_IDS rwkv_combine(P, H, BONUS, GG, INP(5), INP(14), INP(15), OMIX0, gw, NGW, lane); }
    }
    SEAM(4);
    PHASE(5) { pg8::Gemm g = pg8::make_gemm(OMIX0, WABO, T, 1024, 1024, 1024, 1024); pg8::EpiResidB E{x, H, PSB, 1024}; RUN_GEMM(pg8::EpiResidB, true, g, E); }
    SEAM(5);

#define ATTN_FFN(base, L, LASTEPI) \
    PHASE(base) { pg8::Gemm g = pg8::make_gemm(H, WQ + (size_t)(L) * D * D, T, 1024, 1024, 1024, 1024); pg8::EpiBf16PS E{P, 1024, 0.0625f, PSB}; RUN_GEMM(pg8::EpiBf16PS, true, g, E); } \
    SEAM(base); \
    PHASE(base + 1) { pg8::Gemm g = pg8::make_gemm(P, KMEM + (size_t)(L) * 4096 * D, SEQ, 256, 256, 1024, 1024); g.nZ = 64; g.zdiv = 4; \
        g.sAo = (long)SEQ * D; g.sAi = 256; g.sBo = 256L * D; g.sBi = 256; g.sCo = (long)SEQ * D; g.sCi = 256; pg8::EpiSoftmax E{PATT, 1024}; RUN_GEMM(pg8::EpiSoftmax, true, g, E); } \
    SEAM(base + 1); \
    PHASE(base + 2) { pg8::Gemm g = pg8::make_gemm(PATT, VT + (size_t)(L) * 4096 * D, SEQ, 256, 256, 1024, 4096); g.nZ = 64; g.zdiv = 4; \
        g.sAo = (long)SEQ * D; g.sAi = 256; g.sBo = 256; g.sBi = 256L * 4096; g.sCo = (long)SEQ * D; g.sCi = 256; pg8::EpiBf16 E{P, 1024, 1.0f, nullptr}; RUN_GEMM(pg8::EpiBf16, true, g, E); } \
    SEAM(base + 2); \
    PHASE(base + 3) { pg8::Gemm g = pg8::make_gemm(P, WO + (size_t)(L) * D * D, T, 1024, 1024, 1024, 1024); pg8::EpiResidB E{nullptr, H, PSB, 1024}; RUN_GEMM(pg8::EpiResidB, true, g, E); } \
    SEAM(base + 3); \
    PHASE(base + 4) { pg8::Gemm g = pg8::make_gemm(H, WF1 + (size_t)(L) * D * 2 * FFN, T, 2 * FFN, 1024, 1024, 1024); pg8::EpiSwiglu E{P, FFN, PSB}; RUN_GEMM(pg8::EpiSwiglu, true, g, E); } \
    SEAM(base + 4); \
    PHASE(base + 5) { pg8::Gemm g = pg8::make_gemm(P, WF2 + (size_t)(L) * FFN * D, T, 1024, FFN, FFN, FFN); LASTEPI } \
    SEAM(base + 5);

    ATTN_FFN(6, 0, pg8::EpiResidB E{nullptr COMMA H COMMA PSB COMMA 1024}; RUN_GEMM(pg8::EpiResidB, true, g, E);)

    PHASE(12) { pg8::Gemm g = pg8::make_gemm(H, WHG, T, HGP, 1024, 1024, 1024); pg8::EpiBf16PS E{P, HGP, 1.0f, PSB}; RUN_GEMM(pg8::EpiBf16PS, true, g, E); }
    SEAM(12);
    PHASE(13) {
#ifdef DUP_HGRN
        for (int cid = bx; cid < 256; cid += G) hgrn_chain(lds, cid, P, INP(25), OMIX1, 1024, 0, 0);
        grid.sync();
#endif
        for (int cid = bx; cid < 256; cid += G) hgrn_chain(lds, cid, P, INP(25), P, HGP, 1024, 1024); }
    SEAM(13);
    PHASE(14) { LOCAL_IDS hgrn_combine(P, INP(24), OMIX1, gw, NGW, lane); }
    SEAM(14);
    PHASE(15) { pg8::Gemm g = pg8::make_gemm(OMIX1, WHGO, T, 1024, 1024, 1024, 1024); pg8::EpiResidB E{nullptr, H, PSB, 1024}; RUN_GEMM(pg8::EpiResidB, true, g, E); }
    SEAM(15);

    ATTN_FFN(16, 1, pg8::EpiResidB E{nullptr COMMA H COMMA PSB COMMA 1024}; RUN_GEMM(pg8::EpiResidB, true, g, E);)

    PHASE(22) { LOCAL_IDS
        const float* fg = INP(34);
#pragma unroll 2
        for (int m = gw; m < T; m += NGW) {
            const f32x4 pa = *(const f32x4*)(PSB + (size_t)m * 16 + (lane & 3) * 4); float sq = (pa[0] + pa[1]) + (pa[2] + pa[3]); sq += __shfl_xor(sq, 1); sq += __shfl_xor(sq, 2);
            const float rs = rsqrtf(sq * (1.f / D) + 1e-6f);
            const bf16_t* hr = H + (size_t)m * D; float* orow = out + (size_t)m * D;
#pragma unroll
            for (int j = 0; j < 2; ++j) { const int c = (lane + 64 * j) * 8; const u32x4 hv = *(const u32x4*)(hr + c); const f32x4 g0 = *(const f32x4*)(fg + c), g1 = *(const f32x4*)(fg + c + 4);
                *(f32x4*)(orow + c) = (f32x4){bflo(hv.x) * rs * g0[0], bfhi(hv.x) * rs * g0[1], bflo(hv.y) * rs * g0[2], bfhi(hv.y) * rs * g0[3]};
                *(f32x4*)(orow + c + 4) = (f32x4){bflo(hv.z) * rs * g1[0], bfhi(hv.z) * rs * g1[1], bflo(hv.w) * rs * g1[2], bfhi(hv.w) * rs * g1[3]}; } }
    }
#undef IN
#undef SEAM
#undef RUN_GEMM
}

extern "C" void kernel_launch(void* const* d_in, const int* in_sizes, int n_in, void* d_out, int out_size, void* d_ws, size_t ws_size, hipStream_t stream) {
    static int grid = 0;
    if (grid == 0) {
        if (n_in != 35 || out_size != T * D || ws_size < WS_END) { fprintf(stderr, "kernel_launch: unexpected shapes (n_in %d out %d ws %zu)\n", n_in, out_size, ws_size); grid = -1; return; }
        int dev = 0, cus = 0, per_cu = 0;
        hipGetDevice(&dev); hipDeviceGetAttribute(&cus, hipDeviceAttributeMultiprocessorCount, dev);
        hipFuncSetAttribute((const void*)mk_fwd, hipFuncAttributeMaxDynamicSharedMemorySize, LDS_BYTES);
        hipOccupancyMaxActiveBlocksPerMultiprocessor(&per_cu, (const void*)mk_fwd, 512, LDS_BYTES);
        if (per_cu < 1) { fprintf(stderr, "kernel_launch: occupancy query says %d blocks per CU\n", per_cu); per_cu = 1; }
        (void)hipGetLastError();
        grid = cus * 1;
    }
    if (grid < 0) return;
    if (hipMemsetAsync(d_ws, 0, 65536, stream) != hipSuccess) { fprintf(stderr, "kernel_launch: memset of the barrier words failed\n"); return; }
    Args a{};
    for (int i = 0; i < 35; ++i) a.in[i] = (const float*)d_in[i];
    a.out = (float*)d_out; a.ws = (unsigned char*)d_ws;
#if MK_COOP
    a.ph_lo = 0; a.ph_hi = NPHASE;
    void* kargs[] = {&a};
    hipError_t e = hipLaunchCooperativeKernel((const void*)mk_fwd, dim3(grid), dim3(512), kargs, LDS_BYTES, stream);
    if (e != hipSuccess) fprintf(stderr, "cooperative launch failed: %s (grid %d)\n", hipGetErrorString(e), grid);
#else
    for (int ph = 0; ph < NPHASE; ++ph) { a.ph_lo = ph; a.ph_hi = ph + 1; hipLaunchKernelGGL(mk_fwd, dim3(grid), dim3(512), LDS_BYTES, stream, a); }
#endif
}
```

```cpp
#include <hip/hip_runtime.h>
#include <hip/hip_cooperative_groups.h>
#include <cstdio>
#include <cstdint>
namespace cg = cooperative_groups;

#ifndef MK_COOP
#define MK_COOP 1
#endif

#define LAS __attribute__((address_space(3)))
typedef unsigned short bf16_t;
typedef short bf16x8 __attribute__((ext_vector_type(8)));
typedef float f32x4 __attribute__((ext_vector_type(4)));
typedef float f32x2 __attribute__((ext_vector_type(2)));
typedef unsigned u32x4 __attribute__((ext_vector_type(4)));
typedef unsigned u32x2 __attribute__((ext_vector_type(2)));

constexpr int NB = 16, SEQ = 4096, T = NB * SEQ, D = 1024;
constexpr int ABPAD = 3584, ABP = 3336;
constexpr int HGP = 5120;
constexpr int FFN = 2816;
constexpr int NPHASE = 19;

constexpr size_t MiB = 1u << 20;
constexpr size_t WS_WAB = 1 * MiB, WS_WABO = 8 * MiB, WS_WHG = 10 * MiB, WS_WHGO = 20 * MiB, WS_WQ = 22 * MiB, WS_WKV = 26 * MiB, WS_WO = 34 * MiB,
                 WS_WF1 = 38 * MiB, WS_WF2 = 60 * MiB, WS_G2T = 71 * MiB, WS_MEMN = 72 * MiB, WS_KMEM = 88 * MiB, WS_VT = 104 * MiB,
                 WS_PS = 120 * MiB, WS_H = 128 * MiB, WS_P = 256 * MiB, WS_PATT = 384 * MiB, WS_OMIX0 = 704 * MiB, WS_OMIX1 = 896 * MiB, WS_END = 1024 * MiB;
constexpr size_t DO_STATES = 0, DO_G = 128 * MiB, DO_SG = 192 * MiB, DO_BONUS = 208 * MiB, DO_TOT = 210 * MiB;

constexpr int LDS_BYTES = 163840;
constexpr int XLDS_OFF = 131072;

typedef __bf16 bf16x2_t __attribute__((ext_vector_type(2)));
__device__ __forceinline__ unsigned pk2(float lo, float hi) { const f32x2 v = {lo, hi}; return __builtin_bit_cast(unsigned, __builtin_convertvector(v, bf16x2_t)); }
__device__ __forceinline__ unsigned f2bf(float f) { return pk2(f, 0.f) & 0xffffu; }
__device__ __forceinline__ float bf2f(unsigned short b) { return __builtin_bit_cast(float, (unsigned)b << 16); }
__device__ __forceinline__ float bflo(unsigned u) { return __builtin_bit_cast(float, u << 16); }
__device__ __forceinline__ float bfhi(unsigned u) { return __builtin_bit_cast(float, u & 0xffff0000u); }
__device__ __forceinline__ float frcp(float x) { return __builtin_amdgcn_rcpf(x); }
__device__ __forceinline__ float sigmoidf_(float x) { return frcp(1.0f + __expf(-x)); }
__device__ __forceinline__ float siluf_(float x) { return x * frcp(1.0f + __expf(-x)); }
__device__ __forceinline__ float wave_sum(float v) {
#pragma unroll
    for (int o = 1; o < 64; o <<= 1) v += __shfl_xor(v, o);
    return v;
}
template <int CTRL> __device__ __forceinline__ float dppf(float x) { return __builtin_bit_cast(float, __builtin_amdgcn_mov_dpp(__builtin_bit_cast(int, x), CTRL, 0xf, 0xf, true)); }
__device__ __forceinline__ float sum8(float v) { v += dppf<0xB1>(v); v += dppf<0x4E>(v); v += dppf<0x141>(v); return v; }
#define LDS_WAIT() asm volatile("s_waitcnt lgkmcnt(0)" ::: "memory")

namespace pg8 {
constexpr int BM = 256, BK = 64, HALF = 128, HTB = HALF * BK * 2, STAGE_BYTES = 8 * HTB, NXCD = 8, WGM = 8;
__host__ __device__ __forceinline__ int lds_byte(int r, int c) { const int st = (r >> 4) * 2 + (c >> 5), rr = r & 15, cc = c & 31, ob = rr * 64 + cc * 2; return st * 1024 + (ob ^ (((ob >> 9) & 1) << 5)); }
__host__ __device__ __forceinline__ void stage_rc(int b, int& R, int& C) { const int st = b / 1024, sb = b % 1024, swz = sb ^ (((sb >> 9) & 1) << 5); R = (st >> 1) * 16 + swz / 64; C = (st & 1) * 32 + (swz % 64) / 2; }
__host__ __device__ __forceinline__ int perm32(int rho) { const int n = rho >> 4, i = rho & 15; return 8 * (i >> 2) + 4 * n + (i & 3); }

struct Unit { int pm, pn, z; };
struct Gemm {
    const bf16_t* A; const bf16_t* Bt; int lda, ldb, K, nM, nN, nZ, zdiv, psz; long sAo, sAi, sBo, sBi, sCo, sCi;
    __device__ __forceinline__ long offA(const Unit& u) const { return (long)(u.z / zdiv) * sAo + (long)(u.z % zdiv) * sAi + (long)u.pm * BM * lda; }
    __device__ __forceinline__ long offB(const Unit& u) const { return (long)(u.z / zdiv) * sBo + (long)(u.z % zdiv) * sBi + (long)u.pn * BM * ldb; }
    __device__ __forceinline__ long offC(const Unit& u) const { return (long)(u.z / zdiv) * sCo + (long)(u.z % zdiv) * sCi; }
};
__device__ __forceinline__ Gemm make_gemm(const bf16_t* A, const bf16_t* Bt, int M, int N, int K, int lda, int ldb) {
    Gemm g; g.A = A; g.Bt = Bt; g.lda = lda; g.ldb = ldb; g.K = K; g.nM = M / BM; g.nN = N / BM; g.nZ = 1; g.zdiv = 1; g.psz = 0; g.sAo = g.sAi = g.sBo = g.sBi = g.sCo = g.sCi = 0; return g;
}
struct Order {
    int nM, nN, nwg, total, G, c;
    __device__ __forceinline__ void init(const Gemm& g, int G_, int c_) { nM = g.nM; nN = g.nN; nwg = nM * nN; total = nwg * g.nZ; G = G_; c = c_; }
    __device__ __forceinline__ bool next(int i, Unit& u) const {
        const long L = (long)i * G + c; if (L >= total) return false;
        u.z = (int)(L / nwg); int wgid = (int)(L % nwg);
        { const int q = nwg / NXCD, r = nwg % NXCD, xcd = wgid % NXCD, off = wgid / NXCD; wgid = (xcd < r ? xcd * (q + 1) : r * (q + 1) + (xcd - r) * q) + off; }
        const int nig = WGM * nN, gid = wgid / nig, fm = gid * WGM, gsz = (nM - fm) < WGM ? (nM - fm) : WGM;
        u.pm = fm + ((wgid % nig) % gsz); u.pn = (wgid % nig) / gsz; return true;
    }
};

__device__ __forceinline__ unsigned cvt_pk_bf16(float lo, float hi) { return pk2(lo, hi); }

__device__ __forceinline__ void row_scales(const float* PS, int rowbase, int fq, float (&rs)[2][4]) {
#pragma unroll
    for (int ai = 0; ai < 2; ++ai)
#pragma unroll
        for (int m = 0; m < 4; ++m) { const f32x4 p = *(const f32x4*)(PS + (size_t)(rowbase + ai * HALF + m * 16) * 16 + fq * 4);
            float s = (p[0] + p[1]) + (p[2] + p[3]); s += __shfl_xor(s, 16); s += __shfl_xor(s, 32); rs[ai][m] = rsqrtf(s * (1.f / 1024.f) + 1e-6f); }
}
__device__ __forceinline__ void row_scales_lds(const LAS float* PSL, int rloc  , int fq, float (&rs)[2][4]) {
#pragma unroll
    for (int ai = 0; ai < 2; ++ai)
#pragma unroll
        for (int m = 0; m < 4; ++m) { const f32x4 p = *(const LAS f32x4*)(PSL + (rloc + ai * HALF + m * 16) * 16 + fq * 4);
            float s = (p[0] + p[1]) + (p[2] + p[3]); s += __shfl_xor(s, 16); s += __shfl_xor(s, 32); rs[ai][m] = rsqrtf(s * (1.f / 1024.f) + 1e-6f); }
}
struct EpiBf16 {
    static constexpr bool PERM = true, PSLDS = false;
    bf16_t* O; int ldc; float scale; const float* PS;
    __device__ __forceinline__ void operator()(const f32x4 (&acc)[2][2][4][2], const Unit& u, long coff, int wr, int wc, int fr, int fq, LAS unsigned char* xl) const {
        const int row0 = u.pm * BM + wr * 64 + fr, col0 = u.pn * BM + wc * 32 + 8 * fq; bf16_t* base = O + coff;
        float rs[2][4];
        if (PS) row_scales(PS, row0, fq, rs);
        else {
#pragma unroll
            for (int ai = 0; ai < 2; ++ai)
#pragma unroll
                for (int m = 0; m < 4; ++m) rs[ai][m] = 1.f; }
#pragma unroll
        for (int ai = 0; ai < 2; ++ai)
#pragma unroll
            for (int m = 0; m < 4; ++m) { bf16_t* rowp = base + (size_t)(row0 + ai * HALF + m * 16) * ldc + col0; const float sc_ = scale * rs[ai][m];
#pragma unroll
                for (int bj = 0; bj < 2; ++bj) { const f32x4 v0 = acc[ai][bj][m][0] * sc_, v1 = acc[ai][bj][m][1] * sc_;
                    u32x4 w; w.x = cvt_pk_bf16(v0[0], v0[1]); w.y = cvt_pk_bf16(v0[2], v0[3]); w.z = cvt_pk_bf16(v1[0], v1[1]); w.w = cvt_pk_bf16(v1[2], v1[3]);
                    *(u32x4*)(rowp + bj * HALF) = w; } }
    }
};
struct EpiBf16PS {
    static constexpr bool PERM = true, PSLDS = true;
    bf16_t* O; int ldc; float scale; const float* PS;
    __device__ __forceinline__ void operator()(const f32x4 (&acc)[2][2][4][2], const Unit& u, long coff, int wr, int wc, int fr, int fq, LAS unsigned char* xl) const {
        const int row0 = u.pm * BM + wr * 64 + fr, col0 = u.pn * BM + wc * 32 + 8 * fq; bf16_t* base = O + coff;
        float rs[2][4];
        row_scales_lds((const LAS float*)(xl + 8192), wr * 64 + fr, fq, rs);
#pragma unroll
        for (int ai = 0; ai < 2; ++ai)
#pragma unroll
            for (int m = 0; m < 4; ++m) { bf16_t* rowp = base + (size_t)(row0 + ai * HALF + m * 16) * ldc + col0; const float sc_ = scale * rs[ai][m];
#pragma unroll
                for (int bj = 0; bj < 2; ++bj) { const f32x4 v0 = acc[ai][bj][m][0] * sc_, v1 = acc[ai][bj][m][1] * sc_;
                    u32x4 w; w.x = cvt_pk_bf16(v0[0], v0[1]); w.y = cvt_pk_bf16(v0[2], v0[3]); w.z = cvt_pk_bf16(v1[0], v1[1]); w.w = cvt_pk_bf16(v1[2], v1[3]);
                    *(u32x4*)(rowp + bj * HALF) = w; } }
    }
};
struct EpiResid {
    static constexpr bool PERM = false, PSLDS = false;
    const float* base; float* out; int ldc;
    __device__ __forceinline__ void operator()(const f32x4 (&acc)[2][2][4][2], const Unit& u, long coff, int wr, int wc, int fr, int fq, LAS unsigned char* xl) const {
        const int col0 = u.pn * BM + wc * 32 + 4 * fq;
#pragma unroll
        for (int ai = 0; ai < 2; ++ai)
#pragma unroll
            for (int m = 0; m < 4; ++m) { const size_t off = (size_t)(u.pm * BM + ai * HALF + wr * 64 + m * 16 + fr) * ldc + col0;
#pragma unroll
                for (int bj = 0; bj < 2; ++bj)
#pragma unroll
                    for (int n = 0; n < 2; ++n) { const f32x4 bs = *(const f32x4*)(base + off + bj * HALF + n * 16); *(f32x4*)(out + off + bj * HALF + n * 16) = bs + acc[ai][bj][m][n]; } }
    }
};
struct EpiResidH {
    static constexpr bool PERM = false, PSLDS = false;
    const float* base; float* out; bf16_t* HB; float* PS; int ldc;
    __device__ __forceinline__ void operator()(const f32x4 (&acc)[2][2][4][2], const Unit& u, long coff, int wr, int wc, int fr, int fq, LAS unsigned char* xl) const {
        const int col0 = u.pn * BM + wc * 32 + 4 * fq;
#pragma unroll
        for (int ai = 0; ai < 2; ++ai)
#pragma unroll
            for (int m = 0; m < 4; ++m) { const int row = u.pm * BM + ai * HALF + wr * 64 + m * 16 + fr; const size_t off = (size_t)row * ldc + col0; float ss = 0.f;
#pragma unroll
                for (int bj = 0; bj < 2; ++bj)
#pragma unroll
                    for (int n = 0; n < 2; ++n) { const f32x4 bs = *(const f32x4*)(base + off + bj * HALF + n * 16); const f32x4 o = bs + acc[ai][bj][m][n]; *(f32x4*)(out + off + bj * HALF + n * 16) = o;
                        ss += (o[0] * o[0] + o[1] * o[1]) + (o[2] * o[2] + o[3] * o[3]);
                        u32x2 w; w.x = cvt_pk_bf16(o[0], o[1]); w.y = cvt_pk_bf16(o[2], o[3]); *(u32x2*)(HB + off + bj * HALF + n * 16) = w; }
                ss += __shfl_xor(ss, 16); ss += __shfl_xor(ss, 32);
                if (fq == 0) PS[(size_t)row * 16 + u.pn * 4 + wc] = ss; }
    }
};
struct EpiResidB {
    static constexpr bool PERM = false, PSLDS = false;
    const float* basef; bf16_t* HB; float* PS; int ldc;
    __device__ __forceinline__ void operator()(const f32x4 (&acc)[2][2][4][2], const Unit& u, long coff, int wr, int wc, int fr, int fq, LAS unsigned char* xl) const {
        const int col0 = u.pn * BM + wc * 32 + 4 * fq;
#pragma unroll
        for (int ai = 0; ai < 2; ++ai)
#pragma unroll
            for (int m = 0; m < 4; ++m) { const int row = (int)(coff / ldc) + u.pm * BM + ai * HALF + wr * 64 + m * 16 + fr; const size_t off = (size_t)row * ldc + col0; float ss = 0.f;
#pragma unroll
                for (int bj = 0; bj < 2; ++bj)
#pragma unroll
                    for (int n = 0; n < 2; ++n) { f32x4 bs;
                        if (basef) bs = *(const f32x4*)(basef + off + bj * HALF + n * 16);
                        else { const u32x2 hb = *(const u32x2*)(HB + off + bj * HALF + n * 16); bs = (f32x4){bflo(hb.x), bfhi(hb.x), bflo(hb.y), bfhi(hb.y)}; }
                        const f32x4 o = bs + acc[ai][bj][m][n];
                        ss += (o[0] * o[0] + o[1] * o[1]) + (o[2] * o[2] + o[3] * o[3]);
                        u32x2 w; w.x = cvt_pk_bf16(o[0], o[1]); w.y = cvt_pk_bf16(o[2], o[3]); *(u32x2*)(HB + off + bj * HALF + n * 16) = w; }
                ss += __shfl_xor(ss, 16); ss += __shfl_xor(ss, 32);
                if (fq == 0) PS[(size_t)row * 16 + u.pn * 4 + wc] = ss; }
    }
};
struct EpiSwiglu {
    static constexpr bool PERM = true, PSLDS = true;
    bf16_t* O; int ldc; const float* PS;
    __device__ __forceinline__ void operator()(const f32x4 (&acc)[2][2][4][2], const Unit& u, long coff, int wr, int wc, int fr, int fq, LAS unsigned char* xl) const {
        const int row0 = u.pm * BM + wr * 64 + fr, col0 = u.pn * HALF + wc * 32 + 8 * fq;
        float rs[2][4]; row_scales_lds((const LAS float*)(xl + 8192), wr * 64 + fr, fq, rs);
#pragma unroll
        for (int ai = 0; ai < 2; ++ai)
#pragma unroll
            for (int m = 0; m < 4; ++m) { bf16_t* rowp = O + (size_t)(row0 + ai * HALF + m * 16) * ldc + col0; float r[8]; const float sc_ = rs[ai][m];
#pragma unroll
                for (int n = 0; n < 2; ++n)
#pragma unroll
                    for (int i = 0; i < 4; ++i) { const float g = acc[ai][0][m][n][i] * sc_, uu = acc[ai][1][m][n][i] * sc_; r[n * 4 + i] = siluf_(g) * uu; }
                u32x4 w; w.x = cvt_pk_bf16(r[0], r[1]); w.y = cvt_pk_bf16(r[2], r[3]); w.z = cvt_pk_bf16(r[4], r[5]); w.w = cvt_pk_bf16(r[6], r[7]);
                *(u32x4*)rowp = w; }
    }
};
struct EpiSoftmax {
    static constexpr bool PERM = true, PSLDS = false;
    bf16_t* O; int ldc;
    __device__ __forceinline__ void operator()(f32x4 (&acc)[2][2][4][2], const Unit& u, long coff, int wr, int wc, int fr, int fq, LAS unsigned char* xl) const {
        LAS float* XM = (LAS float*)xl; LAS float* XS = (LAS float*)(xl + 4096);
#pragma unroll
        for (int ai = 0; ai < 2; ++ai)
#pragma unroll
            for (int m = 0; m < 4; ++m) { float mx = -3.0e38f;
#pragma unroll
                for (int bj = 0; bj < 2; ++bj)
#pragma unroll
                    for (int n = 0; n < 2; ++n)
#pragma unroll
                        for (int i = 0; i < 4; ++i) mx = fmaxf(mx, acc[ai][bj][m][n][i]);
                mx = fmaxf(mx, __shfl_xor(mx, 16)); mx = fmaxf(mx, __shfl_xor(mx, 32));
                if (fq == 0) XM[(ai * HALF + wr * 64 + m * 16 + fr) * 4 + wc] = mx; }
        LDS_WAIT(); __builtin_amdgcn_s_barrier(); asm volatile("" ::: "memory");
#pragma unroll
        for (int ai = 0; ai < 2; ++ai)
#pragma unroll
            for (int m = 0; m < 4; ++m) { const f32x4 mm = *(const LAS f32x4*)(XM + (ai * HALF + wr * 64 + m * 16 + fr) * 4);
                const float mx = fmaxf(fmaxf(mm[0], mm[1]), fmaxf(mm[2], mm[3])); float s = 0.f;
#pragma unroll
                for (int bj = 0; bj < 2; ++bj)
#pragma unroll
                    for (int n = 0; n < 2; ++n)
#pragma unroll
                        for (int i = 0; i < 4; ++i) { const float e = __expf(acc[ai][bj][m][n][i] - mx); acc[ai][bj][m][n][i] = e; s += e; }
                s += __shfl_xor(s, 16); s += __shfl_xor(s, 32);
                if (fq == 0) XS[(ai * HALF + wr * 64 + m * 16 + fr) * 4 + wc] = s; }
        LDS_WAIT(); __builtin_amdgcn_s_barrier(); asm volatile("" ::: "memory");
        const int row0 = u.pm * BM + wr * 64 + fr, col0 = wc * 32 + 8 * fq; bf16_t* base = O + coff;
#pragma unroll
        for (int ai = 0; ai < 2; ++ai)
#pragma unroll
            for (int m = 0; m < 4; ++m) { const f32x4 ss = *(const LAS f32x4*)(XS + (ai * HALF + wr * 64 + m * 16 + fr) * 4);
                const float inv = frcp((ss[0] + ss[1]) + (ss[2] + ss[3])); bf16_t* rowp = base + (size_t)(row0 + ai * HALF + m * 16) * ldc + col0;
#pragma unroll
                for (int bj = 0; bj < 2; ++bj) { const f32x4 v0 = acc[ai][bj][m][0] * inv, v1 = acc[ai][bj][m][1] * inv;
                    u32x4 w; w.x = cvt_pk_bf16(v0[0], v0[1]); w.y = cvt_pk_bf16(v0[2], v0[3]); w.z = cvt_pk_bf16(v1[0], v1[1]); w.w = cvt_pk_bf16(v1[2], v1[3]);
                    *(u32x4*)(rowp + bj * HALF) = w; } }
    }
};

struct EpiSoftmaxPS {
    const float* PS;
    static constexpr bool PERM = true, PSLDS = true;
    bf16_t* O; int ldc;
    __device__ __forceinline__ void operator()(f32x4 (&acc)[2][2][4][2], const Unit& u, long coff, int wr, int wc, int fr, int fq, LAS unsigned char* xl) const {
        LAS float* XM = (LAS float*)xl; LAS float* XS = (LAS float*)(xl + 4096);
        { float rs[2][4]; row_scales_lds((const LAS float*)(xl + 8192), wr * 64 + fr, fq, rs);
#pragma unroll
          for (int ai = 0; ai < 2; ++ai)
#pragma unroll
              for (int m = 0; m < 4; ++m)
#pragma unroll
                  for (int bj = 0; bj < 2; ++bj)
#pragma unroll
                      for (int n = 0; n < 2; ++n) acc[ai][bj][m][n] = acc[ai][bj][m][n] * rs[ai][m]; }
#pragma unroll
        for (int ai = 0; ai < 2; ++ai)
#pragma unroll
            for (int m = 0; m < 4; ++m) { float mx = -3.0e38f;
#pragma unroll
                for (int bj = 0; bj < 2; ++bj)
#pragma unroll
                    for (int n = 0; n < 2; ++n)
#pragma unroll
                        for (int i = 0; i < 4; ++i) mx = fmaxf(mx, acc[ai][bj][m][n][i]);
                mx = fmaxf(mx, __shfl_xor(mx, 16)); mx = fmaxf(mx, __shfl_xor(mx, 32));
                if (fq == 0) XM[(ai * HALF + wr * 64 + m * 16 + fr) * 4 + wc] = mx; }
        LDS_WAIT(); __builtin_amdgcn_s_barrier(); asm volatile("" ::: "memory");
#pragma unroll
        for (int ai = 0; ai < 2; ++ai)
#pragma unroll
            for (int m = 0; m < 4; ++m) { const f32x4 mm = *(const LAS f32x4*)(XM + (ai * HALF + wr * 64 + m * 16 + fr) * 4);
                const float mx = fmaxf(fmaxf(mm[0], mm[1]), fmaxf(mm[2], mm[3])); float s = 0.f;
#pragma unroll
                for (int bj = 0; bj < 2; ++bj)
#pragma unroll
                    for (int n = 0; n < 2; ++n)
#pragma unroll
                        for (int i = 0; i < 4; ++i) { const float e = __expf(acc[ai][bj][m][n][i] - mx); acc[ai][bj][m][n][i] = e; s += e; }
                s += __shfl_xor(s, 16); s += __shfl_xor(s, 32);
                if (fq == 0) XS[(ai * HALF + wr * 64 + m * 16 + fr) * 4 + wc] = s; }
        LDS_WAIT(); __builtin_amdgcn_s_barrier(); asm volatile("" ::: "memory");
        const int row0 = u.pm * BM + wr * 64 + fr, col0 = wc * 32 + 8 * fq; bf16_t* base = O + coff;
#pragma unroll
        for (int ai = 0; ai < 2; ++ai)
#pragma unroll
            for (int m = 0; m < 4; ++m) { const f32x4 ss = *(const LAS f32x4*)(XS + (ai * HALF + wr * 64 + m * 16 + fr) * 4);
                const float inv = frcp((ss[0] + ss[1]) + (ss[2] + ss[3])); bf16_t* rowp = base + (size_t)(row0 + ai * HALF + m * 16) * ldc + col0;
#pragma unroll
                for (int bj = 0; bj < 2; ++bj) { const f32x4 v0 = acc[ai][bj][m][0] * inv, v1 = acc[ai][bj][m][1] * inv;
                    u32x4 w; w.x = cvt_pk_bf16(v0[0], v0[1]); w.y = cvt_pk_bf16(v0[2], v0[3]); w.z = cvt_pk_bf16(v1[0], v1[1]); w.w = cvt_pk_bf16(v1[2], v1[3]);
                    *(u32x4*)(rowp + bj * HALF) = w; } }
    }
};

template <class Epi, bool ALIGN_EPI>
__device__ __forceinline__ void gemm_phase(LAS unsigned char* lds, LAS unsigned char* xl, const Gemm g, const Order& S, Epi& E) {
    const int tid = threadIdx.x, wid = __builtin_amdgcn_readfirstlane(tid >> 6), lane = tid & 63, wr = wid >> 2, wc = wid & 3, fr = lane & 15, fq = lane >> 4;
    const int K = g.K, nt = K / BK;
    unsigned voffA[2], voffB[2];
#pragma unroll
    for (int i = 0; i < 2; ++i) { int R, C; stage_rc(tid * 16 + i * 8192, R, C); const int Rb = Epi::PERM ? ((R & ~31) + perm32(R & 31)) : R;
        voffA[i] = (unsigned)(R * g.lda + C) * 2u; voffB[i] = (unsigned)(Rb * g.ldb + C) * 2u; }
    const size_t kstep = (size_t)(BK * 2);
    const size_t hstepA = (size_t)HALF * g.lda * 2, hstepB = (size_t)HALF * g.ldb * 2;
    const unsigned ldsw = (unsigned)wid * 1024u;
    const int aoff = lds_byte(wr * 64 + fr, fq * 8), boff = lds_byte(wc * 32 + fr, fq * 8);
#define PG8_SA(b, h) (((b) * 2 + (h)) * HTB)
#define PG8_SB(b, h) ((4 + (b) * 2 + (h)) * HTB)
#define PG8_STAGE(bufoff, gbase, voff) do { _Pragma("unroll") for (int _i = 0; _i < 2; ++_i) \
        __builtin_amdgcn_global_load_lds((const unsigned*)((const char*)(gbase) + (voff)[_i]), (LAS unsigned*)(lds + (bufoff) + ldsw + _i * 8192), 16, 0, 0); } while (0)
#define PG8_LDA(dst, b, h) do { _Pragma("unroll") for (int m = 0; m < 4; ++m) _Pragma("unroll") for (int k = 0; k < 2; ++k) dst[m][k] = *(const LAS bf16x8*)(lds + PG8_SA(b, h) + aoff + m * 2048 + k * 1024); } while (0)
#define PG8_LDB(dst, b, h) do { _Pragma("unroll") for (int n = 0; n < 2; ++n) _Pragma("unroll") for (int k = 0; k < 2; ++k) dst[n][k] = *(const LAS bf16x8*)(lds + PG8_SB(b, h) + boff + n * 2048 + k * 1024); } while (0)
#define PG8_MMA(ai, bj, At, Bt) do { __builtin_amdgcn_s_setprio(1); _Pragma("unroll") for (int m = 0; m < 4; ++m) _Pragma("unroll") for (int n = 0; n < 2; ++n) _Pragma("unroll") for (int k = 0; k < 2; ++k) \
        acc[ai][bj][m][n] = __builtin_amdgcn_mfma_f32_16x16x32_bf16(Bt[n][k], At[m][k], acc[ai][bj][m][n], 0, 0, 0); __builtin_amdgcn_s_setprio(0); } while (0)
#define PG8_WAIT_V(n) asm volatile("s_waitcnt vmcnt(" #n ")" ::: "memory")
#define PG8_WAIT_L(n) asm volatile("s_waitcnt lgkmcnt(" #n ")" ::: "memory")
#define PG8_BAR __builtin_amdgcn_s_barrier()
#define PG8_SCHED __builtin_amdgcn_sched_barrier(0)
    Unit cur, nxt; int ui = 0;
    if (!S.next(0, cur)) return;
    f32x4 acc[2][2][4][2];
#pragma unroll
    for (int a = 0; a < 2; ++a)
#pragma unroll
        for (int b = 0; b < 2; ++b)
#pragma unroll
            for (int m = 0; m < 4; ++m)
#pragma unroll
                for (int n = 0; n < 2; ++n) acc[a][b][m][n] = (f32x4){0.f, 0.f, 0.f, 0.f};
    bf16x8 At[4][2], B0[2][2], B1[2][2];
    const char* cA = (const char*)g.A + 2 * g.offA(cur); const char* cB = (const char*)g.Bt + 2 * g.offB(cur);
    PG8_STAGE(PG8_SB(0, 0), cB, voffB); PG8_STAGE(PG8_SB(0, 1), cB + hstepB, voffB); PG8_STAGE(PG8_SA(0, 0), cA, voffA); PG8_STAGE(PG8_SA(0, 1), cA + hstepA, voffA);
    if (wr == 1) PG8_BAR;
    PG8_WAIT_V(2); PG8_BAR;
    PG8_STAGE(PG8_SB(1, 0), cB + kstep, voffB); PG8_STAGE(PG8_SA(1, 0), cA + kstep, voffA); PG8_STAGE(PG8_SB(1, 1), cB + hstepB + kstep, voffB);
    PG8_WAIT_V(6); PG8_BAR;
    for (;;) {
        const bool has_next = S.next(ui + 1, nxt);
        const char* nA = has_next ? (const char*)g.A + 2 * g.offA(nxt) : cA; const char* nB = has_next ? (const char*)g.Bt + 2 * g.offB(nxt) : cB;
        for (int t = 0; t < nt; t += 2) {
            const bool last = (t == nt - 2);
            const char* a1 = cA + (size_t)(t + 1) * kstep;
            const char* a2 = last ? nA : cA + (size_t)(t + 2) * kstep; const char* b2 = last ? nB : cB + (size_t)(t + 2) * kstep;
            const char* a3 = a2 + kstep; const char* b3 = b2 + kstep;
            if constexpr (Epi::PSLDS) { if (last) {
                const char* psrc = (const char*)(E.PS + (size_t)((cur.z / g.zdiv) * g.psz + cur.pm) * (BM * 16)) + tid * 16;
#pragma unroll
                for (int _i = 0; _i < 2; ++_i) __builtin_amdgcn_global_load_lds((const unsigned*)(psrc + _i * 8192), (LAS unsigned*)(xl + 8192 + ldsw + _i * 8192), 16, 0, 0); } }
            PG8_LDB(B0, 0, 0); PG8_LDB(B1, 0, 1); PG8_SCHED; PG8_LDA(At, 0, 0); PG8_STAGE(PG8_SA(1, 1), a1 + hstepA, voffA);
            PG8_WAIT_V(8); PG8_WAIT_L(0); PG8_BAR; PG8_MMA(0, 0, At, B0); PG8_MMA(0, 1, At, B1); PG8_BAR; PG8_SCHED;
            PG8_LDA(At, 0, 1); PG8_STAGE(PG8_SB(0, 0), b2, voffB); PG8_STAGE(PG8_SB(0, 1), b2 + hstepB, voffB); PG8_STAGE(PG8_SA(0, 0), a2, voffA);
            PG8_WAIT_V(8); PG8_WAIT_L(0); PG8_BAR; PG8_MMA(1, 0, At, B0); PG8_MMA(1, 1, At, B1); PG8_BAR; PG8_SCHED;
            PG8_LDB(B0, 1, 0); PG8_LDB(B1, 1, 1); PG8_SCHED; PG8_LDA(At, 1, 0); PG8_STAGE(PG8_SA(0, 1), a2 + hstepA, voffA);
            PG8_WAIT_V(8); PG8_WAIT_L(0); PG8_BAR; PG8_MMA(0, 0, At, B0); PG8_MMA(0, 1, At, B1); PG8_BAR; PG8_SCHED;
            PG8_LDA(At, 1, 1); PG8_STAGE(PG8_SB(1, 0), b3, voffB); PG8_STAGE(PG8_SB(1, 1), b3 + hstepB, voffB); PG8_STAGE(PG8_SA(1, 0), a3, voffA);
            PG8_WAIT_V(8); PG8_WAIT_L(0); PG8_BAR; PG8_MMA(1, 0, At, B0); PG8_MMA(1, 1, At, B1); PG8_BAR; PG8_SCHED;
        }
        if constexpr (ALIGN_EPI) { if (wr == 0) PG8_BAR; }
        E(acc, cur, g.offC(cur), wr, wc, fr, fq, xl);
        if (!has_next) break;
#pragma unroll
        for (int a = 0; a < 2; ++a)
#pragma unroll
            for (int b = 0; b < 2; ++b)
#pragma unroll
                for (int m = 0; m < 4; ++m)
#pragma unroll
                    for (int n = 0; n < 2; ++n) acc[a][b][m][n] = (f32x4){0.f, 0.f, 0.f, 0.f};
        cur = nxt; cA = nA; cB = nB; ++ui;
        if constexpr (ALIGN_EPI) { if (wr == 1) PG8_BAR; }
    }
    PG8_WAIT_V(0);
    if constexpr (!ALIGN_EPI) { if (wr == 0) PG8_BAR; }
    PG8_BAR;
#undef PG8_SA
#undef PG8_SB
#undef PG8_STAGE
#undef PG8_LDA
#undef PG8_LDB
#undef PG8_MMA
#undef PG8_WAIT_V
#undef PG8_WAIT_L
#undef PG8_BAR
#undef PG8_SCHED
}
}

__device__ __forceinline__ f32x4 mfma16(bf16x8 bfrag, bf16x8 afrag, f32x4 acc) { return __builtin_amdgcn_mfma_f32_16x16x32_bf16(bfrag, afrag, acc, 0, 0, 0); }
__device__ __forceinline__ bf16x8 ldsfrag(const LAS bf16_t* base, int ld, int r0, int k0, int fr, int fq) { return *(const LAS bf16x8*)(base + (r0 + fr) * ld + k0 + fq * 8); }

template <int MODE> __device__ __forceinline__ void transpose_item(const float* W, int K, int N, bf16_t* WT, LAS float* scr, int item, int nblk, int lane, const float* gain = nullptr) {
    const int kb = item / nblk, nb = item % nblk, k0 = 64 * kb, n0 = 32 * nb; const int nsrc = n0 + (lane & 31);
#pragma unroll 8
    for (int i = 0; i < 32; ++i) { const int kk = 2 * i + (lane >> 5); scr[kk * 33 + (lane & 31)] = (nsrc < N) ? W[(size_t)(k0 + kk) * N + nsrc] * (gain ? gain[k0 + kk] : 1.f) : 0.f; }
    LDS_WAIT();
    const int c = lane & 7;
#pragma unroll
    for (int j = 0; j < 4; ++j) { const int n = (lane >> 3) + 8 * j; const LAS float* s = scr + (8 * c) * 33 + n;
        u32x4 o; o.x = pk2(s[0 * 33], s[1 * 33]); o.y = pk2(s[2 * 33], s[3 * 33]); o.z = pk2(s[4 * 33], s[5 * 33]); o.w = pk2(s[6 * 33], s[7 * 33]);
        int drow = n0 + n; if (MODE == 1) { const int jn = drow % FFN, isu = drow / FFN; drow = (jn / 128) * 256 + isu * 128 + (jn % 128); }
        *(u32x4*)(WT + (size_t)drow * K + k0 + 8 * c) = o; }
    LDS_WAIT();
}
__device__ __forceinline__ void rms_row_bf16(const float* xrow, const float* gain, bf16_t* orow, int lane) {
    const f32x4* xr = (const f32x4*)xrow + lane; f32x4 v[4]; float s = 0.f;
#pragma unroll
    for (int j = 0; j < 4; ++j) { v[j] = xr[64 * j]; s += (v[j].x * v[j].x + v[j].y * v[j].y) + (v[j].z * v[j].z + v[j].w * v[j].w); }
    const float rs = rsqrtf(wave_sum(s) * (1.f / D) + 1e-6f);
    const f32x4* gr = (const f32x4*)gain + lane; u32x2* o8 = (u32x2*)orow + lane;
#pragma unroll
    for (int j = 0; j < 4; ++j) { const f32x4 g = gr[64 * j]; u32x2 w; w.x = pk2(v[j].x * rs * g.x, v[j].y * rs * g.y); w.y = pk2(v[j].z * rs * g.z, v[j].w * rs * g.w); o8[64 * j] = w; }
}
__device__ __forceinline__ void rms_row2_bf16(const float* xa, const float* xb, const float* gain, bf16_t* oa, bf16_t* ob, int lane) {
    const f32x4* ra = (const f32x4*)xa + lane; const f32x4* rb = (const f32x4*)xb + lane; f32x4 va[4], vb[4]; float sa = 0.f, sb = 0.f;
#pragma unroll
    for (int j = 0; j < 4; ++j) { va[j] = ra[64 * j]; vb[j] = rb[64 * j]; }
#pragma unroll
    for (int j = 0; j < 4; ++j) { sa += (va[j].x * va[j].x + va[j].y * va[j].y) + (va[j].z * va[j].z + va[j].w * va[j].w); sb += (vb[j].x * vb[j].x + vb[j].y * vb[j].y) + (vb[j].z * vb[j].z + vb[j].w * vb[j].w); }
#pragma unroll
    for (int o = 1; o < 64; o <<= 1) { sa += __shfl_xor(sa, o); sb += __shfl_xor(sb, o); }
    const float rsa = rsqrtf(sa * (1.f / D) + 1e-6f), rsb = rsqrtf(sb * (1.f / D) + 1e-6f);
    const f32x4* gr = (const f32x4*)gain + lane; u32x2* pa = (u32x2*)oa + lane; u32x2* pb = (u32x2*)ob + lane;
#pragma unroll
    for (int j = 0; j < 4; ++j) { const f32x4 g = gr[64 * j]; u32x2 w;
        w.x = pk2(va[j].x * rsa * g.x, va[j].y * rsa * g.y); w.y = pk2(va[j].z * rsa * g.z, va[j].w * rsa * g.w); pa[64 * j] = w;
        w.x = pk2(vb[j].x * rsb * g.x, vb[j].y * rsb * g.y); w.y = pk2(vb[j].z * rsb * g.z, vb[j].w * rsb * g.w); pb[64 * j] = w; }
}
__device__ __forceinline__ void rms_rows_phase(const float* X, const float* gain, bf16_t* H, int nrows, int gw, int NGW, int lane) {
    int m = gw;
    for (; m + NGW < nrows; m += 2 * NGW) rms_row2_bf16(X + (size_t)m * D, X + (size_t)(m + NGW) * D, gain, H + (size_t)m * D, H + (size_t)(m + NGW) * D, lane);
    if (m < nrows) rms_row_bf16(X + (size_t)m * D, gain, H + (size_t)m * D, lane);
}

__device__ __forceinline__ void rwkv_chain(LAS unsigned char* lds, int cid, const bf16_t* P0, const float* mu, const float* w0, const float* w2, const float* a0, const float* a2,
                                           const float* k_k, const float* k_a, const float* r_k, bf16_t* ORW, bf16_t* SG, float* BONUS) {
    const int tid = threadIdx.x, lane = tid & 63, wid = tid >> 6, fr = lane & 15, fq = lane >> 4;
    const int b = cid >> 4, h = (cid >> 1) & 7, dir = cid & 1;
    LAS float* rS = (LAS float*)(lds); LAS float* kS = (LAS float*)(lds + 8192); LAS float* vS = (LAS float*)(lds + 16384); LAS float* wS = (LAS float*)(lds + 24576);
    LAS float* nkS = (LAS float*)(lds + 32768); LAS float* bS = (LAS float*)(lds + 40960); LAS float* preA = (LAS float*)(lds + 49152); LAS float* preW = (LAS float*)(lds + 57344);
    LAS bf16_t* adB = (LAS bf16_t*)(lds + 65536); LAS bf16_t* wdB = (LAS bf16_t*)(lds + 70144);
    LAS bf16_t* a2B = (LAS bf16_t*)(lds + 74752); LAS bf16_t* w2B = (LAS bf16_t*)(lds + 83968); LAS float* cst = (LAS float*)(lds + 93184);
    LAS bf16_t* At = (LAS bf16_t*)(lds + 97280); LAS bf16_t* Bt = (LAS bf16_t*)(lds + 101888); LAS bf16_t* Kt = (LAS bf16_t*)(lds + 106496); LAS bf16_t* Rt = (LAS bf16_t*)(lds + 111104);
    LAS bf16_t* BtT = (LAS bf16_t*)(lds + 115712); LAS bf16_t* KtT = (LAS bf16_t*)(lds + 120832); LAS bf16_t* VT = (LAS bf16_t*)(lds + 125952); LAS bf16_t* S0b = (LAS bf16_t*)(lds + 131072);
    LAS float* NT4 = (LAS float*)(lds + 140288); LAS bf16_t* NakT = (LAS bf16_t*)(lds + 146432); LAS bf16_t* MbrT = (LAS bf16_t*)(lds + 148992); LAS bf16_t* MkrT = (LAS bf16_t*)(lds + 151552);
    LAS float* gL = (LAS float*)(lds + 154112);
    LAS float* WS = preA;
    LAS bf16_t* Ub = (LAS bf16_t*)preW;
#define RW_IDS int tid_o = threadIdx.x; asm volatile("" : "+v"(tid_o)); const int tid = tid_o, lane = tid & 63, wid = __builtin_amdgcn_readfirstlane(tid >> 6), fr = lane & 15, fq = lane >> 4, vt = wid >> 1, tt2 = wid & 1; (void)lane; (void)wid; (void)fr; (void)fq; (void)vt; (void)tt2;
    __syncthreads();
    for (int e = tid; e < 64 * 64; e += 512) { const int j = e & 63, r = e >> 6;
        a2B[j * 72 + r] = (bf16_t)f2bf(a2[r * 512 + h * 64 + j]); w2B[j * 72 + r] = (bf16_t)f2bf(w2[(dir * 64 + r) * 512 + h * 64 + j]); }
    for (int e = tid; e < 64 * 72 / 2; e += 512) ((LAS unsigned*)S0b)[e] = 0u;
    if (tid < 64) { const int j = tid, c = h * 64 + j;
        cst[0 * 64 + j] = a0[c]; cst[1 * 64 + j] = w0[dir * 512 + c]; cst[2 * 64 + j] = k_k[c]; cst[3 * 64 + j] = k_a[c]; cst[4 * 64 + j] = r_k[c];
        cst[5 * 64 + j] = mu[c]; cst[6 * 64 + j] = mu[512 + c]; cst[7 * 64 + j] = mu[1024 + c]; cst[8 * 64 + j] = mu[1536 + j]; cst[9 * 64 + j] = mu[1600 + j];
        cst[10 * 64 + j] = (j < 16) ? mu[1664 + h * 16 + j] : 0.f; }
    const int vt = wid >> 1, tt2 = wid & 1;
    f32x4 st[2]; st[0] = (f32x4){0.f, 0.f, 0.f, 0.f}; st[1] = st[0];
    __syncthreads();
    const bf16_t* Pb = P0 + (size_t)b * SEQ * ABPAD;
    unsigned rc[10], rpv[10], rnx[10]; unsigned short gcv = 0, gpv = 0, gnv = 0;
#define RW_IDX(i) const int grp = (i) >> 1; const int idx_ = tid + 512 * ((i) & 1); const int tok = idx_ >> 5, c2 = (idx_ & 31) * 2; \
                  const int gcol = (grp == 0 ? h * 64 : grp == 1 ? 512 + h * 64 : grp == 2 ? 1024 + h * 64 : grp == 3 ? 1536 : 1600) + c2;
    const unsigned voff = (unsigned)((((int)threadIdx.x >> 5) * ABPAD + ((int)threadIdx.x & 31) * 2) * 2);
#define RW_CG(g) ((g) == 0 ? h * 128 : (g) == 1 ? 1024 + h * 128 : (g) == 2 ? 2048 + h * 128 : (g) == 3 ? 3072 : 3200)
#define RW_ISSUE(t0n) do { const char* bp_ = (const char*)(Pb + (size_t)(t0n) * ABPAD); const bool first_ = ((t0n) == 0) && (tid < 32), last_ = ((t0n) == SEQ - 32) && (tid >= 480); \
        _Pragma("unroll") for (int i = 0; i < 10; ++i) { const char* p = bp_ + (RW_CG(i >> 1) + (i & 1) * 16 * ABPAD * 2) + voff; \
            rc[i] = *(const unsigned*)p; \
            if ((i & 1) == 0) { const unsigned v_ = *(const unsigned*)(p - (first_ ? 0 : ABPAD * 2)); rpv[i] = first_ ? 0u : v_; rnx[i] = *(const unsigned*)(p + ABPAD * 2); } \
            else { const unsigned v_ = *(const unsigned*)(p + (last_ ? 0 : ABPAD * 2)); rnx[i] = last_ ? 0u : v_; rpv[i] = *(const unsigned*)(p - ABPAD * 2); } } \
        if (dir == 0) { const bool fg_ = ((t0n) == 0) && (tid < 16), lg_ = ((t0n) == SEQ - 32) && (tid >= 496); \
            const bf16_t* p = (const bf16_t*)bp_ + (size_t)(tid >> 4) * ABPAD + 1664 + h * 16 + (tid & 15); \
            gcv = *p; { const unsigned short v_ = *(p - (fg_ ? 0 : ABPAD)); gpv = fg_ ? (unsigned short)0 : v_; } { const unsigned short v_ = *(p + (lg_ ? 0 : ABPAD)); gnv = lg_ ? (unsigned short)0 : v_; } } } while (0)
    RW_ISSUE(dir ? 127 * 32 : 0);
    for (int cc = 0; cc < 128; ++cc) {
        const int t0 = dir ? (127 - cc) * 32 : cc * 32;
        { RW_IDS
#pragma unroll
        for (int i = 0; i < 10; ++i) { RW_IDX(i) (void)gcol;
            const unsigned cur = rc[i], prv = rpv[i], nxt = rnx[i];
            const float m0 = cst[(5 + grp) * 64 + c2], m1 = cst[(5 + grp) * 64 + c2 + 1];
            const float c0 = bflo(cur), c1 = bfhi(cur);
            const float x0 = c0 + m0 * (0.5f * (bflo(prv) + bflo(nxt)) - c0), x1 = c1 + m1 * (0.5f * (bfhi(prv) + bfhi(nxt)) - c1);
            if (grp == 0) { *(LAS f32x2*)(rS + tok * 64 + c2) = (f32x2){x0, x1}; }
            else if (grp == 1) { *(LAS f32x2*)(kS + tok * 64 + c2) = (f32x2){x0, x1}; }
            else if (grp == 2) { *(LAS f32x2*)(vS + tok * 64 + c2) = (f32x2){x0, x1}; }
            else if (grp == 3) { const float e0 = __expf(2.f * x0), e1 = __expf(2.f * x1); *(LAS unsigned*)(wdB + tok * 72 + c2) = pk2(1.f - 2.f * frcp(e0 + 1.f), 1.f - 2.f * frcp(e1 + 1.f)); }
            else { *(LAS unsigned*)(adB + tok * 72 + c2) = pk2(x0, x1); }
        }
        if (dir == 0) {
            const int tok = tid >> 4, c = tid & 15, t = t0 + tok;
            const float cur = bf2f(gcv), prv = bf2f(gpv), nxt = bf2f(gnv);
            const float x = cur + cst[10 * 64 + c] * (0.5f * (prv + nxt) - cur);
            SG[((size_t)b * SEQ + t) * 128 + h * 16 + c] = (bf16_t)f2bf(sigmoidf_(x));
        } }
        __syncthreads();
        if (cc + 1 < 128) { RW_IDS const int t0n = dir ? (126 - cc) * 32 : (cc + 1) * 32; RW_ISSUE(t0n); }
        { RW_IDS const int mat = wid >> 2, ntile = wid & 3; const LAS bf16_t* Aop = mat ? wdB : adB; const LAS bf16_t* Bop = mat ? w2B : a2B; LAS float* pre = mat ? preW : preA;
#pragma unroll
          for (int mt = 0; mt < 2; ++mt) { f32x4 acc = (f32x4){0.f, 0.f, 0.f, 0.f};
#pragma unroll
              for (int ks = 0; ks < 2; ++ks) acc = mfma16(ldsfrag(Bop, 72, ntile * 16, ks * 32, fr, fq), ldsfrag(Aop, 72, mt * 16, ks * 32, fr, fq), acc);
              *(LAS f32x4*)(pre + (mt * 16 + fr) * 64 + ntile * 16 + fq * 4) = acc; } }
        __syncthreads();
        { RW_IDS const int tok = tid >> 4, c0 = (tid & 15) * 4; float kkr[4], av[4], kp[4], wv[4]; float ss = 0.f, bon = 0.f;
#pragma unroll
          for (int i = 0; i < 4; ++i) { const int c = c0 + i, ix = tok * 64 + c;
              const float a = sigmoidf_(cst[c] + preA[ix]); const float sg = sigmoidf_(cst[64 + c] + preW[ix]);
              wv[i] = -0.60653065971f * sg;
              const float kraw = kS[ix]; kkr[i] = kraw * cst[128 + c]; ss += kkr[i] * kkr[i];
              kp[i] = kraw * (1.0f + (a - 1.0f) * cst[192 + c]); av[i] = a; bon += rS[ix] * kp[i] * cst[256 + c]; }
          ss += dppf<0xB1>(ss); bon += dppf<0xB1>(bon); ss += dppf<0x4E>(ss); bon += dppf<0x4E>(bon);
          ss += dppf<0x141>(ss); bon += dppf<0x141>(bon); ss += dppf<0x140>(ss); bon += dppf<0x140>(bon);
          const float inv = frcp(fmaxf(__builtin_amdgcn_sqrtf(ss), 1e-12f));
          f32x4 o_nk, o_b, o_k, o_w;
#pragma unroll
          for (int i = 0; i < 4; ++i) { const float kk = kkr[i] * inv; o_nk[i] = -kk; o_b[i] = kk * av[i]; o_k[i] = kp[i]; o_w[i] = wv[i]; }
          *(LAS f32x4*)(nkS + tok * 64 + c0) = o_nk; *(LAS f32x4*)(bS + tok * 64 + c0) = o_b; *(LAS f32x4*)(kS + tok * 64 + c0) = o_k; *(LAS f32x4*)(wS + tok * 64 + c0) = o_w;
          if (dir == 0 && (tid & 15) == 0) BONUS[((size_t)b * SEQ + t0 + tok) * 8 + h] = bon; }
        __syncthreads();
        { RW_IDS if (tid < 64) { float lw[32];
#pragma unroll
            for (int s = 0; s < 32; ++s) lw[s] = wS[(dir ? 31 - s : s) * 64 + tid];
#pragma unroll
            for (int s = 1; s < 32; ++s) lw[s] += lw[s - 1];
#pragma unroll
            for (int s = 0; s < 32; ++s) wS[(dir ? 31 - s : s) * 64 + tid] = lw[s]; } }
        __syncthreads();
        { RW_IDS const int s = tid >> 4, c0 = (tid & 15) * 4; const int tok = dir ? 31 - s : s, tokp = dir ? tok + 1 : tok - 1;
          const f32x4 cum = *(const LAS f32x4*)(wS + tok * 64 + c0); f32x4 cump = (f32x4){0.f, 0.f, 0.f, 0.f}; if (s > 0) cump = *(const LAS f32x4*)(wS + tokp * 64 + c0);
          const f32x4 nk4 = *(const LAS f32x4*)(nkS + tok * 64 + c0), b4 = *(const LAS f32x4*)(bS + tok * 64 + c0), k4 = *(const LAS f32x4*)(kS + tok * 64 + c0), r4 = *(const LAS f32x4*)(rS + tok * 64 + c0), v4 = *(const LAS f32x4*)(vS + tok * 64 + c0);
          float ta[4], tb[4], tk[4], tr[4];
#pragma unroll
          for (int i = 0; i < 4; ++i) { const float g = __expf(cum[i]), gp = __expf(cump[i]), ig = __expf(-cum[i]);
              ta[i] = nk4[i] * gp; tb[i] = b4[i] * ig; tk[i] = k4[i] * ig; tr[i] = r4[i] * g;
              BtT[(c0 + i) * 40 + s] = (bf16_t)f2bf(tb[i]); KtT[(c0 + i) * 40 + s] = (bf16_t)f2bf(tk[i]); VT[(c0 + i) * 40 + s] = (bf16_t)f2bf(v4[i]);
              if (s == 31) gL[c0 + i] = g; }
          u32x2 w; w.x = pk2(ta[0], ta[1]); w.y = pk2(ta[2], ta[3]); *(LAS u32x2*)(At + s * 72 + c0) = w;
          w.x = pk2(tb[0], tb[1]); w.y = pk2(tb[2], tb[3]); *(LAS u32x2*)(Bt + s * 72 + c0) = w;
          w.x = pk2(tk[0], tk[1]); w.y = pk2(tk[2], tk[3]); *(LAS u32x2*)(Kt + s * 72 + c0) = w;
          w.x = pk2(tr[0], tr[1]); w.y = pk2(tr[2], tr[3]); *(LAS u32x2*)(Rt + s * 72 + c0) = w; }
        __syncthreads();
        { RW_IDS const int mat = wid >> 1, mt = wid & 1; const LAS bf16_t* Aop = (mat < 2) ? At : Rt; const LAS bf16_t* Bop = (mat & 1) ? Kt : Bt;
#pragma unroll
          for (int nt = 0; nt < 2; ++nt) { f32x4 acc = (f32x4){0.f, 0.f, 0.f, 0.f};
#pragma unroll
              for (int ks = 0; ks < 2; ++ks) acc = mfma16(ldsfrag(Bop, 72, nt * 16, ks * 32, fr, fq), ldsfrag(Aop, 72, mt * 16, ks * 32, fr, fq), acc);
              const int srow = mt * 16 + fr;
#pragma unroll
              for (int e = 0; e < 4; ++e) { const int i = nt * 16 + fq * 4 + e; const bool keep = (mat < 2) ? (i < srow) : (i <= srow); if (!keep) acc[e] = 0.f; }
              if (mat == 0) {
#pragma unroll
                  for (int e = 0; e < 4; ++e) NT4[e * 384 + srow * 12 + nt * 4 + fq] = acc[e]; }
              else { LAS bf16_t* X = (mat == 1) ? NakT : (mat == 2) ? MbrT : MkrT; u32x2 o; o.x = pk2(acc[0], acc[1]); o.y = pk2(acc[2], acc[3]); *(LAS u32x2*)(X + srow * 40 + nt * 16 + fq * 4) = o; } } }
        __syncthreads();
        f32x4 oacc = (f32x4){0.f, 0.f, 0.f, 0.f};
        { RW_IDS f32x4 wacc = (f32x4){0.f, 0.f, 0.f, 0.f};
#pragma unroll
          for (int ks = 0; ks < 2; ++ks) { const bf16x8 sf = ldsfrag(S0b, 72, vt * 16, ks * 32, fr, fq);
              wacc = mfma16(ldsfrag(At, 72, tt2 * 16, ks * 32, fr, fq), sf, wacc); oacc = mfma16(ldsfrag(Rt, 72, tt2 * 16, ks * 32, fr, fq), sf, oacc); }
          const bf16x8 vf = ldsfrag(VT, 40, vt * 16, 0, fr, fq);
          wacc = mfma16(ldsfrag(NakT, 40, tt2 * 16, 0, fr, fq), vf, wacc); oacc = mfma16(ldsfrag(MkrT, 40, tt2 * 16, 0, fr, fq), vf, oacc);
#pragma unroll
          for (int n2 = 0; n2 < 2; ++n2) st[n2] = mfma16(ldsfrag(KtT, 40, (tt2 * 2 + n2) * 16, 0, fr, fq), vf, st[n2]);
#pragma unroll
          for (int e = 0; e < 4; ++e) WS[(tt2 * 16 + fq * 4 + e) * 64 + vt * 16 + fr] = wacc[e]; }
        __syncthreads();
        { RW_IDS if (wid < 4) { const int v = wid * 16 + (lane >> 2), p = lane & 3; const LAS float* NTp = NT4 + p * 384; float u[8];
#pragma unroll
            for (int j = 0; j < 8; ++j) u[j] = 0.f;
#pragma unroll
            for (int t = 0; t < 32; ++t) { float q0 = (p == 0) ? WS[t * 64 + v] : 0.f, q1 = 0.f;
#pragma unroll
                for (int j4 = 0; j4 < ((t + 3) / 4 + 3) / 4; ++j4) { const f32x4 nv = *(const LAS f32x4*)(NTp + t * 12 + j4 * 4);
                    q0 += u[j4 * 4] * nv[0]; q1 += u[j4 * 4 + 1] * nv[1]; q0 += u[j4 * 4 + 2] * nv[2]; q1 += u[j4 * 4 + 3] * nv[3]; }
                float q = q0 + q1; q += dppf<0xB1>(q); q += dppf<0x4E>(q);
                u[t >> 2] = ((t & 3) == p) ? q : u[t >> 2]; asm volatile("" ::: "memory"); }
#pragma unroll
            for (int j = 0; j < 8; ++j) Ub[v * 40 + 4 * j + p] = (bf16_t)f2bf(u[j]); } }
        __syncthreads();
        { RW_IDS const bf16x8 uf = ldsfrag(Ub, 40, vt * 16, 0, fr, fq);
          oacc = mfma16(ldsfrag(MbrT, 40, tt2 * 16, 0, fr, fq), uf, oacc);
#pragma unroll
          for (int e = 0; e < 4; ++e) { const int sidx = tt2 * 16 + fq * 4 + e, tok = dir ? 31 - sidx : sidx;
              ORW[(size_t)dir * T * 512 + ((size_t)b * SEQ + t0 + tok) * 512 + h * 64 + vt * 16 + fr] = (bf16_t)f2bf(oacc[e]); }
#pragma unroll
          for (int n2 = 0; n2 < 2; ++n2) { const int kt = tt2 * 2 + n2; st[n2] = mfma16(ldsfrag(BtT, 40, kt * 16, 0, fr, fq), uf, st[n2]);
              const f32x4 gl = *(const LAS f32x4*)(gL + kt * 16 + fq * 4); st[n2] = st[n2] * gl;
              u32x2 o; o.x = pk2(st[n2][0], st[n2][1]); o.y = pk2(st[n2][2], st[n2][3]); *(LAS u32x2*)(S0b + (vt * 16 + fr) * 72 + kt * 16 + fq * 4) = o; } }
    }
#undef RW_IDX
#undef RW_ISSUE
#undef RW_IDS
#undef RW_CG
    __syncthreads();
}

__device__ __forceinline__ void rwkv_combine(const bf16_t* P0, const bf16_t* ORW, const float* BONUS, const bf16_t* G, const float* mu, const float* gn_w, const float* gn_b, bf16_t* OMIX, int gw, int NGW, int lane) {
    const int c0 = lane * 8, head = lane >> 3;
    float muv[8], gw8[8], gb8[8];
#pragma unroll
    for (int i = 0; i < 8; ++i) { muv[i] = mu[1024 + c0 + i]; gw8[i] = gn_w[c0 + i]; gb8[i] = gn_b[c0 + i]; }
#pragma unroll 2
    for (int tk = gw; tk < T; tk += NGW) {
        const int t = tk & (SEQ - 1);
        const u32x4 uf = *(const u32x4*)(ORW + (size_t)tk * 512 + c0), ub = *(const u32x4*)(ORW + (size_t)T * 512 + (size_t)tk * 512 + c0);
        float o[8];
#pragma unroll
        for (int i = 0; i < 4; ++i) { o[2 * i] = bflo(uf[i]) + bflo(ub[i]); o[2 * i + 1] = bfhi(uf[i]) + bfhi(ub[i]); }
        float s = 0.f;
#pragma unroll
        for (int i = 0; i < 8; ++i) s += o[i];
        const float mean = sum8(s) * (1.f / 64.f); float q = 0.f;
#pragma unroll
        for (int i = 0; i < 8; ++i) { o[i] -= mean; q += o[i] * o[i]; }
        const float rstd = rsqrtf(sum8(q) * (1.f / 64.f) + 64e-5f);
        const bf16_t* pv = P0 + (size_t)tk * ABPAD + 1024 + c0;
        const u32x4 vc = *(const u32x4*)pv; u32x4 vp = (u32x4){0u, 0u, 0u, 0u}, vn = (u32x4){0u, 0u, 0u, 0u};
        if (t > 0) vp = *(const u32x4*)(pv - ABPAD);
        if (t < SEQ - 1) vn = *(const u32x4*)(pv + ABPAD);
        const u32x4 gg = *(const u32x4*)(G + (size_t)tk * 512 + c0);
        const float bon = BONUS[(size_t)tk * 8 + head];
        float r[8];
#pragma unroll
        for (int i = 0; i < 4; ++i) {
            const float c_lo = bflo(vc[i]), c_hi = bfhi(vc[i]);
            const float v_lo = c_lo + muv[2 * i] * (0.5f * (bflo(vp[i]) + bflo(vn[i])) - c_lo), v_hi = c_hi + muv[2 * i + 1] * (0.5f * (bfhi(vp[i]) + bfhi(vn[i])) - c_hi);
            r[2 * i] = (o[2 * i] * rstd * gw8[2 * i] + gb8[2 * i] + bon * v_lo) * bflo(gg[i]);
            r[2 * i + 1] = (o[2 * i + 1] * rstd * gw8[2 * i + 1] + gb8[2 * i + 1] + bon * v_hi) * bfhi(gg[i]); }
        u32x4 w; w.x = pk2(r[0], r[1]); w.y = pk2(r[2], r[3]); w.z = pk2(r[4], r[5]); w.w = pk2(r[6], r[7]);
        *(u32x4*)(OMIX + (size_t)tk * D + c0) = w;
    }
}

constexpr int SLD = 136;
__device__ __forceinline__ float softplusf_(float x) { return x > 20.f ? x : log1pf(__expf(x)); }
__device__ __forceinline__ void ssd_dt_cum(LAS float* dtS, LAS float* cumS, LAS float* totS, const bf16_t* Prow0, int g, int w, int lane, const float* dt_bias, const float* a_log) {
    const int j = w >> 1, d = w & 1, head = g * 4 + j;
    const float bias = dt_bias[d * 8 + head], A = -__expf(a_log[d * 8 + head]);
    const float x0 = bf2f(Prow0[(size_t)(2 * lane) * ABPAD + 3328 + head]), x1 = bf2f(Prow0[(size_t)(2 * lane + 1) * ABPAD + 3328 + head]);
    const float dt0 = softplusf_(x0 + bias), dt1 = softplusf_(x1 + bias), la0 = dt0 * A, la1 = dt1 * A;
    const float s = la0 + la1; float inc = s;
#pragma unroll
    for (int off = 1; off < 64; off <<= 1) { const float n = __shfl_up(inc, off); if (lane >= off) inc += n; }
    const float tot = __shfl(inc, 63), exc = inc - s;
    float c0, c1; if (d == 0) { c0 = exc + la0; c1 = inc; } else { c0 = tot - exc; c1 = tot - exc - la0; }
    dtS[w * 128 + 2 * lane] = dt0; dtS[w * 128 + 2 * lane + 1] = dt1; cumS[w * 128 + 2 * lane] = c0; cumS[w * 128 + 2 * lane + 1] = c1;
    if (lane == 0) totS[w] = tot;
}
template <int NR, bool TR> __device__ __forceinline__ void ssd_conv8(LAS bf16_t* dst, int col0, int cx0, int l0, const bf16_t* Pb, int t0, const float* cw, const float* cb) {
    u32x4 raw[NR + 2];
    const bf16_t* p = Pb + (size_t)(t0 + l0) * ABPAD + 2304 + cx0;
#pragma unroll
    for (int i = 0; i < NR + 2; ++i) { const int t = t0 + l0 + i - 1; raw[i] = (t >= 0 && t < SEQ) ? *(const u32x4*)(p + (long)(i - 1) * ABPAD) : (u32x4){0u, 0u, 0u, 0u}; }
    float w0[8], w1[8], w2[8], bs[8];
#pragma unroll
    for (int q = 0; q < 2; ++q) { const f32x4 a = *(const f32x4*)(cw + cx0 + 4 * q), bq = *(const f32x4*)(cw + 1024 + cx0 + 4 * q), c = *(const f32x4*)(cw + 2048 + cx0 + 4 * q), d = *(const f32x4*)(cb + cx0 + 4 * q);
#pragma unroll
        for (int i = 0; i < 4; ++i) { w0[4 * q + i] = a[i]; w1[4 * q + i] = bq[i]; w2[4 * q + i] = c[i]; bs[4 * q + i] = d[i]; } }
    float o[NR][8];
#pragma unroll
    for (int i = 0; i < NR; ++i)
#pragma unroll
        for (int c = 0; c < 8; ++c) { const unsigned um = raw[i][c >> 1], u0 = raw[i + 1][c >> 1], up = raw[i + 2][c >> 1];
            const float fm = (c & 1) ? bfhi(um) : bflo(um), f0 = (c & 1) ? bfhi(u0) : bflo(u0), fp = (c & 1) ? bfhi(up) : bflo(up);
            o[i][c] = siluf_(w0[c] * fm + w1[c] * f0 + w2[c] * fp + bs[c]); }
    if (TR) {
#pragma unroll
        for (int c = 0; c < 8; ++c) { LAS bf16_t* q = dst + (col0 + c) * SLD + l0;
            if (NR == 8) { u32x4 w; w.x = pk2(o[0][c], o[1][c]); w.y = pk2(o[2][c], o[3][c]); w.z = pk2(o[4 % NR][c], o[5 % NR][c]); w.w = pk2(o[6 % NR][c], o[7 % NR][c]); *(LAS u32x4*)q = w; }
            else { u32x2 w; w.x = pk2(o[0][c], o[1][c]); w.y = pk2(o[2][c], o[3][c]); *(LAS u32x2*)q = w; } }
    } else {
#pragma unroll
        for (int i = 0; i < NR; ++i) { u32x4 w; w.x = pk2(o[i][0], o[i][1]); w.y = pk2(o[i][2], o[i][3]); w.z = pk2(o[i][4], o[i][5]); w.w = pk2(o[i][6], o[i][7]); *(LAS u32x4*)(dst + (l0 + i) * SLD + col0) = w; }
    }
}
__device__ __forceinline__ void ssd_s1_unit(LAS unsigned char* lds, int unit, const bf16_t* P0, const float* cw, const float* cb, const float* dt_bias, const float* a_log, bf16_t* STATES, float* TOT) {
    const int tid = threadIdx.x, lane = tid & 63, w = tid >> 6, fr = lane & 15, fq = lane >> 4;
    const int g = unit & 1, c = (unit >> 1) & 31, b = unit >> 6, t0 = c * 128;
    LAS bf16_t* BT = (LAS bf16_t*)lds; LAS bf16_t* XT = (LAS bf16_t*)(lds + 34816); LAS float* dtS = (LAS float*)(lds + 104448); LAS float* cumS = (LAS float*)(lds + 108544);
    LAS float* scS = (LAS float*)(lds + 112640); LAS float* totS = (LAS float*)(lds + 116736);
    const bf16_t* Pb = P0 + (size_t)b * SEQ * ABPAD;
    __syncthreads();
    ssd_conv8<4, true>(BT, (tid & 15) * 8, 512 + g * 128 + (tid & 15) * 8, (tid >> 4) * 4, Pb, t0, cw, cb);
    ssd_conv8<8, true>(XT, (tid & 31) * 8, g * 256 + (tid & 31) * 8, (tid >> 5) * 8, Pb, t0, cw, cb);
    ssd_dt_cum(dtS, cumS, totS, Pb + (size_t)t0 * ABPAD, g, w, lane, dt_bias, a_log);
    __syncthreads();
    for (int e = tid; e < 1024; e += 512) scS[e] = dtS[e] * __expf(totS[e >> 7] - cumS[e]);
    if (tid < 8) TOT[((size_t)(b * 32 + c) * 2 + (tid & 1)) * 8 + g * 4 + (tid >> 1)] = totS[tid];
    __syncthreads();
    const int j = w >> 1;
#pragma unroll 1
    for (int d = 0; d < 2; ++d) {
        f32x4 acc[2][8];
#pragma unroll
        for (int mt = 0; mt < 2; ++mt)
#pragma unroll
            for (int nt = 0; nt < 8; ++nt) acc[mt][nt] = (f32x4){0.f, 0.f, 0.f, 0.f};
#pragma unroll 1
        for (int ks = 0; ks < 4; ++ks) {
            const int k0 = ks * 32; const LAS float* sp = scS + (j * 2 + d) * 128 + k0 + fq * 8;
            const f32x4 s0 = *(const LAS f32x4*)sp, s1 = *(const LAS f32x4*)(sp + 4);
            bf16x8 afr[2];
#pragma unroll
            for (int mt = 0; mt < 2; ++mt) { const u32x4 raw = *(const LAS u32x4*)(XT + (32 * w + mt * 16 + fr) * SLD + k0 + fq * 8); u32x4 o;
                o.x = pk2(bflo(raw.x) * s0[0], bfhi(raw.x) * s0[1]); o.y = pk2(bflo(raw.y) * s0[2], bfhi(raw.y) * s0[3]);
                o.z = pk2(bflo(raw.z) * s1[0], bfhi(raw.z) * s1[1]); o.w = pk2(bflo(raw.w) * s1[2], bfhi(raw.w) * s1[3]);
                afr[mt] = __builtin_bit_cast(bf16x8, o); }
#pragma unroll
            for (int nt = 0; nt < 8; ++nt) { const bf16x8 bfr = ldsfrag(BT, SLD, nt * 16, k0, fr, fq);
#pragma unroll
                for (int mt = 0; mt < 2; ++mt) acc[mt][nt] = mfma16(bfr, afr[mt], acc[mt][nt]); }
        }
        bf16_t* dst = STATES + (((size_t)(b * 32 + c) * 2 + d) * 8 + g * 4 + j) * 8192;
#pragma unroll
        for (int mt = 0; mt < 2; ++mt) { const int p = (w & 1) * 32 + mt * 16 + fr;
#pragma unroll
            for (int nt = 0; nt < 8; ++nt) { u32x2 o; o.x = pk2(acc[mt][nt][0], acc[mt][nt][1]); o.y = pk2(acc[mt][nt][2], acc[mt][nt][3]);
                *(u32x2*)(dst + p * 128 + nt * 16 + fq * 4) = o; } }
    }
}
__device__ __forceinline__ void ssd_s2(const bf16_t* __restrict__ STATES, bf16_t* __restrict__ CARR, const float* __restrict__ TOT, int gtid, int NGT) {
    for (int it = gtid; it < 16 * 2 * 8 * 1024; it += NGT) {
        const int e8 = it & 1023, head = (it >> 10) & 7, d = (it >> 13) & 1, b = it >> 14;
        float run[8];
#pragma unroll
        for (int i = 0; i < 8; ++i) run[i] = 0.f;
#pragma unroll 1
        for (int c8 = 0; c8 < 32; c8 += 8) {
            u32x4 loc[8]; float dec[8];
#pragma unroll
            for (int q = 0; q < 8; ++q) { const int cc = c8 + q, c = d ? 31 - cc : cc; const size_t sidx = ((size_t)(b * 32 + c) * 2 + d) * 8 + head;
                loc[q] = *(const u32x4*)(STATES + sidx * 8192 + e8 * 8); dec[q] = TOT[sidx]; }
#pragma unroll
            for (int q = 0; q < 8; ++q) { const int cc = c8 + q, c = d ? 31 - cc : cc; const size_t sidx = ((size_t)(b * 32 + c) * 2 + d) * 8 + head;
                u32x4 o; o.x = pk2(run[0], run[1]); o.y = pk2(run[2], run[3]); o.z = pk2(run[4], run[5]); o.w = pk2(run[6], run[7]); *(u32x4*)(CARR + sidx * 8192 + e8 * 8) = o;
                const float dq = __expf(dec[q]);
#pragma unroll
                for (int i = 0; i < 4; ++i) { run[2 * i] = run[2 * i] * dq + bflo(loc[q][i]); run[2 * i + 1] = run[2 * i + 1] * dq + bfhi(loc[q][i]); } }
        }
    }
}
__device__ __forceinline__ void ssd_s3_unit(LAS unsigned char* lds, int unit, const bf16_t* P0, const float* cw, const float* cb, const float* dt_bias, const float* a_log, const float* dskip, const float* norm_w,
                                            const bf16_t* STATES, bf16_t* OMIX) {
    const int tid = threadIdx.x, lane = tid & 63, w = tid >> 6, fr = lane & 15, fq = lane >> 4;
    const int g = unit & 1, c = (unit >> 1) & 31, b = unit >> 6, t0 = c * 128;
    LAS bf16_t* CS = (LAS bf16_t*)lds; LAS bf16_t* BS = (LAS bf16_t*)(lds + 34816); LAS bf16_t* XT = (LAS bf16_t*)(lds + 69632);
    LAS float* dtS = (LAS float*)(lds + 139264); LAS float* cumS = (LAS float*)(lds + 143360); LAS float* totS = (LAS float*)(lds + 147456);
    const bf16_t* Pb = P0 + (size_t)b * SEQ * ABPAD;
    __syncthreads();
    ssd_conv8<4, false>(BS, (tid & 15) * 8, 512 + g * 128 + (tid & 15) * 8, (tid >> 4) * 4, Pb, t0, cw, cb);
    ssd_conv8<4, false>(CS, (tid & 15) * 8, 768 + g * 128 + (tid & 15) * 8, (tid >> 4) * 4, Pb, t0, cw, cb);
    ssd_conv8<8, true>(XT, (tid & 31) * 8, g * 256 + (tid & 31) * 8, (tid >> 5) * 8, Pb, t0, cw, cb);
    ssd_dt_cum(dtS, cumS, totS, Pb + (size_t)t0 * ABPAD, g, w, lane, dt_bias, a_log);
    __syncthreads();
    const int l = 16 * w + fr;
    f32x4 sc[8];
#pragma unroll
    for (int nt = 0; nt < 8; ++nt) sc[nt] = (f32x4){0.f, 0.f, 0.f, 0.f};
#pragma unroll
    for (int ks = 0; ks < 4; ++ks) { const bf16x8 afr = ldsfrag(CS, SLD, 16 * w, ks * 32, fr, fq);
#pragma unroll
        for (int nt = 0; nt < 8; ++nt) sc[nt] = mfma16(ldsfrag(BS, SLD, nt * 16, ks * 32, fr, fq), afr, sc[nt]); }
    __syncthreads();
    LAS bf16_t* Mw = BS + w * 16 * SLD;
    const size_t row = (size_t)b * SEQ + t0 + l; float ss = 0.f;
#pragma unroll 1
    for (int j = 0; j < 4; ++j) {
        const LAS float* cf = cumS + (j * 2) * 128; const LAS float* cbw = cumS + (j * 2 + 1) * 128; const LAS float* df = dtS + (j * 2) * 128; const LAS float* db = dtS + (j * 2 + 1) * 128;
        const float cfl = cf[l], cbl = cbw[l];
        const size_t sbase = ((size_t)(b * 32 + c) * 2) * 8 + g * 4 + j;
        const bf16_t* carf = STATES + sbase * 8192; const bf16_t* carb = STATES + (sbase + 8) * 8192;
        bf16x8 cF[4][4], cB[4][4]; u32x2 zz4[4];
#pragma unroll
        for (int ks = 0; ks < 4; ++ks)
#pragma unroll
            for (int pt = 0; pt < 4; ++pt) cF[ks][pt] = *(const bf16x8*)(carf + (pt * 16 + fr) * 128 + ks * 32 + fq * 8);
#pragma unroll
        for (int pt = 0; pt < 4; ++pt) zz4[pt] = *(const u32x2*)(P0 + row * ABPAD + 1792 + g * 256 + j * 64 + pt * 16 + fq * 4);
#pragma unroll
        for (int nt = 0; nt < 8; ++nt) { float mv[4];
#pragma unroll
            for (int i = 0; i < 4; ++i) { const int s = nt * 16 + fq * 4 + i;
                const float ff = (s <= l) ? __expf(cfl - cf[s]) * df[s] : 0.f; const float fb = (s >= l) ? __expf(cbl - cbw[s]) * db[s] : 0.f;
                mv[i] = sc[nt][i] * (ff + fb); }
            u32x2 o; o.x = pk2(mv[0], mv[1]); o.y = pk2(mv[2], mv[3]); *(LAS u32x2*)(Mw + fr * SLD + nt * 16 + fq * 4) = o; }
        LDS_WAIT();
#pragma unroll
        for (int ks = 0; ks < 4; ++ks)
#pragma unroll
            for (int pt = 0; pt < 4; ++pt) cB[ks][pt] = *(const bf16x8*)(carb + (pt * 16 + fr) * 128 + ks * 32 + fq * 8);
        f32x4 yd[4], yf[4], yb[4];
#pragma unroll
        for (int pt = 0; pt < 4; ++pt) { yd[pt] = (f32x4){0.f, 0.f, 0.f, 0.f}; yf[pt] = yd[pt]; yb[pt] = yd[pt]; }
        bf16x8 acs[4];
#pragma unroll
        for (int ks = 0; ks < 4; ++ks) {
            const bf16x8 am = *(const LAS bf16x8*)(Mw + fr * SLD + ks * 32 + fq * 8); acs[ks] = ldsfrag(CS, SLD, 16 * w, ks * 32, fr, fq);
#pragma unroll
            for (int pt = 0; pt < 4; ++pt) {
                yd[pt] = mfma16(ldsfrag(XT, SLD, j * 64 + pt * 16, ks * 32, fr, fq), am, yd[pt]);
                yf[pt] = mfma16(cF[ks][pt], acs[ks], yf[pt]); }
        }
#pragma unroll
        for (int ks = 0; ks < 4; ++ks)
#pragma unroll
            for (int pt = 0; pt < 4; ++pt) yb[pt] = mfma16(cB[ks][pt], acs[ks], yb[pt]);
        const float ef = __expf(cfl), eb = __expf(cbl), dsk = dskip[g * 4 + j];
#pragma unroll
        for (int pt = 0; pt < 4; ++pt) { const f32x4 yv = yd[pt] + yf[pt] * ef + yb[pt] * eb;
            const int col = j * 64 + pt * 16 + fq * 4; const u32x2 zz = zz4[pt];
            const float z4[4] = {bflo(zz.x), bfhi(zz.x), bflo(zz.y), bfhi(zz.y)}; float v4[4];
#pragma unroll
            for (int i = 0; i < 4; ++i) { const float xs = bf2f(XT[(col + i) * SLD + l]); float v = yv[i] + dsk * xs; const float z = z4[i]; v = v * siluf_(z);
                v4[i] = v; ss += v * v; }
            u32x2 o; o.x = pk2(v4[0], v4[1]); o.y = pk2(v4[2], v4[3]); *(u32x2*)(OMIX + row * D + 512 + g * 256 + col) = o; }
        asm volatile("" ::: "memory");
    }
    ss += __shfl_xor(ss, 16); ss += __shfl_xor(ss, 32);
    const float rs = rsqrtf(ss * (1.f / 256.f) + 1e-6f);
    asm volatile("s_waitcnt vmcnt(0)" ::: "memory");
#pragma unroll 4
    for (int q = 0; q < 16; ++q) { const int col = g * 256 + q * 16 + fq * 4; const f32x4 nw = *(const f32x4*)(norm_w + col);
        u32x2* p = (u32x2*)(OMIX + row * D + 512 + col); const u32x2 v = *p;
        u32x2 o; o.x = pk2(bflo(v.x) * rs * nw[0], bfhi(v.x) * rs * nw[1]); o.y = pk2(bflo(v.y) * rs * nw[2], bfhi(v.y) * rs * nw[3]); *p = o; }
}

constexpr int HLD = 136, HLS = 72;
__device__ __forceinline__ void hgrn_chain(LAS unsigned char* lds, int cid, bf16_t* P1, const float* hg_lb, bf16_t* Ob, int ldo, int ocbase, int ocdir) {
    const int tid = threadIdx.x, lane = tid & 63, w = tid >> 6, fr = lane & 15, fq = lane >> 4;
    const int b = cid >> 4, h = (cid >> 1) & 7, dir = cid & 1;
    LAS bf16_t* QE = (LAS bf16_t*)lds;
    LAS bf16_t* KE = (LAS bf16_t*)(lds + 17408);
    LAS bf16_t* KLT = (LAS bf16_t*)(lds + 34816);
    LAS bf16_t* VT = (LAS bf16_t*)(lds + 53248);
    LAS bf16_t* AT = (LAS bf16_t*)(lds + 71680);
    LAS bf16_t* ST = (LAS bf16_t*)(lds + 80896);
    LAS float* totS = (LAS float*)(lds + 115712);
    LAS float* lastS = (LAS float*)(lds + 117760);
    __syncthreads();
    for (int e = tid; e < 128 * HLD / 2; e += 512) ((LAS unsigned*)ST)[e] = 0u;
    const int dcol = tid & 127, qtr = tid >> 7, i0 = qtr * 16;
    const float lbv = frcp(1.0f + __expf(hg_lb[h * 128 + dcol] - hg_lb[1024 + h * 128 + dcol]));
    f32x4 st[8];
#pragma unroll
    for (int i = 0; i < 8; ++i) st[i] = (f32x4){0.f, 0.f, 0.f, 0.f};
    bf16_t* Pb = P1 + (size_t)b * SEQ * HGP;
    __syncthreads();
    unsigned short rq[16], rf[16], rv[16];
#define HG_ISSUE(t0n) do { _Pragma("unroll") for (int i = 0; i < 16; ++i) { const int tk = (t0n) + (dir ? 63 - (i0 + i) : (i0 + i)); const bf16_t* pr = Pb + (size_t)tk * HGP + h * 128 + dcol; \
        rq[i] = pr[0]; rf[i] = pr[1024 * (1 + dir)]; rv[i] = pr[3072]; } } while (0)
    HG_ISSUE((dir ? 63 : 0) * 64);
    for (int cc = 0; cc < 64; ++cc) {
        const int t0 = (dir ? 63 - cc : cc) * 64;
        float gq[16], gk[16], gc[16]; float run = 0.f;
#pragma unroll
        for (int i = 0; i < 16; ++i) { const float q = bf2f(rq[i]), fr_ = bf2f(rf[i]);
            const float f = lbv + (1.0f - lbv) * sigmoidf_(fr_); run += __logf(f); gq[i] = q; gk[i] = 1.0f - f; gc[i] = run; }
        totS[qtr * 128 + dcol] = run;
#pragma unroll
        for (int i = 0; i < 16; i += 2) *(LAS unsigned*)(VT + dcol * HLS + i0 + i) = (unsigned)rv[i] | ((unsigned)rv[i + 1] << 16);
        __syncthreads();
        { float pre = 0.f, tot = 0.f;
#pragma unroll
          for (int q4 = 0; q4 < 4; ++q4) { const float tq = totS[q4 * 128 + dcol]; if (q4 < qtr) pre += tq; tot += tq; }
          const float etot = __expf(tot);
          if (qtr == 0) lastS[dcol] = etot;
#pragma unroll
          for (int i = 0; i < 16; i += 2) { const float b0 = pre + gc[i], b1 = pre + gc[i + 1];
              const float e0 = __expf(b0), e1 = __expf(b1), n0 = frcp(e0), n1 = frcp(e1), l0 = etot * n0, l1 = etot * n1;
              QE[(i0 + i) * HLD + dcol] = (bf16_t)f2bf(gq[i] * e0); QE[(i0 + i + 1) * HLD + dcol] = (bf16_t)f2bf(gq[i + 1] * e1);
              KE[(i0 + i) * HLD + dcol] = (bf16_t)f2bf(gk[i] * n0); KE[(i0 + i + 1) * HLD + dcol] = (bf16_t)f2bf(gk[i + 1] * n1);
              *(LAS unsigned*)(KLT + dcol * HLS + i0 + i) = pk2(gk[i] * l0, gk[i + 1] * l1); } }
        if (cc + 1 < 64) HG_ISSUE((dir ? 62 - cc : cc + 1) * 64);
        __syncthreads();
        { const int mt = w >> 1;
#pragma unroll
          for (int n2 = 0; n2 < 2; ++n2) { const int nt = (w & 1) * 2 + n2; f32x4 acc = (f32x4){0.f, 0.f, 0.f, 0.f};
#pragma unroll
              for (int ks = 0; ks < 4; ++ks) acc = mfma16(ldsfrag(KE, HLD, nt * 16, ks * 32, fr, fq), ldsfrag(QE, HLD, mt * 16, ks * 32, fr, fq), acc);
              const int lrow = mt * 16 + fr; float mv[4];
#pragma unroll
              for (int i = 0; i < 4; ++i) { const int s = nt * 16 + fq * 4 + i; mv[i] = (s <= lrow) ? acc[i] : 0.f; }
              u32x2 o; o.x = pk2(mv[0], mv[1]); o.y = pk2(mv[2], mv[3]); *(LAS u32x2*)(AT + lrow * HLS + nt * 16 + fq * 4) = o; } }
        __syncthreads();
        { const int mt = w >> 1;
#pragma unroll
          for (int n4 = 0; n4 < 4; ++n4) { const int nt = (w & 1) * 4 + n4; f32x4 acc = (f32x4){0.f, 0.f, 0.f, 0.f};
#pragma unroll
              for (int ks = 0; ks < 2; ++ks) acc = mfma16(ldsfrag(VT, HLS, nt * 16, ks * 32, fr, fq), ldsfrag(AT, HLS, mt * 16, ks * 32, fr, fq), acc);
#pragma unroll
              for (int ks = 0; ks < 4; ++ks) acc = mfma16(ldsfrag(ST, HLD, nt * 16, ks * 32, fr, fq), ldsfrag(QE, HLD, mt * 16, ks * 32, fr, fq), acc);
              const int i = mt * 16 + fr, tk = t0 + (dir ? 63 - i : i);
              u32x2 o; o.x = pk2(acc[0], acc[1]); o.y = pk2(acc[2], acc[3]);
              *(u32x2*)(Ob + ((size_t)b * SEQ + tk) * ldo + ocbase + ocdir * dir + h * 128 + nt * 16 + fq * 4) = o; } }
#pragma unroll
        for (int nt = 0; nt < 8; ++nt) { const f32x4 el = *(const LAS f32x4*)(lastS + nt * 16 + fq * 4); st[nt] = st[nt] * el;
#pragma unroll
            for (int ks = 0; ks < 2; ++ks) st[nt] = mfma16(ldsfrag(KLT, HLS, nt * 16, ks * 32, fr, fq), ldsfrag(VT, HLS, w * 16, ks * 32, fr, fq), st[nt]); }
        __syncthreads();
#pragma unroll
        for (int nt = 0; nt < 8; ++nt) { u32x2 o; o.x = pk2(st[nt][0], st[nt][1]); o.y = pk2(st[nt][2], st[nt][3]); *(LAS u32x2*)(ST + (w * 16 + fr) * HLD + nt * 16 + fq * 4) = o; }
    }
    __syncthreads();
}
__device__ __forceinline__ void hgrn_combine(const bf16_t* P1, const float* norm_w, bf16_t* OMIX, int gw, int NGW, int lane) {
    const int c0 = lane * 16;
#pragma unroll 2
    for (int tk = gw; tk < T; tk += NGW) {
        const bf16_t* pr = P1 + (size_t)tk * HGP + c0; float o[16]; float ss = 0.f;
#pragma unroll
        for (int hh = 0; hh < 2; ++hh) { const u32x4 uf = *(const u32x4*)(pr + 1024 + hh * 8), ub = *(const u32x4*)(pr + 2048 + hh * 8);
#pragma unroll
            for (int i = 0; i < 4; ++i) { o[hh * 8 + 2 * i] = bflo(uf[i]) + bflo(ub[i]); o[hh * 8 + 2 * i + 1] = bfhi(uf[i]) + bfhi(ub[i]); } }
#pragma unroll
        for (int i = 0; i < 16; ++i) ss += o[i] * o[i];
        const float rs = rsqrtf(sum8(ss) * (1.f / 128.f) + 1e-6f);
#pragma unroll
        for (int hh = 0; hh < 2; ++hh) { const u32x4 ug = *(const u32x4*)(pr + 4096 + hh * 8); float r[8];
#pragma unroll
            for (int i = 0; i < 4; ++i) { const float g0 = bflo(ug[i]), g1 = bfhi(ug[i]);
                r[2 * i] = o[hh * 8 + 2 * i] * rs * norm_w[c0 + hh * 8 + 2 * i] * siluf_(g0);
                r[2 * i + 1] = o[hh * 8 + 2 * i + 1] * rs * norm_w[c0 + hh * 8 + 2 * i + 1] * siluf_(g1); }
            u32x4 wv; wv.x = pk2(r[0], r[1]); wv.y = pk2(r[2], r[3]); wv.z = pk2(r[4], r[5]); wv.w = pk2(r[6], r[7]);
            *(u32x4*)(OMIX + (size_t)tk * D + c0 + hh * 8) = wv; }
    }
}

#define XB_TMO      128
#define XB_XCNT(j)  (256  + 64 * (j))
#define XB_XSUB(j)  (1280 + 64 * (j))
#define XB_XGEN(j)  (2304 + 64 * (j))
#define XB_TOP      3328
#define XB_TOPGEN   3392
#define XCD_BAR_WORDS 3456
#define XB_SPIN_CAP (1u << 18)

__device__ __forceinline__ unsigned xb_ld(unsigned* p)              { return __hip_atomic_load(p, __ATOMIC_RELAXED, __HIP_MEMORY_SCOPE_AGENT); }
__device__ __forceinline__ unsigned xb_add(unsigned* p, unsigned v) { return __hip_atomic_fetch_add(p, v, __ATOMIC_RELAXED, __HIP_MEMORY_SCOPE_AGENT); }
__device__ __forceinline__ unsigned xb_xcc_id() { return (unsigned)__builtin_amdgcn_s_getreg((3 << 11) | 20) & 0xFu; }
#define XB_SPIN(cond, bar) do { unsigned _sp = 0; while (cond) { __builtin_amdgcn_s_sleep(1); \
    if ((++_sp & 255u) == 0u) { if (xb_ld(&(bar)[XB_TMO])) break; if (_sp > XB_SPIN_CAP) { atomicAdd(&(bar)[XB_TMO], 1u); break; } } } } while (0)

struct XcdBarrier {
    unsigned* bar; unsigned x;
    volatile LAS unsigned* st;
};

__device__ __forceinline__ XcdBarrier xcd_barrier_post(unsigned* bar, volatile LAS unsigned* st) {
    XcdBarrier b; b.bar = bar; b.x = xb_xcc_id(); b.st = st;
    if (threadIdx.x == 0) (void)xb_add(&bar[XB_XCNT(b.x)], 1u);
    return b;
}
__device__ __forceinline__ void xcd_barrier_complete(unsigned* bar, unsigned x, unsigned& nloc, unsigned& nx) {
    const unsigned G = gridDim.x * gridDim.y * gridDim.z;
    unsigned sum, cnt, mine, sp = 0u;
    for (;;) {
        sum = 0u; cnt = 0u; mine = 0u;
#pragma unroll
        for (unsigned j = 0; j < 16; ++j) { const unsigned c = xb_ld(&bar[XB_XCNT(j)]); sum += c; cnt += (c > 0u) ? 1u : 0u; mine = (j == x) ? c : mine; }
        if (sum == G) break;
        __builtin_amdgcn_s_sleep(1);
        if ((++sp & 255u) == 0u) { if (xb_ld(&bar[XB_TMO])) break; if (sp > XB_SPIN_CAP) { atomicAdd(&bar[XB_TMO], 1u); break; } }
    }
    nloc = mine > 0u ? mine : 1u; nx = cnt > 0u ? cnt : 1u;
}

__device__ __forceinline__ void xcd_barrier(const XcdBarrier& b) {
    asm volatile("s_waitcnt vmcnt(0)" ::: "memory");
    __syncthreads();
    if (threadIdx.x == 0) {
        unsigned* bar = b.bar;
        __builtin_amdgcn_s_waitcnt(0);
        unsigned nloc = b.st[0], nx = b.st[1];
        if (nloc == 0u) { xcd_barrier_complete(bar, b.x, nloc, nx); b.st[0] = nloc; b.st[1] = nx; }
        const unsigned old = xb_add(&bar[XB_XSUB(b.x)], 1u);
        const unsigned gen = old / nloc;
        if (old + 1u == (gen + 1u) * nloc) {
            __builtin_amdgcn_fence(__ATOMIC_RELEASE, "agent");
            asm volatile("s_waitcnt vmcnt(0)" ::: "memory");
            const unsigned og = xb_add(&bar[XB_TOP], 1u);
            const unsigned tg = og / nx;
            if (og + 1u == (tg + 1u) * nx) xb_add(&bar[XB_TOPGEN], 1u);
            else XB_SPIN(xb_ld(&bar[XB_TOPGEN]) == tg, bar);
            __builtin_amdgcn_fence(__ATOMIC_ACQUIRE, "agent");
            xb_add(&bar[XB_XGEN(b.x)], 1u);
            asm volatile("s_waitcnt vmcnt(0)" ::: "memory");
        } else {
            XB_SPIN(xb_ld(&bar[XB_XGEN(b.x)]) == gen, bar);
            __builtin_amdgcn_fence(__ATOMIC_ACQUIRE, "agent");
            asm volatile("s_waitcnt vmcnt(0)" ::: "memory");
        }
    }
    __syncthreads();
}


struct Args { const float* in[35]; float* out; unsigned char* ws; int ph_lo, ph_hi; };
static_assert(sizeof(Args) == 304, "Args layout");

__global__ void __launch_bounds__(512, 2) mk_fwd(Args args) {
    extern __shared__ __attribute__((aligned(16))) unsigned char lds_raw[];
    LAS unsigned char* lds = (LAS unsigned char*)lds_raw; LAS unsigned char* xl = lds + XLDS_OFF;
    const int G = gridDim.x, bx = blockIdx.x, NGW = G * 8;
#define LOCAL_IDS int tid = threadIdx.x; asm volatile("" : "+v"(tid)); const int lane = tid & 63, wave = __builtin_amdgcn_readfirstlane(tid >> 6), gw = bx * 8 + wave; (void)lane; (void)gw;
    typedef const __attribute__((address_space(4))) unsigned char* kaptr_t;
    kaptr_t ka = (kaptr_t)__builtin_amdgcn_kernarg_segment_ptr();
#define INP(k) (*(const float* const volatile __attribute__((address_space(4)))*)(ka + 8 * (k)))
    unsigned char* ws = *(unsigned char* const volatile __attribute__((address_space(4)))*)(ka + 288); float* out = *(float* const volatile __attribute__((address_space(4)))*)(ka + 280);
    const float* x = INP(0);
    bf16_t* WAB = (bf16_t*)(ws + WS_WAB); bf16_t* WABO = (bf16_t*)(ws + WS_WABO); bf16_t* WHG = (bf16_t*)(ws + WS_WHG); bf16_t* WHGO = (bf16_t*)(ws + WS_WHGO);
    bf16_t* WQ = (bf16_t*)(ws + WS_WQ); bf16_t* WKV = (bf16_t*)(ws + WS_WKV); bf16_t* WO = (bf16_t*)(ws + WS_WO); bf16_t* WF1 = (bf16_t*)(ws + WS_WF1); bf16_t* WF2 = (bf16_t*)(ws + WS_WF2);
    bf16_t* G2T = (bf16_t*)(ws + WS_G2T); bf16_t* MEMN = (bf16_t*)(ws + WS_MEMN); bf16_t* KMEM = (bf16_t*)(ws + WS_KMEM);
    bf16_t* WKT = (bf16_t*)out; bf16_t* VWT = (bf16_t*)((unsigned char*)out + 64 * MiB);
    bf16_t* H = (bf16_t*)(ws + WS_H); bf16_t* P = (bf16_t*)(ws + WS_P); bf16_t* PATT = (bf16_t*)(ws + WS_PATT); bf16_t* OMIX0 = (bf16_t*)(ws + WS_OMIX0); bf16_t* OMIX1 = (bf16_t*)(ws + WS_OMIX1); float* PSB = (float*)(ws + WS_PS);
#define COMMA ,
    bf16_t* STATES = (bf16_t*)((unsigned char*)out + DO_STATES); bf16_t* GG = (bf16_t*)((unsigned char*)out + DO_G); bf16_t* SG = (bf16_t*)((unsigned char*)out + DO_SG);
    float* BONUS = (float*)((unsigned char*)out + DO_BONUS); float* TOT = (float*)((unsigned char*)out + DO_TOT);
    cg::grid_group grid = cg::this_grid();
    { volatile LAS unsigned* st_ = (volatile LAS unsigned*)(lds + LDS_BYTES - 16); if (threadIdx.x < 4) st_[threadIdx.x] = 0u; }
    __syncthreads();
    const XcdBarrier xbar = xcd_barrier_post((unsigned*)ws, (volatile LAS unsigned*)(lds + LDS_BYTES - 16));
    const int lo = *(const int volatile __attribute__((address_space(4)))*)(ka + 296), hi = *(const int volatile __attribute__((address_space(4)))*)(ka + 300);
#ifndef PH_EN
#define PH_EN(k) 1
#endif
#define IN(k) (PH_EN(k) && lo <= (k) && (k) < hi)
#ifndef DUP_MASK
#define DUP_MASK 0ull
#endif
#define REPS(k) (1 + (int)(((unsigned long long)(DUP_MASK) >> (k)) & 1ull))
#define PHASE(k) for (int rep_ = 0; rep_ < (IN(k) ? REPS(k) : 0); ++rep_, ((REPS(k) > 1) ? (grid.sync(), 0) : 0))
#define SEAM(k) do { if (IN(k) && IN((k) + 1)) xcd_barrier(xbar); } while (0)
    if (lo < 0) grid.sync();
#define RUN_GEMM(EPI, ALIGN, gd, ep) do { pg8::Order S_; S_.init(gd, G, bx); pg8::gemm_phase<EPI, ALIGN>(lds, xl, gd, S_, ep); } while (0)

    PHASE(0) { LOCAL_IDS
        LAS float* scr = (LAS float*)(lds + wave * 16384);
        constexpr int I_AB = 16 * 112, I_SQ = 16 * 32, I_HG = 16 * 160, I_KV = 16 * 64, I_F1 = 16 * 176, I_F2 = 44 * 32, I_G2 = 2 * 16;
        constexpr int NIT = I_AB + I_SQ + I_HG + I_SQ + 2 * I_KV + 2 * I_SQ + 2 * I_F1 + 2 * I_F2 + I_G2;
        for (int it = gw; it < NIT; it += NGW) {
            int r = it;
            if (r < I_AB) { transpose_item<0>(INP(3), 1024, ABP, WAB, scr, r, 112, lane); continue; } r -= I_AB;
            if (r < I_SQ) { transpose_item<0>(INP(4), 1024, 1024, WABO, scr, r, 32, lane); continue; } r -= I_SQ;
            if (r < I_HG) { transpose_item<0>(INP(22), 1024, HGP, WHG, scr, r, 160, lane, INP(2) + D); continue; } r -= I_HG;
            if (r < I_SQ) { transpose_item<0>(INP(23), 1024, 1024, WHGO, scr, r, 32, lane); continue; } r -= I_SQ;
            if (r < 2 * I_KV) { const int l = r / I_KV; transpose_item<0>(INP(29) + (size_t)l * D * 2048, 1024, 2048, WKV + (size_t)l * D * 2048, scr, r % I_KV, 64, lane); continue; } r -= 2 * I_KV;
            if (r < 2 * I_SQ) { const int l = r / I_SQ; transpose_item<0>(INP(30) + (size_t)l * D * D, 1024, 1024, WO + (size_t)l * D * D, scr, r % I_SQ, 32, lane); continue; } r -= 2 * I_SQ;
            if (r < 2 * I_F1) { const int l = r / I_F1; transpose_item<1>(INP(32) + (size_t)l * D * 2 * FFN, 1024, 2 * FFN, WF1 + (size_t)l * D * 2 * FFN, scr, r % I_F1, 176, lane, INP(31) + l * D); continue; } r -= 2 * I_F1;
            if (r < 2 * I_F2) { const int l = r / I_F2; transpose_item<0>(INP(33) + (size_t)l * FFN * D, FFN, 1024, WF2 + (size_t)l * FFN * D, scr, r % I_F2, 32, lane); continue; } r -= 2 * I_F2;
            transpose_item<0>(INP(10), 128, 512, G2T, scr, r, 16, lane);
        }
        for (size_t e8 = (size_t)bx * 512 + tid; e8 < (size_t)2 * D * D / 8; e8 += (size_t)G * 512) { const size_t idx = e8 * 8; const int l = (int)(idx / ((size_t)D * D)), k = (int)((idx % ((size_t)D * D)) / D);
            const float gk = INP(26)[l * D + k]; const f32x4 a0 = *(const f32x4*)(INP(28) + idx), a1 = *(const f32x4*)(INP(28) + idx + 4);
            u32x4 o; o.x = pk2(a0[0] * gk, a0[1] * gk); o.y = pk2(a0[2] * gk, a0[3] * gk); o.z = pk2(a1[0] * gk, a1[1] * gk); o.w = pk2(a1[2] * gk, a1[3] * gk); *(u32x4*)(WQ + idx) = o; }
        rms_rows_phase(x, INP(2), H, T, gw, NGW, lane);
        for (int m = gw; m < 2 * 4096; m += NGW) { const int l = m >> 12, r = m & 4095; rms_row_bf16(INP(1) + (size_t)r * D, INP(27) + l * D, MEMN + (size_t)m * D, lane); }
        __syncthreads();
    }
    SEAM(0);
    PHASE(1) {
        { pg8::Gemm g = pg8::make_gemm(H, WAB, T, ABPAD, 1024, 1024, 1024); pg8::EpiBf16 E{P, ABPAD, 1.0f, nullptr}; RUN_GEMM(pg8::EpiBf16, true, g, E); }
        { pg8::Gemm g = pg8::make_gemm(MEMN, WKV, 4096, 2048, 1024, 1024, 1024); g.nZ = 2; g.sAo = 4096L * D; g.sBo = 2048L * D; g.sCo = 4096L * 2048; pg8::EpiBf16 E{KMEM, 2048, 1.0f, nullptr}; RUN_GEMM(pg8::EpiBf16, true, g, E); }
    }
    SEAM(1);
    PHASE(2) {
#ifndef DUP_RWKV
#define DUP_RWKV 0
#endif
#ifndef DUP_S1
#define DUP_S1 0
#endif
        for (int r2 = 0; r2 <= DUP_RWKV; ++r2)
        for (int cid = bx; cid < 256; cid += G)
            rwkv_chain(lds, cid, P, INP(5), INP(6), INP(7), INP(8), INP(9), INP(11), INP(12), INP(13), H, SG, BONUS);
        for (int r2 = 0; r2 <= DUP_S1; ++r2)
        for (int u = bx; u < 1024; u += G) ssd_s1_unit(lds, u, P, INP(16), INP(17), INP(18), INP(19), STATES, TOT);
        __syncthreads();
    }
    SEAM(2);
    PHASE(3) {
        { int k128 = 128; asm volatile("" : "+s"(k128)); pg8::Gemm g = pg8::make_gemm(SG, G2T, T, 512, k128, 128, 128); pg8::EpiBf16 E{GG, 512, 1.0f, nullptr}; RUN_GEMM(pg8::EpiBf16, true, g, E); }
        { LOCAL_IDS ssd_s2(STATES, OMIX1, TOT, bx * 512 + tid, G * 512); }
    }
    SEAM(3);
    PHASE(4) {
#ifndef DUP_S3
#define DUP_S3 0
#endif
        for (int r2 = 0; r2 <= DUP_S3; ++r2)
        for (int u = bx; u < 1024; u += G) ssd_s3_unit(lds, u, P, INP(16), INP(17), INP(18), INP(19), INP(20), INP(21), OMIX1, OMIX0);
        __syncthreads();
        { LOCAL_IDS rwkv_combine(P, H, BONUS, GG, INP(5), INP(14), INP(15), OMIX0, gw, NGW, lane); }
    }
    SEAM(4);
    PHASE(5) { { pg8::Gemm g = pg8::make_gemm(OMIX0, WABO, T, 1024, 1024, 1024, 1024); pg8::EpiResidB E{x, H, PSB, 1024}; RUN_GEMM(pg8::EpiResidB, true, g, E); }
        for (int l = 0; l < 2; ++l) {
            { pg8::Gemm g = pg8::make_gemm(KMEM + (size_t)l * 4096 * 2048, WQ + (size_t)l * D * D, 256, 1024, 256, 2048, 1024); g.nZ = 64; g.zdiv = 4;
              g.sAo = 256L * 2048; g.sAi = 256; g.sBo = 0; g.sBi = 256; g.sCo = 4L * 256 * 1024; g.sCi = 256L * 1024; pg8::EpiBf16 E{WKT + (size_t)l * 16777216, 1024, 0.0625f, nullptr}; RUN_GEMM(pg8::EpiBf16, true, g, E); }
            { pg8::Gemm g = pg8::make_gemm(WO + (size_t)l * D * D, KMEM + (size_t)l * 4096 * 2048 + 1024, 1024, 256, 256, 1024, 2048); g.nZ = 64; g.zdiv = 4;
              g.sAo = 0; g.sAi = 256; g.sBo = 256L * 2048; g.sBi = 256; g.sCo = 1024L * 1024; g.sCi = 256; pg8::EpiBf16 E{VWT + (size_t)l * 16777216, 1024, 1.0f, nullptr}; RUN_GEMM(pg8::EpiBf16, true, g, E); }
        } }
    SEAM(5);

#define ATTN_FFN(base, L) \
    PHASE(base) { pg8::Gemm g = pg8::make_gemm(H, WKT + (size_t)(L) * 16777216, SEQ, 256, 1024, 1024, 1024); g.nZ = 64; g.zdiv = 4; g.psz = 16; \
        g.sAo = (long)SEQ * D; g.sAi = 0; g.sBo = 4L * 256 * 1024; g.sBi = 256L * 1024; g.sCo = (long)SEQ * D; g.sCi = 256; pg8::EpiSoftmaxPS E{PSB, PATT, 1024}; RUN_GEMM(pg8::EpiSoftmaxPS, true, g, E); } \
    SEAM(base); \
    PHASE(base + 1) { pg8::Gemm g = pg8::make_gemm(PATT, VWT + (size_t)(L) * 16777216, SEQ, 1024, 1024, 1024, 1024); g.nZ = 16; g.zdiv = 1; \
        g.sAo = (long)SEQ * D; g.sBo = 1024L * 1024; g.sCo = (long)SEQ * D; pg8::EpiResidB E{nullptr, H, PSB, 1024}; RUN_GEMM(pg8::EpiResidB, true, g, E); } \
    SEAM(base + 1); \
    PHASE(base + 2) { pg8::Gemm g = pg8::make_gemm(H, WF1 + (size_t)(L) * D * 2 * FFN, T, 2 * FFN, 1024, 1024, 1024); pg8::EpiSwiglu E{P, FFN, PSB}; RUN_GEMM(pg8::EpiSwiglu, true, g, E); } \
    SEAM(base + 2); \
    PHASE(base + 3) { pg8::Gemm g = pg8::make_gemm(P, WF2 + (size_t)(L) * FFN * D, T, 1024, FFN, FFN, FFN); pg8::EpiResidB E{nullptr, H, PSB, 1024}; RUN_GEMM(pg8::EpiResidB, true, g, E); } \
    SEAM(base + 3);

    ATTN_FFN(6, 0)

    PHASE(10) { pg8::Gemm g = pg8::make_gemm(H, WHG, T, HGP, 1024, 1024, 1024); pg8::EpiBf16PS E{P, HGP, 1.0f, PSB}; RUN_GEMM(pg8::EpiBf16PS, true, g, E); }
    SEAM(10);
    PHASE(11) { for (int cid = bx; cid < 256; cid += G) hgrn_chain(lds, cid, P, INP(25), P, HGP, 1024, 1024); }
    SEAM(11);
    PHASE(12) { LOCAL_IDS hgrn_combine(P, INP(24), OMIX1, gw, NGW, lane); }
    SEAM(12);
    PHASE(13) { pg8::Gemm g = pg8::make_gemm(OMIX1, WHGO, T, 1024, 1024, 1024, 1024); pg8::EpiResidB E{nullptr, H, PSB, 1024}; RUN_GEMM(pg8::EpiResidB, true, g, E); }
    SEAM(13);

    ATTN_FFN(14, 1)

    PHASE(18) { LOCAL_IDS
        const float* fg = INP(34);
#pragma unroll 2
        for (int m = gw; m < T; m += NGW) {
            const f32x4 pa = *(const f32x4*)(PSB + (size_t)m * 16 + (lane & 3) * 4); float sq = (pa[0] + pa[1]) + (pa[2] + pa[3]); sq += __shfl_xor(sq, 1); sq += __shfl_xor(sq, 2);
            const float rs = rsqrtf(sq * (1.f / D) + 1e-6f);
            const bf16_t* hr = H + (size_t)m * D; float* orow = out + (size_t)m * D;
#pragma unroll
            for (int j = 0; j < 2; ++j) { const int c = (lane + 64 * j) * 8; const u32x4 hv = *(const u32x4*)(hr + c); const f32x4 g0 = *(const f32x4*)(fg + c), g1 = *(const f32x4*)(fg + c + 4);
                *(f32x4*)(orow + c) = (f32x4){bflo(hv.x) * rs * g0[0], bfhi(hv.x) * rs * g0[1], bflo(hv.y) * rs * g0[2], bfhi(hv.y) * rs * g0[3]};
                *(f32x4*)(orow + c + 4) = (f32x4){bflo(hv.z) * rs * g1[0], bfhi(hv.z) * rs * g1[1], bflo(hv.w) * rs * g1[2], bfhi(hv.w) * rs * g1[3]}; } }
    }
#undef IN
#undef SEAM
#undef RUN_GEMM
}

extern "C" void kernel_launch(void* const* d_in, const int* in_sizes, int n_in, void* d_out, int out_size, void* d_ws, size_t ws_size, hipStream_t stream) {
    static int grid = 0;
    if (grid == 0) {
        if (n_in != 35 || out_size != T * D || ws_size < WS_END) { fprintf(stderr, "kernel_launch: unexpected shapes (n_in %d out %d ws %zu)\n", n_in, out_size, ws_size); grid = -1; return; }
        int dev = 0, cus = 0, per_cu = 0;
        hipGetDevice(&dev); hipDeviceGetAttribute(&cus, hipDeviceAttributeMultiprocessorCount, dev);
        hipFuncSetAttribute((const void*)mk_fwd, hipFuncAttributeMaxDynamicSharedMemorySize, LDS_BYTES);
        hipOccupancyMaxActiveBlocksPerMultiprocessor(&per_cu, (const void*)mk_fwd, 512, LDS_BYTES);
        if (per_cu < 1) { fprintf(stderr, "kernel_launch: occupancy query says %d blocks per CU\n", per_cu); per_cu = 1; }
        (void)hipGetLastError();
        grid = cus * 1;
    }
    if (grid < 0) return;
    if (hipMemsetAsync(d_ws, 0, 65536, stream) != hipSuccess) { fprintf(stderr, "kernel_launch: memset of the barrier words failed\n"); return; }
    Args a{};
    for (int i = 0; i < 35; ++i) a.in[i] = (const float*)d_in[i];
    a.out = (float*)d_out; a.ws = (unsigned char*)d_ws;
#if MK_COOP
    a.ph_lo = 0; a.ph_hi = NPHASE;
    void* kargs[] = {&a};
    hipError_t e = hipLaunchCooperativeKernel((const void*)mk_fwd, dim3(grid), dim3(512), kargs, LDS_BYTES, stream);
    if (e != hipSuccess) fprintf(stderr, "cooperative launch failed: %s (grid %d)\n", hipGetErrorString(e), grid);
#else
    for (int ph = 0; ph < NPHASE; ++ph) { a.ph_lo = ph; a.ph_hi = ph + 1; hipLaunchKernelGGL(mk_fwd, dim3(grid), dim3(512), LDS_BYTES, stream, a); }
#endif
}
```

```cpp
#include <hip/hip_runtime.h>
#include <hip/hip_cooperative_groups.h>
#include <cstdio>
#include <cstdint>
namespace cg = cooperative_groups;

#ifndef MK_COOP
#define MK_COOP 1
#endif

#define LAS __attribute__((address_space(3)))
typedef unsigned short bf16_t;
typedef short bf16x8 __attribute__((ext_vector_type(8)));
typedef float f32x4 __attribute__((ext_vector_type(4)));
typedef float f32x2 __attribute__((ext_vector_type(2)));
typedef unsigned u32x4 __attribute__((ext_vector_type(4)));
typedef unsigned u32x2 __attribute__((ext_vector_type(2)));

constexpr int NB = 16, SEQ = 4096, T = NB * SEQ, D = 1024;
constexpr int ABPAD = 3584, ABP = 3336;
constexpr int HGP = 5120;
constexpr int FFN = 2816;
constexpr int NPHASE = 19;

constexpr size_t MiB = 1u << 20;
constexpr size_t WS_WAB = 1 * MiB, WS_WABO = 8 * MiB, WS_WHG = 10 * MiB, WS_WHGO = 20 * MiB, WS_WQ = 22 * MiB, WS_WKV = 26 * MiB, WS_WO = 34 * MiB,
                 WS_WF1 = 38 * MiB, WS_WF2 = 60 * MiB, WS_G2T = 71 * MiB, WS_MEMN = 72 * MiB, WS_KMEM = 88 * MiB, WS_VT = 104 * MiB,
                 WS_PS = 120 * MiB, WS_H = 128 * MiB, WS_P = 256 * MiB, WS_PATT = 384 * MiB, WS_OMIX0 = 704 * MiB, WS_OMIX1 = 896 * MiB, WS_END = 1024 * MiB;
constexpr size_t DO_STATES = 0, DO_G = 128 * MiB, DO_SG = 192 * MiB, DO_BONUS = 208 * MiB, DO_TOT = 210 * MiB;

constexpr int LDS_BYTES = 163840;
constexpr int XLDS_OFF = 131072;

typedef __bf16 bf16x2_t __attribute__((ext_vector_type(2)));
__device__ __forceinline__ unsigned pk2(float lo, float hi) { const f32x2 v = {lo, hi}; return __builtin_bit_cast(unsigned, __builtin_convertvector(v, bf16x2_t)); }
__device__ __forceinline__ unsigned f2bf(float f) { return pk2(f, 0.f) & 0xffffu; }
__device__ __forceinline__ float bf2f(unsigned short b) { return __builtin_bit_cast(float, (unsigned)b << 16); }
__device__ __forceinline__ float bflo(unsigned u) { return __builtin_bit_cast(float, u << 16); }
__device__ __forceinline__ float bfhi(unsigned u) { return __builtin_bit_cast(float, u & 0xffff0000u); }
__device__ __forceinline__ float frcp(float x) { return __builtin_amdgcn_rcpf(x); }
__device__ __forceinline__ float sigmoidf_(float x) { return frcp(1.0f + __expf(-x)); }
__device__ __forceinline__ float siluf_(float x) { return x * frcp(1.0f + __expf(-x)); }
__device__ __forceinline__ float wave_sum(float v) {
#pragma unroll
    for (int o = 1; o < 64; o <<= 1) v += __shfl_xor(v, o);
    return v;
}
template <int CTRL> __device__ __forceinline__ float dppf(float x) { return __builtin_bit_cast(float, __builtin_amdgcn_mov_dpp(__builtin_bit_cast(int, x), CTRL, 0xf, 0xf, true)); }
__device__ __forceinline__ float sum8(float v) { v += dppf<0xB1>(v); v += dppf<0x4E>(v); v += dppf<0x141>(v); return v; }
#define LDS_WAIT() asm volatile("s_waitcnt lgkmcnt(0)" ::: "memory")

namespace pg8 {
constexpr int BM = 256, BK = 64, HALF = 128, HTB = HALF * BK * 2, STAGE_BYTES = 8 * HTB, NXCD = 8, WGM = 8;
__host__ __device__ __forceinline__ int lds_byte(int r, int c) { const int st = (r >> 4) * 2 + (c >> 5), rr = r & 15, cc = c & 31, ob = rr * 64 + cc * 2; return st * 1024 + (ob ^ (((ob >> 9) & 1) << 5)); }
__host__ __device__ __forceinline__ void stage_rc(int b, int& R, int& C) { const int st = b / 1024, sb = b % 1024, swz = sb ^ (((sb >> 9) & 1) << 5); R = (st >> 1) * 16 + swz / 64; C = (st & 1) * 32 + (swz % 64) / 2; }
__host__ __device__ __forceinline__ int perm32(int rho) { const int n = rho >> 4, i = rho & 15; return 8 * (i >> 2) + 4 * n + (i & 3); }

struct Unit { int pm, pn, z; };
struct Gemm {
    const bf16_t* A; const bf16_t* Bt; int lda, ldb, K, nM, nN, nZ, zdiv, psz; long sAo, sAi, sBo, sBi, sCo, sCi;
    __device__ __forceinline__ long offA(const Unit& u) const { return (long)(u.z / zdiv) * sAo + (long)(u.z % zdiv) * sAi + (long)u.pm * BM * lda; }
    __device__ __forceinline__ long offB(const Unit& u) const { return (long)(u.z / zdiv) * sBo + (long)(u.z % zdiv) * sBi + (long)u.pn * BM * ldb; }
    __device__ __forceinline__ long offC(const Unit& u) const { return (long)(u.z / zdiv) * sCo + (long)(u.z % zdiv) * sCi; }
};
__device__ __forceinline__ Gemm make_gemm(const bf16_t* A, const bf16_t* Bt, int M, int N, int K, int lda, int ldb) {
    Gemm g; g.A = A; g.Bt = Bt; g.lda = lda; g.ldb = ldb; g.K = K; g.nM = M / BM; g.nN = N / BM; g.nZ = 1; g.zdiv = 1; g.psz = 0; g.sAo = g.sAi = g.sBo = g.sBi = g.sCo = g.sCi = 0; return g;
}
struct Order {
    int nM, nN, nwg, total, G, c;
    __device__ __forceinline__ void init(const Gemm& g, int G_, int c_) { nM = g.nM; nN = g.nN; nwg = nM * nN; total = nwg * g.nZ; G = G_; c = c_; }
    __device__ __forceinline__ bool next(int i, Unit& u) const {
        const long L = (long)i * G + c; if (L >= total) return false;
        u.z = (int)(L / nwg); int wgid = (int)(L % nwg);
        { const int q = nwg / NXCD, r = nwg % NXCD, xcd = wgid % NXCD, off = wgid / NXCD; wgid = (xcd < r ? xcd * (q + 1) : r * (q + 1) + (xcd - r) * q) + off; }
        const int nig = WGM * nN, gid = wgid / nig, fm = gid * WGM, gsz = (nM - fm) < WGM ? (nM - fm) : WGM;
        u.pm = fm + ((wgid % nig) % gsz); u.pn = (wgid % nig) / gsz; return true;
    }
};

__device__ __forceinline__ unsigned cvt_pk_bf16(float lo, float hi) { return pk2(lo, hi); }

__device__ __forceinline__ void row_scales(const float* PS, int rowbase, int fq, float (&rs)[2][4]) {
#pragma unroll
    for (int ai = 0; ai < 2; ++ai)
#pragma unroll
        for (int m = 0; m < 4; ++m) { const f32x4 p = *(const f32x4*)(PS + (size_t)(rowbase + ai * HALF + m * 16) * 16 + fq * 4);
            float s = (p[0] + p[1]) + (p[2] + p[3]); s += __shfl_xor(s, 16); s += __shfl_xor(s, 32); rs[ai][m] = rsqrtf(s * (1.f / 1024.f) + 1e-6f); }
}
__device__ __forceinline__ void row_scales_lds(const LAS float* PSL, int rloc  , int fq, float (&rs)[2][4]) {
#pragma unroll
    for (int ai = 0; ai < 2; ++ai)
#pragma unroll
        for (int m = 0; m < 4; ++m) { const f32x4 p = *(const LAS f32x4*)(PSL + (rloc + ai * HALF + m * 16) * 16 + fq * 4);
            float s = (p[0] + p[1]) + (p[2] + p[3]); s += __shfl_xor(s, 16); s += __shfl_xor(s, 32); rs[ai][m] = rsqrtf(s * (1.f / 1024.f) + 1e-6f); }
}
struct EpiBf16 {
    static constexpr bool PERM = true, PSLDS = false;
    bf16_t* O; int ldc; float scale; const float* PS;
    __device__ __forceinline__ void operator()(const f32x4 (&acc)[2][2][4][2], const Unit& u, long coff, int wr, int wc, int fr, int fq, LAS unsigned char* xl) const {
        const int row0 = u.pm * BM + wr * 64 + fr, col0 = u.pn * BM + wc * 32 + 8 * fq; bf16_t* base = O + coff;
        float rs[2][4];
        if (PS) row_scales(PS, row0, fq, rs);
        else {
#pragma unroll
            for (int ai = 0; ai < 2; ++ai)
#pragma unroll
                for (int m = 0; m < 4; ++m) rs[ai][m] = 1.f; }
#pragma unroll
        for (int ai = 0; ai < 2; ++ai)
#pragma unroll
            for (int m = 0; m < 4; ++m) { bf16_t* rowp = base + (size_t)(row0 + ai * HALF + m * 16) * ldc + col0; const float sc_ = scale * rs[ai][m];
#pragma unroll
                for (int bj = 0; bj < 2; ++bj) { const f32x4 v0 = acc[ai][bj][m][0] * sc_, v1 = acc[ai][bj][m][1] * sc_;
                    u32x4 w; w.x = cvt_pk_bf16(v0[0], v0[1]); w.y = cvt_pk_bf16(v0[2], v0[3]); w.z = cvt_pk_bf16(v1[0], v1[1]); w.w = cvt_pk_bf16(v1[2], v1[3]);
                    *(u32x4*)(rowp + bj * HALF) = w; } }
    }
};
struct EpiBf16PS {
    static constexpr bool PERM = true, PSLDS = true;
    bf16_t* O; int ldc; float scale; const float* PS;
    __device__ __forceinline__ void operator()(const f32x4 (&acc)[2][2][4][2], const Unit& u, long coff, int wr, int wc, int fr, int fq, LAS unsigned char* xl) const {
        const int row0 = u.pm * BM + wr * 64 + fr, col0 = u.pn * BM + wc * 32 + 8 * fq; bf16_t* base = O + coff;
        float rs[2][4];
        row_scales_lds((const LAS float*)(xl + 8192), wr * 64 + fr, fq, rs);
#pragma unroll
        for (int ai = 0; ai < 2; ++ai)
#pragma unroll
            for (int m = 0; m < 4; ++m) { bf16_t* rowp = base + (size_t)(row0 + ai * HALF + m * 16) * ldc + col0; const float sc_ = scale * rs[ai][m];
#pragma unroll
                for (int bj = 0; bj < 2; ++bj) { const f32x4 v0 = acc[ai][bj][m][0] * sc_, v1 = acc[ai][bj][m][1] * sc_;
                    u32x4 w; w.x = cvt_pk_bf16(v0[0], v0[1]); w.y = cvt_pk_bf16(v0[2], v0[3]); w.z = cvt_pk_bf16(v1[0], v1[1]); w.w = cvt_pk_bf16(v1[2], v1[3]);
                    *(u32x4*)(rowp + bj * HALF) = w; } }
    }
};
struct EpiResid {
    static constexpr bool PERM = false, PSLDS = false;
    const float* base; float* out; int ldc;
    __device__ __forceinline__ void operator()(const f32x4 (&acc)[2][2][4][2], const Unit& u, long coff, int wr, int wc, int fr, int fq, LAS unsigned char* xl) const {
        const int col0 = u.pn * BM + wc * 32 + 4 * fq;
#pragma unroll
        for (int ai = 0; ai < 2; ++ai)
#pragma unroll
            for (int m = 0; m < 4; ++m) { const size_t off = (size_t)(u.pm * BM + ai * HALF + wr * 64 + m * 16 + fr) * ldc + col0;
#pragma unroll
                for (int bj = 0; bj < 2; ++bj)
#pragma unroll
                    for (int n = 0; n < 2; ++n) { const f32x4 bs = *(const f32x4*)(base + off + bj * HALF + n * 16); *(f32x4*)(out + off + bj * HALF + n * 16) = bs + acc[ai][bj][m][n]; } }
    }
};
struct EpiResidH {
    static constexpr bool PERM = false, PSLDS = false;
    const float* base; float* out; bf16_t* HB; float* PS; int ldc;
    __device__ __forceinline__ void operator()(const f32x4 (&acc)[2][2][4][2], const Unit& u, long coff, int wr, int wc, int fr, int fq, LAS unsigned char* xl) const {
        const int col0 = u.pn * BM + wc * 32 + 4 * fq;
#pragma unroll
        for (int ai = 0; ai < 2; ++ai)
#pragma unroll
            for (int m = 0; m < 4; ++m) { const int row = u.pm * BM + ai * HALF + wr * 64 + m * 16 + fr; const size_t off = (size_t)row * ldc + col0; float ss = 0.f;
#pragma unroll
                for (int bj = 0; bj < 2; ++bj)
#pragma unroll
                    for (int n = 0; n < 2; ++n) { const f32x4 bs = *(const f32x4*)(base + off + bj * HALF + n * 16); const f32x4 o = bs + acc[ai][bj][m][n]; *(f32x4*)(out + off + bj * HALF + n * 16) = o;
                        ss += (o[0] * o[0] + o[1] * o[1]) + (o[2] * o[2] + o[3] * o[3]);
                        u32x2 w; w.x = cvt_pk_bf16(o[0], o[1]); w.y = cvt_pk_bf16(o[2], o[3]); *(u32x2*)(HB + off + bj * HALF + n * 16) = w; }
                ss += __shfl_xor(ss, 16); ss += __shfl_xor(ss, 32);
                if (fq == 0) PS[(size_t)row * 16 + u.pn * 4 + wc] = ss; }
    }
};
struct EpiResidB {
    static constexpr bool PERM = false, PSLDS = false;
    const float* basef; bf16_t* HB; float* PS; int ldc;
    __device__ __forceinline__ void operator()(const f32x4 (&acc)[2][2][4][2], const Unit& u, long coff, int wr, int wc, int fr, int fq, LAS unsigned char* xl) const {
        const int col0 = u.pn * BM + wc * 32 + 4 * fq;
#pragma unroll
        for (int ai = 0; ai < 2; ++ai)
#pragma unroll
            for (int m = 0; m < 4; ++m) { const int row = (int)(coff / ldc) + u.pm * BM + ai * HALF + wr * 64 + m * 16 + fr; const size_t off = (size_t)row * ldc + col0; float ss = 0.f;
#pragma unroll
                for (int bj = 0; bj < 2; ++bj)
#pragma unroll
                    for (int n = 0; n < 2; ++n) { f32x4 bs;
                        if (basef) bs = *(const f32x4*)(basef + off + bj * HALF + n * 16);
                        else { const u32x2 hb = *(const u32x2*)(HB + off + bj * HALF + n * 16); bs = (f32x4){bflo(hb.x), bfhi(hb.x), bflo(hb.y), bfhi(hb.y)}; }
                        const f32x4 o = bs + acc[ai][bj][m][n];
                        ss += (o[0] * o[0] + o[1] * o[1]) + (o[2] * o[2] + o[3] * o[3]);
                        u32x2 w; w.x = cvt_pk_bf16(o[0], o[1]); w.y = cvt_pk_bf16(o[2], o[3]); *(u32x2*)(HB + off + bj * HALF + n * 16) = w; }
                ss += __shfl_xor(ss, 16); ss += __shfl_xor(ss, 32);
                if (fq == 0) PS[(size_t)row * 16 + u.pn * 4 + wc] = ss; }
    }
};
struct EpiSwiglu {
    static constexpr bool PERM = true, PSLDS = true;
    bf16_t* O; int ldc; const float* PS;
    __device__ __forceinline__ void operator()(const f32x4 (&acc)[2][2][4][2], const Unit& u, long coff, int wr, int wc, int fr, int fq, LAS unsigned char* xl) const {
        const int row0 = u.pm * BM + wr * 64 + fr, col0 = u.pn * HALF + wc * 32 + 8 * fq;
        float rs[2][4]; row_scales_lds((const LAS float*)(xl + 8192), wr * 64 + fr, fq, rs);
#pragma unroll
        for (int ai = 0; ai < 2; ++ai)
#pragma unroll
            for (int m = 0; m < 4; ++m) { bf16_t* rowp = O + (size_t)(row0 + ai * HALF + m * 16) * ldc + col0; float r[8]; const float sc_ = rs[ai][m];
#pragma unroll
                for (int n = 0; n < 2; ++n)
#pragma unroll
                    for (int i = 0; i < 4; ++i) { const float g = acc[ai][0][m][n][i] * sc_, uu = acc[ai][1][m][n][i] * sc_; r[n * 4 + i] = siluf_(g) * uu; }
                u32x4 w; w.x = cvt_pk_bf16(r[0], r[1]); w.y = cvt_pk_bf16(r[2], r[3]); w.z = cvt_pk_bf16(r[4], r[5]); w.w = cvt_pk_bf16(r[6], r[7]);
                *(u32x4*)rowp = w; }
    }
};
struct EpiSoftmax {
    static constexpr bool PERM = true, PSLDS = false;
    bf16_t* O; int ldc;
    __device__ __forceinline__ void operator()(f32x4 (&acc)[2][2][4][2], const Unit& u, long coff, int wr, int wc, int fr, int fq, LAS unsigned char* xl) const {
        LAS float* XM = (LAS float*)xl; LAS float* XS = (LAS float*)(xl + 4096);
#pragma unroll
        for (int ai = 0; ai < 2; ++ai)
#pragma unroll
            for (int m = 0; m < 4; ++m) { float mx = -3.0e38f;
#pragma unroll
                for (int bj = 0; bj < 2; ++bj)
#pragma unroll
                    for (int n = 0; n < 2; ++n)
#pragma unroll
                        for (int i = 0; i < 4; ++i) mx = fmaxf(mx, acc[ai][bj][m][n][i]);
                mx = fmaxf(mx, __shfl_xor(mx, 16)); mx = fmaxf(mx, __shfl_xor(mx, 32));
                if (fq == 0) XM[(ai * HALF + wr * 64 + m * 16 + fr) * 4 + wc] = mx; }
        LDS_WAIT(); __builtin_amdgcn_s_barrier(); asm volatile("" ::: "memory");
#pragma unroll
        for (int ai = 0; ai < 2; ++ai)
#pragma unroll
            for (int m = 0; m < 4; ++m) { const f32x4 mm = *(const LAS f32x4*)(XM + (ai * HALF + wr * 64 + m * 16 + fr) * 4);
                const float mx = fmaxf(fmaxf(mm[0], mm[1]), fmaxf(mm[2], mm[3])); float s = 0.f;
#pragma unroll
                for (int bj = 0; bj < 2; ++bj)
#pragma unroll
                    for (int n = 0; n < 2; ++n)
#pragma unroll
                        for (int i = 0; i < 4; ++i) { const float e = __expf(acc[ai][bj][m][n][i] - mx); acc[ai][bj][m][n][i] = e; s += e; }
                s += __shfl_xor(s, 16); s += __shfl_xor(s, 32);
                if (fq == 0) XS[(ai * HALF + wr * 64 + m * 16 + fr) * 4 + wc] = s; }
        LDS_WAIT(); __builtin_amdgcn_s_barrier(); asm volatile("" ::: "memory");
        const int row0 = u.pm * BM + wr * 64 + fr, col0 = wc * 32 + 8 * fq; bf16_t* base = O + coff;
#pragma unroll
        for (int ai = 0; ai < 2; ++ai)
#pragma unroll
            for (int m = 0; m < 4; ++m) { const f32x4 ss = *(const LAS f32x4*)(XS + (ai * HALF + wr * 64 + m * 16 + fr) * 4);
                const float inv = frcp((ss[0] + ss[1]) + (ss[2] + ss[3])); bf16_t* rowp = base + (size_t)(row0 + ai * HALF + m * 16) * ldc + col0;
#pragma unroll
                for (int bj = 0; bj < 2; ++bj) { const f32x4 v0 = acc[ai][bj][m][0] * inv, v1 = acc[ai][bj][m][1] * inv;
                    u32x4 w; w.x = cvt_pk_bf16(v0[0], v0[1]); w.y = cvt_pk_bf16(v0[2], v0[3]); w.z = cvt_pk_bf16(v1[0], v1[1]); w.w = cvt_pk_bf16(v1[2], v1[3]);
                    *(u32x4*)(rowp + bj * HALF) = w; } }
    }
};

struct EpiSoftmaxPS {
    const float* PS;
    static constexpr bool PERM = true, PSLDS = true;
    bf16_t* O; int ldc;
    __device__ __forceinline__ void operator()(f32x4 (&acc)[2][2][4][2], const Unit& u, long coff, int wr, int wc, int fr, int fq, LAS unsigned char* xl) const {
        LAS float* XM = (LAS float*)xl; LAS float* XS = (LAS float*)(xl + 4096);
        { float rs[2][4]; row_scales_lds((const LAS float*)(xl + 8192), wr * 64 + fr, fq, rs);
#pragma unroll
          for (int ai = 0; ai < 2; ++ai)
#pragma unroll
              for (int m = 0; m < 4; ++m)
#pragma unroll
                  for (int bj = 0; bj < 2; ++bj)
#pragma unroll
                      for (int n = 0; n < 2; ++n) acc[ai][bj][m][n] = acc[ai][bj][m][n] * rs[ai][m]; }
#pragma unroll
        for (int ai = 0; ai < 2; ++ai)
#pragma unroll
            for (int m = 0; m < 4; ++m) { float mx = -3.0e38f;
#pragma unroll
                for (int bj = 0; bj < 2; ++bj)
#pragma unroll
                    for (int n = 0; n < 2; ++n)
#pragma unroll
                        for (int i = 0; i < 4; ++i) mx = fmaxf(mx, acc[ai][bj][m][n][i]);
                mx = fmaxf(mx, __shfl_xor(mx, 16)); mx = fmaxf(mx, __shfl_xor(mx, 32));
                if (fq == 0) XM[(ai * HALF + wr * 64 + m * 16 + fr) * 4 + wc] = mx; }
        LDS_WAIT(); __builtin_amdgcn_s_barrier(); asm volatile("" ::: "memory");
#pragma unroll
        for (int ai = 0; ai < 2; ++ai)
#pragma unroll
            for (int m = 0; m < 4; ++m) { const f32x4 mm = *(const LAS f32x4*)(XM + (ai * HALF + wr * 64 + m * 16 + fr) * 4);
                const float mx = fmaxf(fmaxf(mm[0], mm[1]), fmaxf(mm[2], mm[3])); float s = 0.f;
#pragma unroll
                for (int bj = 0; bj < 2; ++bj)
#pragma unroll
                    for (int n = 0; n < 2; ++n)
#pragma unroll
                        for (int i = 0; i < 4; ++i) { const float e = __expf(acc[ai][bj][m][n][i] - mx); acc[ai][bj][m][n][i] = e; s += e; }
                s += __shfl_xor(s, 16); s += __shfl_xor(s, 32);
                if (fq == 0) XS[(ai * HALF + wr * 64 + m * 16 + fr) * 4 + wc] = s; }
        LDS_WAIT(); __builtin_amdgcn_s_barrier(); asm volatile("" ::: "memory");
        const int row0 = u.pm * BM + wr * 64 + fr, col0 = wc * 32 + 8 * fq; bf16_t* base = O + coff;
#pragma unroll
        for (int ai = 0; ai < 2; ++ai)
#pragma unroll
            for (int m = 0; m < 4; ++m) { const f32x4 ss = *(const LAS f32x4*)(XS + (ai * HALF + wr * 64 + m * 16 + fr) * 4);
                const float inv = frcp((ss[0] + ss[1]) + (ss[2] + ss[3])); bf16_t* rowp = base + (size_t)(row0 + ai * HALF + m * 16) * ldc + col0;
#pragma unroll
                for (int bj = 0; bj < 2; ++bj) { const f32x4 v0 = acc[ai][bj][m][0] * inv, v1 = acc[ai][bj][m][1] * inv;
                    u32x4 w; w.x = cvt_pk_bf16(v0[0], v0[1]); w.y = cvt_pk_bf16(v0[2], v0[3]); w.z = cvt_pk_bf16(v1[0], v1[1]); w.w = cvt_pk_bf16(v1[2], v1[3]);
                    *(u32x4*)(rowp + bj * HALF) = w; } }
    }
};

template <class Epi, bool ALIGN_EPI>
__device__ __forceinline__ void gemm_phase(LAS unsigned char* lds, LAS unsigned char* xl, const Gemm g, const Order& S, Epi& E) {
    const int tid = threadIdx.x, wid = __builtin_amdgcn_readfirstlane(tid >> 6), lane = tid & 63, wr = wid >> 2, wc = wid & 3, fr = lane & 15, fq = lane >> 4;
    const int K = g.K, nt = K / BK;
    unsigned voffA[2], voffB[2];
#pragma unroll
    for (int i = 0; i < 2; ++i) { int R, C; stage_rc(tid * 16 + i * 8192, R, C); const int Rb = Epi::PERM ? ((R & ~31) + perm32(R & 31)) : R;
        voffA[i] = (unsigned)(R * g.lda + C) * 2u; voffB[i] = (unsigned)(Rb * g.ldb + C) * 2u; }
    const size_t kstep = (size_t)(BK * 2);
    const size_t hstepA = (size_t)HALF * g.lda * 2, hstepB = (size_t)HALF * g.ldb * 2;
    const unsigned ldsw = (unsigned)wid * 1024u;
    const int aoff = lds_byte(wr * 64 + fr, fq * 8), boff = lds_byte(wc * 32 + fr, fq * 8);
#define PG8_SA(b, h) (((b) * 2 + (h)) * HTB)
#define PG8_SB(b, h) ((4 + (b) * 2 + (h)) * HTB)
#define PG8_STAGE(bufoff, gbase, voff) do { _Pragma("unroll") for (int _i = 0; _i < 2; ++_i) \
        __builtin_amdgcn_global_load_lds((const unsigned*)((const char*)(gbase) + (voff)[_i]), (LAS unsigned*)(lds + (bufoff) + ldsw + _i * 8192), 16, 0, 0); } while (0)
#define PG8_LDA(dst, b, h) do { _Pragma("unroll") for (int m = 0; m < 4; ++m) _Pragma("unroll") for (int k = 0; k < 2; ++k) dst[m][k] = *(const LAS bf16x8*)(lds + PG8_SA(b, h) + aoff + m * 2048 + k * 1024); } while (0)
#define PG8_LDB(dst, b, h) do { _Pragma("unroll") for (int n = 0; n < 2; ++n) _Pragma("unroll") for (int k = 0; k < 2; ++k) dst[n][k] = *(const LAS bf16x8*)(lds + PG8_SB(b, h) + boff + n * 2048 + k * 1024); } while (0)
#define PG8_MMA(ai, bj, At, Bt) do { __builtin_amdgcn_s_setprio(1); _Pragma("unroll") for (int m = 0; m < 4; ++m) _Pragma("unroll") for (int n = 0; n < 2; ++n) _Pragma("unroll") for (int k = 0; k < 2; ++k) \
        acc[ai][bj][m][n] = __builtin_amdgcn_mfma_f32_16x16x32_bf16(Bt[n][k], At[m][k], acc[ai][bj][m][n], 0, 0, 0); __builtin_amdgcn_s_setprio(0); } while (0)
#define PG8_WAIT_V(n) asm volatile("s_waitcnt vmcnt(" #n ")" ::: "memory")
#define PG8_WAIT_L(n) asm volatile("s_waitcnt lgkmcnt(" #n ")" ::: "memory")
#define PG8_BAR __builtin_amdgcn_s_barrier()
#define PG8_SCHED __builtin_amdgcn_sched_barrier(0)
    Unit cur, nxt; int ui = 0;
    if (!S.next(0, cur)) return;
    f32x4 acc[2][2][4][2];
#pragma unroll
    for (int a = 0; a < 2; ++a)
#pragma unroll
        for (int b = 0; b < 2; ++b)
#pragma unroll
            for (int m = 0; m < 4; ++m)
#pragma unroll
                for (int n = 0; n < 2; ++n) acc[a][b][m][n] = (f32x4){0.f, 0.f, 0.f, 0.f};
    bf16x8 At[4][2], B0[2][2], B1[2][2];
    const char* cA = (const char*)g.A + 2 * g.offA(cur); const char* cB = (const char*)g.Bt + 2 * g.offB(cur);
    PG8_STAGE(PG8_SB(0, 0), cB, voffB); PG8_STAGE(PG8_SB(0, 1), cB + hstepB, voffB); PG8_STAGE(PG8_SA(0, 0), cA, voffA); PG8_STAGE(PG8_SA(0, 1), cA + hstepA, voffA);
    if (wr == 1) PG8_BAR;
    PG8_WAIT_V(2); PG8_BAR;
    PG8_STAGE(PG8_SB(1, 0), cB + kstep, voffB); PG8_STAGE(PG8_SA(1, 0), cA + kstep, voffA); PG8_STAGE(PG8_SB(1, 1), cB + hstepB + kstep, voffB);
    PG8_WAIT_V(6); PG8_BAR;
    for (;;) {
        const bool has_next = S.next(ui + 1, nxt);
        const char* nA = has_next ? (const char*)g.A + 2 * g.offA(nxt) : cA; const char* nB = has_next ? (const char*)g.Bt + 2 * g.offB(nxt) : cB;
        for (int t = 0; t < nt; t += 2) {
            const bool last = (t == nt - 2);
            const char* a1 = cA + (size_t)(t + 1) * kstep;
            const char* a2 = last ? nA : cA + (size_t)(t + 2) * kstep; const char* b2 = last ? nB : cB + (size_t)(t + 2) * kstep;
            const char* a3 = a2 + kstep; const char* b3 = b2 + kstep;
            if constexpr (Epi::PSLDS) { if (last) {
                const char* psrc = (const char*)(E.PS + (size_t)((cur.z / g.zdiv) * g.psz + cur.pm) * (BM * 16)) + tid * 16;
#pragma unroll
                for (int _i = 0; _i < 2; ++_i) __builtin_amdgcn_global_load_lds((const unsigned*)(psrc + _i * 8192), (LAS unsigned*)(xl + 8192 + ldsw + _i * 8192), 16, 0, 0); } }
            PG8_LDB(B0, 0, 0); PG8_LDB(B1, 0, 1); PG8_SCHED; PG8_LDA(At, 0, 0); PG8_STAGE(PG8_SA(1, 1), a1 + hstepA, voffA);
            PG8_WAIT_V(8); PG8_WAIT_L(0); PG8_BAR; PG8_MMA(0, 0, At, B0); PG8_MMA(0, 1, At, B1); PG8_BAR; PG8_SCHED;
            PG8_LDA(At, 0, 1); PG8_STAGE(PG8_SB(0, 0), b2, voffB); PG8_STAGE(PG8_SB(0, 1), b2 + hstepB, voffB); PG8_STAGE(PG8_SA(0, 0), a2, voffA);
            PG8_WAIT_V(8); PG8_WAIT_L(0); PG8_BAR; PG8_MMA(1, 0, At, B0); PG8_MMA(1, 1, At, B1); PG8_BAR; PG8_SCHED;
            PG8_LDB(B0, 1, 0); PG8_LDB(B1, 1, 1); PG8_SCHED; PG8_LDA(At, 1, 0); PG8_STAGE(PG8_SA(0, 1), a2 + hstepA, voffA);
            PG8_WAIT_V(8); PG8_WAIT_L(0); PG8_BAR; PG8_MMA(0, 0, At, B0); PG8_MMA(0, 1, At, B1); PG8_BAR; PG8_SCHED;
            PG8_LDA(At, 1, 1); PG8_STAGE(PG8_SB(1, 0), b3, voffB); PG8_STAGE(PG8_SB(1, 1), b3 + hstepB, voffB); PG8_STAGE(PG8_SA(1, 0), a3, voffA);
            PG8_WAIT_V(8); PG8_WAIT_L(0); PG8_BAR; PG8_MMA(1, 0, At, B0); PG8_MMA(1, 1, At, B1); PG8_BAR; PG8_SCHED;
        }
        if constexpr (ALIGN_EPI) { if (wr == 0) PG8_BAR; }
        E(acc, cur, g.offC(cur), wr, wc, fr, fq, xl);
        if (!has_next) break;
#pragma unroll
        for (int a = 0; a < 2; ++a)
#pragma unroll
            for (int b = 0; b < 2; ++b)
#pragma unroll
                for (int m = 0; m < 4; ++m)
#pragma unroll
                    for (int n = 0; n < 2; ++n) acc[a][b][m][n] = (f32x4){0.f, 0.f, 0.f, 0.f};
        cur = nxt; cA = nA; cB = nB; ++ui;
        if constexpr (ALIGN_EPI) { if (wr == 1) PG8_BAR; }
    }
    PG8_WAIT_V(0);
    if constexpr (!ALIGN_EPI) { if (wr == 0) PG8_BAR; }
    PG8_BAR;
#undef PG8_SA
#undef PG8_SB
#undef PG8_STAGE
#undef PG8_LDA
#undef PG8_LDB
#undef PG8_MMA
#undef PG8_WAIT_V
#undef PG8_WAIT_L
#undef PG8_BAR
#undef PG8_SCHED
}
}

__device__ __forceinline__ f32x4 mfma16(bf16x8 bfrag, bf16x8 afrag, f32x4 acc) { return __builtin_amdgcn_mfma_f32_16x16x32_bf16(bfrag, afrag, acc, 0, 0, 0); }
__device__ __forceinline__ bf16x8 ldsfrag(const LAS bf16_t* base, int ld, int r0, int k0, int fr, int fq) { return *(const LAS bf16x8*)(base + (r0 + fr) * ld + k0 + fq * 8); }

template <int MODE> __device__ __forceinline__ void transpose_item(const float* W, int K, int N, bf16_t* WT, LAS float* scr, int item, int nblk, int lane, const float* gain = nullptr) {
    const int kb = item / nblk, nb = item % nblk, k0 = 64 * kb, n0 = 32 * nb; const int nsrc = n0 + (lane & 31);
#pragma unroll 8
    for (int i = 0; i < 32; ++i) { const int kk = 2 * i + (lane >> 5); scr[kk * 33 + (lane & 31)] = (nsrc < N) ? W[(size_t)(k0 + kk) * N + nsrc] * (gain ? gain[k0 + kk] : 1.f) : 0.f; }
    LDS_WAIT();
    const int c = lane & 7;
#pragma unroll
    for (int j = 0; j < 4; ++j) { const int n = (lane >> 3) + 8 * j; const LAS float* s = scr + (8 * c) * 33 + n;
        u32x4 o; o.x = pk2(s[0 * 33], s[1 * 33]); o.y = pk2(s[2 * 33], s[3 * 33]); o.z = pk2(s[4 * 33], s[5 * 33]); o.w = pk2(s[6 * 33], s[7 * 33]);
        int drow = n0 + n; if (MODE == 1) { const int jn = drow % FFN, isu = drow / FFN; drow = (jn / 128) * 256 + isu * 128 + (jn % 128); }
        *(u32x4*)(WT + (size_t)drow * K + k0 + 8 * c) = o; }
    LDS_WAIT();
}
__device__ __forceinline__ void rms_row_bf16(const float* xrow, const float* gain, bf16_t* orow, int lane) {
    const f32x4* xr = (const f32x4*)xrow + lane; f32x4 v[4]; float s = 0.f;
#pragma unroll
    for (int j = 0; j < 4; ++j) { v[j] = xr[64 * j]; s += (v[j].x * v[j].x + v[j].y * v[j].y) + (v[j].z * v[j].z + v[j].w * v[j].w); }
    const float rs = rsqrtf(wave_sum(s) * (1.f / D) + 1e-6f);
    const f32x4* gr = (const f32x4*)gain + lane; u32x2* o8 = (u32x2*)orow + lane;
#pragma unroll
    for (int j = 0; j < 4; ++j) { const f32x4 g = gr[64 * j]; u32x2 w; w.x = pk2(v[j].x * rs * g.x, v[j].y * rs * g.y); w.y = pk2(v[j].z * rs * g.z, v[j].w * rs * g.w); o8[64 * j] = w; }
}
__device__ __forceinline__ void rms_row2_bf16(const float* xa, const float* xb, const float* gain, bf16_t* oa, bf16_t* ob, int lane) {
    const f32x4* ra = (const f32x4*)xa + lane; const f32x4* rb = (const f32x4*)xb + lane; f32x4 va[4], vb[4]; float sa = 0.f, sb = 0.f;
#pragma unroll
    for (int j = 0; j < 4; ++j) { va[j] = ra[64 * j]; vb[j] = rb[64 * j]; }
#pragma unroll
    for (int j = 0; j < 4; ++j) { sa += (va[j].x * va[j].x + va[j].y * va[j].y) + (va[j].z * va[j].z + va[j].w * va[j].w); sb += (vb[j].x * vb[j].x + vb[j].y * vb[j].y) + (vb[j].z * vb[j].z + vb[j].w * vb[j].w); }
#pragma unroll
    for (int o = 1; o < 64; o <<= 1) { sa += __shfl_xor(sa, o); sb += __shfl_xor(sb, o); }
    const float rsa = rsqrtf(sa * (1.f / D) + 1e-6f), rsb = rsqrtf(sb * (1.f / D) + 1e-6f);
    const f32x4* gr = (const f32x4*)gain + lane; u32x2* pa = (u32x2*)oa + lane; u32x2* pb = (u32x2*)ob + lane;
#pragma unroll
    for (int j = 0; j < 4; ++j) { const f32x4 g = gr[64 * j]; u32x2 w;
        w.x = pk2(va[j].x * rsa * g.x, va[j].y * rsa * g.y); w.y = pk2(va[j].z * rsa * g.z, va[j].w * rsa * g.w); pa[64 * j] = w;
        w.x = pk2(vb[j].x * rsb * g.x, vb[j].y * rsb * g.y); w.y = pk2(vb[j].z * rsb * g.z, vb[j].w * rsb * g.w); pb[64 * j] = w; }
}
__device__ __forceinline__ void rms_rows_phase(const float* X, const float* gain, bf16_t* H, int nrows, int gw, int NGW, int lane) {
    int m = gw;
    for (; m + NGW < nrows; m += 2 * NGW) rms_row2_bf16(X + (size_t)m * D, X + (size_t)(m + NGW) * D, gain, H + (size_t)m * D, H + (size_t)(m + NGW) * D, lane);
    if (m < nrows) rms_row_bf16(X + (size_t)m * D, gain, H + (size_t)m * D, lane);
}

__device__ __forceinline__ void rwkv_chain(LAS unsigned char* lds, int cid, const bf16_t* P0, const float* mu, const float* w0, const float* w2, const float* a0, const float* a2,
                                           const float* k_k, const float* k_a, const float* r_k, bf16_t* ORW, bf16_t* SG, float* BONUS) {
    const int tid = threadIdx.x, lane = tid & 63, wid = tid >> 6, fr = lane & 15, fq = lane >> 4;
    const int b = cid >> 4, h = (cid >> 1) & 7, dir = cid & 1;
    LAS float* rS = (LAS float*)(lds); LAS float* kS = (LAS float*)(lds + 8192); LAS float* vS = (LAS float*)(lds + 16384); LAS float* wS = (LAS float*)(lds + 24576);
    LAS float* nkS = (LAS float*)(lds + 32768); LAS float* bS = (LAS float*)(lds + 40960); LAS float* preA = (LAS float*)(lds + 49152); LAS float* preW = (LAS float*)(lds + 57344);
    LAS bf16_t* adB = (LAS bf16_t*)(lds + 65536); LAS bf16_t* wdB = (LAS bf16_t*)(lds + 70144);
    LAS bf16_t* a2B = (LAS bf16_t*)(lds + 74752); LAS bf16_t* w2B = (LAS bf16_t*)(lds + 83968); LAS float* cst = (LAS float*)(lds + 93184);
    LAS bf16_t* At = (LAS bf16_t*)(lds + 97280); LAS bf16_t* Bt = (LAS bf16_t*)(lds + 101888); LAS bf16_t* Kt = (LAS bf16_t*)(lds + 106496); LAS bf16_t* Rt = (LAS bf16_t*)(lds + 111104);
    LAS bf16_t* BtT = (LAS bf16_t*)(lds + 115712); LAS bf16_t* KtT = (LAS bf16_t*)(lds + 120832); LAS bf16_t* VT = (LAS bf16_t*)(lds + 125952); LAS bf16_t* S0b = (LAS bf16_t*)(lds + 131072);
    LAS float* NT4 = (LAS float*)(lds + 140288); LAS bf16_t* NakT = (LAS bf16_t*)(lds + 146432); LAS bf16_t* MbrT = (LAS bf16_t*)(lds + 148992); LAS bf16_t* MkrT = (LAS bf16_t*)(lds + 151552);
    LAS float* gL = (LAS float*)(lds + 154112);
    LAS float* WS = preA;
    LAS bf16_t* Ub = (LAS bf16_t*)preW;
#define RW_IDS int tid_o = threadIdx.x; asm volatile("" : "+v"(tid_o)); const int tid = tid_o, lane = tid & 63, wid = __builtin_amdgcn_readfirstlane(tid >> 6), fr = lane & 15, fq = lane >> 4, vt = wid >> 1, tt2 = wid & 1; (void)lane; (void)wid; (void)fr; (void)fq; (void)vt; (void)tt2;
    __syncthreads();
    for (int e = tid; e < 64 * 64; e += 512) { const int j = e & 63, r = e >> 6;
        a2B[j * 72 + r] = (bf16_t)f2bf(a2[r * 512 + h * 64 + j]); w2B[j * 72 + r] = (bf16_t)f2bf(w2[(dir * 64 + r) * 512 + h * 64 + j]); }
    for (int e = tid; e < 64 * 72 / 2; e += 512) ((LAS unsigned*)S0b)[e] = 0u;
    if (tid < 64) { const int j = tid, c = h * 64 + j;
        cst[0 * 64 + j] = a0[c]; cst[1 * 64 + j] = w0[dir * 512 + c]; cst[2 * 64 + j] = k_k[c]; cst[3 * 64 + j] = k_a[c]; cst[4 * 64 + j] = r_k[c];
        cst[5 * 64 + j] = mu[c]; cst[6 * 64 + j] = mu[512 + c]; cst[7 * 64 + j] = mu[1024 + c]; cst[8 * 64 + j] = mu[1536 + j]; cst[9 * 64 + j] = mu[1600 + j];
        cst[10 * 64 + j] = (j < 16) ? mu[1664 + h * 16 + j] : 0.f; }
    const int vt = wid >> 1, tt2 = wid & 1;
    f32x4 st[2]; st[0] = (f32x4){0.f, 0.f, 0.f, 0.f}; st[1] = st[0];
    __syncthreads();
    const bf16_t* Pb = P0 + (size_t)b * SEQ * ABPAD;
    unsigned rc[10], rpv[10], rnx[10]; unsigned short gcv = 0, gpv = 0, gnv = 0;
#define RW_IDX(i) const int grp = (i) >> 1; const int idx_ = tid + 512 * ((i) & 1); const int tok = idx_ >> 5, c2 = (idx_ & 31) * 2; \
                  const int gcol = (grp == 0 ? h * 64 : grp == 1 ? 512 + h * 64 : grp == 2 ? 1024 + h * 64 : grp == 3 ? 1536 : 1600) + c2;
    const unsigned voff = (unsigned)((((int)threadIdx.x >> 5) * ABPAD + ((int)threadIdx.x & 31) * 2) * 2);
#define RW_CG(g) ((g) == 0 ? h * 128 : (g) == 1 ? 1024 + h * 128 : (g) == 2 ? 2048 + h * 128 : (g) == 3 ? 3072 : 3200)
#define RW_ISSUE(t0n) do { const char* bp_ = (const char*)(Pb + (size_t)(t0n) * ABPAD); const bool first_ = ((t0n) == 0) && (tid < 32), last_ = ((t0n) == SEQ - 32) && (tid >= 480); \
        _Pragma("unroll") for (int i = 0; i < 10; ++i) { const char* p = bp_ + (RW_CG(i >> 1) + (i & 1) * 16 * ABPAD * 2) + voff; \
            rc[i] = *(const unsigned*)p; \
            if ((i & 1) == 0) { const unsigned v_ = *(const unsigned*)(p - (first_ ? 0 : ABPAD * 2)); rpv[i] = first_ ? 0u : v_; rnx[i] = *(const unsigned*)(p + ABPAD * 2); } \
            else { const unsigned v_ = *(const unsigned*)(p + (last_ ? 0 : ABPAD * 2)); rnx[i] = last_ ? 0u : v_; rpv[i] = *(const unsigned*)(p - ABPAD * 2); } } \
        if (dir == 0) { const bool fg_ = ((t0n) == 0) && (tid < 16), lg_ = ((t0n) == SEQ - 32) && (tid >= 496); \
            const bf16_t* p = (const bf16_t*)bp_ + (size_t)(tid >> 4) * ABPAD + 1664 + h * 16 + (tid & 15); \
            gcv = *p; { const unsigned short v_ = *(p - (fg_ ? 0 : ABPAD)); gpv = fg_ ? (unsigned short)0 : v_; } { const unsigned short v_ = *(p + (lg_ ? 0 : ABPAD)); gnv = lg_ ? (unsigned short)0 : v_; } } } while (0)
    RW_ISSUE(dir ? 127 * 32 : 0);
    for (int cc = 0; cc < 128; ++cc) {
        const int t0 = dir ? (127 - cc) * 32 : cc * 32;
        { RW_IDS
#pragma unroll
        for (int i = 0; i < 10; ++i) { RW_IDX(i) (void)gcol;
            const unsigned cur = rc[i], prv = rpv[i], nxt = rnx[i];
            const float m0 = cst[(5 + grp) * 64 + c2], m1 = cst[(5 + grp) * 64 + c2 + 1];
            const float c0 = bflo(cur), c1 = bfhi(cur);
            const float x0 = c0 + m0 * (0.5f * (bflo(prv) + bflo(nxt)) - c0), x1 = c1 + m1 * (0.5f * (bfhi(prv) + bfhi(nxt)) - c1);
            if (grp == 0) { *(LAS f32x2*)(rS + tok * 64 + c2) = (f32x2){x0, x1}; }
            else if (grp == 1) { *(LAS f32x2*)(kS + tok * 64 + c2) = (f32x2){x0, x1}; }
            else if (grp == 2) { *(LAS f32x2*)(vS + tok * 64 + c2) = (f32x2){x0, x1}; }
            else if (grp == 3) { const float e0 = __expf(2.f * x0), e1 = __expf(2.f * x1); *(LAS unsigned*)(wdB + tok * 72 + c2) = pk2(1.f - 2.f * frcp(e0 + 1.f), 1.f - 2.f * frcp(e1 + 1.f)); }
            else { *(LAS unsigned*)(adB + tok * 72 + c2) = pk2(x0, x1); }
        }
        if (dir == 0) {
            const int tok = tid >> 4, c = tid & 15, t = t0 + tok;
            const float cur = bf2f(gcv), prv = bf2f(gpv), nxt = bf2f(gnv);
            const float x = cur + cst[10 * 64 + c] * (0.5f * (prv + nxt) - cur);
            SG[((size_t)b * SEQ + t) * 128 + h * 16 + c] = (bf16_t)f2bf(sigmoidf_(x));
        } }
        __syncthreads();
        if (cc + 1 < 128) { RW_IDS const int t0n = dir ? (126 - cc) * 32 : (cc + 1) * 32; RW_ISSUE(t0n); }
        { RW_IDS const int mat = wid >> 2, ntile = wid & 3; const LAS bf16_t* Aop = mat ? wdB : adB; const LAS bf16_t* Bop = mat ? w2B : a2B; LAS float* pre = mat ? preW : preA;
#pragma unroll
          for (int mt = 0; mt < 2; ++mt) { f32x4 acc = (f32x4){0.f, 0.f, 0.f, 0.f};
#pragma unroll
              for (int ks = 0; ks < 2; ++ks) acc = mfma16(ldsfrag(Bop, 72, ntile * 16, ks * 32, fr, fq), ldsfrag(Aop, 72, mt * 16, ks * 32, fr, fq), acc);
              *(LAS f32x4*)(pre + (mt * 16 + fr) * 64 + ntile * 16 + fq * 4) = acc; } }
        __syncthreads();
        { RW_IDS const int tok = tid >> 4, c0 = (tid & 15) * 4; float kkr[4], av[4], kp[4], wv[4]; float ss = 0.f, bon = 0.f;
#pragma unroll
          for (int i = 0; i < 4; ++i) { const int c = c0 + i, ix = tok * 64 + c;
              const float a = sigmoidf_(cst[c] + preA[ix]); const float sg = sigmoidf_(cst[64 + c] + preW[ix]);
              wv[i] = -0.60653065971f * sg;
              const float kraw = kS[ix]; kkr[i] = kraw * cst[128 + c]; ss += kkr[i] * kkr[i];
              kp[i] = kraw * (1.0f + (a - 1.0f) * cst[192 + c]); av[i] = a; bon += rS[ix] * kp[i] * cst[256 + c]; }
          ss += dppf<0xB1>(ss); bon += dppf<0xB1>(bon); ss += dppf<0x4E>(ss); bon += dppf<0x4E>(bon);
          ss += dppf<0x141>(ss); bon += dppf<0x141>(bon); ss += dppf<0x140>(ss); bon += dppf<0x140>(bon);
          const float inv = frcp(fmaxf(__builtin_amdgcn_sqrtf(ss), 1e-12f));
          f32x4 o_nk, o_b, o_k, o_w;
#pragma unroll
          for (int i = 0; i < 4; ++i) { const float kk = kkr[i] * inv; o_nk[i] = -kk; o_b[i] = kk * av[i]; o_k[i] = kp[i]; o_w[i] = wv[i]; }
          *(LAS f32x4*)(nkS + tok * 64 + c0) = o_nk; *(LAS f32x4*)(bS + tok * 64 + c0) = o_b; *(LAS f32x4*)(kS + tok * 64 + c0) = o_k; *(LAS f32x4*)(wS + tok * 64 + c0) = o_w;
          if (dir == 0 && (tid & 15) == 0) BONUS[((size_t)b * SEQ + t0 + tok) * 8 + h] = bon; }
        __syncthreads();
        { RW_IDS if (tid < 64) { float lw[32];
#pragma unroll
            for (int s = 0; s < 32; ++s) lw[s] = wS[(dir ? 31 - s : s) * 64 + tid];
#pragma unroll
            for (int s = 1; s < 32; ++s) lw[s] += lw[s - 1];
#pragma unroll
            for (int s = 0; s < 32; ++s) wS[(dir ? 31 - s : s) * 64 + tid] = lw[s]; } }
        __syncthreads();
        { RW_IDS const int s = tid >> 4, c0 = (tid & 15) * 4; const int tok = dir ? 31 - s : s, tokp = dir ? tok + 1 : tok - 1;
          const f32x4 cum = *(const LAS f32x4*)(wS + tok * 64 + c0); f32x4 cump = (f32x4){0.f, 0.f, 0.f, 0.f}; if (s > 0) cump = *(const LAS f32x4*)(wS + tokp * 64 + c0);
          const f32x4 nk4 = *(const LAS f32x4*)(nkS + tok * 64 + c0), b4 = *(const LAS f32x4*)(bS + tok * 64 + c0), k4 = *(const LAS f32x4*)(kS + tok * 64 + c0), r4 = *(const LAS f32x4*)(rS + tok * 64 + c0), v4 = *(const LAS f32x4*)(vS + tok * 64 + c0);
          float ta[4], tb[4], tk[4], tr[4];
#pragma unroll
          for (int i = 0; i < 4; ++i) { const float g = __expf(cum[i]), gp = __expf(cump[i]), ig = __expf(-cum[i]);
              ta[i] = nk4[i] * gp; tb[i] = b4[i] * ig; tk[i] = k4[i] * ig; tr[i] = r4[i] * g;
              BtT[(c0 + i) * 40 + s] = (bf16_t)f2bf(tb[i]); KtT[(c0 + i) * 40 + s] = (bf16_t)f2bf(tk[i]); VT[(c0 + i) * 40 + s] = (bf16_t)f2bf(v4[i]);
              if (s == 31) gL[c0 + i] = g; }
          u32x2 w; w.x = pk2(ta[0], ta[1]); w.y = pk2(ta[2], ta[3]); *(LAS u32x2*)(At + s * 72 + c0) = w;
          w.x = pk2(tb[0], tb[1]); w.y = pk2(tb[2], tb[3]); *(LAS u32x2*)(Bt + s * 72 + c0) = w;
          w.x = pk2(tk[0], tk[1]); w.y = pk2(tk[2], tk[3]); *(LAS u32x2*)(Kt + s * 72 + c0) = w;
          w.x = pk2(tr[0], tr[1]); w.y = pk2(tr[2], tr[3]); *(LAS u32x2*)(Rt + s * 72 + c0) = w; }
        __syncthreads();
        { RW_IDS const int mat = wid >> 1, mt = wid & 1; const LAS bf16_t* Aop = (mat < 2) ? At : Rt; const LAS bf16_t* Bop = (mat & 1) ? Kt : Bt;
#pragma unroll
          for (int nt = 0; nt < 2; ++nt) { f32x4 acc = (f32x4){0.f, 0.f, 0.f, 0.f};
#pragma unroll
              for (int ks = 0; ks < 2; ++ks) acc = mfma16(ldsfrag(Bop, 72, nt * 16, ks * 32, fr, fq), ldsfrag(Aop, 72, mt * 16, ks * 32, fr, fq), acc);
              const int srow = mt * 16 + fr;
#pragma unroll
              for (int e = 0; e < 4; ++e) { const int i = nt * 16 + fq * 4 + e; const bool keep = (mat < 2) ? (i < srow) : (i <= srow); if (!keep) acc[e] = 0.f; }
              if (mat == 0) {
#pragma unroll
                  for (int e = 0; e < 4; ++e) NT4[e * 384 + srow * 12 + nt * 4 + fq] = acc[e]; }
              else { LAS bf16_t* X = (mat == 1) ? NakT : (mat == 2) ? MbrT : MkrT; u32x2 o; o.x = pk2(acc[0], acc[1]); o.y = pk2(acc[2], acc[3]); *(LAS u32x2*)(X + srow * 40 + nt * 16 + fq * 4) = o; } } }
        __syncthreads();
        f32x4 oacc = (f32x4){0.f, 0.f, 0.f, 0.f};
        { RW_IDS f32x4 wacc = (f32x4){0.f, 0.f, 0.f, 0.f};
#pragma unroll
          for (int ks = 0; ks < 2; ++ks) { const bf16x8 sf = ldsfrag(S0b, 72, vt * 16, ks * 32, fr, fq);
              wacc = mfma16(ldsfrag(At, 72, tt2 * 16, ks * 32, fr, fq), sf, wacc); oacc = mfma16(ldsfrag(Rt, 72, tt2 * 16, ks * 32, fr, fq), sf, oacc); }
          const bf16x8 vf = ldsfrag(VT, 40, vt * 16, 0, fr, fq);
          wacc = mfma16(ldsfrag(NakT, 40, tt2 * 16, 0, fr, fq), vf, wacc); oacc = mfma16(ldsfrag(MkrT, 40, tt2 * 16, 0, fr, fq), vf, oacc);
#pragma unroll
          for (int n2 = 0; n2 < 2; ++n2) st[n2] = mfma16(ldsfrag(KtT, 40, (tt2 * 2 + n2) * 16, 0, fr, fq), vf, st[n2]);
#pragma unroll
          for (int e = 0; e < 4; ++e) WS[(tt2 * 16 + fq * 4 + e) * 64 + vt * 16 + fr] = wacc[e]; }
        __syncthreads();
        { RW_IDS if (wid < 4) { const int v = wid * 16 + (lane >> 2), p = lane & 3; const LAS float* NTp = NT4 + p * 384; float u[8];
#pragma unroll
            for (int j = 0; j < 8; ++j) u[j] = 0.f;
#pragma unroll
            for (int t = 0; t < 32; ++t) { float q0 = (p == 0) ? WS[t * 64 + v] : 0.f, q1 = 0.f;
#pragma unroll
                for (int j4 = 0; j4 < ((t + 3) / 4 + 3) / 4; ++j4) { const f32x4 nv = *(const LAS f32x4*)(NTp + t * 12 + j4 * 4);
                    q0 += u[j4 * 4] * nv[0]; q1 += u[j4 * 4 + 1] * nv[1]; q0 += u[j4 * 4 + 2] * nv[2]; q1 += u[j4 * 4 + 3] * nv[3]; }
                float q = q0 + q1; q += dppf<0xB1>(q); q += dppf<0x4E>(q);
                u[t >> 2] = ((t & 3) == p) ? q : u[t >> 2]; asm volatile("" ::: "memory"); }
#pragma unroll
            for (int j = 0; j < 8; ++j) Ub[v * 40 + 4 * j + p] = (bf16_t)f2bf(u[j]); } }
        __syncthreads();
        { RW_IDS const bf16x8 uf = ldsfrag(Ub, 40, vt * 16, 0, fr, fq);
          oacc = mfma16(ldsfrag(MbrT, 40, tt2 * 16, 0, fr, fq), uf, oacc);
#pragma unroll
          for (int e = 0; e < 4; ++e) { const int sidx = tt2 * 16 + fq * 4 + e, tok = dir ? 31 - sidx : sidx;
              ORW[(size_t)dir * T * 512 + ((size_t)b * SEQ + t0 + tok) * 512 + h * 64 + vt * 16 + fr] = (bf16_t)f2bf(oacc[e]); }
#pragma unroll
          for (int n2 = 0; n2 < 2; ++n2) { const int kt = tt2 * 2 + n2; st[n2] = mfma16(ldsfrag(BtT, 40, kt * 16, 0, fr, fq), uf, st[n2]);
              const f32x4 gl = *(const LAS f32x4*)(gL + kt * 16 + fq * 4); st[n2] = st[n2] * gl;
              u32x2 o; o.x = pk2(st[n2][0], st[n2][1]); o.y = pk2(st[n2][2], st[n2][3]); *(LAS u32x2*)(S0b + (vt * 16 + fr) * 72 + kt * 16 + fq * 4) = o; } }
    }
#undef RW_IDX
#undef RW_ISSUE
#undef RW_IDS
#undef RW_CG
    __syncthreads();
}

__device__ __forceinline__ void rwkv_combine(const bf16_t* P0, const bf16_t* ORW, const float* BONUS, const bf16_t* G, const float* mu, const float* gn_w, const float* gn_b, bf16_t* OMIX, int gw, int NGW, int lane) {
    const int c0 = lane * 8, head = lane >> 3;
    float muv[8], gw8[8], gb8[8];
#pragma unroll
    for (int i = 0; i < 8; ++i) { muv[i] = mu[1024 + c0 + i]; gw8[i] = gn_w[c0 + i]; gb8[i] = gn_b[c0 + i]; }
#pragma unroll 2
    for (int tk = gw; tk < T; tk += NGW) {
        const int t = tk & (SEQ - 1);
        const u32x4 uf = *(const u32x4*)(ORW + (size_t)tk * 512 + c0), ub = *(const u32x4*)(ORW + (size_t)T * 512 + (size_t)tk * 512 + c0);
        float o[8];
#pragma unroll
        for (int i = 0; i < 4; ++i) { o[2 * i] = bflo(uf[i]) + bflo(ub[i]); o[2 * i + 1] = bfhi(uf[i]) + bfhi(ub[i]); }
        float s = 0.f;
#pragma unroll
        for (int i = 0; i < 8; ++i) s += o[i];
        const float mean = sum8(s) * (1.f / 64.f); float q = 0.f;
#pragma unroll
        for (int i = 0; i < 8; ++i) { o[i] -= mean; q += o[i] * o[i]; }
        const float rstd = rsqrtf(sum8(q) * (1.f / 64.f) + 64e-5f);
        const bf16_t* pv = P0 + (size_t)tk * ABPAD + 1024 + c0;
        const u32x4 vc = *(const u32x4*)pv; u32x4 vp = (u32x4){0u, 0u, 0u, 0u}, vn = (u32x4){0u, 0u, 0u, 0u};
        if (t > 0) vp = *(const u32x4*)(pv - ABPAD);
        if (t < SEQ - 1) vn = *(const u32x4*)(pv + ABPAD);
        const u32x4 gg = *(const u32x4*)(G + (size_t)tk * 512 + c0);
        const float bon = BONUS[(size_t)tk * 8 + head];
        float r[8];
#pragma unroll
        for (int i = 0; i < 4; ++i) {
            const float c_lo = bflo(vc[i]), c_hi = bfhi(vc[i]);
            const float v_lo = c_lo + muv[2 * i] * (0.5f * (bflo(vp[i]) + bflo(vn[i])) - c_lo), v_hi = c_hi + muv[2 * i + 1] * (0.5f * (bfhi(vp[i]) + bfhi(vn[i])) - c_hi);
            r[2 * i] = (o[2 * i] * rstd * gw8[2 * i] + gb8[2 * i] + bon * v_lo) * bflo(gg[i]);
            r[2 * i + 1] = (o[2 * i + 1] * rstd * gw8[2 * i + 1] + gb8[2 * i + 1] + bon * v_hi) * bfhi(gg[i]); }
        u32x4 w; w.x = pk2(r[0], r[1]); w.y = pk2(r[2], r[3]); w.z = pk2(r[4], r[5]); w.w = pk2(r[6], r[7]);
        *(u32x4*)(OMIX + (size_t)tk * D + c0) = w;
    }
}

constexpr int SLD = 136;
__device__ __forceinline__ float softplusf_(float x) { return x > 20.f ? x : log1pf(__expf(x)); }
__device__ __forceinline__ void ssd_dt_cum(LAS float* dtS, LAS float* cumS, LAS float* totS, const bf16_t* Prow0, int g, int w, int lane, const float* dt_bias, const float* a_log) {
    const int j = w >> 1, d = w & 1, head = g * 4 + j;
    const float bias = dt_bias[d * 8 + head], A = -__expf(a_log[d * 8 + head]);
    const float x0 = bf2f(Prow0[(size_t)(2 * lane) * ABPAD + 3328 + head]), x1 = bf2f(Prow0[(size_t)(2 * lane + 1) * ABPAD + 3328 + head]);
    const float dt0 = softplusf_(x0 + bias), dt1 = softplusf_(x1 + bias), la0 = dt0 * A, la1 = dt1 * A;
    const float s = la0 + la1; float inc = s;
#pragma unroll
    for (int off = 1; off < 64; off <<= 1) { const float n = __shfl_up(inc, off); if (lane >= off) inc += n; }
    const float tot = __shfl(inc, 63), exc = inc - s;
    float c0, c1; if (d == 0) { c0 = exc + la0; c1 = inc; } else { c0 = tot - exc; c1 = tot - exc - la0; }
    dtS[w * 128 + 2 * lane] = dt0; dtS[w * 128 + 2 * lane + 1] = dt1; cumS[w * 128 + 2 * lane] = c0; cumS[w * 128 + 2 * lane + 1] = c1;
    if (lane == 0) totS[w] = tot;
}
template <int NR, bool TR> __device__ __forceinline__ void ssd_conv8(LAS bf16_t* dst, int col0, int cx0, int l0, const bf16_t* Pb, int t0, const float* cw, const float* cb) {
    u32x4 raw[NR + 2];
    const bf16_t* p = Pb + (size_t)(t0 + l0) * ABPAD + 2304 + cx0;
#pragma unroll
    for (int i = 0; i < NR + 2; ++i) { const int t = t0 + l0 + i - 1; raw[i] = (t >= 0 && t < SEQ) ? *(const u32x4*)(p + (long)(i - 1) * ABPAD) : (u32x4){0u, 0u, 0u, 0u}; }
    float w0[8], w1[8], w2[8], bs[8];
#pragma unroll
    for (int q = 0; q < 2; ++q) { const f32x4 a = *(const f32x4*)(cw + cx0 + 4 * q), bq = *(const f32x4*)(cw + 1024 + cx0 + 4 * q), c = *(const f32x4*)(cw + 2048 + cx0 + 4 * q), d = *(const f32x4*)(cb + cx0 + 4 * q);
#pragma unroll
        for (int i = 0; i < 4; ++i) { w0[4 * q + i] = a[i]; w1[4 * q + i] = bq[i]; w2[4 * q + i] = c[i]; bs[4 * q + i] = d[i]; } }
    float o[NR][8];
#pragma unroll
    for (int i = 0; i < NR; ++i)
#pragma unroll
        for (int c = 0; c < 8; ++c) { const unsigned um = raw[i][c >> 1], u0 = raw[i + 1][c >> 1], up = raw[i + 2][c >> 1];
            const float fm = (c & 1) ? bfhi(um) : bflo(um), f0 = (c & 1) ? bfhi(u0) : bflo(u0), fp = (c & 1) ? bfhi(up) : bflo(up);
            o[i][c] = siluf_(w0[c] * fm + w1[c] * f0 + w2[c] * fp + bs[c]); }
    if (TR) {
#pragma unroll
        for (int c = 0; c < 8; ++c) { LAS bf16_t* q = dst + (col0 + c) * SLD + l0;
            if (NR == 8) { u32x4 w; w.x = pk2(o[0][c], o[1][c]); w.y = pk2(o[2][c], o[3][c]); w.z = pk2(o[4 % NR][c], o[5 % NR][c]); w.w = pk2(o[6 % NR][c], o[7 % NR][c]); *(LAS u32x4*)q = w; }
            else { u32x2 w; w.x = pk2(o[0][c], o[1][c]); w.y = pk2(o[2][c], o[3][c]); *(LAS u32x2*)q = w; } }
    } else {
#pragma unroll
        for (int i = 0; i < NR; ++i) { u32x4 w; w.x = pk2(o[i][0], o[i][1]); w.y = pk2(o[i][2], o[i][3]); w.z = pk2(o[i][4], o[i][5]); w.w = pk2(o[i][6], o[i][7]); *(LAS u32x4*)(dst + (l0 + i) * SLD + col0) = w; }
    }
}
__device__ __forceinline__ void ssd_s1_unit(LAS unsigned char* lds, int unit, const bf16_t* P0, const float* cw, const float* cb, const float* dt_bias, const float* a_log, bf16_t* STATES, float* TOT) {
    const int tid = threadIdx.x, lane = tid & 63, w = tid >> 6, fr = lane & 15, fq = lane >> 4;
    const int g = unit & 1, c = (unit >> 1) & 31, b = unit >> 6, t0 = c * 128;
    LAS bf16_t* BT = (LAS bf16_t*)lds; LAS bf16_t* XT = (LAS bf16_t*)(lds + 34816); LAS float* dtS = (LAS float*)(lds + 104448); LAS float* cumS = (LAS float*)(lds + 108544);
    LAS float* scS = (LAS float*)(lds + 112640); LAS float* totS = (LAS float*)(lds + 116736);
    const bf16_t* Pb = P0 + (size_t)b * SEQ * ABPAD;
    __syncthreads();
    ssd_conv8<4, true>(BT, (tid & 15) * 8, 512 + g * 128 + (tid & 15) * 8, (tid >> 4) * 4, Pb, t0, cw, cb);
    ssd_conv8<8, true>(XT, (tid & 31) * 8, g * 256 + (tid & 31) * 8, (tid >> 5) * 8, Pb, t0, cw, cb);
    ssd_dt_cum(dtS, cumS, totS, Pb + (size_t)t0 * ABPAD, g, w, lane, dt_bias, a_log);
    __syncthreads();
    for (int e = tid; e < 1024; e += 512) scS[e] = dtS[e] * __expf(totS[e >> 7] - cumS[e]);
    if (tid < 8) TOT[((size_t)(b * 32 + c) * 2 + (tid & 1)) * 8 + g * 4 + (tid >> 1)] = totS[tid];
    __syncthreads();
    const int j = w >> 1;
#pragma unroll 1
    for (int d = 0; d < 2; ++d) {
        f32x4 acc[2][8];
#pragma unroll
        for (int mt = 0; mt < 2; ++mt)
#pragma unroll
            for (int nt = 0; nt < 8; ++nt) acc[mt][nt] = (f32x4){0.f, 0.f, 0.f, 0.f};
#pragma unroll 1
        for (int ks = 0; ks < 4; ++ks) {
            const int k0 = ks * 32; const LAS float* sp = scS + (j * 2 + d) * 128 + k0 + fq * 8;
            const f32x4 s0 = *(const LAS f32x4*)sp, s1 = *(const LAS f32x4*)(sp + 4);
            bf16x8 afr[2];
#pragma unroll
            for (int mt = 0; mt < 2; ++mt) { const u32x4 raw = *(const LAS u32x4*)(XT + (32 * w + mt * 16 + fr) * SLD + k0 + fq * 8); u32x4 o;
                o.x = pk2(bflo(raw.x) * s0[0], bfhi(raw.x) * s0[1]); o.y = pk2(bflo(raw.y) * s0[2], bfhi(raw.y) * s0[3]);
                o.z = pk2(bflo(raw.z) * s1[0], bfhi(raw.z) * s1[1]); o.w = pk2(bflo(raw.w) * s1[2], bfhi(raw.w) * s1[3]);
                afr[mt] = __builtin_bit_cast(bf16x8, o); }
#pragma unroll
            for (int nt = 0; nt < 8; ++nt) { const bf16x8 bfr = ldsfrag(BT, SLD, nt * 16, k0, fr, fq);
#pragma unroll
                for (int mt = 0; mt < 2; ++mt) acc[mt][nt] = mfma16(bfr, afr[mt], acc[mt][nt]); }
        }
        bf16_t* dst = STATES + (((size_t)(b * 32 + c) * 2 + d) * 8 + g * 4 + j) * 8192;
#pragma unroll
        for (int mt = 0; mt < 2; ++mt) { const int p = (w & 1) * 32 + mt * 16 + fr;
#pragma unroll
            for (int nt = 0; nt < 8; ++nt) { u32x2 o; o.x = pk2(acc[mt][nt][0], acc[mt][nt][1]); o.y = pk2(acc[mt][nt][2], acc[mt][nt][3]);
                *(u32x2*)(dst + p * 128 + nt * 16 + fq * 4) = o; } }
    }
}
__device__ __forceinline__ void ssd_s2(const bf16_t* __restrict__ STATES, bf16_t* __restrict__ CARR, const float* __restrict__ TOT, int gtid, int NGT) {
    for (int it = gtid; it < 16 * 2 * 8 * 1024; it += NGT) {
        const int e8 = it & 1023, head = (it >> 10) & 7, d = (it >> 13) & 1, b = it >> 14;
        float run[8];
#pragma unroll
        for (int i = 0; i < 8; ++i) run[i] = 0.f;
#pragma unroll 1
        for (int c8 = 0; c8 < 32; c8 += 8) {
            u32x4 loc[8]; float dec[8];
#pragma unroll
            for (int q = 0; q < 8; ++q) { const int cc = c8 + q, c = d ? 31 - cc : cc; const size_t sidx = ((size_t)(b * 32 + c) * 2 + d) * 8 + head;
                loc[q] = *(const u32x4*)(STATES + sidx * 8192 + e8 * 8); dec[q] = TOT[sidx]; }
#pragma unroll
            for (int q = 0; q < 8; ++q) { const int cc = c8 + q, c = d ? 31 - cc : cc; const size_t sidx = ((size_t)(b * 32 + c) * 2 + d) * 8 + head;
                u32x4 o; o.x = pk2(run[0], run[1]); o.y = pk2(run[2], run[3]); o.z = pk2(run[4], run[5]); o.w = pk2(run[6], run[7]); *(u32x4*)(CARR + sidx * 8192 + e8 * 8) = o;
                const float dq = __expf(dec[q]);
#pragma unroll
                for (int i = 0; i < 4; ++i) { run[2 * i] = run[2 * i] * dq + bflo(loc[q][i]); run[2 * i + 1] = run[2 * i + 1] * dq + bfhi(loc[q][i]); } }
        }
    }
}
__device__ __forceinline__ void ssd_s3_unit(LAS unsigned char* lds, int unit, const bf16_t* P0, const float* cw, const float* cb, const float* dt_bias, const float* a_log, const float* dskip, const float* norm_w,
                                            const bf16_t* STATES, bf16_t* OMIX) {
    const int tid = threadIdx.x, lane = tid & 63, w = tid >> 6, fr = lane & 15, fq = lane >> 4;
    const int g = unit & 1, c = (unit >> 1) & 31, b = unit >> 6, t0 = c * 128;
    LAS bf16_t* CS = (LAS bf16_t*)lds; LAS bf16_t* BS = (LAS bf16_t*)(lds + 34816); LAS bf16_t* XT = (LAS bf16_t*)(lds + 69632);
    LAS float* dtS = (LAS float*)(lds + 139264); LAS float* cumS = (LAS float*)(lds + 143360); LAS float* totS = (LAS float*)(lds + 147456);
    const bf16_t* Pb = P0 + (size_t)b * SEQ * ABPAD;
    __syncthreads();
    ssd_conv8<4, false>(BS, (tid & 15) * 8, 512 + g * 128 + (tid & 15) * 8, (tid >> 4) * 4, Pb, t0, cw, cb);
    ssd_conv8<4, false>(CS, (tid & 15) * 8, 768 + g * 128 + (tid & 15) * 8, (tid >> 4) * 4, Pb, t0, cw, cb);
    ssd_conv8<8, true>(XT, (tid & 31) * 8, g * 256 + (tid & 31) * 8, (tid >> 5) * 8, Pb, t0, cw, cb);
    ssd_dt_cum(dtS, cumS, totS, Pb + (size_t)t0 * ABPAD, g, w, lane, dt_bias, a_log);
    __syncthreads();
    const int l = 16 * w + fr;
    f32x4 sc[8];
#pragma unroll
    for (int nt = 0; nt < 8; ++nt) sc[nt] = (f32x4){0.f, 0.f, 0.f, 0.f};
#pragma unroll
    for (int ks = 0; ks < 4; ++ks) { const bf16x8 afr = ldsfrag(CS, SLD, 16 * w, ks * 32, fr, fq);
#pragma unroll
        for (int nt = 0; nt < 8; ++nt) sc[nt] = mfma16(ldsfrag(BS, SLD, nt * 16, ks * 32, fr, fq), afr, sc[nt]); }
    __syncthreads();
    LAS bf16_t* Mw = BS + w * 16 * SLD;
    const size_t row = (size_t)b * SEQ + t0 + l; float ss = 0.f;
#pragma unroll 1
    for (int j = 0; j < 4; ++j) {
        const LAS float* cf = cumS + (j * 2) * 128; const LAS float* cbw = cumS + (j * 2 + 1) * 128; const LAS float* df = dtS + (j * 2) * 128; const LAS float* db = dtS + (j * 2 + 1) * 128;
        const float cfl = cf[l], cbl = cbw[l];
        const size_t sbase = ((size_t)(b * 32 + c) * 2) * 8 + g * 4 + j;
        const bf16_t* carf = STATES + sbase * 8192; const bf16_t* carb = STATES + (sbase + 8) * 8192;
        bf16x8 cF[4][4], cB[4][4]; u32x2 zz4[4];
#pragma unroll
        for (int ks = 0; ks < 4; ++ks)
#pragma unroll
            for (int pt = 0; pt < 4; ++pt) cF[ks][pt] = *(const bf16x8*)(carf + (pt * 16 + fr) * 128 + ks * 32 + fq * 8);
#pragma unroll
        for (int pt = 0; pt < 4; ++pt) zz4[pt] = *(const u32x2*)(P0 + row * ABPAD + 1792 + g * 256 + j * 64 + pt * 16 + fq * 4);
#pragma unroll
        for (int nt = 0; nt < 8; ++nt) { float mv[4];
#pragma unroll
            for (int i = 0; i < 4; ++i) { const int s = nt * 16 + fq * 4 + i;
                const float ff = (s <= l) ? __expf(cfl - cf[s]) * df[s] : 0.f; const float fb = (s >= l) ? __expf(cbl - cbw[s]) * db[s] : 0.f;
                mv[i] = sc[nt][i] * (ff + fb); }
            u32x2 o; o.x = pk2(mv[0], mv[1]); o.y = pk2(mv[2], mv[3]); *(LAS u32x2*)(Mw + fr * SLD + nt * 16 + fq * 4) = o; }
        LDS_WAIT();
#pragma unroll
        for (int ks = 0; ks < 4; ++ks)
#pragma unroll
            for (int pt = 0; pt < 4; ++pt) cB[ks][pt] = *(const bf16x8*)(carb + (pt * 16 + fr) * 128 + ks * 32 + fq * 8);
        f32x4 yd[4], yf[4], yb[4];
#pragma unroll
        for (int pt = 0; pt < 4; ++pt) { yd[pt] = (f32x4){0.f, 0.f, 0.f, 0.f}; yf[pt] = yd[pt]; yb[pt] = yd[pt]; }
        bf16x8 acs[4];
#pragma unroll
        for (int ks = 0; ks < 4; ++ks) {
            const bf16x8 am = *(const LAS bf16x8*)(Mw + fr * SLD + ks * 32 + fq * 8); acs[ks] = ldsfrag(CS, SLD, 16 * w, ks * 32, fr, fq);
#pragma unroll
            for (int pt = 0; pt < 4; ++pt) {
                yd[pt] = mfma16(ldsfrag(XT, SLD, j * 64 + pt * 16, ks * 32, fr, fq), am, yd[pt]);
                yf[pt] = mfma16(cF[ks][pt], acs[ks], yf[pt]); }
        }
#pragma unroll
        for (int ks = 0; ks < 4; ++ks)
#pragma unroll
            for (int pt = 0; pt < 4; ++pt) yb[pt] = mfma16(cB[ks][pt], acs[ks], yb[pt]);
        const float ef = __expf(cfl), eb = __expf(cbl), dsk = dskip[g * 4 + j];
#pragma unroll
        for (int pt = 0; pt < 4; ++pt) { const f32x4 yv = yd[pt] + yf[pt] * ef + yb[pt] * eb;
            const int col = j * 64 + pt * 16 + fq * 4; const u32x2 zz = zz4[pt];
            const float z4[4] = {bflo(zz.x), bfhi(zz.x), bflo(zz.y), bfhi(zz.y)}; float v4[4];
#pragma unroll
            for (int i = 0; i < 4; ++i) { const float xs = bf2f(XT[(col + i) * SLD + l]); float v = yv[i] + dsk * xs; const float z = z4[i]; v = v * siluf_(z);
                v4[i] = v; ss += v * v; }
            u32x2 o; o.x = pk2(v4[0], v4[1]); o.y = pk2(v4[2], v4[3]); *(u32x2*)(OMIX + row * D + 512 + g * 256 + col) = o; }
        asm volatile("" ::: "memory");
    }
    ss += __shfl_xor(ss, 16); ss += __shfl_xor(ss, 32);
    const float rs = rsqrtf(ss * (1.f / 256.f) + 1e-6f);
    asm volatile("s_waitcnt vmcnt(0)" ::: "memory");
#pragma unroll 4
    for (int q = 0; q < 16; ++q) { const int col = g * 256 + q * 16 + fq * 4; const f32x4 nw = *(const f32x4*)(norm_w + col);
        u32x2* p = (u32x2*)(OMIX + row * D + 512 + col); const u32x2 v = *p;
        u32x2 o; o.x = pk2(bflo(v.x) * rs * nw[0], bfhi(v.x) * rs * nw[1]); o.y = pk2(bflo(v.y) * rs * nw[2], bfhi(v.y) * rs * nw[3]); *p = o; }
}

constexpr int HLD = 136, HLS = 72;
__device__ __forceinline__ void hgrn_chain(LAS unsigned char* lds, int cid, bf16_t* P1, const float* hg_lb, bf16_t* Ob, int ldo, int ocbase, int ocdir) {
    const int tid = threadIdx.x, lane = tid & 63, w = tid >> 6, fr = lane & 15, fq = lane >> 4;
    const int b = cid >> 4, h = (cid >> 1) & 7, dir = cid & 1;
    LAS bf16_t* QE = (LAS bf16_t*)lds;
    LAS bf16_t* KE = (LAS bf16_t*)(lds + 17408);
    LAS bf16_t* KLT = (LAS bf16_t*)(lds + 34816);
    LAS bf16_t* VT = (LAS bf16_t*)(lds + 53248);
    LAS bf16_t* AT = (LAS bf16_t*)(lds + 71680);
    LAS bf16_t* ST = (LAS bf16_t*)(lds + 80896);
    LAS float* totS = (LAS float*)(lds + 115712);
    LAS float* lastS = (LAS float*)(lds + 117760);
    __syncthreads();
    for (int e = tid; e < 128 * HLD / 2; e += 512) ((LAS unsigned*)ST)[e] = 0u;
    const int dcol = tid & 127, qtr = tid >> 7, i0 = qtr * 16;
    const float lbv = frcp(1.0f + __expf(hg_lb[h * 128 + dcol] - hg_lb[1024 + h * 128 + dcol]));
    f32x4 st[8];
#pragma unroll
    for (int i = 0; i < 8; ++i) st[i] = (f32x4){0.f, 0.f, 0.f, 0.f};
    bf16_t* Pb = P1 + (size_t)b * SEQ * HGP;
    __syncthreads();
    unsigned short rq[16], rf[16], rv[16];
#define HG_ISSUE(t0n) do { _Pragma("unroll") for (int i = 0; i < 16; ++i) { const int tk = (t0n) + (dir ? 63 - (i0 + i) : (i0 + i)); const bf16_t* pr = Pb + (size_t)tk * HGP + h * 128 + dcol; \
        rq[i] = pr[0]; rf[i] = pr[1024 * (1 + dir)]; rv[i] = pr[3072]; } } while (0)
    HG_ISSUE((dir ? 63 : 0) * 64);
    for (int cc = 0; cc < 64; ++cc) {
        const int t0 = (dir ? 63 - cc : cc) * 64;
        float gq[16], gk[16], gc[16]; float run = 1.0f;
#pragma unroll
        for (int i = 0; i < 16; ++i) { const float q = bf2f(rq[i]), fr_ = bf2f(rf[i]);
            const float f = lbv + (1.0f - lbv) * sigmoidf_(fr_); run *= f; gq[i] = q; gk[i] = 1.0f - f; gc[i] = run; }
        totS[qtr * 128 + dcol] = run;
#pragma unroll
        for (int i = 0; i < 16; i += 2) *(LAS unsigned*)(VT + dcol * HLS + i0 + i) = (unsigned)rv[i] | ((unsigned)rv[i + 1] << 16);
        __syncthreads();
        { float pre = 1.0f, tot = 1.0f;
#pragma unroll
          for (int q4 = 0; q4 < 4; ++q4) { const float tq = totS[q4 * 128 + dcol]; if (q4 < qtr) pre *= tq; tot *= tq; }
          const float etot = tot;
          if (qtr == 0) lastS[dcol] = etot;
#pragma unroll
          for (int i = 0; i < 16; i += 2) { const float e0 = fmaxf(pre * gc[i], 1e-30f), e1 = fmaxf(pre * gc[i + 1], 1e-30f), n0 = frcp(e0), n1 = frcp(e1), l0 = etot * n0, l1 = etot * n1;
              QE[(i0 + i) * HLD + dcol] = (bf16_t)f2bf(gq[i] * e0); QE[(i0 + i + 1) * HLD + dcol] = (bf16_t)f2bf(gq[i + 1] * e1);
              KE[(i0 + i) * HLD + dcol] = (bf16_t)f2bf(gk[i] * n0); KE[(i0 + i + 1) * HLD + dcol] = (bf16_t)f2bf(gk[i + 1] * n1);
              *(LAS unsigned*)(KLT + dcol * HLS + i0 + i) = pk2(gk[i] * l0, gk[i + 1] * l1); } }
        if (cc + 1 < 64) HG_ISSUE((dir ? 62 - cc : cc + 1) * 64);
        __syncthreads();
        { const int mt = w >> 1;
#pragma unroll
          for (int n2 = 0; n2 < 2; ++n2) { const int nt = (w & 1) * 2 + n2; f32x4 acc = (f32x4){0.f, 0.f, 0.f, 0.f};
#pragma unroll
              for (int ks = 0; ks < 4; ++ks) acc = mfma16(ldsfrag(KE, HLD, nt * 16, ks * 32, fr, fq), ldsfrag(QE, HLD, mt * 16, ks * 32, fr, fq), acc);
              const int lrow = mt * 16 + fr; float mv[4];
#pragma unroll
              for (int i = 0; i < 4; ++i) { const int s = nt * 16 + fq * 4 + i; mv[i] = (s <= lrow) ? acc[i] : 0.f; }
              u32x2 o; o.x = pk2(mv[0], mv[1]); o.y = pk2(mv[2], mv[3]); *(LAS u32x2*)(AT + lrow * HLS + nt * 16 + fq * 4) = o; } }
        __syncthreads();
        { const int mt = w >> 1;
#pragma unroll
          for (int n4 = 0; n4 < 4; ++n4) { const int nt = (w & 1) * 4 + n4; f32x4 acc = (f32x4){0.f, 0.f, 0.f, 0.f};
#pragma unroll
              for (int ks = 0; ks < 2; ++ks) acc = mfma16(ldsfrag(VT, HLS, nt * 16, ks * 32, fr, fq), ldsfrag(AT, HLS, mt * 16, ks * 32, fr, fq), acc);
#pragma unroll
              for (int ks = 0; ks < 4; ++ks) acc = mfma16(ldsfrag(ST, HLD, nt * 16, ks * 32, fr, fq), ldsfrag(QE, HLD, mt * 16, ks * 32, fr, fq), acc);
              const int i = mt * 16 + fr, tk = t0 + (dir ? 63 - i : i);
              u32x2 o; o.x = pk2(acc[0], acc[1]); o.y = pk2(acc[2], acc[3]);
              *(u32x2*)(Ob + ((size_t)b * SEQ + tk) * ldo + ocbase + ocdir * dir + h * 128 + nt * 16 + fq * 4) = o; } }
#pragma unroll
        for (int nt = 0; nt < 8; ++nt) { const f32x4 el = *(const LAS f32x4*)(lastS + nt * 16 + fq * 4); st[nt] = st[nt] * el;
#pragma unroll
            for (int ks = 0; ks < 2; ++ks) st[nt] = mfma16(ldsfrag(KLT, HLS, nt * 16, ks * 32, fr, fq), ldsfrag(VT, HLS, w * 16, ks * 32, fr, fq), st[nt]); }
        __syncthreads();
#pragma unroll
        for (int nt = 0; nt < 8; ++nt) { u32x2 o; o.x = pk2(st[nt][0], st[nt][1]); o.y = pk2(st[nt][2], st[nt][3]); *(LAS u32x2*)(ST + (w * 16 + fr) * HLD + nt * 16 + fq * 4) = o; }
    }
    __syncthreads();
}
__device__ __forceinline__ void hgrn_combine(const bf16_t* P1, const float* norm_w, bf16_t* OMIX, int gw, int NGW, int lane) {
    const int c0 = lane * 16;
#pragma unroll 2
    for (int tk = gw; tk < T; tk += NGW) {
        const bf16_t* pr = P1 + (size_t)tk * HGP + c0; float o[16]; float ss = 0.f;
#pragma unroll
        for (int hh = 0; hh < 2; ++hh) { const u32x4 uf = *(const u32x4*)(pr + 1024 + hh * 8), ub = *(const u32x4*)(pr + 2048 + hh * 8);
#pragma unroll
            for (int i = 0; i < 4; ++i) { o[hh * 8 + 2 * i] = bflo(uf[i]) + bflo(ub[i]); o[hh * 8 + 2 * i + 1] = bfhi(uf[i]) + bfhi(ub[i]); } }
#pragma unroll
        for (int i = 0; i < 16; ++i) ss += o[i] * o[i];
        const float rs = rsqrtf(sum8(ss) * (1.f / 128.f) + 1e-6f);
#pragma unroll
        for (int hh = 0; hh < 2; ++hh) { const u32x4 ug = *(const u32x4*)(pr + 4096 + hh * 8); float r[8];
#pragma unroll
            for (int i = 0; i < 4; ++i) { const float g0 = bflo(ug[i]), g1 = bfhi(ug[i]);
                r[2 * i] = o[hh * 8 + 2 * i] * rs * norm_w[c0 + hh * 8 + 2 * i] * siluf_(g0);
                r[2 * i + 1] = o[hh * 8 + 2 * i + 1] * rs * norm_w[c0 + hh * 8 + 2 * i + 1] * siluf_(g1); }
            u32x4 wv; wv.x = pk2(r[0], r[1]); wv.y = pk2(r[2], r[3]); wv.z = pk2(r[4], r[5]); wv.w = pk2(r[6], r[7]);
            *(u32x4*)(OMIX + (size_t)tk * D + c0 + hh * 8) = wv; }
    }
}

#define XB_TMO      128
#define XB_XCNT(j)  (256  + 64 * (j))
#define XB_XSUB(j)  (1280 + 64 * (j))
#define XB_XGEN(j)  (2304 + 64 * (j))
#define XB_TOP      3328
#define XB_TOPGEN   3392
#define XCD_BAR_WORDS 3456
#define XB_SPIN_CAP (1u << 18)

__device__ __forceinline__ unsigned xb_ld(unsigned* p)              { return __hip_atomic_load(p, __ATOMIC_RELAXED, __HIP_MEMORY_SCOPE_AGENT); }
__device__ __forceinline__ unsigned xb_add(unsigned* p, unsigned v) { return __hip_atomic_fetch_add(p, v, __ATOMIC_RELAXED, __HIP_MEMORY_SCOPE_AGENT); }
__device__ __forceinline__ unsigned xb_xcc_id() { return (unsigned)__builtin_amdgcn_s_getreg((3 << 11) | 20) & 0xFu; }
#define XB_SPIN(cond, bar) do { unsigned _sp = 0; while (cond) { __builtin_amdgcn_s_sleep(1); \
    if ((++_sp & 255u) == 0u) { if (xb_ld(&(bar)[XB_TMO])) break; if (_sp > XB_SPIN_CAP) { atomicAdd(&(bar)[XB_TMO], 1u); break; } } } } while (0)

struct XcdBarrier {
    unsigned* bar; unsigned x;
    volatile LAS unsigned* st;
};

__device__ __forceinline__ XcdBarrier xcd_barrier_post(unsigned* bar, volatile LAS unsigned* st) {
    XcdBarrier b; b.bar = bar; b.x = xb_xcc_id(); b.st = st;
    if (threadIdx.x == 0) (void)xb_add(&bar[XB_XCNT(b.x)], 1u);
    return b;
}
__device__ __forceinline__ void xcd_barrier_complete(unsigned* bar, unsigned x, unsigned& nloc, unsigned& nx) {
    const unsigned G = gridDim.x * gridDim.y * gridDim.z;
    unsigned sum, cnt, mine, sp = 0u;
    for (;;) {
        sum = 0u; cnt = 0u; mine = 0u;
#pragma unroll
        for (unsigned j = 0; j < 16; ++j) { const unsigned c = xb_ld(&bar[XB_XCNT(j)]); sum += c; cnt += (c > 0u) ? 1u : 0u; mine = (j == x) ? c : mine; }
        if (sum == G) break;
        __builtin_amdgcn_s_sleep(1);
        if ((++sp & 255u) == 0u) { if (xb_ld(&bar[XB_TMO])) break; if (sp > XB_SPIN_CAP) { atomicAdd(&bar[XB_TMO], 1u); break; } }
    }
    nloc = mine > 0u ? mine : 1u; nx = cnt > 0u ? cnt : 1u;
}

__device__ __forceinline__ void xcd_barrier(const XcdBarrier& b) {
    asm volatile("s_waitcnt vmcnt(0)" ::: "memory");
    __syncthreads();
    if (threadIdx.x == 0) {
        unsigned* bar = b.bar;
        __builtin_amdgcn_s_waitcnt(0);
        unsigned nloc = b.st[0], nx = b.st[1];
        if (nloc == 0u) { xcd_barrier_complete(bar, b.x, nloc, nx); b.st[0] = nloc; b.st[1] = nx; }
        const unsigned old = xb_add(&bar[XB_XSUB(b.x)], 1u);
        const unsigned gen = old / nloc;
        if (old + 1u == (gen + 1u) * nloc) {
            __builtin_amdgcn_fence(__ATOMIC_RELEASE, "agent");
            asm volatile("s_waitcnt vmcnt(0)" ::: "memory");
            const unsigned og = xb_add(&bar[XB_TOP], 1u);
            const unsigned tg = og / nx;
            if (og + 1u == (tg + 1u) * nx) xb_add(&bar[XB_TOPGEN], 1u);
            else XB_SPIN(xb_ld(&bar[XB_TOPGEN]) == tg, bar);
            __builtin_amdgcn_fence(__ATOMIC_ACQUIRE, "agent");
            xb_add(&bar[XB_XGEN(b.x)], 1u);
            asm volatile("s_waitcnt vmcnt(0)" ::: "memory");
        } else {
            XB_SPIN(xb_ld(&bar[XB_XGEN(b.x)]) == gen, bar);
            __builtin_amdgcn_fence(__ATOMIC_ACQUIRE, "agent");
            asm volatile("s_waitcnt vmcnt(0)" ::: "memory");
        }
    }
    __syncthreads();
}


struct Args { const float* in[35]; float* out; unsigned char* ws; int ph_lo, ph_hi; };
static_assert(sizeof(Args) == 304, "Args layout");

__global__ void __launch_bounds__(512, 2) mk_fwd(Args args) {
    extern __shared__ __attribute__((aligned(16))) unsigned char lds_raw[];
    LAS unsigned char* lds = (LAS unsigned char*)lds_raw; LAS unsigned char* xl = lds + XLDS_OFF;
    const int G = gridDim.x, bx = blockIdx.x, NGW = G * 8;
#define LOCAL_IDS int tid = threadIdx.x; asm volatile("" : "+v"(tid)); const int lane = tid & 63, wave = __builtin_amdgcn_readfirstlane(tid >> 6), gw = bx * 8 + wave; (void)lane; (void)gw;
    typedef const __attribute__((address_space(4))) unsigned char* kaptr_t;
    kaptr_t ka = (kaptr_t)__builtin_amdgcn_kernarg_segment_ptr();
#define INP(k) (*(const float* const volatile __attribute__((address_space(4)))*)(ka + 8 * (k)))
    unsigned char* ws = *(unsigned char* const volatile __attribute__((address_space(4)))*)(ka + 288); float* out = *(float* const volatile __attribute__((address_space(4)))*)(ka + 280);
    const float* x = INP(0);
    bf16_t* WAB = (bf16_t*)(ws + WS_WAB); bf16_t* WABO = (bf16_t*)(ws + WS_WABO); bf16_t* WHG = (bf16_t*)(ws + WS_WHG); bf16_t* WHGO = (bf16_t*)(ws + WS_WHGO);
    bf16_t* WQ = (bf16_t*)(ws + WS_WQ); bf16_t* WKV = (bf16_t*)(ws + WS_WKV); bf16_t* WO = (bf16_t*)(ws + WS_WO); bf16_t* WF1 = (bf16_t*)(ws + WS_WF1); bf16_t* WF2 = (bf16_t*)(ws + WS_WF2);
    bf16_t* G2T = (bf16_t*)(ws + WS_G2T); bf16_t* MEMN = (bf16_t*)(ws + WS_MEMN); bf16_t* KMEM = (bf16_t*)(ws + WS_KMEM);
    bf16_t* WKT = (bf16_t*)out; bf16_t* VWT = (bf16_t*)((unsigned char*)out + 64 * MiB);
    bf16_t* H = (bf16_t*)(ws + WS_H); bf16_t* P = (bf16_t*)(ws + WS_P); bf16_t* PATT = (bf16_t*)(ws + WS_PATT); bf16_t* OMIX0 = (bf16_t*)(ws + WS_OMIX0); bf16_t* OMIX1 = (bf16_t*)(ws + WS_OMIX1); float* PSB = (float*)(ws + WS_PS);
#define COMMA ,
    bf16_t* STATES = (bf16_t*)((unsigned char*)out + DO_STATES); bf16_t* GG = (bf16_t*)((unsigned char*)out + DO_G); bf16_t* SG = (bf16_t*)((unsigned char*)out + DO_SG);
    float* BONUS = (float*)((unsigned char*)out + DO_BONUS); float* TOT = (float*)((unsigned char*)out + DO_TOT);
    cg::grid_group grid = cg::this_grid();
    { volatile LAS unsigned* st_ = (volatile LAS unsigned*)(lds + LDS_BYTES - 16); if (threadIdx.x < 4) st_[threadIdx.x] = 0u; }
    __syncthreads();
    const XcdBarrier xbar = xcd_barrier_post((unsigned*)ws, (volatile LAS unsigned*)(lds + LDS_BYTES - 16));
    const int lo = *(const int volatile __attribute__((address_space(4)))*)(ka + 296), hi = *(const int volatile __attribute__((address_space(4)))*)(ka + 300);
#ifndef PH_EN
#define PH_EN(k) 1
#endif
#define IN(k) (PH_EN(k) && lo <= (k) && (k) < hi)
#ifndef DUP_MASK
#define DUP_MASK 0ull
#endif
#define REPS(k) (1 + (int)(((unsigned long long)(DUP_MASK) >> (k)) & 1ull))
#define PHASE(k) for (int rep_ = 0; rep_ < (IN(k) ? REPS(k) : 0); ++rep_, ((REPS(k) > 1) ? (grid.sync(), 0) : 0))
#define SEAM(k) do { if (IN(k) && IN((k) + 1)) xcd_barrier(xbar); } while (0)
    if (lo < 0) grid.sync();
#define RUN_GEMM(EPI, ALIGN, gd, ep) do { pg8::Order S_; S_.init(gd, G, bx); pg8::gemm_phase<EPI, ALIGN>(lds, xl, gd, S_, ep); } while (0)

    PHASE(0) { LOCAL_IDS
        LAS float* scr = (LAS float*)(lds + wave * 16384);
        constexpr int I_AB = 16 * 112, I_SQ = 16 * 32, I_HG = 16 * 160, I_KV = 16 * 64, I_F1 = 16 * 176, I_F2 = 44 * 32, I_G2 = 2 * 16;
        constexpr int NIT = I_AB + I_SQ + I_HG + I_SQ + 2 * I_KV + 2 * I_SQ + 2 * I_F1 + 2 * I_F2 + I_G2;
        for (int it = gw; it < NIT; it += NGW) {
            int r = it;
            if (r < I_AB) { transpose_item<0>(INP(3), 1024, ABP, WAB, scr, r, 112, lane); continue; } r -= I_AB;
            if (r < I_SQ) { transpose_item<0>(INP(4), 1024, 1024, WABO, scr, r, 32, lane); continue; } r -= I_SQ;
            if (r < I_HG) { transpose_item<0>(INP(22), 1024, HGP, WHG, scr, r, 160, lane, INP(2) + D); continue; } r -= I_HG;
            if (r < I_SQ) { transpose_item<0>(INP(23), 1024, 1024, WHGO, scr, r, 32, lane); continue; } r -= I_SQ;
            if (r < 2 * I_KV) { const int l = r / I_KV; transpose_item<0>(INP(29) + (size_t)l * D * 2048, 1024, 2048, WKV + (size_t)l * D * 2048, scr, r % I_KV, 64, lane); continue; } r -= 2 * I_KV;
            if (r < 2 * I_SQ) { const int l = r / I_SQ; transpose_item<0>(INP(30) + (size_t)l * D * D, 1024, 1024, WO + (size_t)l * D * D, scr, r % I_SQ, 32, lane); continue; } r -= 2 * I_SQ;
            if (r < 2 * I_F1) { const int l = r / I_F1; transpose_item<1>(INP(32) + (size_t)l * D * 2 * FFN, 1024, 2 * FFN, WF1 + (size_t)l * D * 2 * FFN, scr, r % I_F1, 176, lane, INP(31) + l * D); continue; } r -= 2 * I_F1;
            if (r < 2 * I_F2) { const int l = r / I_F2; transpose_item<0>(INP(33) + (size_t)l * FFN * D, FFN, 1024, WF2 + (size_t)l * FFN * D, scr, r % I_F2, 32, lane); continue; } r -= 2 * I_F2;
            transpose_item<0>(INP(10), 128, 512, G2T, scr, r, 16, lane);
        }
        for (size_t e8 = (size_t)bx * 512 + tid; e8 < (size_t)2 * D * D / 8; e8 += (size_t)G * 512) { const size_t idx = e8 * 8; const int l = (int)(idx / ((size_t)D * D)), k = (int)((idx % ((size_t)D * D)) / D);
            const float gk = INP(26)[l * D + k]; const f32x4 a0 = *(const f32x4*)(INP(28) + idx), a1 = *(const f32x4*)(INP(28) + idx + 4);
            u32x4 o; o.x = pk2(a0[0] * gk, a0[1] * gk); o.y = pk2(a0[2] * gk, a0[3] * gk); o.z = pk2(a1[0] * gk, a1[1] * gk); o.w = pk2(a1[2] * gk, a1[3] * gk); *(u32x4*)(WQ + idx) = o; }
        rms_rows_phase(x, INP(2), H, T, gw, NGW, lane);
        for (int m = gw; m < 2 * 4096; m += NGW) { const int l = m >> 12, r = m & 4095; rms_row_bf16(INP(1) + (size_t)r * D, INP(27) + l * D, MEMN + (size_t)m * D, lane); }
        __syncthreads();
    }
    SEAM(0);
    PHASE(1) {
        { pg8::Gemm g = pg8::make_gemm(H, WAB, T, ABPAD, 1024, 1024, 1024); pg8::EpiBf16 E{P, ABPAD, 1.0f, nullptr}; RUN_GEMM(pg8::EpiBf16, true, g, E); }
        { pg8::Gemm g = pg8::make_gemm(MEMN, WKV, 4096, 2048, 1024, 1024, 1024); g.nZ = 2; g.sAo = 4096L * D; g.sBo = 2048L * D; g.sCo = 4096L * 2048; pg8::EpiBf16 E{KMEM, 2048, 1.0f, nullptr}; RUN_GEMM(pg8::EpiBf16, true, g, E); }
    }
    SEAM(1);
    PHASE(2) {
#ifndef DUP_RWKV
#define DUP_RWKV 0
#endif
#ifndef DUP_S1
#define DUP_S1 0
#endif
        for (int r2 = 0; r2 <= DUP_RWKV; ++r2)
        for (int cid = bx; cid < 256; cid += G)
            rwkv_chain(lds, cid, P, INP(5), INP(6), INP(7), INP(8), INP(9), INP(11), INP(12), INP(13), H, SG, BONUS);
        for (int r2 = 0; r2 <= DUP_S1; ++r2)
        for (int u = bx; u < 1024; u += G) ssd_s1_unit(lds, u, P, INP(16), INP(17), INP(18), INP(19), STATES, TOT);
        __syncthreads();
    }
    SEAM(2);
    PHASE(3) {
        { int k128 = 128; asm volatile("" : "+s"(k128)); pg8::Gemm g = pg8::make_gemm(SG, G2T, T, 512, k128, 128, 128); pg8::EpiBf16 E{GG, 512, 1.0f, nullptr}; RUN_GEMM(pg8::EpiBf16, true, g, E); }
        { LOCAL_IDS ssd_s2(STATES, OMIX1, TOT, bx * 512 + tid, G * 512); }
    }
    SEAM(3);
    PHASE(4) {
#ifndef DUP_S3
#define DUP_S3 0
#endif
        for (int r2 = 0; r2 <= DUP_S3; ++r2)
        for (int u = bx; u < 1024; u += G) ssd_s3_unit(lds, u, P, INP(16), INP(17), INP(18), INP(19), INP(20), INP(21), OMIX1, OMIX0);
        __syncthreads();
        { LOCAL_IDS rwkv_combine(P, H, BONUS, GG, INP(5), INP(14), INP(15), OMIX0, gw, NGW, lane); }
    }
    SEAM(4);
    PHASE(5) { { pg8::Gemm g = pg8::make_gemm(OMIX0, WABO, T, 1024, 1024, 1024, 1024); pg8::EpiResidB E{x, H, PSB, 1024}; RUN_GEMM(pg8::EpiResidB, true, g, E); }
        for (int l = 0; l < 2; ++l) {
            { pg8::Gemm g = pg8::make_gemm(KMEM + (size_t)l * 4096 * 2048, WQ + (size_t)l * D * D, 256, 1024, 256, 2048, 1024); g.nZ = 64; g.zdiv = 4;
              g.sAo = 256L * 2048; g.sAi = 256; g.sBo = 0; g.sBi = 256; g.sCo = 4L * 256 * 1024; g.sCi = 256L * 1024; pg8::EpiBf16 E{WKT + (size_t)l * 16777216, 1024, 0.0625f, nullptr}; RUN_GEMM(pg8::EpiBf16, true, g, E); }
            { pg8::Gemm g = pg8::make_gemm(WO + (size_t)l * D * D, KMEM + (size_t)l * 4096 * 2048 + 1024, 1024, 256, 256, 1024, 2048); g.nZ = 64; g.zdiv = 4;
              g.sAo = 0; g.sAi = 256; g.sBo = 256L * 2048; g.sBi = 256; g.sCo = 1024L * 1024; g.sCi = 256; pg8::EpiBf16 E{VWT + (size_t)l * 16777216, 1024, 1.0f, nullptr}; RUN_GEMM(pg8::EpiBf16, true, g, E); }
        } }
    SEAM(5);

#define ATTN_FFN(base, L) \
    PHASE(base) { pg8::Gemm g = pg8::make_gemm(H, WKT + (size_t)(L) * 16777216, SEQ, 256, 1024, 1024, 1024); g.nZ = 64; g.zdiv = 4; g.psz = 16; \
        g.sAo = (long)SEQ * D; g.sAi = 0; g.sBo = 4L * 256 * 1024; g.sBi = 256L * 1024; g.sCo = (long)SEQ * D; g.sCi = 256; pg8::EpiSoftmaxPS E{PSB, PATT, 1024}; RUN_GEMM(pg8::EpiSoftmaxPS, true, g, E); } \
    SEAM(base); \
    PHASE(base + 1) { pg8::Gemm g = pg8::make_gemm(PATT, VWT + (size_t)(L) * 16777216, SEQ, 1024, 1024, 1024, 1024); g.nZ = 16; g.zdiv = 1; \
        g.sAo = (long)SEQ * D; g.sBo = 1024L * 1024; g.sCo = (long)SEQ * D; pg8::EpiResidB E{nullptr, H, PSB, 1024}; RUN_GEMM(pg8::EpiResidB, true, g, E); } \
    SEAM(base + 1); \
    PHASE(base + 2) { pg8::Gemm g = pg8::make_gemm(H, WF1 + (size_t)(L) * D * 2 * FFN, T, 2 * FFN, 1024, 1024, 1024); pg8::EpiSwiglu E{P, FFN, PSB}; RUN_GEMM(pg8::EpiSwiglu, true, g, E); } \
    SEAM(base + 2); \
    PHASE(base + 3) { pg8::Gemm g = pg8::make_gemm(P, WF2 + (size_t)(L) * FFN * D, T, 1024, FFN, FFN, FFN); pg8::EpiResidB E{nullptr, H, PSB, 1024}; RUN_GEMM(pg8::EpiResidB, true, g, E); } \
    SEAM(base + 3);

    ATTN_FFN(6, 0)

    PHASE(10) { pg8::Gemm g = pg8::make_gemm(H, WHG, T, HGP, 1024, 1024, 1024); pg8::EpiBf16PS E{P, HGP, 1.0f, PSB}; RUN_GEMM(pg8::EpiBf16PS, true, g, E); }
    SEAM(10);
    PHASE(11) { for (int cid = bx; cid < 256; cid += G) hgrn_chain(lds, cid, P, INP(25), P, HGP, 1024, 1024); }
    SEAM(11);
    PHASE(12) { LOCAL_IDS hgrn_combine(P, INP(24), OMIX1, gw, NGW, lane); }
    SEAM(12);
    PHASE(13) { pg8::Gemm g = pg8::make_gemm(OMIX1, WHGO, T, 1024, 1024, 1024, 1024); pg8::EpiResidB E{nullptr, H, PSB, 1024}; RUN_GEMM(pg8::EpiResidB, true, g, E); }
    SEAM(13);

    ATTN_FFN(14, 1)

    PHASE(18) { LOCAL_IDS
        const float* fg = INP(34);
#pragma unroll 2
        for (int m = gw; m < T; m += NGW) {
            const f32x4 pa = *(const f32x4*)(PSB + (size_t)m * 16 + (lane & 3) * 4); float sq = (pa[0] + pa[1]) + (pa[2] + pa[3]); sq += __shfl_xor(sq, 1); sq += __shfl_xor(sq, 2);
            const float rs = rsqrtf(sq * (1.f / D) + 1e-6f);
            const bf16_t* hr = H + (size_t)m * D; float* orow = out + (size_t)m * D;
#pragma unroll
            for (int j = 0; j < 2; ++j) { const int c = (lane + 64 * j) * 8; const u32x4 hv = *(const u32x4*)(hr + c); const f32x4 g0 = *(const f32x4*)(fg + c), g1 = *(const f32x4*)(fg + c + 4);
                *(f32x4*)(orow + c) = (f32x4){bflo(hv.x) * rs * g0[0], bfhi(hv.x) * rs * g0[1], bflo(hv.y) * rs * g0[2], bfhi(hv.y) * rs * g0[3]};
                *(f32x4*)(orow + c + 4) = (f32x4){bflo(hv.z) * rs * g1[0], bfhi(hv.z) * rs * g1[1], bflo(hv.w) * rs * g1[2], bfhi(hv.w) * rs * g1[3]}; } }
    }
#undef IN
#undef SEAM
#undef RUN_GEMM
}

extern "C" void kernel_launch(void* const* d_in, const int* in_sizes, int n_in, void* d_out, int out_size, void* d_ws, size_t ws_size, hipStream_t stream) {
    static int grid = 0;
    if (grid == 0) {
        if (n_in != 35 || out_size != T * D || ws_size < WS_END) { fprintf(stderr, "kernel_launch: unexpected shapes (n_in %d out %d ws %zu)\n", n_in, out_size, ws_size); grid = -1; return; }
        int dev = 0, cus = 0, per_cu = 0;
        hipGetDevice(&dev); hipDeviceGetAttribute(&cus, hipDeviceAttributeMultiprocessorCount, dev);
        hipFuncSetAttribute((const void*)mk_fwd, hipFuncAttributeMaxDynamicSharedMemorySize, LDS_BYTES);
        hipOccupancyMaxActiveBlocksPerMultiprocessor(&per_cu, (const void*)mk_fwd, 512, LDS_BYTES);
        if (per_cu < 1) { fprintf(stderr, "kernel_launch: occupancy query says %d blocks per CU\n", per_cu); per_cu = 1; }
        (void)hipGetLastError();
        grid = cus * 1;
    }
    if (grid < 0) return;
    if (hipMemsetAsync(d_ws, 0, 65536, stream) != hipSuccess) { fprintf(stderr, "kernel_launch: memset of the barrier words failed\n"); return; }
    Args a{};
    for (int i = 0; i < 35; ++i) a.in[i] = (const float*)d_in[i];
    a.out = (float*)d_out; a.ws = (unsigned char*)d_ws;
#if MK_COOP
    a.ph_lo = 0; a.ph_hi = NPHASE;
    void* kargs[] = {&a};
    hipError_t e = hipLaunchCooperativeKernel((const void*)mk_fwd, dim3(grid), dim3(512), kargs, LDS_BYTES, stream);
    if (e != hipSuccess) fprintf(stderr, "cooperative launch failed: %s (grid %d)\n", hipGetErrorString(e), grid);
#else
    for (int ph = 0; ph < NPHASE; ++ph) { a.ph_lo = ph; a.ph_hi = ph + 1; hipLaunchKernelGGL(mk_fwd, dim3(grid), dim3(512), LDS_BYTES, stream, a); }
#endif
}
```

```cpp
#include <hip/hip_runtime.h>
#include <hip/hip_cooperative_groups.h>
#include <cstdio>
#include <cstdint>
namespace cg = cooperative_groups;

#ifndef MK_COOP
#define MK_COOP 1
#endif

#define LAS __attribute__((address_space(3)))
typedef unsigned short bf16_t;
typedef short bf16x8 __attribute__((ext_vector_type(8)));
typedef float f32x4 __attribute__((ext_vector_type(4)));
typedef float f32x2 __attribute__((ext_vector_type(2)));
typedef unsigned u32x4 __attribute__((ext_vector_type(4)));
typedef unsigned u32x2 __attribute__((ext_vector_type(2)));

constexpr int NB = 16, SEQ = 4096, T = NB * SEQ, D = 1024;
constexpr int ABPAD = 3584, ABP = 3336;
constexpr int HGP = 5120;
constexpr int FFN = 2816;
constexpr int NPHASE = 19;

constexpr size_t MiB = 1u << 20;
constexpr size_t WS_WAB = 1 * MiB, WS_WABO = 8 * MiB, WS_WHG = 10 * MiB, WS_WHGO = 20 * MiB, WS_WQ = 22 * MiB, WS_WKV = 26 * MiB, WS_WO = 34 * MiB,
                 WS_WF1 = 38 * MiB, WS_WF2 = 60 * MiB, WS_G2T = 71 * MiB, WS_MEMN = 72 * MiB, WS_KMEM = 88 * MiB, WS_VT = 104 * MiB,
                 WS_PS = 120 * MiB, WS_H = 128 * MiB, WS_P = 256 * MiB, WS_PATT = 384 * MiB, WS_OMIX0 = 704 * MiB, WS_OMIX1 = 896 * MiB, WS_END = 1024 * MiB;
constexpr size_t DO_STATES = 0, DO_G = 128 * MiB, DO_SG = 192 * MiB, DO_BONUS = 208 * MiB, DO_TOT = 210 * MiB;

constexpr int LDS_BYTES = 163840;
constexpr int XLDS_OFF = 131072;

typedef __bf16 bf16x2_t __attribute__((ext_vector_type(2)));
__device__ __forceinline__ unsigned pk2(float lo, float hi) { const f32x2 v = {lo, hi}; return __builtin_bit_cast(unsigned, __builtin_convertvector(v, bf16x2_t)); }
__device__ __forceinline__ unsigned f2bf(float f) { return pk2(f, 0.f) & 0xffffu; }
__device__ __forceinline__ float bf2f(unsigned short b) { return __builtin_bit_cast(float, (unsigned)b << 16); }
__device__ __forceinline__ float bflo(unsigned u) { return __builtin_bit_cast(float, u << 16); }
__device__ __forceinline__ float bfhi(unsigned u) { return __builtin_bit_cast(float, u & 0xffff0000u); }
__device__ __forceinline__ float frcp(float x) { return __builtin_amdgcn_rcpf(x); }
__device__ __forceinline__ float sigmoidf_(float x) { return frcp(1.0f + __expf(-x)); }
__device__ __forceinline__ float siluf_(float x) { return x * frcp(1.0f + __expf(-x)); }
__device__ __forceinline__ float wave_sum(float v) {
#pragma unroll
    for (int o = 1; o < 64; o <<= 1) v += __shfl_xor(v, o);
    return v;
}
template <int CTRL> __device__ __forceinline__ float dppf(float x) { return __builtin_bit_cast(float, __builtin_amdgcn_mov_dpp(__builtin_bit_cast(int, x), CTRL, 0xf, 0xf, true)); }
__device__ __forceinline__ float sum8(float v) { v += dppf<0xB1>(v); v += dppf<0x4E>(v); v += dppf<0x141>(v); return v; }
#define LDS_WAIT() asm volatile("s_waitcnt lgkmcnt(0)" ::: "memory")

namespace pg8 {
constexpr int BM = 256, BK = 64, HALF = 128, HTB = HALF * BK * 2, STAGE_BYTES = 8 * HTB, NXCD = 8, WGM = 8;
__host__ __device__ __forceinline__ int lds_byte(int r, int c) { const int st = (r >> 4) * 2 + (c >> 5), rr = r & 15, cc = c & 31, ob = rr * 64 + cc * 2; return st * 1024 + (ob ^ (((ob >> 9) & 1) << 5)); }
__host__ __device__ __forceinline__ void stage_rc(int b, int& R, int& C) { const int st = b / 1024, sb = b % 1024, swz = sb ^ (((sb >> 9) & 1) << 5); R = (st >> 1) * 16 + swz / 64; C = (st & 1) * 32 + (swz % 64) / 2; }
__host__ __device__ __forceinline__ int perm32(int rho) { const int n = rho >> 4, i = rho & 15; return 8 * (i >> 2) + 4 * n + (i & 3); }

struct Unit { int pm, pn, z; };
struct Gemm {
    const bf16_t* A; const bf16_t* Bt; int lda, ldb, K, nM, nN, nZ, zdiv, psz; long sAo, sAi, sBo, sBi, sCo, sCi;
    __device__ __forceinline__ long offA(const Unit& u) const { return (long)(u.z / zdiv) * sAo + (long)(u.z % zdiv) * sAi + (long)u.pm * BM * lda; }
    __device__ __forceinline__ long offB(const Unit& u) const { return (long)(u.z / zdiv) * sBo + (long)(u.z % zdiv) * sBi + (long)u.pn * BM * ldb; }
    __device__ __forceinline__ long offC(const Unit& u) const { return (long)(u.z / zdiv) * sCo + (long)(u.z % zdiv) * sCi; }
};
__device__ __forceinline__ Gemm make_gemm(const bf16_t* A, const bf16_t* Bt, int M, int N, int K, int lda, int ldb) {
    Gemm g; g.A = A; g.Bt = Bt; g.lda = lda; g.ldb = ldb; g.K = K; g.nM = M / BM; g.nN = N / BM; g.nZ = 1; g.zdiv = 1; g.psz = 0; g.sAo = g.sAi = g.sBo = g.sBi = g.sCo = g.sCi = 0; return g;
}
struct Order {
    int nM, nN, nwg, total, G, c;
    __device__ __forceinline__ void init(const Gemm& g, int G_, int c_) { nM = g.nM; nN = g.nN; nwg = nM * nN; total = nwg * g.nZ; G = G_; c = c_; }
    __device__ __forceinline__ bool next(int i, Unit& u) const {
        const long L = (long)i * G + c; if (L >= total) return false;
        u.z = (int)(L / nwg); int wgid = (int)(L % nwg);
        { const int q = nwg / NXCD, r = nwg % NXCD, xcd = wgid % NXCD, off = wgid / NXCD; wgid = (xcd < r ? xcd * (q + 1) : r * (q + 1) + (xcd - r) * q) + off; }
        const int nig = WGM * nN, gid = wgid / nig, fm = gid * WGM, gsz = (nM - fm) < WGM ? (nM - fm) : WGM;
        u.pm = fm + ((wgid % nig) % gsz); u.pn = (wgid % nig) / gsz; return true;
    }
};

__device__ __forceinline__ unsigned cvt_pk_bf16(float lo, float hi) { return pk2(lo, hi); }

__device__ __forceinline__ void row_scales(const float* PS, int rowbase, int fq, float (&rs)[2][4]) {
#pragma unroll
    for (int ai = 0; ai < 2; ++ai)
#pragma unroll
        for (int m = 0; m < 4; ++m) { const f32x4 p = *(const f32x4*)(PS + (size_t)(rowbase + ai * HALF + m * 16) * 16 + fq * 4);
            float s = (p[0] + p[1]) + (p[2] + p[3]); s += __shfl_xor(s, 16); s += __shfl_xor(s, 32); rs[ai][m] = rsqrtf(s * (1.f / 1024.f) + 1e-6f); }
}
__device__ __forceinline__ void row_scales_lds(const LAS float* PSL, int rloc  , int fq, float (&rs)[2][4]) {
#pragma unroll
    for (int ai = 0; ai < 2; ++ai)
#pragma unroll
        for (int m = 0; m < 4; ++m) { const f32x4 p = *(const LAS f32x4*)(PSL + (rloc + ai * HALF + m * 16) * 16 + fq * 4);
            float s = (p[0] + p[1]) + (p[2] + p[3]); s += __shfl_xor(s, 16); s += __shfl_xor(s, 32); rs[ai][m] = rsqrtf(s * (1.f / 1024.f) + 1e-6f); }
}
struct EpiBf16 {
    static constexpr bool PERM = true, PSLDS = false;
    bf16_t* O; int ldc; float scale; const float* PS;
    __device__ __forceinline__ void operator()(const f32x4 (&acc)[2][2][4][2], const Unit& u, long coff, int wr, int wc, int fr, int fq, LAS unsigned char* xl) const {
        const int row0 = u.pm * BM + wr * 64 + fr, col0 = u.pn * BM + wc * 32 + 8 * fq; bf16_t* base = O + coff;
        float rs[2][4];
        if (PS) row_scales(PS, row0, fq, rs);
        else {
#pragma unroll
            for (int ai = 0; ai < 2; ++ai)
#pragma unroll
                for (int m = 0; m < 4; ++m) rs[ai][m] = 1.f; }
#pragma unroll
        for (int ai = 0; ai < 2; ++ai)
#pragma unroll
            for (int m = 0; m < 4; ++m) { bf16_t* rowp = base + (size_t)(row0 + ai * HALF + m * 16) * ldc + col0; const float sc_ = scale * rs[ai][m];
#pragma unroll
                for (int bj = 0; bj < 2; ++bj) { const f32x4 v0 = acc[ai][bj][m][0] * sc_, v1 = acc[ai][bj][m][1] * sc_;
                    u32x4 w; w.x = cvt_pk_bf16(v0[0], v0[1]); w.y = cvt_pk_bf16(v0[2], v0[3]); w.z = cvt_pk_bf16(v1[0], v1[1]); w.w = cvt_pk_bf16(v1[2], v1[3]);
                    *(u32x4*)(rowp + bj * HALF) = w; } }
    }
};
struct EpiBf16PS {
    static constexpr bool PERM = true, PSLDS = true;
    bf16_t* O; int ldc; float scale; const float* PS;
    __device__ __forceinline__ void operator()(const f32x4 (&acc)[2][2][4][2], const Unit& u, long coff, int wr, int wc, int fr, int fq, LAS unsigned char* xl) const {
        const int row0 = u.pm * BM + wr * 64 + fr, col0 = u.pn * BM + wc * 32 + 8 * fq; bf16_t* base = O + coff;
        float rs[2][4];
        row_scales_lds((const LAS float*)(xl + 8192), wr * 64 + fr, fq, rs);
#pragma unroll
        for (int ai = 0; ai < 2; ++ai)
#pragma unroll
            for (int m = 0; m < 4; ++m) { bf16_t* rowp = base + (size_t)(row0 + ai * HALF + m * 16) * ldc + col0; const float sc_ = scale * rs[ai][m];
#pragma unroll
                for (int bj = 0; bj < 2; ++bj) { const f32x4 v0 = acc[ai][bj][m][0] * sc_, v1 = acc[ai][bj][m][1] * sc_;
                    u32x4 w; w.x = cvt_pk_bf16(v0[0], v0[1]); w.y = cvt_pk_bf16(v0[2], v0[3]); w.z = cvt_pk_bf16(v1[0], v1[1]); w.w = cvt_pk_bf16(v1[2], v1[3]);
                    *(u32x4*)(rowp + bj * HALF) = w; } }
    }
};
struct EpiResid {
    static constexpr bool PERM = false, PSLDS = false;
    const float* base; float* out; int ldc;
    __device__ __forceinline__ void operator()(const f32x4 (&acc)[2][2][4][2], const Unit& u, long coff, int wr, int wc, int fr, int fq, LAS unsigned char* xl) const {
        const int col0 = u.pn * BM + wc * 32 + 4 * fq;
#pragma unroll
        for (int ai = 0; ai < 2; ++ai)
#pragma unroll
            for (int m = 0; m < 4; ++m) { const size_t off = (size_t)(u.pm * BM + ai * HALF + wr * 64 + m * 16 + fr) * ldc + col0;
#pragma unroll
                for (int bj = 0; bj < 2; ++bj)
#pragma unroll
                    for (int n = 0; n < 2; ++n) { const f32x4 bs = *(const f32x4*)(base + off + bj * HALF + n * 16); *(f32x4*)(out + off + bj * HALF + n * 16) = bs + acc[ai][bj][m][n]; } }
    }
};
struct EpiResidH {
    static constexpr bool PERM = false, PSLDS = false;
    const float* base; float* out; bf16_t* HB; float* PS; int ldc;
    __device__ __forceinline__ void operator()(const f32x4 (&acc)[2][2][4][2], const Unit& u, long coff, int wr, int wc, int fr, int fq, LAS unsigned char* xl) const {
        const int col0 = u.pn * BM + wc * 32 + 4 * fq;
#pragma unroll
        for (int ai = 0; ai < 2; ++ai)
#pragma unroll
            for (int m = 0; m < 4; ++m) { const int row = u.pm * BM + ai * HALF + wr * 64 + m * 16 + fr; const size_t off = (size_t)row * ldc + col0; float ss = 0.f;
#pragma unroll
                for (int bj = 0; bj < 2; ++bj)
#pragma unroll
                    for (int n = 0; n < 2; ++n) { const f32x4 bs = *(const f32x4*)(base + off + bj * HALF + n * 16); const f32x4 o = bs + acc[ai][bj][m][n]; *(f32x4*)(out + off + bj * HALF + n * 16) = o;
                        ss += (o[0] * o[0] + o[1] * o[1]) + (o[2] * o[2] + o[3] * o[3]);
                        u32x2 w; w.x = cvt_pk_bf16(o[0], o[1]); w.y = cvt_pk_bf16(o[2], o[3]); *(u32x2*)(HB + off + bj * HALF + n * 16) = w; }
                ss += __shfl_xor(ss, 16); ss += __shfl_xor(ss, 32);
                if (fq == 0) PS[(size_t)row * 16 + u.pn * 4 + wc] = ss; }
    }
};
struct EpiResidB {
    static constexpr bool PERM = false, PSLDS = false;
    const float* basef; bf16_t* HB; float* PS; int ldc;
    __device__ __forceinline__ void operator()(const f32x4 (&acc)[2][2][4][2], const Unit& u, long coff, int wr, int wc, int fr, int fq, LAS unsigned char* xl) const {
        const int col0 = u.pn * BM + wc * 32 + 4 * fq;
#pragma unroll
        for (int ai = 0; ai < 2; ++ai)
#pragma unroll
            for (int m = 0; m < 4; ++m) { const int row = (int)(coff / ldc) + u.pm * BM + ai * HALF + wr * 64 + m * 16 + fr; const size_t off = (size_t)row * ldc + col0; float ss = 0.f;
#pragma unroll
                for (int bj = 0; bj < 2; ++bj)
#pragma unroll
                    for (int n = 0; n < 2; ++n) { f32x4 bs;
                        if (basef) bs = *(const f32x4*)(basef + off + bj * HALF + n * 16);
                        else { const u32x2 hb = *(const u32x2*)(HB + off + bj * HALF + n * 16); bs = (f32x4){bflo(hb.x), bfhi(hb.x), bflo(hb.y), bfhi(hb.y)}; }
                        const f32x4 o = bs + acc[ai][bj][m][n];
                        ss += (o[0] * o[0] + o[1] * o[1]) + (o[2] * o[2] + o[3] * o[3]);
                        u32x2 w; w.x = cvt_pk_bf16(o[0], o[1]); w.y = cvt_pk_bf16(o[2], o[3]); *(u32x2*)(HB + off + bj * HALF + n * 16) = w; }
                ss += __shfl_xor(ss, 16); ss += __shfl_xor(ss, 32);
                if (fq == 0) PS[(size_t)row * 16 + u.pn * 4 + wc] = ss; }
    }
};
struct EpiSwiglu {
    static constexpr bool PERM = true, PSLDS = true;
    bf16_t* O; int ldc; const float* PS;
    __device__ __forceinline__ void operator()(const f32x4 (&acc)[2][2][4][2], const Unit& u, long coff, int wr, int wc, int fr, int fq, LAS unsigned char* xl) const {
        const int row0 = u.pm * BM + wr * 64 + fr, col0 = u.pn * HALF + wc * 32 + 8 * fq;
        float rs[2][4]; row_scales_lds((const LAS float*)(xl + 8192), wr * 64 + fr, fq, rs);
#pragma unroll
        for (int ai = 0; ai < 2; ++ai)
#pragma unroll
            for (int m = 0; m < 4; ++m) { bf16_t* rowp = O + (size_t)(row0 + ai * HALF + m * 16) * ldc + col0; float r[8]; const float sc_ = rs[ai][m];
#pragma unroll
                for (int n = 0; n < 2; ++n)
#pragma unroll
                    for (int i = 0; i < 4; ++i) { const float g = acc[ai][0][m][n][i] * sc_, uu = acc[ai][1][m][n][i] * sc_; r[n * 4 + i] = siluf_(g) * uu; }
                u32x4 w; w.x = cvt_pk_bf16(r[0], r[1]); w.y = cvt_pk_bf16(r[2], r[3]); w.z = cvt_pk_bf16(r[4], r[5]); w.w = cvt_pk_bf16(r[6], r[7]);
                *(u32x4*)rowp = w; }
    }
};
struct EpiSoftmax {
    static constexpr bool PERM = true, PSLDS = false;
    bf16_t* O; int ldc;
    __device__ __forceinline__ void operator()(f32x4 (&acc)[2][2][4][2], const Unit& u, long coff, int wr, int wc, int fr, int fq, LAS unsigned char* xl) const {
        LAS float* XM = (LAS float*)xl; LAS float* XS = (LAS float*)(xl + 4096);
#pragma unroll
        for (int ai = 0; ai < 2; ++ai)
#pragma unroll
            for (int m = 0; m < 4; ++m) { float mx = -3.0e38f;
#pragma unroll
                for (int bj = 0; bj < 2; ++bj)
#pragma unroll
                    for (int n = 0; n < 2; ++n)
#pragma unroll
                        for (int i = 0; i < 4; ++i) mx = fmaxf(mx, acc[ai][bj][m][n][i]);
                mx = fmaxf(mx, __shfl_xor(mx, 16)); mx = fmaxf(mx, __shfl_xor(mx, 32));
                if (fq == 0) XM[(ai * HALF + wr * 64 + m * 16 + fr) * 4 + wc] = mx; }
        LDS_WAIT(); __builtin_amdgcn_s_barrier(); asm volatile("" ::: "memory");
#pragma unroll
        for (int ai = 0; ai < 2; ++ai)
#pragma unroll
            for (int m = 0; m < 4; ++m) { const f32x4 mm = *(const LAS f32x4*)(XM + (ai * HALF + wr * 64 + m * 16 + fr) * 4);
                const float mx = fmaxf(fmaxf(mm[0], mm[1]), fmaxf(mm[2], mm[3])); float s = 0.f;
#pragma unroll
                for (int bj = 0; bj < 2; ++bj)
#pragma unroll
                    for (int n = 0; n < 2; ++n)
#pragma unroll
                        for (int i = 0; i < 4; ++i) { const float e = __expf(acc[ai][bj][m][n][i] - mx); acc[ai][bj][m][n][i] = e; s += e; }
                s += __shfl_xor(s, 16); s += __shfl_xor(s, 32);
                if (fq == 0) XS[(ai * HALF + wr * 64 + m * 16 + fr) * 4 + wc] = s; }
        LDS_WAIT(); __builtin_amdgcn_s_barrier(); asm volatile("" ::: "memory");
        const int row0 = u.pm * BM + wr * 64 + fr, col0 = wc * 32 + 8 * fq; bf16_t* base = O + coff;
#pragma unroll
        for (int ai = 0; ai < 2; ++ai)
#pragma unroll
            for (int m = 0; m < 4; ++m) { const f32x4 ss = *(const LAS f32x4*)(XS + (ai * HALF + wr * 64 + m * 16 + fr) * 4);
                const float inv = frcp((ss[0] + ss[1]) + (ss[2] + ss[3])); bf16_t* rowp = base + (size_t)(row0 + ai * HALF + m * 16) * ldc + col0;
#pragma unroll
                for (int bj = 0; bj < 2; ++bj) { const f32x4 v0 = acc[ai][bj][m][0] * inv, v1 = acc[ai][bj][m][1] * inv;
                    u32x4 w; w.x = cvt_pk_bf16(v0[0], v0[1]); w.y = cvt_pk_bf16(v0[2], v0[3]); w.z = cvt_pk_bf16(v1[0], v1[1]); w.w = cvt_pk_bf16(v1[2], v1[3]);
                    *(u32x4*)(rowp + bj * HALF) = w; } }
    }
};

struct EpiSoftmaxPS {
    const float* PS;
    static constexpr bool PERM = true, PSLDS = true;
    bf16_t* O; int ldc;
    __device__ __forceinline__ void operator()(f32x4 (&acc)[2][2][4][2], const Unit& u, long coff, int wr, int wc, int fr, int fq, LAS unsigned char* xl) const {
        LAS float* XM = (LAS float*)xl; LAS float* XS = (LAS float*)(xl + 4096);
        { float rs[2][4]; row_scales_lds((const LAS float*)(xl + 8192), wr * 64 + fr, fq, rs);
#pragma unroll
          for (int ai = 0; ai < 2; ++ai)
#pragma unroll
              for (int m = 0; m < 4; ++m)
#pragma unroll
                  for (int bj = 0; bj < 2; ++bj)
#pragma unroll
                      for (int n = 0; n < 2; ++n) acc[ai][bj][m][n] = acc[ai][bj][m][n] * rs[ai][m]; }
#pragma unroll
        for (int ai = 0; ai < 2; ++ai)
#pragma unroll
            for (int m = 0; m < 4; ++m) { float mx = -3.0e38f;
#pragma unroll
                for (int bj = 0; bj < 2; ++bj)
#pragma unroll
                    for (int n = 0; n < 2; ++n)
#pragma unroll
                        for (int i = 0; i < 4; ++i) mx = fmaxf(mx, acc[ai][bj][m][n][i]);
                mx = fmaxf(mx, __shfl_xor(mx, 16)); mx = fmaxf(mx, __shfl_xor(mx, 32));
                if (fq == 0) XM[(ai * HALF + wr * 64 + m * 16 + fr) * 4 + wc] = mx; }
        LDS_WAIT(); __builtin_amdgcn_s_barrier(); asm volatile("" ::: "memory");
#pragma unroll
        for (int ai = 0; ai < 2; ++ai)
#pragma unroll
            for (int m = 0; m < 4; ++m) { const f32x4 mm = *(const LAS f32x4*)(XM + (ai * HALF + wr * 64 + m * 16 + fr) * 4);
                const float mx = fmaxf(fmaxf(mm[0], mm[1]), fmaxf(mm[2], mm[3])); float s = 0.f;
#pragma unroll
                for (int bj = 0; bj < 2; ++bj)
#pragma unroll
                    for (int n = 0; n < 2; ++n)
#pragma unroll
                        for (int i = 0; i < 4; ++i) { const float e = __expf(acc[ai][bj][m][n][i] - mx); acc[ai][bj][m][n][i] = e; s += e; }
                s += __shfl_xor(s, 16); s += __shfl_xor(s, 32);
                if (fq == 0) XS[(ai * HALF + wr * 64 + m * 16 + fr) * 4 + wc] = s; }
        LDS_WAIT(); __builtin_amdgcn_s_barrier(); asm volatile("" ::: "memory");
        const int row0 = u.pm * BM + wr * 64 + fr, col0 = wc * 32 + 8 * fq; bf16_t* base = O + coff;
#pragma unroll
        for (int ai = 0; ai < 2; ++ai)
#pragma unroll
            for (int m = 0; m < 4; ++m) { const f32x4 ss = *(const LAS f32x4*)(XS + (ai * HALF + wr * 64 + m * 16 + fr) * 4);
                const float inv = frcp((ss[0] + ss[1]) + (ss[2] + ss[3])); bf16_t* rowp = base + (size_t)(row0 + ai * HALF + m * 16) * ldc + col0;
#pragma unroll
                for (int bj = 0; bj < 2; ++bj) { const f32x4 v0 = acc[ai][bj][m][0] * inv, v1 = acc[ai][bj][m][1] * inv;
                    u32x4 w; w.x = cvt_pk_bf16(v0[0], v0[1]); w.y = cvt_pk_bf16(v0[2], v0[3]); w.z = cvt_pk_bf16(v1[0], v1[1]); w.w = cvt_pk_bf16(v1[2], v1[3]);
                    *(u32x4*)(rowp + bj * HALF) = w; } }
    }
};

template <class Epi, bool ALIGN_EPI>
__device__ __forceinline__ void gemm_phase(LAS unsigned char* lds, LAS unsigned char* xl, const Gemm g, const Order& S, Epi& E) {
    const int tid = threadIdx.x, wid = __builtin_amdgcn_readfirstlane(tid >> 6), lane = tid & 63, wr = wid >> 2, wc = wid & 3, fr = lane & 15, fq = lane >> 4;
    const int K = g.K, nt = K / BK;
    unsigned voffA[2], voffB[2];
#pragma unroll
    for (int i = 0; i < 2; ++i) { int R, C; stage_rc(tid * 16 + i * 8192, R, C); const int Rb = Epi::PERM ? ((R & ~31) + perm32(R & 31)) : R;
        voffA[i] = (unsigned)(R * g.lda + C) * 2u; voffB[i] = (unsigned)(Rb * g.ldb + C) * 2u; }
    const size_t kstep = (size_t)(BK * 2);
    const size_t hstepA = (size_t)HALF * g.lda * 2, hstepB = (size_t)HALF * g.ldb * 2;
    const unsigned ldsw = (unsigned)wid * 1024u;
    const int aoff = lds_byte(wr * 64 + fr, fq * 8), boff = lds_byte(wc * 32 + fr, fq * 8);
#define PG8_SA(b, h) (((b) * 2 + (h)) * HTB)
#define PG8_SB(b, h) ((4 + (b) * 2 + (h)) * HTB)
#define PG8_STAGE(bufoff, gbase, voff) do { _Pragma("unroll") for (int _i = 0; _i < 2; ++_i) \
        __builtin_amdgcn_global_load_lds((const unsigned*)((const char*)(gbase) + (voff)[_i]), (LAS unsigned*)(lds + (bufoff) + ldsw + _i * 8192), 16, 0, 0); } while (0)
#define PG8_LDA(dst, b, h) do { _Pragma("unroll") for (int m = 0; m < 4; ++m) _Pragma("unroll") for (int k = 0; k < 2; ++k) dst[m][k] = *(const LAS bf16x8*)(lds + PG8_SA(b, h) + aoff + m * 2048 + k * 1024); } while (0)
#define PG8_LDB(dst, b, h) do { _Pragma("unroll") for (int n = 0; n < 2; ++n) _Pragma("unroll") for (int k = 0; k < 2; ++k) dst[n][k] = *(const LAS bf16x8*)(lds + PG8_SB(b, h) + boff + n * 2048 + k * 1024); } while (0)
#define PG8_MMA(ai, bj, At, Bt) do { __builtin_amdgcn_s_setprio(1); _Pragma("unroll") for (int m = 0; m < 4; ++m) _Pragma("unroll") for (int n = 0; n < 2; ++n) _Pragma("unroll") for (int k = 0; k < 2; ++k) \
        acc[ai][bj][m][n] = __builtin_amdgcn_mfma_f32_16x16x32_bf16(Bt[n][k], At[m][k], acc[ai][bj][m][n], 0, 0, 0); __builtin_amdgcn_s_setprio(0); } while (0)
#define PG8_WAIT_V(n) asm volatile("s_waitcnt vmcnt(" #n ")" ::: "memory")
#define PG8_WAIT_L(n) asm volatile("s_waitcnt lgkmcnt(" #n ")" ::: "memory")
#define PG8_BAR __builtin_amdgcn_s_barrier()
#define PG8_SCHED __builtin_amdgcn_sched_barrier(0)
    Unit cur, nxt; int ui = 0;
    if (!S.next(0, cur)) return;
    f32x4 acc[2][2][4][2];
#pragma unroll
    for (int a = 0; a < 2; ++a)
#pragma unroll
        for (int b = 0; b < 2; ++b)
#pragma unroll
            for (int m = 0; m < 4; ++m)
#pragma unroll
                for (int n = 0; n < 2; ++n) acc[a][b][m][n] = (f32x4){0.f, 0.f, 0.f, 0.f};
    bf16x8 At[4][2], B0[2][2], B1[2][2];
    const char* cA = (const char*)g.A + 2 * g.offA(cur); const char* cB = (const char*)g.Bt + 2 * g.offB(cur);
    PG8_STAGE(PG8_SB(0, 0), cB, voffB); PG8_STAGE(PG8_SB(0, 1), cB + hstepB, voffB); PG8_STAGE(PG8_SA(0, 0), cA, voffA); PG8_STAGE(PG8_SA(0, 1), cA + hstepA, voffA);
    if (wr == 1) PG8_BAR;
    PG8_WAIT_V(2); PG8_BAR;
    PG8_STAGE(PG8_SB(1, 0), cB + kstep, voffB); PG8_STAGE(PG8_SA(1, 0), cA + kstep, voffA); PG8_STAGE(PG8_SB(1, 1), cB + hstepB + kstep, voffB);
    PG8_WAIT_V(6); PG8_BAR;
    for (;;) {
        const bool has_next = S.next(ui + 1, nxt);
        const char* nA = has_next ? (const char*)g.A + 2 * g.offA(nxt) : cA; const char* nB = has_next ? (const char*)g.Bt + 2 * g.offB(nxt) : cB;
        for (int t = 0; t < nt; t += 2) {
            const bool last = (t == nt - 2);
            const char* a1 = cA + (size_t)(t + 1) * kstep;
            const char* a2 = last ? nA : cA + (size_t)(t + 2) * kstep; const char* b2 = last ? nB : cB + (size_t)(t + 2) * kstep;
            const char* a3 = a2 + kstep; const char* b3 = b2 + kstep;
            if constexpr (Epi::PSLDS) { if (last) {
                const char* psrc = (const char*)(E.PS + (size_t)((cur.z / g.zdiv) * g.psz + cur.pm) * (BM * 16)) + tid * 16;
#pragma unroll
                for (int _i = 0; _i < 2; ++_i) __builtin_amdgcn_global_load_lds((const unsigned*)(psrc + _i * 8192), (LAS unsigned*)(xl + 8192 + ldsw + _i * 8192), 16, 0, 0); } }
            PG8_LDB(B0, 0, 0); PG8_LDB(B1, 0, 1); PG8_SCHED; PG8_LDA(At, 0, 0); PG8_STAGE(PG8_SA(1, 1), a1 + hstepA, voffA);
            PG8_WAIT_V(8); PG8_WAIT_L(0); PG8_BAR; PG8_MMA(0, 0, At, B0); PG8_MMA(0, 1, At, B1); PG8_BAR; PG8_SCHED;
            PG8_LDA(At, 0, 1); PG8_STAGE(PG8_SB(0, 0), b2, voffB); PG8_STAGE(PG8_SB(0, 1), b2 + hstepB, voffB); PG8_STAGE(PG8_SA(0, 0), a2, voffA);
            PG8_WAIT_V(8); PG8_WAIT_L(0); PG8_BAR; PG8_MMA(1, 0, At, B0); PG8_MMA(1, 1, At, B1); PG8_BAR; PG8_SCHED;
            PG8_LDB(B0, 1, 0); PG8_LDB(B1, 1, 1); PG8_SCHED; PG8_LDA(At, 1, 0); PG8_STAGE(PG8_SA(0, 1), a2 + hstepA, voffA);
            PG8_WAIT_V(8); PG8_WAIT_L(0); PG8_BAR; PG8_MMA(0, 0, At, B0); PG8_MMA(0, 1, At, B1); PG8_BAR; PG8_SCHED;
            PG8_LDA(At, 1, 1); PG8_STAGE(PG8_SB(1, 0), b3, voffB); PG8_STAGE(PG8_SB(1, 1), b3 + hstepB, voffB); PG8_STAGE(PG8_SA(1, 0), a3, voffA);
            PG8_WAIT_V(8); PG8_WAIT_L(0); PG8_BAR; PG8_MMA(1, 0, At, B0); PG8_MMA(1, 1, At, B1); PG8_BAR; PG8_SCHED;
        }
        if constexpr (ALIGN_EPI) { if (wr == 0) PG8_BAR; }
        E(acc, cur, g.offC(cur), wr, wc, fr, fq, xl);
        if (!has_next) break;
#pragma unroll
        for (int a = 0; a < 2; ++a)
#pragma unroll
            for (int b = 0; b < 2; ++b)
#pragma unroll
                for (int m = 0; m < 4; ++m)
#pragma unroll
                    for (int n = 0; n < 2; ++n) acc[a][b][m][n] = (f32x4){0.f, 0.f, 0.f, 0.f};
        cur = nxt; cA = nA; cB = nB; ++ui;
        if constexpr (ALIGN_EPI) { if (wr == 1) PG8_BAR; }
    }
    PG8_WAIT_V(0);
    if constexpr (!ALIGN_EPI) { if (wr == 0) PG8_BAR; }
    PG8_BAR;
#undef PG8_SA
#undef PG8_SB
#undef PG8_STAGE
#undef PG8_LDA
#undef PG8_LDB
#undef PG8_MMA
#undef PG8_WAIT_V
#undef PG8_WAIT_L
#undef PG8_BAR
#undef PG8_SCHED
}
}

__device__ __forceinline__ f32x4 mfma16(bf16x8 bfrag, bf16x8 afrag, f32x4 acc) { return __builtin_amdgcn_mfma_f32_16x16x32_bf16(bfrag, afrag, acc, 0, 0, 0); }
__device__ __forceinline__ bf16x8 ldsfrag(const LAS bf16_t* base, int ld, int r0, int k0, int fr, int fq) { return *(const LAS bf16x8*)(base + (r0 + fr) * ld + k0 + fq * 8); }

template <int MODE> __device__ __forceinline__ void transpose_item(const float* W, int K, int N, bf16_t* WT, LAS float* scr, int item, int nblk, int lane, const float* gain = nullptr) {
    const int kb = item / nblk, nb = item % nblk, k0 = 64 * kb, n0 = 32 * nb; const int nsrc = n0 + (lane & 31);
    float wv_[32];
#pragma unroll
    for (int i = 0; i < 32; ++i) { const int kk = 2 * i + (lane >> 5); wv_[i] = (nsrc < N) ? W[(size_t)(k0 + kk) * N + nsrc] : 0.f; }
#pragma unroll
    for (int i = 0; i < 32; ++i) { const int kk = 2 * i + (lane >> 5); scr[kk * 33 + (lane & 31)] = wv_[i] * (gain ? gain[k0 + kk] : 1.f); }
    LDS_WAIT();
    const int c = lane & 7;
#pragma unroll
    for (int j = 0; j < 4; ++j) { const int n = (lane >> 3) + 8 * j; const LAS float* s = scr + (8 * c) * 33 + n;
        u32x4 o; o.x = pk2(s[0 * 33], s[1 * 33]); o.y = pk2(s[2 * 33], s[3 * 33]); o.z = pk2(s[4 * 33], s[5 * 33]); o.w = pk2(s[6 * 33], s[7 * 33]);
        int drow = n0 + n; if (MODE == 1) { const int jn = drow % FFN, isu = drow / FFN; drow = (jn / 128) * 256 + isu * 128 + (jn % 128); }
        *(u32x4*)(WT + (size_t)drow * K + k0 + 8 * c) = o; }
    LDS_WAIT();
}
__device__ __forceinline__ void rms_row_bf16(const float* xrow, const float* gain, bf16_t* orow, int lane) {
    const f32x4* xr = (const f32x4*)xrow + lane; f32x4 v[4]; float s = 0.f;
#pragma unroll
    for (int j = 0; j < 4; ++j) { v[j] = xr[64 * j]; s += (v[j].x * v[j].x + v[j].y * v[j].y) + (v[j].z * v[j].z + v[j].w * v[j].w); }
    const float rs = rsqrtf(wave_sum(s) * (1.f / D) + 1e-6f);
    const f32x4* gr = (const f32x4*)gain + lane; u32x2* o8 = (u32x2*)orow + lane;
#pragma unroll
    for (int j = 0; j < 4; ++j) { const f32x4 g = gr[64 * j]; u32x2 w; w.x = pk2(v[j].x * rs * g.x, v[j].y * rs * g.y); w.y = pk2(v[j].z * rs * g.z, v[j].w * rs * g.w); o8[64 * j] = w; }
}
__device__ __forceinline__ void rms_row2_bf16(const float* xa, const float* xb, const float* gain, bf16_t* oa, bf16_t* ob, int lane) {
    const f32x4* ra = (const f32x4*)xa + lane; const f32x4* rb = (const f32x4*)xb + lane; f32x4 va[4], vb[4]; float sa = 0.f, sb = 0.f;
#pragma unroll
    for (int j = 0; j < 4; ++j) { va[j] = ra[64 * j]; vb[j] = rb[64 * j]; }
#pragma unroll
    for (int j = 0; j < 4; ++j) { sa += (va[j].x * va[j].x + va[j].y * va[j].y) + (va[j].z * va[j].z + va[j].w * va[j].w); sb += (vb[j].x * vb[j].x + vb[j].y * vb[j].y) + (vb[j].z * vb[j].z + vb[j].w * vb[j].w); }
#pragma unroll
    for (int o = 1; o < 64; o <<= 1) { sa += __shfl_xor(sa, o); sb += __shfl_xor(sb, o); }
    const float rsa = rsqrtf(sa * (1.f / D) + 1e-6f), rsb = rsqrtf(sb * (1.f / D) + 1e-6f);
    const f32x4* gr = (const f32x4*)gain + lane; u32x2* pa = (u32x2*)oa + lane; u32x2* pb = (u32x2*)ob + lane;
#pragma unroll
    for (int j = 0; j < 4; ++j) { const f32x4 g = gr[64 * j]; u32x2 w;
        w.x = pk2(va[j].x * rsa * g.x, va[j].y * rsa * g.y); w.y = pk2(va[j].z * rsa * g.z, va[j].w * rsa * g.w); pa[64 * j] = w;
        w.x = pk2(vb[j].x * rsb * g.x, vb[j].y * rsb * g.y); w.y = pk2(vb[j].z * rsb * g.z, vb[j].w * rsb * g.w); pb[64 * j] = w; }
}
__device__ __forceinline__ void rms_rows_phase(const float* X, const float* gain, bf16_t* H, int nrows, int gw, int NGW, int lane) {
    int m = gw;
    for (; m + NGW < nrows; m += 2 * NGW) rms_row2_bf16(X + (size_t)m * D, X + (size_t)(m + NGW) * D, gain, H + (size_t)m * D, H + (size_t)(m + NGW) * D, lane);
    if (m < nrows) rms_row_bf16(X + (size_t)m * D, gain, H + (size_t)m * D, lane);
}

__device__ __forceinline__ void rwkv_chain(LAS unsigned char* lds, int cid, const bf16_t* P0, const float* mu, const float* w0, const float* w2, const float* a0, const float* a2,
                                           const float* k_k, const float* k_a, const float* r_k, bf16_t* ORW, bf16_t* SG, float* BONUS) {
    const int tid = threadIdx.x, lane = tid & 63, wid = tid >> 6, fr = lane & 15, fq = lane >> 4;
    const int b = cid >> 4, h = (cid >> 1) & 7, dir = cid & 1;
    LAS float* rS = (LAS float*)(lds); LAS float* kS = (LAS float*)(lds + 8192); LAS float* vS = (LAS float*)(lds + 16384); LAS float* wS = (LAS float*)(lds + 24576);
    LAS float* nkS = (LAS float*)(lds + 32768); LAS float* bS = (LAS float*)(lds + 40960); LAS float* preA = (LAS float*)(lds + 49152); LAS float* preW = (LAS float*)(lds + 57344);
    LAS bf16_t* adB = (LAS bf16_t*)(lds + 65536); LAS bf16_t* wdB = (LAS bf16_t*)(lds + 70144);
    LAS bf16_t* a2B = (LAS bf16_t*)(lds + 74752); LAS bf16_t* w2B = (LAS bf16_t*)(lds + 83968); LAS float* cst = (LAS float*)(lds + 93184);
    LAS bf16_t* At = (LAS bf16_t*)(lds + 97280); LAS bf16_t* Bt = (LAS bf16_t*)(lds + 101888); LAS bf16_t* Kt = (LAS bf16_t*)(lds + 106496); LAS bf16_t* Rt = (LAS bf16_t*)(lds + 111104);
    LAS bf16_t* BtT = (LAS bf16_t*)(lds + 115712); LAS bf16_t* KtT = (LAS bf16_t*)(lds + 120832); LAS bf16_t* VT = (LAS bf16_t*)(lds + 125952); LAS bf16_t* S0b = (LAS bf16_t*)(lds + 131072);
    LAS float* NT4 = (LAS float*)(lds + 140288); LAS bf16_t* NakT = (LAS bf16_t*)(lds + 146432); LAS bf16_t* MbrT = (LAS bf16_t*)(lds + 148992); LAS bf16_t* MkrT = (LAS bf16_t*)(lds + 151552);
    LAS float* gL = (LAS float*)(lds + 154112);
    LAS float* WS = preA;
    LAS bf16_t* Ub = (LAS bf16_t*)preW;
#define RW_IDS int tid_o = threadIdx.x; asm volatile("" : "+v"(tid_o)); const int tid = tid_o, lane = tid & 63, wid = __builtin_amdgcn_readfirstlane(tid >> 6), fr = lane & 15, fq = lane >> 4, vt = wid >> 1, tt2 = wid & 1; (void)lane; (void)wid; (void)fr; (void)fq; (void)vt; (void)tt2;
    __syncthreads();
    for (int e = tid; e < 64 * 64; e += 512) { const int j = e & 63, r = e >> 6;
        a2B[j * 72 + r] = (bf16_t)f2bf(a2[r * 512 + h * 64 + j]); w2B[j * 72 + r] = (bf16_t)f2bf(w2[(dir * 64 + r) * 512 + h * 64 + j]); }
    for (int e = tid; e < 64 * 72 / 2; e += 512) ((LAS unsigned*)S0b)[e] = 0u;
    if (tid < 64) { const int j = tid, c = h * 64 + j;
        cst[0 * 64 + j] = a0[c]; cst[1 * 64 + j] = w0[dir * 512 + c]; cst[2 * 64 + j] = k_k[c]; cst[3 * 64 + j] = k_a[c]; cst[4 * 64 + j] = r_k[c];
        cst[5 * 64 + j] = mu[c]; cst[6 * 64 + j] = mu[512 + c]; cst[7 * 64 + j] = mu[1024 + c]; cst[8 * 64 + j] = mu[1536 + j]; cst[9 * 64 + j] = mu[1600 + j];
        cst[10 * 64 + j] = (j < 16) ? mu[1664 + h * 16 + j] : 0.f; }
    const int vt = wid >> 1, tt2 = wid & 1;
    f32x4 st[2]; st[0] = (f32x4){0.f, 0.f, 0.f, 0.f}; st[1] = st[0];
    __syncthreads();
    const bf16_t* Pb = P0 + (size_t)b * SEQ * ABPAD;
    unsigned rc[10], rpv[10], rnx[10]; unsigned short gcv = 0, gpv = 0, gnv = 0;
#define RW_IDX(i) const int grp = (i) >> 1; const int idx_ = tid + 512 * ((i) & 1); const int tok = idx_ >> 5, c2 = (idx_ & 31) * 2; \
                  const int gcol = (grp == 0 ? h * 64 : grp == 1 ? 512 + h * 64 : grp == 2 ? 1024 + h * 64 : grp == 3 ? 1536 : 1600) + c2;
    const unsigned voff = (unsigned)((((int)threadIdx.x >> 5) * ABPAD + ((int)threadIdx.x & 31) * 2) * 2);
#define RW_CG(g) ((g) == 0 ? h * 128 : (g) == 1 ? 1024 + h * 128 : (g) == 2 ? 2048 + h * 128 : (g) == 3 ? 3072 : 3200)
#define RW_ISSUE(t0n) do { const char* bp_ = (const char*)(Pb + (size_t)(t0n) * ABPAD); const bool first_ = ((t0n) == 0) && (tid < 32), last_ = ((t0n) == SEQ - 32) && (tid >= 480); \
        _Pragma("unroll") for (int i = 0; i < 10; ++i) { const char* p = bp_ + (RW_CG(i >> 1) + (i & 1) * 16 * ABPAD * 2) + voff; \
            rc[i] = *(const unsigned*)p; \
            if ((i & 1) == 0) { const unsigned v_ = *(const unsigned*)(p - (first_ ? 0 : ABPAD * 2)); rpv[i] = first_ ? 0u : v_; rnx[i] = *(const unsigned*)(p + ABPAD * 2); } \
            else { const unsigned v_ = *(const unsigned*)(p + (last_ ? 0 : ABPAD * 2)); rnx[i] = last_ ? 0u : v_; rpv[i] = *(const unsigned*)(p - ABPAD * 2); } } \
        if (dir == 0) { const bool fg_ = ((t0n) == 0) && (tid < 16), lg_ = ((t0n) == SEQ - 32) && (tid >= 496); \
            const bf16_t* p = (const bf16_t*)bp_ + (size_t)(tid >> 4) * ABPAD + 1664 + h * 16 + (tid & 15); \
            gcv = *p; { const unsigned short v_ = *(p - (fg_ ? 0 : ABPAD)); gpv = fg_ ? (unsigned short)0 : v_; } { const unsigned short v_ = *(p + (lg_ ? 0 : ABPAD)); gnv = lg_ ? (unsigned short)0 : v_; } } } while (0)
    RW_ISSUE(dir ? 127 * 32 : 0);
    for (int cc = 0; cc < 128; ++cc) {
        const int t0 = dir ? (127 - cc) * 32 : cc * 32;
        { RW_IDS
#pragma unroll
        for (int i = 0; i < 10; ++i) { RW_IDX(i) (void)gcol;
            const unsigned cur = rc[i], prv = rpv[i], nxt = rnx[i];
            const float m0 = cst[(5 + grp) * 64 + c2], m1 = cst[(5 + grp) * 64 + c2 + 1];
            const float c0 = bflo(cur), c1 = bfhi(cur);
            const float x0 = c0 + m0 * (0.5f * (bflo(prv) + bflo(nxt)) - c0), x1 = c1 + m1 * (0.5f * (bfhi(prv) + bfhi(nxt)) - c1);
            if (grp == 0) { *(LAS f32x2*)(rS + tok * 64 + c2) = (f32x2){x0, x1}; }
            else if (grp == 1) { *(LAS f32x2*)(kS + tok * 64 + c2) = (f32x2){x0, x1}; }
            else if (grp == 2) { *(LAS f32x2*)(vS + tok * 64 + c2) = (f32x2){x0, x1}; }
            else if (grp == 3) { const float e0 = __expf(2.f * x0), e1 = __expf(2.f * x1); *(LAS unsigned*)(wdB + tok * 72 + c2) = pk2(1.f - 2.f * frcp(e0 + 1.f), 1.f - 2.f * frcp(e1 + 1.f)); }
            else { *(LAS unsigned*)(adB + tok * 72 + c2) = pk2(x0, x1); }
        }
        if (dir == 0) {
            const int tok = tid >> 4, c = tid & 15, t = t0 + tok;
            const float cur = bf2f(gcv), prv = bf2f(gpv), nxt = bf2f(gnv);
            const float x = cur + cst[10 * 64 + c] * (0.5f * (prv + nxt) - cur);
            SG[((size_t)b * SEQ + t) * 128 + h * 16 + c] = (bf16_t)f2bf(sigmoidf_(x));
        } }
        __syncthreads();
        if (cc + 1 < 128) { RW_IDS const int t0n = dir ? (126 - cc) * 32 : (cc + 1) * 32; RW_ISSUE(t0n); }
        { RW_IDS const int mat = wid >> 2, ntile = wid & 3; const LAS bf16_t* Aop = mat ? wdB : adB; const LAS bf16_t* Bop = mat ? w2B : a2B; LAS float* pre = mat ? preW : preA;
#pragma unroll
          for (int mt = 0; mt < 2; ++mt) { f32x4 acc = (f32x4){0.f, 0.f, 0.f, 0.f};
#pragma unroll
              for (int ks = 0; ks < 2; ++ks) acc = mfma16(ldsfrag(Bop, 72, ntile * 16, ks * 32, fr, fq), ldsfrag(Aop, 72, mt * 16, ks * 32, fr, fq), acc);
              *(LAS f32x4*)(pre + (mt * 16 + fr) * 64 + ntile * 16 + fq * 4) = acc; } }
        __syncthreads();
        { RW_IDS const int tok = tid >> 4, c0 = (tid & 15) * 4; float kkr[4], av[4], kp[4], wv[4]; float ss = 0.f, bon = 0.f;
#pragma unroll
          for (int i = 0; i < 4; ++i) { const int c = c0 + i, ix = tok * 64 + c;
              const float a = sigmoidf_(cst[c] + preA[ix]); const float sg = sigmoidf_(cst[64 + c] + preW[ix]);
              wv[i] = -0.60653065971f * sg;
              const float kraw = kS[ix]; kkr[i] = kraw * cst[128 + c]; ss += kkr[i] * kkr[i];
              kp[i] = kraw * (1.0f + (a - 1.0f) * cst[192 + c]); av[i] = a; bon += rS[ix] * kp[i] * cst[256 + c]; }
          ss += dppf<0xB1>(ss); bon += dppf<0xB1>(bon); ss += dppf<0x4E>(ss); bon += dppf<0x4E>(bon);
          ss += dppf<0x141>(ss); bon += dppf<0x141>(bon); ss += dppf<0x140>(ss); bon += dppf<0x140>(bon);
          const float inv = frcp(fmaxf(__builtin_amdgcn_sqrtf(ss), 1e-12f));
          f32x4 o_nk, o_b, o_k, o_w;
#pragma unroll
          for (int i = 0; i < 4; ++i) { const float kk = kkr[i] * inv; o_nk[i] = -kk; o_b[i] = kk * av[i]; o_k[i] = kp[i]; o_w[i] = wv[i]; }
          *(LAS f32x4*)(nkS + tok * 64 + c0) = o_nk; *(LAS f32x4*)(bS + tok * 64 + c0) = o_b; *(LAS f32x4*)(kS + tok * 64 + c0) = o_k; *(LAS f32x4*)(wS + tok * 64 + c0) = o_w;
          if (dir == 0 && (tid & 15) == 0) BONUS[((size_t)b * SEQ + t0 + tok) * 8 + h] = bon; }
        __syncthreads();
        { RW_IDS if (tid < 64) { float lw[32];
#pragma unroll
            for (int s = 0; s < 32; ++s) lw[s] = wS[(dir ? 31 - s : s) * 64 + tid];
#pragma unroll
            for (int s = 1; s < 32; ++s) lw[s] += lw[s - 1];
#pragma unroll
            for (int s = 0; s < 32; ++s) wS[(dir ? 31 - s : s) * 64 + tid] = lw[s]; } }
        __syncthreads();
        { RW_IDS const int s = tid >> 4, c0 = (tid & 15) * 4; const int tok = dir ? 31 - s : s, tokp = dir ? tok + 1 : tok - 1;
          const f32x4 cum = *(const LAS f32x4*)(wS + tok * 64 + c0); f32x4 cump = (f32x4){0.f, 0.f, 0.f, 0.f}; if (s > 0) cump = *(const LAS f32x4*)(wS + tokp * 64 + c0);
          const f32x4 nk4 = *(const LAS f32x4*)(nkS + tok * 64 + c0), b4 = *(const LAS f32x4*)(bS + tok * 64 + c0), k4 = *(const LAS f32x4*)(kS + tok * 64 + c0), r4 = *(const LAS f32x4*)(rS + tok * 64 + c0), v4 = *(const LAS f32x4*)(vS + tok * 64 + c0);
          float ta[4], tb[4], tk[4], tr[4];
#pragma unroll
          for (int i = 0; i < 4; ++i) { const float g = __expf(cum[i]), gp = __expf(cump[i]), ig = __expf(-cum[i]);
              ta[i] = nk4[i] * gp; tb[i] = b4[i] * ig; tk[i] = k4[i] * ig; tr[i] = r4[i] * g;
              BtT[(c0 + i) * 40 + s] = (bf16_t)f2bf(tb[i]); KtT[(c0 + i) * 40 + s] = (bf16_t)f2bf(tk[i]); VT[(c0 + i) * 40 + s] = (bf16_t)f2bf(v4[i]);
              if (s == 31) gL[c0 + i] = g; }
          u32x2 w; w.x = pk2(ta[0], ta[1]); w.y = pk2(ta[2], ta[3]); *(LAS u32x2*)(At + s * 72 + c0) = w;
          w.x = pk2(tb[0], tb[1]); w.y = pk2(tb[2], tb[3]); *(LAS u32x2*)(Bt + s * 72 + c0) = w;
          w.x = pk2(tk[0], tk[1]); w.y = pk2(tk[2], tk[3]); *(LAS u32x2*)(Kt + s * 72 + c0) = w;
          w.x = pk2(tr[0], tr[1]); w.y = pk2(tr[2], tr[3]); *(LAS u32x2*)(Rt + s * 72 + c0) = w; }
        __syncthreads();
        { RW_IDS const int mat = wid >> 1, mt = wid & 1; const LAS bf16_t* Aop = (mat < 2) ? At : Rt; const LAS bf16_t* Bop = (mat & 1) ? Kt : Bt;
#pragma unroll
          for (int nt = 0; nt < 2; ++nt) { f32x4 acc = (f32x4){0.f, 0.f, 0.f, 0.f};
#pragma unroll
              for (int ks = 0; ks < 2; ++ks) acc = mfma16(ldsfrag(Bop, 72, nt * 16, ks * 32, fr, fq), ldsfrag(Aop, 72, mt * 16, ks * 32, fr, fq), acc);
              const int srow = mt * 16 + fr;
#pragma unroll
              for (int e = 0; e < 4; ++e) { const int i = nt * 16 + fq * 4 + e; const bool keep = (mat < 2) ? (i < srow) : (i <= srow); if (!keep) acc[e] = 0.f; }
              if (mat == 0) {
#pragma unroll
                  for (int e = 0; e < 4; ++e) NT4[e * 384 + srow * 12 + nt * 4 + fq] = acc[e]; }
              else { LAS bf16_t* X = (mat == 1) ? NakT : (mat == 2) ? MbrT : MkrT; u32x2 o; o.x = pk2(acc[0], acc[1]); o.y = pk2(acc[2], acc[3]); *(LAS u32x2*)(X + srow * 40 + nt * 16 + fq * 4) = o; } } }
        __syncthreads();
        f32x4 oacc = (f32x4){0.f, 0.f, 0.f, 0.f};
        { RW_IDS f32x4 wacc = (f32x4){0.f, 0.f, 0.f, 0.f};
#pragma unroll
          for (int ks = 0; ks < 2; ++ks) { const bf16x8 sf = ldsfrag(S0b, 72, vt * 16, ks * 32, fr, fq);
              wacc = mfma16(ldsfrag(At, 72, tt2 * 16, ks * 32, fr, fq), sf, wacc); oacc = mfma16(ldsfrag(Rt, 72, tt2 * 16, ks * 32, fr, fq), sf, oacc); }
          const bf16x8 vf = ldsfrag(VT, 40, vt * 16, 0, fr, fq);
          wacc = mfma16(ldsfrag(NakT, 40, tt2 * 16, 0, fr, fq), vf, wacc); oacc = mfma16(ldsfrag(MkrT, 40, tt2 * 16, 0, fr, fq), vf, oacc);
#pragma unroll
          for (int n2 = 0; n2 < 2; ++n2) st[n2] = mfma16(ldsfrag(KtT, 40, (tt2 * 2 + n2) * 16, 0, fr, fq), vf, st[n2]);
#pragma unroll
          for (int e = 0; e < 4; ++e) WS[(tt2 * 16 + fq * 4 + e) * 64 + vt * 16 + fr] = wacc[e]; }
        __syncthreads();
        { RW_IDS if (wid < 4) { const int v = wid * 16 + (lane >> 2), p = lane & 3; const LAS float* NTp = NT4 + p * 384; float u[8];
#pragma unroll
            for (int j = 0; j < 8; ++j) u[j] = 0.f;
#pragma unroll
            for (int t = 0; t < 32; ++t) { float q0 = (p == 0) ? WS[t * 64 + v] : 0.f, q1 = 0.f;
#pragma unroll
                for (int j4 = 0; j4 < ((t + 3) / 4 + 3) / 4; ++j4) { const f32x4 nv = *(const LAS f32x4*)(NTp + t * 12 + j4 * 4);
                    q0 += u[j4 * 4] * nv[0]; q1 += u[j4 * 4 + 1] * nv[1]; q0 += u[j4 * 4 + 2] * nv[2]; q1 += u[j4 * 4 + 3] * nv[3]; }
                float q = q0 + q1; q += dppf<0xB1>(q); q += dppf<0x4E>(q);
                u[t >> 2] = ((t & 3) == p) ? q : u[t >> 2]; asm volatile("" ::: "memory"); }
#pragma unroll
            for (int j = 0; j < 8; ++j) Ub[v * 40 + 4 * j + p] = (bf16_t)f2bf(u[j]); } }
        __syncthreads();
        { RW_IDS const bf16x8 uf = ldsfrag(Ub, 40, vt * 16, 0, fr, fq);
          oacc = mfma16(ldsfrag(MbrT, 40, tt2 * 16, 0, fr, fq), uf, oacc);
#pragma unroll
          for (int e = 0; e < 4; ++e) { const int sidx = tt2 * 16 + fq * 4 + e, tok = dir ? 31 - sidx : sidx;
              ORW[(size_t)dir * T * 512 + ((size_t)b * SEQ + t0 + tok) * 512 + h * 64 + vt * 16 + fr] = (bf16_t)f2bf(oacc[e]); }
#pragma unroll
          for (int n2 = 0; n2 < 2; ++n2) { const int kt = tt2 * 2 + n2; st[n2] = mfma16(ldsfrag(BtT, 40, kt * 16, 0, fr, fq), uf, st[n2]);
              const f32x4 gl = *(const LAS f32x4*)(gL + kt * 16 + fq * 4); st[n2] = st[n2] * gl;
              u32x2 o; o.x = pk2(st[n2][0], st[n2][1]); o.y = pk2(st[n2][2], st[n2][3]); *(LAS u32x2*)(S0b + (vt * 16 + fr) * 72 + kt * 16 + fq * 4) = o; } }
    }
#undef RW_IDX
#undef RW_ISSUE
#undef RW_IDS
#undef RW_CG
    __syncthreads();
}

__device__ __forceinline__ void rwkv_combine(const bf16_t* P0, const bf16_t* ORW, const float* BONUS, const bf16_t* G, const float* mu, const float* gn_w, const float* gn_b, bf16_t* OMIX, int gw, int NGW, int lane) {
    const int c0 = lane * 8, head = lane >> 3;
    float muv[8], gw8[8], gb8[8];
#pragma unroll
    for (int i = 0; i < 8; ++i) { muv[i] = mu[1024 + c0 + i]; gw8[i] = gn_w[c0 + i]; gb8[i] = gn_b[c0 + i]; }
#pragma unroll 2
    for (int tk = gw; tk < T; tk += NGW) {
        const int t = tk & (SEQ - 1);
        const u32x4 uf = *(const u32x4*)(ORW + (size_t)tk * 512 + c0), ub = *(const u32x4*)(ORW + (size_t)T * 512 + (size_t)tk * 512 + c0);
        float o[8];
#pragma unroll
        for (int i = 0; i < 4; ++i) { o[2 * i] = bflo(uf[i]) + bflo(ub[i]); o[2 * i + 1] = bfhi(uf[i]) + bfhi(ub[i]); }
        float s = 0.f;
#pragma unroll
        for (int i = 0; i < 8; ++i) s += o[i];
        const float mean = sum8(s) * (1.f / 64.f); float q = 0.f;
#pragma unroll
        for (int i = 0; i < 8; ++i) { o[i] -= mean; q += o[i] * o[i]; }
        const float rstd = rsqrtf(sum8(q) * (1.f / 64.f) + 64e-5f);
        const bf16_t* pv = P0 + (size_t)tk * ABPAD + 1024 + c0;
        const u32x4 vc = *(const u32x4*)pv; u32x4 vp = (u32x4){0u, 0u, 0u, 0u}, vn = (u32x4){0u, 0u, 0u, 0u};
        if (t > 0) vp = *(const u32x4*)(pv - ABPAD);
        if (t < SEQ - 1) vn = *(const u32x4*)(pv + ABPAD);
        const u32x4 gg = *(const u32x4*)(G + (size_t)tk * 512 + c0);
        const float bon = BONUS[(size_t)tk * 8 + head];
        float r[8];
#pragma unroll
        for (int i = 0; i < 4; ++i) {
            const float c_lo = bflo(vc[i]), c_hi = bfhi(vc[i]);
            const float v_lo = c_lo + muv[2 * i] * (0.5f * (bflo(vp[i]) + bflo(vn[i])) - c_lo), v_hi = c_hi + muv[2 * i + 1] * (0.5f * (bfhi(vp[i]) + bfhi(vn[i])) - c_hi);
            r[2 * i] = (o[2 * i] * rstd * gw8[2 * i] + gb8[2 * i] + bon * v_lo) * bflo(gg[i]);
            r[2 * i + 1] = (o[2 * i + 1] * rstd * gw8[2 * i + 1] + gb8[2 * i + 1] + bon * v_hi) * bfhi(gg[i]); }
        u32x4 w; w.x = pk2(r[0], r[1]); w.y = pk2(r[2], r[3]); w.z = pk2(r[4], r[5]); w.w = pk2(r[6], r[7]);
        *(u32x4*)(OMIX + (size_t)tk * D + c0) = w;
    }
}

constexpr int SLD = 136;
__device__ __forceinline__ float softplusf_(float x) { return x > 20.f ? x : log1pf(__expf(x)); }
__device__ __forceinline__ void ssd_dt_cum(LAS float* dtS, LAS float* cumS, LAS float* totS, const bf16_t* Prow0, int g, int w, int lane, const float* dt_bias, const float* a_log) {
    const int j = w >> 1, d = w & 1, head = g * 4 + j;
    const float bias = dt_bias[d * 8 + head], A = -__expf(a_log[d * 8 + head]);
    const float x0 = bf2f(Prow0[(size_t)(2 * lane) * ABPAD + 3328 + head]), x1 = bf2f(Prow0[(size_t)(2 * lane + 1) * ABPAD + 3328 + head]);
    const float dt0 = softplusf_(x0 + bias), dt1 = softplusf_(x1 + bias), la0 = dt0 * A, la1 = dt1 * A;
    const float s = la0 + la1; float inc = s;
#pragma unroll
    for (int off = 1; off < 64; off <<= 1) { const float n = __shfl_up(inc, off); if (lane >= off) inc += n; }
    const float tot = __shfl(inc, 63), exc = inc - s;
    float c0, c1; if (d == 0) { c0 = exc + la0; c1 = inc; } else { c0 = tot - exc; c1 = tot - exc - la0; }
    dtS[w * 128 + 2 * lane] = dt0; dtS[w * 128 + 2 * lane + 1] = dt1; cumS[w * 128 + 2 * lane] = c0; cumS[w * 128 + 2 * lane + 1] = c1;
    if (lane == 0) totS[w] = tot;
}
template <int NR, bool TR> __device__ __forceinline__ void ssd_conv8(LAS bf16_t* dst, int col0, int cx0, int l0, const bf16_t* Pb, int t0, const float* cw, const float* cb) {
    u32x4 raw[NR + 2];
    const bf16_t* p = Pb + (size_t)(t0 + l0) * ABPAD + 2304 + cx0;
#pragma unroll
    for (int i = 0; i < NR + 2; ++i) { const int t = t0 + l0 + i - 1; raw[i] = (t >= 0 && t < SEQ) ? *(const u32x4*)(p + (long)(i - 1) * ABPAD) : (u32x4){0u, 0u, 0u, 0u}; }
    float w0[8], w1[8], w2[8], bs[8];
#pragma unroll
    for (int q = 0; q < 2; ++q) { const f32x4 a = *(const f32x4*)(cw + cx0 + 4 * q), bq = *(const f32x4*)(cw + 1024 + cx0 + 4 * q), c = *(const f32x4*)(cw + 2048 + cx0 + 4 * q), d = *(const f32x4*)(cb + cx0 + 4 * q);
#pragma unroll
        for (int i = 0; i < 4; ++i) { w0[4 * q + i] = a[i]; w1[4 * q + i] = bq[i]; w2[4 * q + i] = c[i]; bs[4 * q + i] = d[i]; } }
    float o[NR][8];
#pragma unroll
    for (int i = 0; i < NR; ++i)
#pragma unroll
        for (int c = 0; c < 8; ++c) { const unsigned um = raw[i][c >> 1], u0 = raw[i + 1][c >> 1], up = raw[i + 2][c >> 1];
            const float fm = (c & 1) ? bfhi(um) : bflo(um), f0 = (c & 1) ? bfhi(u0) : bflo(u0), fp = (c & 1) ? bfhi(up) : bflo(up);
            o[i][c] = siluf_(w0[c] * fm + w1[c] * f0 + w2[c] * fp + bs[c]); }
    if (TR) {
#pragma unroll
        for (int c = 0; c < 8; ++c) { LAS bf16_t* q = dst + (col0 + c) * SLD + l0;
            if (NR == 8) { u32x4 w; w.x = pk2(o[0][c], o[1][c]); w.y = pk2(o[2][c], o[3][c]); w.z = pk2(o[4 % NR][c], o[5 % NR][c]); w.w = pk2(o[6 % NR][c], o[7 % NR][c]); *(LAS u32x4*)q = w; }
            else { u32x2 w; w.x = pk2(o[0][c], o[1][c]); w.y = pk2(o[2][c], o[3][c]); *(LAS u32x2*)q = w; } }
    } else {
#pragma unroll
        for (int i = 0; i < NR; ++i) { u32x4 w; w.x = pk2(o[i][0], o[i][1]); w.y = pk2(o[i][2], o[i][3]); w.z = pk2(o[i][4], o[i][5]); w.w = pk2(o[i][6], o[i][7]); *(LAS u32x4*)(dst + (l0 + i) * SLD + col0) = w; }
    }
}
__device__ __forceinline__ void ssd_s1_unit(LAS unsigned char* lds, int unit, const bf16_t* P0, const float* cw, const float* cb, const float* dt_bias, const float* a_log, bf16_t* STATES, float* TOT) {
    const int tid = threadIdx.x, lane = tid & 63, w = tid >> 6, fr = lane & 15, fq = lane >> 4;
    const int g = unit & 1, c = (unit >> 1) & 31, b = unit >> 6, t0 = c * 128;
    LAS bf16_t* BT = (LAS bf16_t*)lds; LAS bf16_t* XT = (LAS bf16_t*)(lds + 34816); LAS float* dtS = (LAS float*)(lds + 104448); LAS float* cumS = (LAS float*)(lds + 108544);
    LAS float* scS = (LAS float*)(lds + 112640); LAS float* totS = (LAS float*)(lds + 116736);
    const bf16_t* Pb = P0 + (size_t)b * SEQ * ABPAD;
    __syncthreads();
    ssd_conv8<4, true>(BT, (tid & 15) * 8, 512 + g * 128 + (tid & 15) * 8, (tid >> 4) * 4, Pb, t0, cw, cb);
    ssd_conv8<8, true>(XT, (tid & 31) * 8, g * 256 + (tid & 31) * 8, (tid >> 5) * 8, Pb, t0, cw, cb);
    ssd_dt_cum(dtS, cumS, totS, Pb + (size_t)t0 * ABPAD, g, w, lane, dt_bias, a_log);
    __syncthreads();
    for (int e = tid; e < 1024; e += 512) scS[e] = dtS[e] * __expf(totS[e >> 7] - cumS[e]);
    if (tid < 8) TOT[((size_t)(b * 32 + c) * 2 + (tid & 1)) * 8 + g * 4 + (tid >> 1)] = totS[tid];
    __syncthreads();
    const int j = w >> 1;
#pragma unroll 1
    for (int d = 0; d < 2; ++d) {
        f32x4 acc[2][8];
#pragma unroll
        for (int mt = 0; mt < 2; ++mt)
#pragma unroll
            for (int nt = 0; nt < 8; ++nt) acc[mt][nt] = (f32x4){0.f, 0.f, 0.f, 0.f};
#pragma unroll 1
        for (int ks = 0; ks < 4; ++ks) {
            const int k0 = ks * 32; const LAS float* sp = scS + (j * 2 + d) * 128 + k0 + fq * 8;
            const f32x4 s0 = *(const LAS f32x4*)sp, s1 = *(const LAS f32x4*)(sp + 4);
            bf16x8 afr[2];
#pragma unroll
            for (int mt = 0; mt < 2; ++mt) { const u32x4 raw = *(const LAS u32x4*)(XT + (32 * w + mt * 16 + fr) * SLD + k0 + fq * 8); u32x4 o;
                o.x = pk2(bflo(raw.x) * s0[0], bfhi(raw.x) * s0[1]); o.y = pk2(bflo(raw.y) * s0[2], bfhi(raw.y) * s0[3]);
                o.z = pk2(bflo(raw.z) * s1[0], bfhi(raw.z) * s1[1]); o.w = pk2(bflo(raw.w) * s1[2], bfhi(raw.w) * s1[3]);
                afr[mt] = __builtin_bit_cast(bf16x8, o); }
#pragma unroll
            for (int nt = 0; nt < 8; ++nt) { const bf16x8 bfr = ldsfrag(BT, SLD, nt * 16, k0, fr, fq);
#pragma unroll
                for (int mt = 0; mt < 2; ++mt) acc[mt][nt] = mfma16(bfr, afr[mt], acc[mt][nt]); }
        }
        bf16_t* dst = STATES + (((size_t)(b * 32 + c) * 2 + d) * 8 + g * 4 + j) * 8192;
#pragma unroll
        for (int mt = 0; mt < 2; ++mt) { const int p = (w & 1) * 32 + mt * 16 + fr;
#pragma unroll
            for (int nt = 0; nt < 8; ++nt) { u32x2 o; o.x = pk2(acc[mt][nt][0], acc[mt][nt][1]); o.y = pk2(acc[mt][nt][2], acc[mt][nt][3]);
                *(u32x2*)(dst + p * 128 + nt * 16 + fq * 4) = o; } }
    }
}
__device__ __forceinline__ void ssd_s2(const bf16_t* __restrict__ STATES, bf16_t* __restrict__ CARR, const float* __restrict__ TOT, int gtid, int NGT) {
    for (int it = gtid; it < 16 * 2 * 8 * 1024; it += NGT) {
        const int e8 = it & 1023, head = (it >> 10) & 7, d = (it >> 13) & 1, b = it >> 14;
        float run[8];
#pragma unroll
        for (int i = 0; i < 8; ++i) run[i] = 0.f;
#pragma unroll 1
        for (int c8 = 0; c8 < 32; c8 += 8) {
            u32x4 loc[8]; float dec[8];
#pragma unroll
            for (int q = 0; q < 8; ++q) { const int cc = c8 + q, c = d ? 31 - cc : cc; const size_t sidx = ((size_t)(b * 32 + c) * 2 + d) * 8 + head;
                loc[q] = *(const u32x4*)(STATES + sidx * 8192 + e8 * 8); dec[q] = TOT[sidx]; }
#pragma unroll
            for (int q = 0; q < 8; ++q) { const int cc = c8 + q, c = d ? 31 - cc : cc; const size_t sidx = ((size_t)(b * 32 + c) * 2 + d) * 8 + head;
                u32x4 o; o.x = pk2(run[0], run[1]); o.y = pk2(run[2], run[3]); o.z = pk2(run[4], run[5]); o.w = pk2(run[6], run[7]); *(u32x4*)(CARR + sidx * 8192 + e8 * 8) = o;
                const float dq = __expf(dec[q]);
#pragma unroll
                for (int i = 0; i < 4; ++i) { run[2 * i] = run[2 * i] * dq + bflo(loc[q][i]); run[2 * i + 1] = run[2 * i + 1] * dq + bfhi(loc[q][i]); } }
        }
    }
}
__device__ __forceinline__ void ssd_s3_unit(LAS unsigned char* lds, int unit, const bf16_t* P0, const float* cw, const float* cb, const float* dt_bias, const float* a_log, const float* dskip, const float* norm_w,
                                            const bf16_t* STATES, bf16_t* OMIX) {
    const int tid = threadIdx.x, lane = tid & 63, w = tid >> 6, fr = lane & 15, fq = lane >> 4;
    const int g = unit & 1, c = (unit >> 1) & 31, b = unit >> 6, t0 = c * 128;
    LAS bf16_t* CS = (LAS bf16_t*)lds; LAS bf16_t* BS = (LAS bf16_t*)(lds + 34816); LAS bf16_t* XT = (LAS bf16_t*)(lds + 69632);
    LAS float* dtS = (LAS float*)(lds + 139264); LAS float* cumS = (LAS float*)(lds + 143360); LAS float* totS = (LAS float*)(lds + 147456);
    const bf16_t* Pb = P0 + (size_t)b * SEQ * ABPAD;
    __syncthreads();
    ssd_conv8<4, false>(BS, (tid & 15) * 8, 512 + g * 128 + (tid & 15) * 8, (tid >> 4) * 4, Pb, t0, cw, cb);
    ssd_conv8<4, false>(CS, (tid & 15) * 8, 768 + g * 128 + (tid & 15) * 8, (tid >> 4) * 4, Pb, t0, cw, cb);
    ssd_conv8<8, true>(XT, (tid & 31) * 8, g * 256 + (tid & 31) * 8, (tid >> 5) * 8, Pb, t0, cw, cb);
    ssd_dt_cum(dtS, cumS, totS, Pb + (size_t)t0 * ABPAD, g, w, lane, dt_bias, a_log);
    __syncthreads();
    const int l = 16 * w + fr;
    f32x4 sc[8];
#pragma unroll
    for (int nt = 0; nt < 8; ++nt) sc[nt] = (f32x4){0.f, 0.f, 0.f, 0.f};
#pragma unroll
    for (int ks = 0; ks < 4; ++ks) { const bf16x8 afr = ldsfrag(CS, SLD, 16 * w, ks * 32, fr, fq);
#pragma unroll
        for (int nt = 0; nt < 8; ++nt) sc[nt] = mfma16(ldsfrag(BS, SLD, nt * 16, ks * 32, fr, fq), afr, sc[nt]); }
    __syncthreads();
    LAS bf16_t* Mw = BS + w * 16 * SLD;
    const size_t row = (size_t)b * SEQ + t0 + l; float ss = 0.f;
#pragma unroll 1
    for (int j = 0; j < 4; ++j) {
        const LAS float* cf = cumS + (j * 2) * 128; const LAS float* cbw = cumS + (j * 2 + 1) * 128; const LAS float* df = dtS + (j * 2) * 128; const LAS float* db = dtS + (j * 2 + 1) * 128;
        const float cfl = cf[l], cbl = cbw[l];
        const size_t sbase = ((size_t)(b * 32 + c) * 2) * 8 + g * 4 + j;
        const bf16_t* carf = STATES + sbase * 8192; const bf16_t* carb = STATES + (sbase + 8) * 8192;
        bf16x8 cF[4][4], cB[4][4]; u32x2 zz4[4];
#pragma unroll
        for (int ks = 0; ks < 4; ++ks)
#pragma unroll
            for (int pt = 0; pt < 4; ++pt) cF[ks][pt] = *(const bf16x8*)(carf + (pt * 16 + fr) * 128 + ks * 32 + fq * 8);
#pragma unroll
        for (int pt = 0; pt < 4; ++pt) zz4[pt] = *(const u32x2*)(P0 + row * ABPAD + 1792 + g * 256 + j * 64 + pt * 16 + fq * 4);
#pragma unroll
        for (int nt = 0; nt < 8; ++nt) { float mv[4];
#pragma unroll
            for (int i = 0; i < 4; ++i) { const int s = nt * 16 + fq * 4 + i;
                const float ff = (s <= l) ? __expf(cfl - cf[s]) * df[s] : 0.f; const float fb = (s >= l) ? __expf(cbl - cbw[s]) * db[s] : 0.f;
                mv[i] = sc[nt][i] * (ff + fb); }
            u32x2 o; o.x = pk2(mv[0], mv[1]); o.y = pk2(mv[2], mv[3]); *(LAS u32x2*)(Mw + fr * SLD + nt * 16 + fq * 4) = o; }
        LDS_WAIT();
#pragma unroll
        for (int ks = 0; ks < 4; ++ks)
#pragma unroll
            for (int pt = 0; pt < 4; ++pt) cB[ks][pt] = *(const bf16x8*)(carb + (pt * 16 + fr) * 128 + ks * 32 + fq * 8);
        f32x4 yd[4], yf[4], yb[4];
#pragma unroll
        for (int pt = 0; pt < 4; ++pt) { yd[pt] = (f32x4){0.f, 0.f, 0.f, 0.f}; yf[pt] = yd[pt]; yb[pt] = yd[pt]; }
        bf16x8 acs[4];
#pragma unroll
        for (int ks = 0; ks < 4; ++ks) {
            const bf16x8 am = *(const LAS bf16x8*)(Mw + fr * SLD + ks * 32 + fq * 8); acs[ks] = ldsfrag(CS, SLD, 16 * w, ks * 32, fr, fq);
#pragma unroll
            for (int pt = 0; pt < 4; ++pt) {
                yd[pt] = mfma16(ldsfrag(XT, SLD, j * 64 + pt * 16, ks * 32, fr, fq), am, yd[pt]);
                yf[pt] = mfma16(cF[ks][pt], acs[ks], yf[pt]); }
        }
#pragma unroll
        for (int ks = 0; ks < 4; ++ks)
#pragma unroll
            for (int pt = 0; pt < 4; ++pt) yb[pt] = mfma16(cB[ks][pt], acs[ks], yb[pt]);
        const float ef = __expf(cfl), eb = __expf(cbl), dsk = dskip[g * 4 + j];
#pragma unroll
        for (int pt = 0; pt < 4; ++pt) { const f32x4 yv = yd[pt] + yf[pt] * ef + yb[pt] * eb;
            const int col = j * 64 + pt * 16 + fq * 4; const u32x2 zz = zz4[pt];
            const float z4[4] = {bflo(zz.x), bfhi(zz.x), bflo(zz.y), bfhi(zz.y)}; float v4[4];
#pragma unroll
            for (int i = 0; i < 4; ++i) { const float xs = bf2f(XT[(col + i) * SLD + l]); float v = yv[i] + dsk * xs; const float z = z4[i]; v = v * siluf_(z);
                v4[i] = v; ss += v * v; }
            u32x2 o; o.x = pk2(v4[0], v4[1]); o.y = pk2(v4[2], v4[3]); *(u32x2*)(OMIX + row * D + 512 + g * 256 + col) = o; }
        asm volatile("" ::: "memory");
    }
    ss += __shfl_xor(ss, 16); ss += __shfl_xor(ss, 32);
    const float rs = rsqrtf(ss * (1.f / 256.f) + 1e-6f);
    asm volatile("s_waitcnt vmcnt(0)" ::: "memory");
#pragma unroll 4
    for (int q = 0; q < 16; ++q) { const int col = g * 256 + q * 16 + fq * 4; const f32x4 nw = *(const f32x4*)(norm_w + col);
        u32x2* p = (u32x2*)(OMIX + row * D + 512 + col); const u32x2 v = *p;
        u32x2 o; o.x = pk2(bflo(v.x) * rs * nw[0], bfhi(v.x) * rs * nw[1]); o.y = pk2(bflo(v.y) * rs * nw[2], bfhi(v.y) * rs * nw[3]); *p = o; }
}

constexpr int HLD = 136, HLS = 72;
__device__ __forceinline__ void hgrn_chain(LAS unsigned char* lds, int cid, bf16_t* P1, const float* hg_lb, bf16_t* Ob, int ldo, int ocbase, int ocdir) {
    const int tid = threadIdx.x, lane = tid & 63, w = tid >> 6, fr = lane & 15, fq = lane >> 4;
    const int b = cid >> 4, h = (cid >> 1) & 7, dir = cid & 1;
    LAS bf16_t* QE = (LAS bf16_t*)lds;
    LAS bf16_t* KE = (LAS bf16_t*)(lds + 17408);
    LAS bf16_t* KLT = (LAS bf16_t*)(lds + 34816);
    LAS bf16_t* VT = (LAS bf16_t*)(lds + 53248);
    LAS bf16_t* AT = (LAS bf16_t*)(lds + 71680);
    LAS bf16_t* ST = (LAS bf16_t*)(lds + 80896);
    LAS float* totS = (LAS float*)(lds + 115712);
    LAS float* lastS = (LAS float*)(lds + 117760);
    __syncthreads();
    for (int e = tid; e < 128 * HLD / 2; e += 512) ((LAS unsigned*)ST)[e] = 0u;
    const int dcol = tid & 127, qtr = tid >> 7, i0 = qtr * 16;
    const float lbv = frcp(1.0f + __expf(hg_lb[h * 128 + dcol] - hg_lb[1024 + h * 128 + dcol]));
    f32x4 st[8];
#pragma unroll
    for (int i = 0; i < 8; ++i) st[i] = (f32x4){0.f, 0.f, 0.f, 0.f};
    bf16_t* Pb = P1 + (size_t)b * SEQ * HGP;
    __syncthreads();
    unsigned short rq[16], rf[16], rv[16];
#define HG_ISSUE(t0n) do { _Pragma("unroll") for (int i = 0; i < 16; ++i) { const int tk = (t0n) + (dir ? 63 - (i0 + i) : (i0 + i)); const bf16_t* pr = Pb + (size_t)tk * HGP + h * 128 + dcol; \
        rq[i] = pr[0]; rf[i] = pr[1024 * (1 + dir)]; rv[i] = pr[3072]; } } while (0)
    HG_ISSUE((dir ? 63 : 0) * 64);
    for (int cc = 0; cc < 64; ++cc) {
        const int t0 = (dir ? 63 - cc : cc) * 64;
        float gq[16], gk[16], gc[16]; float run = 1.0f;
#pragma unroll
        for (int i = 0; i < 16; ++i) { const float q = bf2f(rq[i]), fr_ = bf2f(rf[i]);
            const float f = lbv + (1.0f - lbv) * sigmoidf_(fr_); run *= f; gq[i] = q; gk[i] = 1.0f - f; gc[i] = run; }
        totS[qtr * 128 + dcol] = run;
#pragma unroll
        for (int i = 0; i < 16; i += 2) *(LAS unsigned*)(VT + dcol * HLS + i0 + i) = (unsigned)rv[i] | ((unsigned)rv[i + 1] << 16);
        __syncthreads();
        { float pre = 1.0f, tot = 1.0f;
#pragma unroll
          for (int q4 = 0; q4 < 4; ++q4) { const float tq = totS[q4 * 128 + dcol]; if (q4 < qtr) pre *= tq; tot *= tq; }
          const float etot = tot;
          if (qtr == 0) lastS[dcol] = etot;
#pragma unroll
          for (int i = 0; i < 16; i += 2) { const float e0 = fmaxf(pre * gc[i], 1e-30f), e1 = fmaxf(pre * gc[i + 1], 1e-30f), n0 = frcp(e0), n1 = frcp(e1), l0 = etot * n0, l1 = etot * n1;
              QE[(i0 + i) * HLD + dcol] = (bf16_t)f2bf(gq[i] * e0); QE[(i0 + i + 1) * HLD + dcol] = (bf16_t)f2bf(gq[i + 1] * e1);
              KE[(i0 + i) * HLD + dcol] = (bf16_t)f2bf(gk[i] * n0); KE[(i0 + i + 1) * HLD + dcol] = (bf16_t)f2bf(gk[i + 1] * n1);
              *(LAS unsigned*)(KLT + dcol * HLS + i0 + i) = pk2(gk[i] * l0, gk[i + 1] * l1); } }
        if (cc + 1 < 64) HG_ISSUE((dir ? 62 - cc : cc + 1) * 64);
        __syncthreads();
        { const int mt = w >> 1;
#pragma unroll
          for (int n2 = 0; n2 < 2; ++n2) { const int nt = (w & 1) * 2 + n2; f32x4 acc = (f32x4){0.f, 0.f, 0.f, 0.f};
#pragma unroll
              for (int ks = 0; ks < 4; ++ks) acc = mfma16(ldsfrag(KE, HLD, nt * 16, ks * 32, fr, fq), ldsfrag(QE, HLD, mt * 16, ks * 32, fr, fq), acc);
              const int lrow = mt * 16 + fr; float mv[4];
#pragma unroll
              for (int i = 0; i < 4; ++i) { const int s = nt * 16 + fq * 4 + i; mv[i] = (s <= lrow) ? acc[i] : 0.f; }
              u32x2 o; o.x = pk2(mv[0], mv[1]); o.y = pk2(mv[2], mv[3]); *(LAS u32x2*)(AT + lrow * HLS + nt * 16 + fq * 4) = o; } }
        __syncthreads();
        { const int mt = w >> 1;
#pragma unroll
          for (int n4 = 0; n4 < 4; ++n4) { const int nt = (w & 1) * 4 + n4; f32x4 acc = (f32x4){0.f, 0.f, 0.f, 0.f};
#pragma unroll
              for (int ks = 0; ks < 2; ++ks) acc = mfma16(ldsfrag(VT, HLS, nt * 16, ks * 32, fr, fq), ldsfrag(AT, HLS, mt * 16, ks * 32, fr, fq), acc);
#pragma unroll
              for (int ks = 0; ks < 4; ++ks) acc = mfma16(ldsfrag(ST, HLD, nt * 16, ks * 32, fr, fq), ldsfrag(QE, HLD, mt * 16, ks * 32, fr, fq), acc);
              const int i = mt * 16 + fr, tk = t0 + (dir ? 63 - i : i);
              u32x2 o; o.x = pk2(acc[0], acc[1]); o.y = pk2(acc[2], acc[3]);
              *(u32x2*)(Ob + ((size_t)b * SEQ + tk) * ldo + ocbase + ocdir * dir + h * 128 + nt * 16 + fq * 4) = o; } }
#pragma unroll
        for (int nt = 0; nt < 8; ++nt) { const f32x4 el = *(const LAS f32x4*)(lastS + nt * 16 + fq * 4); st[nt] = st[nt] * el;
#pragma unroll
            for (int ks = 0; ks < 2; ++ks) st[nt] = mfma16(ldsfrag(KLT, HLS, nt * 16, ks * 32, fr, fq), ldsfrag(VT, HLS, w * 16, ks * 32, fr, fq), st[nt]); }
        __syncthreads();
#pragma unroll
        for (int nt = 0; nt < 8; ++nt) { u32x2 o; o.x = pk2(st[nt][0], st[nt][1]); o.y = pk2(st[nt][2], st[nt][3]); *(LAS u32x2*)(ST + (w * 16 + fr) * HLD + nt * 16 + fq * 4) = o; }
    }
    __syncthreads();
}
__device__ __forceinline__ void hgrn_combine(const bf16_t* P1, const float* norm_w, bf16_t* OMIX, int gw, int NGW, int lane) {
    const int c0 = lane * 16;
#pragma unroll 2
    for (int tk = gw; tk < T; tk += NGW) {
        const bf16_t* pr = P1 + (size_t)tk * HGP + c0; float o[16]; float ss = 0.f;
#pragma unroll
        for (int hh = 0; hh < 2; ++hh) { const u32x4 uf = *(const u32x4*)(pr + 1024 + hh * 8), ub = *(const u32x4*)(pr + 2048 + hh * 8);
#pragma unroll
            for (int i = 0; i < 4; ++i) { o[hh * 8 + 2 * i] = bflo(uf[i]) + bflo(ub[i]); o[hh * 8 + 2 * i + 1] = bfhi(uf[i]) + bfhi(ub[i]); } }
#pragma unroll
        for (int i = 0; i < 16; ++i) ss += o[i] * o[i];
        const float rs = rsqrtf(sum8(ss) * (1.f / 128.f) + 1e-6f);
#pragma unroll
        for (int hh = 0; hh < 2; ++hh) { const u32x4 ug = *(const u32x4*)(pr + 4096 + hh * 8); float r[8];
#pragma unroll
            for (int i = 0; i < 4; ++i) { const float g0 = bflo(ug[i]), g1 = bfhi(ug[i]);
                r[2 * i] = o[hh * 8 + 2 * i] * rs * norm_w[c0 + hh * 8 + 2 * i] * siluf_(g0);
                r[2 * i + 1] = o[hh * 8 + 2 * i + 1] * rs * norm_w[c0 + hh * 8 + 2 * i + 1] * siluf_(g1); }
            u32x4 wv; wv.x = pk2(r[0], r[1]); wv.y = pk2(r[2], r[3]); wv.z = pk2(r[4], r[5]); wv.w = pk2(r[6], r[7]);
            *(u32x4*)(OMIX + (size_t)tk * D + c0 + hh * 8) = wv; }
    }
}

#define XB_TMO      128
#define XB_XCNT(j)  (256  + 64 * (j))
#define XB_XSUB(j)  (1280 + 64 * (j))
#define XB_XGEN(j)  (2304 + 64 * (j))
#define XB_TOP      3328
#define XB_TOPGEN   3392
#define XCD_BAR_WORDS 3456
#define XB_SPIN_CAP (1u << 18)

__device__ __forceinline__ unsigned xb_ld(unsigned* p)              { return __hip_atomic_load(p, __ATOMIC_RELAXED, __HIP_MEMORY_SCOPE_AGENT); }
__device__ __forceinline__ unsigned xb_add(unsigned* p, unsigned v) { return __hip_atomic_fetch_add(p, v, __ATOMIC_RELAXED, __HIP_MEMORY_SCOPE_AGENT); }
__device__ __forceinline__ unsigned xb_xcc_id() { return (unsigned)__builtin_amdgcn_s_getreg((3 << 11) | 20) & 0xFu; }
#define XB_SPIN(cond, bar) do { unsigned _sp = 0; while (cond) { __builtin_amdgcn_s_sleep(1); \
    if ((++_sp & 255u) == 0u) { if (xb_ld(&(bar)[XB_TMO])) break; if (_sp > XB_SPIN_CAP) { atomicAdd(&(bar)[XB_TMO], 1u); break; } } } } while (0)

struct XcdBarrier {
    unsigned* bar; unsigned x;
    volatile LAS unsigned* st;
};

__device__ __forceinline__ XcdBarrier xcd_barrier_post(unsigned* bar, volatile LAS unsigned* st) {
    XcdBarrier b; b.bar = bar; b.x = xb_xcc_id(); b.st = st;
    if (threadIdx.x == 0) (void)xb_add(&bar[XB_XCNT(b.x)], 1u);
    return b;
}
__device__ __forceinline__ void xcd_barrier_complete(unsigned* bar, unsigned x, unsigned& nloc, unsigned& nx) {
    const unsigned G = gridDim.x * gridDim.y * gridDim.z;
    unsigned sum, cnt, mine, sp = 0u;
    for (;;) {
        sum = 0u; cnt = 0u; mine = 0u;
#pragma unroll
        for (unsigned j = 0; j < 16; ++j) { const unsigned c = xb_ld(&bar[XB_XCNT(j)]); sum += c; cnt += (c > 0u) ? 1u : 0u; mine = (j == x) ? c : mine; }
        if (sum == G) break;
        __builtin_amdgcn_s_sleep(1);
        if ((++sp & 255u) == 0u) { if (xb_ld(&bar[XB_TMO])) break; if (sp > XB_SPIN_CAP) { atomicAdd(&bar[XB_TMO], 1u); break; } }
    }
    nloc = mine > 0u ? mine : 1u; nx = cnt > 0u ? cnt : 1u;
}

__device__ __forceinline__ void xcd_barrier(const XcdBarrier& b) {
    asm volatile("s_waitcnt vmcnt(0)" ::: "memory");
    __syncthreads();
    if (threadIdx.x == 0) {
        unsigned* bar = b.bar;
        __builtin_amdgcn_s_waitcnt(0);
        unsigned nloc = b.st[0], nx = b.st[1];
        if (nloc == 0u) { xcd_barrier_complete(bar, b.x, nloc, nx); b.st[0] = nloc; b.st[1] = nx; }
        const unsigned old = xb_add(&bar[XB_XSUB(b.x)], 1u);
        const unsigned gen = old / nloc;
        if (old + 1u == (gen + 1u) * nloc) {
            __builtin_amdgcn_fence(__ATOMIC_RELEASE, "agent");
            asm volatile("s_waitcnt vmcnt(0)" ::: "memory");
            const unsigned og = xb_add(&bar[XB_TOP], 1u);
            const unsigned tg = og / nx;
            if (og + 1u == (tg + 1u) * nx) xb_add(&bar[XB_TOPGEN], 1u);
            else XB_SPIN(xb_ld(&bar[XB_TOPGEN]) == tg, bar);
            __builtin_amdgcn_fence(__ATOMIC_ACQUIRE, "agent");
            xb_add(&bar[XB_XGEN(b.x)], 1u);
            asm volatile("s_waitcnt vmcnt(0)" ::: "memory");
        } else {
            XB_SPIN(xb_ld(&bar[XB_XGEN(b.x)]) == gen, bar);
            __builtin_amdgcn_fence(__ATOMIC_ACQUIRE, "agent");
            asm volatile("s_waitcnt vmcnt(0)" ::: "memory");
        }
    }
    __syncthreads();
}


struct Args { const float* in[35]; float* out; unsigned char* ws; int ph_lo, ph_hi; };
static_assert(sizeof(Args) == 304, "Args layout");

__global__ void __launch_bounds__(512, 2) mk_fwd(Args args) {
    extern __shared__ __attribute__((aligned(16))) unsigned char lds_raw[];
    LAS unsigned char* lds = (LAS unsigned char*)lds_raw; LAS unsigned char* xl = lds + XLDS_OFF;
    const int G = gridDim.x, bx = blockIdx.x, NGW = G * 8;
#define LOCAL_IDS int tid = threadIdx.x; asm volatile("" : "+v"(tid)); const int lane = tid & 63, wave = __builtin_amdgcn_readfirstlane(tid >> 6), gw = bx * 8 + wave; (void)lane; (void)gw;
    typedef const __attribute__((address_space(4))) unsigned char* kaptr_t;
    kaptr_t ka = (kaptr_t)__builtin_amdgcn_kernarg_segment_ptr();
#define INP(k) (*(const float* const volatile __attribute__((address_space(4)))*)(ka + 8 * (k)))
    unsigned char* ws = *(unsigned char* const volatile __attribute__((address_space(4)))*)(ka + 288); float* out = *(float* const volatile __attribute__((address_space(4)))*)(ka + 280);
    const float* x = INP(0);
    bf16_t* WAB = (bf16_t*)(ws + WS_WAB); bf16_t* WABO = (bf16_t*)(ws + WS_WABO); bf16_t* WHG = (bf16_t*)(ws + WS_WHG); bf16_t* WHGO = (bf16_t*)(ws + WS_WHGO);
    bf16_t* WQ = (bf16_t*)(ws + WS_WQ); bf16_t* WKV = (bf16_t*)(ws + WS_WKV); bf16_t* WO = (bf16_t*)(ws + WS_WO); bf16_t* WF1 = (bf16_t*)(ws + WS_WF1); bf16_t* WF2 = (bf16_t*)(ws + WS_WF2);
    bf16_t* G2T = (bf16_t*)(ws + WS_G2T); bf16_t* MEMN = (bf16_t*)(ws + WS_MEMN); bf16_t* KMEM = (bf16_t*)(ws + WS_KMEM);
    bf16_t* WKT = (bf16_t*)out; bf16_t* VWT = (bf16_t*)((unsigned char*)out + 64 * MiB);
    bf16_t* H = (bf16_t*)(ws + WS_H); bf16_t* P = (bf16_t*)(ws + WS_P); bf16_t* PATT = (bf16_t*)(ws + WS_PATT); bf16_t* OMIX0 = (bf16_t*)(ws + WS_OMIX0); bf16_t* OMIX1 = (bf16_t*)(ws + WS_OMIX1); float* PSB = (float*)(ws + WS_PS);
#define COMMA ,
    bf16_t* STATES = (bf16_t*)((unsigned char*)out + DO_STATES); bf16_t* GG = (bf16_t*)((unsigned char*)out + DO_G); bf16_t* SG = (bf16_t*)((unsigned char*)out + DO_SG);
    float* BONUS = (float*)((unsigned char*)out + DO_BONUS); float* TOT = (float*)((unsigned char*)out + DO_TOT);
    cg::grid_group grid = cg::this_grid();
    { volatile LAS unsigned* st_ = (volatile LAS unsigned*)(lds + LDS_BYTES - 16); if (threadIdx.x < 4) st_[threadIdx.x] = 0u; }
    __syncthreads();
    const XcdBarrier xbar = xcd_barrier_post((unsigned*)ws, (volatile LAS unsigned*)(lds + LDS_BYTES - 16));
    const int lo = *(const int volatile __attribute__((address_space(4)))*)(ka + 296), hi = *(const int volatile __attribute__((address_space(4)))*)(ka + 300);
#ifndef PH_EN
#define PH_EN(k) 1
#endif
#define IN(k) (PH_EN(k) && lo <= (k) && (k) < hi)
#ifndef DUP_MASK
#define DUP_MASK 0ull
#endif
#define REPS(k) (1 + (int)(((unsigned long long)(DUP_MASK) >> (k)) & 1ull))
#define PHASE(k) for (int rep_ = 0; rep_ < (IN(k) ? REPS(k) : 0); ++rep_, ((REPS(k) > 1) ? (grid.sync(), 0) : 0))
#define SEAM(k) do { if (IN(k) && IN((k) + 1)) xcd_barrier(xbar); } while (0)
    if (lo < 0) grid.sync();
#define RUN_GEMM(EPI, ALIGN, gd, ep) do { pg8::Order S_; S_.init(gd, G, bx); pg8::gemm_phase<EPI, ALIGN>(lds, xl, gd, S_, ep); } while (0)

    PHASE(0) { LOCAL_IDS
        LAS float* scr = (LAS float*)(lds + wave * 16384);
        constexpr int I_AB = 16 * 112, I_SQ = 16 * 32, I_HG = 16 * 160, I_KV = 16 * 64, I_F1 = 16 * 176, I_F2 = 44 * 32, I_G2 = 2 * 16;
        constexpr int NIT = I_AB + I_SQ + I_HG + I_SQ + 2 * I_KV + 2 * I_SQ + 2 * I_F1 + 2 * I_F2 + I_G2;
        for (int it = gw; it < NIT; it += NGW) {
            int r = it;
            if (r < I_AB) { transpose_item<0>(INP(3), 1024, ABP, WAB, scr, r, 112, lane); continue; } r -= I_AB;
            if (r < I_SQ) { transpose_item<0>(INP(4), 1024, 1024, WABO, scr, r, 32, lane); continue; } r -= I_SQ;
            if (r < I_HG) { transpose_item<0>(INP(22), 1024, HGP, WHG, scr, r, 160, lane, INP(2) + D); continue; } r -= I_HG;
            if (r < I_SQ) { transpose_item<0>(INP(23), 1024, 1024, WHGO, scr, r, 32, lane); continue; } r -= I_SQ;
            if (r < 2 * I_KV) { const int l = r / I_KV; transpose_item<0>(INP(29) + (size_t)l * D * 2048, 1024, 2048, WKV + (size_t)l * D * 2048, scr, r % I_KV, 64, lane); continue; } r -= 2 * I_KV;
            if (r < 2 * I_SQ) { const int l = r / I_SQ; transpose_item<0>(INP(30) + (size_t)l * D * D, 1024, 1024, WO + (size_t)l * D * D, scr, r % I_SQ, 32, lane); continue; } r -= 2 * I_SQ;
            if (r < 2 * I_F1) { const int l = r / I_F1; transpose_item<1>(INP(32) + (size_t)l * D * 2 * FFN, 1024, 2 * FFN, WF1 + (size_t)l * D * 2 * FFN, scr, r % I_F1, 176, lane, INP(31) + l * D); continue; } r -= 2 * I_F1;
            if (r < 2 * I_F2) { const int l = r / I_F2; transpose_item<0>(INP(33) + (size_t)l * FFN * D, FFN, 1024, WF2 + (size_t)l * FFN * D, scr, r % I_F2, 32, lane); continue; } r -= 2 * I_F2;
            transpose_item<0>(INP(10), 128, 512, G2T, scr, r, 16, lane);
        }
        for (size_t e8 = (size_t)bx * 512 + tid; e8 < (size_t)2 * D * D / 8; e8 += (size_t)G * 512) { const size_t idx = e8 * 8; const int l = (int)(idx / ((size_t)D * D)), k = (int)((idx % ((size_t)D * D)) / D);
            const float gk = INP(26)[l * D + k]; const f32x4 a0 = *(const f32x4*)(INP(28) + idx), a1 = *(const f32x4*)(INP(28) + idx + 4);
            u32x4 o; o.x = pk2(a0[0] * gk, a0[1] * gk); o.y = pk2(a0[2] * gk, a0[3] * gk); o.z = pk2(a1[0] * gk, a1[1] * gk); o.w = pk2(a1[2] * gk, a1[3] * gk); *(u32x4*)(WQ + idx) = o; }
        rms_rows_phase(x, INP(2), H, T, gw, NGW, lane);
        for (int m = gw; m < 2 * 4096; m += NGW) { const int l = m >> 12, r = m & 4095; rms_row_bf16(INP(1) + (size_t)r * D, INP(27) + l * D, MEMN + (size_t)m * D, lane); }
        __syncthreads();
    }
    SEAM(0);
    PHASE(1) {
        { pg8::Gemm g = pg8::make_gemm(H, WAB, T, ABPAD, 1024, 1024, 1024); pg8::EpiBf16 E{P, ABPAD, 1.0f, nullptr}; RUN_GEMM(pg8::EpiBf16, true, g, E); }
        { pg8::Gemm g = pg8::make_gemm(MEMN, WKV, 4096, 2048, 1024, 1024, 1024); g.nZ = 2; g.sAo = 4096L * D; g.sBo = 2048L * D; g.sCo = 4096L * 2048; pg8::EpiBf16 E{KMEM, 2048, 1.0f, nullptr}; RUN_GEMM(pg8::EpiBf16, true, g, E); }
    }
    SEAM(1);
    PHASE(2) {
#ifndef DUP_RWKV
#define DUP_RWKV 0
#endif
#ifndef DUP_S1
#define DUP_S1 0
#endif
        for (int r2 = 0; r2 <= DUP_RWKV; ++r2)
        for (int cid = bx; cid < 256; cid += G)
            rwkv_chain(lds, cid, P, INP(5), INP(6), INP(7), INP(8), INP(9), INP(11), INP(12), INP(13), H, SG, BONUS);
        for (int r2 = 0; r2 <= DUP_S1; ++r2)
        for (int u = bx; u < 1024; u += G) ssd_s1_unit(lds, u, P, INP(16), INP(17), INP(18), INP(19), STATES, TOT);
        __syncthreads();
    }
    SEAM(2);
    PHASE(3) {
        { int k128 = 128; asm volatile("" : "+s"(k128)); pg8::Gemm g = pg8::make_gemm(SG, G2T, T, 512, k128, 128, 128); pg8::EpiBf16 E{GG, 512, 1.0f, nullptr}; RUN_GEMM(pg8::EpiBf16, true, g, E); }
        { LOCAL_IDS ssd_s2(STATES, OMIX1, TOT, bx * 512 + tid, G * 512); }
    }
    SEAM(3);
    PHASE(4) {
#ifndef DUP_S3
#define DUP_S3 0
#endif
        for (int r2 = 0; r2 <= DUP_S3; ++r2)
        for (int u = bx; u < 1024; u += G) ssd_s3_unit(lds, u, P, INP(16), INP(17), INP(18), INP(19), INP(20), INP(21), OMIX1, OMIX0);
        __syncthreads();
        { LOCAL_IDS rwkv_combine(P, H, BONUS, GG, INP(5), INP(14), INP(15), OMIX0, gw, NGW, lane); }
    }
    SEAM(4);
    PHASE(5) { { pg8::Gemm g = pg8::make_gemm(OMIX0, WABO, T, 1024, 1024, 1024, 1024); pg8::EpiResidB E{x, H, PSB, 1024}; RUN_GEMM(pg8::EpiResidB, true, g, E); }
        for (int l = 0; l < 2; ++l) {
            { pg8::Gemm g = pg8::make_gemm(KMEM + (size_t)l * 4096 * 2048, WQ + (size_t)l * D * D, 256, 1024, 256, 2048, 1024); g.nZ = 64; g.zdiv = 4;
              g.sAo = 256L * 2048; g.sAi = 256; g.sBo = 0; g.sBi = 256; g.sCo = 4L * 256 * 1024; g.sCi = 256L * 1024; pg8::EpiBf16 E{WKT + (size_t)l * 16777216, 1024, 0.0625f, nullptr}; RUN_GEMM(pg8::EpiBf16, true, g, E); }
            { pg8::Gemm g = pg8::make_gemm(WO + (size_t)l * D * D, KMEM + (size_t)l * 4096 * 2048 + 1024, 1024, 256, 256, 1024, 2048); g.nZ = 64; g.zdiv = 4;
              g.sAo = 0; g.sAi = 256; g.sBo = 256L * 2048; g.sBi = 256; g.sCo = 1024L * 1024; g.sCi = 256; pg8::EpiBf16 E{VWT + (size_t)l * 16777216, 1024, 1.0f, nullptr}; RUN_GEMM(pg8::EpiBf16, true, g, E); }
        } }
    SEAM(5);

#define ATTN_FFN(base, L) \
    PHASE(base) { pg8::Gemm g = pg8::make_gemm(H, WKT + (size_t)(L) * 16777216, SEQ, 256, 1024, 1024, 1024); g.nZ = 64; g.zdiv = 4; g.psz = 16; \
        g.sAo = (long)SEQ * D; g.sAi = 0; g.sBo = 4L * 256 * 1024; g.sBi = 256L * 1024; g.sCo = (long)SEQ * D; g.sCi = 256; pg8::EpiSoftmaxPS E{PSB, PATT, 1024}; RUN_GEMM(pg8::EpiSoftmaxPS, true, g, E); } \
    SEAM(base); \
    PHASE(base + 1) { pg8::Gemm g = pg8::make_gemm(PATT, VWT + (size_t)(L) * 16777216, SEQ, 1024, 1024, 1024, 1024); g.nZ = 16; g.zdiv = 1; \
        g.sAo = (long)SEQ * D; g.sBo = 1024L * 1024; g.sCo = (long)SEQ * D; pg8::EpiResidB E{nullptr, H, PSB, 1024}; RUN_GEMM(pg8::EpiResidB, true, g, E); } \
    SEAM(base + 1); \
    PHASE(base + 2) { pg8::Gemm g = pg8::make_gemm(H, WF1 + (size_t)(L) * D * 2 * FFN, T, 2 * FFN, 1024, 1024, 1024); pg8::EpiSwiglu E{P, FFN, PSB}; RUN_GEMM(pg8::EpiSwiglu, true, g, E); } \
    SEAM(base + 2); \
    PHASE(base + 3) { pg8::Gemm g = pg8::make_gemm(P, WF2 + (size_t)(L) * FFN * D, T, 1024, FFN, FFN, FFN); pg8::EpiResidB E{nullptr, H, PSB, 1024}; RUN_GEMM(pg8::EpiResidB, true, g, E); } \
    SEAM(base + 3);

    ATTN_FFN(6, 0)

    PHASE(10) { pg8::Gemm g = pg8::make_gemm(H, WHG, T, HGP, 1024, 1024, 1024); pg8::EpiBf16PS E{P, HGP, 1.0f, PSB}; RUN_GEMM(pg8::EpiBf16PS, true, g, E); }
    SEAM(10);
    PHASE(11) { for (int cid = bx; cid < 256; cid += G) hgrn_chain(lds, cid, P, INP(25), P, HGP, 1024, 1024); }
    SEAM(11);
    PHASE(12) { LOCAL_IDS hgrn_combine(P, INP(24), OMIX1, gw, NGW, lane); }
    SEAM(12);
    PHASE(13) { pg8::Gemm g = pg8::make_gemm(OMIX1, WHGO, T, 1024, 1024, 1024, 1024); pg8::EpiResidB E{nullptr, H, PSB, 1024}; RUN_GEMM(pg8::EpiResidB, true, g, E); }
    SEAM(13);

    ATTN_FFN(14, 1)

    PHASE(18) { LOCAL_IDS
        const float* fg = INP(34);
#pragma unroll 2
        for (int m = gw; m < T; m += NGW) {
            const f32x4 pa = *(const f32x4*)(PSB + (size_t)m * 16 + (lane & 3) * 4); float sq = (pa[0] + pa[1]) + (pa[2] + pa[3]); sq += __shfl_xor(sq, 1); sq += __shfl_xor(sq, 2);
            const float rs = rsqrtf(sq * (1.f / D) + 1e-6f);
            const bf16_t* hr = H + (size_t)m * D; float* orow = out + (size_t)m * D;
#pragma unroll
            for (int j = 0; j < 2; ++j) { const int c = (lane + 64 * j) * 8; const u32x4 hv = *(const u32x4*)(hr + c); const f32x4 g0 = *(const f32x4*)(fg + c), g1 = *(const f32x4*)(fg + c + 4);
                *(f32x4*)(orow + c) = (f32x4){bflo(hv.x) * rs * g0[0], bfhi(hv.x) * rs * g0[1], bflo(hv.y) * rs * g0[2], bfhi(hv.y) * rs * g0[3]};
                *(f32x4*)(orow + c + 4) = (f32x4){bflo(hv.z) * rs * g1[0], bfhi(hv.z) * rs * g1[1], bflo(hv.w) * rs * g1[2], bfhi(hv.w) * rs * g1[3]}; } }
    }
#undef IN
#undef SEAM
#undef RUN_GEMM
}

extern "C" void kernel_launch(void* const* d_in, const int* in_sizes, int n_in, void* d_out, int out_size, void* d_ws, size_t ws_size, hipStream_t stream) {
    static int grid = 0;
    if (grid == 0) {
        if (n_in != 35 || out_size != T * D || ws_size < WS_END) { fprintf(stderr, "kernel_launch: unexpected shapes (n_in %d out %d ws %zu)\n", n_in, out_size, ws_size); grid = -1; return; }
        int dev = 0, cus = 0, per_cu = 0;
        hipGetDevice(&dev); hipDeviceGetAttribute(&cus, hipDeviceAttributeMultiprocessorCount, dev);
        hipFuncSetAttribute((const void*)mk_fwd, hipFuncAttributeMaxDynamicSharedMemorySize, LDS_BYTES);
        hipOccupancyMaxActiveBlocksPerMultiprocessor(&per_cu, (const void*)mk_fwd, 512, LDS_BYTES);
        if (per_cu < 1) { fprintf(stderr, "kernel_launch: occupancy query says %d blocks per CU\n", per_cu); per_cu = 1; }
        (void)hipGetLastError();
        grid = cus * 1;
    }
    if (grid < 0) return;
    if (hipMemsetAsync(d_ws, 0, 65536, stream) != hipSuccess) { fprintf(stderr, "kernel_launch: memset of the barrier words failed\n"); return; }
    Args a{};
    for (int i = 0; i < 35; ++i) a.in[i] = (const float*)d_in[i];
    a.out = (float*)d_out; a.ws = (unsigned char*)d_ws;
#if MK_COOP
    a.ph_lo = 0; a.ph_hi = NPHASE;
    void* kargs[] = {&a};
    hipError_t e = hipLaunchCooperativeKernel((const void*)mk_fwd, dim3(grid), dim3(512), kargs, LDS_BYTES, stream);
    if (e != hipSuccess) fprintf(stderr, "cooperative launch failed: %s (grid %d)\n", hipGetErrorString(e), grid);
#else
    for (int ph = 0; ph < NPHASE; ++ph) { a.ph_lo = ph; a.ph_hi = ph + 1; hipLaunchKernelGGL(mk_fwd, dim3(grid), dim3(512), LDS_BYTES, stream, a); }
#endif
}
```

```cpp
#include <hip/hip_runtime.h>
#include <hip/hip_cooperative_groups.h>
#include <cstdio>
#include <cstdint>
namespace cg = cooperative_groups;

#ifndef MK_COOP
#define MK_COOP 1
#endif

#define LAS __attribute__((address_space(3)))
typedef unsigned short bf16_t;
typedef short bf16x8 __attribute__((ext_vector_type(8)));
typedef float f32x4 __attribute__((ext_vector_type(4)));
typedef float f32x2 __attribute__((ext_vector_type(2)));
typedef unsigned u32x4 __attribute__((ext_vector_type(4)));
typedef unsigned u32x2 __attribute__((ext_vector_type(2)));

constexpr int NB = 16, SEQ = 4096, T = NB * SEQ, D = 1024;
constexpr int ABPAD = 3584, ABP = 3336;
constexpr int HGP = 5120;
constexpr int FFN = 2816;
constexpr int NPHASE = 19;

constexpr size_t MiB = 1u << 20;
constexpr size_t WS_WAB = 1 * MiB, WS_WABO = 8 * MiB, WS_WHG = 10 * MiB, WS_WHGO = 20 * MiB, WS_WQ = 22 * MiB, WS_WKV = 26 * MiB, WS_WO = 34 * MiB,
                 WS_WF1 = 38 * MiB, WS_WF2 = 60 * MiB, WS_G2T = 71 * MiB, WS_MEMN = 72 * MiB, WS_KMEM = 88 * MiB, WS_VT = 104 * MiB,
                 WS_PS = 120 * MiB, WS_H = 128 * MiB, WS_P = 256 * MiB, WS_PATT = 384 * MiB, WS_OMIX0 = 704 * MiB, WS_OMIX1 = 896 * MiB, WS_END = 1024 * MiB;
constexpr size_t DO_STATES = 0, DO_G = 128 * MiB, DO_SG = 192 * MiB, DO_BONUS = 208 * MiB, DO_TOT = 210 * MiB;

constexpr int LDS_BYTES = 163840;
constexpr int XLDS_OFF = 131072;

typedef __bf16 bf16x2_t __attribute__((ext_vector_type(2)));
__device__ __forceinline__ unsigned pk2(float lo, float hi) { const f32x2 v = {lo, hi}; return __builtin_bit_cast(unsigned, __builtin_convertvector(v, bf16x2_t)); }
__device__ __forceinline__ unsigned f2bf(float f) { return pk2(f, 0.f) & 0xffffu; }
__device__ __forceinline__ float bf2f(unsigned short b) { return __builtin_bit_cast(float, (unsigned)b << 16); }
__device__ __forceinline__ float bflo(unsigned u) { return __builtin_bit_cast(float, u << 16); }
__device__ __forceinline__ float bfhi(unsigned u) { return __builtin_bit_cast(float, u & 0xffff0000u); }
__device__ __forceinline__ float frcp(float x) { return __builtin_amdgcn_rcpf(x); }
__device__ __forceinline__ float sigmoidf_(float x) { return frcp(1.0f + __expf(-x)); }
__device__ __forceinline__ float siluf_(float x) { return x * frcp(1.0f + __expf(-x)); }
__device__ __forceinline__ float wave_sum(float v) {
#pragma unroll
    for (int o = 1; o < 64; o <<= 1) v += __shfl_xor(v, o);
    return v;
}
template <int CTRL> __device__ __forceinline__ float dppf(float x) { return __builtin_bit_cast(float, __builtin_amdgcn_mov_dpp(__builtin_bit_cast(int, x), CTRL, 0xf, 0xf, true)); }
__device__ __forceinline__ float sum8(float v) { v += dppf<0xB1>(v); v += dppf<0x4E>(v); v += dppf<0x141>(v); return v; }
#define LDS_WAIT() asm volatile("s_waitcnt lgkmcnt(0)" ::: "memory")

namespace pg8 {
constexpr int BM = 256, BK = 64, HALF = 128, HTB = HALF * BK * 2, STAGE_BYTES = 8 * HTB, NXCD = 8, WGM = 8;
__host__ __device__ __forceinline__ int lds_byte(int r, int c) { const int st = (r >> 4) * 2 + (c >> 5), rr = r & 15, cc = c & 31, ob = rr * 64 + cc * 2; return st * 1024 + (ob ^ (((ob >> 9) & 1) << 5)); }
__host__ __device__ __forceinline__ void stage_rc(int b, int& R, int& C) { const int st = b / 1024, sb = b % 1024, swz = sb ^ (((sb >> 9) & 1) << 5); R = (st >> 1) * 16 + swz / 64; C = (st & 1) * 32 + (swz % 64) / 2; }
__host__ __device__ __forceinline__ int perm32(int rho) { const int n = rho >> 4, i = rho & 15; return 8 * (i >> 2) + 4 * n + (i & 3); }

struct Unit { int pm, pn, z; };
struct Gemm {
    const bf16_t* A; const bf16_t* Bt; int lda, ldb, K, nM, nN, nZ, zdiv, psz; long sAo, sAi, sBo, sBi, sCo, sCi;
    __device__ __forceinline__ long offA(const Unit& u) const { return (long)(u.z / zdiv) * sAo + (long)(u.z % zdiv) * sAi + (long)u.pm * BM * lda; }
    __device__ __forceinline__ long offB(const Unit& u) const { return (long)(u.z / zdiv) * sBo + (long)(u.z % zdiv) * sBi + (long)u.pn * BM * ldb; }
    __device__ __forceinline__ long offC(const Unit& u) const { return (long)(u.z / zdiv) * sCo + (long)(u.z % zdiv) * sCi; }
};
__device__ __forceinline__ Gemm make_gemm(const bf16_t* A, const bf16_t* Bt, int M, int N, int K, int lda, int ldb) {
    Gemm g; g.A = A; g.Bt = Bt; g.lda = lda; g.ldb = ldb; g.K = K; g.nM = M / BM; g.nN = N / BM; g.nZ = 1; g.zdiv = 1; g.psz = 0; g.sAo = g.sAi = g.sBo = g.sBi = g.sCo = g.sCi = 0; return g;
}
struct Order {
    int nM, nN, nwg, total, G, c;
    __device__ __forceinline__ void init(const Gemm& g, int G_, int c_) { nM = g.nM; nN = g.nN; nwg = nM * nN; total = nwg * g.nZ; G = G_; c = c_; }
    __device__ __forceinline__ bool next(int i, Unit& u) const {
        const long L = (long)i * G + c; if (L >= total) return false;
        u.z = (int)(L / nwg); int wgid = (int)(L % nwg);
        { const int q = nwg / NXCD, r = nwg % NXCD, xcd = wgid % NXCD, off = wgid / NXCD; wgid = (xcd < r ? xcd * (q + 1) : r * (q + 1) + (xcd - r) * q) + off; }
        const int nig = WGM * nN, gid = wgid / nig, fm = gid * WGM, gsz = (nM - fm) < WGM ? (nM - fm) : WGM;
        u.pm = fm + ((wgid % nig) % gsz); u.pn = (wgid % nig) / gsz; return true;
    }
};

__device__ __forceinline__ unsigned cvt_pk_bf16(float lo, float hi) { return pk2(lo, hi); }

__device__ __forceinline__ void row_scales(const float* PS, int rowbase, int fq, float (&rs)[2][4]) {
#pragma unroll
    for (int ai = 0; ai < 2; ++ai)
#pragma unroll
        for (int m = 0; m < 4; ++m) { const f32x4 p = *(const f32x4*)(PS + (size_t)(rowbase + ai * HALF + m * 16) * 16 + fq * 4);
            float s = (p[0] + p[1]) + (p[2] + p[3]); s += __shfl_xor(s, 16); s += __shfl_xor(s, 32); rs[ai][m] = rsqrtf(s * (1.f / 1024.f) + 1e-6f); }
}
__device__ __forceinline__ void row_scales_lds(const LAS float* PSL, int rloc  , int fq, float (&rs)[2][4]) {
#pragma unroll
    for (int ai = 0; ai < 2; ++ai)
#pragma unroll
        for (int m = 0; m < 4; ++m) { const f32x4 p = *(const LAS f32x4*)(PSL + (rloc + ai * HALF + m * 16) * 16 + fq * 4);
            float s = (p[0] + p[1]) + (p[2] + p[3]); s += __shfl_xor(s, 16); s += __shfl_xor(s, 32); rs[ai][m] = rsqrtf(s * (1.f / 1024.f) + 1e-6f); }
}
struct EpiBf16 {
    static constexpr bool PERM = true, PSLDS = false;
    bf16_t* O; int ldc; float scale; const float* PS;
    __device__ __forceinline__ void operator()(const f32x4 (&acc)[2][2][4][2], const Unit& u, long coff, int wr, int wc, int fr, int fq, LAS unsigned char* xl) const {
        const int row0 = u.pm * BM + wr * 64 + fr, col0 = u.pn * BM + wc * 32 + 8 * fq; bf16_t* base = O + coff;
        float rs[2][4];
        if (PS) row_scales(PS, row0, fq, rs);
        else {
#pragma unroll
            for (int ai = 0; ai < 2; ++ai)
#pragma unroll
                for (int m = 0; m < 4; ++m) rs[ai][m] = 1.f; }
#pragma unroll
        for (int ai = 0; ai < 2; ++ai)
#pragma unroll
            for (int m = 0; m < 4; ++m) { bf16_t* rowp = base + (size_t)(row0 + ai * HALF + m * 16) * ldc + col0; const float sc_ = scale * rs[ai][m];
#pragma unroll
                for (int bj = 0; bj < 2; ++bj) { const f32x4 v0 = acc[ai][bj][m][0] * sc_, v1 = acc[ai][bj][m][1] * sc_;
                    u32x4 w; w.x = cvt_pk_bf16(v0[0], v0[1]); w.y = cvt_pk_bf16(v0[2], v0[3]); w.z = cvt_pk_bf16(v1[0], v1[1]); w.w = cvt_pk_bf16(v1[2], v1[3]);
                    *(u32x4*)(rowp + bj * HALF) = w; } }
    }
};
struct EpiBf16PS {
    static constexpr bool PERM = true, PSLDS = true;
    bf16_t* O; int ldc; float scale; const float* PS;
    __device__ __forceinline__ void operator()(const f32x4 (&acc)[2][2][4][2], const Unit& u, long coff, int wr, int wc, int fr, int fq, LAS unsigned char* xl) const {
        const int row0 = u.pm * BM + wr * 64 + fr, col0 = u.pn * BM + wc * 32 + 8 * fq; bf16_t* base = O + coff;
        float rs[2][4];
        row_scales_lds((const LAS float*)(xl + 8192), wr * 64 + fr, fq, rs);
#pragma unroll
        for (int ai = 0; ai < 2; ++ai)
#pragma unroll
            for (int m = 0; m < 4; ++m) { bf16_t* rowp = base + (size_t)(row0 + ai * HALF + m * 16) * ldc + col0; const float sc_ = scale * rs[ai][m];
#pragma unroll
                for (int bj = 0; bj < 2; ++bj) { const f32x4 v0 = acc[ai][bj][m][0] * sc_, v1 = acc[ai][bj][m][1] * sc_;
                    u32x4 w; w.x = cvt_pk_bf16(v0[0], v0[1]); w.y = cvt_pk_bf16(v0[2], v0[3]); w.z = cvt_pk_bf16(v1[0], v1[1]); w.w = cvt_pk_bf16(v1[2], v1[3]);
                    *(u32x4*)(rowp + bj * HALF) = w; } }
    }
};
struct EpiResid {
    static constexpr bool PERM = false, PSLDS = false;
    const float* base; float* out; int ldc;
    __device__ __forceinline__ void operator()(const f32x4 (&acc)[2][2][4][2], const Unit& u, long coff, int wr, int wc, int fr, int fq, LAS unsigned char* xl) const {
        const int col0 = u.pn * BM + wc * 32 + 4 * fq;
#pragma unroll
        for (int ai = 0; ai < 2; ++ai)
#pragma unroll
            for (int m = 0; m < 4; ++m) { const size_t off = (size_t)(u.pm * BM + ai * HALF + wr * 64 + m * 16 + fr) * ldc + col0;
#pragma unroll
                for (int bj = 0; bj < 2; ++bj)
#pragma unroll
                    for (int n = 0; n < 2; ++n) { const f32x4 bs = *(const f32x4*)(base + off + bj * HALF + n * 16); *(f32x4*)(out + off + bj * HALF + n * 16) = bs + acc[ai][bj][m][n]; } }
    }
};
struct EpiResidH {
    static constexpr bool PERM = false, PSLDS = false;
    const float* base; float* out; bf16_t* HB; float* PS; int ldc;
    __device__ __forceinline__ void operator()(const f32x4 (&acc)[2][2][4][2], const Unit& u, long coff, int wr, int wc, int fr, int fq, LAS unsigned char* xl) const {
        const int col0 = u.pn * BM + wc * 32 + 4 * fq;
#pragma unroll
        for (int ai = 0; ai < 2; ++ai)
#pragma unroll
            for (int m = 0; m < 4; ++m) { const int row = u.pm * BM + ai * HALF + wr * 64 + m * 16 + fr; const size_t off = (size_t)row * ldc + col0; float ss = 0.f;
#pragma unroll
                for (int bj = 0; bj < 2; ++bj)
#pragma unroll
                    for (int n = 0; n < 2; ++n) { const f32x4 bs = *(const f32x4*)(base + off + bj * HALF + n * 16); const f32x4 o = bs + acc[ai][bj][m][n]; *(f32x4*)(out + off + bj * HALF + n * 16) = o;
                        ss += (o[0] * o[0] + o[1] * o[1]) + (o[2] * o[2] + o[3] * o[3]);
                        u32x2 w; w.x = cvt_pk_bf16(o[0], o[1]); w.y = cvt_pk_bf16(o[2], o[3]); *(u32x2*)(HB + off + bj * HALF + n * 16) = w; }
                ss += __shfl_xor(ss, 16); ss += __shfl_xor(ss, 32);
                if (fq == 0) PS[(size_t)row * 16 + u.pn * 4 + wc] = ss; }
    }
};
struct EpiResidB {
    static constexpr bool PERM = false, PSLDS = false;
    const float* basef; bf16_t* HB; float* PS; int ldc;
    __device__ __forceinline__ void operator()(const f32x4 (&acc)[2][2][4][2], const Unit& u, long coff, int wr, int wc, int fr, int fq, LAS unsigned char* xl) const {
        const int col0 = u.pn * BM + wc * 32 + 4 * fq;
#pragma unroll
        for (int ai = 0; ai < 2; ++ai)
#pragma unroll
            for (int m = 0; m < 4; ++m) { const int row = (int)(coff / ldc) + u.pm * BM + ai * HALF + wr * 64 + m * 16 + fr; const size_t off = (size_t)row * ldc + col0; float ss = 0.f;
#pragma unroll
                for (int bj = 0; bj < 2; ++bj)
#pragma unroll
                    for (int n = 0; n < 2; ++n) { f32x4 bs;
                        if (basef) bs = *(const f32x4*)(basef + off + bj * HALF + n * 16);
                        else { const u32x2 hb = *(const u32x2*)(HB + off + bj * HALF + n * 16); bs = (f32x4){bflo(hb.x), bfhi(hb.x), bflo(hb.y), bfhi(hb.y)}; }
                        const f32x4 o = bs + acc[ai][bj][m][n];
                        ss += (o[0] * o[0] + o[1] * o[1]) + (o[2] * o[2] + o[3] * o[3]);
                        u32x2 w; w.x = cvt_pk_bf16(o[0], o[1]); w.y = cvt_pk_bf16(o[2], o[3]); *(u32x2*)(HB + off + bj * HALF + n * 16) = w; }
                ss += __shfl_xor(ss, 16); ss += __shfl_xor(ss, 32);
                if (fq == 0) PS[(size_t)row * 16 + u.pn * 4 + wc] = ss; }
    }
};
struct EpiSwiglu {
    static constexpr bool PERM = true, PSLDS = true;
    bf16_t* O; int ldc; const float* PS;
    __device__ __forceinline__ void operator()(const f32x4 (&acc)[2][2][4][2], const Unit& u, long coff, int wr, int wc, int fr, int fq, LAS unsigned char* xl) const {
        const int row0 = u.pm * BM + wr * 64 + fr, col0 = u.pn * HALF + wc * 32 + 8 * fq;
        float rs[2][4]; row_scales_lds((const LAS float*)(xl + 8192), wr * 64 + fr, fq, rs);
#pragma unroll
        for (int ai = 0; ai < 2; ++ai)
#pragma unroll
            for (int m = 0; m < 4; ++m) { bf16_t* rowp = O + (size_t)(row0 + ai * HALF + m * 16) * ldc + col0; float r[8]; const float sc_ = rs[ai][m];
#pragma unroll
                for (int n = 0; n < 2; ++n)
#pragma unroll
                    for (int i = 0; i < 4; ++i) { const float g = acc[ai][0][m][n][i] * sc_, uu = acc[ai][1][m][n][i] * sc_; r[n * 4 + i] = siluf_(g) * uu; }
                u32x4 w; w.x = cvt_pk_bf16(r[0], r[1]); w.y = cvt_pk_bf16(r[2], r[3]); w.z = cvt_pk_bf16(r[4], r[5]); w.w = cvt_pk_bf16(r[6], r[7]);
                *(u32x4*)rowp = w; }
    }
};
struct EpiSoftmax {
    static constexpr bool PERM = true, PSLDS = false;
    bf16_t* O; int ldc;
    __device__ __forceinline__ void operator()(f32x4 (&acc)[2][2][4][2], const Unit& u, long coff, int wr, int wc, int fr, int fq, LAS unsigned char* xl) const {
        LAS float* XM = (LAS float*)xl; LAS float* XS = (LAS float*)(xl + 4096);
#pragma unroll
        for (int ai = 0; ai < 2; ++ai)
#pragma unroll
            for (int m = 0; m < 4; ++m) { float mx = -3.0e38f;
#pragma unroll
                for (int bj = 0; bj < 2; ++bj)
#pragma unroll
                    for (int n = 0; n < 2; ++n)
#pragma unroll
                        for (int i = 0; i < 4; ++i) mx = fmaxf(mx, acc[ai][bj][m][n][i]);
                mx = fmaxf(mx, __shfl_xor(mx, 16)); mx = fmaxf(mx, __shfl_xor(mx, 32));
                if (fq == 0) XM[(ai * HALF + wr * 64 + m * 16 + fr) * 4 + wc] = mx; }
        LDS_WAIT(); __builtin_amdgcn_s_barrier(); asm volatile("" ::: "memory");
#pragma unroll
        for (int ai = 0; ai < 2; ++ai)
#pragma unroll
            for (int m = 0; m < 4; ++m) { const f32x4 mm = *(const LAS f32x4*)(XM + (ai * HALF + wr * 64 + m * 16 + fr) * 4);
                const float mx = fmaxf(fmaxf(mm[0], mm[1]), fmaxf(mm[2], mm[3])); float s = 0.f;
#pragma unroll
                for (int bj = 0; bj < 2; ++bj)
#pragma unroll
                    for (int n = 0; n < 2; ++n)
#pragma unroll
                        for (int i = 0; i < 4; ++i) { const float e = __expf(acc[ai][bj][m][n][i] - mx); acc[ai][bj][m][n][i] = e; s += e; }
                s += __shfl_xor(s, 16); s += __shfl_xor(s, 32);
                if (fq == 0) XS[(ai * HALF + wr * 64 + m * 16 + fr) * 4 + wc] = s; }
        LDS_WAIT(); __builtin_amdgcn_s_barrier(); asm volatile("" ::: "memory");
        const int row0 = u.pm * BM + wr * 64 + fr, col0 = wc * 32 + 8 * fq; bf16_t* base = O + coff;
#pragma unroll
        for (int ai = 0; ai < 2; ++ai)
#pragma unroll
            for (int m = 0; m < 4; ++m) { const f32x4 ss = *(const LAS f32x4*)(XS + (ai * HALF + wr * 64 + m * 16 + fr) * 4);
                const float inv = frcp((ss[0] + ss[1]) + (ss[2] + ss[3])); bf16_t* rowp = base + (size_t)(row0 + ai * HALF + m * 16) * ldc + col0;
#pragma unroll
                for (int bj = 0; bj < 2; ++bj) { const f32x4 v0 = acc[ai][bj][m][0] * inv, v1 = acc[ai][bj][m][1] * inv;
                    u32x4 w; w.x = cvt_pk_bf16(v0[0], v0[1]); w.y = cvt_pk_bf16(v0[2], v0[3]); w.z = cvt_pk_bf16(v1[0], v1[1]); w.w = cvt_pk_bf16(v1[2], v1[3]);
                    *(u32x4*)(rowp + bj * HALF) = w; } }
    }
};

struct EpiSoftmaxPS {
    const float* PS;
    static constexpr bool PERM = true, PSLDS = true;
    bf16_t* O; int ldc;
    __device__ __forceinline__ void operator()(f32x4 (&acc)[2][2][4][2], const Unit& u, long coff, int wr, int wc, int fr, int fq, LAS unsigned char* xl) const {
        LAS float* XM = (LAS float*)xl; LAS float* XS = (LAS float*)(xl + 4096);
        { float rs[2][4]; row_scales_lds((const LAS float*)(xl + 8192), wr * 64 + fr, fq, rs);
#pragma unroll
          for (int ai = 0; ai < 2; ++ai)
#pragma unroll
              for (int m = 0; m < 4; ++m)
#pragma unroll
                  for (int bj = 0; bj < 2; ++bj)
#pragma unroll
                      for (int n = 0; n < 2; ++n) acc[ai][bj][m][n] = acc[ai][bj][m][n] * rs[ai][m]; }
#pragma unroll
        for (int ai = 0; ai < 2; ++ai)
#pragma unroll
            for (int m = 0; m < 4; ++m) { float mx = -3.0e38f;
#pragma unroll
                for (int bj = 0; bj < 2; ++bj)
#pragma unroll
                    for (int n = 0; n < 2; ++n)
#pragma unroll
                        for (int i = 0; i < 4; ++i) mx = fmaxf(mx, acc[ai][bj][m][n][i]);
                mx = fmaxf(mx, __shfl_xor(mx, 16)); mx = fmaxf(mx, __shfl_xor(mx, 32));
                if (fq == 0) XM[(ai * HALF + wr * 64 + m * 16 + fr) * 4 + wc] = mx; }
        LDS_WAIT(); __builtin_amdgcn_s_barrier(); asm volatile("" ::: "memory");
#pragma unroll
        for (int ai = 0; ai < 2; ++ai)
#pragma unroll
            for (int m = 0; m < 4; ++m) { const f32x4 mm = *(const LAS f32x4*)(XM + (ai * HALF + wr * 64 + m * 16 + fr) * 4);
                const float mx = fmaxf(fmaxf(mm[0], mm[1]), fmaxf(mm[2], mm[3])); float s = 0.f;
#pragma unroll
                for (int bj = 0; bj < 2; ++bj)
#pragma unroll
                    for (int n = 0; n < 2; ++n)
#pragma unroll
                        for (int i = 0; i < 4; ++i) { const float e = __expf(acc[ai][bj][m][n][i] - mx); acc[ai][bj][m][n][i] = e; s += e; }
                s += __shfl_xor(s, 16); s += __shfl_xor(s, 32);
                if (fq == 0) XS[(ai * HALF + wr * 64 + m * 16 + fr) * 4 + wc] = s; }
        LDS_WAIT(); __builtin_amdgcn_s_barrier(); asm volatile("" ::: "memory");
        const int row0 = u.pm * BM + wr * 64 + fr, col0 = wc * 32 + 8 * fq; bf16_t* base = O + coff;
#pragma unroll
        for (int ai = 0; ai < 2; ++ai)
#pragma unroll
            for (int m = 0; m < 4; ++m) { const f32x4 ss = *(const LAS f32x4*)(XS + (ai * HALF + wr * 64 + m * 16 + fr) * 4);
                const float inv = frcp((ss[0] + ss[1]) + (ss[2] + ss[3])); bf16_t* rowp = base + (size_t)(row0 + ai * HALF + m * 16) * ldc + col0;
#pragma unroll
                for (int bj = 0; bj < 2; ++bj) { const f32x4 v0 = acc[ai][bj][m][0] * inv, v1 = acc[ai][bj][m][1] * inv;
                    u32x4 w; w.x = cvt_pk_bf16(v0[0], v0[1]); w.y = cvt_pk_bf16(v0[2], v0[3]); w.z = cvt_pk_bf16(v1[0], v1[1]); w.w = cvt_pk_bf16(v1[2], v1[3]);
                    *(u32x4*)(rowp + bj * HALF) = w; } }
    }
};

template <class Epi, bool ALIGN_EPI>
__device__ __forceinline__ void gemm_phase(LAS unsigned char* lds, LAS unsigned char* xl, const Gemm g, const Order& S, Epi& E) {
    const int tid = threadIdx.x, wid = __builtin_amdgcn_readfirstlane(tid >> 6), lane = tid & 63, wr = wid >> 2, wc = wid & 3, fr = lane & 15, fq = lane >> 4;
    const int K = g.K, nt = K / BK;
    unsigned voffA[2], voffB[2];
#pragma unroll
    for (int i = 0; i < 2; ++i) { int R, C; stage_rc(tid * 16 + i * 8192, R, C); const int Rb = Epi::PERM ? ((R & ~31) + perm32(R & 31)) : R;
        voffA[i] = (unsigned)(R * g.lda + C) * 2u; voffB[i] = (unsigned)(Rb * g.ldb + C) * 2u; }
    const size_t kstep = (size_t)(BK * 2);
    const size_t hstepA = (size_t)HALF * g.lda * 2, hstepB = (size_t)HALF * g.ldb * 2;
    const unsigned ldsw = (unsigned)wid * 1024u;
    const int aoff = lds_byte(wr * 64 + fr, fq * 8), boff = lds_byte(wc * 32 + fr, fq * 8);
#define PG8_SA(b, h) (((b) * 2 + (h)) * HTB)
#define PG8_SB(b, h) ((4 + (b) * 2 + (h)) * HTB)
#define PG8_STAGE(bufoff, gbase, voff) do { _Pragma("unroll") for (int _i = 0; _i < 2; ++_i) \
        __builtin_amdgcn_global_load_lds((const unsigned*)((const char*)(gbase) + (voff)[_i]), (LAS unsigned*)(lds + (bufoff) + ldsw + _i * 8192), 16, 0, 0); } while (0)
#define PG8_LDA(dst, b, h) do { _Pragma("unroll") for (int m = 0; m < 4; ++m) _Pragma("unroll") for (int k = 0; k < 2; ++k) dst[m][k] = *(const LAS bf16x8*)(lds + PG8_SA(b, h) + aoff + m * 2048 + k * 1024); } while (0)
#define PG8_LDB(dst, b, h) do { _Pragma("unroll") for (int n = 0; n < 2; ++n) _Pragma("unroll") for (int k = 0; k < 2; ++k) dst[n][k] = *(const LAS bf16x8*)(lds + PG8_SB(b, h) + boff + n * 2048 + k * 1024); } while (0)
#define PG8_MMA(ai, bj, At, Bt) do { __builtin_amdgcn_s_setprio(1); _Pragma("unroll") for (int m = 0; m < 4; ++m) _Pragma("unroll") for (int n = 0; n < 2; ++n) _Pragma("unroll") for (int k = 0; k < 2; ++k) \
        acc[ai][bj][m][n] = __builtin_amdgcn_mfma_f32_16x16x32_bf16(Bt[n][k], At[m][k], acc[ai][bj][m][n], 0, 0, 0); __builtin_amdgcn_s_setprio(0); } while (0)
#define PG8_WAIT_V(n) asm volatile("s_waitcnt vmcnt(" #n ")" ::: "memory")
#define PG8_WAIT_L(n) asm volatile("s_waitcnt lgkmcnt(" #n ")" ::: "memory")
#define PG8_BAR __builtin_amdgcn_s_barrier()
#define PG8_SCHED __builtin_amdgcn_sched_barrier(0)
    Unit cur, nxt; int ui = 0;
    if (!S.next(0, cur)) return;
    f32x4 acc[2][2][4][2];
#pragma unroll
    for (int a = 0; a < 2; ++a)
#pragma unroll
        for (int b = 0; b < 2; ++b)
#pragma unroll
            for (int m = 0; m < 4; ++m)
#pragma unroll
                for (int n = 0; n < 2; ++n) acc[a][b][m][n] = (f32x4){0.f, 0.f, 0.f, 0.f};
    bf16x8 At[4][2], B0[2][2], B1[2][2];
    const char* cA = (const char*)g.A + 2 * g.offA(cur); const char* cB = (const char*)g.Bt + 2 * g.offB(cur);
    PG8_STAGE(PG8_SB(0, 0), cB, voffB); PG8_STAGE(PG8_SB(0, 1), cB + hstepB, voffB); PG8_STAGE(PG8_SA(0, 0), cA, voffA); PG8_STAGE(PG8_SA(0, 1), cA + hstepA, voffA);
    if (wr == 1) PG8_BAR;
    PG8_WAIT_V(2); PG8_BAR;
    PG8_STAGE(PG8_SB(1, 0), cB + kstep, voffB); PG8_STAGE(PG8_SA(1, 0), cA + kstep, voffA); PG8_STAGE(PG8_SB(1, 1), cB + hstepB + kstep, voffB);
    PG8_WAIT_V(6); PG8_BAR;
    for (;;) {
        const bool has_next = S.next(ui + 1, nxt);
        const char* nA = has_next ? (const char*)g.A + 2 * g.offA(nxt) : cA; const char* nB = has_next ? (const char*)g.Bt + 2 * g.offB(nxt) : cB;
        for (int t = 0; t < nt; t += 2) {
            const bool last = (t == nt - 2);
            const char* a1 = cA + (size_t)(t + 1) * kstep;
            const char* a2 = last ? nA : cA + (size_t)(t + 2) * kstep; const char* b2 = last ? nB : cB + (size_t)(t + 2) * kstep;
            const char* a3 = a2 + kstep; const char* b3 = b2 + kstep;
            if constexpr (Epi::PSLDS) { if (last) {
                const char* psrc = (const char*)(E.PS + (size_t)((cur.z / g.zdiv) * g.psz + cur.pm) * (BM * 16)) + tid * 16;
#pragma unroll
                for (int _i = 0; _i < 2; ++_i) __builtin_amdgcn_global_load_lds((const unsigned*)(psrc + _i * 8192), (LAS unsigned*)(xl + 8192 + ldsw + _i * 8192), 16, 0, 0); } }
            PG8_LDB(B0, 0, 0); PG8_LDB(B1, 0, 1); PG8_SCHED; PG8_LDA(At, 0, 0); PG8_STAGE(PG8_SA(1, 1), a1 + hstepA, voffA);
            PG8_WAIT_V(8); PG8_WAIT_L(0); PG8_BAR; PG8_MMA(0, 0, At, B0); PG8_MMA(0, 1, At, B1); PG8_BAR; PG8_SCHED;
            PG8_LDA(At, 0, 1); PG8_STAGE(PG8_SB(0, 0), b2, voffB); PG8_STAGE(PG8_SB(0, 1), b2 + hstepB, voffB); PG8_STAGE(PG8_SA(0, 0), a2, voffA);
            PG8_WAIT_V(8); PG8_WAIT_L(0); PG8_BAR; PG8_MMA(1, 0, At, B0); PG8_MMA(1, 1, At, B1); PG8_BAR; PG8_SCHED;
            PG8_LDB(B0, 1, 0); PG8_LDB(B1, 1, 1); PG8_SCHED; PG8_LDA(At, 1, 0); PG8_STAGE(PG8_SA(0, 1), a2 + hstepA, voffA);
            PG8_WAIT_V(8); PG8_WAIT_L(0); PG8_BAR; PG8_MMA(0, 0, At, B0); PG8_MMA(0, 1, At, B1); PG8_BAR; PG8_SCHED;
            PG8_LDA(At, 1, 1); PG8_STAGE(PG8_SB(1, 0), b3, voffB); PG8_STAGE(PG8_SB(1, 1), b3 + hstepB, voffB); PG8_STAGE(PG8_SA(1, 0), a3, voffA);
            PG8_WAIT_V(8); PG8_WAIT_L(0); PG8_BAR; PG8_MMA(1, 0, At, B0); PG8_MMA(1, 1, At, B1); PG8_BAR; PG8_SCHED;
        }
        if constexpr (ALIGN_EPI) { if (wr == 0) PG8_BAR; }
        E(acc, cur, g.offC(cur), wr, wc, fr, fq, xl);
        if (!has_next) break;
#pragma unroll
        for (int a = 0; a < 2; ++a)
#pragma unroll
            for (int b = 0; b < 2; ++b)
#pragma unroll
                for (int m = 0; m < 4; ++m)
#pragma unroll
                    for (int n = 0; n < 2; ++n) acc[a][b][m][n] = (f32x4){0.f, 0.f, 0.f, 0.f};
        cur = nxt; cA = nA; cB = nB; ++ui;
        if constexpr (ALIGN_EPI) { if (wr == 1) PG8_BAR; }
    }
    PG8_WAIT_V(0);
    if constexpr (!ALIGN_EPI) { if (wr == 0) PG8_BAR; }
    PG8_BAR;
#undef PG8_SA
#undef PG8_SB
#undef PG8_STAGE
#undef PG8_LDA
#undef PG8_LDB
#undef PG8_MMA
#undef PG8_WAIT_V
#undef PG8_WAIT_L
#undef PG8_BAR
#undef PG8_SCHED
}
}

__device__ __forceinline__ f32x4 mfma16(bf16x8 bfrag, bf16x8 afrag, f32x4 acc) { return __builtin_amdgcn_mfma_f32_16x16x32_bf16(bfrag, afrag, acc, 0, 0, 0); }
__device__ __forceinline__ bf16x8 ldsfrag(const LAS bf16_t* base, int ld, int r0, int k0, int fr, int fq) { return *(const LAS bf16x8*)(base + (r0 + fr) * ld + k0 + fq * 8); }

template <int MODE> __device__ __forceinline__ void transpose_item(const float* W, int K, int N, bf16_t* WT, LAS float* scr, int item, int nblk, int lane, const float* gain = nullptr) {
    const int kb = item / nblk, nb = item % nblk, k0 = 64 * kb, n0 = 32 * nb; const int nsrc = n0 + (lane & 31);
    float wv_[32];
#pragma unroll
    for (int i = 0; i < 32; ++i) { const int kk = 2 * i + (lane >> 5); wv_[i] = (nsrc < N) ? W[(size_t)(k0 + kk) * N + nsrc] : 0.f; }
#pragma unroll
    for (int i = 0; i < 32; ++i) { const int kk = 2 * i + (lane >> 5); scr[kk * 33 + (lane & 31)] = wv_[i] * (gain ? gain[k0 + kk] : 1.f); }
    LDS_WAIT();
    const int c = lane & 7;
#pragma unroll
    for (int j = 0; j < 4; ++j) { const int n = (lane >> 3) + 8 * j; const LAS float* s = scr + (8 * c) * 33 + n;
        u32x4 o; o.x = pk2(s[0 * 33], s[1 * 33]); o.y = pk2(s[2 * 33], s[3 * 33]); o.z = pk2(s[4 * 33], s[5 * 33]); o.w = pk2(s[6 * 33], s[7 * 33]);
        int drow = n0 + n; if (MODE == 1) { const int jn = drow % FFN, isu = drow / FFN; drow = (jn / 128) * 256 + isu * 128 + (jn % 128); }
        *(u32x4*)(WT + (size_t)drow * K + k0 + 8 * c) = o; }
    LDS_WAIT();
}
__device__ __forceinline__ void rms_row_bf16(const float* xrow, const float* gain, bf16_t* orow, int lane) {
    const f32x4* xr = (const f32x4*)xrow + lane; f32x4 v[4]; float s = 0.f;
#pragma unroll
    for (int j = 0; j < 4; ++j) { v[j] = xr[64 * j]; s += (v[j].x * v[j].x + v[j].y * v[j].y) + (v[j].z * v[j].z + v[j].w * v[j].w); }
    const float rs = rsqrtf(wave_sum(s) * (1.f / D) + 1e-6f);
    const f32x4* gr = (const f32x4*)gain + lane; u32x2* o8 = (u32x2*)orow + lane;
#pragma unroll
    for (int j = 0; j < 4; ++j) { const f32x4 g = gr[64 * j]; u32x2 w; w.x = pk2(v[j].x * rs * g.x, v[j].y * rs * g.y); w.y = pk2(v[j].z * rs * g.z, v[j].w * rs * g.w); o8[64 * j] = w; }
}
__device__ __forceinline__ void rms_row2_bf16(const float* xa, const float* xb, const float* gain, bf16_t* oa, bf16_t* ob, int lane) {
    const f32x4* ra = (const f32x4*)xa + lane; const f32x4* rb = (const f32x4*)xb + lane; f32x4 va[4], vb[4]; float sa = 0.f, sb = 0.f;
#pragma unroll
    for (int j = 0; j < 4; ++j) { va[j] = ra[64 * j]; vb[j] = rb[64 * j]; }
#pragma unroll
    for (int j = 0; j < 4; ++j) { sa += (va[j].x * va[j].x + va[j].y * va[j].y) + (va[j].z * va[j].z + va[j].w * va[j].w); sb += (vb[j].x * vb[j].x + vb[j].y * vb[j].y) + (vb[j].z * vb[j].z + vb[j].w * vb[j].w); }
#pragma unroll
    for (int o = 1; o < 64; o <<= 1) { sa += __shfl_xor(sa, o); sb += __shfl_xor(sb, o); }
    const float rsa = rsqrtf(sa * (1.f / D) + 1e-6f), rsb = rsqrtf(sb * (1.f / D) + 1e-6f);
    const f32x4* gr = (const f32x4*)gain + lane; u32x2* pa = (u32x2*)oa + lane; u32x2* pb = (u32x2*)ob + lane;
#pragma unroll
    for (int j = 0; j < 4; ++j) { const f32x4 g = gr[64 * j]; u32x2 w;
        w.x = pk2(va[j].x * rsa * g.x, va[j].y * rsa * g.y); w.y = pk2(va[j].z * rsa * g.z, va[j].w * rsa * g.w); pa[64 * j] = w;
        w.x = pk2(vb[j].x * rsb * g.x, vb[j].y * rsb * g.y); w.y = pk2(vb[j].z * rsb * g.z, vb[j].w * rsb * g.w); pb[64 * j] = w; }
}
__device__ __forceinline__ void rms_rows_phase(const float* X, const float* gain, bf16_t* H, int nrows, int gw, int NGW, int lane) {
    int m = gw;
    for (; m + NGW < nrows; m += 2 * NGW) rms_row2_bf16(X + (size_t)m * D, X + (size_t)(m + NGW) * D, gain, H + (size_t)m * D, H + (size_t)(m + NGW) * D, lane);
    if (m < nrows) rms_row_bf16(X + (size_t)m * D, gain, H + (size_t)m * D, lane);
}

__device__ __forceinline__ void rwkv_chain(LAS unsigned char* lds, int cid, const bf16_t* P0, const float* mu, const float* w0, const float* w2, const float* a0, const float* a2,
                                           const float* k_k, const float* k_a, const float* r_k, bf16_t* ORW, bf16_t* SG, float* BONUS) {
    const int tid = threadIdx.x, lane = tid & 63, wid = tid >> 6, fr = lane & 15, fq = lane >> 4;
    const int b = cid >> 4, h = (cid >> 1) & 7, dir = cid & 1;
    LAS float* rS = (LAS float*)(lds); LAS float* kS = (LAS float*)(lds + 8192); LAS float* vS = (LAS float*)(lds + 16384); LAS float* wS = (LAS float*)(lds + 24576);
    LAS float* nkS = (LAS float*)(lds + 32768); LAS float* bS = (LAS float*)(lds + 40960); LAS float* preA = (LAS float*)(lds + 49152); LAS float* preW = (LAS float*)(lds + 57344);
    LAS bf16_t* adB = (LAS bf16_t*)(lds + 65536); LAS bf16_t* wdB = (LAS bf16_t*)(lds + 70144);
    LAS bf16_t* a2B = (LAS bf16_t*)(lds + 74752); LAS bf16_t* w2B = (LAS bf16_t*)(lds + 83968); LAS float* cst = (LAS float*)(lds + 93184);
    LAS bf16_t* At = (LAS bf16_t*)(lds + 97280); LAS bf16_t* Bt = (LAS bf16_t*)(lds + 101888); LAS bf16_t* Kt = (LAS bf16_t*)(lds + 106496); LAS bf16_t* Rt = (LAS bf16_t*)(lds + 111104);
    LAS bf16_t* BtT = (LAS bf16_t*)(lds + 115712); LAS bf16_t* KtT = (LAS bf16_t*)(lds + 120832); LAS bf16_t* VT = (LAS bf16_t*)(lds + 125952); LAS bf16_t* S0b = (LAS bf16_t*)(lds + 131072);
    LAS float* NT4 = (LAS float*)(lds + 140288); LAS bf16_t* NakT = (LAS bf16_t*)(lds + 146432); LAS bf16_t* MbrT = (LAS bf16_t*)(lds + 148992); LAS bf16_t* MkrT = (LAS bf16_t*)(lds + 151552);
    LAS float* gL = (LAS float*)(lds + 154112);
    LAS float* WS = preA;
    LAS bf16_t* Ub = (LAS bf16_t*)preW;
#define RW_IDS int tid_o = threadIdx.x; asm volatile("" : "+v"(tid_o)); const int tid = tid_o, lane = tid & 63, wid = __builtin_amdgcn_readfirstlane(tid >> 6), fr = lane & 15, fq = lane >> 4, vt = wid >> 1, tt2 = wid & 1; (void)lane; (void)wid; (void)fr; (void)fq; (void)vt; (void)tt2;
    __syncthreads();
    for (int e = tid; e < 64 * 64; e += 512) { const int j = e & 63, r = e >> 6;
        a2B[j * 72 + r] = (bf16_t)f2bf(a2[r * 512 + h * 64 + j]); w2B[j * 72 + r] = (bf16_t)f2bf(w2[(dir * 64 + r) * 512 + h * 64 + j]); }
    for (int e = tid; e < 64 * 72 / 2; e += 512) ((LAS unsigned*)S0b)[e] = 0u;
    if (tid < 64) { const int j = tid, c = h * 64 + j;
        cst[0 * 64 + j] = a0[c]; cst[1 * 64 + j] = w0[dir * 512 + c]; cst[2 * 64 + j] = k_k[c]; cst[3 * 64 + j] = k_a[c]; cst[4 * 64 + j] = r_k[c];
        cst[5 * 64 + j] = mu[c]; cst[6 * 64 + j] = mu[512 + c]; cst[7 * 64 + j] = mu[1024 + c]; cst[8 * 64 + j] = mu[1536 + j]; cst[9 * 64 + j] = mu[1600 + j];
        cst[10 * 64 + j] = (j < 16) ? mu[1664 + h * 16 + j] : 0.f; }
    const int vt = wid >> 1, tt2 = wid & 1;
    f32x4 st[2]; st[0] = (f32x4){0.f, 0.f, 0.f, 0.f}; st[1] = st[0];
    __syncthreads();
    const bf16_t* Pb = P0 + (size_t)b * SEQ * ABPAD;
    unsigned rc[10], rpv[10], rnx[10]; unsigned short gcv = 0, gpv = 0, gnv = 0;
#define RW_IDX(i) const int grp = (i) >> 1; const int idx_ = tid + 512 * ((i) & 1); const int tok = idx_ >> 5, c2 = (idx_ & 31) * 2; \
                  const int gcol = (grp == 0 ? h * 64 : grp == 1 ? 512 + h * 64 : grp == 2 ? 1024 + h * 64 : grp == 3 ? 1536 : 1600) + c2;
    const unsigned voff = (unsigned)((((int)threadIdx.x >> 5) * ABPAD + ((int)threadIdx.x & 31) * 2) * 2);
#define RW_CG(g) ((g) == 0 ? h * 128 : (g) == 1 ? 1024 + h * 128 : (g) == 2 ? 2048 + h * 128 : (g) == 3 ? 3072 : 3200)
#define RW_ISSUE(t0n) do { const char* bp_ = (const char*)(Pb + (size_t)(t0n) * ABPAD); const bool first_ = ((t0n) == 0) && (tid < 32), last_ = ((t0n) == SEQ - 32) && (tid >= 480); \
        _Pragma("unroll") for (int i = 0; i < 10; ++i) { const char* p = bp_ + (RW_CG(i >> 1) + (i & 1) * 16 * ABPAD * 2) + voff; \
            rc[i] = *(const unsigned*)p; \
            if ((i & 1) == 0) { const unsigned v_ = *(const unsigned*)(p - (first_ ? 0 : ABPAD * 2)); rpv[i] = first_ ? 0u : v_; rnx[i] = *(const unsigned*)(p + ABPAD * 2); } \
            else { const unsigned v_ = *(const unsigned*)(p + (last_ ? 0 : ABPAD * 2)); rnx[i] = last_ ? 0u : v_; rpv[i] = *(const unsigned*)(p - ABPAD * 2); } } \
        if (dir == 0) { const bool fg_ = ((t0n) == 0) && (tid < 16), lg_ = ((t0n) == SEQ - 32) && (tid >= 496); \
            const bf16_t* p = (const bf16_t*)bp_ + (size_t)(tid >> 4) * ABPAD + 1664 + h * 16 + (tid & 15); \
            gcv = *p; { const unsigned short v_ = *(p - (fg_ ? 0 : ABPAD)); gpv = fg_ ? (unsigned short)0 : v_; } { const unsigned short v_ = *(p + (lg_ ? 0 : ABPAD)); gnv = lg_ ? (unsigned short)0 : v_; } } } while (0)
    RW_ISSUE(dir ? 127 * 32 : 0);
    for (int cc = 0; cc < 128; ++cc) {
        const int t0 = dir ? (127 - cc) * 32 : cc * 32;
        { RW_IDS
#pragma unroll
        for (int i = 0; i < 10; ++i) { RW_IDX(i) (void)gcol;
            const unsigned cur = rc[i], prv = rpv[i], nxt = rnx[i];
            const float m0 = cst[(5 + grp) * 64 + c2], m1 = cst[(5 + grp) * 64 + c2 + 1];
            const float c0 = bflo(cur), c1 = bfhi(cur);
            const float x0 = c0 + m0 * (0.5f * (bflo(prv) + bflo(nxt)) - c0), x1 = c1 + m1 * (0.5f * (bfhi(prv) + bfhi(nxt)) - c1);
            if (grp == 0) { *(LAS f32x2*)(rS + tok * 64 + c2) = (f32x2){x0, x1}; }
            else if (grp == 1) { *(LAS f32x2*)(kS + tok * 64 + c2) = (f32x2){x0, x1}; }
            else if (grp == 2) { *(LAS f32x2*)(vS + tok * 64 + c2) = (f32x2){x0, x1}; }
            else if (grp == 3) { const float e0 = __expf(2.f * x0), e1 = __expf(2.f * x1); *(LAS unsigned*)(wdB + tok * 72 + c2) = pk2(1.f - 2.f * frcp(e0 + 1.f), 1.f - 2.f * frcp(e1 + 1.f)); }
            else { *(LAS unsigned*)(adB + tok * 72 + c2) = pk2(x0, x1); }
        }
        if (dir == 0) {
            const int tok = tid >> 4, c = tid & 15, t = t0 + tok;
            const float cur = bf2f(gcv), prv = bf2f(gpv), nxt = bf2f(gnv);
            const float x = cur + cst[10 * 64 + c] * (0.5f * (prv + nxt) - cur);
            SG[((size_t)b * SEQ + t) * 128 + h * 16 + c] = (bf16_t)f2bf(sigmoidf_(x));
        } }
        __syncthreads();
        if (cc + 1 < 128) { RW_IDS const int t0n = dir ? (126 - cc) * 32 : (cc + 1) * 32; RW_ISSUE(t0n); }
        { RW_IDS const int mat = wid >> 2, ntile = wid & 3; const LAS bf16_t* Aop = mat ? wdB : adB; const LAS bf16_t* Bop = mat ? w2B : a2B; LAS float* pre = mat ? preW : preA;
#pragma unroll
          for (int mt = 0; mt < 2; ++mt) { f32x4 acc = (f32x4){0.f, 0.f, 0.f, 0.f};
#pragma unroll
              for (int ks = 0; ks < 2; ++ks) acc = mfma16(ldsfrag(Bop, 72, ntile * 16, ks * 32, fr, fq), ldsfrag(Aop, 72, mt * 16, ks * 32, fr, fq), acc);
              *(LAS f32x4*)(pre + (mt * 16 + fr) * 64 + ntile * 16 + fq * 4) = acc; } }
        __syncthreads();
        { RW_IDS const int tok = tid >> 4, c0 = (tid & 15) * 4; float kkr[4], av[4], kp[4], wv[4]; float ss = 0.f, bon = 0.f;
#pragma unroll
          for (int i = 0; i < 4; ++i) { const int c = c0 + i, ix = tok * 64 + c;
              const float a = sigmoidf_(cst[c] + preA[ix]); const float sg = sigmoidf_(cst[64 + c] + preW[ix]);
              wv[i] = -0.60653065971f * sg;
              const float kraw = kS[ix]; kkr[i] = kraw * cst[128 + c]; ss += kkr[i] * kkr[i];
              kp[i] = kraw * (1.0f + (a - 1.0f) * cst[192 + c]); av[i] = a; bon += rS[ix] * kp[i] * cst[256 + c]; }
          ss += dppf<0xB1>(ss); bon += dppf<0xB1>(bon); ss += dppf<0x4E>(ss); bon += dppf<0x4E>(bon);
          ss += dppf<0x141>(ss); bon += dppf<0x141>(bon); ss += dppf<0x140>(ss); bon += dppf<0x140>(bon);
          const float inv = frcp(fmaxf(__builtin_amdgcn_sqrtf(ss), 1e-12f));
          f32x4 o_nk, o_b, o_k, o_w;
#pragma unroll
          for (int i = 0; i < 4; ++i) { const float kk = kkr[i] * inv; o_nk[i] = -kk; o_b[i] = kk * av[i]; o_k[i] = kp[i]; o_w[i] = wv[i]; }
          *(LAS f32x4*)(nkS + tok * 64 + c0) = o_nk; *(LAS f32x4*)(bS + tok * 64 + c0) = o_b; *(LAS f32x4*)(kS + tok * 64 + c0) = o_k; *(LAS f32x4*)(wS + tok * 64 + c0) = o_w;
          if (dir == 0 && (tid & 15) == 0) BONUS[((size_t)b * SEQ + t0 + tok) * 8 + h] = bon; }
        __syncthreads();
        { RW_IDS if (tid < 64) { float lw[32];
#pragma unroll
            for (int s = 0; s < 32; ++s) lw[s] = wS[(dir ? 31 - s : s) * 64 + tid];
#pragma unroll
            for (int s = 1; s < 32; ++s) lw[s] += lw[s - 1];
#pragma unroll
            for (int s = 0; s < 32; ++s) wS[(dir ? 31 - s : s) * 64 + tid] = lw[s]; } }
        __syncthreads();
        { RW_IDS const int s = tid >> 4, c0 = (tid & 15) * 4; const int tok = dir ? 31 - s : s, tokp = dir ? tok + 1 : tok - 1;
          const f32x4 cum = *(const LAS f32x4*)(wS + tok * 64 + c0); f32x4 cump = (f32x4){0.f, 0.f, 0.f, 0.f}; if (s > 0) cump = *(const LAS f32x4*)(wS + tokp * 64 + c0);
          const f32x4 nk4 = *(const LAS f32x4*)(nkS + tok * 64 + c0), b4 = *(const LAS f32x4*)(bS + tok * 64 + c0), k4 = *(const LAS f32x4*)(kS + tok * 64 + c0), r4 = *(const LAS f32x4*)(rS + tok * 64 + c0), v4 = *(const LAS f32x4*)(vS + tok * 64 + c0);
          float ta[4], tb[4], tk[4], tr[4];
#pragma unroll
          for (int i = 0; i < 4; ++i) { const float g = __expf(cum[i]), gp = __expf(cump[i]), ig = __expf(-cum[i]);
              ta[i] = nk4[i] * gp; tb[i] = b4[i] * ig; tk[i] = k4[i] * ig; tr[i] = r4[i] * g;
              BtT[(c0 + i) * 40 + s] = (bf16_t)f2bf(tb[i]); KtT[(c0 + i) * 40 + s] = (bf16_t)f2bf(tk[i]); VT[(c0 + i) * 40 + s] = (bf16_t)f2bf(v4[i]);
              if (s == 31) gL[c0 + i] = g; }
          u32x2 w; w.x = pk2(ta[0], ta[1]); w.y = pk2(ta[2], ta[3]); *(LAS u32x2*)(At + s * 72 + c0) = w;
          w.x = pk2(tb[0], tb[1]); w.y = pk2(tb[2], tb[3]); *(LAS u32x2*)(Bt + s * 72 + c0) = w;
          w.x = pk2(tk[0], tk[1]); w.y = pk2(tk[2], tk[3]); *(LAS u32x2*)(Kt + s * 72 + c0) = w;
          w.x = pk2(tr[0], tr[1]); w.y = pk2(tr[2], tr[3]); *(LAS u32x2*)(Rt + s * 72 + c0) = w; }
        __syncthreads();
        { RW_IDS const int mat = wid >> 1, mt = wid & 1; const LAS bf16_t* Aop = (mat < 2) ? At : Rt; const LAS bf16_t* Bop = (mat & 1) ? Kt : Bt;
#pragma unroll
          for (int nt = 0; nt < 2; ++nt) { f32x4 acc = (f32x4){0.f, 0.f, 0.f, 0.f};
#pragma unroll
              for (int ks = 0; ks < 2; ++ks) acc = mfma16(ldsfrag(Bop, 72, nt * 16, ks * 32, fr, fq), ldsfrag(Aop, 72, mt * 16, ks * 32, fr, fq), acc);
              const int srow = mt * 16 + fr;
#pragma unroll
              for (int e = 0; e < 4; ++e) { const int i = nt * 16 + fq * 4 + e; const bool keep = (mat < 2) ? (i < srow) : (i <= srow); if (!keep) acc[e] = 0.f; }
              if (mat == 0) {
#pragma unroll
                  for (int e = 0; e < 4; ++e) NT4[e * 384 + srow * 12 + nt * 4 + fq] = acc[e]; }
              else { LAS bf16_t* X = (mat == 1) ? NakT : (mat == 2) ? MbrT : MkrT; u32x2 o; o.x = pk2(acc[0], acc[1]); o.y = pk2(acc[2], acc[3]); *(LAS u32x2*)(X + srow * 40 + nt * 16 + fq * 4) = o; } } }
        __syncthreads();
        f32x4 oacc = (f32x4){0.f, 0.f, 0.f, 0.f};
        { RW_IDS f32x4 wacc = (f32x4){0.f, 0.f, 0.f, 0.f};
#pragma unroll
          for (int ks = 0; ks < 2; ++ks) { const bf16x8 sf = ldsfrag(S0b, 72, vt * 16, ks * 32, fr, fq);
              wacc = mfma16(ldsfrag(At, 72, tt2 * 16, ks * 32, fr, fq), sf, wacc); oacc = mfma16(ldsfrag(Rt, 72, tt2 * 16, ks * 32, fr, fq), sf, oacc); }
          const bf16x8 vf = ldsfrag(VT, 40, vt * 16, 0, fr, fq);
          wacc = mfma16(ldsfrag(NakT, 40, tt2 * 16, 0, fr, fq), vf, wacc); oacc = mfma16(ldsfrag(MkrT, 40, tt2 * 16, 0, fr, fq), vf, oacc);
#pragma unroll
          for (int n2 = 0; n2 < 2; ++n2) st[n2] = mfma16(ldsfrag(KtT, 40, (tt2 * 2 + n2) * 16, 0, fr, fq), vf, st[n2]);
#pragma unroll
          for (int e = 0; e < 4; ++e) WS[(tt2 * 16 + fq * 4 + e) * 64 + vt * 16 + fr] = wacc[e]; }
        __syncthreads();
        { RW_IDS if (wid < 4) { const int v = wid * 16 + (lane >> 2), p = lane & 3; const LAS float* NTp = NT4 + p * 384; float u[8];
#pragma unroll
            for (int j = 0; j < 8; ++j) u[j] = 0.f;
#pragma unroll
            for (int t = 0; t < 32; ++t) { float q0 = (p == 0) ? WS[t * 64 + v] : 0.f, q1 = 0.f;
#pragma unroll
                for (int j4 = 0; j4 < ((t + 3) / 4 + 3) / 4; ++j4) { const f32x4 nv = *(const LAS f32x4*)(NTp + t * 12 + j4 * 4);
                    q0 += u[j4 * 4] * nv[0]; q1 += u[j4 * 4 + 1] * nv[1]; q0 += u[j4 * 4 + 2] * nv[2]; q1 += u[j4 * 4 + 3] * nv[3]; }
                float q = q0 + q1; q += dppf<0xB1>(q); q += dppf<0x4E>(q);
                u[t >> 2] = ((t & 3) == p) ? q : u[t >> 2]; asm volatile("" ::: "memory"); }
#pragma unroll
            for (int j = 0; j < 8; ++j) Ub[v * 40 + 4 * j + p] = (bf16_t)f2bf(u[j]); } }
        __syncthreads();
        { RW_IDS const bf16x8 uf = ldsfrag(Ub, 40, vt * 16, 0, fr, fq);
          oacc = mfma16(ldsfrag(MbrT, 40, tt2 * 16, 0, fr, fq), uf, oacc);
#pragma unroll
          for (int e = 0; e < 4; ++e) { const int sidx = tt2 * 16 + fq * 4 + e, tok = dir ? 31 - sidx : sidx;
              ORW[(size_t)dir * T * 512 + ((size_t)b * SEQ + t0 + tok) * 512 + h * 64 + vt * 16 + fr] = (bf16_t)f2bf(oacc[e]); }
#pragma unroll
          for (int n2 = 0; n2 < 2; ++n2) { const int kt = tt2 * 2 + n2; st[n2] = mfma16(ldsfrag(BtT, 40, kt * 16, 0, fr, fq), uf, st[n2]);
              const f32x4 gl = *(const LAS f32x4*)(gL + kt * 16 + fq * 4); st[n2] = st[n2] * gl;
              u32x2 o; o.x = pk2(st[n2][0], st[n2][1]); o.y = pk2(st[n2][2], st[n2][3]); *(LAS u32x2*)(S0b + (vt * 16 + fr) * 72 + kt * 16 + fq * 4) = o; } }
    }
#undef RW_IDX
#undef RW_ISSUE
#undef RW_IDS
#undef RW_CG
    __syncthreads();
}

__device__ __forceinline__ void rwkv_combine(const bf16_t* P0, const bf16_t* ORW, const float* BONUS, const bf16_t* G, const float* mu, const float* gn_w, const float* gn_b, bf16_t* OMIX, int gw, int NGW, int lane) {
    const int c0 = lane * 8, head = lane >> 3;
    float muv[8], gw8[8], gb8[8];
#pragma unroll
    for (int i = 0; i < 8; ++i) { muv[i] = mu[1024 + c0 + i]; gw8[i] = gn_w[c0 + i]; gb8[i] = gn_b[c0 + i]; }
    for (int tk0 = gw; tk0 < T; tk0 += 2 * NGW) {
        u32x4 uf[2], ub[2], vc[2], vp[2], vn[2], gg[2]; float bon[2];
#pragma unroll
        for (int r2 = 0; r2 < 2; ++r2) { const int tk = tk0 + r2 * NGW; if (tk < T) { const int t = tk & (SEQ - 1);
            uf[r2] = *(const u32x4*)(ORW + (size_t)tk * 512 + c0); ub[r2] = *(const u32x4*)(ORW + (size_t)T * 512 + (size_t)tk * 512 + c0);
            const bf16_t* pv = P0 + (size_t)tk * ABPAD + 1024 + c0;
            vc[r2] = *(const u32x4*)pv; vp[r2] = (u32x4){0u, 0u, 0u, 0u}; vn[r2] = (u32x4){0u, 0u, 0u, 0u};
            if (t > 0) vp[r2] = *(const u32x4*)(pv - ABPAD);
            if (t < SEQ - 1) vn[r2] = *(const u32x4*)(pv + ABPAD);
            gg[r2] = *(const u32x4*)(G + (size_t)tk * 512 + c0); bon[r2] = BONUS[(size_t)tk * 8 + head]; } }
#pragma unroll
        for (int r2 = 0; r2 < 2; ++r2) { const int tk = tk0 + r2 * NGW; if (tk < T) {
            float o[8];
#pragma unroll
            for (int i = 0; i < 4; ++i) { o[2 * i] = bflo(uf[r2][i]) + bflo(ub[r2][i]); o[2 * i + 1] = bfhi(uf[r2][i]) + bfhi(ub[r2][i]); }
            float s_ = 0.f;
#pragma unroll
            for (int i = 0; i < 8; ++i) s_ += o[i];
            const float mean = sum8(s_) * (1.f / 64.f); float q = 0.f;
#pragma unroll
            for (int i = 0; i < 8; ++i) { o[i] -= mean; q += o[i] * o[i]; }
            const float rstd = rsqrtf(sum8(q) * (1.f / 64.f) + 64e-5f);
            float r[8];
#pragma unroll
            for (int i = 0; i < 4; ++i) {
                const float c_lo = bflo(vc[r2][i]), c_hi = bfhi(vc[r2][i]);
                const float v_lo = c_lo + muv[2 * i] * (0.5f * (bflo(vp[r2][i]) + bflo(vn[r2][i])) - c_lo), v_hi = c_hi + muv[2 * i + 1] * (0.5f * (bfhi(vp[r2][i]) + bfhi(vn[r2][i])) - c_hi);
                r[2 * i] = (o[2 * i] * rstd * gw8[2 * i] + gb8[2 * i] + bon[r2] * v_lo) * bflo(gg[r2][i]);
                r[2 * i + 1] = (o[2 * i + 1] * rstd * gw8[2 * i + 1] + gb8[2 * i + 1] + bon[r2] * v_hi) * bfhi(gg[r2][i]); }
            u32x4 w; w.x = pk2(r[0], r[1]); w.y = pk2(r[2], r[3]); w.z = pk2(r[4], r[5]); w.w = pk2(r[6], r[7]);
            *(u32x4*)(OMIX + (size_t)tk * D + c0) = w; } }
    }
}

constexpr int SLD = 136;
__device__ __forceinline__ float softplusf_(float x) { return x > 20.f ? x : log1pf(__expf(x)); }
__device__ __forceinline__ void ssd_dt_cum(LAS float* dtS, LAS float* cumS, LAS float* totS, const bf16_t* Prow0, int g, int w, int lane, const float* dt_bias, const float* a_log) {
    const int j = w >> 1, d = w & 1, head = g * 4 + j;
    const float bias = dt_bias[d * 8 + head], A = -__expf(a_log[d * 8 + head]);
    const float x0 = bf2f(Prow0[(size_t)(2 * lane) * ABPAD + 3328 + head]), x1 = bf2f(Prow0[(size_t)(2 * lane + 1) * ABPAD + 3328 + head]);
    const float dt0 = softplusf_(x0 + bias), dt1 = softplusf_(x1 + bias), la0 = dt0 * A, la1 = dt1 * A;
    const float s = la0 + la1; float inc = s;
#pragma unroll
    for (int off = 1; off < 64; off <<= 1) { const float n = __shfl_up(inc, off); if (lane >= off) inc += n; }
    const float tot = __shfl(inc, 63), exc = inc - s;
    float c0, c1; if (d == 0) { c0 = exc + la0; c1 = inc; } else { c0 = tot - exc; c1 = tot - exc - la0; }
    dtS[w * 128 + 2 * lane] = dt0; dtS[w * 128 + 2 * lane + 1] = dt1; cumS[w * 128 + 2 * lane] = c0; cumS[w * 128 + 2 * lane + 1] = c1;
    if (lane == 0) totS[w] = tot;
}
template <int NR, bool TR> __device__ __forceinline__ void ssd_conv8(LAS bf16_t* dst, int col0, int cx0, int l0, const bf16_t* Pb, int t0, const float* cw, const float* cb) {
    u32x4 raw[NR + 2];
    const bf16_t* p = Pb + (size_t)(t0 + l0) * ABPAD + 2304 + cx0;
#pragma unroll
    for (int i = 0; i < NR + 2; ++i) { const int t = t0 + l0 + i - 1; raw[i] = (t >= 0 && t < SEQ) ? *(const u32x4*)(p + (long)(i - 1) * ABPAD) : (u32x4){0u, 0u, 0u, 0u}; }
    float w0[8], w1[8], w2[8], bs[8];
#pragma unroll
    for (int q = 0; q < 2; ++q) { const f32x4 a = *(const f32x4*)(cw + cx0 + 4 * q), bq = *(const f32x4*)(cw + 1024 + cx0 + 4 * q), c = *(const f32x4*)(cw + 2048 + cx0 + 4 * q), d = *(const f32x4*)(cb + cx0 + 4 * q);
#pragma unroll
        for (int i = 0; i < 4; ++i) { w0[4 * q + i] = a[i]; w1[4 * q + i] = bq[i]; w2[4 * q + i] = c[i]; bs[4 * q + i] = d[i]; } }
    float o[NR][8];
#pragma unroll
    for (int i = 0; i < NR; ++i)
#pragma unroll
        for (int c = 0; c < 8; ++c) { const unsigned um = raw[i][c >> 1], u0 = raw[i + 1][c >> 1], up = raw[i + 2][c >> 1];
            const float fm = (c & 1) ? bfhi(um) : bflo(um), f0 = (c & 1) ? bfhi(u0) : bflo(u0), fp = (c & 1) ? bfhi(up) : bflo(up);
            o[i][c] = siluf_(w0[c] * fm + w1[c] * f0 + w2[c] * fp + bs[c]); }
    if (TR) {
#pragma unroll
        for (int c = 0; c < 8; ++c) { LAS bf16_t* q = dst + (col0 + c) * SLD + l0;
            if (NR == 8) { u32x4 w; w.x = pk2(o[0][c], o[1][c]); w.y = pk2(o[2][c], o[3][c]); w.z = pk2(o[4 % NR][c], o[5 % NR][c]); w.w = pk2(o[6 % NR][c], o[7 % NR][c]); *(LAS u32x4*)q = w; }
            else { u32x2 w; w.x = pk2(o[0][c], o[1][c]); w.y = pk2(o[2][c], o[3][c]); *(LAS u32x2*)q = w; } }
    } else {
#pragma unroll
        for (int i = 0; i < NR; ++i) { u32x4 w; w.x = pk2(o[i][0], o[i][1]); w.y = pk2(o[i][2], o[i][3]); w.z = pk2(o[i][4], o[i][5]); w.w = pk2(o[i][6], o[i][7]); *(LAS u32x4*)(dst + (l0 + i) * SLD + col0) = w; }
    }
}
__device__ __forceinline__ void ssd_s1_unit(LAS unsigned char* lds, int unit, const bf16_t* P0, const float* cw, const float* cb, const float* dt_bias, const float* a_log, bf16_t* STATES, float* TOT) {
    const int tid = threadIdx.x, lane = tid & 63, w = tid >> 6, fr = lane & 15, fq = lane >> 4;
    const int g = unit & 1, c = (unit >> 1) & 31, b = unit >> 6, t0 = c * 128;
    LAS bf16_t* BT = (LAS bf16_t*)lds; LAS bf16_t* XT = (LAS bf16_t*)(lds + 34816); LAS float* dtS = (LAS float*)(lds + 104448); LAS float* cumS = (LAS float*)(lds + 108544);
    LAS float* scS = (LAS float*)(lds + 112640); LAS float* totS = (LAS float*)(lds + 116736);
    const bf16_t* Pb = P0 + (size_t)b * SEQ * ABPAD;
    __syncthreads();
    ssd_conv8<4, true>(BT, (tid & 15) * 8, 512 + g * 128 + (tid & 15) * 8, (tid >> 4) * 4, Pb, t0, cw, cb);
    ssd_conv8<8, true>(XT, (tid & 31) * 8, g * 256 + (tid & 31) * 8, (tid >> 5) * 8, Pb, t0, cw, cb);
    ssd_dt_cum(dtS, cumS, totS, Pb + (size_t)t0 * ABPAD, g, w, lane, dt_bias, a_log);
    __syncthreads();
    for (int e = tid; e < 1024; e += 512) scS[e] = dtS[e] * __expf(totS[e >> 7] - cumS[e]);
    if (tid < 8) TOT[((size_t)(b * 32 + c) * 2 + (tid & 1)) * 8 + g * 4 + (tid >> 1)] = totS[tid];
    __syncthreads();
    const int j = w >> 1;
#pragma unroll 1
    for (int d = 0; d < 2; ++d) {
        f32x4 acc[2][8];
#pragma unroll
        for (int mt = 0; mt < 2; ++mt)
#pragma unroll
            for (int nt = 0; nt < 8; ++nt) acc[mt][nt] = (f32x4){0.f, 0.f, 0.f, 0.f};
#pragma unroll 1
        for (int ks = 0; ks < 4; ++ks) {
            const int k0 = ks * 32; const LAS float* sp = scS + (j * 2 + d) * 128 + k0 + fq * 8;
            const f32x4 s0 = *(const LAS f32x4*)sp, s1 = *(const LAS f32x4*)(sp + 4);
            bf16x8 afr[2];
#pragma unroll
            for (int mt = 0; mt < 2; ++mt) { const u32x4 raw = *(const LAS u32x4*)(XT + (32 * w + mt * 16 + fr) * SLD + k0 + fq * 8); u32x4 o;
                o.x = pk2(bflo(raw.x) * s0[0], bfhi(raw.x) * s0[1]); o.y = pk2(bflo(raw.y) * s0[2], bfhi(raw.y) * s0[3]);
                o.z = pk2(bflo(raw.z) * s1[0], bfhi(raw.z) * s1[1]); o.w = pk2(bflo(raw.w) * s1[2], bfhi(raw.w) * s1[3]);
                afr[mt] = __builtin_bit_cast(bf16x8, o); }
#pragma unroll
            for (int nt = 0; nt < 8; ++nt) { const bf16x8 bfr = ldsfrag(BT, SLD, nt * 16, k0, fr, fq);
#pragma unroll
                for (int mt = 0; mt < 2; ++mt) acc[mt][nt] = mfma16(bfr, afr[mt], acc[mt][nt]); }
        }
        bf16_t* dst = STATES + (((size_t)(b * 32 + c) * 2 + d) * 8 + g * 4 + j) * 8192;
#pragma unroll
        for (int mt = 0; mt < 2; ++mt) { const int p = (w & 1) * 32 + mt * 16 + fr;
#pragma unroll
            for (int nt = 0; nt < 8; ++nt) { u32x2 o; o.x = pk2(acc[mt][nt][0], acc[mt][nt][1]); o.y = pk2(acc[mt][nt][2], acc[mt][nt][3]);
                *(u32x2*)(dst + p * 128 + nt * 16 + fq * 4) = o; } }
    }
}
__device__ __forceinline__ void ssd_s2(const bf16_t* __restrict__ STATES, bf16_t* __restrict__ CARR, const float* __restrict__ TOT, int gtid, int NGT) {
    for (int it = gtid; it < 16 * 2 * 8 * 1024; it += NGT) {
        const int e8 = it & 1023, head = (it >> 10) & 7, d = (it >> 13) & 1, b = it >> 14;
        float run[8];
#pragma unroll
        for (int i = 0; i < 8; ++i) run[i] = 0.f;
#pragma unroll 1
        for (int c8 = 0; c8 < 32; c8 += 8) {
            u32x4 loc[8]; float dec[8];
#pragma unroll
            for (int q = 0; q < 8; ++q) { const int cc = c8 + q, c = d ? 31 - cc : cc; const size_t sidx = ((size_t)(b * 32 + c) * 2 + d) * 8 + head;
                loc[q] = *(const u32x4*)(STATES + sidx * 8192 + e8 * 8); dec[q] = TOT[sidx]; }
#pragma unroll
            for (int q = 0; q < 8; ++q) { const int cc = c8 + q, c = d ? 31 - cc : cc; const size_t sidx = ((size_t)(b * 32 + c) * 2 + d) * 8 + head;
                u32x4 o; o.x = pk2(run[0], run[1]); o.y = pk2(run[2], run[3]); o.z = pk2(run[4], run[5]); o.w = pk2(run[6], run[7]); *(u32x4*)(CARR + sidx * 8192 + e8 * 8) = o;
                const float dq = __expf(dec[q]);
#pragma unroll
                for (int i = 0; i < 4; ++i) { run[2 * i] = run[2 * i] * dq + bflo(loc[q][i]); run[2 * i + 1] = run[2 * i + 1] * dq + bfhi(loc[q][i]); } }
        }
    }
}
__device__ __forceinline__ void ssd_s3_unit(LAS unsigned char* lds, int unit, const bf16_t* P0, const float* cw, const float* cb, const float* dt_bias, const float* a_log, const float* dskip, const float* norm_w,
                                            const bf16_t* STATES, bf16_t* OMIX) {
    const int tid = threadIdx.x, lane = tid & 63, w = tid >> 6, fr = lane & 15, fq = lane >> 4;
    const int g = unit & 1, c = (unit >> 1) & 31, b = unit >> 6, t0 = c * 128;
    LAS bf16_t* CS = (LAS bf16_t*)lds; LAS bf16_t* BS = (LAS bf16_t*)(lds + 34816); LAS bf16_t* XT = (LAS bf16_t*)(lds + 69632);
    LAS float* dtS = (LAS float*)(lds + 139264); LAS float* cumS = (LAS float*)(lds + 143360); LAS float* totS = (LAS float*)(lds + 147456);
    const bf16_t* Pb = P0 + (size_t)b * SEQ * ABPAD;
    __syncthreads();
    ssd_conv8<4, false>(BS, (tid & 15) * 8, 512 + g * 128 + (tid & 15) * 8, (tid >> 4) * 4, Pb, t0, cw, cb);
    ssd_conv8<4, false>(CS, (tid & 15) * 8, 768 + g * 128 + (tid & 15) * 8, (tid >> 4) * 4, Pb, t0, cw, cb);
    ssd_conv8<8, true>(XT, (tid & 31) * 8, g * 256 + (tid & 31) * 8, (tid >> 5) * 8, Pb, t0, cw, cb);
    ssd_dt_cum(dtS, cumS, totS, Pb + (size_t)t0 * ABPAD, g, w, lane, dt_bias, a_log);
    __syncthreads();
    const int l = 16 * w + fr;
    f32x4 sc[8];
#pragma unroll
    for (int nt = 0; nt < 8; ++nt) sc[nt] = (f32x4){0.f, 0.f, 0.f, 0.f};
#pragma unroll
    for (int ks = 0; ks < 4; ++ks) { const bf16x8 afr = ldsfrag(CS, SLD, 16 * w, ks * 32, fr, fq);
#pragma unroll
        for (int nt = 0; nt < 8; ++nt) sc[nt] = mfma16(ldsfrag(BS, SLD, nt * 16, ks * 32, fr, fq), afr, sc[nt]); }
    __syncthreads();
    LAS bf16_t* Mw = BS + w * 16 * SLD;
    const size_t row = (size_t)b * SEQ + t0 + l; float ss = 0.f;
#pragma unroll 1
    for (int j = 0; j < 4; ++j) {
        const LAS float* cf = cumS + (j * 2) * 128; const LAS float* cbw = cumS + (j * 2 + 1) * 128; const LAS float* df = dtS + (j * 2) * 128; const LAS float* db = dtS + (j * 2 + 1) * 128;
        const float cfl = cf[l], cbl = cbw[l];
        const size_t sbase = ((size_t)(b * 32 + c) * 2) * 8 + g * 4 + j;
        const bf16_t* carf = STATES + sbase * 8192; const bf16_t* carb = STATES + (sbase + 8) * 8192;
        bf16x8 cF[4][4], cB[4][4]; u32x2 zz4[4];
#pragma unroll
        for (int ks = 0; ks < 4; ++ks)
#pragma unroll
            for (int pt = 0; pt < 4; ++pt) cF[ks][pt] = *(const bf16x8*)(carf + (pt * 16 + fr) * 128 + ks * 32 + fq * 8);
#pragma unroll
        for (int pt = 0; pt < 4; ++pt) zz4[pt] = *(const u32x2*)(P0 + row * ABPAD + 1792 + g * 256 + j * 64 + pt * 16 + fq * 4);
#pragma unroll
        for (int nt = 0; nt < 8; ++nt) { float mv[4];
#pragma unroll
            for (int i = 0; i < 4; ++i) { const int s = nt * 16 + fq * 4 + i;
                const float ff = (s <= l) ? __expf(cfl - cf[s]) * df[s] : 0.f; const float fb = (s >= l) ? __expf(cbl - cbw[s]) * db[s] : 0.f;
                mv[i] = sc[nt][i] * (ff + fb); }
            u32x2 o; o.x = pk2(mv[0], mv[1]); o.y = pk2(mv[2], mv[3]); *(LAS u32x2*)(Mw + fr * SLD + nt * 16 + fq * 4) = o; }
        LDS_WAIT();
#pragma unroll
        for (int ks = 0; ks < 4; ++ks)
#pragma unroll
            for (int pt = 0; pt < 4; ++pt) cB[ks][pt] = *(const bf16x8*)(carb + (pt * 16 + fr) * 128 + ks * 32 + fq * 8);
        f32x4 yd[4], yf[4], yb[4];
#pragma unroll
        for (int pt = 0; pt < 4; ++pt) { yd[pt] = (f32x4){0.f, 0.f, 0.f, 0.f}; yf[pt] = yd[pt]; yb[pt] = yd[pt]; }
        bf16x8 acs[4];
#pragma unroll
        for (int ks = 0; ks < 4; ++ks) {
            const bf16x8 am = *(const LAS bf16x8*)(Mw + fr * SLD + ks * 32 + fq * 8); acs[ks] = ldsfrag(CS, SLD, 16 * w, ks * 32, fr, fq);
#pragma unroll
            for (int pt = 0; pt < 4; ++pt) {
                yd[pt] = mfma16(ldsfrag(XT, SLD, j * 64 + pt * 16, ks * 32, fr, fq), am, yd[pt]);
                yf[pt] = mfma16(cF[ks][pt], acs[ks], yf[pt]); }
        }
#pragma unroll
        for (int ks = 0; ks < 4; ++ks)
#pragma unroll
            for (int pt = 0; pt < 4; ++pt) yb[pt] = mfma16(cB[ks][pt], acs[ks], yb[pt]);
        const float ef = __expf(cfl), eb = __expf(cbl), dsk = dskip[g * 4 + j];
#pragma unroll
        for (int pt = 0; pt < 4; ++pt) { const f32x4 yv = yd[pt] + yf[pt] * ef + yb[pt] * eb;
            const int col = j * 64 + pt * 16 + fq * 4; const u32x2 zz = zz4[pt];
            const float z4[4] = {bflo(zz.x), bfhi(zz.x), bflo(zz.y), bfhi(zz.y)}; float v4[4];
#pragma unroll
            for (int i = 0; i < 4; ++i) { const float xs = bf2f(XT[(col + i) * SLD + l]); float v = yv[i] + dsk * xs; const float z = z4[i]; v = v * siluf_(z);
                v4[i] = v; ss += v * v; }
            u32x2 o; o.x = pk2(v4[0], v4[1]); o.y = pk2(v4[2], v4[3]); *(u32x2*)(OMIX + row * D + 512 + g * 256 + col) = o; }
        asm volatile("" ::: "memory");
    }
    ss += __shfl_xor(ss, 16); ss += __shfl_xor(ss, 32);
    const float rs = rsqrtf(ss * (1.f / 256.f) + 1e-6f);
    asm volatile("s_waitcnt vmcnt(0)" ::: "memory");
#pragma unroll 4
    for (int q = 0; q < 16; ++q) { const int col = g * 256 + q * 16 + fq * 4; const f32x4 nw = *(const f32x4*)(norm_w + col);
        u32x2* p = (u32x2*)(OMIX + row * D + 512 + col); const u32x2 v = *p;
        u32x2 o; o.x = pk2(bflo(v.x) * rs * nw[0], bfhi(v.x) * rs * nw[1]); o.y = pk2(bflo(v.y) * rs * nw[2], bfhi(v.y) * rs * nw[3]); *p = o; }
}

constexpr int HLD = 136, HLS = 72;
__device__ __forceinline__ void hgrn_chain(LAS unsigned char* lds, int cid, bf16_t* P1, const float* hg_lb, bf16_t* Ob, int ldo, int ocbase, int ocdir) {
    const int tid = threadIdx.x, lane = tid & 63, w = tid >> 6, fr = lane & 15, fq = lane >> 4;
    const int b = cid >> 4, h = (cid >> 1) & 7, dir = cid & 1;
    LAS bf16_t* QE = (LAS bf16_t*)lds;
    LAS bf16_t* KE = (LAS bf16_t*)(lds + 17408);
    LAS bf16_t* KLT = (LAS bf16_t*)(lds + 34816);
    LAS bf16_t* VT = (LAS bf16_t*)(lds + 53248);
    LAS bf16_t* AT = (LAS bf16_t*)(lds + 71680);
    LAS bf16_t* ST = (LAS bf16_t*)(lds + 80896);
    LAS float* totS = (LAS float*)(lds + 115712);
    LAS float* lastS = (LAS float*)(lds + 117760);
    __syncthreads();
    for (int e = tid; e < 128 * HLD / 2; e += 512) ((LAS unsigned*)ST)[e] = 0u;
    const int dcol = tid & 127, qtr = tid >> 7, i0 = qtr * 16;
    const float lbv = frcp(1.0f + __expf(hg_lb[h * 128 + dcol] - hg_lb[1024 + h * 128 + dcol]));
    f32x4 st[8];
#pragma unroll
    for (int i = 0; i < 8; ++i) st[i] = (f32x4){0.f, 0.f, 0.f, 0.f};
    bf16_t* Pb = P1 + (size_t)b * SEQ * HGP;
    __syncthreads();
    unsigned short rq[16], rf[16], rv[16];
#define HG_ISSUE(t0n) do { _Pragma("unroll") for (int i = 0; i < 16; ++i) { const int tk = (t0n) + (dir ? 63 - (i0 + i) : (i0 + i)); const bf16_t* pr = Pb + (size_t)tk * HGP + h * 128 + dcol; \
        rq[i] = pr[0]; rf[i] = pr[1024 * (1 + dir)]; rv[i] = pr[3072]; } } while (0)
    HG_ISSUE((dir ? 63 : 0) * 64);
    for (int cc = 0; cc < 64; ++cc) {
        const int t0 = (dir ? 63 - cc : cc) * 64;
        float gq[16], gk[16], gc[16]; float run = 1.0f;
#pragma unroll
        for (int i = 0; i < 16; ++i) { const float q = bf2f(rq[i]), fr_ = bf2f(rf[i]);
            const float f = lbv + (1.0f - lbv) * sigmoidf_(fr_); run *= f; gq[i] = q; gk[i] = 1.0f - f; gc[i] = run; }
        totS[qtr * 128 + dcol] = run;
#pragma unroll
        for (int i = 0; i < 16; i += 2) *(LAS unsigned*)(VT + dcol * HLS + i0 + i) = (unsigned)rv[i] | ((unsigned)rv[i + 1] << 16);
        __syncthreads();
        { float pre = 1.0f, tot = 1.0f;
#pragma unroll
          for (int q4 = 0; q4 < 4; ++q4) { const float tq = totS[q4 * 128 + dcol]; if (q4 < qtr) pre *= tq; tot *= tq; }
          const float etot = tot;
          if (qtr == 0) lastS[dcol] = etot;
#pragma unroll
          for (int i = 0; i < 16; i += 2) { const float e0 = fmaxf(pre * gc[i], 1e-30f), e1 = fmaxf(pre * gc[i + 1], 1e-30f), n0 = frcp(e0), n1 = frcp(e1), l0 = etot * n0, l1 = etot * n1;
              QE[(i0 + i) * HLD + dcol] = (bf16_t)f2bf(gq[i] * e0); QE[(i0 + i + 1) * HLD + dcol] = (bf16_t)f2bf(gq[i + 1] * e1);
              KE[(i0 + i) * HLD + dcol] = (bf16_t)f2bf(gk[i] * n0); KE[(i0 + i + 1) * HLD + dcol] = (bf16_t)f2bf(gk[i + 1] * n1);
              *(LAS unsigned*)(KLT + dcol * HLS + i0 + i) = pk2(gk[i] * l0, gk[i + 1] * l1); } }
        if (cc + 1 < 64) HG_ISSUE((dir ? 62 - cc : cc + 1) * 64);
        __syncthreads();
        { const int mt = w >> 1;
#pragma unroll
          for (int n2 = 0; n2 < 2; ++n2) { const int nt = (w & 1) * 2 + n2; f32x4 acc = (f32x4){0.f, 0.f, 0.f, 0.f};
#pragma unroll
              for (int ks = 0; ks < 4; ++ks) acc = mfma16(ldsfrag(KE, HLD, nt * 16, ks * 32, fr, fq), ldsfrag(QE, HLD, mt * 16, ks * 32, fr, fq), acc);
              const int lrow = mt * 16 + fr; float mv[4];
#pragma unroll
              for (int i = 0; i < 4; ++i) { const int s = nt * 16 + fq * 4 + i; mv[i] = (s <= lrow) ? acc[i] : 0.f; }
              u32x2 o; o.x = pk2(mv[0], mv[1]); o.y = pk2(mv[2], mv[3]); *(LAS u32x2*)(AT + lrow * HLS + nt * 16 + fq * 4) = o; } }
        __syncthreads();
        { const int mt = w >> 1;
#pragma unroll
          for (int n4 = 0; n4 < 4; ++n4) { const int nt = (w & 1) * 4 + n4; f32x4 acc = (f32x4){0.f, 0.f, 0.f, 0.f};
#pragma unroll
              for (int ks = 0; ks < 2; ++ks) acc = mfma16(ldsfrag(VT, HLS, nt * 16, ks * 32, fr, fq), ldsfrag(AT, HLS, mt * 16, ks * 32, fr, fq), acc);
#pragma unroll
              for (int ks = 0; ks < 4; ++ks) acc = mfma16(ldsfrag(ST, HLD, nt * 16, ks * 32, fr, fq), ldsfrag(QE, HLD, mt * 16, ks * 32, fr, fq), acc);
              const int i = mt * 16 + fr, tk = t0 + (dir ? 63 - i : i);
              u32x2 o; o.x = pk2(acc[0], acc[1]); o.y = pk2(acc[2], acc[3]);
              *(u32x2*)(Ob + ((size_t)b * SEQ + tk) * ldo + ocbase + ocdir * dir + h * 128 + nt * 16 + fq * 4) = o; } }
#pragma unroll
        for (int nt = 0; nt < 8; ++nt) { const f32x4 el = *(const LAS f32x4*)(lastS + nt * 16 + fq * 4); st[nt] = st[nt] * el;
#pragma unroll
            for (int ks = 0; ks < 2; ++ks) st[nt] = mfma16(ldsfrag(KLT, HLS, nt * 16, ks * 32, fr, fq), ldsfrag(VT, HLS, w * 16, ks * 32, fr, fq), st[nt]); }
        __syncthreads();
#pragma unroll
        for (int nt = 0; nt < 8; ++nt) { u32x2 o; o.x = pk2(st[nt][0], st[nt][1]); o.y = pk2(st[nt][2], st[nt][3]); *(LAS u32x2*)(ST + (w * 16 + fr) * HLD + nt * 16 + fq * 4) = o; }
    }
    __syncthreads();
}
__device__ __forceinline__ void hgrn_combine(const bf16_t* P1, const float* norm_w, bf16_t* OMIX, int gw, int NGW, int lane) {
    const int c0 = lane * 16;
#pragma unroll 2
    for (int tk = gw; tk < T; tk += NGW) {
        const bf16_t* pr = P1 + (size_t)tk * HGP + c0; float o[16]; float ss = 0.f;
#pragma unroll
        for (int hh = 0; hh < 2; ++hh) { const u32x4 uf = *(const u32x4*)(pr + 1024 + hh * 8), ub = *(const u32x4*)(pr + 2048 + hh * 8);
#pragma unroll
            for (int i = 0; i < 4; ++i) { o[hh * 8 + 2 * i] = bflo(uf[i]) + bflo(ub[i]); o[hh * 8 + 2 * i + 1] = bfhi(uf[i]) + bfhi(ub[i]); } }
#pragma unroll
        for (int i = 0; i < 16; ++i) ss += o[i] * o[i];
        const float rs = rsqrtf(sum8(ss) * (1.f / 128.f) + 1e-6f);
#pragma unroll
        for (int hh = 0; hh < 2; ++hh) { const u32x4 ug = *(const u32x4*)(pr + 4096 + hh * 8); float r[8];
#pragma unroll
            for (int i = 0; i < 4; ++i) { const float g0 = bflo(ug[i]), g1 = bfhi(ug[i]);
                r[2 * i] = o[hh * 8 + 2 * i] * rs * norm_w[c0 + hh * 8 + 2 * i] * siluf_(g0);
                r[2 * i + 1] = o[hh * 8 + 2 * i + 1] * rs * norm_w[c0 + hh * 8 + 2 * i + 1] * siluf_(g1); }
            u32x4 wv; wv.x = pk2(r[0], r[1]); wv.y = pk2(r[2], r[3]); wv.z = pk2(r[4], r[5]); wv.w = pk2(r[6], r[7]);
            *(u32x4*)(OMIX + (size_t)tk * D + c0 + hh * 8) = wv; }
    }
}

#define XB_TMO      128
#define XB_XCNT(j)  (256  + 64 * (j))
#define XB_XSUB(j)  (1280 + 64 * (j))
#define XB_XGEN(j)  (2304 + 64 * (j))
#define XB_TOP      3328
#define XB_TOPGEN   3392
#define XCD_BAR_WORDS 3456
#define XB_SPIN_CAP (1u << 18)

__device__ __forceinline__ unsigned xb_ld(unsigned* p)              { return __hip_atomic_load(p, __ATOMIC_RELAXED, __HIP_MEMORY_SCOPE_AGENT); }
__device__ __forceinline__ unsigned xb_add(unsigned* p, unsigned v) { return __hip_atomic_fetch_add(p, v, __ATOMIC_RELAXED, __HIP_MEMORY_SCOPE_AGENT); }
__device__ __forceinline__ unsigned xb_xcc_id() { return (unsigned)__builtin_amdgcn_s_getreg((3 << 11) | 20) & 0xFu; }
#define XB_SPIN(cond, bar) do { unsigned _sp = 0; while (cond) { __builtin_amdgcn_s_sleep(1); \
    if ((++_sp & 255u) == 0u) { if (xb_ld(&(bar)[XB_TMO])) break; if (_sp > XB_SPIN_CAP) { atomicAdd(&(bar)[XB_TMO], 1u); break; } } } } while (0)

struct XcdBarrier {
    unsigned* bar; unsigned x;
    volatile LAS unsigned* st;
};

__device__ __forceinline__ XcdBarrier xcd_barrier_post(unsigned* bar, volatile LAS unsigned* st) {
    XcdBarrier b; b.bar = bar; b.x = xb_xcc_id(); b.st = st;
    if (threadIdx.x == 0) (void)xb_add(&bar[XB_XCNT(b.x)], 1u);
    return b;
}
__device__ __forceinline__ void xcd_barrier_complete(unsigned* bar, unsigned x, unsigned& nloc, unsigned& nx) {
    const unsigned G = gridDim.x * gridDim.y * gridDim.z;
    unsigned sum, cnt, mine, sp = 0u;
    for (;;) {
        sum = 0u; cnt = 0u; mine = 0u;
#pragma unroll
        for (unsigned j = 0; j < 16; ++j) { const unsigned c = xb_ld(&bar[XB_XCNT(j)]); sum += c; cnt += (c > 0u) ? 1u : 0u; mine = (j == x) ? c : mine; }
        if (sum == G) break;
        __builtin_amdgcn_s_sleep(1);
        if ((++sp & 255u) == 0u) { if (xb_ld(&bar[XB_TMO])) break; if (sp > XB_SPIN_CAP) { atomicAdd(&bar[XB_TMO], 1u); break; } }
    }
    nloc = mine > 0u ? mine : 1u; nx = cnt > 0u ? cnt : 1u;
}

__device__ __forceinline__ void xcd_barrier(const XcdBarrier& b) {
    asm volatile("s_waitcnt vmcnt(0)" ::: "memory");
    __syncthreads();
    if (threadIdx.x == 0) {
        unsigned* bar = b.bar;
        __builtin_amdgcn_s_waitcnt(0);
        unsigned nloc = b.st[0], nx = b.st[1];
        if (nloc == 0u) { xcd_barrier_complete(bar, b.x, nloc, nx); b.st[0] = nloc; b.st[1] = nx; }
        const unsigned old = xb_add(&bar[XB_XSUB(b.x)], 1u);
        const unsigned gen = old / nloc;
        if (old + 1u == (gen + 1u) * nloc) {
            __builtin_amdgcn_fence(__ATOMIC_RELEASE, "agent");
            asm volatile("s_waitcnt vmcnt(0)" ::: "memory");
            const unsigned og = xb_add(&bar[XB_TOP], 1u);
            const unsigned tg = og / nx;
            if (og + 1u == (tg + 1u) * nx) xb_add(&bar[XB_TOPGEN], 1u);
            else XB_SPIN(xb_ld(&bar[XB_TOPGEN]) == tg, bar);
            __builtin_amdgcn_fence(__ATOMIC_ACQUIRE, "agent");
            xb_add(&bar[XB_XGEN(b.x)], 1u);
            asm volatile("s_waitcnt vmcnt(0)" ::: "memory");
        } else {
            XB_SPIN(xb_ld(&bar[XB_XGEN(b.x)]) == gen, bar);
            __builtin_amdgcn_fence(__ATOMIC_ACQUIRE, "agent");
            asm volatile("s_waitcnt vmcnt(0)" ::: "memory");
        }
    }
    __syncthreads();
}


struct Args { const float* in[35]; float* out; unsigned char* ws; int ph_lo, ph_hi; };
static_assert(sizeof(Args) == 304, "Args layout");

__global__ void __launch_bounds__(512, 2) mk_fwd(Args args) {
    extern __shared__ __attribute__((aligned(16))) unsigned char lds_raw[];
    LAS unsigned char* lds = (LAS unsigned char*)lds_raw; LAS unsigned char* xl = lds + XLDS_OFF;
    const int G = gridDim.x, bx = blockIdx.x, NGW = G * 8;
#define LOCAL_IDS int tid = threadIdx.x; asm volatile("" : "+v"(tid)); const int lane = tid & 63, wave = __builtin_amdgcn_readfirstlane(tid >> 6), gw = bx * 8 + wave; (void)lane; (void)gw;
    typedef const __attribute__((address_space(4))) unsigned char* kaptr_t;
    kaptr_t ka = (kaptr_t)__builtin_amdgcn_kernarg_segment_ptr();
#define INP(k) (*(const float* const volatile __attribute__((address_space(4)))*)(ka + 8 * (k)))
    unsigned char* ws = *(unsigned char* const volatile __attribute__((address_space(4)))*)(ka + 288); float* out = *(float* const volatile __attribute__((address_space(4)))*)(ka + 280);
    const float* x = INP(0);
    bf16_t* WAB = (bf16_t*)(ws + WS_WAB); bf16_t* WABO = (bf16_t*)(ws + WS_WABO); bf16_t* WHG = (bf16_t*)(ws + WS_WHG); bf16_t* WHGO = (bf16_t*)(ws + WS_WHGO);
    bf16_t* WQ = (bf16_t*)(ws + WS_WQ); bf16_t* WKV = (bf16_t*)(ws + WS_WKV); bf16_t* WO = (bf16_t*)(ws + WS_WO); bf16_t* WF1 = (bf16_t*)(ws + WS_WF1); bf16_t* WF2 = (bf16_t*)(ws + WS_WF2);
    bf16_t* G2T = (bf16_t*)(ws + WS_G2T); bf16_t* MEMN = (bf16_t*)(ws + WS_MEMN); bf16_t* KMEM = (bf16_t*)(ws + WS_KMEM);
    bf16_t* WKT = (bf16_t*)out; bf16_t* VWT = (bf16_t*)((unsigned char*)out + 64 * MiB);
    bf16_t* H = (bf16_t*)(ws + WS_H); bf16_t* P = (bf16_t*)(ws + WS_P); bf16_t* PATT = (bf16_t*)(ws + WS_PATT); bf16_t* OMIX0 = (bf16_t*)(ws + WS_OMIX0); bf16_t* OMIX1 = (bf16_t*)(ws + WS_OMIX1); float* PSB = (float*)(ws + WS_PS);
#define COMMA ,
    bf16_t* STATES = (bf16_t*)((unsigned char*)out + DO_STATES); bf16_t* GG = (bf16_t*)((unsigned char*)out + DO_G); bf16_t* SG = (bf16_t*)((unsigned char*)out + DO_SG);
    float* BONUS = (float*)((unsigned char*)out + DO_BONUS); float* TOT = (float*)((unsigned char*)out + DO_TOT);
    cg::grid_group grid = cg::this_grid();
    { volatile LAS unsigned* st_ = (volatile LAS unsigned*)(lds + LDS_BYTES - 16); if (threadIdx.x < 4) st_[threadIdx.x] = 0u; }
    __syncthreads();
    const XcdBarrier xbar = xcd_barrier_post((unsigned*)ws, (volatile LAS unsigned*)(lds + LDS_BYTES - 16));
    const int lo = *(const int volatile __attribute__((address_space(4)))*)(ka + 296), hi = *(const int volatile __attribute__((address_space(4)))*)(ka + 300);
#ifndef PH_EN
#define PH_EN(k) 1
#endif
#define IN(k) (PH_EN(k) && lo <= (k) && (k) < hi)
#ifndef DUP_MASK
#define DUP_MASK 0ull
#endif
#define REPS(k) (1 + (int)(((unsigned long long)(DUP_MASK) >> (k)) & 1ull))
#define PHASE(k) for (int rep_ = 0; rep_ < (IN(k) ? REPS(k) : 0); ++rep_, ((REPS(k) > 1) ? (grid.sync(), 0) : 0))
#define SEAM(k) do { if (IN(k) && IN((k) + 1)) xcd_barrier(xbar); } while (0)
    if (lo < 0) grid.sync();
#define RUN_GEMM(EPI, ALIGN, gd, ep) do { pg8::Order S_; S_.init(gd, G, bx); pg8::gemm_phase<EPI, ALIGN>(lds, xl, gd, S_, ep); } while (0)

    PHASE(0) { LOCAL_IDS
        LAS float* scr = (LAS float*)(lds + wave * 16384);
        constexpr int I_AB = 16 * 112, I_SQ = 16 * 32, I_HG = 16 * 160, I_KV = 16 * 64, I_F1 = 16 * 176, I_F2 = 44 * 32, I_G2 = 2 * 16;
        constexpr int NIT = I_AB + I_SQ + I_HG + I_SQ + 2 * I_KV + 2 * I_SQ + 2 * I_F1 + 2 * I_F2 + I_G2;
        for (int it = gw; it < NIT; it += NGW) {
            int r = it;
            if (r < I_AB) { transpose_item<0>(INP(3), 1024, ABP, WAB, scr, r, 112, lane); continue; } r -= I_AB;
            if (r < I_SQ) { transpose_item<0>(INP(4), 1024, 1024, WABO, scr, r, 32, lane); continue; } r -= I_SQ;
            if (r < I_HG) { transpose_item<0>(INP(22), 1024, HGP, WHG, scr, r, 160, lane, INP(2) + D); continue; } r -= I_HG;
            if (r < I_SQ) { transpose_item<0>(INP(23), 1024, 1024, WHGO, scr, r, 32, lane); continue; } r -= I_SQ;
            if (r < 2 * I_KV) { const int l = r / I_KV; transpose_item<0>(INP(29) + (size_t)l * D * 2048, 1024, 2048, WKV + (size_t)l * D * 2048, scr, r % I_KV, 64, lane); continue; } r -= 2 * I_KV;
            if (r < 2 * I_SQ) { const int l = r / I_SQ; transpose_item<0>(INP(30) + (size_t)l * D * D, 1024, 1024, WO + (size_t)l * D * D, scr, r % I_SQ, 32, lane); continue; } r -= 2 * I_SQ;
            if (r < 2 * I_F1) { const int l = r / I_F1; transpose_item<1>(INP(32) + (size_t)l * D * 2 * FFN, 1024, 2 * FFN, WF1 + (size_t)l * D * 2 * FFN, scr, r % I_F1, 176, lane, INP(31) + l * D); continue; } r -= 2 * I_F1;
            if (r < 2 * I_F2) { const int l = r / I_F2; transpose_item<0>(INP(33) + (size_t)l * FFN * D, FFN, 1024, WF2 + (size_t)l * FFN * D, scr, r % I_F2, 32, lane); continue; } r -= 2 * I_F2;
            transpose_item<0>(INP(10), 128, 512, G2T, scr, r, 16, lane);
        }
        for (size_t e8 = (size_t)bx * 512 + tid; e8 < (size_t)2 * D * D / 8; e8 += (size_t)G * 512) { const size_t idx = e8 * 8; const int l = (int)(idx / ((size_t)D * D)), k = (int)((idx % ((size_t)D * D)) / D);
            const float gk = INP(26)[l * D + k]; const f32x4 a0 = *(const f32x4*)(INP(28) + idx), a1 = *(const f32x4*)(INP(28) + idx + 4);
            u32x4 o; o.x = pk2(a0[0] * gk, a0[1] * gk); o.y = pk2(a0[2] * gk, a0[3] * gk); o.z = pk2(a1[0] * gk, a1[1] * gk); o.w = pk2(a1[2] * gk, a1[3] * gk); *(u32x4*)(WQ + idx) = o; }
        rms_rows_phase(x, INP(2), H, T, gw, NGW, lane);
        for (int m = gw; m < 2 * 4096; m += NGW) { const int l = m >> 12, r = m & 4095; rms_row_bf16(INP(1) + (size_t)r * D, INP(27) + l * D, MEMN + (size_t)m * D, lane); }
        __syncthreads();
    }
    SEAM(0);
    PHASE(1) {
        { pg8::Gemm g = pg8::make_gemm(H, WAB, T, ABPAD, 1024, 1024, 1024); pg8::EpiBf16 E{P, ABPAD, 1.0f, nullptr}; RUN_GEMM(pg8::EpiBf16, true, g, E); }
        { pg8::Gemm g = pg8::make_gemm(MEMN, WKV, 4096, 2048, 1024, 1024, 1024); g.nZ = 2; g.sAo = 4096L * D; g.sBo = 2048L * D; g.sCo = 4096L * 2048; pg8::EpiBf16 E{KMEM, 2048, 1.0f, nullptr}; RUN_GEMM(pg8::EpiBf16, true, g, E); }
    }
    SEAM(1);
    PHASE(2) {
#ifndef DUP_RWKV
#define DUP_RWKV 0
#endif
#ifndef DUP_S1
#define DUP_S1 0
#endif
        for (int r2 = 0; r2 <= DUP_RWKV; ++r2)
        for (int cid = bx; cid < 256; cid += G)
            rwkv_chain(lds, cid, P, INP(5), INP(6), INP(7), INP(8), INP(9), INP(11), INP(12), INP(13), H, SG, BONUS);
        for (int r2 = 0; r2 <= DUP_S1; ++r2)
        for (int u = bx; u < 1024; u += G) ssd_s1_unit(lds, u, P, INP(16), INP(17), INP(18), INP(19), STATES, TOT);
        __syncthreads();
    }
    SEAM(2);
    PHASE(3) {
        { int k128 = 128; asm volatile("" : "+s"(k128)); pg8::Gemm g = pg8::make_gemm(SG, G2T, T, 512, k128, 128, 128); pg8::EpiBf16 E{GG, 512, 1.0f, nullptr}; RUN_GEMM(pg8::EpiBf16, true, g, E); }
        { LOCAL_IDS ssd_s2(STATES, OMIX1, TOT, bx * 512 + tid, G * 512); }
    }
    SEAM(3);
    PHASE(4) {
#ifndef DUP_S3
#define DUP_S3 0
#endif
        for (int r2 = 0; r2 <= DUP_S3; ++r2)
        for (int u = bx; u < 1024; u += G) ssd_s3_unit(lds, u, P, INP(16), INP(17), INP(18), INP(19), INP(20), INP(21), OMIX1, OMIX0);
        __syncthreads();
        { LOCAL_IDS rwkv_combine(P, H, BONUS, GG, INP(5), INP(14), INP(15), OMIX0, gw, NGW, lane); }
    }
    SEAM(4);
    PHASE(5) { { pg8::Gemm g = pg8::make_gemm(OMIX0, WABO, T, 1024, 1024, 1024, 1024); pg8::EpiResidB E{x, H, PSB, 1024}; RUN_GEMM(pg8::EpiResidB, true, g, E); }
        for (int l = 0; l < 2; ++l) {
            { pg8::Gemm g = pg8::make_gemm(KMEM + (size_t)l * 4096 * 2048, WQ + (size_t)l * D * D, 256, 1024, 256, 2048, 1024); g.nZ = 64; g.zdiv = 4;
              g.sAo = 256L * 2048; g.sAi = 256; g.sBo = 0; g.sBi = 256; g.sCo = 4L * 256 * 1024; g.sCi = 256L * 1024; pg8::EpiBf16 E{WKT + (size_t)l * 16777216, 1024, 0.0625f, nullptr}; RUN_GEMM(pg8::EpiBf16, true, g, E); }
            { pg8::Gemm g = pg8::make_gemm(WO + (size_t)l * D * D, KMEM + (size_t)l * 4096 * 2048 + 1024, 1024, 256, 256, 1024, 2048); g.nZ = 64; g.zdiv = 4;
              g.sAo = 0; g.sAi = 256; g.sBo = 256L * 2048; g.sBi = 256; g.sCo = 1024L * 1024; g.sCi = 256; pg8::EpiBf16 E{VWT + (size_t)l * 16777216, 1024, 1.0f, nullptr}; RUN_GEMM(pg8::EpiBf16, true, g, E); }
        } }
    SEAM(5);

#define ATTN_FFN(base, L) \
    PHASE(base) { pg8::Gemm g = pg8::make_gemm(H, WKT + (size_t)(L) * 16777216, SEQ, 256, 1024, 1024, 1024); g.nZ = 64; g.zdiv = 4; g.psz = 16; \
        g.sAo = (long)SEQ * D; g.sAi = 0; g.sBo = 4L * 256 * 1024; g.sBi = 256L * 1024; g.sCo = (long)SEQ * D; g.sCi = 256; pg8::EpiSoftmaxPS E{PSB, PATT, 1024}; RUN_GEMM(pg8::EpiSoftmaxPS, true, g, E); } \
    SEAM(base); \
    PHASE(base + 1) { pg8::Gemm g = pg8::make_gemm(PATT, VWT + (size_t)(L) * 16777216, SEQ, 1024, 1024, 1024, 1024); g.nZ = 16; g.zdiv = 1; \
        g.sAo = (long)SEQ * D; g.sBo = 1024L * 1024; g.sCo = (long)SEQ * D; pg8::EpiResidB E{nullptr, H, PSB, 1024}; RUN_GEMM(pg8::EpiResidB, true, g, E); } \
    SEAM(base + 1); \
    PHASE(base + 2) { pg8::Gemm g = pg8::make_gemm(H, WF1 + (size_t)(L) * D * 2 * FFN, T, 2 * FFN, 1024, 1024, 1024); pg8::EpiSwiglu E{P, FFN, PSB}; RUN_GEMM(pg8::EpiSwiglu, true, g, E); } \
    SEAM(base + 2); \
    PHASE(base + 3) { pg8::Gemm g = pg8::make_gemm(P, WF2 + (size_t)(L) * FFN * D, T, 1024, FFN, FFN, FFN); pg8::EpiResidB E{nullptr, H, PSB, 1024}; RUN_GEMM(pg8::EpiResidB, true, g, E); } \
    SEAM(base + 3);

    ATTN_FFN(6, 0)

    PHASE(10) { pg8::Gemm g = pg8::make_gemm(H, WHG, T, HGP, 1024, 1024, 1024); pg8::EpiBf16PS E{P, HGP, 1.0f, PSB}; RUN_GEMM(pg8::EpiBf16PS, true, g, E); }
    SEAM(10);
    PHASE(11) { for (int cid = bx; cid < 256; cid += G) hgrn_chain(lds, cid, P, INP(25), P, HGP, 1024, 1024); }
    SEAM(11);
    PHASE(12) { LOCAL_IDS hgrn_combine(P, INP(24), OMIX1, gw, NGW, lane); }
    SEAM(12);
    PHASE(13) { pg8::Gemm g = pg8::make_gemm(OMIX1, WHGO, T, 1024, 1024, 1024, 1024); pg8::EpiResidB E{nullptr, H, PSB, 1024}; RUN_GEMM(pg8::EpiResidB, true, g, E); }
    SEAM(13);

    ATTN_FFN(14, 1)

    PHASE(18) { LOCAL_IDS
        const float* fg = INP(34);
        f32x4 g0[2], g1[2];
#pragma unroll
        for (int j = 0; j < 2; ++j) { const int c = (lane + 64 * j) * 8; g0[j] = *(const f32x4*)(fg + c); g1[j] = *(const f32x4*)(fg + c + 4); }
        for (int m0 = gw; m0 < T; m0 += 4 * NGW) {
            f32x4 pa[4]; u32x4 hv[4][2];
#pragma unroll
            for (int r = 0; r < 4; ++r) { const int m = m0 + r * NGW; if (m < T) { pa[r] = *(const f32x4*)(PSB + (size_t)m * 16 + (lane & 3) * 4);
#pragma unroll
                for (int j = 0; j < 2; ++j) hv[r][j] = *(const u32x4*)(H + (size_t)m * D + (lane + 64 * j) * 8); } }
#pragma unroll
            for (int r = 0; r < 4; ++r) { const int m = m0 + r * NGW; if (m < T) {
                float sq = (pa[r][0] + pa[r][1]) + (pa[r][2] + pa[r][3]); sq += __shfl_xor(sq, 1); sq += __shfl_xor(sq, 2);
                const float rs = rsqrtf(sq * (1.f / D) + 1e-6f); float* orow = out + (size_t)m * D;
#pragma unroll
                for (int j = 0; j < 2; ++j) { const int c = (lane + 64 * j) * 8; const u32x4 h4 = hv[r][j];
                    *(f32x4*)(orow + c) = (f32x4){bflo(h4.x) * rs * g0[j][0], bfhi(h4.x) * rs * g0[j][1], bflo(h4.y) * rs * g0[j][2], bfhi(h4.y) * rs * g0[j][3]};
                    *(f32x4*)(orow + c + 4) = (f32x4){bflo(h4.z) * rs * g1[j][0], bfhi(h4.z) * rs * g1[j][1], bflo(h4.w) * rs * g1[j][2], bfhi(h4.w) * rs * g1[j][3]}; } } }
        }
    }
#undef IN
#undef SEAM
#undef RUN_GEMM
}

extern "C" void kernel_launch(void* const* d_in, const int* in_sizes, int n_in, void* d_out, int out_size, void* d_ws, size_t ws_size, hipStream_t stream) {
    static int grid = 0;
    if (grid == 0) {
        if (n_in != 35 || out_size != T * D || ws_size < WS_END) { fprintf(stderr, "kernel_launch: unexpected shapes (n_in %d out %d ws %zu)\n", n_in, out_size, ws_size); grid = -1; return; }
        int dev = 0, cus = 0, per_cu = 0;
        hipGetDevice(&dev); hipDeviceGetAttribute(&cus, hipDeviceAttributeMultiprocessorCount, dev);
        hipFuncSetAttribute((const void*)mk_fwd, hipFuncAttributeMaxDynamicSharedMemorySize, LDS_BYTES);
        hipOccupancyMaxActiveBlocksPerMultiprocessor(&per_cu, (const void*)mk_fwd, 512, LDS_BYTES);
        if (per_cu < 1) { fprintf(stderr, "kernel_launch: occupancy query says %d blocks per CU\n", per_cu); per_cu = 1; }
        (void)hipGetLastError();
        grid = cus * 1;
    }
    if (grid < 0) return;
    if (hipMemsetAsync(d_ws, 0, 65536, stream) != hipSuccess) { fprintf(stderr, "kernel_launch: memset of the barrier words failed\n"); return; }
    Args a{};
    for (int i = 0; i < 35; ++i) a.in[i] = (const float*)d_in[i];
    a.out = (float*)d_out; a.ws = (unsigned char*)d_ws;
#if MK_COOP
    a.ph_lo = 0; a.ph_hi = NPHASE;
    void* kargs[] = {&a};
    hipError_t e = hipLaunchCooperativeKernel((const void*)mk_fwd, dim3(grid), dim3(512), kargs, LDS_BYTES, stream);
    if (e != hipSuccess) fprintf(stderr, "cooperative launch failed: %s (grid %d)\n", hipGetErrorString(e), grid);
#else
    for (int ph = 0; ph < NPHASE; ++ph) { a.ph_lo = ph; a.ph_hi = ph + 1; hipLaunchKernelGGL(mk_fwd, dim3(grid), dim3(512), LDS_BYTES, stream, a); }
#endif
}
```

```cpp
#include <hip/hip_runtime.h>
#include <hip/hip_cooperative_groups.h>
#include <cstdio>
#include <cstdint>
namespace cg = cooperative_groups;

#ifndef MK_COOP
#define MK_COOP 1
#endif

#define LAS __attribute__((address_space(3)))
typedef unsigned short bf16_t;
typedef short bf16x8 __attribute__((ext_vector_type(8)));
typedef float f32x4 __attribute__((ext_vector_type(4)));
typedef float f32x2 __attribute__((ext_vector_type(2)));
typedef unsigned u32x4 __attribute__((ext_vector_type(4)));
typedef unsigned u32x2 __attribute__((ext_vector_type(2)));

constexpr int NB = 16, SEQ = 4096, T = NB * SEQ, D = 1024;
constexpr int ABPAD = 3584, ABP = 3336;
constexpr int HGP = 5120;
constexpr int FFN = 2816;
constexpr int NPHASE = 19;

constexpr size_t MiB = 1u << 20;
constexpr size_t WS_WAB = 1 * MiB, WS_WABO = 8 * MiB, WS_WHG = 10 * MiB, WS_WHGO = 20 * MiB, WS_WQ = 22 * MiB, WS_WKV = 26 * MiB, WS_WO = 34 * MiB,
                 WS_WF1 = 38 * MiB, WS_WF2 = 60 * MiB, WS_G2T = 71 * MiB, WS_MEMN = 72 * MiB, WS_KMEM = 88 * MiB, WS_VT = 104 * MiB,
                 WS_PS = 120 * MiB, WS_H = 128 * MiB, WS_P = 256 * MiB, WS_PATT = 384 * MiB, WS_OMIX0 = 704 * MiB, WS_OMIX1 = 896 * MiB, WS_END = 1024 * MiB;
constexpr size_t DO_STATES = 0, DO_G = 128 * MiB, DO_SG = 192 * MiB, DO_BONUS = 208 * MiB, DO_TOT = 210 * MiB;

constexpr int LDS_BYTES = 163840;
constexpr int XLDS_OFF = 131072;

typedef __bf16 bf16x2_t __attribute__((ext_vector_type(2)));
__device__ __forceinline__ unsigned pk2(float lo, float hi) { const f32x2 v = {lo, hi}; return __builtin_bit_cast(unsigned, __builtin_convertvector(v, bf16x2_t)); }
__device__ __forceinline__ unsigned f2bf(float f) { return pk2(f, 0.f) & 0xffffu; }
__device__ __forceinline__ float bf2f(unsigned short b) { return __builtin_bit_cast(float, (unsigned)b << 16); }
__device__ __forceinline__ float bflo(unsigned u) { return __builtin_bit_cast(float, u << 16); }
__device__ __forceinline__ float bfhi(unsigned u) { return __builtin_bit_cast(float, u & 0xffff0000u); }
__device__ __forceinline__ float frcp(float x) { return __builtin_amdgcn_rcpf(x); }
__device__ __forceinline__ float sigmoidf_(float x) { return frcp(1.0f + __expf(-x)); }
__device__ __forceinline__ float siluf_(float x) { return x * frcp(1.0f + __expf(-x)); }
__device__ __forceinline__ float wave_sum(float v) {
#pragma unroll
    for (int o = 1; o < 64; o <<= 1) v += __shfl_xor(v, o);
    return v;
}
template <int CTRL> __device__ __forceinline__ float dppf(float x) { return __builtin_bit_cast(float, __builtin_amdgcn_mov_dpp(__builtin_bit_cast(int, x), CTRL, 0xf, 0xf, true)); }
__device__ __forceinline__ float sum8(float v) { v += dppf<0xB1>(v); v += dppf<0x4E>(v); v += dppf<0x141>(v); return v; }
#define LDS_WAIT() asm volatile("s_waitcnt lgkmcnt(0)" ::: "memory")

namespace pg8 {
constexpr int BM = 256, BK = 64, HALF = 128, HTB = HALF * BK * 2, STAGE_BYTES = 8 * HTB, NXCD = 8, WGM = 8;
__host__ __device__ __forceinline__ int lds_byte(int r, int c) { const int st = (r >> 4) * 2 + (c >> 5), rr = r & 15, cc = c & 31, ob = rr * 64 + cc * 2; return st * 1024 + (ob ^ (((ob >> 9) & 1) << 5)); }
__host__ __device__ __forceinline__ void stage_rc(int b, int& R, int& C) { const int st = b / 1024, sb = b % 1024, swz = sb ^ (((sb >> 9) & 1) << 5); R = (st >> 1) * 16 + swz / 64; C = (st & 1) * 32 + (swz % 64) / 2; }
__host__ __device__ __forceinline__ int perm32(int rho) { const int n = rho >> 4, i = rho & 15; return 8 * (i >> 2) + 4 * n + (i & 3); }

struct Unit { int pm, pn, z; };
struct Gemm {
    const bf16_t* A; const bf16_t* Bt; int lda, ldb, K, nM, nN, nZ, zdiv, psz; long sAo, sAi, sBo, sBi, sCo, sCi;
    __device__ __forceinline__ long offA(const Unit& u) const { return (long)(u.z / zdiv) * sAo + (long)(u.z % zdiv) * sAi + (long)u.pm * BM * lda; }
    __device__ __forceinline__ long offB(const Unit& u) const { return (long)(u.z / zdiv) * sBo + (long)(u.z % zdiv) * sBi + (long)u.pn * BM * ldb; }
    __device__ __forceinline__ long offC(const Unit& u) const { return (long)(u.z / zdiv) * sCo + (long)(u.z % zdiv) * sCi; }
};
__device__ __forceinline__ Gemm make_gemm(const bf16_t* A, const bf16_t* Bt, int M, int N, int K, int lda, int ldb) {
    Gemm g; g.A = A; g.Bt = Bt; g.lda = lda; g.ldb = ldb; g.K = K; g.nM = M / BM; g.nN = N / BM; g.nZ = 1; g.zdiv = 1; g.psz = 0; g.sAo = g.sAi = g.sBo = g.sBi = g.sCo = g.sCi = 0; return g;
}
struct Order {
    int nM, nN, nwg, total, G, c;
    __device__ __forceinline__ void init(const Gemm& g, int G_, int c_) { nM = g.nM; nN = g.nN; nwg = nM * nN; total = nwg * g.nZ; G = G_; c = c_; }
    __device__ __forceinline__ bool next(int i, Unit& u) const {
        const long L = (long)i * G + c; if (L >= total) return false;
        u.z = (int)(L / nwg); int wgid = (int)(L % nwg);
        { const int q = nwg / NXCD, r = nwg % NXCD, xcd = wgid % NXCD, off = wgid / NXCD; wgid = (xcd < r ? xcd * (q + 1) : r * (q + 1) + (xcd - r) * q) + off; }
        const int nig = WGM * nN, gid = wgid / nig, fm = gid * WGM, gsz = (nM - fm) < WGM ? (nM - fm) : WGM;
        u.pm = fm + ((wgid % nig) % gsz); u.pn = (wgid % nig) / gsz; return true;
    }
};

__device__ __forceinline__ unsigned cvt_pk_bf16(float lo, float hi) { return pk2(lo, hi); }

__device__ __forceinline__ void row_scales(const float* PS, int rowbase, int fq, float (&rs)[2][4]) {
#pragma unroll
    for (int ai = 0; ai < 2; ++ai)
#pragma unroll
        for (int m = 0; m < 4; ++m) { const f32x4 p = *(const f32x4*)(PS + (size_t)(rowbase + ai * HALF + m * 16) * 16 + fq * 4);
            float s = (p[0] + p[1]) + (p[2] + p[3]); s += __shfl_xor(s, 16); s += __shfl_xor(s, 32); rs[ai][m] = rsqrtf(s * (1.f / 1024.f) + 1e-6f); }
}
__device__ __forceinline__ void row_scales_lds(const LAS float* PSL, int rloc  , int fq, float (&rs)[2][4]) {
#pragma unroll
    for (int ai = 0; ai < 2; ++ai)
#pragma unroll
        for (int m = 0; m < 4; ++m) { const f32x4 p = *(const LAS f32x4*)(PSL + (rloc + ai * HALF + m * 16) * 16 + fq * 4);
            float s = (p[0] + p[1]) + (p[2] + p[3]); s += __shfl_xor(s, 16); s += __shfl_xor(s, 32); rs[ai][m] = rsqrtf(s * (1.f / 1024.f) + 1e-6f); }
}
struct EpiBf16 {
    static constexpr bool PERM = true, PSLDS = false;
    bf16_t* O; int ldc; float scale; const float* PS;
    __device__ __forceinline__ void operator()(const f32x4 (&acc)[2][2][4][2], const Unit& u, long coff, int wr, int wc, int fr, int fq, LAS unsigned char* xl) const {
        const int row0 = u.pm * BM + wr * 64 + fr, col0 = u.pn * BM + wc * 32 + 8 * fq; bf16_t* base = O + coff;
        float rs[2][4];
        if (PS) row_scales(PS, row0, fq, rs);
        else {
#pragma unroll
            for (int ai = 0; ai < 2; ++ai)
#pragma unroll
                for (int m = 0; m < 4; ++m) rs[ai][m] = 1.f; }
#pragma unroll
        for (int ai = 0; ai < 2; ++ai)
#pragma unroll
            for (int m = 0; m < 4; ++m) { bf16_t* rowp = base + (size_t)(row0 + ai * HALF + m * 16) * ldc + col0; const float sc_ = scale * rs[ai][m];
#pragma unroll
                for (int bj = 0; bj < 2; ++bj) { const f32x4 v0 = acc[ai][bj][m][0] * sc_, v1 = acc[ai][bj][m][1] * sc_;
                    u32x4 w; w.x = cvt_pk_bf16(v0[0], v0[1]); w.y = cvt_pk_bf16(v0[2], v0[3]); w.z = cvt_pk_bf16(v1[0], v1[1]); w.w = cvt_pk_bf16(v1[2], v1[3]);
                    *(u32x4*)(rowp + bj * HALF) = w; } }
    }
};
struct EpiBf16PS {
    static constexpr bool PERM = true, PSLDS = true;
    bf16_t* O; int ldc; float scale; const float* PS;
    __device__ __forceinline__ void operator()(const f32x4 (&acc)[2][2][4][2], const Unit& u, long coff, int wr, int wc, int fr, int fq, LAS unsigned char* xl) const {
        const int row0 = u.pm * BM + wr * 64 + fr, col0 = u.pn * BM + wc * 32 + 8 * fq; bf16_t* base = O + coff;
        float rs[2][4];
        row_scales_lds((const LAS float*)(xl + 8192), wr * 64 + fr, fq, rs);
#pragma unroll
        for (int ai = 0; ai < 2; ++ai)
#pragma unroll
            for (int m = 0; m < 4; ++m) { bf16_t* rowp = base + (size_t)(row0 + ai * HALF + m * 16) * ldc + col0; const float sc_ = scale * rs[ai][m];
#pragma unroll
                for (int bj = 0; bj < 2; ++bj) { const f32x4 v0 = acc[ai][bj][m][0] * sc_, v1 = acc[ai][bj][m][1] * sc_;
                    u32x4 w; w.x = cvt_pk_bf16(v0[0], v0[1]); w.y = cvt_pk_bf16(v0[2], v0[3]); w.z = cvt_pk_bf16(v1[0], v1[1]); w.w = cvt_pk_bf16(v1[2], v1[3]);
                    *(u32x4*)(rowp + bj * HALF) = w; } }
    }
};
struct EpiResid {
    static constexpr bool PERM = false, PSLDS = false;
    const float* base; float* out; int ldc;
    __device__ __forceinline__ void operator()(const f32x4 (&acc)[2][2][4][2], const Unit& u, long coff, int wr, int wc, int fr, int fq, LAS unsigned char* xl) const {
        const int col0 = u.pn * BM + wc * 32 + 4 * fq;
#pragma unroll
        for (int ai = 0; ai < 2; ++ai)
#pragma unroll
            for (int m = 0; m < 4; ++m) { const size_t off = (size_t)(u.pm * BM + ai * HALF + wr * 64 + m * 16 + fr) * ldc + col0;
#pragma unroll
                for (int bj = 0; bj < 2; ++bj)
#pragma unroll
                    for (int n = 0; n < 2; ++n) { const f32x4 bs = *(const f32x4*)(base + off + bj * HALF + n * 16); *(f32x4*)(out + off + bj * HALF + n * 16) = bs + acc[ai][bj][m][n]; } }
    }
};
struct EpiResidH {
    static constexpr bool PERM = false, PSLDS = false;
    const float* base; float* out; bf16_t* HB; float* PS; int ldc;
    __device__ __forceinline__ void operator()(const f32x4 (&acc)[2][2][4][2], const Unit& u, long coff, int wr, int wc, int fr, int fq, LAS unsigned char* xl) const {
        const int col0 = u.pn * BM + wc * 32 + 4 * fq;
#pragma unroll
        for (int ai = 0; ai < 2; ++ai)
#pragma unroll
            for (int m = 0; m < 4; ++m) { const int row = u.pm * BM + ai * HALF + wr * 64 + m * 16 + fr; const size_t off = (size_t)row * ldc + col0; float ss = 0.f;
#pragma unroll
                for (int bj = 0; bj < 2; ++bj)
#pragma unroll
                    for (int n = 0; n < 2; ++n) { const f32x4 bs = *(const f32x4*)(base + off + bj * HALF + n * 16); const f32x4 o = bs + acc[ai][bj][m][n]; *(f32x4*)(out + off + bj * HALF + n * 16) = o;
                        ss += (o[0] * o[0] + o[1] * o[1]) + (o[2] * o[2] + o[3] * o[3]);
                        u32x2 w; w.x = cvt_pk_bf16(o[0], o[1]); w.y = cvt_pk_bf16(o[2], o[3]); *(u32x2*)(HB + off + bj * HALF + n * 16) = w; }
                ss += __shfl_xor(ss, 16); ss += __shfl_xor(ss, 32);
                if (fq == 0) PS[(size_t)row * 16 + u.pn * 4 + wc] = ss; }
    }
};
struct EpiResidB {
    static constexpr bool PERM = false, PSLDS = false;
    const float* basef; bf16_t* HB; float* PS; int ldc;
    __device__ __forceinline__ void operator()(const f32x4 (&acc)[2][2][4][2], const Unit& u, long coff, int wr, int wc, int fr, int fq, LAS unsigned char* xl) const {
        const int col0 = u.pn * BM + wc * 32 + 4 * fq;
#pragma unroll
        for (int ai = 0; ai < 2; ++ai)
#pragma unroll
            for (int m = 0; m < 4; ++m) { const int row = (int)(coff / ldc) + u.pm * BM + ai * HALF + wr * 64 + m * 16 + fr; const size_t off = (size_t)row * ldc + col0; float ss = 0.f;
#pragma unroll
                for (int bj = 0; bj < 2; ++bj)
#pragma unroll
                    for (int n = 0; n < 2; ++n) { f32x4 bs;
                        if (basef) bs = *(const f32x4*)(basef + off + bj * HALF + n * 16);
                        else { const u32x2 hb = *(const u32x2*)(HB + off + bj * HALF + n * 16); bs = (f32x4){bflo(hb.x), bfhi(hb.x), bflo(hb.y), bfhi(hb.y)}; }
                        const f32x4 o = bs + acc[ai][bj][m][n];
                        ss += (o[0] * o[0] + o[1] * o[1]) + (o[2] * o[2] + o[3] * o[3]);
                        u32x2 w; w.x = cvt_pk_bf16(o[0], o[1]); w.y = cvt_pk_bf16(o[2], o[3]); *(u32x2*)(HB + off + bj * HALF + n * 16) = w; }
                ss += __shfl_xor(ss, 16); ss += __shfl_xor(ss, 32);
                if (fq == 0) PS[(size_t)row * 16 + u.pn * 4 + wc] = ss; }
    }
};
struct EpiSwiglu {
    static constexpr bool PERM = true, PSLDS = true;
    bf16_t* O; int ldc; const float* PS;
    __device__ __forceinline__ void operator()(const f32x4 (&acc)[2][2][4][2], const Unit& u, long coff, int wr, int wc, int fr, int fq, LAS unsigned char* xl) const {
        const int row0 = u.pm * BM + wr * 64 + fr, col0 = u.pn * HALF + wc * 32 + 8 * fq;
        float rs[2][4]; row_scales_lds((const LAS float*)(xl + 8192), wr * 64 + fr, fq, rs);
#pragma unroll
        for (int ai = 0; ai < 2; ++ai)
#pragma unroll
            for (int m = 0; m < 4; ++m) { bf16_t* rowp = O + (size_t)(row0 + ai * HALF + m * 16) * ldc + col0; float r[8]; const float sc_ = rs[ai][m];
#pragma unroll
                for (int n = 0; n < 2; ++n)
#pragma unroll
                    for (int i = 0; i < 4; ++i) { const float g = acc[ai][0][m][n][i] * sc_, uu = acc[ai][1][m][n][i] * sc_; r[n * 4 + i] = siluf_(g) * uu; }
                u32x4 w; w.x = cvt_pk_bf16(r[0], r[1]); w.y = cvt_pk_bf16(r[2], r[3]); w.z = cvt_pk_bf16(r[4], r[5]); w.w = cvt_pk_bf16(r[6], r[7]);
                *(u32x4*)rowp = w; }
    }
};
struct EpiSoftmax {
    static constexpr bool PERM = true, PSLDS = false;
    bf16_t* O; int ldc;
    __device__ __forceinline__ void operator()(f32x4 (&acc)[2][2][4][2], const Unit& u, long coff, int wr, int wc, int fr, int fq, LAS unsigned char* xl) const {
        LAS float* XM = (LAS float*)xl; LAS float* XS = (LAS float*)(xl + 4096);
#pragma unroll
        for (int ai = 0; ai < 2; ++ai)
#pragma unroll
            for (int m = 0; m < 4; ++m) { float mx = -3.0e38f;
#pragma unroll
                for (int bj = 0; bj < 2; ++bj)
#pragma unroll
                    for (int n = 0; n < 2; ++n)
#pragma unroll
                        for (int i = 0; i < 4; ++i) mx = fmaxf(mx, acc[ai][bj][m][n][i]);
                mx = fmaxf(mx, __shfl_xor(mx, 16)); mx = fmaxf(mx, __shfl_xor(mx, 32));
                if (fq == 0) XM[(ai * HALF + wr * 64 + m * 16 + fr) * 4 + wc] = mx; }
        LDS_WAIT(); __builtin_amdgcn_s_barrier(); asm volatile("" ::: "memory");
#pragma unroll
        for (int ai = 0; ai < 2; ++ai)
#pragma unroll
            for (int m = 0; m < 4; ++m) { const f32x4 mm = *(const LAS f32x4*)(XM + (ai * HALF + wr * 64 + m * 16 + fr) * 4);
                const float mx = fmaxf(fmaxf(mm[0], mm[1]), fmaxf(mm[2], mm[3])); float s = 0.f;
#pragma unroll
                for (int bj = 0; bj < 2; ++bj)
#pragma unroll
                    for (int n = 0; n < 2; ++n)
#pragma unroll
                        for (int i = 0; i < 4; ++i) { const float e = __expf(acc[ai][bj][m][n][i] - mx); acc[ai][bj][m][n][i] = e; s += e; }
                s += __shfl_xor(s, 16); s += __shfl_xor(s, 32);
                if (fq == 0) XS[(ai * HALF + wr * 64 + m * 16 + fr) * 4 + wc] = s; }
        LDS_WAIT(); __builtin_amdgcn_s_barrier(); asm volatile("" ::: "memory");
        const int row0 = u.pm * BM + wr * 64 + fr, col0 = wc * 32 + 8 * fq; bf16_t* base = O + coff;
#pragma unroll
        for (int ai = 0; ai < 2; ++ai)
#pragma unroll
            for (int m = 0; m < 4; ++m) { const f32x4 ss = *(const LAS f32x4*)(XS + (ai * HALF + wr * 64 + m * 16 + fr) * 4);
                const float inv = frcp((ss[0] + ss[1]) + (ss[2] + ss[3])); bf16_t* rowp = base + (size_t)(row0 + ai * HALF + m * 16) * ldc + col0;
#pragma unroll
                for (int bj = 0; bj < 2; ++bj) { const f32x4 v0 = acc[ai][bj][m][0] * inv, v1 = acc[ai][bj][m][1] * inv;
                    u32x4 w; w.x = cvt_pk_bf16(v0[0], v0[1]); w.y = cvt_pk_bf16(v0[2], v0[3]); w.z = cvt_pk_bf16(v1[0], v1[1]); w.w = cvt_pk_bf16(v1[2], v1[3]);
                    *(u32x4*)(rowp + bj * HALF) = w; } }
    }
};

struct EpiSoftmaxPS {
    const float* PS;
    static constexpr bool PERM = true, PSLDS = true;
    bf16_t* O; int ldc;
    __device__ __forceinline__ void operator()(f32x4 (&acc)[2][2][4][2], const Unit& u, long coff, int wr, int wc, int fr, int fq, LAS unsigned char* xl) const {
        LAS float* XM = (LAS float*)xl; LAS float* XS = (LAS float*)(xl + 4096);
        { float rs[2][4]; row_scales_lds((const LAS float*)(xl + 8192), wr * 64 + fr, fq, rs);
#pragma unroll
          for (int ai = 0; ai < 2; ++ai)
#pragma unroll
              for (int m = 0; m < 4; ++m)
#pragma unroll
                  for (int bj = 0; bj < 2; ++bj)
#pragma unroll
                      for (int n = 0; n < 2; ++n) acc[ai][bj][m][n] = acc[ai][bj][m][n] * rs[ai][m]; }
#pragma unroll
        for (int ai = 0; ai < 2; ++ai)
#pragma unroll
            for (int m = 0; m < 4; ++m) { float mx = -3.0e38f;
#pragma unroll
                for (int bj = 0; bj < 2; ++bj)
#pragma unroll
                    for (int n = 0; n < 2; ++n)
#pragma unroll
                        for (int i = 0; i < 4; ++i) mx = fmaxf(mx, acc[ai][bj][m][n][i]);
                mx = fmaxf(mx, __shfl_xor(mx, 16)); mx = fmaxf(mx, __shfl_xor(mx, 32));
                if (fq == 0) XM[(ai * HALF + wr * 64 + m * 16 + fr) * 4 + wc] = mx; }
        LDS_WAIT(); __builtin_amdgcn_s_barrier(); asm volatile("" ::: "memory");
#pragma unroll
        for (int ai = 0; ai < 2; ++ai)
#pragma unroll
            for (int m = 0; m < 4; ++m) { const f32x4 mm = *(const LAS f32x4*)(XM + (ai * HALF + wr * 64 + m * 16 + fr) * 4);
                const float mx = fmaxf(fmaxf(mm[0], mm[1]), fmaxf(mm[2], mm[3])); float s = 0.f;
#pragma unroll
                for (int bj = 0; bj < 2; ++bj)
#pragma unroll
                    for (int n = 0; n < 2; ++n)
#pragma unroll
                        for (int i = 0; i < 4; ++i) { const float e = __expf(acc[ai][bj][m][n][i] - mx); acc[ai][bj][m][n][i] = e; s += e; }
                s += __shfl_xor(s, 16); s += __shfl_xor(s, 32);
                if (fq == 0) XS[(ai * HALF + wr * 64 + m * 16 + fr) * 4 + wc] = s; }
        LDS_WAIT(); __builtin_amdgcn_s_barrier(); asm volatile("" ::: "memory");
        const int row0 = u.pm * BM + wr * 64 + fr, col0 = wc * 32 + 8 * fq; bf16_t* base = O + coff;
#pragma unroll
        for (int ai = 0; ai < 2; ++ai)
#pragma unroll
            for (int m = 0; m < 4; ++m) { const f32x4 ss = *(const LAS f32x4*)(XS + (ai * HALF + wr * 64 + m * 16 + fr) * 4);
                const float inv = frcp((ss[0] + ss[1]) + (ss[2] + ss[3])); bf16_t* rowp = base + (size_t)(row0 + ai * HALF + m * 16) * ldc + col0;
#pragma unroll
                for (int bj = 0; bj < 2; ++bj) { const f32x4 v0 = acc[ai][bj][m][0] * inv, v1 = acc[ai][bj][m][1] * inv;
                    u32x4 w; w.x = cvt_pk_bf16(v0[0], v0[1]); w.y = cvt_pk_bf16(v0[2], v0[3]); w.z = cvt_pk_bf16(v1[0], v1[1]); w.w = cvt_pk_bf16(v1[2], v1[3]);
                    *(u32x4*)(rowp + bj * HALF) = w; } }
    }
};

template <class Epi, bool ALIGN_EPI>
__device__ __forceinline__ void gemm_phase(LAS unsigned char* lds, LAS unsigned char* xl, const Gemm g, const Order& S, Epi& E) {
    const int tid = threadIdx.x, wid = __builtin_amdgcn_readfirstlane(tid >> 6), lane = tid & 63, wr = wid >> 2, wc = wid & 3, fr = lane & 15, fq = lane >> 4;
    const int K = g.K, nt = K / BK;
    unsigned voffA[2], voffB[2];
#pragma unroll
    for (int i = 0; i < 2; ++i) { int R, C; stage_rc(tid * 16 + i * 8192, R, C); const int Rb = Epi::PERM ? ((R & ~31) + perm32(R & 31)) : R;
        voffA[i] = (unsigned)(R * g.lda + C) * 2u; voffB[i] = (unsigned)(Rb * g.ldb + C) * 2u; }
    const size_t kstep = (size_t)(BK * 2);
    const size_t hstepA = (size_t)HALF * g.lda * 2, hstepB = (size_t)HALF * g.ldb * 2;
    const unsigned ldsw = (unsigned)wid * 1024u;
    const int aoff = lds_byte(wr * 64 + fr, fq * 8), boff = lds_byte(wc * 32 + fr, fq * 8);
#define PG8_SA(b, h) (((b) * 2 + (h)) * HTB)
#define PG8_SB(b, h) ((4 + (b) * 2 + (h)) * HTB)
#define PG8_STAGE(bufoff, gbase, voff) do { _Pragma("unroll") for (int _i = 0; _i < 2; ++_i) \
        __builtin_amdgcn_global_load_lds((const unsigned*)((const char*)(gbase) + (voff)[_i]), (LAS unsigned*)(lds + (bufoff) + ldsw + _i * 8192), 16, 0, 0); } while (0)
#define PG8_LDA(dst, b, h) do { _Pragma("unroll") for (int m = 0; m < 4; ++m) _Pragma("unroll") for (int k = 0; k < 2; ++k) dst[m][k] = *(const LAS bf16x8*)(lds + PG8_SA(b, h) + aoff + m * 2048 + k * 1024); } while (0)
#define PG8_LDB(dst, b, h) do { _Pragma("unroll") for (int n = 0; n < 2; ++n) _Pragma("unroll") for (int k = 0; k < 2; ++k) dst[n][k] = *(const LAS bf16x8*)(lds + PG8_SB(b, h) + boff + n * 2048 + k * 1024); } while (0)
#define PG8_MMA(ai, bj, At, Bt) do { __builtin_amdgcn_s_setprio(1); _Pragma("unroll") for (int m = 0; m < 4; ++m) _Pragma("unroll") for (int n = 0; n < 2; ++n) _Pragma("unroll") for (int k = 0; k < 2; ++k) \
        acc[ai][bj][m][n] = __builtin_amdgcn_mfma_f32_16x16x32_bf16(Bt[n][k], At[m][k], acc[ai][bj][m][n], 0, 0, 0); __builtin_amdgcn_s_setprio(0); } while (0)
#define PG8_WAIT_V(n) asm volatile("s_waitcnt vmcnt(" #n ")" ::: "memory")
#define PG8_WAIT_L(n) asm volatile("s_waitcnt lgkmcnt(" #n ")" ::: "memory")
#define PG8_BAR __builtin_amdgcn_s_barrier()
#define PG8_SCHED __builtin_amdgcn_sched_barrier(0)
    Unit cur, nxt; int ui = 0;
    if (!S.next(0, cur)) return;
    f32x4 acc[2][2][4][2];
#pragma unroll
    for (int a = 0; a < 2; ++a)
#pragma unroll
        for (int b = 0; b < 2; ++b)
#pragma unroll
            for (int m = 0; m < 4; ++m)
#pragma unroll
                for (int n = 0; n < 2; ++n) acc[a][b][m][n] = (f32x4){0.f, 0.f, 0.f, 0.f};
    bf16x8 At[4][2], B0[2][2], B1[2][2];
    const char* cA = (const char*)g.A + 2 * g.offA(cur); const char* cB = (const char*)g.Bt + 2 * g.offB(cur);
    PG8_STAGE(PG8_SB(0, 0), cB, voffB); PG8_STAGE(PG8_SB(0, 1), cB + hstepB, voffB); PG8_STAGE(PG8_SA(0, 0), cA, voffA); PG8_STAGE(PG8_SA(0, 1), cA + hstepA, voffA);
    if (wr == 1) PG8_BAR;
    PG8_WAIT_V(2); PG8_BAR;
    PG8_STAGE(PG8_SB(1, 0), cB + kstep, voffB); PG8_STAGE(PG8_SA(1, 0), cA + kstep, voffA); PG8_STAGE(PG8_SB(1, 1), cB + hstepB + kstep, voffB);
    PG8_WAIT_V(6); PG8_BAR;
    for (;;) {
        const bool has_next = S.next(ui + 1, nxt);
        const char* nA = has_next ? (const char*)g.A + 2 * g.offA(nxt) : cA; const char* nB = has_next ? (const char*)g.Bt + 2 * g.offB(nxt) : cB;
        for (int t = 0; t < nt; t += 2) {
            const bool last = (t == nt - 2);
            const char* a1 = cA + (size_t)(t + 1) * kstep;
            const char* a2 = last ? nA : cA + (size_t)(t + 2) * kstep; const char* b2 = last ? nB : cB + (size_t)(t + 2) * kstep;
            const char* a3 = a2 + kstep; const char* b3 = b2 + kstep;
            if constexpr (Epi::PSLDS) { if (last) {
                const char* psrc = (const char*)(E.PS + (size_t)((cur.z / g.zdiv) * g.psz + cur.pm) * (BM * 16)) + tid * 16;
#pragma unroll
                for (int _i = 0; _i < 2; ++_i) __builtin_amdgcn_global_load_lds((const unsigned*)(psrc + _i * 8192), (LAS unsigned*)(xl + 8192 + ldsw + _i * 8192), 16, 0, 0); } }
            PG8_LDB(B0, 0, 0); PG8_LDB(B1, 0, 1); PG8_SCHED; PG8_LDA(At, 0, 0); PG8_STAGE(PG8_SA(1, 1), a1 + hstepA, voffA);
            PG8_WAIT_V(8); PG8_WAIT_L(0); PG8_BAR; PG8_MMA(0, 0, At, B0); PG8_MMA(0, 1, At, B1); PG8_BAR; PG8_SCHED;
            PG8_LDA(At, 0, 1); PG8_STAGE(PG8_SB(0, 0), b2, voffB); PG8_STAGE(PG8_SB(0, 1), b2 + hstepB, voffB); PG8_STAGE(PG8_SA(0, 0), a2, voffA);
            PG8_WAIT_V(8); PG8_WAIT_L(0); PG8_BAR; PG8_MMA(1, 0, At, B0); PG8_MMA(1, 1, At, B1); PG8_BAR; PG8_SCHED;
            PG8_LDB(B0, 1, 0); PG8_LDB(B1, 1, 1); PG8_SCHED; PG8_LDA(At, 1, 0); PG8_STAGE(PG8_SA(0, 1), a2 + hstepA, voffA);
            PG8_WAIT_V(8); PG8_WAIT_L(0); PG8_BAR; PG8_MMA(0, 0, At, B0); PG8_MMA(0, 1, At, B1); PG8_BAR; PG8_SCHED;
            PG8_LDA(At, 1, 1); PG8_STAGE(PG8_SB(1, 0), b3, voffB); PG8_STAGE(PG8_SB(1, 1), b3 + hstepB, voffB); PG8_STAGE(PG8_SA(1, 0), a3, voffA);
            PG8_WAIT_V(8); PG8_WAIT_L(0); PG8_BAR; PG8_MMA(1, 0, At, B0); PG8_MMA(1, 1, At, B1); PG8_BAR; PG8_SCHED;
        }
        if constexpr (ALIGN_EPI) { if (wr == 0) PG8_BAR; }
        E(acc, cur, g.offC(cur), wr, wc, fr, fq, xl);
        if (!has_next) break;
#pragma unroll
        for (int a = 0; a < 2; ++a)
#pragma unroll
            for (int b = 0; b < 2; ++b)
#pragma unroll
                for (int m = 0; m < 4; ++m)
#pragma unroll
                    for (int n = 0; n < 2; ++n) acc[a][b][m][n] = (f32x4){0.f, 0.f, 0.f, 0.f};
        cur = nxt; cA = nA; cB = nB; ++ui;
        if constexpr (ALIGN_EPI) { if (wr == 1) PG8_BAR; }
    }
    PG8_WAIT_V(0);
    if constexpr (!ALIGN_EPI) { if (wr == 0) PG8_BAR; }
    PG8_BAR;
#undef PG8_SA
#undef PG8_SB
#undef PG8_STAGE
#undef PG8_LDA
#undef PG8_LDB
#undef PG8_MMA
#undef PG8_WAIT_V
#undef PG8_WAIT_L
#undef PG8_BAR
#undef PG8_SCHED
}
}

__device__ __forceinline__ f32x4 mfma16(bf16x8 bfrag, bf16x8 afrag, f32x4 acc) { return __builtin_amdgcn_mfma_f32_16x16x32_bf16(bfrag, afrag, acc, 0, 0, 0); }
__device__ __forceinline__ bf16x8 ldsfrag(const LAS bf16_t* base, int ld, int r0, int k0, int fr, int fq) { return *(const LAS bf16x8*)(base + (r0 + fr) * ld + k0 + fq * 8); }

template <int MODE> __device__ __forceinline__ void transpose_item(const float* W, int K, int N, bf16_t* WT, LAS float* scr, int item, int nblk, int lane, const float* gain = nullptr) {
    const int kb = item / nblk, nb = item % nblk, k0 = 64 * kb, n0 = 32 * nb; const int nsrc = n0 + (lane & 31);
    float wv_[32];
#pragma unroll
    for (int i = 0; i < 32; ++i) { const int kk = 2 * i + (lane >> 5); wv_[i] = (nsrc < N) ? W[(size_t)(k0 + kk) * N + nsrc] : 0.f; }
#pragma unroll
    for (int i = 0; i < 32; ++i) { const int kk = 2 * i + (lane >> 5); scr[kk * 33 + (lane & 31)] = wv_[i] * (gain ? gain[k0 + kk] : 1.f); }
    LDS_WAIT();
    const int c = lane & 7;
#pragma unroll
    for (int j = 0; j < 4; ++j) { const int n = (lane >> 3) + 8 * j; const LAS float* s = scr + (8 * c) * 33 + n;
        u32x4 o; o.x = pk2(s[0 * 33], s[1 * 33]); o.y = pk2(s[2 * 33], s[3 * 33]); o.z = pk2(s[4 * 33], s[5 * 33]); o.w = pk2(s[6 * 33], s[7 * 33]);
        int drow = n0 + n; if (MODE == 1) { const int jn = drow % FFN, isu = drow / FFN; drow = (jn / 128) * 256 + isu * 128 + (jn % 128); }
        *(u32x4*)(WT + (size_t)drow * K + k0 + 8 * c) = o; }
    LDS_WAIT();
}
__device__ __forceinline__ void rms_row_bf16(const float* xrow, const float* gain, bf16_t* orow, int lane) {
    const f32x4* xr = (const f32x4*)xrow + lane; f32x4 v[4]; float s = 0.f;
#pragma unroll
    for (int j = 0; j < 4; ++j) { v[j] = xr[64 * j]; s += (v[j].x * v[j].x + v[j].y * v[j].y) + (v[j].z * v[j].z + v[j].w * v[j].w); }
    const float rs = rsqrtf(wave_sum(s) * (1.f / D) + 1e-6f);
    const f32x4* gr = (const f32x4*)gain + lane; u32x2* o8 = (u32x2*)orow + lane;
#pragma unroll
    for (int j = 0; j < 4; ++j) { const f32x4 g = gr[64 * j]; u32x2 w; w.x = pk2(v[j].x * rs * g.x, v[j].y * rs * g.y); w.y = pk2(v[j].z * rs * g.z, v[j].w * rs * g.w); o8[64 * j] = w; }
}
__device__ __forceinline__ void rms_row2_bf16(const float* xa, const float* xb, const float* gain, bf16_t* oa, bf16_t* ob, int lane) {
    const f32x4* ra = (const f32x4*)xa + lane; const f32x4* rb = (const f32x4*)xb + lane; f32x4 va[4], vb[4]; float sa = 0.f, sb = 0.f;
#pragma unroll
    for (int j = 0; j < 4; ++j) { va[j] = ra[64 * j]; vb[j] = rb[64 * j]; }
#pragma unroll
    for (int j = 0; j < 4; ++j) { sa += (va[j].x * va[j].x + va[j].y * va[j].y) + (va[j].z * va[j].z + va[j].w * va[j].w); sb += (vb[j].x * vb[j].x + vb[j].y * vb[j].y) + (vb[j].z * vb[j].z + vb[j].w * vb[j].w); }
#pragma unroll
    for (int o = 1; o < 64; o <<= 1) { sa += __shfl_xor(sa, o); sb += __shfl_xor(sb, o); }
    const float rsa = rsqrtf(sa * (1.f / D) + 1e-6f), rsb = rsqrtf(sb * (1.f / D) + 1e-6f);
    const f32x4* gr = (const f32x4*)gain + lane; u32x2* pa = (u32x2*)oa + lane; u32x2* pb = (u32x2*)ob + lane;
#pragma unroll
    for (int j = 0; j < 4; ++j) { const f32x4 g = gr[64 * j]; u32x2 w;
        w.x = pk2(va[j].x * rsa * g.x, va[j].y * rsa * g.y); w.y = pk2(va[j].z * rsa * g.z, va[j].w * rsa * g.w); pa[64 * j] = w;
        w.x = pk2(vb[j].x * rsb * g.x, vb[j].y * rsb * g.y); w.y = pk2(vb[j].z * rsb * g.z, vb[j].w * rsb * g.w); pb[64 * j] = w; }
}
__device__ __forceinline__ void rms_rows_phase(const float* X, const float* gain, bf16_t* H, int nrows, int gw, int NGW, int lane) {
    int m = gw;
    for (; m + NGW < nrows; m += 2 * NGW) rms_row2_bf16(X + (size_t)m * D, X + (size_t)(m + NGW) * D, gain, H + (size_t)m * D, H + (size_t)(m + NGW) * D, lane);
    if (m < nrows) rms_row_bf16(X + (size_t)m * D, gain, H + (size_t)m * D, lane);
}

__device__ __forceinline__ void rwkv_chain(LAS unsigned char* lds, int cid, const bf16_t* P0, const float* mu, const float* w0, const float* w2, const float* a0, const float* a2,
                                           const float* k_k, const float* k_a, const float* r_k, bf16_t* ORW, bf16_t* SG, float* BONUS) {
    const int tid = threadIdx.x, lane = tid & 63, wid = tid >> 6, fr = lane & 15, fq = lane >> 4;
    const int b = cid >> 4, h = (cid >> 1) & 7, dir = cid & 1;
    LAS float* rS = (LAS float*)(lds); LAS float* kS = (LAS float*)(lds + 8192); LAS float* vS = (LAS float*)(lds + 16384); LAS float* wS = (LAS float*)(lds + 24576);
    LAS float* nkS = (LAS float*)(lds + 32768); LAS float* bS = (LAS float*)(lds + 40960); LAS float* preA = (LAS float*)(lds + 49152); LAS float* preW = (LAS float*)(lds + 57344);
    LAS bf16_t* adB = (LAS bf16_t*)(lds + 65536); LAS bf16_t* wdB = (LAS bf16_t*)(lds + 70144);
    LAS bf16_t* a2B = (LAS bf16_t*)(lds + 74752); LAS bf16_t* w2B = (LAS bf16_t*)(lds + 83968); LAS float* cst = (LAS float*)(lds + 93184);
    LAS bf16_t* At = (LAS bf16_t*)(lds + 97280); LAS bf16_t* Bt = (LAS bf16_t*)(lds + 101888); LAS bf16_t* Kt = (LAS bf16_t*)(lds + 106496); LAS bf16_t* Rt = (LAS bf16_t*)(lds + 111104);
    LAS bf16_t* BtT = (LAS bf16_t*)(lds + 115712); LAS bf16_t* KtT = (LAS bf16_t*)(lds + 120832); LAS bf16_t* VT = (LAS bf16_t*)(lds + 125952); LAS bf16_t* S0b = (LAS bf16_t*)(lds + 131072);
    LAS float* NT4 = (LAS float*)(lds + 140288); LAS bf16_t* NakT = (LAS bf16_t*)(lds + 146432); LAS bf16_t* MbrT = (LAS bf16_t*)(lds + 148992); LAS bf16_t* MkrT = (LAS bf16_t*)(lds + 151552);
    LAS float* gL = (LAS float*)(lds + 154112);
    LAS float* WS = preA;
    LAS bf16_t* Ub = (LAS bf16_t*)preW;
#define RW_IDS int tid_o = threadIdx.x; asm volatile("" : "+v"(tid_o)); const int tid = tid_o, lane = tid & 63, wid = __builtin_amdgcn_readfirstlane(tid >> 6), fr = lane & 15, fq = lane >> 4, vt = wid >> 1, tt2 = wid & 1; (void)lane; (void)wid; (void)fr; (void)fq; (void)vt; (void)tt2;
    __syncthreads();
    for (int e = tid; e < 64 * 64; e += 512) { const int j = e & 63, r = e >> 6;
        a2B[j * 72 + r] = (bf16_t)f2bf(a2[r * 512 + h * 64 + j]); w2B[j * 72 + r] = (bf16_t)f2bf(w2[(dir * 64 + r) * 512 + h * 64 + j]); }
    for (int e = tid; e < 64 * 72 / 2; e += 512) ((LAS unsigned*)S0b)[e] = 0u;
    if (tid < 64) { const int j = tid, c = h * 64 + j;
        cst[0 * 64 + j] = a0[c]; cst[1 * 64 + j] = w0[dir * 512 + c]; cst[2 * 64 + j] = k_k[c]; cst[3 * 64 + j] = k_a[c]; cst[4 * 64 + j] = r_k[c];
        cst[5 * 64 + j] = mu[c]; cst[6 * 64 + j] = mu[512 + c]; cst[7 * 64 + j] = mu[1024 + c]; cst[8 * 64 + j] = mu[1536 + j]; cst[9 * 64 + j] = mu[1600 + j];
        cst[10 * 64 + j] = (j < 16) ? mu[1664 + h * 16 + j] : 0.f; }
    const int vt = wid >> 1, tt2 = wid & 1;
    f32x4 st[2]; st[0] = (f32x4){0.f, 0.f, 0.f, 0.f}; st[1] = st[0];
    __syncthreads();
    const bf16_t* Pb = P0 + (size_t)b * SEQ * ABPAD;
    unsigned rc[10], rpv[10], rnx[10]; unsigned short gcv = 0, gpv = 0, gnv = 0;
#define RW_IDX(i) const int grp = (i) >> 1; const int idx_ = tid + 512 * ((i) & 1); const int tok = idx_ >> 5, c2 = (idx_ & 31) * 2; \
                  const int gcol = (grp == 0 ? h * 64 : grp == 1 ? 512 + h * 64 : grp == 2 ? 1024 + h * 64 : grp == 3 ? 1536 : 1600) + c2;
    const unsigned voff = (unsigned)((((int)threadIdx.x >> 5) * ABPAD + ((int)threadIdx.x & 31) * 2) * 2);
#define RW_CG(g) ((g) == 0 ? h * 128 : (g) == 1 ? 1024 + h * 128 : (g) == 2 ? 2048 + h * 128 : (g) == 3 ? 3072 : 3200)
#define RW_ISSUE(t0n) do { const char* bp_ = (const char*)(Pb + (size_t)(t0n) * ABPAD); const bool first_ = ((t0n) == 0) && (tid < 32), last_ = ((t0n) == SEQ - 32) && (tid >= 480); \
        _Pragma("unroll") for (int i = 0; i < 10; ++i) { const char* p = bp_ + (RW_CG(i >> 1) + (i & 1) * 16 * ABPAD * 2) + voff; \
            rc[i] = *(const unsigned*)p; \
            if ((i & 1) == 0) { const unsigned v_ = *(const unsigned*)(p - (first_ ? 0 : ABPAD * 2)); rpv[i] = first_ ? 0u : v_; rnx[i] = *(const unsigned*)(p + ABPAD * 2); } \
            else { const unsigned v_ = *(const unsigned*)(p + (last_ ? 0 : ABPAD * 2)); rnx[i] = last_ ? 0u : v_; rpv[i] = *(const unsigned*)(p - ABPAD * 2); } } \
        if (dir == 0) { const bool fg_ = ((t0n) == 0) && (tid < 16), lg_ = ((t0n) == SEQ - 32) && (tid >= 496); \
            const bf16_t* p = (const bf16_t*)bp_ + (size_t)(tid >> 4) * ABPAD + 1664 + h * 16 + (tid & 15); \
            gcv = *p; { const unsigned short v_ = *(p - (fg_ ? 0 : ABPAD)); gpv = fg_ ? (unsigned short)0 : v_; } { const unsigned short v_ = *(p + (lg_ ? 0 : ABPAD)); gnv = lg_ ? (unsigned short)0 : v_; } } } while (0)
    RW_ISSUE(dir ? 127 * 32 : 0);
    for (int cc = 0; cc < 128; ++cc) {
        const int t0 = dir ? (127 - cc) * 32 : cc * 32;
        { RW_IDS
#pragma unroll
        for (int i = 0; i < 10; ++i) { RW_IDX(i) (void)gcol;
            const unsigned cur = rc[i], prv = rpv[i], nxt = rnx[i];
            const float m0 = cst[(5 + grp) * 64 + c2], m1 = cst[(5 + grp) * 64 + c2 + 1];
            const float c0 = bflo(cur), c1 = bfhi(cur);
            const float x0 = c0 + m0 * (0.5f * (bflo(prv) + bflo(nxt)) - c0), x1 = c1 + m1 * (0.5f * (bfhi(prv) + bfhi(nxt)) - c1);
            if (grp == 0) { *(LAS f32x2*)(rS + tok * 64 + c2) = (f32x2){x0, x1}; }
            else if (grp == 1) { *(LAS f32x2*)(kS + tok * 64 + c2) = (f32x2){x0, x1}; }
            else if (grp == 2) { *(LAS f32x2*)(vS + tok * 64 + c2) = (f32x2){x0, x1}; }
            else if (grp == 3) { const float e0 = __expf(2.f * x0), e1 = __expf(2.f * x1); *(LAS unsigned*)(wdB + tok * 72 + c2) = pk2(1.f - 2.f * frcp(e0 + 1.f), 1.f - 2.f * frcp(e1 + 1.f)); }
            else { *(LAS unsigned*)(adB + tok * 72 + c2) = pk2(x0, x1); }
        }
        if (dir == 0) {
            const int tok = tid >> 4, c = tid & 15, t = t0 + tok;
            const float cur = bf2f(gcv), prv = bf2f(gpv), nxt = bf2f(gnv);
            const float x = cur + cst[10 * 64 + c] * (0.5f * (prv + nxt) - cur);
            SG[((size_t)b * SEQ + t) * 128 + h * 16 + c] = (bf16_t)f2bf(sigmoidf_(x));
        } }
        __syncthreads();
        if (cc + 1 < 128) { RW_IDS const int t0n = dir ? (126 - cc) * 32 : (cc + 1) * 32; RW_ISSUE(t0n); }
        { RW_IDS const int mat = wid >> 2, ntile = wid & 3; const LAS bf16_t* Aop = mat ? wdB : adB; const LAS bf16_t* Bop = mat ? w2B : a2B; LAS float* pre = mat ? preW : preA;
#pragma unroll
          for (int mt = 0; mt < 2; ++mt) { f32x4 acc = (f32x4){0.f, 0.f, 0.f, 0.f};
#pragma unroll
              for (int ks = 0; ks < 2; ++ks) acc = mfma16(ldsfrag(Bop, 72, ntile * 16, ks * 32, fr, fq), ldsfrag(Aop, 72, mt * 16, ks * 32, fr, fq), acc);
              *(LAS f32x4*)(pre + (mt * 16 + fr) * 64 + ntile * 16 + fq * 4) = acc; } }
        __syncthreads();
        { RW_IDS const int tok = tid >> 4, c0 = (tid & 15) * 4; float kkr[4], av[4], kp[4], wv[4]; float ss = 0.f, bon = 0.f;
#pragma unroll
          for (int i = 0; i < 4; ++i) { const int c = c0 + i, ix = tok * 64 + c;
              const float a = sigmoidf_(cst[c] + preA[ix]); const float sg = sigmoidf_(cst[64 + c] + preW[ix]);
              wv[i] = -0.60653065971f * sg;
              const float kraw = kS[ix]; kkr[i] = kraw * cst[128 + c]; ss += kkr[i] * kkr[i];
              kp[i] = kraw * (1.0f + (a - 1.0f) * cst[192 + c]); av[i] = a; bon += rS[ix] * kp[i] * cst[256 + c]; }
          ss += dppf<0xB1>(ss); bon += dppf<0xB1>(bon); ss += dppf<0x4E>(ss); bon += dppf<0x4E>(bon);
          ss += dppf<0x141>(ss); bon += dppf<0x141>(bon); ss += dppf<0x140>(ss); bon += dppf<0x140>(bon);
          const float inv = frcp(fmaxf(__builtin_amdgcn_sqrtf(ss), 1e-12f));
          f32x4 o_nk, o_b, o_k, o_w;
#pragma unroll
          for (int i = 0; i < 4; ++i) { const float kk = kkr[i] * inv; o_nk[i] = -kk; o_b[i] = kk * av[i]; o_k[i] = kp[i]; o_w[i] = wv[i]; }
          *(LAS f32x4*)(nkS + tok * 64 + c0) = o_nk; *(LAS f32x4*)(bS + tok * 64 + c0) = o_b; *(LAS f32x4*)(kS + tok * 64 + c0) = o_k; *(LAS f32x4*)(wS + tok * 64 + c0) = o_w;
          if (dir == 0 && (tid & 15) == 0) BONUS[((size_t)b * SEQ + t0 + tok) * 8 + h] = bon; }
        __syncthreads();
        { RW_IDS if (tid < 64) { float lw[32];
#pragma unroll
            for (int s = 0; s < 32; ++s) lw[s] = wS[(dir ? 31 - s : s) * 64 + tid];
#pragma unroll
            for (int s = 1; s < 32; ++s) lw[s] += lw[s - 1];
#pragma unroll
            for (int s = 0; s < 32; ++s) wS[(dir ? 31 - s : s) * 64 + tid] = lw[s]; } }
        __syncthreads();
        { RW_IDS const int s = tid >> 4, c0 = (tid & 15) * 4; const int tok = dir ? 31 - s : s, tokp = dir ? tok + 1 : tok - 1;
          const f32x4 cum = *(const LAS f32x4*)(wS + tok * 64 + c0); f32x4 cump = (f32x4){0.f, 0.f, 0.f, 0.f}; if (s > 0) cump = *(const LAS f32x4*)(wS + tokp * 64 + c0);
          const f32x4 nk4 = *(const LAS f32x4*)(nkS + tok * 64 + c0), b4 = *(const LAS f32x4*)(bS + tok * 64 + c0), k4 = *(const LAS f32x4*)(kS + tok * 64 + c0), r4 = *(const LAS f32x4*)(rS + tok * 64 + c0), v4 = *(const LAS f32x4*)(vS + tok * 64 + c0);
          float ta[4], tb[4], tk[4], tr[4];
#pragma unroll
          for (int i = 0; i < 4; ++i) { const float g = __expf(cum[i]), gp = __expf(cump[i]), ig = __expf(-cum[i]);
              ta[i] = nk4[i] * gp; tb[i] = b4[i] * ig; tk[i] = k4[i] * ig; tr[i] = r4[i] * g;
              BtT[(c0 + i) * 40 + s] = (bf16_t)f2bf(tb[i]); KtT[(c0 + i) * 40 + s] = (bf16_t)f2bf(tk[i]); VT[(c0 + i) * 40 + s] = (bf16_t)f2bf(v4[i]);
              if (s == 31) gL[c0 + i] = g; }
          u32x2 w; w.x = pk2(ta[0], ta[1]); w.y = pk2(ta[2], ta[3]); *(LAS u32x2*)(At + s * 72 + c0) = w;
          w.x = pk2(tb[0], tb[1]); w.y = pk2(tb[2], tb[3]); *(LAS u32x2*)(Bt + s * 72 + c0) = w;
          w.x = pk2(tk[0], tk[1]); w.y = pk2(tk[2], tk[3]); *(LAS u32x2*)(Kt + s * 72 + c0) = w;
          w.x = pk2(tr[0], tr[1]); w.y = pk2(tr[2], tr[3]); *(LAS u32x2*)(Rt + s * 72 + c0) = w; }
        __syncthreads();
        { RW_IDS const int mat = wid >> 1, mt = wid & 1; const LAS bf16_t* Aop = (mat < 2) ? At : Rt; const LAS bf16_t* Bop = (mat & 1) ? Kt : Bt;
#pragma unroll
          for (int nt = 0; nt < 2; ++nt) { f32x4 acc = (f32x4){0.f, 0.f, 0.f, 0.f};
#pragma unroll
              for (int ks = 0; ks < 2; ++ks) acc = mfma16(ldsfrag(Bop, 72, nt * 16, ks * 32, fr, fq), ldsfrag(Aop, 72, mt * 16, ks * 32, fr, fq), acc);
              const int srow = mt * 16 + fr;
#pragma unroll
              for (int e = 0; e < 4; ++e) { const int i = nt * 16 + fq * 4 + e; const bool keep = (mat < 2) ? (i < srow) : (i <= srow); if (!keep) acc[e] = 0.f; }
              if (mat == 0) {
#pragma unroll
                  for (int e = 0; e < 4; ++e) NT4[e * 384 + srow * 12 + nt * 4 + fq] = acc[e]; }
              else { LAS bf16_t* X = (mat == 1) ? NakT : (mat == 2) ? MbrT : MkrT; u32x2 o; o.x = pk2(acc[0], acc[1]); o.y = pk2(acc[2], acc[3]); *(LAS u32x2*)(X + srow * 40 + nt * 16 + fq * 4) = o; } } }
        __syncthreads();
        f32x4 oacc = (f32x4){0.f, 0.f, 0.f, 0.f};
        { RW_IDS f32x4 wacc = (f32x4){0.f, 0.f, 0.f, 0.f};
#pragma unroll
          for (int ks = 0; ks < 2; ++ks) { const bf16x8 sf = ldsfrag(S0b, 72, vt * 16, ks * 32, fr, fq);
              wacc = mfma16(ldsfrag(At, 72, tt2 * 16, ks * 32, fr, fq), sf, wacc); oacc = mfma16(ldsfrag(Rt, 72, tt2 * 16, ks * 32, fr, fq), sf, oacc); }
          const bf16x8 vf = ldsfrag(VT, 40, vt * 16, 0, fr, fq);
          wacc = mfma16(ldsfrag(NakT, 40, tt2 * 16, 0, fr, fq), vf, wacc); oacc = mfma16(ldsfrag(MkrT, 40, tt2 * 16, 0, fr, fq), vf, oacc);
#pragma unroll
          for (int n2 = 0; n2 < 2; ++n2) st[n2] = mfma16(ldsfrag(KtT, 40, (tt2 * 2 + n2) * 16, 0, fr, fq), vf, st[n2]);
#pragma unroll
          for (int e = 0; e < 4; ++e) WS[(tt2 * 16 + fq * 4 + e) * 64 + vt * 16 + fr] = wacc[e]; }
        __syncthreads();
        { RW_IDS if (wid < 4) { const int v = wid * 16 + (lane >> 2), p = lane & 3; const LAS float* NTp = NT4 + p * 384; float u[8];
#pragma unroll
            for (int j = 0; j < 8; ++j) u[j] = 0.f;
#pragma unroll
            for (int t = 0; t < 32; ++t) { float q0 = (p == 0) ? WS[t * 64 + v] : 0.f, q1 = 0.f;
#pragma unroll
                for (int j4 = 0; j4 < ((t + 3) / 4 + 3) / 4; ++j4) { const f32x4 nv = *(const LAS f32x4*)(NTp + t * 12 + j4 * 4);
                    q0 += u[j4 * 4] * nv[0]; q1 += u[j4 * 4 + 1] * nv[1]; q0 += u[j4 * 4 + 2] * nv[2]; q1 += u[j4 * 4 + 3] * nv[3]; }
                float q = q0 + q1; q += dppf<0xB1>(q); q += dppf<0x4E>(q);
                u[t >> 2] = ((t & 3) == p) ? q : u[t >> 2]; asm volatile("" ::: "memory"); }
#pragma unroll
            for (int j = 0; j < 8; ++j) Ub[v * 40 + 4 * j + p] = (bf16_t)f2bf(u[j]); } }
        __syncthreads();
        { RW_IDS const bf16x8 uf = ldsfrag(Ub, 40, vt * 16, 0, fr, fq);
          oacc = mfma16(ldsfrag(MbrT, 40, tt2 * 16, 0, fr, fq), uf, oacc);
#pragma unroll
          for (int e = 0; e < 4; ++e) { const int sidx = tt2 * 16 + fq * 4 + e, tok = dir ? 31 - sidx : sidx;
              ORW[(size_t)dir * T * 512 + ((size_t)b * SEQ + t0 + tok) * 512 + h * 64 + vt * 16 + fr] = (bf16_t)f2bf(oacc[e]); }
#pragma unroll
          for (int n2 = 0; n2 < 2; ++n2) { const int kt = tt2 * 2 + n2; st[n2] = mfma16(ldsfrag(BtT, 40, kt * 16, 0, fr, fq), uf, st[n2]);
              const f32x4 gl = *(const LAS f32x4*)(gL + kt * 16 + fq * 4); st[n2] = st[n2] * gl;
              u32x2 o; o.x = pk2(st[n2][0], st[n2][1]); o.y = pk2(st[n2][2], st[n2][3]); *(LAS u32x2*)(S0b + (vt * 16 + fr) * 72 + kt * 16 + fq * 4) = o; } }
    }
#undef RW_IDX
#undef RW_ISSUE
#undef RW_IDS
#undef RW_CG
    __syncthreads();
}

__device__ __forceinline__ void rwkv_combine(const bf16_t* P0, const bf16_t* ORW, const float* BONUS, const bf16_t* G, const float* mu, const float* gn_w, const float* gn_b, bf16_t* OMIX, int gw, int NGW, int lane) {
    const int c0 = lane * 8, head = lane >> 3;
    float muv[8], gw8[8], gb8[8];
#pragma unroll
    for (int i = 0; i < 8; ++i) { muv[i] = mu[1024 + c0 + i]; gw8[i] = gn_w[c0 + i]; gb8[i] = gn_b[c0 + i]; }
    for (int tk0 = gw; tk0 < T; tk0 += 2 * NGW) {
        u32x4 uf[2], ub[2], vc[2], vp[2], vn[2], gg[2]; float bon[2];
#pragma unroll
        for (int r2 = 0; r2 < 2; ++r2) { const int tk = tk0 + r2 * NGW; if (tk < T) { const int t = tk & (SEQ - 1);
            uf[r2] = *(const u32x4*)(ORW + (size_t)tk * 512 + c0); ub[r2] = *(const u32x4*)(ORW + (size_t)T * 512 + (size_t)tk * 512 + c0);
            const bf16_t* pv = P0 + (size_t)tk * ABPAD + 1024 + c0;
            vc[r2] = *(const u32x4*)pv; vp[r2] = (u32x4){0u, 0u, 0u, 0u}; vn[r2] = (u32x4){0u, 0u, 0u, 0u};
            if (t > 0) vp[r2] = *(const u32x4*)(pv - ABPAD);
            if (t < SEQ - 1) vn[r2] = *(const u32x4*)(pv + ABPAD);
            gg[r2] = *(const u32x4*)(G + (size_t)tk * 512 + c0); bon[r2] = BONUS[(size_t)tk * 8 + head]; } }
#pragma unroll
        for (int r2 = 0; r2 < 2; ++r2) { const int tk = tk0 + r2 * NGW; if (tk < T) {
            float o[8];
#pragma unroll
            for (int i = 0; i < 4; ++i) { o[2 * i] = bflo(uf[r2][i]) + bflo(ub[r2][i]); o[2 * i + 1] = bfhi(uf[r2][i]) + bfhi(ub[r2][i]); }
            float s_ = 0.f;
#pragma unroll
            for (int i = 0; i < 8; ++i) s_ += o[i];
            const float mean = sum8(s_) * (1.f / 64.f); float q = 0.f;
#pragma unroll
            for (int i = 0; i < 8; ++i) { o[i] -= mean; q += o[i] * o[i]; }
            const float rstd = rsqrtf(sum8(q) * (1.f / 64.f) + 64e-5f);
            float r[8];
#pragma unroll
            for (int i = 0; i < 4; ++i) {
                const float c_lo = bflo(vc[r2][i]), c_hi = bfhi(vc[r2][i]);
                const float v_lo = c_lo + muv[2 * i] * (0.5f * (bflo(vp[r2][i]) + bflo(vn[r2][i])) - c_lo), v_hi = c_hi + muv[2 * i + 1] * (0.5f * (bfhi(vp[r2][i]) + bfhi(vn[r2][i])) - c_hi);
                r[2 * i] = (o[2 * i] * rstd * gw8[2 * i] + gb8[2 * i] + bon[r2] * v_lo) * bflo(gg[r2][i]);
                r[2 * i + 1] = (o[2 * i + 1] * rstd * gw8[2 * i + 1] + gb8[2 * i + 1] + bon[r2] * v_hi) * bfhi(gg[r2][i]); }
            u32x4 w; w.x = pk2(r[0], r[1]); w.y = pk2(r[2], r[3]); w.z = pk2(r[4], r[5]); w.w = pk2(r[6], r[7]);
            *(u32x4*)(OMIX + (size_t)tk * D + c0) = w; } }
    }
}

constexpr int SLD = 136;
__device__ __forceinline__ float softplusf_(float x) { return x > 20.f ? x : log1pf(__expf(x)); }
__device__ __forceinline__ void ssd_dt_cum(LAS float* dtS, LAS float* cumS, LAS float* totS, const bf16_t* Prow0, int g, int w, int lane, const float* dt_bias, const float* a_log) {
    const int j = w >> 1, d = w & 1, head = g * 4 + j;
    const float bias = dt_bias[d * 8 + head], A = -__expf(a_log[d * 8 + head]);
    const float x0 = bf2f(Prow0[(size_t)(2 * lane) * ABPAD + 3328 + head]), x1 = bf2f(Prow0[(size_t)(2 * lane + 1) * ABPAD + 3328 + head]);
    const float dt0 = softplusf_(x0 + bias), dt1 = softplusf_(x1 + bias), la0 = dt0 * A, la1 = dt1 * A;
    const float s = la0 + la1; float inc = s;
#pragma unroll
    for (int off = 1; off < 64; off <<= 1) { const float n = __shfl_up(inc, off); if (lane >= off) inc += n; }
    const float tot = __shfl(inc, 63), exc = inc - s;
    float c0, c1; if (d == 0) { c0 = exc + la0; c1 = inc; } else { c0 = tot - exc; c1 = tot - exc - la0; }
    dtS[w * 128 + 2 * lane] = dt0; dtS[w * 128 + 2 * lane + 1] = dt1; cumS[w * 128 + 2 * lane] = c0; cumS[w * 128 + 2 * lane + 1] = c1;
    if (lane == 0) totS[w] = tot;
}
template <int NR, bool TR> __device__ __forceinline__ void ssd_conv8(LAS bf16_t* dst, int col0, int cx0, int l0, const bf16_t* Pb, int t0, const float* cw, const float* cb) {
    u32x4 raw[NR + 2];
    const bf16_t* p = Pb + (size_t)(t0 + l0) * ABPAD + 2304 + cx0;
#pragma unroll
    for (int i = 0; i < NR + 2; ++i) { const int t = t0 + l0 + i - 1; raw[i] = (t >= 0 && t < SEQ) ? *(const u32x4*)(p + (long)(i - 1) * ABPAD) : (u32x4){0u, 0u, 0u, 0u}; }
    float w0[8], w1[8], w2[8], bs[8];
#pragma unroll
    for (int q = 0; q < 2; ++q) { const f32x4 a = *(const f32x4*)(cw + cx0 + 4 * q), bq = *(const f32x4*)(cw + 1024 + cx0 + 4 * q), c = *(const f32x4*)(cw + 2048 + cx0 + 4 * q), d = *(const f32x4*)(cb + cx0 + 4 * q);
#pragma unroll
        for (int i = 0; i < 4; ++i) { w0[4 * q + i] = a[i]; w1[4 * q + i] = bq[i]; w2[4 * q + i] = c[i]; bs[4 * q + i] = d[i]; } }
    float o[NR][8];
#pragma unroll
    for (int i = 0; i < NR; ++i)
#pragma unroll
        for (int c = 0; c < 8; ++c) { const unsigned um = raw[i][c >> 1], u0 = raw[i + 1][c >> 1], up = raw[i + 2][c >> 1];
            const float fm = (c & 1) ? bfhi(um) : bflo(um), f0 = (c & 1) ? bfhi(u0) : bflo(u0), fp = (c & 1) ? bfhi(up) : bflo(up);
            o[i][c] = siluf_(w0[c] * fm + w1[c] * f0 + w2[c] * fp + bs[c]); }
    if (TR) {
#pragma unroll
        for (int c = 0; c < 8; ++c) { LAS bf16_t* q = dst + (col0 + c) * SLD + l0;
            if (NR == 8) { u32x4 w; w.x = pk2(o[0][c], o[1][c]); w.y = pk2(o[2][c], o[3][c]); w.z = pk2(o[4 % NR][c], o[5 % NR][c]); w.w = pk2(o[6 % NR][c], o[7 % NR][c]); *(LAS u32x4*)q = w; }
            else { u32x2 w; w.x = pk2(o[0][c], o[1][c]); w.y = pk2(o[2][c], o[3][c]); *(LAS u32x2*)q = w; } }
    } else {
#pragma unroll
        for (int i = 0; i < NR; ++i) { u32x4 w; w.x = pk2(o[i][0], o[i][1]); w.y = pk2(o[i][2], o[i][3]); w.z = pk2(o[i][4], o[i][5]); w.w = pk2(o[i][6], o[i][7]); *(LAS u32x4*)(dst + (l0 + i) * SLD + col0) = w; }
    }
}
__device__ __forceinline__ void ssd_s1_unit(LAS unsigned char* lds, int unit, const bf16_t* P0, const float* cw, const float* cb, const float* dt_bias, const float* a_log, bf16_t* STATES, float* TOT) {
    const int tid = threadIdx.x, lane = tid & 63, w = tid >> 6, fr = lane & 15, fq = lane >> 4;
    const int g = unit & 1, c = (unit >> 1) & 31, b = unit >> 6, t0 = c * 128;
    LAS bf16_t* BT = (LAS bf16_t*)lds; LAS bf16_t* XT = (LAS bf16_t*)(lds + 34816); LAS float* dtS = (LAS float*)(lds + 104448); LAS float* cumS = (LAS float*)(lds + 108544);
    LAS float* scS = (LAS float*)(lds + 112640); LAS float* totS = (LAS float*)(lds + 116736);
    const bf16_t* Pb = P0 + (size_t)b * SEQ * ABPAD;
    __syncthreads();
    ssd_conv8<4, true>(BT, (tid & 15) * 8, 512 + g * 128 + (tid & 15) * 8, (tid >> 4) * 4, Pb, t0, cw, cb);
    ssd_conv8<8, true>(XT, (tid & 31) * 8, g * 256 + (tid & 31) * 8, (tid >> 5) * 8, Pb, t0, cw, cb);
    ssd_dt_cum(dtS, cumS, totS, Pb + (size_t)t0 * ABPAD, g, w, lane, dt_bias, a_log);
    __syncthreads();
    for (int e = tid; e < 1024; e += 512) scS[e] = dtS[e] * __expf(totS[e >> 7] - cumS[e]);
    if (tid < 8) TOT[((size_t)(b * 32 + c) * 2 + (tid & 1)) * 8 + g * 4 + (tid >> 1)] = totS[tid];
    __syncthreads();
    const int j = w >> 1;
#pragma unroll 1
    for (int d = 0; d < 2; ++d) {
        f32x4 acc[2][8];
#pragma unroll
        for (int mt = 0; mt < 2; ++mt)
#pragma unroll
            for (int nt = 0; nt < 8; ++nt) acc[mt][nt] = (f32x4){0.f, 0.f, 0.f, 0.f};
#pragma unroll 1
        for (int ks = 0; ks < 4; ++ks) {
            const int k0 = ks * 32; const LAS float* sp = scS + (j * 2 + d) * 128 + k0 + fq * 8;
            const f32x4 s0 = *(const LAS f32x4*)sp, s1 = *(const LAS f32x4*)(sp + 4);
            bf16x8 afr[2];
#pragma unroll
            for (int mt = 0; mt < 2; ++mt) { const u32x4 raw = *(const LAS u32x4*)(XT + (32 * w + mt * 16 + fr) * SLD + k0 + fq * 8); u32x4 o;
                o.x = pk2(bflo(raw.x) * s0[0], bfhi(raw.x) * s0[1]); o.y = pk2(bflo(raw.y) * s0[2], bfhi(raw.y) * s0[3]);
                o.z = pk2(bflo(raw.z) * s1[0], bfhi(raw.z) * s1[1]); o.w = pk2(bflo(raw.w) * s1[2], bfhi(raw.w) * s1[3]);
                afr[mt] = __builtin_bit_cast(bf16x8, o); }
#pragma unroll
            for (int nt = 0; nt < 8; ++nt) { const bf16x8 bfr = ldsfrag(BT, SLD, nt * 16, k0, fr, fq);
#pragma unroll
                for (int mt = 0; mt < 2; ++mt) acc[mt][nt] = mfma16(bfr, afr[mt], acc[mt][nt]); }
        }
        bf16_t* dst = STATES + (((size_t)(b * 32 + c) * 2 + d) * 8 + g * 4 + j) * 8192;
#pragma unroll
        for (int mt = 0; mt < 2; ++mt) { const int p = (w & 1) * 32 + mt * 16 + fr;
#pragma unroll
            for (int nt = 0; nt < 8; ++nt) { u32x2 o; o.x = pk2(acc[mt][nt][0], acc[mt][nt][1]); o.y = pk2(acc[mt][nt][2], acc[mt][nt][3]);
                *(u32x2*)(dst + p * 128 + nt * 16 + fq * 4) = o; } }
    }
}
__device__ __forceinline__ void ssd_s2(const bf16_t* __restrict__ STATES, bf16_t* __restrict__ CARR, const float* __restrict__ TOT, int gtid, int NGT) {
    for (int it = gtid; it < 16 * 2 * 8 * 1024; it += NGT) {
        const int e8 = it & 1023, head = (it >> 10) & 7, d = (it >> 13) & 1, b = it >> 14;
        float run[8];
#pragma unroll
        for (int i = 0; i < 8; ++i) run[i] = 0.f;
#pragma unroll 1
        for (int c8 = 0; c8 < 32; c8 += 16) {
            u32x4 loc[16]; float dec[16];
#pragma unroll
            for (int q = 0; q < 16; ++q) { const int cc = c8 + q, c = d ? 31 - cc : cc; const size_t sidx = ((size_t)(b * 32 + c) * 2 + d) * 8 + head;
                loc[q] = *(const u32x4*)(STATES + sidx * 8192 + e8 * 8); dec[q] = TOT[sidx]; }
#pragma unroll
            for (int q = 0; q < 16; ++q) { const int cc = c8 + q, c = d ? 31 - cc : cc; const size_t sidx = ((size_t)(b * 32 + c) * 2 + d) * 8 + head;
                u32x4 o; o.x = pk2(run[0], run[1]); o.y = pk2(run[2], run[3]); o.z = pk2(run[4], run[5]); o.w = pk2(run[6], run[7]); *(u32x4*)(CARR + sidx * 8192 + e8 * 8) = o;
                const float dq = __expf(dec[q]);
#pragma unroll
                for (int i = 0; i < 4; ++i) { run[2 * i] = run[2 * i] * dq + bflo(loc[q][i]); run[2 * i + 1] = run[2 * i + 1] * dq + bfhi(loc[q][i]); } }
        }
    }
}
__device__ __forceinline__ void ssd_s3_unit(LAS unsigned char* lds, int unit, const bf16_t* P0, const float* cw, const float* cb, const float* dt_bias, const float* a_log, const float* dskip, const float* norm_w,
                                            const bf16_t* STATES, bf16_t* OMIX) {
    const int tid = threadIdx.x, lane = tid & 63, w = tid >> 6, fr = lane & 15, fq = lane >> 4;
    const int g = unit & 1, c = (unit >> 1) & 31, b = unit >> 6, t0 = c * 128;
    LAS bf16_t* CS = (LAS bf16_t*)lds; LAS bf16_t* BS = (LAS bf16_t*)(lds + 34816); LAS bf16_t* XT = (LAS bf16_t*)(lds + 69632);
    LAS float* dtS = (LAS float*)(lds + 139264); LAS float* cumS = (LAS float*)(lds + 143360); LAS float* totS = (LAS float*)(lds + 147456);
    const bf16_t* Pb = P0 + (size_t)b * SEQ * ABPAD;
    __syncthreads();
    ssd_conv8<4, false>(BS, (tid & 15) * 8, 512 + g * 128 + (tid & 15) * 8, (tid >> 4) * 4, Pb, t0, cw, cb);
    ssd_conv8<4, false>(CS, (tid & 15) * 8, 768 + g * 128 + (tid & 15) * 8, (tid >> 4) * 4, Pb, t0, cw, cb);
    ssd_conv8<8, true>(XT, (tid & 31) * 8, g * 256 + (tid & 31) * 8, (tid >> 5) * 8, Pb, t0, cw, cb);
    ssd_dt_cum(dtS, cumS, totS, Pb + (size_t)t0 * ABPAD, g, w, lane, dt_bias, a_log);
    __syncthreads();
    const int l = 16 * w + fr;
    f32x4 sc[8];
#pragma unroll
    for (int nt = 0; nt < 8; ++nt) sc[nt] = (f32x4){0.f, 0.f, 0.f, 0.f};
#pragma unroll
    for (int ks = 0; ks < 4; ++ks) { const bf16x8 afr = ldsfrag(CS, SLD, 16 * w, ks * 32, fr, fq);
#pragma unroll
        for (int nt = 0; nt < 8; ++nt) sc[nt] = mfma16(ldsfrag(BS, SLD, nt * 16, ks * 32, fr, fq), afr, sc[nt]); }
    __syncthreads();
    LAS bf16_t* Mw = BS + w * 16 * SLD;
    const size_t row = (size_t)b * SEQ + t0 + l; float ss = 0.f;
#pragma unroll 1
    for (int j = 0; j < 4; ++j) {
        const LAS float* cf = cumS + (j * 2) * 128; const LAS float* cbw = cumS + (j * 2 + 1) * 128; const LAS float* df = dtS + (j * 2) * 128; const LAS float* db = dtS + (j * 2 + 1) * 128;
        const float cfl = cf[l], cbl = cbw[l];
        const size_t sbase = ((size_t)(b * 32 + c) * 2) * 8 + g * 4 + j;
        const bf16_t* carf = STATES + sbase * 8192; const bf16_t* carb = STATES + (sbase + 8) * 8192;
        bf16x8 cF[4][4], cB[4][4]; u32x2 zz4[4];
#pragma unroll
        for (int ks = 0; ks < 4; ++ks)
#pragma unroll
            for (int pt = 0; pt < 4; ++pt) cF[ks][pt] = *(const bf16x8*)(carf + (pt * 16 + fr) * 128 + ks * 32 + fq * 8);
#pragma unroll
        for (int pt = 0; pt < 4; ++pt) zz4[pt] = *(const u32x2*)(P0 + row * ABPAD + 1792 + g * 256 + j * 64 + pt * 16 + fq * 4);
#pragma unroll
        for (int nt = 0; nt < 8; ++nt) { float mv[4];
#pragma unroll
            for (int i = 0; i < 4; ++i) { const int s = nt * 16 + fq * 4 + i;
                const float ff = (s <= l) ? __expf(cfl - cf[s]) * df[s] : 0.f; const float fb = (s >= l) ? __expf(cbl - cbw[s]) * db[s] : 0.f;
                mv[i] = sc[nt][i] * (ff + fb); }
            u32x2 o; o.x = pk2(mv[0], mv[1]); o.y = pk2(mv[2], mv[3]); *(LAS u32x2*)(Mw + fr * SLD + nt * 16 + fq * 4) = o; }
        LDS_WAIT();
#pragma unroll
        for (int ks = 0; ks < 4; ++ks)
#pragma unroll
            for (int pt = 0; pt < 4; ++pt) cB[ks][pt] = *(const bf16x8*)(carb + (pt * 16 + fr) * 128 + ks * 32 + fq * 8);
        f32x4 yd[4], yf[4], yb[4];
#pragma unroll
        for (int pt = 0; pt < 4; ++pt) { yd[pt] = (f32x4){0.f, 0.f, 0.f, 0.f}; yf[pt] = yd[pt]; yb[pt] = yd[pt]; }
        bf16x8 acs[4];
#pragma unroll
        for (int ks = 0; ks < 4; ++ks) {
            const bf16x8 am = *(const LAS bf16x8*)(Mw + fr * SLD + ks * 32 + fq * 8); acs[ks] = ldsfrag(CS, SLD, 16 * w, ks * 32, fr, fq);
#pragma unroll
            for (int pt = 0; pt < 4; ++pt) {
                yd[pt] = mfma16(ldsfrag(XT, SLD, j * 64 + pt * 16, ks * 32, fr, fq), am, yd[pt]);
                yf[pt] = mfma16(cF[ks][pt], acs[ks], yf[pt]); }
        }
#pragma unroll
        for (int ks = 0; ks < 4; ++ks)
#pragma unroll
            for (int pt = 0; pt < 4; ++pt) yb[pt] = mfma16(cB[ks][pt], acs[ks], yb[pt]);
        const float ef = __expf(cfl), eb = __expf(cbl), dsk = dskip[g * 4 + j];
#pragma unroll
        for (int pt = 0; pt < 4; ++pt) { const f32x4 yv = yd[pt] + yf[pt] * ef + yb[pt] * eb;
            const int col = j * 64 + pt * 16 + fq * 4; const u32x2 zz = zz4[pt];
            const float z4[4] = {bflo(zz.x), bfhi(zz.x), bflo(zz.y), bfhi(zz.y)}; float v4[4];
#pragma unroll
            for (int i = 0; i < 4; ++i) { const float xs = bf2f(XT[(col + i) * SLD + l]); float v = yv[i] + dsk * xs; const float z = z4[i]; v = v * siluf_(z);
                v4[i] = v; ss += v * v; }
            u32x2 o; o.x = pk2(v4[0], v4[1]); o.y = pk2(v4[2], v4[3]); *(u32x2*)(OMIX + row * D + 512 + g * 256 + col) = o; }
        asm volatile("" ::: "memory");
    }
    ss += __shfl_xor(ss, 16); ss += __shfl_xor(ss, 32);
    const float rs = rsqrtf(ss * (1.f / 256.f) + 1e-6f);
    asm volatile("s_waitcnt vmcnt(0)" ::: "memory");
#pragma unroll 4
    for (int q = 0; q < 16; ++q) { const int col = g * 256 + q * 16 + fq * 4; const f32x4 nw = *(const f32x4*)(norm_w + col);
        u32x2* p = (u32x2*)(OMIX + row * D + 512 + col); const u32x2 v = *p;
        u32x2 o; o.x = pk2(bflo(v.x) * rs * nw[0], bfhi(v.x) * rs * nw[1]); o.y = pk2(bflo(v.y) * rs * nw[2], bfhi(v.y) * rs * nw[3]); *p = o; }
}

constexpr int HLD = 136, HLS = 72;
__device__ __forceinline__ void hgrn_chain(LAS unsigned char* lds, int cid, bf16_t* P1, const float* hg_lb, bf16_t* Ob, int ldo, int ocbase, int ocdir) {
    const int tid = threadIdx.x, lane = tid & 63, w = tid >> 6, fr = lane & 15, fq = lane >> 4;
    const int b = cid >> 4, h = (cid >> 1) & 7, dir = cid & 1;
    LAS bf16_t* QE = (LAS bf16_t*)lds;
    LAS bf16_t* KE = (LAS bf16_t*)(lds + 17408);
    LAS bf16_t* KLT = (LAS bf16_t*)(lds + 34816);
    LAS bf16_t* VT = (LAS bf16_t*)(lds + 53248);
    LAS bf16_t* AT = (LAS bf16_t*)(lds + 71680);
    LAS bf16_t* ST = (LAS bf16_t*)(lds + 80896);
    LAS float* totS = (LAS float*)(lds + 115712);
    LAS float* lastS = (LAS float*)(lds + 117760);
    __syncthreads();
    for (int e = tid; e < 128 * HLD / 2; e += 512) ((LAS unsigned*)ST)[e] = 0u;
    const int dcol = tid & 127, qtr = tid >> 7, i0 = qtr * 16;
    const float lbv = frcp(1.0f + __expf(hg_lb[h * 128 + dcol] - hg_lb[1024 + h * 128 + dcol]));
    f32x4 st[8];
#pragma unroll
    for (int i = 0; i < 8; ++i) st[i] = (f32x4){0.f, 0.f, 0.f, 0.f};
    bf16_t* Pb = P1 + (size_t)b * SEQ * HGP;
    __syncthreads();
    unsigned short rq[16], rf[16], rv[16];
#define HG_ISSUE(t0n) do { _Pragma("unroll") for (int i = 0; i < 16; ++i) { const int tk = (t0n) + (dir ? 63 - (i0 + i) : (i0 + i)); const bf16_t* pr = Pb + (size_t)tk * HGP + h * 128 + dcol; \
        rq[i] = pr[0]; rf[i] = pr[1024 * (1 + dir)]; rv[i] = pr[3072]; } } while (0)
    HG_ISSUE((dir ? 63 : 0) * 64);
    for (int cc = 0; cc < 64; ++cc) {
        const int t0 = (dir ? 63 - cc : cc) * 64;
        float gq[16], gk[16], gc[16]; float run = 1.0f;
#pragma unroll
        for (int i = 0; i < 16; ++i) { const float q = bf2f(rq[i]), fr_ = bf2f(rf[i]);
            const float f = lbv + (1.0f - lbv) * sigmoidf_(fr_); run *= f; gq[i] = q; gk[i] = 1.0f - f; gc[i] = run; }
        totS[qtr * 128 + dcol] = run;
#pragma unroll
        for (int i = 0; i < 16; i += 2) *(LAS unsigned*)(VT + dcol * HLS + i0 + i) = (unsigned)rv[i] | ((unsigned)rv[i + 1] << 16);
        __syncthreads();
        { float pre = 1.0f, tot = 1.0f;
#pragma unroll
          for (int q4 = 0; q4 < 4; ++q4) { const float tq = totS[q4 * 128 + dcol]; if (q4 < qtr) pre *= tq; tot *= tq; }
          const float etot = tot;
          if (qtr == 0) lastS[dcol] = etot;
#pragma unroll
          for (int i = 0; i < 16; i += 2) { const float e0 = fmaxf(pre * gc[i], 1e-30f), e1 = fmaxf(pre * gc[i + 1], 1e-30f), n0 = frcp(e0), n1 = frcp(e1), l0 = etot * n0, l1 = etot * n1;
              QE[(i0 + i) * HLD + dcol] = (bf16_t)f2bf(gq[i] * e0); QE[(i0 + i + 1) * HLD + dcol] = (bf16_t)f2bf(gq[i + 1] * e1);
              KE[(i0 + i) * HLD + dcol] = (bf16_t)f2bf(gk[i] * n0); KE[(i0 + i + 1) * HLD + dcol] = (bf16_t)f2bf(gk[i + 1] * n1);
              *(LAS unsigned*)(KLT + dcol * HLS + i0 + i) = pk2(gk[i] * l0, gk[i + 1] * l1); } }
        if (cc + 1 < 64) HG_ISSUE((dir ? 62 - cc : cc + 1) * 64);
        __syncthreads();
        { const int mt = w >> 1;
#pragma unroll
          for (int n2 = 0; n2 < 2; ++n2) { const int nt = (w & 1) * 2 + n2; f32x4 acc = (f32x4){0.f, 0.f, 0.f, 0.f};
#pragma unroll
              for (int ks = 0; ks < 4; ++ks) acc = mfma16(ldsfrag(KE, HLD, nt * 16, ks * 32, fr, fq), ldsfrag(QE, HLD, mt * 16, ks * 32, fr, fq), acc);
              const int lrow = mt * 16 + fr; float mv[4];
#pragma unroll
              for (int i = 0; i < 4; ++i) { const int s = nt * 16 + fq * 4 + i; mv[i] = (s <= lrow) ? acc[i] : 0.f; }
              u32x2 o; o.x = pk2(mv[0], mv[1]); o.y = pk2(mv[2], mv[3]); *(LAS u32x2*)(AT + lrow * HLS + nt * 16 + fq * 4) = o; } }
        __syncthreads();
        { const int mt = w >> 1;
#pragma unroll
          for (int n4 = 0; n4 < 4; ++n4) { const int nt = (w & 1) * 4 + n4; f32x4 acc = (f32x4){0.f, 0.f, 0.f, 0.f};
#pragma unroll
              for (int ks = 0; ks < 2; ++ks) acc = mfma16(ldsfrag(VT, HLS, nt * 16, ks * 32, fr, fq), ldsfrag(AT, HLS, mt * 16, ks * 32, fr, fq), acc);
#pragma unroll
              for (int ks = 0; ks < 4; ++ks) acc = mfma16(ldsfrag(ST, HLD, nt * 16, ks * 32, fr, fq), ldsfrag(QE, HLD, mt * 16, ks * 32, fr, fq), acc);
              const int i = mt * 16 + fr, tk = t0 + (dir ? 63 - i : i);
              u32x2 o; o.x = pk2(acc[0], acc[1]); o.y = pk2(acc[2], acc[3]);
              *(u32x2*)(Ob + ((size_t)b * SEQ + tk) * ldo + ocbase + ocdir * dir + h * 128 + nt * 16 + fq * 4) = o; } }
#pragma unroll
        for (int nt = 0; nt < 8; ++nt) { const f32x4 el = *(const LAS f32x4*)(lastS + nt * 16 + fq * 4); st[nt] = st[nt] * el;
#pragma unroll
            for (int ks = 0; ks < 2; ++ks) st[nt] = mfma16(ldsfrag(KLT, HLS, nt * 16, ks * 32, fr, fq), ldsfrag(VT, HLS, w * 16, ks * 32, fr, fq), st[nt]); }
        __syncthreads();
#pragma unroll
        for (int nt = 0; nt < 8; ++nt) { u32x2 o; o.x = pk2(st[nt][0], st[nt][1]); o.y = pk2(st[nt][2], st[nt][3]); *(LAS u32x2*)(ST + (w * 16 + fr) * HLD + nt * 16 + fq * 4) = o; }
    }
    __syncthreads();
}
__device__ __forceinline__ void hgrn_combine(const bf16_t* P1, const float* norm_w, bf16_t* OMIX, int gw, int NGW, int lane) {
    const int c0 = lane * 16;
#pragma unroll 2
    for (int tk = gw; tk < T; tk += NGW) {
        const bf16_t* pr = P1 + (size_t)tk * HGP + c0; float o[16]; float ss = 0.f;
#pragma unroll
        for (int hh = 0; hh < 2; ++hh) { const u32x4 uf = *(const u32x4*)(pr + 1024 + hh * 8), ub = *(const u32x4*)(pr + 2048 + hh * 8);
#pragma unroll
            for (int i = 0; i < 4; ++i) { o[hh * 8 + 2 * i] = bflo(uf[i]) + bflo(ub[i]); o[hh * 8 + 2 * i + 1] = bfhi(uf[i]) + bfhi(ub[i]); } }
#pragma unroll
        for (int i = 0; i < 16; ++i) ss += o[i] * o[i];
        const float rs = rsqrtf(sum8(ss) * (1.f / 128.f) + 1e-6f);
#pragma unroll
        for (int hh = 0; hh < 2; ++hh) { const u32x4 ug = *(const u32x4*)(pr + 4096 + hh * 8); float r[8];
#pragma unroll
            for (int i = 0; i < 4; ++i) { const float g0 = bflo(ug[i]), g1 = bfhi(ug[i]);
                r[2 * i] = o[hh * 8 + 2 * i] * rs * norm_w[c0 + hh * 8 + 2 * i] * siluf_(g0);
                r[2 * i + 1] = o[hh * 8 + 2 * i + 1] * rs * norm_w[c0 + hh * 8 + 2 * i + 1] * siluf_(g1); }
            u32x4 wv; wv.x = pk2(r[0], r[1]); wv.y = pk2(r[2], r[3]); wv.z = pk2(r[4], r[5]); wv.w = pk2(r[6], r[7]);
            *(u32x4*)(OMIX + (size_t)tk * D + c0 + hh * 8) = wv; }
    }
}

#define XB_TMO      128
#define XB_XCNT(j)  (256  + 64 * (j))
#define XB_XSUB(j)  (1280 + 64 * (j))
#define XB_XGEN(j)  (2304 + 64 * (j))
#define XB_TOP      3328
#define XB_TOPGEN   3392
#define XCD_BAR_WORDS 3456
#define XB_SPIN_CAP (1u << 18)

__device__ __forceinline__ unsigned xb_ld(unsigned* p)              { return __hip_atomic_load(p, __ATOMIC_RELAXED, __HIP_MEMORY_SCOPE_AGENT); }
__device__ __forceinline__ unsigned xb_add(unsigned* p, unsigned v) { return __hip_atomic_fetch_add(p, v, __ATOMIC_RELAXED, __HIP_MEMORY_SCOPE_AGENT); }
__device__ __forceinline__ unsigned xb_xcc_id() { return (unsigned)__builtin_amdgcn_s_getreg((3 << 11) | 20) & 0xFu; }
#define XB_SPIN(cond, bar) do { unsigned _sp = 0; while (cond) { __builtin_amdgcn_s_sleep(1); \
    if ((++_sp & 255u) == 0u) { if (xb_ld(&(bar)[XB_TMO])) break; if (_sp > XB_SPIN_CAP) { atomicAdd(&(bar)[XB_TMO], 1u); break; } } } } while (0)

struct XcdBarrier {
    unsigned* bar; unsigned x;
    volatile LAS unsigned* st;
};

__device__ __forceinline__ XcdBarrier xcd_barrier_post(unsigned* bar, volatile LAS unsigned* st) {
    XcdBarrier b; b.bar = bar; b.x = xb_xcc_id(); b.st = st;
    if (threadIdx.x == 0) (void)xb_add(&bar[XB_XCNT(b.x)], 1u);
    return b;
}
__device__ __forceinline__ void xcd_barrier_complete(unsigned* bar, unsigned x, unsigned& nloc, unsigned& nx) {
    const unsigned G = gridDim.x * gridDim.y * gridDim.z;
    unsigned sum, cnt, mine, sp = 0u;
    for (;;) {
        sum = 0u; cnt = 0u; mine = 0u;
#pragma unroll
        for (unsigned j = 0; j < 16; ++j) { const unsigned c = xb_ld(&bar[XB_XCNT(j)]); sum += c; cnt += (c > 0u) ? 1u : 0u; mine = (j == x) ? c : mine; }
        if (sum == G) break;
        __builtin_amdgcn_s_sleep(1);
        if ((++sp & 255u) == 0u) { if (xb_ld(&bar[XB_TMO])) break; if (sp > XB_SPIN_CAP) { atomicAdd(&bar[XB_TMO], 1u); break; } }
    }
    nloc = mine > 0u ? mine : 1u; nx = cnt > 0u ? cnt : 1u;
}

__device__ __forceinline__ void xcd_barrier(const XcdBarrier& b) {
    asm volatile("s_waitcnt vmcnt(0)" ::: "memory");
    __syncthreads();
    if (threadIdx.x == 0) {
        unsigned* bar = b.bar;
        __builtin_amdgcn_s_waitcnt(0);
        unsigned nloc = b.st[0], nx = b.st[1];
        if (nloc == 0u) { xcd_barrier_complete(bar, b.x, nloc, nx); b.st[0] = nloc; b.st[1] = nx; }
        const unsigned old = xb_add(&bar[XB_XSUB(b.x)], 1u);
        const unsigned gen = old / nloc;
        if (old + 1u == (gen + 1u) * nloc) {
            __builtin_amdgcn_fence(__ATOMIC_RELEASE, "agent");
            asm volatile("s_waitcnt vmcnt(0)" ::: "memory");
            const unsigned og = xb_add(&bar[XB_TOP], 1u);
            const unsigned tg = og / nx;
            if (og + 1u == (tg + 1u) * nx) xb_add(&bar[XB_TOPGEN], 1u);
            else XB_SPIN(xb_ld(&bar[XB_TOPGEN]) == tg, bar);
            __builtin_amdgcn_fence(__ATOMIC_ACQUIRE, "agent");
            xb_add(&bar[XB_XGEN(b.x)], 1u);
            asm volatile("s_waitcnt vmcnt(0)" ::: "memory");
        } else {
            XB_SPIN(xb_ld(&bar[XB_XGEN(b.x)]) == gen, bar);
            __builtin_amdgcn_fence(__ATOMIC_ACQUIRE, "agent");
            asm volatile("s_waitcnt vmcnt(0)" ::: "memory");
        }
    }
    __syncthreads();
}


struct Args { const float* in[35]; float* out; unsigned char* ws; int ph_lo, ph_hi; };
static_assert(sizeof(Args) == 304, "Args layout");

__global__ void __launch_bounds__(512, 2) mk_fwd(Args args) {
    extern __shared__ __attribute__((aligned(16))) unsigned char lds_raw[];
    LAS unsigned char* lds = (LAS unsigned char*)lds_raw; LAS unsigned char* xl = lds + XLDS_OFF;
    const int G = gridDim.x, bx = blockIdx.x, NGW = G * 8;
#define LOCAL_IDS int tid = threadIdx.x; asm volatile("" : "+v"(tid)); const int lane = tid & 63, wave = __builtin_amdgcn_readfirstlane(tid >> 6), gw = bx * 8 + wave; (void)lane; (void)gw;
    typedef const __attribute__((address_space(4))) unsigned char* kaptr_t;
    kaptr_t ka = (kaptr_t)__builtin_amdgcn_kernarg_segment_ptr();
#define INP(k) (*(const float* const volatile __attribute__((address_space(4)))*)(ka + 8 * (k)))
    unsigned char* ws = *(unsigned char* const volatile __attribute__((address_space(4)))*)(ka + 288); float* out = *(float* const volatile __attribute__((address_space(4)))*)(ka + 280);
    const float* x = INP(0);
    bf16_t* WAB = (bf16_t*)(ws + WS_WAB); bf16_t* WABO = (bf16_t*)(ws + WS_WABO); bf16_t* WHG = (bf16_t*)(ws + WS_WHG); bf16_t* WHGO = (bf16_t*)(ws + WS_WHGO);
    bf16_t* WQ = (bf16_t*)(ws + WS_WQ); bf16_t* WKV = (bf16_t*)(ws + WS_WKV); bf16_t* WO = (bf16_t*)(ws + WS_WO); bf16_t* WF1 = (bf16_t*)(ws + WS_WF1); bf16_t* WF2 = (bf16_t*)(ws + WS_WF2);
    bf16_t* G2T = (bf16_t*)(ws + WS_G2T); bf16_t* MEMN = (bf16_t*)(ws + WS_MEMN); bf16_t* KMEM = (bf16_t*)(ws + WS_KMEM);
    bf16_t* WKT = (bf16_t*)out; bf16_t* VWT = (bf16_t*)((unsigned char*)out + 64 * MiB);
    bf16_t* H = (bf16_t*)(ws + WS_H); bf16_t* P = (bf16_t*)(ws + WS_P); bf16_t* PATT = (bf16_t*)(ws + WS_PATT); bf16_t* OMIX0 = (bf16_t*)(ws + WS_OMIX0); bf16_t* OMIX1 = (bf16_t*)(ws + WS_OMIX1); float* PSB = (float*)(ws + WS_PS);
#define COMMA ,
    bf16_t* STATES = (bf16_t*)((unsigned char*)out + DO_STATES); bf16_t* GG = (bf16_t*)((unsigned char*)out + DO_G); bf16_t* SG = (bf16_t*)((unsigned char*)out + DO_SG);
    float* BONUS = (float*)((unsigned char*)out + DO_BONUS); float* TOT = (float*)((unsigned char*)out + DO_TOT);
    cg::grid_group grid = cg::this_grid();
    { volatile LAS unsigned* st_ = (volatile LAS unsigned*)(lds + LDS_BYTES - 16); if (threadIdx.x < 4) st_[threadIdx.x] = 0u; }
    __syncthreads();
    const XcdBarrier xbar = xcd_barrier_post((unsigned*)ws, (volatile LAS unsigned*)(lds + LDS_BYTES - 16));
    const int lo = *(const int volatile __attribute__((address_space(4)))*)(ka + 296), hi = *(const int volatile __attribute__((address_space(4)))*)(ka + 300);
#ifndef PH_EN
#define PH_EN(k) 1
#endif
#define IN(k) (PH_EN(k) && lo <= (k) && (k) < hi)
#ifndef DUP_MASK
#define DUP_MASK 0ull
#endif
#define REPS(k) (1 + (int)(((unsigned long long)(DUP_MASK) >> (k)) & 1ull))
#define PHASE(k) for (int rep_ = 0; rep_ < (IN(k) ? REPS(k) : 0); ++rep_, ((REPS(k) > 1) ? (grid.sync(), 0) : 0))
#define SEAM(k) do { if (IN(k) && IN((k) + 1)) xcd_barrier(xbar); } while (0)
    if (lo < 0) grid.sync();
#define RUN_GEMM(EPI, ALIGN, gd, ep) do { pg8::Order S_; S_.init(gd, G, bx); pg8::gemm_phase<EPI, ALIGN>(lds, xl, gd, S_, ep); } while (0)

    PHASE(0) { LOCAL_IDS
        LAS float* scr = (LAS float*)(lds + wave * 16384);
        constexpr int I_AB = 16 * 112, I_SQ = 16 * 32, I_HG = 16 * 160, I_KV = 16 * 64, I_F1 = 16 * 176, I_F2 = 44 * 32, I_G2 = 2 * 16;
        constexpr int NIT = I_AB + I_SQ + I_HG + I_SQ + 2 * I_KV + 2 * I_SQ + 2 * I_F1 + 2 * I_F2 + I_G2;
        for (int it = gw; it < NIT; it += NGW) {
            int r = it;
            if (r < I_AB) { transpose_item<0>(INP(3), 1024, ABP, WAB, scr, r, 112, lane); continue; } r -= I_AB;
            if (r < I_SQ) { transpose_item<0>(INP(4), 1024, 1024, WABO, scr, r, 32, lane); continue; } r -= I_SQ;
            if (r < I_HG) { transpose_item<0>(INP(22), 1024, HGP, WHG, scr, r, 160, lane, INP(2) + D); continue; } r -= I_HG;
            if (r < I_SQ) { transpose_item<0>(INP(23), 1024, 1024, WHGO, scr, r, 32, lane); continue; } r -= I_SQ;
            if (r < 2 * I_KV) { const int l = r / I_KV; transpose_item<0>(INP(29) + (size_t)l * D * 2048, 1024, 2048, WKV + (size_t)l * D * 2048, scr, r % I_KV, 64, lane); continue; } r -= 2 * I_KV;
            if (r < 2 * I_SQ) { const int l = r / I_SQ; transpose_item<0>(INP(30) + (size_t)l * D * D, 1024, 1024, WO + (size_t)l * D * D, scr, r % I_SQ, 32, lane); continue; } r -= 2 * I_SQ;
            if (r < 2 * I_F1) { const int l = r / I_F1; transpose_item<1>(INP(32) + (size_t)l * D * 2 * FFN, 1024, 2 * FFN, WF1 + (size_t)l * D * 2 * FFN, scr, r % I_F1, 176, lane, INP(31) + l * D); continue; } r -= 2 * I_F1;
            if (r < 2 * I_F2) { const int l = r / I_F2; transpose_item<0>(INP(33) + (size_t)l * FFN * D, FFN, 1024, WF2 + (size_t)l * FFN * D, scr, r % I_F2, 32, lane); continue; } r -= 2 * I_F2;
            transpose_item<0>(INP(10), 128, 512, G2T, scr, r, 16, lane);
        }
        for (size_t e8 = (size_t)bx * 512 + tid; e8 < (size_t)2 * D * D / 8; e8 += (size_t)G * 512) { const size_t idx = e8 * 8; const int l = (int)(idx / ((size_t)D * D)), k = (int)((idx % ((size_t)D * D)) / D);
            const float gk = INP(26)[l * D + k]; const f32x4 a0 = *(const f32x4*)(INP(28) + idx), a1 = *(const f32x4*)(INP(28) + idx + 4);
            u32x4 o; o.x = pk2(a0[0] * gk, a0[1] * gk); o.y = pk2(a0[2] * gk, a0[3] * gk); o.z = pk2(a1[0] * gk, a1[1] * gk); o.w = pk2(a1[2] * gk, a1[3] * gk); *(u32x4*)(WQ + idx) = o; }
        rms_rows_phase(x, INP(2), H, T, gw, NGW, lane);
        for (int l = 0; l < 2; ++l) { int r = gw;
            for (; r + NGW < 4096; r += 2 * NGW) rms_row2_bf16(INP(1) + (size_t)r * D, INP(1) + (size_t)(r + NGW) * D, INP(27) + l * D, MEMN + ((size_t)l * 4096 + r) * D, MEMN + ((size_t)l * 4096 + r + NGW) * D, lane);
            if (r < 4096) rms_row_bf16(INP(1) + (size_t)r * D, INP(27) + l * D, MEMN + ((size_t)l * 4096 + r) * D, lane); }
        __syncthreads();
    }
    SEAM(0);
    PHASE(1) {
        { pg8::Gemm g = pg8::make_gemm(H, WAB, T, ABPAD, 1024, 1024, 1024); pg8::EpiBf16 E{P, ABPAD, 1.0f, nullptr}; RUN_GEMM(pg8::EpiBf16, true, g, E); }
        { pg8::Gemm g = pg8::make_gemm(MEMN, WKV, 4096, 2048, 1024, 1024, 1024); g.nZ = 2; g.sAo = 4096L * D; g.sBo = 2048L * D; g.sCo = 4096L * 2048; pg8::EpiBf16 E{KMEM, 2048, 1.0f, nullptr}; RUN_GEMM(pg8::EpiBf16, true, g, E); }
    }
    SEAM(1);
    PHASE(2) {
#ifndef DUP_RWKV
#define DUP_RWKV 0
#endif
#ifndef DUP_S1
#define DUP_S1 0
#endif
        for (int r2 = 0; r2 <= DUP_RWKV; ++r2)
        for (int cid = bx; cid < 256; cid += G)
            rwkv_chain(lds, cid, P, INP(5), INP(6), INP(7), INP(8), INP(9), INP(11), INP(12), INP(13), H, SG, BONUS);
        for (int r2 = 0; r2 <= DUP_S1; ++r2)
        for (int u = bx; u < 1024; u += G) ssd_s1_unit(lds, u, P, INP(16), INP(17), INP(18), INP(19), STATES, TOT);
        __syncthreads();
    }
    SEAM(2);
    PHASE(3) {
        { int k128 = 128; asm volatile("" : "+s"(k128)); pg8::Gemm g = pg8::make_gemm(SG, G2T, T, 512, k128, 128, 128); pg8::EpiBf16 E{GG, 512, 1.0f, nullptr}; RUN_GEMM(pg8::EpiBf16, true, g, E); }
        { LOCAL_IDS ssd_s2(STATES, OMIX1, TOT, bx * 512 + tid, G * 512); }
    }
    SEAM(3);
    PHASE(4) {
#ifndef DUP_S3
#define DUP_S3 0
#endif
        for (int r2 = 0; r2 <= DUP_S3; ++r2)
        for (int u = bx; u < 1024; u += G) ssd_s3_unit(lds, u, P, INP(16), INP(17), INP(18), INP(19), INP(20), INP(21), OMIX1, OMIX0);
        __syncthreads();
        { LOCAL_IDS rwkv_combine(P, H, BONUS, GG, INP(5), INP(14), INP(15), OMIX0, gw, NGW, lane); }
    }
    SEAM(4);
    PHASE(5) { { pg8::Gemm g = pg8::make_gemm(OMIX0, WABO, T, 1024, 1024, 1024, 1024); pg8::EpiResidB E{x, H, PSB, 1024}; RUN_GEMM(pg8::EpiResidB, true, g, E); }
        for (int l = 0; l < 2; ++l) {
            { pg8::Gemm g = pg8::make_gemm(KMEM + (size_t)l * 4096 * 2048, WQ + (size_t)l * D * D, 256, 1024, 256, 2048, 1024); g.nZ = 64; g.zdiv = 4;
              g.sAo = 256L * 2048; g.sAi = 256; g.sBo = 0; g.sBi = 256; g.sCo = 4L * 256 * 1024; g.sCi = 256L * 1024; pg8::EpiBf16 E{WKT + (size_t)l * 16777216, 1024, 0.0625f, nullptr}; RUN_GEMM(pg8::EpiBf16, true, g, E); }
            { pg8::Gemm g = pg8::make_gemm(WO + (size_t)l * D * D, KMEM + (size_t)l * 4096 * 2048 + 1024, 1024, 256, 256, 1024, 2048); g.nZ = 64; g.zdiv = 4;
              g.sAo = 0; g.sAi = 256; g.sBo = 256L * 2048; g.sBi = 256; g.sCo = 1024L * 1024; g.sCi = 256; pg8::EpiBf16 E{VWT + (size_t)l * 16777216, 1024, 1.0f, nullptr}; RUN_GEMM(pg8::EpiBf16, true, g, E); }
        } }
    SEAM(5);

#define ATTN_FFN(base, L) \
    PHASE(base) { pg8::Gemm g = pg8::make_gemm(H, WKT + (size_t)(L) * 16777216, SEQ, 256, 1024, 1024, 1024); g.nZ = 64; g.zdiv = 4; g.psz = 16; \
        g.sAo = (long)SEQ * D; g.sAi = 0; g.sBo = 4L * 256 * 1024; g.sBi = 256L * 1024; g.sCo = (long)SEQ * D; g.sCi = 256; pg8::EpiSoftmaxPS E{PSB, PATT, 1024}; RUN_GEMM(pg8::EpiSoftmaxPS, true, g, E); } \
    SEAM(base); \
    PHASE(base + 1) { pg8::Gemm g = pg8::make_gemm(PATT, VWT + (size_t)(L) * 16777216, SEQ, 1024, 1024, 1024, 1024); g.nZ = 16; g.zdiv = 1; \
        g.sAo = (long)SEQ * D; g.sBo = 1024L * 1024; g.sCo = (long)SEQ * D; pg8::EpiResidB E{nullptr, H, PSB, 1024}; RUN_GEMM(pg8::EpiResidB, true, g, E); } \
    SEAM(base + 1); \
    PHASE(base + 2) { pg8::Gemm g = pg8::make_gemm(H, WF1 + (size_t)(L) * D * 2 * FFN, T, 2 * FFN, 1024, 1024, 1024); pg8::EpiSwiglu E{P, FFN, PSB}; RUN_GEMM(pg8::EpiSwiglu, true, g, E); } \
    SEAM(base + 2); \
    PHASE(base + 3) { pg8::Gemm g = pg8::make_gemm(P, WF2 + (size_t)(L) * FFN * D, T, 1024, FFN, FFN, FFN); pg8::EpiResidB E{nullptr, H, PSB, 1024}; RUN_GEMM(pg8::EpiResidB, true, g, E); } \
    SEAM(base + 3);

    ATTN_FFN(6, 0)

    PHASE(10) { pg8::Gemm g = pg8::make_gemm(H, WHG, T, HGP, 1024, 1024, 1024); pg8::EpiBf16PS E{P, HGP, 1.0f, PSB}; RUN_GEMM(pg8::EpiBf16PS, true, g, E); }
    SEAM(10);
    PHASE(11) { for (int cid = bx; cid < 256; cid += G) hgrn_chain(lds, cid, P, INP(25), P, HGP, 1024, 1024); }
    SEAM(11);
    PHASE(12) { LOCAL_IDS hgrn_combine(P, INP(24), OMIX1, gw, NGW, lane); }
    SEAM(12);
    PHASE(13) { pg8::Gemm g = pg8::make_gemm(OMIX1, WHGO, T, 1024, 1024, 1024, 1024); pg8::EpiResidB E{nullptr, H, PSB, 1024}; RUN_GEMM(pg8::EpiResidB, true, g, E); }
    SEAM(13);

    ATTN_FFN(14, 1)

    PHASE(18) { LOCAL_IDS
        const float* fg = INP(34);
        f32x4 g0[2], g1[2];
#pragma unroll
        for (int j = 0; j < 2; ++j) { const int c = (lane + 64 * j) * 8; g0[j] = *(const f32x4*)(fg + c); g1[j] = *(const f32x4*)(fg + c + 4); }
        for (int m0 = gw; m0 < T; m0 += 4 * NGW) {
            f32x4 pa[4]; u32x4 hv[4][2];
#pragma unroll
            for (int r = 0; r < 4; ++r) { const int m = m0 + r * NGW; if (m < T) { pa[r] = *(const f32x4*)(PSB + (size_t)m * 16 + (lane & 3) * 4);
#pragma unroll
                for (int j = 0; j < 2; ++j) hv[r][j] = *(const u32x4*)(H + (size_t)m * D + (lane + 64 * j) * 8); } }
#pragma unroll
            for (int r = 0; r < 4; ++r) { const int m = m0 + r * NGW; if (m < T) {
                float sq = (pa[r][0] + pa[r][1]) + (pa[r][2] + pa[r][3]); sq += __shfl_xor(sq, 1); sq += __shfl_xor(sq, 2);
                const float rs = rsqrtf(sq * (1.f / D) + 1e-6f); float* orow = out + (size_t)m * D;
#pragma unroll
                for (int j = 0; j < 2; ++j) { const int c = (lane + 64 * j) * 8; const u32x4 h4 = hv[r][j];
                    *(f32x4*)(orow + c) = (f32x4){bflo(h4.x) * rs * g0[j][0], bfhi(h4.x) * rs * g0[j][1], bflo(h4.y) * rs * g0[j][2], bfhi(h4.y) * rs * g0[j][3]};
                    *(f32x4*)(orow + c + 4) = (f32x4){bflo(h4.z) * rs * g1[j][0], bfhi(h4.z) * rs * g1[j][1], bflo(h4.w) * rs * g1[j][2], bfhi(h4.w) * rs * g1[j][3]}; } } }
        }
    }
#undef IN
#undef SEAM
#undef RUN_GEMM
}

extern "C" void kernel_launch(void* const* d_in, const int* in_sizes, int n_in, void* d_out, int out_size, void* d_ws, size_t ws_size, hipStream_t stream) {
    static int grid = 0;
    if (grid == 0) {
        if (n_in != 35 || out_size != T * D || ws_size < WS_END) { fprintf(stderr, "kernel_launch: unexpected shapes (n_in %d out %d ws %zu)\n", n_in, out_size, ws_size); grid = -1; return; }
        int dev = 0, cus = 0, per_cu = 0;
        hipGetDevice(&dev); hipDeviceGetAttribute(&cus, hipDeviceAttributeMultiprocessorCount, dev);
        hipFuncSetAttribute((const void*)mk_fwd, hipFuncAttributeMaxDynamicSharedMemorySize, LDS_BYTES);
        hipOccupancyMaxActiveBlocksPerMultiprocessor(&per_cu, (const void*)mk_fwd, 512, LDS_BYTES);
        if (per_cu < 1) { fprintf(stderr, "kernel_launch: occupancy query says %d blocks per CU\n", per_cu); per_cu = 1; }
        (void)hipGetLastError();
        grid = cus * 1;
    }
    if (grid < 0) return;
    if (hipMemsetAsync(d_ws, 0, 65536, stream) != hipSuccess) { fprintf(stderr, "kernel_launch: memset of the barrier words failed\n"); return; }
    Args a{};
    for (int i = 0; i < 35; ++i) a.in[i] = (const float*)d_in[i];
    a.out = (float*)d_out; a.ws = (unsigned char*)d_ws;
#if MK_COOP
    a.ph_lo = 0; a.ph_hi = NPHASE;
    void* kargs[] = {&a};
    hipError_t e = hipLaunchCooperativeKernel((const void*)mk_fwd, dim3(grid), dim3(512), kargs, LDS_BYTES, stream);
    if (e != hipSuccess) fprintf(stderr, "cooperative launch failed: %s (grid %d)\n", hipGetErrorString(e), grid);
#else
    for (int ph = 0; ph < NPHASE; ++ph) { a.ph_lo = ph; a.ph_hi = ph + 1; hipLaunchKernelGGL(mk_fwd, dim3(grid), dim3(512), LDS_BYTES, stream, a); }
#endif
}
```

```cpp
#include <hip/hip_runtime.h>
#include <hip/hip_cooperative_groups.h>
#include <cstdio>
#include <cstdint>
namespace cg = cooperative_groups;

#ifndef MK_COOP
#define MK_COOP 1
#endif

#define LAS __attribute__((address_space(3)))
typedef unsigned short bf16_t;
typedef short bf16x8 __attribute__((ext_vector_type(8)));
typedef float f32x4 __attribute__((ext_vector_type(4)));
typedef float f32x2 __attribute__((ext_vector_type(2)));
typedef unsigned u32x4 __attribute__((ext_vector_type(4)));
typedef unsigned u32x2 __attribute__((ext_vector_type(2)));

constexpr int NB = 16, SEQ = 4096, T = NB * SEQ, D = 1024;
constexpr int ABPAD = 3584, ABP = 3336;
constexpr int HGP = 5120;
constexpr int FFN = 2816;
constexpr int NPHASE = 19;

constexpr size_t MiB = 1u << 20;
constexpr size_t WS_WAB = 1 * MiB, WS_WABO = 8 * MiB, WS_WHG = 10 * MiB, WS_WHGO = 20 * MiB, WS_WQ = 22 * MiB, WS_WKV = 26 * MiB, WS_WO = 34 * MiB,
                 WS_WF1 = 38 * MiB, WS_WF2 = 60 * MiB, WS_G2T = 71 * MiB, WS_MEMN = 72 * MiB, WS_KMEM = 88 * MiB, WS_VT = 104 * MiB,
                 WS_PS = 120 * MiB, WS_H = 128 * MiB, WS_P = 256 * MiB, WS_PATT = 384 * MiB, WS_OMIX0 = 704 * MiB, WS_OMIX1 = 896 * MiB, WS_END = 1024 * MiB;
constexpr size_t DO_STATES = 0, DO_G = 128 * MiB, DO_SG = 192 * MiB, DO_BONUS = 208 * MiB, DO_TOT = 210 * MiB;

constexpr int LDS_BYTES = 163840;
constexpr int XLDS_OFF = 131072;

typedef __bf16 bf16x2_t __attribute__((ext_vector_type(2)));
__device__ __forceinline__ unsigned pk2(float lo, float hi) { const f32x2 v = {lo, hi}; return __builtin_bit_cast(unsigned, __builtin_convertvector(v, bf16x2_t)); }
__device__ __forceinline__ unsigned f2bf(float f) { return pk2(f, 0.f) & 0xffffu; }
__device__ __forceinline__ float bf2f(unsigned short b) { return __builtin_bit_cast(float, (unsigned)b << 16); }
__device__ __forceinline__ float bflo(unsigned u) { return __builtin_bit_cast(float, u << 16); }
__device__ __forceinline__ float bfhi(unsigned u) { return __builtin_bit_cast(float, u & 0xffff0000u); }
__device__ __forceinline__ float frcp(float x) { return __builtin_amdgcn_rcpf(x); }
__device__ __forceinline__ float sigmoidf_(float x) { return frcp(1.0f + __expf(-x)); }
__device__ __forceinline__ float siluf_(float x) { return x * frcp(1.0f + __expf(-x)); }
__device__ __forceinline__ float wave_sum(float v) {
#pragma unroll
    for (int o = 1; o < 64; o <<= 1) v += __shfl_xor(v, o);
    return v;
}
template <int CTRL> __device__ __forceinline__ float dppf(float x) { return __builtin_bit_cast(float, __builtin_amdgcn_mov_dpp(__builtin_bit_cast(int, x), CTRL, 0xf, 0xf, true)); }
__device__ __forceinline__ float sum8(float v) { v += dppf<0xB1>(v); v += dppf<0x4E>(v); v += dppf<0x141>(v); return v; }
#define LDS_WAIT() asm volatile("s_waitcnt lgkmcnt(0)" ::: "memory")

namespace pg8 {
constexpr int BM = 256, BK = 64, HALF = 128, HTB = HALF * BK * 2, STAGE_BYTES = 8 * HTB, NXCD = 8, WGM = 8;
__host__ __device__ __forceinline__ int lds_byte(int r, int c) { const int st = (r >> 4) * 2 + (c >> 5), rr = r & 15, cc = c & 31, ob = rr * 64 + cc * 2; return st * 1024 + (ob ^ (((ob >> 9) & 1) << 5)); }
__host__ __device__ __forceinline__ void stage_rc(int b, int& R, int& C) { const int st = b / 1024, sb = b % 1024, swz = sb ^ (((sb >> 9) & 1) << 5); R = (st >> 1) * 16 + swz / 64; C = (st & 1) * 32 + (swz % 64) / 2; }
__host__ __device__ __forceinline__ int perm32(int rho) { const int n = rho >> 4, i = rho & 15; return 8 * (i >> 2) + 4 * n + (i & 3); }

struct Unit { int pm, pn, z; };
struct Gemm {
    const bf16_t* A; const bf16_t* Bt; int lda, ldb, K, nM, nN, nZ, zdiv, psz; long sAo, sAi, sBo, sBi, sCo, sCi;
    __device__ __forceinline__ long offA(const Unit& u) const { return (long)(u.z / zdiv) * sAo + (long)(u.z % zdiv) * sAi + (long)u.pm * BM * lda; }
    __device__ __forceinline__ long offB(const Unit& u) const { return (long)(u.z / zdiv) * sBo + (long)(u.z % zdiv) * sBi + (long)u.pn * BM * ldb; }
    __device__ __forceinline__ long offC(const Unit& u) const { return (long)(u.z / zdiv) * sCo + (long)(u.z % zdiv) * sCi; }
};
__device__ __forceinline__ Gemm make_gemm(const bf16_t* A, const bf16_t* Bt, int M, int N, int K, int lda, int ldb) {
    Gemm g; g.A = A; g.Bt = Bt; g.lda = lda; g.ldb = ldb; g.K = K; g.nM = M / BM; g.nN = N / BM; g.nZ = 1; g.zdiv = 1; g.psz = 0; g.sAo = g.sAi = g.sBo = g.sBi = g.sCo = g.sCi = 0; return g;
}
struct Order {
    int nM, nN, nwg, total, G, c;
    __device__ __forceinline__ void init(const Gemm& g, int G_, int c_) { nM = g.nM; nN = g.nN; nwg = nM * nN; total = nwg * g.nZ; G = G_; c = c_; }
    __device__ __forceinline__ bool next(int i, Unit& u) const {
        const long L = (long)i * G + c; if (L >= total) return false;
        u.z = (int)(L / nwg); int wgid = (int)(L % nwg);
        { const int q = nwg / NXCD, r = nwg % NXCD, xcd = wgid % NXCD, off = wgid / NXCD; wgid = (xcd < r ? xcd * (q + 1) : r * (q + 1) + (xcd - r) * q) + off; }
        const int nig = WGM * nN, gid = wgid / nig, fm = gid * WGM, gsz = (nM - fm) < WGM ? (nM - fm) : WGM;
        u.pm = fm + ((wgid % nig) % gsz); u.pn = (wgid % nig) / gsz; return true;
    }
};

__device__ __forceinline__ unsigned cvt_pk_bf16(float lo, float hi) { return pk2(lo, hi); }

__device__ __forceinline__ void row_scales(const float* PS, int rowbase, int fq, float (&rs)[2][4]) {
#pragma unroll
    for (int ai = 0; ai < 2; ++ai)
#pragma unroll
        for (int m = 0; m < 4; ++m) { const f32x4 p = *(const f32x4*)(PS + (size_t)(rowbase + ai * HALF + m * 16) * 16 + fq * 4);
            float s = (p[0] + p[1]) + (p[2] + p[3]); s += __shfl_xor(s, 16); s += __shfl_xor(s, 32); rs[ai][m] = rsqrtf(s * (1.f / 1024.f) + 1e-6f); }
}
__device__ __forceinline__ void row_scales_lds(const LAS float* PSL, int rloc  , int fq, float (&rs)[2][4]) {
#pragma unroll
    for (int ai = 0; ai < 2; ++ai)
#pragma unroll
        for (int m = 0; m < 4; ++m) { const f32x4 p = *(const LAS f32x4*)(PSL + (rloc + ai * HALF + m * 16) * 16 + fq * 4);
            float s = (p[0] + p[1]) + (p[2] + p[3]); s += __shfl_xor(s, 16); s += __shfl_xor(s, 32); rs[ai][m] = rsqrtf(s * (1.f / 1024.f) + 1e-6f); }
}
struct EpiBf16 {
    static constexpr bool PERM = true, PSLDS = false;
    bf16_t* O; int ldc; float scale; const float* PS;
    __device__ __forceinline__ void operator()(const f32x4 (&acc)[2][2][4][2], const Unit& u, long coff, int wr, int wc, int fr, int fq, LAS unsigned char* xl) const {
        const int row0 = u.pm * BM + wr * 64 + fr, col0 = u.pn * BM + wc * 32 + 8 * fq; bf16_t* base = O + coff;
        float rs[2][4];
        if (PS) row_scales(PS, row0, fq, rs);
        else {
#pragma unroll
            for (int ai = 0; ai < 2; ++ai)
#pragma unroll
                for (int m = 0; m < 4; ++m) rs[ai][m] = 1.f; }
#pragma unroll
        for (int ai = 0; ai < 2; ++ai)
#pragma unroll
            for (int m = 0; m < 4; ++m) { bf16_t* rowp = base + (size_t)(row0 + ai * HALF + m * 16) * ldc + col0; const float sc_ = scale * rs[ai][m];
#pragma unroll
                for (int bj = 0; bj < 2; ++bj) { const f32x4 v0 = acc[ai][bj][m][0] * sc_, v1 = acc[ai][bj][m][1] * sc_;
                    u32x4 w; w.x = cvt_pk_bf16(v0[0], v0[1]); w.y = cvt_pk_bf16(v0[2], v0[3]); w.z = cvt_pk_bf16(v1[0], v1[1]); w.w = cvt_pk_bf16(v1[2], v1[3]);
                    *(u32x4*)(rowp + bj * HALF) = w; } }
    }
};
struct EpiBf16PS {
    static constexpr bool PERM = true, PSLDS = true;
    bf16_t* O; int ldc; float scale; const float* PS;
    __device__ __forceinline__ void operator()(const f32x4 (&acc)[2][2][4][2], const Unit& u, long coff, int wr, int wc, int fr, int fq, LAS unsigned char* xl) const {
        const int row0 = u.pm * BM + wr * 64 + fr, col0 = u.pn * BM + wc * 32 + 8 * fq; bf16_t* base = O + coff;
        float rs[2][4];
        row_scales_lds((const LAS float*)(xl + 8192), wr * 64 + fr, fq, rs);
#pragma unroll
        for (int ai = 0; ai < 2; ++ai)
#pragma unroll
            for (int m = 0; m < 4; ++m) { bf16_t* rowp = base + (size_t)(row0 + ai * HALF + m * 16) * ldc + col0; const float sc_ = scale * rs[ai][m];
#pragma unroll
                for (int bj = 0; bj < 2; ++bj) { const f32x4 v0 = acc[ai][bj][m][0] * sc_, v1 = acc[ai][bj][m][1] * sc_;
                    u32x4 w; w.x = cvt_pk_bf16(v0[0], v0[1]); w.y = cvt_pk_bf16(v0[2], v0[3]); w.z = cvt_pk_bf16(v1[0], v1[1]); w.w = cvt_pk_bf16(v1[2], v1[3]);
                    *(u32x4*)(rowp + bj * HALF) = w; } }
    }
};
struct EpiResid {
    static constexpr bool PERM = false, PSLDS = false;
    const float* base; float* out; int ldc;
    __device__ __forceinline__ void operator()(const f32x4 (&acc)[2][2][4][2], const Unit& u, long coff, int wr, int wc, int fr, int fq, LAS unsigned char* xl) const {
        const int col0 = u.pn * BM + wc * 32 + 4 * fq;
#pragma unroll
        for (int ai = 0; ai < 2; ++ai)
#pragma unroll
            for (int m = 0; m < 4; ++m) { const size_t off = (size_t)(u.pm * BM + ai * HALF + wr * 64 + m * 16 + fr) * ldc + col0;
#pragma unroll
                for (int bj = 0; bj < 2; ++bj)
#pragma unroll
                    for (int n = 0; n < 2; ++n) { const f32x4 bs = *(const f32x4*)(base + off + bj * HALF + n * 16); *(f32x4*)(out + off + bj * HALF + n * 16) = bs + acc[ai][bj][m][n]; } }
    }
};
struct EpiResidH {
    static constexpr bool PERM = false, PSLDS = false;
    const float* base; float* out; bf16_t* HB; float* PS; int ldc;
    __device__ __forceinline__ void operator()(const f32x4 (&acc)[2][2][4][2], const Unit& u, long coff, int wr, int wc, int fr, int fq, LAS unsigned char* xl) const {
        const int col0 = u.pn * BM + wc * 32 + 4 * fq;
#pragma unroll
        for (int ai = 0; ai < 2; ++ai)
#pragma unroll
            for (int m = 0; m < 4; ++m) { const int row = u.pm * BM + ai * HALF + wr * 64 + m * 16 + fr; const size_t off = (size_t)row * ldc + col0; float ss = 0.f;
#pragma unroll
                for (int bj = 0; bj < 2; ++bj)
#pragma unroll
                    for (int n = 0; n < 2; ++n) { const f32x4 bs = *(const f32x4*)(base + off + bj * HALF + n * 16); const f32x4 o = bs + acc[ai][bj][m][n]; *(f32x4*)(out + off + bj * HALF + n * 16) = o;
                        ss += (o[0] * o[0] + o[1] * o[1]) + (o[2] * o[2] + o[3] * o[3]);
                        u32x2 w; w.x = cvt_pk_bf16(o[0], o[1]); w.y = cvt_pk_bf16(o[2], o[3]); *(u32x2*)(HB + off + bj * HALF + n * 16) = w; }
                ss += __shfl_xor(ss, 16); ss += __shfl_xor(ss, 32);
                if (fq == 0) PS[(size_t)row * 16 + u.pn * 4 + wc] = ss; }
    }
};
struct EpiResidB {
    static constexpr bool PERM = true, PSLDS = false;
    const float* basef; bf16_t* HB; float* PS; int ldc;
    __device__ __forceinline__ void operator()(const f32x4 (&acc)[2][2][4][2], const Unit& u, long coff, int wr, int wc, int fr, int fq, LAS unsigned char* xl) const {
        const int col0 = u.pn * BM + wc * 32 + 8 * fq; const int rowb = (int)(coff / ldc) + u.pm * BM + wr * 64 + fr;
        u32x4 hb[2][4][2];
        if (!basef) {
#pragma unroll
            for (int ai = 0; ai < 2; ++ai)
#pragma unroll
                for (int m = 0; m < 4; ++m)
#pragma unroll
                    for (int bj = 0; bj < 2; ++bj) hb[ai][m][bj] = *(const u32x4*)(HB + (size_t)(rowb + ai * HALF + m * 16) * ldc + col0 + bj * HALF); }
#pragma unroll
        for (int ai = 0; ai < 2; ++ai)
#pragma unroll
            for (int m = 0; m < 4; ++m) { const int row = rowb + ai * HALF + m * 16; const size_t off = (size_t)row * ldc + col0; float ss = 0.f;
#pragma unroll
                for (int bj = 0; bj < 2; ++bj) { f32x4 b0, b1;
                    if (basef) { b0 = *(const f32x4*)(basef + off + bj * HALF); b1 = *(const f32x4*)(basef + off + bj * HALF + 4); }
                    else { const u32x4 h4 = hb[ai][m][bj]; b0 = (f32x4){bflo(h4.x), bfhi(h4.x), bflo(h4.y), bfhi(h4.y)}; b1 = (f32x4){bflo(h4.z), bfhi(h4.z), bflo(h4.w), bfhi(h4.w)}; }
                    const f32x4 o0 = b0 + acc[ai][bj][m][0], o1 = b1 + acc[ai][bj][m][1];
                    ss += ((o0[0] * o0[0] + o0[1] * o0[1]) + (o0[2] * o0[2] + o0[3] * o0[3])) + ((o1[0] * o1[0] + o1[1] * o1[1]) + (o1[2] * o1[2] + o1[3] * o1[3]));
                    u32x4 w; w.x = cvt_pk_bf16(o0[0], o0[1]); w.y = cvt_pk_bf16(o0[2], o0[3]); w.z = cvt_pk_bf16(o1[0], o1[1]); w.w = cvt_pk_bf16(o1[2], o1[3]);
                    *(u32x4*)(HB + off + bj * HALF) = w; }
                ss += __shfl_xor(ss, 16); ss += __shfl_xor(ss, 32);
                if (fq == 0) PS[(size_t)row * 16 + u.pn * 4 + wc] = ss; }
    }
};
struct EpiSwiglu {
    static constexpr bool PERM = true, PSLDS = true;
    bf16_t* O; int ldc; const float* PS;
    __device__ __forceinline__ void operator()(const f32x4 (&acc)[2][2][4][2], const Unit& u, long coff, int wr, int wc, int fr, int fq, LAS unsigned char* xl) const {
        const int row0 = u.pm * BM + wr * 64 + fr, col0 = u.pn * HALF + wc * 32 + 8 * fq;
        float rs[2][4]; row_scales_lds((const LAS float*)(xl + 8192), wr * 64 + fr, fq, rs);
#pragma unroll
        for (int ai = 0; ai < 2; ++ai)
#pragma unroll
            for (int m = 0; m < 4; ++m) { bf16_t* rowp = O + (size_t)(row0 + ai * HALF + m * 16) * ldc + col0; float r[8]; const float sc_ = rs[ai][m];
#pragma unroll
                for (int n = 0; n < 2; ++n)
#pragma unroll
                    for (int i = 0; i < 4; ++i) { const float g = acc[ai][0][m][n][i] * sc_, uu = acc[ai][1][m][n][i] * sc_; r[n * 4 + i] = siluf_(g) * uu; }
                u32x4 w; w.x = cvt_pk_bf16(r[0], r[1]); w.y = cvt_pk_bf16(r[2], r[3]); w.z = cvt_pk_bf16(r[4], r[5]); w.w = cvt_pk_bf16(r[6], r[7]);
                *(u32x4*)rowp = w; }
    }
};
struct EpiSoftmax {
    static constexpr bool PERM = true, PSLDS = false;
    bf16_t* O; int ldc;
    __device__ __forceinline__ void operator()(f32x4 (&acc)[2][2][4][2], const Unit& u, long coff, int wr, int wc, int fr, int fq, LAS unsigned char* xl) const {
        LAS float* XM = (LAS float*)xl; LAS float* XS = (LAS float*)(xl + 4096);
#pragma unroll
        for (int ai = 0; ai < 2; ++ai)
#pragma unroll
            for (int m = 0; m < 4; ++m) { float mx = -3.0e38f;
#pragma unroll
                for (int bj = 0; bj < 2; ++bj)
#pragma unroll
                    for (int n = 0; n < 2; ++n)
#pragma unroll
                        for (int i = 0; i < 4; ++i) mx = fmaxf(mx, acc[ai][bj][m][n][i]);
                mx = fmaxf(mx, __shfl_xor(mx, 16)); mx = fmaxf(mx, __shfl_xor(mx, 32));
                if (fq == 0) XM[(ai * HALF + wr * 64 + m * 16 + fr) * 4 + wc] = mx; }
        LDS_WAIT(); __builtin_amdgcn_s_barrier(); asm volatile("" ::: "memory");
#pragma unroll
        for (int ai = 0; ai < 2; ++ai)
#pragma unroll
            for (int m = 0; m < 4; ++m) { const f32x4 mm = *(const LAS f32x4*)(XM + (ai * HALF + wr * 64 + m * 16 + fr) * 4);
                const float mx = fmaxf(fmaxf(mm[0], mm[1]), fmaxf(mm[2], mm[3])); float s = 0.f;
#pragma unroll
                for (int bj = 0; bj < 2; ++bj)
#pragma unroll
                    for (int n = 0; n < 2; ++n)
#pragma unroll
                        for (int i = 0; i < 4; ++i) { const float e = __expf(acc[ai][bj][m][n][i] - mx); acc[ai][bj][m][n][i] = e; s += e; }
                s += __shfl_xor(s, 16); s += __shfl_xor(s, 32);
                if (fq == 0) XS[(ai * HALF + wr * 64 + m * 16 + fr) * 4 + wc] = s; }
        LDS_WAIT(); __builtin_amdgcn_s_barrier(); asm volatile("" ::: "memory");
        const int row0 = u.pm * BM + wr * 64 + fr, col0 = wc * 32 + 8 * fq; bf16_t* base = O + coff;
#pragma unroll
        for (int ai = 0; ai < 2; ++ai)
#pragma unroll
            for (int m = 0; m < 4; ++m) { const f32x4 ss = *(const LAS f32x4*)(XS + (ai * HALF + wr * 64 + m * 16 + fr) * 4);
                const float inv = frcp((ss[0] + ss[1]) + (ss[2] + ss[3])); bf16_t* rowp = base + (size_t)(row0 + ai * HALF + m * 16) * ldc + col0;
#pragma unroll
                for (int bj = 0; bj < 2; ++bj) { const f32x4 v0 = acc[ai][bj][m][0] * inv, v1 = acc[ai][bj][m][1] * inv;
                    u32x4 w; w.x = cvt_pk_bf16(v0[0], v0[1]); w.y = cvt_pk_bf16(v0[2], v0[3]); w.z = cvt_pk_bf16(v1[0], v1[1]); w.w = cvt_pk_bf16(v1[2], v1[3]);
                    *(u32x4*)(rowp + bj * HALF) = w; } }
    }
};

struct EpiSoftmaxPS {
    const float* PS;
    static constexpr bool PERM = true, PSLDS = true;
    bf16_t* O; int ldc;
    __device__ __forceinline__ void operator()(f32x4 (&acc)[2][2][4][2], const Unit& u, long coff, int wr, int wc, int fr, int fq, LAS unsigned char* xl) const {
        LAS float* XM = (LAS float*)xl; LAS float* XS = (LAS float*)(xl + 4096);
        { float rs[2][4]; row_scales_lds((const LAS float*)(xl + 8192), wr * 64 + fr, fq, rs);
#pragma unroll
          for (int ai = 0; ai < 2; ++ai)
#pragma unroll
              for (int m = 0; m < 4; ++m)
#pragma unroll
                  for (int bj = 0; bj < 2; ++bj)
#pragma unroll
                      for (int n = 0; n < 2; ++n) acc[ai][bj][m][n] = acc[ai][bj][m][n] * rs[ai][m]; }
#pragma unroll
        for (int ai = 0; ai < 2; ++ai)
#pragma unroll
            for (int m = 0; m < 4; ++m) { float mx = -3.0e38f;
#pragma unroll
                for (int bj = 0; bj < 2; ++bj)
#pragma unroll
                    for (int n = 0; n < 2; ++n)
#pragma unroll
                        for (int i = 0; i < 4; ++i) mx = fmaxf(mx, acc[ai][bj][m][n][i]);
                mx = fmaxf(mx, __shfl_xor(mx, 16)); mx = fmaxf(mx, __shfl_xor(mx, 32));
                if (fq == 0) XM[(ai * HALF + wr * 64 + m * 16 + fr) * 4 + wc] = mx; }
        LDS_WAIT(); __builtin_amdgcn_s_barrier(); asm volatile("" ::: "memory");
#pragma unroll
        for (int ai = 0; ai < 2; ++ai)
#pragma unroll
            for (int m = 0; m < 4; ++m) { const f32x4 mm = *(const LAS f32x4*)(XM + (ai * HALF + wr * 64 + m * 16 + fr) * 4);
                const float mx = fmaxf(fmaxf(mm[0], mm[1]), fmaxf(mm[2], mm[3])); float s = 0.f;
#pragma unroll
                for (int bj = 0; bj < 2; ++bj)
#pragma unroll
                    for (int n = 0; n < 2; ++n)
#pragma unroll
                        for (int i = 0; i < 4; ++i) { const float e = __expf(acc[ai][bj][m][n][i] - mx); acc[ai][bj][m][n][i] = e; s += e; }
                s += __shfl_xor(s, 16); s += __shfl_xor(s, 32);
                if (fq == 0) XS[(ai * HALF + wr * 64 + m * 16 + fr) * 4 + wc] = s; }
        LDS_WAIT(); __builtin_amdgcn_s_barrier(); asm volatile("" ::: "memory");
        const int row0 = u.pm * BM + wr * 64 + fr, col0 = wc * 32 + 8 * fq; bf16_t* base = O + coff;
#pragma unroll
        for (int ai = 0; ai < 2; ++ai)
#pragma unroll
            for (int m = 0; m < 4; ++m) { const f32x4 ss = *(const LAS f32x4*)(XS + (ai * HALF + wr * 64 + m * 16 + fr) * 4);
                const float inv = frcp((ss[0] + ss[1]) + (ss[2] + ss[3])); bf16_t* rowp = base + (size_t)(row0 + ai * HALF + m * 16) * ldc + col0;
#pragma unroll
                for (int bj = 0; bj < 2; ++bj) { const f32x4 v0 = acc[ai][bj][m][0] * inv, v1 = acc[ai][bj][m][1] * inv;
                    u32x4 w; w.x = cvt_pk_bf16(v0[0], v0[1]); w.y = cvt_pk_bf16(v0[2], v0[3]); w.z = cvt_pk_bf16(v1[0], v1[1]); w.w = cvt_pk_bf16(v1[2], v1[3]);
                    *(u32x4*)(rowp + bj * HALF) = w; } }
    }
};

template <class Epi, bool ALIGN_EPI>
__device__ __forceinline__ void gemm_phase(LAS unsigned char* lds, LAS unsigned char* xl, const Gemm g, const Order& S, Epi& E) {
    const int tid = threadIdx.x, wid = __builtin_amdgcn_readfirstlane(tid >> 6), lane = tid & 63, wr = wid >> 2, wc = wid & 3, fr = lane & 15, fq = lane >> 4;
    const int K = g.K, nt = K / BK;
    unsigned voffA[2], voffB[2];
#pragma unroll
    for (int i = 0; i < 2; ++i) { int R, C; stage_rc(tid * 16 + i * 8192, R, C); const int Rb = Epi::PERM ? ((R & ~31) + perm32(R & 31)) : R;
        voffA[i] = (unsigned)(R * g.lda + C) * 2u; voffB[i] = (unsigned)(Rb * g.ldb + C) * 2u; }
    const size_t kstep = (size_t)(BK * 2);
    const size_t hstepA = (size_t)HALF * g.lda * 2, hstepB = (size_t)HALF * g.ldb * 2;
    const unsigned ldsw = (unsigned)wid * 1024u;
    const int aoff = lds_byte(wr * 64 + fr, fq * 8), boff = lds_byte(wc * 32 + fr, fq * 8);
#define PG8_SA(b, h) (((b) * 2 + (h)) * HTB)
#define PG8_SB(b, h) ((4 + (b) * 2 + (h)) * HTB)
#define PG8_STAGE(bufoff, gbase, voff) do { _Pragma("unroll") for (int _i = 0; _i < 2; ++_i) \
        __builtin_amdgcn_global_load_lds((const unsigned*)((const char*)(gbase) + (voff)[_i]), (LAS unsigned*)(lds + (bufoff) + ldsw + _i * 8192), 16, 0, 0); } while (0)
#define PG8_LDA(dst, b, h) do { _Pragma("unroll") for (int m = 0; m < 4; ++m) _Pragma("unroll") for (int k = 0; k < 2; ++k) dst[m][k] = *(const LAS bf16x8*)(lds + PG8_SA(b, h) + aoff + m * 2048 + k * 1024); } while (0)
#define PG8_LDB(dst, b, h) do { _Pragma("unroll") for (int n = 0; n < 2; ++n) _Pragma("unroll") for (int k = 0; k < 2; ++k) dst[n][k] = *(const LAS bf16x8*)(lds + PG8_SB(b, h) + boff + n * 2048 + k * 1024); } while (0)
#define PG8_MMA(ai, bj, At, Bt) do { __builtin_amdgcn_s_setprio(1); _Pragma("unroll") for (int m = 0; m < 4; ++m) _Pragma("unroll") for (int n = 0; n < 2; ++n) _Pragma("unroll") for (int k = 0; k < 2; ++k) \
        acc[ai][bj][m][n] = __builtin_amdgcn_mfma_f32_16x16x32_bf16(Bt[n][k], At[m][k], acc[ai][bj][m][n], 0, 0, 0); __builtin_amdgcn_s_setprio(0); } while (0)
#define PG8_WAIT_V(n) asm volatile("s_waitcnt vmcnt(" #n ")" ::: "memory")
#define PG8_WAIT_L(n) asm volatile("s_waitcnt lgkmcnt(" #n ")" ::: "memory")
#define PG8_BAR __builtin_amdgcn_s_barrier()
#define PG8_SCHED __builtin_amdgcn_sched_barrier(0)
    Unit cur, nxt; int ui = 0;
    if (!S.next(0, cur)) return;
    f32x4 acc[2][2][4][2];
#pragma unroll
    for (int a = 0; a < 2; ++a)
#pragma unroll
        for (int b = 0; b < 2; ++b)
#pragma unroll
            for (int m = 0; m < 4; ++m)
#pragma unroll
                for (int n = 0; n < 2; ++n) acc[a][b][m][n] = (f32x4){0.f, 0.f, 0.f, 0.f};
    bf16x8 At[4][2], B0[2][2], B1[2][2];
    const char* cA = (const char*)g.A + 2 * g.offA(cur); const char* cB = (const char*)g.Bt + 2 * g.offB(cur);
    PG8_STAGE(PG8_SB(0, 0), cB, voffB); PG8_STAGE(PG8_SB(0, 1), cB + hstepB, voffB); PG8_STAGE(PG8_SA(0, 0), cA, voffA); PG8_STAGE(PG8_SA(0, 1), cA + hstepA, voffA);
    if (wr == 1) PG8_BAR;
    PG8_WAIT_V(2); PG8_BAR;
    PG8_STAGE(PG8_SB(1, 0), cB + kstep, voffB); PG8_STAGE(PG8_SA(1, 0), cA + kstep, voffA); PG8_STAGE(PG8_SB(1, 1), cB + hstepB + kstep, voffB);
    PG8_WAIT_V(6); PG8_BAR;
    for (;;) {
        const bool has_next = S.next(ui + 1, nxt);
        const char* nA = has_next ? (const char*)g.A + 2 * g.offA(nxt) : cA; const char* nB = has_next ? (const char*)g.Bt + 2 * g.offB(nxt) : cB;
        for (int t = 0; t < nt; t += 2) {
            const bool last = (t == nt - 2);
            const char* a1 = cA + (size_t)(t + 1) * kstep;
            const char* a2 = last ? nA : cA + (size_t)(t + 2) * kstep; const char* b2 = last ? nB : cB + (size_t)(t + 2) * kstep;
            const char* a3 = a2 + kstep; const char* b3 = b2 + kstep;
            if constexpr (Epi::PSLDS) { if (last) {
                const char* psrc = (const char*)(E.PS + (size_t)((cur.z / g.zdiv) * g.psz + cur.pm) * (BM * 16)) + tid * 16;
#pragma unroll
                for (int _i = 0; _i < 2; ++_i) __builtin_amdgcn_global_load_lds((const unsigned*)(psrc + _i * 8192), (LAS unsigned*)(xl + 8192 + ldsw + _i * 8192), 16, 0, 0); } }
            PG8_LDB(B0, 0, 0); PG8_LDB(B1, 0, 1); PG8_SCHED; PG8_LDA(At, 0, 0); PG8_STAGE(PG8_SA(1, 1), a1 + hstepA, voffA);
            PG8_WAIT_V(8); PG8_WAIT_L(0); PG8_BAR; PG8_MMA(0, 0, At, B0); PG8_MMA(0, 1, At, B1); PG8_BAR; PG8_SCHED;
            PG8_LDA(At, 0, 1); PG8_STAGE(PG8_SB(0, 0), b2, voffB); PG8_STAGE(PG8_SB(0, 1), b2 + hstepB, voffB); PG8_STAGE(PG8_SA(0, 0), a2, voffA);
            PG8_WAIT_V(8); PG8_WAIT_L(0); PG8_BAR; PG8_MMA(1, 0, At, B0); PG8_MMA(1, 1, At, B1); PG8_BAR; PG8_SCHED;
            PG8_LDB(B0, 1, 0); PG8_LDB(B1, 1, 1); PG8_SCHED; PG8_LDA(At, 1, 0); PG8_STAGE(PG8_SA(0, 1), a2 + hstepA, voffA);
            PG8_WAIT_V(8); PG8_WAIT_L(0); PG8_BAR; PG8_MMA(0, 0, At, B0); PG8_MMA(0, 1, At, B1); PG8_BAR; PG8_SCHED;
            PG8_LDA(At, 1, 1); PG8_STAGE(PG8_SB(1, 0), b3, voffB); PG8_STAGE(PG8_SB(1, 1), b3 + hstepB, voffB); PG8_STAGE(PG8_SA(1, 0), a3, voffA);
            PG8_WAIT_V(8); PG8_WAIT_L(0); PG8_BAR; PG8_MMA(1, 0, At, B0); PG8_MMA(1, 1, At, B1); PG8_BAR; PG8_SCHED;
        }
        if constexpr (ALIGN_EPI) { if (wr == 0) PG8_BAR; }
        E(acc, cur, g.offC(cur), wr, wc, fr, fq, xl);
        if (!has_next) break;
#pragma unroll
        for (int a = 0; a < 2; ++a)
#pragma unroll
            for (int b = 0; b < 2; ++b)
#pragma unroll
                for (int m = 0; m < 4; ++m)
#pragma unroll
                    for (int n = 0; n < 2; ++n) acc[a][b][m][n] = (f32x4){0.f, 0.f, 0.f, 0.f};
        cur = nxt; cA = nA; cB = nB; ++ui;
        if constexpr (ALIGN_EPI) { if (wr == 1) PG8_BAR; }
    }
    PG8_WAIT_V(0);
    if constexpr (!ALIGN_EPI) { if (wr == 0) PG8_BAR; }
    PG8_BAR;
#undef PG8_SA
#undef PG8_SB
#undef PG8_STAGE
#undef PG8_LDA
#undef PG8_LDB
#undef PG8_MMA
#undef PG8_WAIT_V
#undef PG8_WAIT_L
#undef PG8_BAR
#undef PG8_SCHED
}
}

__device__ __forceinline__ f32x4 mfma16(bf16x8 bfrag, bf16x8 afrag, f32x4 acc) { return __builtin_amdgcn_mfma_f32_16x16x32_bf16(bfrag, afrag, acc, 0, 0, 0); }
__device__ __forceinline__ bf16x8 ldsfrag(const LAS bf16_t* base, int ld, int r0, int k0, int fr, int fq) { return *(const LAS bf16x8*)(base + (r0 + fr) * ld + k0 + fq * 8); }

template <int MODE> __device__ __forceinline__ void transpose_item(const float* W, int K, int N, bf16_t* WT, LAS float* scr, int item, int nblk, int lane, const float* gain = nullptr) {
    const int kb = item / nblk, nb = item % nblk, k0 = 64 * kb, n0 = 32 * nb; const int nsrc = n0 + (lane & 31);
    float wv_[32];
#pragma unroll
    for (int i = 0; i < 32; ++i) { const int kk = 2 * i + (lane >> 5); wv_[i] = (nsrc < N) ? W[(size_t)(k0 + kk) * N + nsrc] : 0.f; }
#pragma unroll
    for (int i = 0; i < 32; ++i) { const int kk = 2 * i + (lane >> 5); scr[kk * 33 + (lane & 31)] = wv_[i] * (gain ? gain[k0 + kk] : 1.f); }
    LDS_WAIT();
    const int c = lane & 7;
#pragma unroll
    for (int j = 0; j < 4; ++j) { const int n = (lane >> 3) + 8 * j; const LAS float* s = scr + (8 * c) * 33 + n;
        u32x4 o; o.x = pk2(s[0 * 33], s[1 * 33]); o.y = pk2(s[2 * 33], s[3 * 33]); o.z = pk2(s[4 * 33], s[5 * 33]); o.w = pk2(s[6 * 33], s[7 * 33]);
        int drow = n0 + n; if (MODE == 1) { const int jn = drow % FFN, isu = drow / FFN; drow = (jn / 128) * 256 + isu * 128 + (jn % 128); }
        *(u32x4*)(WT + (size_t)drow * K + k0 + 8 * c) = o; }
    LDS_WAIT();
}
__device__ __forceinline__ void rms_row_bf16(const float* xrow, const float* gain, bf16_t* orow, int lane) {
    const f32x4* xr = (const f32x4*)xrow + lane; f32x4 v[4]; float s = 0.f;
#pragma unroll
    for (int j = 0; j < 4; ++j) { v[j] = xr[64 * j]; s += (v[j].x * v[j].x + v[j].y * v[j].y) + (v[j].z * v[j].z + v[j].w * v[j].w); }
    const float rs = rsqrtf(wave_sum(s) * (1.f / D) + 1e-6f);
    const f32x4* gr = (const f32x4*)gain + lane; u32x2* o8 = (u32x2*)orow + lane;
#pragma unroll
    for (int j = 0; j < 4; ++j) { const f32x4 g = gr[64 * j]; u32x2 w; w.x = pk2(v[j].x * rs * g.x, v[j].y * rs * g.y); w.y = pk2(v[j].z * rs * g.z, v[j].w * rs * g.w); o8[64 * j] = w; }
}
__device__ __forceinline__ void rms_row2_bf16(const float* xa, const float* xb, const float* gain, bf16_t* oa, bf16_t* ob, int lane) {
    const f32x4* ra = (const f32x4*)xa + lane; const f32x4* rb = (const f32x4*)xb + lane; f32x4 va[4], vb[4]; float sa = 0.f, sb = 0.f;
#pragma unroll
    for (int j = 0; j < 4; ++j) { va[j] = ra[64 * j]; vb[j] = rb[64 * j]; }
#pragma unroll
    for (int j = 0; j < 4; ++j) { sa += (va[j].x * va[j].x + va[j].y * va[j].y) + (va[j].z * va[j].z + va[j].w * va[j].w); sb += (vb[j].x * vb[j].x + vb[j].y * vb[j].y) + (vb[j].z * vb[j].z + vb[j].w * vb[j].w); }
#pragma unroll
    for (int o = 1; o < 64; o <<= 1) { sa += __shfl_xor(sa, o); sb += __shfl_xor(sb, o); }
    const float rsa = rsqrtf(sa * (1.f / D) + 1e-6f), rsb = rsqrtf(sb * (1.f / D) + 1e-6f);
    const f32x4* gr = (const f32x4*)gain + lane; u32x2* pa = (u32x2*)oa + lane; u32x2* pb = (u32x2*)ob + lane;
#pragma unroll
    for (int j = 0; j < 4; ++j) { const f32x4 g = gr[64 * j]; u32x2 w;
        w.x = pk2(va[j].x * rsa * g.x, va[j].y * rsa * g.y); w.y = pk2(va[j].z * rsa * g.z, va[j].w * rsa * g.w); pa[64 * j] = w;
        w.x = pk2(vb[j].x * rsb * g.x, vb[j].y * rsb * g.y); w.y = pk2(vb[j].z * rsb * g.z, vb[j].w * rsb * g.w); pb[64 * j] = w; }
}
__device__ __forceinline__ void rms_rows_phase(const float* X, const float* gain, bf16_t* H, int nrows, int gw, int NGW, int lane) {
    int m = gw;
    for (; m + NGW < nrows; m += 2 * NGW) rms_row2_bf16(X + (size_t)m * D, X + (size_t)(m + NGW) * D, gain, H + (size_t)m * D, H + (size_t)(m + NGW) * D, lane);
    if (m < nrows) rms_row_bf16(X + (size_t)m * D, gain, H + (size_t)m * D, lane);
}

__device__ __forceinline__ void rwkv_chain(LAS unsigned char* lds, int cid, const bf16_t* P0, const float* mu, const float* w0, const float* w2, const float* a0, const float* a2,
                                           const float* k_k, const float* k_a, const float* r_k, bf16_t* ORW, bf16_t* SG, float* BONUS) {
    const int tid = threadIdx.x, lane = tid & 63, wid = tid >> 6, fr = lane & 15, fq = lane >> 4;
    const int b = cid >> 4, h = (cid >> 1) & 7, dir = cid & 1;
    LAS float* rS = (LAS float*)(lds); LAS float* kS = (LAS float*)(lds + 8192); LAS float* vS = (LAS float*)(lds + 16384); LAS float* wS = (LAS float*)(lds + 24576);
    LAS float* nkS = (LAS float*)(lds + 32768); LAS float* bS = (LAS float*)(lds + 40960); LAS float* preA = (LAS float*)(lds + 49152); LAS float* preW = (LAS float*)(lds + 57344);
    LAS bf16_t* adB = (LAS bf16_t*)(lds + 65536); LAS bf16_t* wdB = (LAS bf16_t*)(lds + 70144);
    LAS bf16_t* a2B = (LAS bf16_t*)(lds + 74752); LAS bf16_t* w2B = (LAS bf16_t*)(lds + 83968); LAS float* cst = (LAS float*)(lds + 93184);
    LAS bf16_t* At = (LAS bf16_t*)(lds + 97280); LAS bf16_t* Bt = (LAS bf16_t*)(lds + 101888); LAS bf16_t* Kt = (LAS bf16_t*)(lds + 106496); LAS bf16_t* Rt = (LAS bf16_t*)(lds + 111104);
    LAS bf16_t* BtT = (LAS bf16_t*)(lds + 115712); LAS bf16_t* KtT = (LAS bf16_t*)(lds + 120832); LAS bf16_t* VT = (LAS bf16_t*)(lds + 125952); LAS bf16_t* S0b = (LAS bf16_t*)(lds + 131072);
    LAS float* NT4 = (LAS float*)(lds + 140288); LAS bf16_t* NakT = (LAS bf16_t*)(lds + 146432); LAS bf16_t* MbrT = (LAS bf16_t*)(lds + 148992); LAS bf16_t* MkrT = (LAS bf16_t*)(lds + 151552);
    LAS float* gL = (LAS float*)(lds + 154112);
    LAS float* WS = preA;
    LAS bf16_t* Ub = (LAS bf16_t*)preW;
#define RW_IDS int tid_o = threadIdx.x; asm volatile("" : "+v"(tid_o)); const int tid = tid_o, lane = tid & 63, wid = __builtin_amdgcn_readfirstlane(tid >> 6), fr = lane & 15, fq = lane >> 4, vt = wid >> 1, tt2 = wid & 1; (void)lane; (void)wid; (void)fr; (void)fq; (void)vt; (void)tt2;
    __syncthreads();
    for (int e = tid; e < 64 * 64; e += 512) { const int j = e & 63, r = e >> 6;
        a2B[j * 72 + r] = (bf16_t)f2bf(a2[r * 512 + h * 64 + j]); w2B[j * 72 + r] = (bf16_t)f2bf(w2[(dir * 64 + r) * 512 + h * 64 + j]); }
    for (int e = tid; e < 64 * 72 / 2; e += 512) ((LAS unsigned*)S0b)[e] = 0u;
    if (tid < 64) { const int j = tid, c = h * 64 + j;
        cst[0 * 64 + j] = a0[c]; cst[1 * 64 + j] = w0[dir * 512 + c]; cst[2 * 64 + j] = k_k[c]; cst[3 * 64 + j] = k_a[c]; cst[4 * 64 + j] = r_k[c];
        cst[5 * 64 + j] = mu[c]; cst[6 * 64 + j] = mu[512 + c]; cst[7 * 64 + j] = mu[1024 + c]; cst[8 * 64 + j] = mu[1536 + j]; cst[9 * 64 + j] = mu[1600 + j];
        cst[10 * 64 + j] = (j < 16) ? mu[1664 + h * 16 + j] : 0.f; }
    const int vt = wid >> 1, tt2 = wid & 1;
    f32x4 st[2]; st[0] = (f32x4){0.f, 0.f, 0.f, 0.f}; st[1] = st[0];
    __syncthreads();
    const bf16_t* Pb = P0 + (size_t)b * SEQ * ABPAD;
    unsigned rc[10], rpv[10], rnx[10]; unsigned short gcv = 0, gpv = 0, gnv = 0;
#define RW_IDX(i) const int grp = (i) >> 1; const int idx_ = tid + 512 * ((i) & 1); const int tok = idx_ >> 5, c2 = (idx_ & 31) * 2; \
                  const int gcol = (grp == 0 ? h * 64 : grp == 1 ? 512 + h * 64 : grp == 2 ? 1024 + h * 64 : grp == 3 ? 1536 : 1600) + c2;
    const unsigned voff = (unsigned)((((int)threadIdx.x >> 5) * ABPAD + ((int)threadIdx.x & 31) * 2) * 2);
#define RW_CG(g) ((g) == 0 ? h * 128 : (g) == 1 ? 1024 + h * 128 : (g) == 2 ? 2048 + h * 128 : (g) == 3 ? 3072 : 3200)
#define RW_ISSUE(t0n) do { const char* bp_ = (const char*)(Pb + (size_t)(t0n) * ABPAD); const bool first_ = ((t0n) == 0) && (tid < 32), last_ = ((t0n) == SEQ - 32) && (tid >= 480); \
        _Pragma("unroll") for (int i = 0; i < 10; ++i) { const char* p = bp_ + (RW_CG(i >> 1) + (i & 1) * 16 * ABPAD * 2) + voff; \
            rc[i] = *(const unsigned*)p; \
            if ((i & 1) == 0) { const unsigned v_ = *(const unsigned*)(p - (first_ ? 0 : ABPAD * 2)); rpv[i] = first_ ? 0u : v_; rnx[i] = *(const unsigned*)(p + ABPAD * 2); } \
            else { const unsigned v_ = *(const unsigned*)(p + (last_ ? 0 : ABPAD * 2)); rnx[i] = last_ ? 0u : v_; rpv[i] = *(const unsigned*)(p - ABPAD * 2); } } \
        if (dir == 0) { const bool fg_ = ((t0n) == 0) && (tid < 16), lg_ = ((t0n) == SEQ - 32) && (tid >= 496); \
            const bf16_t* p = (const bf16_t*)bp_ + (size_t)(tid >> 4) * ABPAD + 1664 + h * 16 + (tid & 15); \
            gcv = *p; { const unsigned short v_ = *(p - (fg_ ? 0 : ABPAD)); gpv = fg_ ? (unsigned short)0 : v_; } { const unsigned short v_ = *(p + (lg_ ? 0 : ABPAD)); gnv = lg_ ? (unsigned short)0 : v_; } } } while (0)
    RW_ISSUE(dir ? 127 * 32 : 0);
    for (int cc = 0; cc < 128; ++cc) {
        const int t0 = dir ? (127 - cc) * 32 : cc * 32;
        { RW_IDS
#pragma unroll
        for (int i = 0; i < 10; ++i) { RW_IDX(i) (void)gcol;
            const unsigned cur = rc[i], prv = rpv[i], nxt = rnx[i];
            const float m0 = cst[(5 + grp) * 64 + c2], m1 = cst[(5 + grp) * 64 + c2 + 1];
            const float c0 = bflo(cur), c1 = bfhi(cur);
            const float x0 = c0 + m0 * (0.5f * (bflo(prv) + bflo(nxt)) - c0), x1 = c1 + m1 * (0.5f * (bfhi(prv) + bfhi(nxt)) - c1);
            if (grp == 0) { *(LAS f32x2*)(rS + tok * 64 + c2) = (f32x2){x0, x1}; }
            else if (grp == 1) { *(LAS f32x2*)(kS + tok * 64 + c2) = (f32x2){x0, x1}; }
            else if (grp == 2) { *(LAS f32x2*)(vS + tok * 64 + c2) = (f32x2){x0, x1}; }
            else if (grp == 3) { const float e0 = __expf(2.f * x0), e1 = __expf(2.f * x1); *(LAS unsigned*)(wdB + tok * 72 + c2) = pk2(1.f - 2.f * frcp(e0 + 1.f), 1.f - 2.f * frcp(e1 + 1.f)); }
            else { *(LAS unsigned*)(adB + tok * 72 + c2) = pk2(x0, x1); }
        }
        if (dir == 0) {
            const int tok = tid >> 4, c = tid & 15, t = t0 + tok;
            const float cur = bf2f(gcv), prv = bf2f(gpv), nxt = bf2f(gnv);
            const float x = cur + cst[10 * 64 + c] * (0.5f * (prv + nxt) - cur);
            SG[((size_t)b * SEQ + t) * 128 + h * 16 + c] = (bf16_t)f2bf(sigmoidf_(x));
        } }
        __syncthreads();
        if (cc + 1 < 128) { RW_IDS const int t0n = dir ? (126 - cc) * 32 : (cc + 1) * 32; RW_ISSUE(t0n); }
        { RW_IDS const int mat = wid >> 2, ntile = wid & 3; const LAS bf16_t* Aop = mat ? wdB : adB; const LAS bf16_t* Bop = mat ? w2B : a2B; LAS float* pre = mat ? preW : preA;
#pragma unroll
          for (int mt = 0; mt < 2; ++mt) { f32x4 acc = (f32x4){0.f, 0.f, 0.f, 0.f};
#pragma unroll
              for (int ks = 0; ks < 2; ++ks) acc = mfma16(ldsfrag(Bop, 72, ntile * 16, ks * 32, fr, fq), ldsfrag(Aop, 72, mt * 16, ks * 32, fr, fq), acc);
              *(LAS f32x4*)(pre + (mt * 16 + fr) * 64 + ntile * 16 + fq * 4) = acc; } }
        __syncthreads();
        { RW_IDS const int tok = tid >> 4, c0 = (tid & 15) * 4; float kkr[4], av[4], kp[4], wv[4]; float ss = 0.f, bon = 0.f;
#pragma unroll
          for (int i = 0; i < 4; ++i) { const int c = c0 + i, ix = tok * 64 + c;
              const float a = sigmoidf_(cst[c] + preA[ix]); const float sg = sigmoidf_(cst[64 + c] + preW[ix]);
              wv[i] = -0.60653065971f * sg;
              const float kraw = kS[ix]; kkr[i] = kraw * cst[128 + c]; ss += kkr[i] * kkr[i];
              kp[i] = kraw * (1.0f + (a - 1.0f) * cst[192 + c]); av[i] = a; bon += rS[ix] * kp[i] * cst[256 + c]; }
          ss += dppf<0xB1>(ss); bon += dppf<0xB1>(bon); ss += dppf<0x4E>(ss); bon += dppf<0x4E>(bon);
          ss += dppf<0x141>(ss); bon += dppf<0x141>(bon); ss += dppf<0x140>(ss); bon += dppf<0x140>(bon);
          const float inv = frcp(fmaxf(__builtin_amdgcn_sqrtf(ss), 1e-12f));
          f32x4 o_nk, o_b, o_k, o_w;
#pragma unroll
          for (int i = 0; i < 4; ++i) { const float kk = kkr[i] * inv; o_nk[i] = -kk; o_b[i] = kk * av[i]; o_k[i] = kp[i]; o_w[i] = wv[i]; }
          *(LAS f32x4*)(nkS + tok * 64 + c0) = o_nk; *(LAS f32x4*)(bS + tok * 64 + c0) = o_b; *(LAS f32x4*)(kS + tok * 64 + c0) = o_k; *(LAS f32x4*)(wS + tok * 64 + c0) = o_w;
          if (dir == 0 && (tid & 15) == 0) BONUS[((size_t)b * SEQ + t0 + tok) * 8 + h] = bon; }
        __syncthreads();
        { RW_IDS if (tid < 64) { float lw[32];
#pragma unroll
            for (int s = 0; s < 32; ++s) lw[s] = wS[(dir ? 31 - s : s) * 64 + tid];
#pragma unroll
            for (int s = 1; s < 32; ++s) lw[s] += lw[s - 1];
#pragma unroll
            for (int s = 0; s < 32; ++s) wS[(dir ? 31 - s : s) * 64 + tid] = lw[s]; } }
        __syncthreads();
        { RW_IDS const int s = tid >> 4, c0 = (tid & 15) * 4; const int tok = dir ? 31 - s : s, tokp = dir ? tok + 1 : tok - 1;
          const f32x4 cum = *(const LAS f32x4*)(wS + tok * 64 + c0); f32x4 cump = (f32x4){0.f, 0.f, 0.f, 0.f}; if (s > 0) cump = *(const LAS f32x4*)(wS + tokp * 64 + c0);
          const f32x4 nk4 = *(const LAS f32x4*)(nkS + tok * 64 + c0), b4 = *(const LAS f32x4*)(bS + tok * 64 + c0), k4 = *(const LAS f32x4*)(kS + tok * 64 + c0), r4 = *(const LAS f32x4*)(rS + tok * 64 + c0), v4 = *(const LAS f32x4*)(vS + tok * 64 + c0);
          float ta[4], tb[4], tk[4], tr[4];
#pragma unroll
          for (int i = 0; i < 4; ++i) { const float g = __expf(cum[i]), gp = __expf(cump[i]), ig = __expf(-cum[i]);
              ta[i] = nk4[i] * gp; tb[i] = b4[i] * ig; tk[i] = k4[i] * ig; tr[i] = r4[i] * g;
              BtT[(c0 + i) * 40 + s] = (bf16_t)f2bf(tb[i]); KtT[(c0 + i) * 40 + s] = (bf16_t)f2bf(tk[i]); VT[(c0 + i) * 40 + s] = (bf16_t)f2bf(v4[i]);
              if (s == 31) gL[c0 + i] = g; }
          u32x2 w; w.x = pk2(ta[0], ta[1]); w.y = pk2(ta[2], ta[3]); *(LAS u32x2*)(At + s * 72 + c0) = w;
          w.x = pk2(tb[0], tb[1]); w.y = pk2(tb[2], tb[3]); *(LAS u32x2*)(Bt + s * 72 + c0) = w;
          w.x = pk2(tk[0], tk[1]); w.y = pk2(tk[2], tk[3]); *(LAS u32x2*)(Kt + s * 72 + c0) = w;
          w.x = pk2(tr[0], tr[1]); w.y = pk2(tr[2], tr[3]); *(LAS u32x2*)(Rt + s * 72 + c0) = w; }
        __syncthreads();
        { RW_IDS const int mat = wid >> 1, mt = wid & 1; const LAS bf16_t* Aop = (mat < 2) ? At : Rt; const LAS bf16_t* Bop = (mat & 1) ? Kt : Bt;
#pragma unroll
          for (int nt = 0; nt < 2; ++nt) { f32x4 acc = (f32x4){0.f, 0.f, 0.f, 0.f};
#pragma unroll
              for (int ks = 0; ks < 2; ++ks) acc = mfma16(ldsfrag(Bop, 72, nt * 16, ks * 32, fr, fq), ldsfrag(Aop, 72, mt * 16, ks * 32, fr, fq), acc);
              const int srow = mt * 16 + fr;
#pragma unroll
              for (int e = 0; e < 4; ++e) { const int i = nt * 16 + fq * 4 + e; const bool keep = (mat < 2) ? (i < srow) : (i <= srow); if (!keep) acc[e] = 0.f; }
              if (mat == 0) {
#pragma unroll
                  for (int e = 0; e < 4; ++e) NT4[e * 384 + srow * 12 + nt * 4 + fq] = acc[e]; }
              else { LAS bf16_t* X = (mat == 1) ? NakT : (mat == 2) ? MbrT : MkrT; u32x2 o; o.x = pk2(acc[0], acc[1]); o.y = pk2(acc[2], acc[3]); *(LAS u32x2*)(X + srow * 40 + nt * 16 + fq * 4) = o; } } }
        __syncthreads();
        f32x4 oacc = (f32x4){0.f, 0.f, 0.f, 0.f};
        { RW_IDS f32x4 wacc = (f32x4){0.f, 0.f, 0.f, 0.f};
#pragma unroll
          for (int ks = 0; ks < 2; ++ks) { const bf16x8 sf = ldsfrag(S0b, 72, vt * 16, ks * 32, fr, fq);
              wacc = mfma16(ldsfrag(At, 72, tt2 * 16, ks * 32, fr, fq), sf, wacc); oacc = mfma16(ldsfrag(Rt, 72, tt2 * 16, ks * 32, fr, fq), sf, oacc); }
          const bf16x8 vf = ldsfrag(VT, 40, vt * 16, 0, fr, fq);
          wacc = mfma16(ldsfrag(NakT, 40, tt2 * 16, 0, fr, fq), vf, wacc); oacc = mfma16(ldsfrag(MkrT, 40, tt2 * 16, 0, fr, fq), vf, oacc);
#pragma unroll
          for (int n2 = 0; n2 < 2; ++n2) st[n2] = mfma16(ldsfrag(KtT, 40, (tt2 * 2 + n2) * 16, 0, fr, fq), vf, st[n2]);
#pragma unroll
          for (int e = 0; e < 4; ++e) WS[(tt2 * 16 + fq * 4 + e) * 64 + vt * 16 + fr] = wacc[e]; }
        __syncthreads();
        { RW_IDS if (wid < 4) { const int v = wid * 16 + (lane >> 2), p = lane & 3; const LAS float* NTp = NT4 + p * 384; float u[8];
#pragma unroll
            for (int j = 0; j < 8; ++j) u[j] = 0.f;
#pragma unroll
            for (int t = 0; t < 32; ++t) { float q0 = (p == 0) ? WS[t * 64 + v] : 0.f, q1 = 0.f;
#pragma unroll
                for (int j4 = 0; j4 < ((t + 3) / 4 + 3) / 4; ++j4) { const f32x4 nv = *(const LAS f32x4*)(NTp + t * 12 + j4 * 4);
                    q0 += u[j4 * 4] * nv[0]; q1 += u[j4 * 4 + 1] * nv[1]; q0 += u[j4 * 4 + 2] * nv[2]; q1 += u[j4 * 4 + 3] * nv[3]; }
                float q = q0 + q1; q += dppf<0xB1>(q); q += dppf<0x4E>(q);
                u[t >> 2] = ((t & 3) == p) ? q : u[t >> 2]; asm volatile("" ::: "memory"); }
#pragma unroll
            for (int j = 0; j < 8; ++j) Ub[v * 40 + 4 * j + p] = (bf16_t)f2bf(u[j]); } }
        __syncthreads();
        { RW_IDS const bf16x8 uf = ldsfrag(Ub, 40, vt * 16, 0, fr, fq);
          oacc = mfma16(ldsfrag(MbrT, 40, tt2 * 16, 0, fr, fq), uf, oacc);
#pragma unroll
          for (int e = 0; e < 4; ++e) { const int sidx = tt2 * 16 + fq * 4 + e, tok = dir ? 31 - sidx : sidx;
              ORW[(size_t)dir * T * 512 + ((size_t)b * SEQ + t0 + tok) * 512 + h * 64 + vt * 16 + fr] = (bf16_t)f2bf(oacc[e]); }
#pragma unroll
          for (int n2 = 0; n2 < 2; ++n2) { const int kt = tt2 * 2 + n2; st[n2] = mfma16(ldsfrag(BtT, 40, kt * 16, 0, fr, fq), uf, st[n2]);
              const f32x4 gl = *(const LAS f32x4*)(gL + kt * 16 + fq * 4); st[n2] = st[n2] * gl;
              u32x2 o; o.x = pk2(st[n2][0], st[n2][1]); o.y = pk2(st[n2][2], st[n2][3]); *(LAS u32x2*)(S0b + (vt * 16 + fr) * 72 + kt * 16 + fq * 4) = o; } }
    }
#undef RW_IDX
#undef RW_ISSUE
#undef RW_IDS
#undef RW_CG
    __syncthreads();
}

__device__ __forceinline__ void rwkv_combine(const bf16_t* P0, const bf16_t* ORW, const float* BONUS, const bf16_t* G, const float* mu, const float* gn_w, const float* gn_b, bf16_t* OMIX, int gw, int NGW, int lane) {
    const int c0 = lane * 8, head = lane >> 3;
    float muv[8], gw8[8], gb8[8];
#pragma unroll
    for (int i = 0; i < 8; ++i) { muv[i] = mu[1024 + c0 + i]; gw8[i] = gn_w[c0 + i]; gb8[i] = gn_b[c0 + i]; }
    for (int tk0 = gw; tk0 < T; tk0 += 2 * NGW) {
        u32x4 uf[2], ub[2], vc[2], vp[2], vn[2], gg[2]; float bon[2];
#pragma unroll
        for (int r2 = 0; r2 < 2; ++r2) { const int tk = tk0 + r2 * NGW; if (tk < T) { const int t = tk & (SEQ - 1);
            uf[r2] = *(const u32x4*)(ORW + (size_t)tk * 512 + c0); ub[r2] = *(const u32x4*)(ORW + (size_t)T * 512 + (size_t)tk * 512 + c0);
            const bf16_t* pv = P0 + (size_t)tk * ABPAD + 1024 + c0;
            vc[r2] = *(const u32x4*)pv; vp[r2] = (u32x4){0u, 0u, 0u, 0u}; vn[r2] = (u32x4){0u, 0u, 0u, 0u};
            if (t > 0) vp[r2] = *(const u32x4*)(pv - ABPAD);
            if (t < SEQ - 1) vn[r2] = *(const u32x4*)(pv + ABPAD);
            gg[r2] = *(const u32x4*)(G + (size_t)tk * 512 + c0); bon[r2] = BONUS[(size_t)tk * 8 + head]; } }
#pragma unroll
        for (int r2 = 0; r2 < 2; ++r2) { const int tk = tk0 + r2 * NGW; if (tk < T) {
            float o[8];
#pragma unroll
            for (int i = 0; i < 4; ++i) { o[2 * i] = bflo(uf[r2][i]) + bflo(ub[r2][i]); o[2 * i + 1] = bfhi(uf[r2][i]) + bfhi(ub[r2][i]); }
            float s_ = 0.f;
#pragma unroll
            for (int i = 0; i < 8; ++i) s_ += o[i];
            const float mean = sum8(s_) * (1.f / 64.f); float q = 0.f;
#pragma unroll
            for (int i = 0; i < 8; ++i) { o[i] -= mean; q += o[i] * o[i]; }
            const float rstd = rsqrtf(sum8(q) * (1.f / 64.f) + 64e-5f);
            float r[8];
#pragma unroll
            for (int i = 0; i < 4; ++i) {
                const float c_lo = bflo(vc[r2][i]), c_hi = bfhi(vc[r2][i]);
                const float v_lo = c_lo + muv[2 * i] * (0.5f * (bflo(vp[r2][i]) + bflo(vn[r2][i])) - c_lo), v_hi = c_hi + muv[2 * i + 1] * (0.5f * (bfhi(vp[r2][i]) + bfhi(vn[r2][i])) - c_hi);
                r[2 * i] = (o[2 * i] * rstd * gw8[2 * i] + gb8[2 * i] + bon[r2] * v_lo) * bflo(gg[r2][i]);
                r[2 * i + 1] = (o[2 * i + 1] * rstd * gw8[2 * i + 1] + gb8[2 * i + 1] + bon[r2] * v_hi) * bfhi(gg[r2][i]); }
            u32x4 w; w.x = pk2(r[0], r[1]); w.y = pk2(r[2], r[3]); w.z = pk2(r[4], r[5]); w.w = pk2(r[6], r[7]);
            *(u32x4*)(OMIX + (size_t)tk * D + c0) = w; } }
    }
}

constexpr int SLD = 136;
__device__ __forceinline__ float softplusf_(float x) { return x > 20.f ? x : log1pf(__expf(x)); }
__device__ __forceinline__ void ssd_dt_cum(LAS float* dtS, LAS float* cumS, LAS float* totS, const bf16_t* Prow0, int g, int w, int lane, const float* dt_bias, const float* a_log) {
    const int j = w >> 1, d = w & 1, head = g * 4 + j;
    const float bias = dt_bias[d * 8 + head], A = -__expf(a_log[d * 8 + head]);
    const float x0 = bf2f(Prow0[(size_t)(2 * lane) * ABPAD + 3328 + head]), x1 = bf2f(Prow0[(size_t)(2 * lane + 1) * ABPAD + 3328 + head]);
    const float dt0 = softplusf_(x0 + bias), dt1 = softplusf_(x1 + bias), la0 = dt0 * A, la1 = dt1 * A;
    const float s = la0 + la1; float inc = s;
#pragma unroll
    for (int off = 1; off < 64; off <<= 1) { const float n = __shfl_up(inc, off); if (lane >= off) inc += n; }
    const float tot = __shfl(inc, 63), exc = inc - s;
    float c0, c1; if (d == 0) { c0 = exc + la0; c1 = inc; } else { c0 = tot - exc; c1 = tot - exc - la0; }
    dtS[w * 128 + 2 * lane] = dt0; dtS[w * 128 + 2 * lane + 1] = dt1; cumS[w * 128 + 2 * lane] = c0; cumS[w * 128 + 2 * lane + 1] = c1;
    if (lane == 0) totS[w] = tot;
}
template <int NR, bool TR> __device__ __forceinline__ void ssd_conv8(LAS bf16_t* dst, int col0, int cx0, int l0, const bf16_t* Pb, int t0, const float* cw, const float* cb) {
    u32x4 raw[NR + 2];
    const bf16_t* p = Pb + (size_t)(t0 + l0) * ABPAD + 2304 + cx0;
#pragma unroll
    for (int i = 0; i < NR + 2; ++i) { const int t = t0 + l0 + i - 1; raw[i] = (t >= 0 && t < SEQ) ? *(const u32x4*)(p + (long)(i - 1) * ABPAD) : (u32x4){0u, 0u, 0u, 0u}; }
    float w0[8], w1[8], w2[8], bs[8];
#pragma unroll
    for (int q = 0; q < 2; ++q) { const f32x4 a = *(const f32x4*)(cw + cx0 + 4 * q), bq = *(const f32x4*)(cw + 1024 + cx0 + 4 * q), c = *(const f32x4*)(cw + 2048 + cx0 + 4 * q), d = *(const f32x4*)(cb + cx0 + 4 * q);
#pragma unroll
        for (int i = 0; i < 4; ++i) { w0[4 * q + i] = a[i]; w1[4 * q + i] = bq[i]; w2[4 * q + i] = c[i]; bs[4 * q + i] = d[i]; } }
    float o[NR][8];
#pragma unroll
    for (int i = 0; i < NR; ++i)
#pragma unroll
        for (int c = 0; c < 8; ++c) { const unsigned um = raw[i][c >> 1], u0 = raw[i + 1][c >> 1], up = raw[i + 2][c >> 1];
            const float fm = (c & 1) ? bfhi(um) : bflo(um), f0 = (c & 1) ? bfhi(u0) : bflo(u0), fp = (c & 1) ? bfhi(up) : bflo(up);
            o[i][c] = siluf_(w0[c] * fm + w1[c] * f0 + w2[c] * fp + bs[c]); }
    if (TR) {
#pragma unroll
        for (int c = 0; c < 8; ++c) { LAS bf16_t* q = dst + (col0 + c) * SLD + l0;
            if (NR == 8) { u32x4 w; w.x = pk2(o[0][c], o[1][c]); w.y = pk2(o[2][c], o[3][c]); w.z = pk2(o[4 % NR][c], o[5 % NR][c]); w.w = pk2(o[6 % NR][c], o[7 % NR][c]); *(LAS u32x4*)q = w; }
            else { u32x2 w; w.x = pk2(o[0][c], o[1][c]); w.y = pk2(o[2][c], o[3][c]); *(LAS u32x2*)q = w; } }
    } else {
#pragma unroll
        for (int i = 0; i < NR; ++i) { u32x4 w; w.x = pk2(o[i][0], o[i][1]); w.y = pk2(o[i][2], o[i][3]); w.z = pk2(o[i][4], o[i][5]); w.w = pk2(o[i][6], o[i][7]); *(LAS u32x4*)(dst + (l0 + i) * SLD + col0) = w; }
    }
}
__device__ __forceinline__ void ssd_s1_unit(LAS unsigned char* lds, int unit, const bf16_t* P0, const float* cw, const float* cb, const float* dt_bias, const float* a_log, bf16_t* STATES, float* TOT) {
    const int tid = threadIdx.x, lane = tid & 63, w = tid >> 6, fr = lane & 15, fq = lane >> 4;
    const int g = unit & 1, c = (unit >> 1) & 31, b = unit >> 6, t0 = c * 128;
    LAS bf16_t* BT = (LAS bf16_t*)lds; LAS bf16_t* XT = (LAS bf16_t*)(lds + 34816); LAS float* dtS = (LAS float*)(lds + 104448); LAS float* cumS = (LAS float*)(lds + 108544);
    LAS float* scS = (LAS float*)(lds + 112640); LAS float* totS = (LAS float*)(lds + 116736);
    const bf16_t* Pb = P0 + (size_t)b * SEQ * ABPAD;
    __syncthreads();
    ssd_conv8<4, true>(BT, (tid & 15) * 8, 512 + g * 128 + (tid & 15) * 8, (tid >> 4) * 4, Pb, t0, cw, cb);
    ssd_conv8<8, true>(XT, (tid & 31) * 8, g * 256 + (tid & 31) * 8, (tid >> 5) * 8, Pb, t0, cw, cb);
    ssd_dt_cum(dtS, cumS, totS, Pb + (size_t)t0 * ABPAD, g, w, lane, dt_bias, a_log);
    __syncthreads();
    for (int e = tid; e < 1024; e += 512) scS[e] = dtS[e] * __expf(totS[e >> 7] - cumS[e]);
    if (tid < 8) TOT[((size_t)(b * 32 + c) * 2 + (tid & 1)) * 8 + g * 4 + (tid >> 1)] = totS[tid];
    __syncthreads();
    const int j = w >> 1;
#pragma unroll 1
    for (int d = 0; d < 2; ++d) {
        f32x4 acc[2][8];
#pragma unroll
        for (int mt = 0; mt < 2; ++mt)
#pragma unroll
            for (int nt = 0; nt < 8; ++nt) acc[mt][nt] = (f32x4){0.f, 0.f, 0.f, 0.f};
#pragma unroll 1
        for (int ks = 0; ks < 4; ++ks) {
            const int k0 = ks * 32; const LAS float* sp = scS + (j * 2 + d) * 128 + k0 + fq * 8;
            const f32x4 s0 = *(const LAS f32x4*)sp, s1 = *(const LAS f32x4*)(sp + 4);
            bf16x8 afr[2];
#pragma unroll
            for (int mt = 0; mt < 2; ++mt) { const u32x4 raw = *(const LAS u32x4*)(XT + (32 * w + mt * 16 + fr) * SLD + k0 + fq * 8); u32x4 o;
                o.x = pk2(bflo(raw.x) * s0[0], bfhi(raw.x) * s0[1]); o.y = pk2(bflo(raw.y) * s0[2], bfhi(raw.y) * s0[3]);
                o.z = pk2(bflo(raw.z) * s1[0], bfhi(raw.z) * s1[1]); o.w = pk2(bflo(raw.w) * s1[2], bfhi(raw.w) * s1[3]);
                afr[mt] = __builtin_bit_cast(bf16x8, o); }
#pragma unroll
            for (int nt = 0; nt < 8; ++nt) { const bf16x8 bfr = ldsfrag(BT, SLD, nt * 16, k0, fr, fq);
#pragma unroll
                for (int mt = 0; mt < 2; ++mt) acc[mt][nt] = mfma16(bfr, afr[mt], acc[mt][nt]); }
        }
        bf16_t* dst = STATES + (((size_t)(b * 32 + c) * 2 + d) * 8 + g * 4 + j) * 8192;
#pragma unroll
        for (int mt = 0; mt < 2; ++mt) { const int p = (w & 1) * 32 + mt * 16 + fr;
#pragma unroll
            for (int nt = 0; nt < 8; ++nt) { u32x2 o; o.x = pk2(acc[mt][nt][0], acc[mt][nt][1]); o.y = pk2(acc[mt][nt][2], acc[mt][nt][3]);
                *(u32x2*)(dst + p * 128 + nt * 16 + fq * 4) = o; } }
    }
}
__device__ __forceinline__ void ssd_s2(const bf16_t* __restrict__ STATES, bf16_t* __restrict__ CARR, const float* __restrict__ TOT, int gtid, int NGT) {
    for (int it = gtid; it < 16 * 2 * 8 * 1024; it += NGT) {
        const int e8 = it & 1023, head = (it >> 10) & 7, d = (it >> 13) & 1, b = it >> 14;
        float run[8];
#pragma unroll
        for (int i = 0; i < 8; ++i) run[i] = 0.f;
#pragma unroll 1
        for (int c8 = 0; c8 < 32; c8 += 16) {
            u32x4 loc[16]; float dec[16];
#pragma unroll
            for (int q = 0; q < 16; ++q) { const int cc = c8 + q, c = d ? 31 - cc : cc; const size_t sidx = ((size_t)(b * 32 + c) * 2 + d) * 8 + head;
                loc[q] = *(const u32x4*)(STATES + sidx * 8192 + e8 * 8); dec[q] = TOT[sidx]; }
#pragma unroll
            for (int q = 0; q < 16; ++q) { const int cc = c8 + q, c = d ? 31 - cc : cc; const size_t sidx = ((size_t)(b * 32 + c) * 2 + d) * 8 + head;
                u32x4 o; o.x = pk2(run[0], run[1]); o.y = pk2(run[2], run[3]); o.z = pk2(run[4], run[5]); o.w = pk2(run[6], run[7]); *(u32x4*)(CARR + sidx * 8192 + e8 * 8) = o;
                const float dq = __expf(dec[q]);
#pragma unroll
                for (int i = 0; i < 4; ++i) { run[2 * i] = run[2 * i] * dq + bflo(loc[q][i]); run[2 * i + 1] = run[2 * i + 1] * dq + bfhi(loc[q][i]); } }
        }
    }
}
__device__ __forceinline__ void ssd_s3_unit(LAS unsigned char* lds, int unit, const bf16_t* P0, const float* cw, const float* cb, const float* dt_bias, const float* a_log, const float* dskip, const float* norm_w,
                                            const bf16_t* STATES, bf16_t* OMIX) {
    const int tid = threadIdx.x, lane = tid & 63, w = tid >> 6, fr = lane & 15, fq = lane >> 4;
    const int g = unit & 1, c = (unit >> 1) & 31, b = unit >> 6, t0 = c * 128;
    LAS bf16_t* CS = (LAS bf16_t*)lds; LAS bf16_t* BS = (LAS bf16_t*)(lds + 34816); LAS bf16_t* XT = (LAS bf16_t*)(lds + 69632);
    LAS float* dtS = (LAS float*)(lds + 139264); LAS float* cumS = (LAS float*)(lds + 143360); LAS float* totS = (LAS float*)(lds + 147456);
    const bf16_t* Pb = P0 + (size_t)b * SEQ * ABPAD;
    __syncthreads();
    ssd_conv8<4, false>(BS, (tid & 15) * 8, 512 + g * 128 + (tid & 15) * 8, (tid >> 4) * 4, Pb, t0, cw, cb);
    ssd_conv8<4, false>(CS, (tid & 15) * 8, 768 + g * 128 + (tid & 15) * 8, (tid >> 4) * 4, Pb, t0, cw, cb);
    ssd_conv8<8, true>(XT, (tid & 31) * 8, g * 256 + (tid & 31) * 8, (tid >> 5) * 8, Pb, t0, cw, cb);
    ssd_dt_cum(dtS, cumS, totS, Pb + (size_t)t0 * ABPAD, g, w, lane, dt_bias, a_log);
    __syncthreads();
    const int l = 16 * w + fr;
    f32x4 sc[8];
#pragma unroll
    for (int nt = 0; nt < 8; ++nt) sc[nt] = (f32x4){0.f, 0.f, 0.f, 0.f};
#pragma unroll
    for (int ks = 0; ks < 4; ++ks) { const bf16x8 afr = ldsfrag(CS, SLD, 16 * w, ks * 32, fr, fq);
#pragma unroll
        for (int nt = 0; nt < 8; ++nt) sc[nt] = mfma16(ldsfrag(BS, SLD, nt * 16, ks * 32, fr, fq), afr, sc[nt]); }
    __syncthreads();
    LAS bf16_t* Mw = BS + w * 16 * SLD;
    const size_t row = (size_t)b * SEQ + t0 + l; float ss = 0.f;
#pragma unroll 1
    for (int j = 0; j < 4; ++j) {
        const LAS float* cf = cumS + (j * 2) * 128; const LAS float* cbw = cumS + (j * 2 + 1) * 128; const LAS float* df = dtS + (j * 2) * 128; const LAS float* db = dtS + (j * 2 + 1) * 128;
        const float cfl = cf[l], cbl = cbw[l];
        const size_t sbase = ((size_t)(b * 32 + c) * 2) * 8 + g * 4 + j;
        const bf16_t* carf = STATES + sbase * 8192; const bf16_t* carb = STATES + (sbase + 8) * 8192;
        bf16x8 cF[4][4], cB[4][4]; u32x2 zz4[4];
#pragma unroll
        for (int ks = 0; ks < 4; ++ks)
#pragma unroll
            for (int pt = 0; pt < 4; ++pt) cF[ks][pt] = *(const bf16x8*)(carf + (pt * 16 + fr) * 128 + ks * 32 + fq * 8);
#pragma unroll
        for (int pt = 0; pt < 4; ++pt) zz4[pt] = *(const u32x2*)(P0 + row * ABPAD + 1792 + g * 256 + j * 64 + pt * 16 + fq * 4);
#pragma unroll
        for (int nt = 0; nt < 8; ++nt) { float mv[4];
#pragma unroll
            for (int i = 0; i < 4; ++i) { const int s = nt * 16 + fq * 4 + i;
                const float ff = (s <= l) ? __expf(cfl - cf[s]) * df[s] : 0.f; const float fb = (s >= l) ? __expf(cbl - cbw[s]) * db[s] : 0.f;
                mv[i] = sc[nt][i] * (ff + fb); }
            u32x2 o; o.x = pk2(mv[0], mv[1]); o.y = pk2(mv[2], mv[3]); *(LAS u32x2*)(Mw + fr * SLD + nt * 16 + fq * 4) = o; }
        LDS_WAIT();
#pragma unroll
        for (int ks = 0; ks < 4; ++ks)
#pragma unroll
            for (int pt = 0; pt < 4; ++pt) cB[ks][pt] = *(const bf16x8*)(carb + (pt * 16 + fr) * 128 + ks * 32 + fq * 8);
        f32x4 yd[4], yf[4], yb[4];
#pragma unroll
        for (int pt = 0; pt < 4; ++pt) { yd[pt] = (f32x4){0.f, 0.f, 0.f, 0.f}; yf[pt] = yd[pt]; yb[pt] = yd[pt]; }
        bf16x8 acs[4];
#pragma unroll
        for (int ks = 0; ks < 4; ++ks) {
            const bf16x8 am = *(const LAS bf16x8*)(Mw + fr * SLD + ks * 32 + fq * 8); acs[ks] = ldsfrag(CS, SLD, 16 * w, ks * 32, fr, fq);
#pragma unroll
            for (int pt = 0; pt < 4; ++pt) {
                yd[pt] = mfma16(ldsfrag(XT, SLD, j * 64 + pt * 16, ks * 32, fr, fq), am, yd[pt]);
                yf[pt] = mfma16(cF[ks][pt], acs[ks], yf[pt]); }
        }
#pragma unroll
        for (int ks = 0; ks < 4; ++ks)
#pragma unroll
            for (int pt = 0; pt < 4; ++pt) yb[pt] = mfma16(cB[ks][pt], acs[ks], yb[pt]);
        const float ef = __expf(cfl), eb = __expf(cbl), dsk = dskip[g * 4 + j];
#pragma unroll
        for (int pt = 0; pt < 4; ++pt) { const f32x4 yv = yd[pt] + yf[pt] * ef + yb[pt] * eb;
            const int col = j * 64 + pt * 16 + fq * 4; const u32x2 zz = zz4[pt];
            const float z4[4] = {bflo(zz.x), bfhi(zz.x), bflo(zz.y), bfhi(zz.y)}; float v4[4];
#pragma unroll
            for (int i = 0; i < 4; ++i) { const float xs = bf2f(XT[(col + i) * SLD + l]); float v = yv[i] + dsk * xs; const float z = z4[i]; v = v * siluf_(z);
                v4[i] = v; ss += v * v; }
            u32x2 o; o.x = pk2(v4[0], v4[1]); o.y = pk2(v4[2], v4[3]); *(u32x2*)(OMIX + row * D + 512 + g * 256 + col) = o; }
        asm volatile("" ::: "memory");
    }
    ss += __shfl_xor(ss, 16); ss += __shfl_xor(ss, 32);
    const float rs = rsqrtf(ss * (1.f / 256.f) + 1e-6f);
    asm volatile("s_waitcnt vmcnt(0)" ::: "memory");
#pragma unroll 4
    for (int q = 0; q < 16; ++q) { const int col = g * 256 + q * 16 + fq * 4; const f32x4 nw = *(const f32x4*)(norm_w + col);
        u32x2* p = (u32x2*)(OMIX + row * D + 512 + col); const u32x2 v = *p;
        u32x2 o; o.x = pk2(bflo(v.x) * rs * nw[0], bfhi(v.x) * rs * nw[1]); o.y = pk2(bflo(v.y) * rs * nw[2], bfhi(v.y) * rs * nw[3]); *p = o; }
}

constexpr int HLD = 136, HLS = 72;
__device__ __forceinline__ void hgrn_chain(LAS unsigned char* lds, int cid, bf16_t* P1, const float* hg_lb, bf16_t* Ob, int ldo, int ocbase, int ocdir) {
    const int tid = threadIdx.x, lane = tid & 63, w = tid >> 6, fr = lane & 15, fq = lane >> 4;
    const int b = cid >> 4, h = (cid >> 1) & 7, dir = cid & 1;
    LAS bf16_t* QE = (LAS bf16_t*)lds;
    LAS bf16_t* KE = (LAS bf16_t*)(lds + 17408);
    LAS bf16_t* KLT = (LAS bf16_t*)(lds + 34816);
    LAS bf16_t* VT = (LAS bf16_t*)(lds + 53248);
    LAS bf16_t* AT = (LAS bf16_t*)(lds + 71680);
    LAS bf16_t* ST = (LAS bf16_t*)(lds + 80896);
    LAS float* totS = (LAS float*)(lds + 115712);
    LAS float* lastS = (LAS float*)(lds + 117760);
    __syncthreads();
    for (int e = tid; e < 128 * HLD / 2; e += 512) ((LAS unsigned*)ST)[e] = 0u;
    const int dcol = tid & 127, qtr = tid >> 7, i0 = qtr * 16;
    const float lbv = frcp(1.0f + __expf(hg_lb[h * 128 + dcol] - hg_lb[1024 + h * 128 + dcol]));
    f32x4 st[8];
#pragma unroll
    for (int i = 0; i < 8; ++i) st[i] = (f32x4){0.f, 0.f, 0.f, 0.f};
    bf16_t* Pb = P1 + (size_t)b * SEQ * HGP;
    __syncthreads();
    unsigned short rq[16], rf[16], rv[16];
#define HG_ISSUE(t0n) do { _Pragma("unroll") for (int i = 0; i < 16; ++i) { const int tk = (t0n) + (dir ? 63 - (i0 + i) : (i0 + i)); const bf16_t* pr = Pb + (size_t)tk * HGP + h * 128 + dcol; \
        rq[i] = pr[0]; rf[i] = pr[1024 * (1 + dir)]; rv[i] = pr[3072]; } } while (0)
    HG_ISSUE((dir ? 63 : 0) * 64);
    for (int cc = 0; cc < 64; ++cc) {
        const int t0 = (dir ? 63 - cc : cc) * 64;
        float gq[16], gk[16], gc[16]; float run = 1.0f;
#pragma unroll
        for (int i = 0; i < 16; ++i) { const float q = bf2f(rq[i]), fr_ = bf2f(rf[i]);
            const float f = lbv + (1.0f - lbv) * sigmoidf_(fr_); run *= f; gq[i] = q; gk[i] = 1.0f - f; gc[i] = run; }
        totS[qtr * 128 + dcol] = run;
#pragma unroll
        for (int i = 0; i < 16; i += 2) *(LAS unsigned*)(VT + dcol * HLS + i0 + i) = (unsigned)rv[i] | ((unsigned)rv[i + 1] << 16);
        __syncthreads();
        { float pre = 1.0f, tot = 1.0f;
#pragma unroll
          for (int q4 = 0; q4 < 4; ++q4) { const float tq = totS[q4 * 128 + dcol]; if (q4 < qtr) pre *= tq; tot *= tq; }
          const float etot = tot;
          if (qtr == 0) lastS[dcol] = etot;
#pragma unroll
          for (int i = 0; i < 16; i += 2) { const float e0 = fmaxf(pre * gc[i], 1e-30f), e1 = fmaxf(pre * gc[i + 1], 1e-30f), n0 = frcp(e0), n1 = frcp(e1), l0 = etot * n0, l1 = etot * n1;
              QE[(i0 + i) * HLD + dcol] = (bf16_t)f2bf(gq[i] * e0); QE[(i0 + i + 1) * HLD + dcol] = (bf16_t)f2bf(gq[i + 1] * e1);
              KE[(i0 + i) * HLD + dcol] = (bf16_t)f2bf(gk[i] * n0); KE[(i0 + i + 1) * HLD + dcol] = (bf16_t)f2bf(gk[i + 1] * n1);
              *(LAS unsigned*)(KLT + dcol * HLS + i0 + i) = pk2(gk[i] * l0, gk[i + 1] * l1); } }
        if (cc + 1 < 64) HG_ISSUE((dir ? 62 - cc : cc + 1) * 64);
        __syncthreads();
        { const int mt = w >> 1;
#pragma unroll
          for (int n2 = 0; n2 < 2; ++n2) { const int nt = (w & 1) * 2 + n2; f32x4 acc = (f32x4){0.f, 0.f, 0.f, 0.f};
#pragma unroll
              for (int ks = 0; ks < 4; ++ks) acc = mfma16(ldsfrag(KE, HLD, nt * 16, ks * 32, fr, fq), ldsfrag(QE, HLD, mt * 16, ks * 32, fr, fq), acc);
              const int lrow = mt * 16 + fr; float mv[4];
#pragma unroll
              for (int i = 0; i < 4; ++i) { const int s = nt * 16 + fq * 4 + i; mv[i] = (s <= lrow) ? acc[i] : 0.f; }
              u32x2 o; o.x = pk2(mv[0], mv[1]); o.y = pk2(mv[2], mv[3]); *(LAS u32x2*)(AT + lrow * HLS + nt * 16 + fq * 4) = o; } }
        __syncthreads();
        { const int mt = w >> 1;
#pragma unroll
          for (int n4 = 0; n4 < 4; ++n4) { const int nt = (w & 1) * 4 + n4; f32x4 acc = (f32x4){0.f, 0.f, 0.f, 0.f};
#pragma unroll
              for (int ks = 0; ks < 2; ++ks) acc = mfma16(ldsfrag(VT, HLS, nt * 16, ks * 32, fr, fq), ldsfrag(AT, HLS, mt * 16, ks * 32, fr, fq), acc);
#pragma unroll
              for (int ks = 0; ks < 4; ++ks) acc = mfma16(ldsfrag(ST, HLD, nt * 16, ks * 32, fr, fq), ldsfrag(QE, HLD, mt * 16, ks * 32, fr, fq), acc);
              const int i = mt * 16 + fr, tk = t0 + (dir ? 63 - i : i);
              u32x2 o; o.x = pk2(acc[0], acc[1]); o.y = pk2(acc[2], acc[3]);
              *(u32x2*)(Ob + ((size_t)b * SEQ + tk) * ldo + ocbase + ocdir * dir + h * 128 + nt * 16 + fq * 4) = o; } }
#pragma unroll
        for (int nt = 0; nt < 8; ++nt) { const f32x4 el = *(const LAS f32x4*)(lastS + nt * 16 + fq * 4); st[nt] = st[nt] * el;
#pragma unroll
            for (int ks = 0; ks < 2; ++ks) st[nt] = mfma16(ldsfrag(KLT, HLS, nt * 16, ks * 32, fr, fq), ldsfrag(VT, HLS, w * 16, ks * 32, fr, fq), st[nt]); }
        __syncthreads();
#pragma unroll
        for (int nt = 0; nt < 8; ++nt) { u32x2 o; o.x = pk2(st[nt][0], st[nt][1]); o.y = pk2(st[nt][2], st[nt][3]); *(LAS u32x2*)(ST + (w * 16 + fr) * HLD + nt * 16 + fq * 4) = o; }
    }
    __syncthreads();
}
__device__ __forceinline__ void hgrn_combine(const bf16_t* P1, const float* norm_w, bf16_t* OMIX, int gw, int NGW, int lane) {
    const int c0 = lane * 16;
#pragma unroll 2
    for (int tk = gw; tk < T; tk += NGW) {
        const bf16_t* pr = P1 + (size_t)tk * HGP + c0; float o[16]; float ss = 0.f;
#pragma unroll
        for (int hh = 0; hh < 2; ++hh) { const u32x4 uf = *(const u32x4*)(pr + 1024 + hh * 8), ub = *(const u32x4*)(pr + 2048 + hh * 8);
#pragma unroll
            for (int i = 0; i < 4; ++i) { o[hh * 8 + 2 * i] = bflo(uf[i]) + bflo(ub[i]); o[hh * 8 + 2 * i + 1] = bfhi(uf[i]) + bfhi(ub[i]); } }
#pragma unroll
        for (int i = 0; i < 16; ++i) ss += o[i] * o[i];
        const float rs = rsqrtf(sum8(ss) * (1.f / 128.f) + 1e-6f);
#pragma unroll
        for (int hh = 0; hh < 2; ++hh) { const u32x4 ug = *(const u32x4*)(pr + 4096 + hh * 8); float r[8];
#pragma unroll
            for (int i = 0; i < 4; ++i) { const float g0 = bflo(ug[i]), g1 = bfhi(ug[i]);
                r[2 * i] = o[hh * 8 + 2 * i] * rs * norm_w[c0 + hh * 8 + 2 * i] * siluf_(g0);
                r[2 * i + 1] = o[hh * 8 + 2 * i + 1] * rs * norm_w[c0 + hh * 8 + 2 * i + 1] * siluf_(g1); }
            u32x4 wv; wv.x = pk2(r[0], r[1]); wv.y = pk2(r[2], r[3]); wv.z = pk2(r[4], r[5]); wv.w = pk2(r[6], r[7]);
            *(u32x4*)(OMIX + (size_t)tk * D + c0 + hh * 8) = wv; }
    }
}

#define XB_TMO      128
#define XB_XCNT(j)  (256  + 64 * (j))
#define XB_XSUB(j)  (1280 + 64 * (j))
#define XB_XGEN(j)  (2304 + 64 * (j))
#define XB_TOP      3328
#define XB_TOPGEN   3392
#define XCD_BAR_WORDS 3456
#define XB_SPIN_CAP (1u << 18)

__device__ __forceinline__ unsigned xb_ld(unsigned* p)              { return __hip_atomic_load(p, __ATOMIC_RELAXED, __HIP_MEMORY_SCOPE_AGENT); }
__device__ __forceinline__ unsigned xb_add(unsigned* p, unsigned v) { return __hip_atomic_fetch_add(p, v, __ATOMIC_RELAXED, __HIP_MEMORY_SCOPE_AGENT); }
__device__ __forceinline__ unsigned xb_xcc_id() { return (unsigned)__builtin_amdgcn_s_getreg((3 << 11) | 20) & 0xFu; }
#define XB_SPIN(cond, bar) do { unsigned _sp = 0; while (cond) { __builtin_amdgcn_s_sleep(1); \
    if ((++_sp & 255u) == 0u) { if (xb_ld(&(bar)[XB_TMO])) break; if (_sp > XB_SPIN_CAP) { atomicAdd(&(bar)[XB_TMO], 1u); break; } } } } while (0)

struct XcdBarrier {
    unsigned* bar; unsigned x;
    volatile LAS unsigned* st;
};

__device__ __forceinline__ XcdBarrier xcd_barrier_post(unsigned* bar, volatile LAS unsigned* st) {
    XcdBarrier b; b.bar = bar; b.x = xb_xcc_id(); b.st = st;
    if (threadIdx.x == 0) (void)xb_add(&bar[XB_XCNT(b.x)], 1u);
    return b;
}
__device__ __forceinline__ void xcd_barrier_complete(unsigned* bar, unsigned x, unsigned& nloc, unsigned& nx) {
    const unsigned G = gridDim.x * gridDim.y * gridDim.z;
    unsigned sum, cnt, mine, sp = 0u;
    for (;;) {
        sum = 0u; cnt = 0u; mine = 0u;
#pragma unroll
        for (unsigned j = 0; j < 16; ++j) { const unsigned c = xb_ld(&bar[XB_XCNT(j)]); sum += c; cnt += (c > 0u) ? 1u : 0u; mine = (j == x) ? c : mine; }
        if (sum == G) break;
        __builtin_amdgcn_s_sleep(1);
        if ((++sp & 255u) == 0u) { if (xb_ld(&bar[XB_TMO])) break; if (sp > XB_SPIN_CAP) { atomicAdd(&bar[XB_TMO], 1u); break; } }
    }
    nloc = mine > 0u ? mine : 1u; nx = cnt > 0u ? cnt : 1u;
}

__device__ __forceinline__ void xcd_barrier(const XcdBarrier& b) {
    asm volatile("s_waitcnt vmcnt(0)" ::: "memory");
    __syncthreads();
    if (threadIdx.x == 0) {
        unsigned* bar = b.bar;
        __builtin_amdgcn_s_waitcnt(0);
        unsigned nloc = b.st[0], nx = b.st[1];
        if (nloc == 0u) { xcd_barrier_complete(bar, b.x, nloc, nx); b.st[0] = nloc; b.st[1] = nx; }
        const unsigned old = xb_add(&bar[XB_XSUB(b.x)], 1u);
        const unsigned gen = old / nloc;
        if (old + 1u == (gen + 1u) * nloc) {
            __builtin_amdgcn_fence(__ATOMIC_RELEASE, "agent");
            asm volatile("s_waitcnt vmcnt(0)" ::: "memory");
            const unsigned og = xb_add(&bar[XB_TOP], 1u);
            const unsigned tg = og / nx;
            if (og + 1u == (tg + 1u) * nx) xb_add(&bar[XB_TOPGEN], 1u);
            else XB_SPIN(xb_ld(&bar[XB_TOPGEN]) == tg, bar);
            __builtin_amdgcn_fence(__ATOMIC_ACQUIRE, "agent");
            xb_add(&bar[XB_XGEN(b.x)], 1u);
            asm volatile("s_waitcnt vmcnt(0)" ::: "memory");
        } else {
            XB_SPIN(xb_ld(&bar[XB_XGEN(b.x)]) == gen, bar);
            __builtin_amdgcn_fence(__ATOMIC_ACQUIRE, "agent");
            asm volatile("s_waitcnt vmcnt(0)" ::: "memory");
        }
    }
    __syncthreads();
}


struct Args { const float* in[35]; float* out; unsigned char* ws; int ph_lo, ph_hi; };
static_assert(sizeof(Args) == 304, "Args layout");

__global__ void __launch_bounds__(512, 2) mk_fwd(Args args) {
    extern __shared__ __attribute__((aligned(16))) unsigned char lds_raw[];
    LAS unsigned char* lds = (LAS unsigned char*)lds_raw; LAS unsigned char* xl = lds + XLDS_OFF;
    const int G = gridDim.x, bx = blockIdx.x, NGW = G * 8;
#define LOCAL_IDS int tid = threadIdx.x; asm volatile("" : "+v"(tid)); const int lane = tid & 63, wave = __builtin_amdgcn_readfirstlane(tid >> 6), gw = bx * 8 + wave; (void)lane; (void)gw;
    typedef const __attribute__((address_space(4))) unsigned char* kaptr_t;
    kaptr_t ka = (kaptr_t)__builtin_amdgcn_kernarg_segment_ptr();
#define INP(k) (*(const float* const volatile __attribute__((address_space(4)))*)(ka + 8 * (k)))
    unsigned char* ws = *(unsigned char* const volatile __attribute__((address_space(4)))*)(ka + 288); float* out = *(float* const volatile __attribute__((address_space(4)))*)(ka + 280);
    const float* x = INP(0);
    bf16_t* WAB = (bf16_t*)(ws + WS_WAB); bf16_t* WABO = (bf16_t*)(ws + WS_WABO); bf16_t* WHG = (bf16_t*)(ws + WS_WHG); bf16_t* WHGO = (bf16_t*)(ws + WS_WHGO);
    bf16_t* WQ = (bf16_t*)(ws + WS_WQ); bf16_t* WKV = (bf16_t*)(ws + WS_WKV); bf16_t* WO = (bf16_t*)(ws + WS_WO); bf16_t* WF1 = (bf16_t*)(ws + WS_WF1); bf16_t* WF2 = (bf16_t*)(ws + WS_WF2);
    bf16_t* G2T = (bf16_t*)(ws + WS_G2T); bf16_t* MEMN = (bf16_t*)(ws + WS_MEMN); bf16_t* KMEM = (bf16_t*)(ws + WS_KMEM);
    bf16_t* WKT = (bf16_t*)out; bf16_t* VWT = (bf16_t*)((unsigned char*)out + 64 * MiB);
    bf16_t* H = (bf16_t*)(ws + WS_H); bf16_t* P = (bf16_t*)(ws + WS_P); bf16_t* PATT = (bf16_t*)(ws + WS_PATT); bf16_t* OMIX0 = (bf16_t*)(ws + WS_OMIX0); bf16_t* OMIX1 = (bf16_t*)(ws + WS_OMIX1); float* PSB = (float*)(ws + WS_PS);
#define COMMA ,
    bf16_t* STATES = (bf16_t*)((unsigned char*)out + DO_STATES); bf16_t* GG = (bf16_t*)((unsigned char*)out + DO_G); bf16_t* SG = (bf16_t*)((unsigned char*)out + DO_SG);
    float* BONUS = (float*)((unsigned char*)out + DO_BONUS); float* TOT = (float*)((unsigned char*)out + DO_TOT);
    cg::grid_group grid = cg::this_grid();
    { volatile LAS unsigned* st_ = (volatile LAS unsigned*)(lds + LDS_BYTES - 16); if (threadIdx.x < 4) st_[threadIdx.x] = 0u; }
    __syncthreads();
    const XcdBarrier xbar = xcd_barrier_post((unsigned*)ws, (volatile LAS unsigned*)(lds + LDS_BYTES - 16));
    const int lo = *(const int volatile __attribute__((address_space(4)))*)(ka + 296), hi = *(const int volatile __attribute__((address_space(4)))*)(ka + 300);
#ifndef PH_EN
#define PH_EN(k) 1
#endif
#define IN(k) (PH_EN(k) && lo <= (k) && (k) < hi)
#ifndef DUP_MASK
#define DUP_MASK 0ull
#endif
#define REPS(k) (1 + (int)(((unsigned long long)(DUP_MASK) >> (k)) & 1ull))
#define PHASE(k) for (int rep_ = 0; rep_ < (IN(k) ? REPS(k) : 0); ++rep_, ((REPS(k) > 1) ? (grid.sync(), 0) : 0))
#define SEAM(k) do { if (IN(k) && IN((k) + 1)) xcd_barrier(xbar); } while (0)
    if (lo < 0) grid.sync();
#define RUN_GEMM(EPI, ALIGN, gd, ep) do { pg8::Order S_; S_.init(gd, G, bx); pg8::gemm_phase<EPI, ALIGN>(lds, xl, gd, S_, ep); } while (0)

    PHASE(0) { LOCAL_IDS
        LAS float* scr = (LAS float*)(lds + wave * 16384);
        constexpr int I_AB = 16 * 112, I_SQ = 16 * 32, I_HG = 16 * 160, I_KV = 16 * 64, I_F1 = 16 * 176, I_F2 = 44 * 32, I_G2 = 2 * 16;
        constexpr int NIT = I_AB + I_SQ + I_HG + I_SQ + 2 * I_KV + 2 * I_SQ + 2 * I_F1 + 2 * I_F2 + I_G2;
        for (int it = gw; it < NIT; it += NGW) {
            int r = it;
            if (r < I_AB) { transpose_item<0>(INP(3), 1024, ABP, WAB, scr, r, 112, lane); continue; } r -= I_AB;
            if (r < I_SQ) { transpose_item<0>(INP(4), 1024, 1024, WABO, scr, r, 32, lane); continue; } r -= I_SQ;
            if (r < I_HG) { transpose_item<0>(INP(22), 1024, HGP, WHG, scr, r, 160, lane, INP(2) + D); continue; } r -= I_HG;
            if (r < I_SQ) { transpose_item<0>(INP(23), 1024, 1024, WHGO, scr, r, 32, lane); continue; } r -= I_SQ;
            if (r < 2 * I_KV) { const int l = r / I_KV; transpose_item<0>(INP(29) + (size_t)l * D * 2048, 1024, 2048, WKV + (size_t)l * D * 2048, scr, r % I_KV, 64, lane); continue; } r -= 2 * I_KV;
            if (r < 2 * I_SQ) { const int l = r / I_SQ; transpose_item<0>(INP(30) + (size_t)l * D * D, 1024, 1024, WO + (size_t)l * D * D, scr, r % I_SQ, 32, lane); continue; } r -= 2 * I_SQ;
            if (r < 2 * I_F1) { const int l = r / I_F1; transpose_item<1>(INP(32) + (size_t)l * D * 2 * FFN, 1024, 2 * FFN, WF1 + (size_t)l * D * 2 * FFN, scr, r % I_F1, 176, lane, INP(31) + l * D); continue; } r -= 2 * I_F1;
            if (r < 2 * I_F2) { const int l = r / I_F2; transpose_item<0>(INP(33) + (size_t)l * FFN * D, FFN, 1024, WF2 + (size_t)l * FFN * D, scr, r % I_F2, 32, lane); continue; } r -= 2 * I_F2;
            transpose_item<0>(INP(10), 128, 512, G2T, scr, r, 16, lane);
        }
        for (size_t e8 = (size_t)bx * 512 + tid; e8 < (size_t)2 * D * D / 8; e8 += (size_t)G * 512) { const size_t idx = e8 * 8; const int l = (int)(idx / ((size_t)D * D)), k = (int)((idx % ((size_t)D * D)) / D);
            const float gk = INP(26)[l * D + k]; const f32x4 a0 = *(const f32x4*)(INP(28) + idx), a1 = *(const f32x4*)(INP(28) + idx + 4);
            u32x4 o; o.x = pk2(a0[0] * gk, a0[1] * gk); o.y = pk2(a0[2] * gk, a0[3] * gk); o.z = pk2(a1[0] * gk, a1[1] * gk); o.w = pk2(a1[2] * gk, a1[3] * gk); *(u32x4*)(WQ + idx) = o; }
        rms_rows_phase(x, INP(2), H, T, gw, NGW, lane);
        for (int l = 0; l < 2; ++l) { int r = gw;
            for (; r + NGW < 4096; r += 2 * NGW) rms_row2_bf16(INP(1) + (size_t)r * D, INP(1) + (size_t)(r + NGW) * D, INP(27) + l * D, MEMN + ((size_t)l * 4096 + r) * D, MEMN + ((size_t)l * 4096 + r + NGW) * D, lane);
            if (r < 4096) rms_row_bf16(INP(1) + (size_t)r * D, INP(27) + l * D, MEMN + ((size_t)l * 4096 + r) * D, lane); }
        __syncthreads();
    }
    SEAM(0);
    PHASE(1) {
        { pg8::Gemm g = pg8::make_gemm(H, WAB, T, ABPAD, 1024, 1024, 1024); pg8::EpiBf16 E{P, ABPAD, 1.0f, nullptr}; RUN_GEMM(pg8::EpiBf16, true, g, E); }
        { pg8::Gemm g = pg8::make_gemm(MEMN, WKV, 4096, 2048, 1024, 1024, 1024); g.nZ = 2; g.sAo = 4096L * D; g.sBo = 2048L * D; g.sCo = 4096L * 2048; pg8::EpiBf16 E{KMEM, 2048, 1.0f, nullptr}; RUN_GEMM(pg8::EpiBf16, true, g, E); }
    }
    SEAM(1);
    PHASE(2) {
#ifndef DUP_RWKV
#define DUP_RWKV 0
#endif
#ifndef DUP_S1
#define DUP_S1 0
#endif
        for (int r2 = 0; r2 <= DUP_RWKV; ++r2)
        for (int cid = bx; cid < 256; cid += G)
            rwkv_chain(lds, cid, P, INP(5), INP(6), INP(7), INP(8), INP(9), INP(11), INP(12), INP(13), H, SG, BONUS);
        for (int r2 = 0; r2 <= DUP_S1; ++r2)
        for (int u = bx; u < 1024; u += G) ssd_s1_unit(lds, u, P, INP(16), INP(17), INP(18), INP(19), STATES, TOT);
        __syncthreads();
    }
    SEAM(2);
    PHASE(3) {
        { int k128 = 128; asm volatile("" : "+s"(k128)); pg8::Gemm g = pg8::make_gemm(SG, G2T, T, 512, k128, 128, 128); pg8::EpiBf16 E{GG, 512, 1.0f, nullptr}; RUN_GEMM(pg8::EpiBf16, true, g, E); }
        { LOCAL_IDS ssd_s2(STATES, OMIX1, TOT, bx * 512 + tid, G * 512); }
    }
    SEAM(3);
    PHASE(4) {
#ifndef DUP_S3
#define DUP_S3 0
#endif
        for (int r2 = 0; r2 <= DUP_S3; ++r2)
        for (int u = bx; u < 1024; u += G) ssd_s3_unit(lds, u, P, INP(16), INP(17), INP(18), INP(19), INP(20), INP(21), OMIX1, OMIX0);
        __syncthreads();
        { LOCAL_IDS rwkv_combine(P, H, BONUS, GG, INP(5), INP(14), INP(15), OMIX0, gw, NGW, lane); }
    }
    SEAM(4);
    PHASE(5) { { pg8::Gemm g = pg8::make_gemm(OMIX0, WABO, T, 1024, 1024, 1024, 1024); pg8::EpiResidB E{x, H, PSB, 1024}; RUN_GEMM(pg8::EpiResidB, true, g, E); }
        for (int l = 0; l < 2; ++l) {
            { pg8::Gemm g = pg8::make_gemm(KMEM + (size_t)l * 4096 * 2048, WQ + (size_t)l * D * D, 256, 1024, 256, 2048, 1024); g.nZ = 64; g.zdiv = 4;
              g.sAo = 256L * 2048; g.sAi = 256; g.sBo = 0; g.sBi = 256; g.sCo = 4L * 256 * 1024; g.sCi = 256L * 1024; pg8::EpiBf16 E{WKT + (size_t)l * 16777216, 1024, 0.0625f, nullptr}; RUN_GEMM(pg8::EpiBf16, true, g, E); }
            { pg8::Gemm g = pg8::make_gemm(WO + (size_t)l * D * D, KMEM + (size_t)l * 4096 * 2048 + 1024, 1024, 256, 256, 1024, 2048); g.nZ = 64; g.zdiv = 4;
              g.sAo = 0; g.sAi = 256; g.sBo = 256L * 2048; g.sBi = 256; g.sCo = 1024L * 1024; g.sCi = 256; pg8::EpiBf16 E{VWT + (size_t)l * 16777216, 1024, 1.0f, nullptr}; RUN_GEMM(pg8::EpiBf16, true, g, E); }
        } }
    SEAM(5);

#define ATTN_FFN(base, L) \
    PHASE(base) { pg8::Gemm g = pg8::make_gemm(H, WKT + (size_t)(L) * 16777216, SEQ, 256, 1024, 1024, 1024); g.nZ = 64; g.zdiv = 4; g.psz = 16; \
        g.sAo = (long)SEQ * D; g.sAi = 0; g.sBo = 4L * 256 * 1024; g.sBi = 256L * 1024; g.sCo = (long)SEQ * D; g.sCi = 256; pg8::EpiSoftmaxPS E{PSB, PATT, 1024}; RUN_GEMM(pg8::EpiSoftmaxPS, true, g, E); } \
    SEAM(base); \
    PHASE(base + 1) { pg8::Gemm g = pg8::make_gemm(PATT, VWT + (size_t)(L) * 16777216, SEQ, 1024, 1024, 1024, 1024); g.nZ = 16; g.zdiv = 1; \
        g.sAo = (long)SEQ * D; g.sBo = 1024L * 1024; g.sCo = (long)SEQ * D; pg8::EpiResidB E{nullptr, H, PSB, 1024}; RUN_GEMM(pg8::EpiResidB, true, g, E); } \
    SEAM(base + 1); \
    PHASE(base + 2) { pg8::Gemm g = pg8::make_gemm(H, WF1 + (size_t)(L) * D * 2 * FFN, T, 2 * FFN, 1024, 1024, 1024); pg8::EpiSwiglu E{P, FFN, PSB}; RUN_GEMM(pg8::EpiSwiglu, true, g, E); } \
    SEAM(base + 2); \
    PHASE(base + 3) { pg8::Gemm g = pg8::make_gemm(P, WF2 + (size_t)(L) * FFN * D, T, 1024, FFN, FFN, FFN); pg8::EpiResidB E{nullptr, H, PSB, 1024}; RUN_GEMM(pg8::EpiResidB, true, g, E); } \
    SEAM(base + 3);

    ATTN_FFN(6, 0)

    PHASE(10) { pg8::Gemm g = pg8::make_gemm(H, WHG, T, HGP, 1024, 1024, 1024); pg8::EpiBf16PS E{P, HGP, 1.0f, PSB}; RUN_GEMM(pg8::EpiBf16PS, true, g, E); }
    SEAM(10);
    PHASE(11) { for (int cid = bx; cid < 256; cid += G) hgrn_chain(lds, cid, P, INP(25), P, HGP, 1024, 1024); }
    SEAM(11);
    PHASE(12) { LOCAL_IDS hgrn_combine(P, INP(24), OMIX1, gw, NGW, lane); }
    SEAM(12);
    PHASE(13) { pg8::Gemm g = pg8::make_gemm(OMIX1, WHGO, T, 1024, 1024, 1024, 1024); pg8::EpiResidB E{nullptr, H, PSB, 1024}; RUN_GEMM(pg8::EpiResidB, true, g, E); }
    SEAM(13);

    ATTN_FFN(14, 1)

    PHASE(18) { LOCAL_IDS
        const float* fg = INP(34);
        f32x4 g0[2], g1[2];
#pragma unroll
        for (int j = 0; j < 2; ++j) { const int c = (lane + 64 * j) * 8; g0[j] = *(const f32x4*)(fg + c); g1[j] = *(const f32x4*)(fg + c + 4); }
        for (int m0 = gw; m0 < T; m0 += 4 * NGW) {
            f32x4 pa[4]; u32x4 hv[4][2];
#pragma unroll
            for (int r = 0; r < 4; ++r) { const int m = m0 + r * NGW; if (m < T) { pa[r] = *(const f32x4*)(PSB + (size_t)m * 16 + (lane & 3) * 4);
#pragma unroll
                for (int j = 0; j < 2; ++j) hv[r][j] = *(const u32x4*)(H + (size_t)m * D + (lane + 64 * j) * 8); } }
#pragma unroll
            for (int r = 0; r < 4; ++r) { const int m = m0 + r * NGW; if (m < T) {
                float sq = (pa[r][0] + pa[r][1]) + (pa[r][2] + pa[r][3]); sq += __shfl_xor(sq, 1); sq += __shfl_xor(sq, 2);
                const float rs = rsqrtf(sq * (1.f / D) + 1e-6f); float* orow = out + (size_t)m * D;
#pragma unroll
                for (int j = 0; j < 2; ++j) { const int c = (lane + 64 * j) * 8; const u32x4 h4 = hv[r][j];
                    *(f32x4*)(orow + c) = (f32x4){bflo(h4.x) * rs * g0[j][0], bfhi(h4.x) * rs * g0[j][1], bflo(h4.y) * rs * g0[j][2], bfhi(h4.y) * rs * g0[j][3]};
                    *(f32x4*)(orow + c + 4) = (f32x4){bflo(h4.z) * rs * g1[j][0], bfhi(h4.z) * rs * g1[j][1], bflo(h4.w) * rs * g1[j][2], bfhi(h4.w) * rs * g1[j][3]}; } } }
        }
    }
#undef IN
#undef SEAM
#undef RUN_GEMM
}

extern "C" void kernel_launch(void* const* d_in, const int* in_sizes, int n_in, void* d_out, int out_size, void* d_ws, size_t ws_size, hipStream_t stream) {
    static int grid = 0;
    if (grid == 0) {
        if (n_in != 35 || out_size != T * D || ws_size < WS_END) { fprintf(stderr, "kernel_launch: unexpected shapes (n_in %d out %d ws %zu)\n", n_in, out_size, ws_size); grid = -1; return; }
        int dev = 0, cus = 0, per_cu = 0;
        hipGetDevice(&dev); hipDeviceGetAttribute(&cus, hipDeviceAttributeMultiprocessorCount, dev);
        hipFuncSetAttribute((const void*)mk_fwd, hipFuncAttributeMaxDynamicSharedMemorySize, LDS_BYTES);
        hipOccupancyMaxActiveBlocksPerMultiprocessor(&per_cu, (const void*)mk_fwd, 512, LDS_BYTES);
        if (per_cu < 1) { fprintf(stderr, "kernel_launch: occupancy query says %d blocks per CU\n", per_cu); per_cu = 1; }
        (void)hipGetLastError();
        grid = cus * 1;
    }
    if (grid < 0) return;
    if (hipMemsetAsync(d_ws, 0, 65536, stream) != hipSuccess) { fprintf(stderr, "kernel_launch: memset of the barrier words failed\n"); return; }
    Args a{};
    for (int i = 0; i < 35; ++i) a.in[i] = (const float*)d_in[i];
    a.out = (float*)d_out; a.ws = (unsigned char*)d_ws;
#if MK_COOP
    a.ph_lo = 0; a.ph_hi = NPHASE;
    void* kargs[] = {&a};
    hipError_t e = hipLaunchCooperativeKernel((const void*)mk_fwd, dim3(grid), dim3(512), kargs, LDS_BYTES, stream);
    if (e != hipSuccess) fprintf(stderr, "cooperative launch failed: %s (grid %d)\n", hipGetErrorString(e), grid);
#else
    for (int ph = 0; ph < NPHASE; ++ph) { a.ph_lo = ph; a.ph_hi = ph + 1; hipLaunchKernelGGL(mk_fwd, dim3(grid), dim3(512), LDS_BYTES, stream, a); }
#endif
}
```
